# Optimizing an MI355X kernel written in HIP

```python
import jax, jax.numpy as jnp
from jax import lax
import numpy as np

D_MODEL = 1024
BATCH = 16
SEQ = 2048
DEPTH = 1

CHUNK = 64
PREV_CHUNKS = 8
BAND = (PREV_CHUNKS + 1) * CHUNK

HEAD_DIM = 64
RWKV_HEADS = 8
ATT_HEADS = 8
RWKV_WIDTH = RWKV_HEADS * HEAD_DIM
ATT_WIDTH = ATT_HEADS * HEAD_DIM
DECAY_LORA = 64
ICLR_LORA = 64
GATE_LORA = 128
N_BRANCH = 2
REL_CLIP = 128
N_REL = 2 * REL_CLIP + 1

RWKV_COLS = 3 * RWKV_WIDTH + DECAY_LORA + ICLR_LORA + GATE_LORA
ATT_COLS = 3 * ATT_WIDTH
GATE_COLS = N_BRANCH * D_MODEL
IN_COLS = RWKV_COLS + ATT_COLS + GATE_COLS

N_GROUPS = 4
EXPERTS_PER_GROUP = 8
N_EXPERTS = N_GROUPS * EXPERTS_PER_GROUP
TOP_K = 2
D_EXPERT = 512
ROUTE_BLOCK = 128

NORM_EPS = 1e-6
GN_EPS = 64e-5
NEG_INF = -1e30

kernel_name = "hybrid_rwkv7_chunkattn_hiermoe_adaln"


def rms_norm(x, gain):
    xf = x.astype(jnp.float32)
    y = xf * lax.rsqrt(jnp.mean(xf * xf, axis=-1, keepdims=True) + NORM_EPS)
    return (y * gain.astype(jnp.float32)).astype(x.dtype)


def modulate(h, shift, scale):
    return h * (1 + scale[:, None, :]) + shift[:, None, :]


def token_shift(p, mu):
    prev = jnp.pad(p, ((0, 0), (1, 0), (0, 0)))[:, :-1]
    return p + (prev - p) * mu


def rwkv7_branch(p, mu, w0, w_up, a0, a_up, g_up, k_k, k_a, r_k, lnx_g, lnx_b):
    dt = p.dtype
    Bn, S, _ = p.shape
    f32 = jnp.float32
    p = token_shift(p.astype(f32), mu.astype(f32))
    o1, o2, o3 = RWKV_WIDTH, 2 * RWKV_WIDTH, 3 * RWKV_WIDTH
    o4, o5 = o3 + DECAY_LORA, o3 + DECAY_LORA + ICLR_LORA
    r, k, v = p[..., :o1], p[..., o1:o2], p[..., o2:o3]
    wd, ad, gd = p[..., o3:o4], p[..., o4:o5], p[..., o5:]
    w = -jax.nn.softplus(-(w0.astype(f32) + jnp.tanh(wd) @ w_up.astype(f32))) - 0.5
    decay = jnp.exp(-jnp.exp(w))
    a = jax.nn.sigmoid(a0.astype(f32) + ad @ a_up.astype(f32))
    g = jax.nn.sigmoid(gd) @ g_up.astype(f32)

    def heads(t):
        return t.reshape(Bn, S, RWKV_HEADS, HEAD_DIM)

    r, k, v, decay, a = heads(r), heads(k), heads(v), heads(decay), heads(a)
    kk = k * k_k.astype(f32).reshape(RWKV_HEADS, HEAD_DIM)
    kk = kk / jnp.maximum(jnp.sqrt(jnp.sum(kk * kk, axis=-1, keepdims=True)), 1e-12)
    k = k * (1 + (a - 1) * k_a.astype(f32).reshape(RWKV_HEADS, HEAD_DIM))

    def step(state, inp):
        r_t, w_t, k_t, v_t, a_t, b_t = inp
        sa = jnp.einsum('bhvk,bhk->bhv', state, a_t)
        state = (state * w_t[:, :, None, :] + sa[..., None] * b_t[:, :, None, :]
                 + v_t[..., None] * k_t[:, :, None, :])
        return state, jnp.einsum('bhvk,bhk->bhv', state, r_t)

    tm = lambda t: jnp.swapaxes(t, 0, 1)
    state0 = jnp.zeros((Bn, RWKV_HEADS, HEAD_DIM, HEAD_DIM), f32)
    _, y = lax.scan(step, state0, (tm(r), tm(decay), tm(k), tm(v), tm(-kk), tm(kk * a)))
    y = tm(y)
    mean = jnp.mean(y, axis=-1, keepdims=True)
    var = jnp.mean(jnp.square(y - mean), axis=-1, keepdims=True)
    y = ((y - mean) * lax.rsqrt(var + GN_EPS)).reshape(Bn, S, RWKV_WIDTH)
    y = y * lnx_g.astype(f32) + lnx_b.astype(f32)
    bonus = jnp.sum(r * k * r_k.astype(f32), axis=-1, keepdims=True) * v
    y = (y + bonus.reshape(Bn, S, RWKV_WIDTH)) * g
    return y.astype(dt)


def chunk_attention_branch(p, q_g, k_g, rel_bias):
    dt = p.dtype
    Bn, S, _ = p.shape
    f32 = jnp.float32
    pf = p.astype(f32)

    def heads(t):
        return t.reshape(Bn, S, ATT_HEADS, HEAD_DIM).transpose(0, 2, 1, 3)

    q = heads(pf[..., :ATT_WIDTH])
    k = heads(pf[..., ATT_WIDTH:2 * ATT_WIDTH])
    v = heads(pf[..., 2 * ATT_WIDTH:])
    q = rms_norm(q, q_g) * (HEAD_DIM ** -0.5)
    k = rms_norm(k, k_g)
    pad = ((0, 0), (0, 0), (PREV_CHUNKS * CHUNK, 0), (0, 0))
    kp = jnp.pad(k, pad)
    vp = jnp.pad(v, pad)
    q_off = jnp.arange(CHUNK)[:, None]
    k_off = jnp.arange(BAND) - PREV_CHUNKS * CHUNK
    rel_idx = jnp.clip(k_off[None, :] - q_off, -REL_CLIP, REL_CLIP) + REL_CLIP
    bias = rel_bias.astype(f32)[:, rel_idx]

    def one_chunk(ci):
        start = ci * CHUNK
        qc = lax.dynamic_slice_in_dim(q, start, CHUNK, axis=2)
        kb = lax.dynamic_slice_in_dim(kp, start, BAND, axis=2)
        vb = lax.dynamic_slice_in_dim(vp, start, BAND, axis=2)
        s = jnp.einsum('bhqd,bhkd->bhqk', qc, kb) + bias
        valid = (start + k_off) >= 0
        s = jnp.where(valid, s, NEG_INF)
        return jnp.einsum('bhqk,bhkd->bhqd', jax.nn.softmax(s, axis=-1), vb)

    o = lax.map(one_chunk, jnp.arange(S // CHUNK))
    o = o.transpose(1, 0, 3, 2, 4).reshape(Bn, S, ATT_WIDTH)
    return o.astype(dt)


def hier_moe(h, wc, bc, wf, bf, w_gate, w_up, w_down):
    Bn, S, D = h.shape
    f32 = jnp.float32
    n_tok = Bn * S
    xt = h.reshape(n_tok, D)
    xf = xt.astype(f32)
    coarse_p = jax.nn.softmax(xf @ wc.astype(f32) + bc.astype(f32), axis=-1)
    grp = jnp.argmax(coarse_p, axis=-1)
    p_grp = jnp.take_along_axis(coarse_p, grp[:, None], axis=-1)
    fine = (xf @ wf.astype(f32) + bf.astype(f32)).reshape(n_tok, N_GROUPS, EXPERTS_PER_GROUP)
    fine = jnp.take_along_axis(fine, grp[:, None, None], axis=1)[:, 0]
    top_v, top_i = lax.top_k(jax.nn.softmax(fine, axis=-1), TOP_K)
    weights = p_grp * top_v / jnp.sum(top_v, axis=-1, keepdims=True)
    eid = (grp[:, None] * EXPERTS_PER_GROUP + top_i).reshape(-1)

    n_asg = n_tok * TOP_K
    order = jnp.argsort(eid)
    e_sorted = eid[order]
    counts = jnp.bincount(eid, length=N_EXPERTS)
    padded = (counts + ROUTE_BLOCK - 1) // ROUTE_BLOCK * ROUTE_BLOCK
    starts = jnp.cumsum(counts) - counts
    pad_ends = jnp.cumsum(padded)
    pad_starts = pad_ends - padded
    dest = pad_starts[e_sorted] + jnp.arange(n_asg) - starts[e_sorted]
    n_rows = n_asg + N_EXPERTS * ROUTE_BLOCK
    n_blocks = n_rows // ROUTE_BLOCK
    buf = jnp.zeros((n_rows, D), xt.dtype).at[dest].set(xt[order // TOP_K])
    block_e = jnp.minimum(
        jnp.searchsorted(pad_ends, jnp.arange(n_blocks) * ROUTE_BLOCK, side='right'), N_EXPERTS - 1)

    def expert_block(args):
        xb, e = args
        hid = jax.nn.silu(xb @ w_gate[e]) * (xb @ w_up[e])
        return hid @ w_down[e]

    yb = lax.map(expert_block, (buf.reshape(n_blocks, ROUTE_BLOCK, D), block_e)).reshape(n_rows, D)
    y_asg = jnp.zeros((n_asg, D), yb.dtype).at[order].set(yb[dest])
    out = jnp.einsum('nkd,nk->nd', y_asg.reshape(n_tok, TOP_K, D).astype(f32), weights)
    return out.astype(h.dtype).reshape(Bn, S, D)


def setup_inputs(seed: int = 0) -> dict:
    key = jax.random.key(seed)
    ks = iter(jax.random.split(key, 40))
    f32 = jnp.float32
    L = DEPTH

    def nrm(shape, scale):
        return jax.random.normal(next(ks), shape, f32) * scale

    return {
        "x": nrm((BATCH, SEQ, D_MODEL), 1.0),
        "c": nrm((BATCH, D_MODEL), 1.0),
        "w_ada": nrm((L, D_MODEL, 6 * D_MODEL), 0.5 * D_MODEL ** -0.5),
        "b_ada": nrm((L, 6 * D_MODEL), 0.02),
        "norm1_g": 1.0 + nrm((L, D_MODEL), 0.05),
        "w_in": nrm((L, D_MODEL, IN_COLS), D_MODEL ** -0.5),
        "rwkv_mu": jax.random.uniform(next(ks), (L, RWKV_COLS), f32),
        "rwkv_w0": nrm((L, RWKV_WIDTH), 0.5),
        "rwkv_w_up": nrm((L, DECAY_LORA, RWKV_WIDTH), 0.3 * DECAY_LORA ** -0.5),
        "rwkv_a0": nrm((L, RWKV_WIDTH), 0.3),
        "rwkv_a_up": nrm((L, ICLR_LORA, RWKV_WIDTH), 0.3 * ICLR_LORA ** -0.5),
        "rwkv_g_up": nrm((L, GATE_LORA, RWKV_WIDTH), GATE_LORA ** -0.5),
        "rwkv_k_k": 0.85 + nrm((L, RWKV_WIDTH), 0.05),
        "rwkv_k_a": 1.0 + nrm((L, RWKV_WIDTH), 0.05),
        "rwkv_r_k": nrm((L, RWKV_HEADS, HEAD_DIM), 0.1),
        "rwkv_lnx_g": 1.0 + nrm((L, RWKV_WIDTH), 0.05),
        "rwkv_lnx_b": nrm((L, RWKV_WIDTH), 0.02),
        "attn_q_g": 1.0 + nrm((L, HEAD_DIM), 0.05),
        "attn_k_g": 1.0 + nrm((L, HEAD_DIM), 0.05),
        "attn_rel_bias": nrm((L, ATT_HEADS, N_REL), 0.5),
        "w_branch_rwkv": nrm((L, RWKV_WIDTH, D_MODEL), RWKV_WIDTH ** -0.5),
        "w_branch_attn": nrm((L, ATT_WIDTH, D_MODEL), ATT_WIDTH ** -0.5),
        "w_out": nrm((L, D_MODEL, D_MODEL), D_MODEL ** -0.5),
        "norm2_g": 1.0 + nrm((L, D_MODEL), 0.05),
        "router_coarse_w": nrm((L, D_MODEL, N_GROUPS), D_MODEL ** -0.5),
        "router_coarse_b": nrm((L, N_GROUPS), 0.01),
        "router_fine_w": nrm((L, D_MODEL, N_EXPERTS), D_MODEL ** -0.5),
        "router_fine_b": nrm((L, N_EXPERTS), 0.01),
        "expert_w_gate": nrm((L, N_EXPERTS, D_MODEL, D_EXPERT), D_MODEL ** -0.5),
        "expert_w_up": nrm((L, N_EXPERTS, D_MODEL, D_EXPERT), D_MODEL ** -0.5),
        "expert_w_down": nrm((L, N_EXPERTS, D_EXPERT, D_MODEL), D_EXPERT ** -0.5),
    }


def reference(x, c, w_ada, b_ada, norm1_g, w_in, rwkv_mu, rwkv_w0, rwkv_w_up, rwkv_a0,
              rwkv_a_up, rwkv_g_up, rwkv_k_k, rwkv_k_a, rwkv_r_k, rwkv_lnx_g, rwkv_lnx_b,
              attn_q_g, attn_k_g, attn_rel_bias, w_branch_rwkv, w_branch_attn, w_out, norm2_g,
              router_coarse_w, router_coarse_b, router_fine_w, router_fine_b,
              expert_w_gate, expert_w_up, expert_w_down):
    for l in range(DEPTH):
        mod = jax.nn.silu(c) @ w_ada[l] + b_ada[l]
        sh1, sc1, g1, sh2, sc2, g2 = jnp.split(mod, 6, axis=-1)

        h = modulate(rms_norm(x, norm1_g[l]), sh1, sc1)
        p = h @ w_in[l]
        p_rwkv = p[..., :RWKV_COLS]
        p_att = p[..., RWKV_COLS:RWKV_COLS + ATT_COLS]
        p_gate = p[..., RWKV_COLS + ATT_COLS:]
        y_r = rwkv7_branch(p_rwkv, rwkv_mu[l], rwkv_w0[l], rwkv_w_up[l], rwkv_a0[l], rwkv_a_up[l],
                           rwkv_g_up[l], rwkv_k_k[l], rwkv_k_a[l], rwkv_r_k[l],
                           rwkv_lnx_g[l], rwkv_lnx_b[l]) @ w_branch_rwkv[l]
        y_a = chunk_attention_branch(p_att, attn_q_g[l], attn_k_g[l],
                                     attn_rel_bias[l]) @ w_branch_attn[l]
        gate_r = jax.nn.sigmoid(p_gate[..., :D_MODEL])
        gate_a = jax.nn.sigmoid(p_gate[..., D_MODEL:])
        mixed = (gate_r * y_r + gate_a * y_a) @ w_out[l]
        x = x + g1[:, None, :] * mixed

        h2 = modulate(rms_norm(x, norm2_g[l]), sh2, sc2)
        x = x + g2[:, None, :] * hier_moe(h2, router_coarse_w[l], router_coarse_b[l],
                                          router_fine_w[l], router_fine_b[l],
                                          expert_w_gate[l], expert_w_up[l], expert_w_down[l])
    return x
```

```cpp
#include <hip/hip_runtime.h>
#include <cstdio>
#include <cstdint>

#define LAS __attribute__((address_space(3)))
#define GAS __attribute__((address_space(1)))
typedef unsigned short bf16_t;
typedef short bf16x8 __attribute__((ext_vector_type(8)));
typedef short s16x4 __attribute__((ext_vector_type(4)));
typedef float f32x4 __attribute__((ext_vector_type(4)));
typedef float f32x2 __attribute__((ext_vector_type(2)));
typedef float f32x16 __attribute__((ext_vector_type(16)));
typedef unsigned u32x4 __attribute__((ext_vector_type(4)));
typedef unsigned u32x2 __attribute__((ext_vector_type(2)));

constexpr int NB = 16, SEQ = 2048, DM = 1024, NTOK = NB * SEQ;
constexpr int RCOLS = 1792, ACOLS = 1536, GCOLS = 2048, INCOLS = 5376;
constexpr int NE = 32, DE = 512, NLIST = 64;
constexpr int MODW = 6 * DM;
constexpr float LOG2E = 1.4426950408889634f;

__device__ __forceinline__ unsigned cvt_pk_bf16(float lo, float hi) { unsigned r; asm volatile("v_cvt_pk_bf16_f32 %0, %1, %2" : "=v"(r) : "v"(lo), "v"(hi)); return r; }
__device__ __forceinline__ float bf_lo(unsigned w) { return __uint_as_float(w << 16); }
__device__ __forceinline__ float bf_hi(unsigned w) { return __uint_as_float(w & 0xffff0000u); }
__device__ __forceinline__ float sigmoidf_(float x) { return __builtin_amdgcn_rcpf(1.0f + __builtin_amdgcn_exp2f(-x * LOG2E)); }

namespace pg8 {
constexpr int BM = 256, BK = 64, HALF = 128, HTB = HALF * BK * 2, STAGE_BYTES = 8 * HTB, NXCD = 8, WGM = 8;
__host__ __device__ __forceinline__ int lds_byte(int r, int c) { const int st = (r >> 4) * 2 + (c >> 5), rr = r & 15, cc = c & 31, ob = rr * 64 + cc * 2; return st * 1024 + (ob ^ (((ob >> 9) & 1) << 5)); }
__host__ __device__ __forceinline__ void stage_rc(int b, int& R, int& C) { const int st = b / 1024, sb = b % 1024, swz = sb ^ (((sb >> 9) & 1) << 5); R = (st >> 1) * 16 + swz / 64; C = (st & 1) * 32 + (swz % 64) / 2; }
__host__ __device__ __forceinline__ int perm32(int rho) { const int n = rho >> 4, i = rho & 15; return 8 * (i >> 2) + 4 * n + (i & 3); }

struct Unit { int pm, pn, e; };
struct Gemm { int lda, ldb, K; };

struct DenseOrder {
    const bf16_t* A; const bf16_t* Bt; int lda, ldb;
    int nM, nN, nwg, G, c;
    __device__ void init(const bf16_t* A_, const bf16_t* Bt_, int lda_, int ldb_, int M, int N, int G_, int c_) { A = A_; Bt = Bt_; lda = lda_; ldb = ldb_; nM = M / BM; nN = N / BM; nwg = nM * nN; G = G_; c = c_; }
    __device__ bool next(int i, Unit& u) const {
        const long L = (long)i * G + c; if (L >= nwg) return false;
        int wgid = (int)L; { const int q = nwg / NXCD, r = nwg % NXCD, xcd = wgid % NXCD, off = wgid / NXCD; wgid = (xcd < r ? xcd * (q + 1) : r * (q + 1) + (xcd - r) * q) + off; }
        const int nig = WGM * nN, gid = wgid / nig, fm = gid * WGM, gsz = (nM - fm) < WGM ? (nM - fm) : WGM;
        u.pm = fm + ((wgid % nig) % gsz); u.pn = (wgid % nig) / gsz; u.e = 0; return true;
    }
    __device__ __forceinline__ const char* a_base(const Unit& u) const { return (const char*)A + (size_t)u.pm * BM * lda * 2; }
    __device__ __forceinline__ const char* b_base(const Unit& u) const { return (const char*)Bt + (size_t)u.pn * BM * ldb * 2; }
};
struct MoeOrder {
    const bf16_t* A; const bf16_t* Bt; int lda, ldb; size_t bt_expert_stride;
    const LAS int* toff;
    int tlo, thi, G, c;
    __device__ bool next(int i, Unit& u) const {
        const long L = (long)i * G + c; const int nt = thi - tlo; if (L >= (long)nt * 4) return false;
        const int tile = tlo + (int)(L >> 2); u.pm = tile; u.pn = (int)(L & 3);
        int l = 0;
#pragma unroll 1
        for (int j = 1; j < NLIST; ++j) l += (toff[j] <= tile) ? 1 : 0;
        u.e = l & 31; return true;
    }
    __device__ __forceinline__ const char* a_base(const Unit& u) const { return (const char*)A + (size_t)u.pm * BM * lda * 2; }
    __device__ __forceinline__ const char* b_base(const Unit& u) const { return (const char*)Bt + ((size_t)u.e * bt_expert_stride + (size_t)u.pn * BM * ldb) * 2; }
};

template <class Epi, class Sched, bool ALIGN_EPI>
__device__ __forceinline__ void gemm_phase(LAS unsigned char* lds, const Gemm g, const Sched& S, const Epi& E) {
    const int tid = threadIdx.x, wid = __builtin_amdgcn_readfirstlane(tid >> 6), lane = tid & 63, wr = wid >> 2, wc = wid & 3, fr = lane & 15, fq = lane >> 4;
    const int K = g.K, nt = K / BK;
    unsigned voffA[2], voffB[2];
#pragma unroll
    for (int i = 0; i < 2; ++i) { int R, C; stage_rc(tid * 16 + i * 8192, R, C); const int Rb = Epi::PERM ? ((R & ~31) + perm32(R & 31)) : R;
        voffA[i] = (unsigned)(R * g.lda + C) * 2u; voffB[i] = (unsigned)(Rb * g.ldb + C) * 2u; }
    const size_t kstep = (size_t)(BK * 2);
    const size_t hstepA = (size_t)HALF * g.lda * 2, hstepB = (size_t)HALF * g.ldb * 2;
    const unsigned ldsw = (unsigned)wid * 1024u;
    const int aoff = lds_byte(wr * 64 + fr, fq * 8), boff = lds_byte(wc * 32 + fr, fq * 8);
#define PG8_SA(b, h) (((b) * 2 + (h)) * HTB)
#define PG8_SB(b, h) ((4 + (b) * 2 + (h)) * HTB)
#define PG8_STAGE(bufoff, gbase, voff) do { _Pragma("unroll") for (int _i = 0; _i < 2; ++_i) \
        __builtin_amdgcn_global_load_lds((const unsigned*)((const char*)(gbase) + (voff)[_i]), (LAS unsigned*)(lds + (bufoff) + ldsw + _i * 8192), 16, 0, 0); } while (0)
#define PG8_LDA(dst, b, h) do { _Pragma("unroll") for (int m = 0; m < 4; ++m) _Pragma("unroll") for (int k = 0; k < 2; ++k) dst[m][k] = *(const LAS bf16x8*)(lds + PG8_SA(b, h) + aoff + m * 2048 + k * 1024); } while (0)
#define PG8_LDB(dst, b, h) do { _Pragma("unroll") for (int n = 0; n < 2; ++n) _Pragma("unroll") for (int k = 0; k < 2; ++k) dst[n][k] = *(const LAS bf16x8*)(lds + PG8_SB(b, h) + boff + n * 2048 + k * 1024); } while (0)
#define PG8_MMA(ai, bj, At, Bt) do { __builtin_amdgcn_s_setprio(1); _Pragma("unroll") for (int m = 0; m < 4; ++m) _Pragma("unroll") for (int n = 0; n < 2; ++n) _Pragma("unroll") for (int k = 0; k < 2; ++k) \
        acc[ai][bj][m][n] = __builtin_amdgcn_mfma_f32_16x16x32_bf16(Bt[n][k], At[m][k], acc[ai][bj][m][n], 0, 0, 0); __builtin_amdgcn_s_setprio(0); } while (0)
#define PG8_WAIT_V(n) asm volatile("s_waitcnt vmcnt(" #n ")" ::: "memory")
#define PG8_WAIT_L(n) asm volatile("s_waitcnt lgkmcnt(" #n ")" ::: "memory")
#define PG8_BAR __builtin_amdgcn_s_barrier()
#define PG8_SCHED __builtin_amdgcn_sched_barrier(0)
    Unit cur, nxt; int ui = 0;
    if (!S.next(0, cur)) return;
    f32x4 acc[2][2][4][2];
#pragma unroll
    for (int a = 0; a < 2; ++a)
#pragma unroll
        for (int b = 0; b < 2; ++b)
#pragma unroll
            for (int m = 0; m < 4; ++m)
#pragma unroll
                for (int n = 0; n < 2; ++n) acc[a][b][m][n] = (f32x4){0.f, 0.f, 0.f, 0.f};
    bf16x8 At[4][2], B0[2][2], B1[2][2];
    const char* cA = S.a_base(cur); const char* cB = S.b_base(cur);
    PG8_STAGE(PG8_SB(0, 0), cB, voffB); PG8_STAGE(PG8_SB(0, 1), cB + hstepB, voffB); PG8_STAGE(PG8_SA(0, 0), cA, voffA); PG8_STAGE(PG8_SA(0, 1), cA + hstepA, voffA);
    if (wr == 1) PG8_BAR;
    PG8_WAIT_V(2); PG8_BAR;
    PG8_STAGE(PG8_SB(1, 0), cB + kstep, voffB); PG8_STAGE(PG8_SA(1, 0), cA + kstep, voffA); PG8_STAGE(PG8_SB(1, 1), cB + hstepB + kstep, voffB);
    PG8_WAIT_V(6); PG8_BAR;
    for (;;) {
        const bool has_next = S.next(ui + 1, nxt);
        const char* nA = has_next ? S.a_base(nxt) : cA; const char* nB = has_next ? S.b_base(nxt) : cB;
        for (int t = 0; t < nt; t += 2) {
            const bool last = (t == nt - 2);
            const char* a1 = cA + (size_t)(t + 1) * kstep;
            const char* a2 = last ? nA : cA + (size_t)(t + 2) * kstep; const char* b2 = last ? nB : cB + (size_t)(t + 2) * kstep;
            const char* a3 = a2 + kstep; const char* b3 = b2 + kstep;
            PG8_LDB(B0, 0, 0); PG8_LDB(B1, 0, 1); PG8_SCHED; PG8_LDA(At, 0, 0); PG8_STAGE(PG8_SA(1, 1), a1 + hstepA, voffA);
            PG8_WAIT_V(8); PG8_WAIT_L(0); PG8_BAR; PG8_MMA(0, 0, At, B0); PG8_MMA(0, 1, At, B1); PG8_BAR; PG8_SCHED;
            PG8_LDA(At, 0, 1); PG8_STAGE(PG8_SB(0, 0), b2, voffB); PG8_STAGE(PG8_SB(0, 1), b2 + hstepB, voffB); PG8_STAGE(PG8_SA(0, 0), a2, voffA);
            PG8_WAIT_V(8); PG8_WAIT_L(0); PG8_BAR; PG8_MMA(1, 0, At, B0); PG8_MMA(1, 1, At, B1); PG8_BAR; PG8_SCHED;
            PG8_LDB(B0, 1, 0); PG8_LDB(B1, 1, 1); PG8_SCHED; PG8_LDA(At, 1, 0); PG8_STAGE(PG8_SA(0, 1), a2 + hstepA, voffA);
            PG8_WAIT_V(8); PG8_WAIT_L(0); PG8_BAR; PG8_MMA(0, 0, At, B0); PG8_MMA(0, 1, At, B1); PG8_BAR; PG8_SCHED;
            PG8_LDA(At, 1, 1); PG8_STAGE(PG8_SB(1, 0), b3, voffB); PG8_STAGE(PG8_SB(1, 1), b3 + hstepB, voffB); PG8_STAGE(PG8_SA(1, 0), a3, voffA);
            PG8_WAIT_V(8); PG8_WAIT_L(0); PG8_BAR; PG8_MMA(1, 0, At, B0); PG8_MMA(1, 1, At, B1); PG8_BAR; PG8_SCHED;
        }
        if constexpr (ALIGN_EPI) { if (wr == 0) PG8_BAR; }
        E(acc, cur, wr, wc, fr, fq);
        if (!has_next) break;
#pragma unroll
        for (int a = 0; a < 2; ++a)
#pragma unroll
            for (int b = 0; b < 2; ++b)
#pragma unroll
                for (int m = 0; m < 4; ++m)
#pragma unroll
                    for (int n = 0; n < 2; ++n) acc[a][b][m][n] = (f32x4){0.f, 0.f, 0.f, 0.f};
        cur = nxt; cA = nA; cB = nB; ++ui;
        if constexpr (ALIGN_EPI) { if (wr == 1) PG8_BAR; }
    }
    PG8_WAIT_V(0);
    if constexpr (!ALIGN_EPI) { if (wr == 0) PG8_BAR; }
    PG8_BAR;
#undef PG8_SA
#undef PG8_SB
#undef PG8_STAGE
#undef PG8_LDA
#undef PG8_LDB
#undef PG8_MMA
#undef PG8_WAIT_V
#undef PG8_WAIT_L
#undef PG8_BAR
#undef PG8_SCHED
}

struct EpiP {
    static constexpr bool PERM = true;
    bf16_t *Prw, *Patt, *Pgate;
    __device__ __forceinline__ void operator()(const f32x4 (&acc)[2][2][4][2], const Unit& u, int wr, int wc, int fr, int fq) const {
        const int row0 = u.pm * BM + wr * 64 + fr; bf16_t* base; int ldc, colt; bool sig = false;
        if (u.pn < 7) { base = Prw; ldc = RCOLS; colt = u.pn * BM; } else if (u.pn < 13) { base = Patt; ldc = ACOLS; colt = (u.pn - 7) * BM; } else { base = Pgate; ldc = GCOLS; colt = (u.pn - 13) * BM; sig = true; }
        const int col0 = colt + wc * 32 + 8 * fq;
#pragma unroll
        for (int ai = 0; ai < 2; ++ai)
#pragma unroll
            for (int m = 0; m < 4; ++m) { bf16_t* rowp = base + (size_t)(row0 + ai * HALF + m * 16) * ldc + col0;
#pragma unroll
                for (int bj = 0; bj < 2; ++bj) { f32x4 v0 = acc[ai][bj][m][0], v1 = acc[ai][bj][m][1];
                    if (sig) {
#pragma unroll
                        for (int j = 0; j < 4; ++j) { v0[j] = sigmoidf_(v0[j]); v1[j] = sigmoidf_(v1[j]); } }
                    u32x4 w; w.x = cvt_pk_bf16(v0[0], v0[1]); w.y = cvt_pk_bf16(v0[2], v0[3]); w.z = cvt_pk_bf16(v1[0], v1[1]); w.w = cvt_pk_bf16(v1[2], v1[3]);
                    *(u32x4*)(rowp + bj * HALF) = w; } }
    }
};
template <bool SECOND> struct EpiBranch {
    static constexpr bool PERM = true;
    bf16_t* T; const bf16_t* Pgate;
    __device__ __forceinline__ void operator()(const f32x4 (&acc)[2][2][4][2], const Unit& u, int wr, int wc, int fr, int fq) const {
        const int row0 = u.pm * BM + wr * 64 + fr, col0 = u.pn * BM + wc * 32 + 8 * fq;
#pragma unroll
        for (int ai = 0; ai < 2; ++ai)
#pragma unroll
            for (int m = 0; m < 4; ++m) { const size_t row = (size_t)(row0 + ai * HALF + m * 16);
#pragma unroll
                for (int bj = 0; bj < 2; ++bj) { const int col = col0 + bj * HALF;
                    const u32x4 gw = *(const u32x4*)(Pgate + row * GCOLS + (SECOND ? DM : 0) + col);
                    f32x4 v0 = acc[ai][bj][m][0], v1 = acc[ai][bj][m][1];
                    v0[0] *= bf_lo(gw.x); v0[1] *= bf_hi(gw.x); v0[2] *= bf_lo(gw.y); v0[3] *= bf_hi(gw.y); v1[0] *= bf_lo(gw.z); v1[1] *= bf_hi(gw.z); v1[2] *= bf_lo(gw.w); v1[3] *= bf_hi(gw.w);
                    bf16_t* tp = T + row * DM + col;
                    if (SECOND) { const u32x4 tw = *(const u32x4*)tp;
                        v0[0] += bf_lo(tw.x); v0[1] += bf_hi(tw.x); v0[2] += bf_lo(tw.y); v0[3] += bf_hi(tw.y); v1[0] += bf_lo(tw.z); v1[1] += bf_hi(tw.z); v1[2] += bf_lo(tw.w); v1[3] += bf_hi(tw.w); }
                    u32x4 w; w.x = cvt_pk_bf16(v0[0], v0[1]); w.y = cvt_pk_bf16(v0[2], v0[3]); w.z = cvt_pk_bf16(v1[0], v1[1]); w.w = cvt_pk_bf16(v1[2], v1[3]);
                    *(u32x4*)tp = w; } }
    }
};
struct EpiOut {
    static constexpr bool PERM = false;
    const float* x; float* out; const float* mod;
    __device__ __forceinline__ void operator()(const f32x4 (&acc)[2][2][4][2], const Unit& u, int wr, int wc, int fr, int fq) const {
        const int row0 = u.pm * BM + wr * 64 + fr, col0 = u.pn * BM + wc * 32 + 4 * fq;
        const int b = (u.pm * BM) / SEQ; const float* g1 = mod + (size_t)b * MODW + 2 * DM;
        f32x4 gv[2][2];
#pragma unroll
        for (int bj = 0; bj < 2; ++bj)
#pragma unroll
            for (int n = 0; n < 2; ++n) gv[bj][n] = *(const f32x4*)(g1 + col0 + bj * HALF + n * 16);
#pragma unroll
        for (int ai = 0; ai < 2; ++ai)
#pragma unroll
            for (int m = 0; m < 4; ++m) { const size_t off = (size_t)(row0 + ai * HALF + m * 16) * DM + col0;
#pragma unroll
                for (int bj = 0; bj < 2; ++bj)
#pragma unroll
                    for (int n = 0; n < 2; ++n) { const f32x4 xv = *(const f32x4*)(x + off + bj * HALF + n * 16); *(f32x4*)(out + off + bj * HALF + n * 16) = xv + gv[bj][n] * acc[ai][bj][m][n]; } }
    }
};
struct EpiHid {
    static constexpr bool PERM = true;
    bf16_t* hid;
    __device__ __forceinline__ void operator()(const f32x4 (&acc)[2][2][4][2], const Unit& u, int wr, int wc, int fr, int fq) const {
        const int row0 = u.pm * BM + wr * 64 + fr, hc0 = u.pn * 128 + wc * 16 + 4 * fq;
#pragma unroll
        for (int ai = 0; ai < 2; ++ai)
#pragma unroll
            for (int m = 0; m < 4; ++m) { bf16_t* rowp = hid + (size_t)(row0 + ai * HALF + m * 16) * DE + hc0;
#pragma unroll
                for (int bj = 0; bj < 2; ++bj) { const f32x4 gt = acc[ai][bj][m][0], up = acc[ai][bj][m][1]; float h[4];
#pragma unroll
                    for (int j = 0; j < 4; ++j) h[j] = gt[j] * sigmoidf_(gt[j]) * up[j];
                    u32x2 w; w.x = cvt_pk_bf16(h[0], h[1]); w.y = cvt_pk_bf16(h[2], h[3]); *(u32x2*)(rowp + bj * 64) = w; } }
    }
};
struct EpiDown {
    static constexpr bool PERM = false;
    float* out; const float* mod; const int* slot_tok; const float* slot_w;
    __device__ __forceinline__ void operator()(const f32x4 (&acc)[2][2][4][2], const Unit& u, int wr, int wc, int fr, int fq) const {
        const int row0 = u.pm * BM + wr * 64 + fr, col0 = u.pn * BM + wc * 32 + 4 * fq;
#pragma unroll
        for (int ai = 0; ai < 2; ++ai)
#pragma unroll
            for (int m = 0; m < 4; ++m) { const int slot = row0 + ai * HALF + m * 16; const int tok = slot_tok[slot];
                if (tok >= 0) { const float w = slot_w[slot]; const float* g2 = mod + (size_t)(tok / SEQ) * MODW + 5 * DM; float* orow = out + (size_t)tok * DM + col0;
#pragma unroll
                    for (int bj = 0; bj < 2; ++bj)
#pragma unroll
                        for (int n = 0; n < 2; ++n) { const f32x4 gv = *(const f32x4*)(g2 + col0 + bj * HALF + n * 16); f32x4* op = (f32x4*)(orow + bj * HALF + n * 16); *op = *op + gv * w * acc[ai][bj][m][n]; } } }
    }
};
}
typedef GAS unsigned gu32;
#define RLX_AGENT __ATOMIC_RELAXED, __HIP_MEMORY_SCOPE_AGENT
#define LDS_WAIT() asm volatile("s_waitcnt lgkmcnt(0)" ::: "memory")
#define VM_WAIT() asm volatile("s_waitcnt vmcnt(0)" ::: "memory")
#define XB_TMO      128
#define XB_XCNT(j)  (256  + 64 * (j))
#define XB_XSUB(j)  (1280 + 64 * (j))
#define XB_XGEN(j)  (2304 + 64 * (j))
#define XB_TOP      3328
#define XB_TOPGEN   3392
#define XCD_BAR_WORDS 3456
#define XB_SPIN_CAP (1u << 18)

__device__ __forceinline__ unsigned xb_ld(unsigned* p)              { return __hip_atomic_load(p, __ATOMIC_RELAXED, __HIP_MEMORY_SCOPE_AGENT); }
__device__ __forceinline__ unsigned xb_add(unsigned* p, unsigned v) { return __hip_atomic_fetch_add(p, v, __ATOMIC_RELAXED, __HIP_MEMORY_SCOPE_AGENT); }
__device__ __forceinline__ unsigned xb_xcc_id() { return (unsigned)__builtin_amdgcn_s_getreg((3 << 11) | 20) & 0xFu; }
#define XB_SPIN(cond, bar) do { unsigned _sp = 0; while (cond) { __builtin_amdgcn_s_sleep(1); \
    if ((++_sp & 255u) == 0u) { if (xb_ld(&(bar)[XB_TMO])) break; if (_sp > XB_SPIN_CAP) { atomicAdd(&(bar)[XB_TMO], 1u); break; } } } } while (0)

struct XcdBarrier {
    unsigned* bar; unsigned x;
    volatile LAS unsigned* st;
};

__device__ __forceinline__ XcdBarrier xcd_barrier_post(unsigned* bar, volatile LAS unsigned* st) {
    XcdBarrier b; b.bar = bar; b.x = xb_xcc_id(); b.st = st;
    if (threadIdx.x == 0) (void)xb_add(&bar[XB_XCNT(b.x)], 1u);
    return b;
}
__device__ __forceinline__ void xcd_barrier_complete(unsigned* bar, unsigned x, unsigned& nloc, unsigned& nx) {
    const unsigned G = gridDim.x * gridDim.y * gridDim.z;
    unsigned sum, cnt, mine, sp = 0u;
    for (;;) {
        sum = 0u; cnt = 0u; mine = 0u;
#pragma unroll
        for (unsigned j = 0; j < 16; ++j) { const unsigned c = xb_ld(&bar[XB_XCNT(j)]); sum += c; cnt += (c > 0u) ? 1u : 0u; mine = (j == x) ? c : mine; }
        if (sum == G) break;
        __builtin_amdgcn_s_sleep(1);
        if ((++sp & 255u) == 0u) { if (xb_ld(&bar[XB_TMO])) break; if (sp > XB_SPIN_CAP) { atomicAdd(&bar[XB_TMO], 1u); break; } }
    }
    nloc = mine > 0u ? mine : 1u; nx = cnt > 0u ? cnt : 1u;
}

__device__ __forceinline__ void xcd_barrier(const XcdBarrier& b) {
    asm volatile("s_waitcnt vmcnt(0)" ::: "memory");
    __syncthreads();
    if (threadIdx.x == 0) {
        unsigned* bar = b.bar;
        __builtin_amdgcn_s_waitcnt(0);
        unsigned nloc = b.st[0], nx = b.st[1];
        if (nloc == 0u) { xcd_barrier_complete(bar, b.x, nloc, nx); b.st[0] = nloc; b.st[1] = nx; }
        const unsigned old = xb_add(&bar[XB_XSUB(b.x)], 1u);
        const unsigned gen = old / nloc;
        if (old + 1u == (gen + 1u) * nloc) {
            __builtin_amdgcn_fence(__ATOMIC_RELEASE, "agent");
            asm volatile("s_waitcnt vmcnt(0)" ::: "memory");
            const unsigned og = xb_add(&bar[XB_TOP], 1u);
            const unsigned tg = og / nx;
            if (og + 1u == (tg + 1u) * nx) xb_add(&bar[XB_TOPGEN], 1u);
            else XB_SPIN(xb_ld(&bar[XB_TOPGEN]) == tg, bar);
            __builtin_amdgcn_fence(__ATOMIC_ACQUIRE, "agent");
            xb_add(&bar[XB_XGEN(b.x)], 1u);
            asm volatile("s_waitcnt vmcnt(0)" ::: "memory");
        } else {
            XB_SPIN(xb_ld(&bar[XB_XGEN(b.x)]) == gen, bar);
            __builtin_amdgcn_fence(__ATOMIC_ACQUIRE, "agent");
            asm volatile("s_waitcnt vmcnt(0)" ::: "memory");
        }
    }
    __syncthreads();
}

constexpr int NWAVES = 8;
constexpr size_t MiB = 1u << 20, KiB = 1u << 10;
constexpr size_t WS_CTL = 0, CTL_ZERO_BYTES = 2 * MiB;
constexpr size_t WS_MOD = 1 * MiB;
constexpr size_t WS_WIN = 2 * MiB;
constexpr size_t WS_WBR = 12 * MiB + 512 * KiB, WS_WBA = 13 * MiB + 512 * KiB, WS_WOUT = 14 * MiB + 512 * KiB;
constexpr size_t WS_WUP = 16 * MiB + 512 * KiB, WS_AUP = WS_WUP + 64 * KiB, WS_GUP = WS_WUP + 128 * KiB;
constexpr size_t WS_WRH = 16 * MiB + 768 * KiB, WS_WRL = WS_WRH + 128 * KiB;
constexpr size_t WS_CB = 17 * MiB, WS_GAM2 = 17 * MiB + 64 * KiB;
constexpr size_t WS_PRW = 18 * MiB, WS_PATT = 130 * MiB, WS_PGATE = 226 * MiB;
constexpr size_t WS_WGU = 354 * MiB, WS_WD = 418 * MiB;
constexpr size_t WS_T = 18 * MiB;
constexpr size_t WS_HID = 18 * MiB, WS_H2 = 98 * MiB, WS_H2S = 162 * MiB;
constexpr size_t WS_SLOTTOK = 322 * MiB, WS_SLOTW = WS_SLOTTOK + 512 * KiB, WS_TOKLIST = 323 * MiB, WS_TOKPOS = WS_TOKLIST + 256 * KiB, WS_TOKW = WS_TOKLIST + 512 * KiB;
constexpr size_t WS_END = 512 * MiB;
constexpr size_t DO_H = 0, DO_YA = 64 * MiB, DO_YR = 96 * MiB;
constexpr int NSLOT_MAX = 2 * NTOK + NLIST * 256;
constexpr int CW_TMO = 0, CW_BAR = 4096, CW_CNT = 16384;
constexpr int LDS_BYTES = 163840, RING_BYTES = 131072;
constexpr int LDSCTL_OFF = LDS_BYTES - 1024, MISC_OFF = LDSCTL_OFF;
constexpr int TOFF_OFF = LDSCTL_OFF + 256;

struct Frame {
    LAS unsigned char* lds; volatile LAS unsigned* MISC; gu32* ctl;
    int tid, lane, wave, vcu, G;
};
__device__ __forceinline__ float wave_sum(float v) {
#pragma unroll
    for (int o = 1; o < 64; o <<= 1) v += __shfl_xor(v, o);
    return v;
}
__device__ __forceinline__ float dpp_f(float x, const int ctrl_sel) {
    const int xi = __builtin_bit_cast(int, x); int r;
    if (ctrl_sel == 0) r = __builtin_amdgcn_update_dpp(0, xi, 0xB1, 0xf, 0xf, true);
    else if (ctrl_sel == 1) r = __builtin_amdgcn_update_dpp(0, xi, 0x4E, 0xf, 0xf, true);
    else r = __builtin_amdgcn_update_dpp(0, xi, 0x141, 0xf, 0xf, true);
    return __builtin_bit_cast(float, r);
}
__device__ __forceinline__ float red8(float x) { x += dpp_f(x, 0); x += dpp_f(x, 1); x += dpp_f(x, 2); return x; }

__device__ __forceinline__ void phase_mod(Frame& F, const float* c, const float* w_ada, const float* b_ada, float* mod) {
    const int gw = F.vcu * NWAVES + F.wave, NGW = F.G * NWAVES;
    for (int task = gw; task < 96 * 16; task += NGW) {
        const int nc = task % 96, ks = task / 96, n = nc * 64 + F.lane, k0 = ks * 64;
        float acc[16];
#pragma unroll
        for (int b = 0; b < 16; ++b) acc[b] = 0.f;
        LAS float* sl = (LAS float*)(F.lds) + F.wave * 1024;
#pragma unroll
        for (int j = 0; j < 16; ++j) { const float cv = c[(F.lane & 15) * DM + k0 + (F.lane >> 4) + 4 * j]; sl[((F.lane >> 4) + 4 * j) * 16 + (F.lane & 15)] = cv * sigmoidf_(cv); }
        LDS_WAIT(); asm volatile("" ::: "memory");
#pragma unroll 4
        for (int kk = 0; kk < 64; ++kk) { const float w = w_ada[(size_t)(k0 + kk) * MODW + n];
            const f32x4 s0 = *(const LAS f32x4*)(sl + kk * 16), s1 = *(const LAS f32x4*)(sl + kk * 16 + 4), s2 = *(const LAS f32x4*)(sl + kk * 16 + 8), s3 = *(const LAS f32x4*)(sl + kk * 16 + 12);
            acc[0] += s0.x * w; acc[1] += s0.y * w; acc[2] += s0.z * w; acc[3] += s0.w * w; acc[4] += s1.x * w; acc[5] += s1.y * w; acc[6] += s1.z * w; acc[7] += s1.w * w;
            acc[8] += s2.x * w; acc[9] += s2.y * w; acc[10] += s2.z * w; acc[11] += s2.w * w; acc[12] += s3.x * w; acc[13] += s3.y * w; acc[14] += s3.z * w; acc[15] += s3.w * w; }
        LDS_WAIT(); asm volatile("" ::: "memory");
#pragma unroll
        for (int b = 0; b < 16; ++b) { const float v = acc[b] + (ks == 0 ? b_ada[n] : 0.f); atomicAdd(mod + (size_t)b * MODW + n, v); }
    }
}

template <int MODE> __device__ __forceinline__ void transpose_item(const float* W, int K, int N, bf16_t* WT, int row_off, LAS float* scr, int item, int lane) {
    const int nblk = N / 32, kb = item / nblk, nb = item % nblk, k0 = 64 * kb, n0 = 32 * nb;
#pragma unroll 8
    for (int i = 0; i < 32; ++i) { const int kk = 2 * i + (lane >> 5); scr[kk * 33 + (lane & 31)] = W[(size_t)(k0 + kk) * N + n0 + (lane & 31)]; }
    LDS_WAIT(); asm volatile("" ::: "memory");
    const int c = lane & 7;
#pragma unroll
    for (int j = 0; j < 4; ++j) { const int n = (lane >> 3) + 8 * j; const LAS float* s = scr + (8 * c) * 33 + n;
        u32x4 o; o.x = cvt_pk_bf16(s[0 * 33], s[1 * 33]); o.y = cvt_pk_bf16(s[2 * 33], s[3 * 33]); o.z = cvt_pk_bf16(s[4 * 33], s[5 * 33]); o.w = cvt_pk_bf16(s[6 * 33], s[7 * 33]);
        const int ng = n0 + n; const int nr = MODE == 0 ? row_off + ng : (MODE == 1 ? 8 * (ng >> 2) + (ng & 3) : 8 * (ng >> 2) + 4 + (ng & 3));
        *(GAS u32x4*)(WT + (size_t)nr * K + k0 + 8 * c) = o; }
    LDS_WAIT(); asm volatile("" ::: "memory");
}

struct Args { const float* in[31]; float* out; unsigned char* ws; int ph_lo, ph_hi; };
struct Ptrs { const float* in[31]; float* out; unsigned char* ws; };

__device__ __forceinline__ void phase_prep(Frame& F, const Ptrs& P) {
    LAS float* scr = (LAS float*)(F.lds + F.wave * 16384);
    const int gw = F.vcu * NWAVES + F.wave, NGW = F.G * NWAVES;
    const float* mod = (const float*)(P.ws + WS_MOD);
    bf16_t* Win_t = (bf16_t*)(P.ws + WS_WIN); bf16_t* Wbr_t = (bf16_t*)(P.ws + WS_WBR); bf16_t* Wba_t = (bf16_t*)(P.ws + WS_WBA); bf16_t* Wout_t = (bf16_t*)(P.ws + WS_WOUT);
    bf16_t* wup_t = (bf16_t*)(P.ws + WS_WUP); bf16_t* aup_t = (bf16_t*)(P.ws + WS_AUP); bf16_t* gup_t = (bf16_t*)(P.ws + WS_GUP);
    constexpr int I_IN = 16 * (INCOLS / 32), I_BR = 8 * 32, I_OUT = 16 * 32, I_UP = 16, I_GUP = 2 * 16;
    constexpr int NITEMS = I_IN + 2 * I_BR + I_OUT + 2 * I_UP + I_GUP;
    for (int it = gw; it < NITEMS; it += NGW) {
        int r = it;
        if (r < I_IN) { transpose_item<0>(P.in[5], DM, INCOLS, Win_t, 0, scr, r, F.lane); continue; } r -= I_IN;
        if (r < I_BR) { transpose_item<0>(P.in[20], 512, DM, Wbr_t, 0, scr, r, F.lane); continue; } r -= I_BR;
        if (r < I_BR) { transpose_item<0>(P.in[21], 512, DM, Wba_t, 0, scr, r, F.lane); continue; } r -= I_BR;
        if (r < I_OUT) { transpose_item<0>(P.in[22], DM, DM, Wout_t, 0, scr, r, F.lane); continue; } r -= I_OUT;
        if (r < I_UP) { transpose_item<0>(P.in[8], 64, 512, wup_t, 0, scr, r, F.lane); continue; } r -= I_UP;
        if (r < I_UP) { transpose_item<0>(P.in[10], 64, 512, aup_t, 0, scr, r, F.lane); continue; } r -= I_UP;
        transpose_item<0>(P.in[11], 128, 512, gup_t, 0, scr, r, F.lane);
    }
    { bf16_t* wrh = (bf16_t*)(P.ws + WS_WRH); bf16_t* wrl = (bf16_t*)(P.ws + WS_WRL);
      for (int idx = (F.vcu * NWAVES * 64 + F.tid); idx < 64 * DM; idx += F.G * NWAVES * 64) { const int o = idx / DM, k = idx % DM;
          const float w = o < 4 ? P.in[24][k * 4 + o] : (o < 36 ? P.in[26][k * 32 + (o - 4)] : 0.f);
          const unsigned hi = cvt_pk_bf16(w, 0.f) & 0xffffu; const float rem = w - __uint_as_float(hi << 16); const unsigned lo = cvt_pk_bf16(rem, 0.f) & 0xffffu;
          wrh[idx] = (bf16_t)hi; wrl[idx] = (bf16_t)lo; } }
    { float* gam2 = (float*)(P.ws + WS_GAM2);
      for (int idx = (F.vcu * NWAVES * 64 + F.tid); idx < NB * DM; idx += F.G * NWAVES * 64) { const int b = idx / DM, k = idx % DM; gam2[idx] = P.in[23][k] * (1.f + mod[(size_t)b * MODW + 4 * DM + k]); } }
    { float* cb = (float*)(P.ws + WS_CB);
      for (int t = gw; t < NB * 36; t += NGW) { const int b = t / 36, o = t % 36; float s = 0.f;
          for (int k = F.lane; k < DM; k += 64) { const float w = o < 4 ? P.in[24][k * 4 + o] : P.in[26][k * 32 + (o - 4)]; s += mod[(size_t)b * MODW + 3 * DM + k] * w; }
          s = wave_sum(s); if (F.lane == 0) cb[b * 64 + o] = s + (o < 4 ? P.in[25][o] : P.in[27][o - 4]); } }
    bf16_t* H = (bf16_t*)((unsigned char*)P.out + DO_H);
    for (int m = gw; m < NTOK; m += NGW) {
        const int b = m / SEQ; const float* sh = mod + (size_t)b * MODW; const float* sc = sh + DM;
        const GAS f32x4* xr = (const GAS f32x4*)(P.in[0] + (size_t)m * DM) + F.lane;
        f32x4 v[4]; float s = 0.f;
#pragma unroll
        for (int j = 0; j < 4; ++j) { v[j] = xr[64 * j]; s += (v[j].x * v[j].x + v[j].y * v[j].y) + (v[j].z * v[j].z + v[j].w * v[j].w); }
        const float rinv = 1.f / sqrtf(wave_sum(s) * (1.f / DM) + 1e-6f);
        GAS u32x2* o8 = (GAS u32x2*)(H + (size_t)m * DM) + F.lane;
#pragma unroll
        for (int j = 0; j < 4; ++j) { const int k = 4 * F.lane + 256 * j; const f32x4 g = *(const f32x4*)(P.in[4] + k), s1 = *(const f32x4*)(sc + k), h1 = *(const f32x4*)(sh + k);
            const f32x4 hv = v[j] * rinv * g * (s1 + 1.f) + h1; u32x2 w; w.x = cvt_pk_bf16(hv.x, hv.y); w.y = cvt_pk_bf16(hv.z, hv.w); o8[64 * j] = w; }
    }
}
__device__ __forceinline__ void expert_convert(Frame& F, const Ptrs& P, int wv, int nwv) {
    LAS float* scr = (LAS float*)(F.lds + RING_BYTES - 8 * 8448 + F.wave * 8448);
    bf16_t* Wgu = (bf16_t*)(P.ws + WS_WGU); bf16_t* Wd = (bf16_t*)(P.ws + WS_WD);
    constexpr int I_G = 16 * 16, I_D = 8 * 32;
    for (int it = wv; it < NE * (2 * I_G + I_D); it += nwv) {
        const int e = it / (2 * I_G + I_D); int r = it % (2 * I_G + I_D);
        if (r < I_G) { transpose_item<1>(P.in[28] + (size_t)e * DM * DE, DM, DE, Wgu + (size_t)e * DM * DM, 0, scr, r, F.lane); continue; } r -= I_G;
        if (r < I_G) { transpose_item<2>(P.in[29] + (size_t)e * DM * DE, DM, DE, Wgu + (size_t)e * DM * DM, 0, scr, r, F.lane); continue; } r -= I_G;
        transpose_item<0>(P.in[30] + (size_t)e * DE * DM, DE, DM, Wd + (size_t)e * DM * DE, 0, scr, r, F.lane);
    }
}
namespace att {
constexpr int SLOT = 16384, NSL = 5, L_WS = NSL * SLOT, L_OST = L_WS + 8 * 256, L_BIAS = L_OST + 8 * 4096, L_END = L_BIAS + 1280;
__device__ __forceinline__ int crow(int r, int hi) { return (r & 3) + 8 * (r >> 2) + 4 * hi; }
__device__ __forceinline__ float max3f(float a, float b, float c) { return fmaxf(fmaxf(a, b), c); }
__device__ __forceinline__ s16x4 vtr(const LAS char* p) { return __builtin_bit_cast(s16x4, __builtin_amdgcn_ds_read_tr16_b64_v4i16((LAS s16x4*)p)); }

__device__ __forceinline__ void attn_unit(Frame& F, const Ptrs& P, int b, int h, int qb) {
    const int tid = F.tid, lane = F.lane, wid = F.wave, r32 = lane & 31, hi = lane >> 5;
    const bf16_t* Patt = (const bf16_t*)(P.ws + WS_PATT);
    bf16_t* Ya = (bf16_t*)((unsigned char*)P.out + DO_YA);
    LAS char* lds = (LAS char*)F.lds;
    LAS float* wsf = (LAS float*)(lds + L_WS) + wid * 64;
    LAS float* biasL = (LAS float*)(lds + L_BIAS);
    const int cq = wid >> 1, ci = qb * 4 + cq, kc0 = qb * 4 - 8;
    const size_t rowbase = (size_t)b * SEQ;
    for (int i = tid; i < 257; i += 512) biasL[i] = P.in[19][h * 257 + i] * LOG2E;
    const int srow = tid >> 3, sc8 = tid & 7;
    f32x4 kg0 = *(const f32x4*)(P.in[18] + 8 * sc8), kg1 = *(const f32x4*)(P.in[18] + 8 * sc8 + 4);
    const int kdst = sc8 * 1024 + srow * 16, vdst = 8192 + (sc8 >> 2) * 4096 + (srow >> 4) * 1024 + (srow & 15) * 64 + (sc8 & 3) * 16;
    auto ld_k = [&](int j) -> u32x4 { return *(const u32x4*)(Patt + (rowbase + (size_t)(kc0 + j) * 64 + srow) * ACOLS + 512 + h * 64 + 8 * sc8); };
    auto ld_v = [&](int j) -> u32x4 { return *(const u32x4*)(Patt + (rowbase + (size_t)(kc0 + j) * 64 + srow) * ACOLS + 1024 + h * 64 + 8 * sc8); };
    auto st_kv = [&](int j, u32x4 kw, u32x4 vw) {
        float kf[8] = {bf_lo(kw.x), bf_hi(kw.x), bf_lo(kw.y), bf_hi(kw.y), bf_lo(kw.z), bf_hi(kw.z), bf_lo(kw.w), bf_hi(kw.w)};
        float ss = 0.f;
#pragma unroll
        for (int i = 0; i < 8; ++i) ss += kf[i] * kf[i];
        ss = red8(ss); const float rk = 1.f / sqrtf(ss * (1.f / 64.f) + 1e-6f);
        u32x4 o; o.x = cvt_pk_bf16(kf[0] * rk * kg0.x, kf[1] * rk * kg0.y); o.y = cvt_pk_bf16(kf[2] * rk * kg0.z, kf[3] * rk * kg0.w);
        o.z = cvt_pk_bf16(kf[4] * rk * kg1.x, kf[5] * rk * kg1.y); o.w = cvt_pk_bf16(kf[6] * rk * kg1.z, kf[7] * rk * kg1.w);
        LAS char* sl = lds + (j % NSL) * SLOT;
        *(LAS u32x4*)(sl + kdst) = o; *(LAS u32x4*)(sl + vdst) = vw; };
#pragma unroll 1
    for (int j = 0; j < 4; ++j) if (kc0 + j >= 0) { const u32x4 kw = ld_k(j), vw = ld_v(j); st_kv(j, kw, vw); }
    const size_t qrow = rowbase + (size_t)ci * 64 + (wid & 1) * 32 + r32;
    bf16x8 qr[4];
    { float qf[4][8]; float ss = 0.f;
#pragma unroll
      for (int d0 = 0; d0 < 4; ++d0) { const u32x4 w = *(const u32x4*)(Patt + qrow * ACOLS + h * 64 + d0 * 16 + hi * 8);
          qf[d0][0] = bf_lo(w.x); qf[d0][1] = bf_hi(w.x); qf[d0][2] = bf_lo(w.y); qf[d0][3] = bf_hi(w.y); qf[d0][4] = bf_lo(w.z); qf[d0][5] = bf_hi(w.z); qf[d0][6] = bf_lo(w.w); qf[d0][7] = bf_hi(w.w);
#pragma unroll
          for (int i = 0; i < 8; ++i) ss += qf[d0][i] * qf[d0][i]; }
      ss += __shfl_xor(ss, 32);
      const float rq = (0.125f * LOG2E) / sqrtf(ss * (1.f / 64.f) + 1e-6f);
#pragma unroll
      for (int d0 = 0; d0 < 4; ++d0) { const f32x4 g0 = *(const f32x4*)(P.in[17] + d0 * 16 + hi * 8), g1 = *(const f32x4*)(P.in[17] + d0 * 16 + hi * 8 + 4);
          u32x4 o; o.x = cvt_pk_bf16(qf[d0][0] * rq * g0.x, qf[d0][1] * rq * g0.y); o.y = cvt_pk_bf16(qf[d0][2] * rq * g0.z, qf[d0][3] * rq * g0.w);
          o.z = cvt_pk_bf16(qf[d0][4] * rq * g1.x, qf[d0][5] * rq * g1.y); o.w = cvt_pk_bf16(qf[d0][6] * rq * g1.z, qf[d0][7] * rq * g1.w);
          qr[d0] = __builtin_bit_cast(bf16x8, o); } }
    float mrun = -1e30f, lrun = 0.f; f32x16 o0 = {}, o1 = {};
    const int qloc = (wid & 1) * 32 + r32;
    __syncthreads();
#pragma unroll 1
    for (int s = 0; s < 9; ++s) {
        const int jn = s + 4; const bool ld = (jn <= 11) && (kc0 + jn >= 0);
        u32x4 kw, vw; if (ld) { kw = ld_k(jn); vw = ld_v(jn); }
        const int j = cq + s;
        if (kc0 + j >= 0) {
            const LAS char* sl = lds + (j % NSL) * SLOT;
            f32x16 p0, p1;
            if (s <= 5) { const float c0 = biasL[0];
#pragma unroll
                for (int r = 0; r < 16; ++r) { p0[r] = c0; p1[r] = c0; } }
            else { const int base = 64 * (s - 8) - qloc + 128;
#pragma unroll
                for (int r = 0; r < 16; ++r) { int i0 = base + crow(r, hi), i1 = i0 + 32; i0 = i0 < 0 ? 0 : (i0 > 256 ? 256 : i0); i1 = i1 < 0 ? 0 : (i1 > 256 ? 256 : i1); p0[r] = biasL[i0]; p1[r] = biasL[i1]; } }
            const LAS char* kb = sl + hi * 1024 + r32 * 16;
#pragma unroll
            for (int d0 = 0; d0 < 4; ++d0) { const bf16x8 b0 = *(const LAS bf16x8*)(kb + d0 * 2048), b1 = *(const LAS bf16x8*)(kb + d0 * 2048 + 512);
                p0 = __builtin_amdgcn_mfma_f32_32x32x16_bf16(b0, qr[d0], p0, 0, 0, 0); p1 = __builtin_amdgcn_mfma_f32_32x32x16_bf16(b1, qr[d0], p1, 0, 0, 0); }
            float a = max3f(p0[0], p0[1], p1[0]), bm = max3f(p0[2], p0[3], p1[1]); a = max3f(a, p1[2], p1[3]);
#pragma unroll
            for (int r = 4; r < 16; r += 4) { a = max3f(a, p0[r], p0[r + 1]); bm = max3f(bm, p0[r + 2], p0[r + 3]); a = max3f(a, p1[r], p1[r + 1]); bm = max3f(bm, p1[r + 2], p1[r + 3]); }
            float rm = fmaxf(a, bm); rm = fmaxf(rm, __shfl_xor(rm, 32));
            const float mnew = fmaxf(mrun, rm), f = __builtin_amdgcn_exp2f(mrun - mnew); mrun = mnew;
            float sacc = 0.f;
#pragma unroll
            for (int r = 0; r < 16; ++r) { p0[r] = __builtin_amdgcn_exp2f(p0[r] - mnew); p1[r] = __builtin_amdgcn_exp2f(p1[r] - mnew); sacc += p0[r] + p1[r]; }
            lrun = lrun * f + sacc;
            if (hi == 0) wsf[r32] = f;
            u32x4 pw0, pw1, pw2, pw3;
            pw0 = (u32x4){cvt_pk_bf16(p0[0], p0[1]), cvt_pk_bf16(p0[2], p0[3]), cvt_pk_bf16(p0[4], p0[5]), cvt_pk_bf16(p0[6], p0[7])};
            pw1 = (u32x4){cvt_pk_bf16(p0[8], p0[9]), cvt_pk_bf16(p0[10], p0[11]), cvt_pk_bf16(p0[12], p0[13]), cvt_pk_bf16(p0[14], p0[15])};
            pw2 = (u32x4){cvt_pk_bf16(p1[0], p1[1]), cvt_pk_bf16(p1[2], p1[3]), cvt_pk_bf16(p1[4], p1[5]), cvt_pk_bf16(p1[6], p1[7])};
            pw3 = (u32x4){cvt_pk_bf16(p1[8], p1[9]), cvt_pk_bf16(p1[10], p1[11]), cvt_pk_bf16(p1[12], p1[13]), cvt_pk_bf16(p1[14], p1[15])};
            LDS_WAIT(); asm volatile("" ::: "memory");
#pragma unroll
            for (int r = 0; r < 16; ++r) { const float fr_ = wsf[crow(r, hi)]; o0[r] *= fr_; o1[r] *= fr_; }
            const LAS char* vp = sl + 8192 + ((lane >> 4) & 1) * 32 + (lane & 3) * 8 + (4 * hi + ((lane & 15) >> 2)) * 64;
            const bf16x8 pa[4] = {__builtin_bit_cast(bf16x8, pw0), __builtin_bit_cast(bf16x8, pw1), __builtin_bit_cast(bf16x8, pw2), __builtin_bit_cast(bf16x8, pw3)};
#pragma unroll
            for (int ks = 0; ks < 4; ++ks) {
                const s16x4 l0 = vtr(vp + ks * 1024), h0 = vtr(vp + ks * 1024 + 512), l1 = vtr(vp + 4096 + ks * 1024), h1 = vtr(vp + 4096 + ks * 1024 + 512);
                const bf16x8 v0 = (bf16x8){l0[0], l0[1], l0[2], l0[3], h0[0], h0[1], h0[2], h0[3]}, v1 = (bf16x8){l1[0], l1[1], l1[2], l1[3], h1[0], h1[1], h1[2], h1[3]};
                o0 = __builtin_amdgcn_mfma_f32_32x32x16_bf16(pa[ks], v0, o0, 0, 0, 0); o1 = __builtin_amdgcn_mfma_f32_32x32x16_bf16(pa[ks], v1, o1, 0, 0, 0); }
        }
        if (ld) st_kv(jn, kw, vw);
        __syncthreads();
    }
    lrun += __shfl_xor(lrun, 32);
    if (hi == 0) wsf[32 + r32] = lrun;
    LDS_WAIT(); asm volatile("" ::: "memory");
    LAS bf16_t* stg = (LAS bf16_t*)(lds + L_OST) + wid * 2048;
#pragma unroll
    for (int r = 0; r < 16; ++r) { const int orow = crow(r, hi); const float rl = __builtin_amdgcn_rcpf(wsf[32 + orow]);
        stg[orow * 64 + r32] = (bf16_t)(cvt_pk_bf16(o0[r] * rl, 0.f) & 0xffffu); stg[orow * 64 + 32 + r32] = (bf16_t)(cvt_pk_bf16(o1[r] * rl, 0.f) & 0xffffu); }
    LDS_WAIT(); asm volatile("" ::: "memory");
    bf16_t* Ow = Ya + (rowbase + (size_t)ci * 64 + (wid & 1) * 32) * 512 + h * 64;
#pragma unroll
    for (int i = 0; i < 4; ++i) { const int row = i * 8 + (lane >> 3), ch = lane & 7; const u32x4 v = *(const LAS u32x4*)(stg + row * 64 + ch * 8); *(u32x4*)(Ow + (size_t)row * 512 + ch * 8) = v; }
    __syncthreads();
}
}

namespace rw {
constexpr int FLD = 68;
constexpr int FB = 64 * FLD * 4;
constexpr int L_R = 0, L_W = FB, L_K = 2 * FB, L_A = 3 * FB, L_B = 4 * FB, L_V = 5 * FB, L_Y = 6 * FB;
constexpr int L_TWD = 7 * FB, L_AD = L_TWD + 64 * 72 * 2, L_SGD = L_AD + 64 * 72 * 2, L_END = L_SGD + 64 * 136 * 2;
static_assert(L_END <= LDSCTL_OFF, "rwkv LDS");

__device__ __forceinline__ void unpack8(const u32x4 w, float* f) { f[0] = bf_lo(w.x); f[1] = bf_hi(w.x); f[2] = bf_lo(w.y); f[3] = bf_hi(w.y); f[4] = bf_lo(w.z); f[5] = bf_hi(w.z); f[6] = bf_lo(w.w); f[7] = bf_hi(w.w); }

__device__ __forceinline__ void rwkv_bh(Frame& F, const Ptrs& P, int b, int h) {
    const int tid = F.tid, lane = F.lane, wid = F.wave, t = tid >> 3, cg = tid & 7, r32 = lane & 31, hi = lane >> 5;
    LAS char* lds = (LAS char*)F.lds;
    const bf16_t* Prw = (const bf16_t*)(P.ws + WS_PRW);
    bf16_t* Yr = (bf16_t*)((unsigned char*)P.out + DO_YR);
    const bf16_t* wup_t = (const bf16_t*)(P.ws + WS_WUP); const bf16_t* aup_t = (const bf16_t*)(P.ws + WS_AUP); const bf16_t* gup_t = (const bf16_t*)(P.ws + WS_GUP);
    const int hd = h * 64 + 8 * cg;
    const int el = lane >> 3, dq = lane & 7, e = 8 * wid + el;
    float S[8];
#pragma unroll
    for (int i = 0; i < 8; ++i) S[i] = 0.f;
    const int lc0 = 1536 + 32 * cg;
    const bool is_ad = (cg == 2 || cg == 3); const float alpha = cg < 2 ? 2.f : 1.f, gamma = cg < 2 ? -1.f : 0.f;
    LAS bf16_t* ldst = (LAS bf16_t*)(lds + (cg < 2 ? L_TWD : (cg < 4 ? L_AD : L_SGD))) + t * (cg < 4 ? 72 : 136) + 32 * (cg < 2 ? cg : (cg < 4 ? cg - 2 : cg - 4));
#pragma unroll 1
    for (int c = 0; c < 32; ++c) {
        const size_t row = (size_t)b * SEQ + 64 * c + t; const bool hasprev = (c > 0) || (t > 0);
        const bf16_t* pc = Prw + row * RCOLS; const bf16_t* pp = pc - RCOLS;
        float rv[8], kv[8], vv[8];
        { float cur[8], prv[8], mu[8];
#pragma unroll
          for (int q = 0; q < 4; ++q) {
              unpack8(*(const u32x4*)(pc + lc0 + 8 * q), cur);
              if (hasprev) unpack8(*(const u32x4*)(pp + lc0 + 8 * q), prv); else {
#pragma unroll
                  for (int i = 0; i < 8; ++i) prv[i] = 0.f; }
              *(f32x4*)mu = *(const f32x4*)(P.in[6] + lc0 + 8 * q); *(f32x4*)(mu + 4) = *(const f32x4*)(P.in[6] + lc0 + 8 * q + 4);
              float o[8];
#pragma unroll
              for (int i = 0; i < 8; ++i) { const float xs = cur[i] + (prv[i] - cur[i]) * mu[i]; const float sg = sigmoidf_(alpha * xs); o[i] = is_ad ? xs : alpha * sg + gamma; }
              u32x4 w; w.x = cvt_pk_bf16(o[0], o[1]); w.y = cvt_pk_bf16(o[2], o[3]); w.z = cvt_pk_bf16(o[4], o[5]); w.w = cvt_pk_bf16(o[6], o[7]);
              *(LAS u32x4*)(ldst + 8 * q) = w; }
#pragma unroll
          for (int which = 0; which < 3; ++which) { const int col = which * 512 + hd;
              unpack8(*(const u32x4*)(pc + col), cur);
              if (hasprev) unpack8(*(const u32x4*)(pp + col), prv); else {
#pragma unroll
                  for (int i = 0; i < 8; ++i) prv[i] = 0.f; }
              *(f32x4*)mu = *(const f32x4*)(P.in[6] + col); *(f32x4*)(mu + 4) = *(const f32x4*)(P.in[6] + col + 4);
#pragma unroll
              for (int i = 0; i < 8; ++i) { const float xs = cur[i] + (prv[i] - cur[i]) * mu[i]; if (which == 0) rv[i] = xs; else if (which == 1) kv[i] = xs; else vv[i] = xs; } } }
        __syncthreads();
        { const int ib = wid & 1, jb = (wid >> 1) & 1;
          auto mm = [&](const LAS bf16_t* In, int ldi, const bf16_t* Wt, int K, LAS float* Out) {
              f32x16 acc = {};
              const LAS bf16_t* qp = In + (ib * 32 + r32) * ldi + 8 * hi; const bf16_t* wp = Wt + (size_t)(h * 64 + jb * 32 + r32) * K + 8 * hi;
              for (int ks = 0; ks < K / 16; ++ks) { const bf16x8 af = *(const bf16x8*)(wp + 16 * ks); const bf16x8 bfr = *(const LAS bf16x8*)(qp + 16 * ks);
                  acc = __builtin_amdgcn_mfma_f32_32x32x16_bf16(af, bfr, acc, 0, 0, 0); }
              LAS float* op = Out + (ib * 32 + r32) * FLD + jb * 32 + 4 * hi;
#pragma unroll
              for (int g = 0; g < 4; ++g) *(LAS f32x4*)(op + 8 * g) = (f32x4){acc[4 * g], acc[4 * g + 1], acc[4 * g + 2], acc[4 * g + 3]}; };
          if (wid < 4) { mm((const LAS bf16_t*)(lds + L_TWD), 72, wup_t, 64, (LAS float*)(lds + L_W)); mm((const LAS bf16_t*)(lds + L_SGD), 136, gup_t, 128, (LAS float*)(lds + L_Y)); }
          else mm((const LAS bf16_t*)(lds + L_AD), 72, aup_t, 64, (LAS float*)(lds + L_B)); }
        __syncthreads();
        float gv[8], c2[8];
        { const int o = t * FLD + 8 * cg;
          float wl[8], al[8];
          *(f32x4*)wl = *(LAS f32x4*)(lds + L_W + 4 * o); *(f32x4*)(wl + 4) = *(LAS f32x4*)(lds + L_W + 4 * o + 16);
          *(f32x4*)al = *(LAS f32x4*)(lds + L_B + 4 * o); *(f32x4*)(al + 4) = *(LAS f32x4*)(lds + L_B + 4 * o + 16);
          *(f32x4*)gv = *(LAS f32x4*)(lds + L_Y + 4 * o); *(f32x4*)(gv + 4) = *(LAS f32x4*)(lds + L_Y + 4 * o + 16);
          float w0[8], a0[8], kk_[8], ka[8], rk[8], lb[8];
          *(f32x4*)w0 = *(const f32x4*)(P.in[7] + hd); *(f32x4*)(w0 + 4) = *(const f32x4*)(P.in[7] + hd + 4);
          *(f32x4*)a0 = *(const f32x4*)(P.in[9] + hd); *(f32x4*)(a0 + 4) = *(const f32x4*)(P.in[9] + hd + 4);
          *(f32x4*)kk_ = *(const f32x4*)(P.in[12] + hd); *(f32x4*)(kk_ + 4) = *(const f32x4*)(P.in[12] + hd + 4);
          *(f32x4*)ka = *(const f32x4*)(P.in[13] + hd); *(f32x4*)(ka + 4) = *(const f32x4*)(P.in[13] + hd + 4);
          *(f32x4*)rk = *(const f32x4*)(P.in[14] + hd); *(f32x4*)(rk + 4) = *(const f32x4*)(P.in[14] + hd + 4);
          *(f32x4*)lb = *(const f32x4*)(P.in[16] + hd); *(f32x4*)(lb + 4) = *(const f32x4*)(P.in[16] + hd + 4);
          float dec[8], asg[8], kkv[8], kp[8]; float ss = 0.f, bon = 0.f;
#pragma unroll
          for (int i = 0; i < 8; ++i) { dec[i] = __builtin_amdgcn_exp2f(-0.60653065971f * LOG2E * sigmoidf_(w0[i] + wl[i])); asg[i] = sigmoidf_(a0[i] + al[i]);
              kkv[i] = kv[i] * kk_[i]; ss += kkv[i] * kkv[i]; kp[i] = kv[i] * (1.f + (asg[i] - 1.f) * ka[i]); bon += rv[i] * kp[i] * rk[i]; }
          ss = red8(ss); bon = red8(bon);
          const float inv = 1.f / fmaxf(sqrtf(ss), 1e-12f);
          float av[8], bv[8];
#pragma unroll
          for (int i = 0; i < 8; ++i) { const float kn = kkv[i] * inv; av[i] = -kn; bv[i] = kn * asg[i]; c2[i] = (lb[i] + bon * vv[i]) * gv[i]; }
          *(LAS f32x4*)(lds + L_R + 4 * o) = *(f32x4*)rv; *(LAS f32x4*)(lds + L_R + 4 * o + 16) = *(f32x4*)(rv + 4);
          *(LAS f32x4*)(lds + L_W + 4 * o) = *(f32x4*)dec; *(LAS f32x4*)(lds + L_W + 4 * o + 16) = *(f32x4*)(dec + 4);
          *(LAS f32x4*)(lds + L_K + 4 * o) = *(f32x4*)kp; *(LAS f32x4*)(lds + L_K + 4 * o + 16) = *(f32x4*)(kp + 4);
          *(LAS f32x4*)(lds + L_A + 4 * o) = *(f32x4*)av; *(LAS f32x4*)(lds + L_A + 4 * o + 16) = *(f32x4*)(av + 4);
          *(LAS f32x4*)(lds + L_B + 4 * o) = *(f32x4*)bv; *(LAS f32x4*)(lds + L_B + 4 * o + 16) = *(f32x4*)(bv + 4);
          *(LAS f32x4*)(lds + L_V + 4 * o) = *(f32x4*)vv; *(LAS f32x4*)(lds + L_V + 4 * o + 16) = *(f32x4*)(vv + 4); }
        __syncthreads();
        { const LAS char* pa = lds + L_A + 32 * dq, *pw = lds + L_W + 32 * dq, *pb = lds + L_B + 32 * dq, *pk = lds + L_K + 32 * dq, *pr = lds + L_R + 32 * dq;
          const LAS float* pv = (const LAS float*)(lds + L_V) + e; LAS float* py = (LAS float*)(lds + L_Y) + e;
#pragma unroll 2
          for (int tt = 0; tt < 64; ++tt) { const int ro = tt * FLD * 4;
              const f32x4 a0v = *(const LAS f32x4*)(pa + ro), a1v = *(const LAS f32x4*)(pa + ro + 16), w0v = *(const LAS f32x4*)(pw + ro), w1v = *(const LAS f32x4*)(pw + ro + 16);
              const f32x4 b0v = *(const LAS f32x4*)(pb + ro), b1v = *(const LAS f32x4*)(pb + ro + 16), k0v = *(const LAS f32x4*)(pk + ro), k1v = *(const LAS f32x4*)(pk + ro + 16);
              const f32x4 r0v = *(const LAS f32x4*)(pr + ro), r1v = *(const LAS f32x4*)(pr + ro + 16); const float vt = pv[tt * FLD];
              float sa = (S[0] * a0v.x + S[1] * a0v.y) + (S[2] * a0v.z + S[3] * a0v.w) + (S[4] * a1v.x + S[5] * a1v.y) + (S[6] * a1v.z + S[7] * a1v.w);
              sa = red8(sa);
              S[0] = S[0] * w0v.x + sa * b0v.x + vt * k0v.x; S[1] = S[1] * w0v.y + sa * b0v.y + vt * k0v.y; S[2] = S[2] * w0v.z + sa * b0v.z + vt * k0v.z; S[3] = S[3] * w0v.w + sa * b0v.w + vt * k0v.w;
              S[4] = S[4] * w1v.x + sa * b1v.x + vt * k1v.x; S[5] = S[5] * w1v.y + sa * b1v.y + vt * k1v.y; S[6] = S[6] * w1v.z + sa * b1v.z + vt * k1v.z; S[7] = S[7] * w1v.w + sa * b1v.w + vt * k1v.w;
              float y = (S[0] * r0v.x + S[1] * r0v.y) + (S[2] * r0v.z + S[3] * r0v.w) + (S[4] * r1v.x + S[5] * r1v.y) + (S[6] * r1v.z + S[7] * r1v.w);
              y = red8(y);
              if (dq == 0) py[tt * FLD] = y; } }
        __syncthreads();
        { float y8[8]; const int o = t * FLD + 8 * cg;
          *(f32x4*)y8 = *(LAS f32x4*)(lds + L_Y + 4 * o); *(f32x4*)(y8 + 4) = *(LAS f32x4*)(lds + L_Y + 4 * o + 16);
          float s = 0.f;
#pragma unroll
          for (int i = 0; i < 8; ++i) s += y8[i];
          const float mean = red8(s) * (1.f / 64.f); float q = 0.f;
#pragma unroll
          for (int i = 0; i < 8; ++i) { y8[i] -= mean; q += y8[i] * y8[i]; }
          const float rstd = 1.f / sqrtf(red8(q) * (1.f / 64.f) + 64e-5f);
          float lg[8]; *(f32x4*)lg = *(const f32x4*)(P.in[15] + hd); *(f32x4*)(lg + 4) = *(const f32x4*)(P.in[15] + hd + 4);
          float ov[8];
#pragma unroll
          for (int i = 0; i < 8; ++i) ov[i] = y8[i] * rstd * lg[i] * gv[i] + c2[i];
          u32x4 w; w.x = cvt_pk_bf16(ov[0], ov[1]); w.y = cvt_pk_bf16(ov[2], ov[3]); w.z = cvt_pk_bf16(ov[4], ov[5]); w.w = cvt_pk_bf16(ov[6], ov[7]);
          *(u32x4*)(Yr + row * 512 + hd) = w; }
    }
    __syncthreads();
}
}
__device__ __forceinline__ void phase_route(Frame& F, const Ptrs& P) {
    const int lane = F.lane, gw = F.vcu * NWAVES + F.wave, NGW = F.G * NWAVES;
    const float* x1 = P.out; const float* mod = (const float*)(P.ws + WS_MOD);
    const float* gam2 = (const float*)(P.ws + WS_GAM2); const float* cb = (const float*)(P.ws + WS_CB);
    const bf16_t* wrh = (const bf16_t*)(P.ws + WS_WRH); const bf16_t* wrl = (const bf16_t*)(P.ws + WS_WRL);
    bf16_t* H2 = (bf16_t*)(P.ws + WS_H2);
    int* tok_list = (int*)(P.ws + WS_TOKLIST); int* tok_pos = (int*)(P.ws + WS_TOKPOS); float* tok_w = (float*)(P.ws + WS_TOKW);
    unsigned* cnt = (unsigned*)(F.ctl + CW_CNT);
    LAS float* scr = (LAS float*)(F.lds) + F.wave * (16 * 52);
    const int fr = lane & 15, kq = lane >> 4;
    for (int task = gw; task < NTOK / 16; task += NGW) {
        const int R0 = task * 16, b = R0 / SEQ;
        const float* xr = x1 + (size_t)(R0 + fr) * DM + 8 * kq; const float* gp = gam2 + (size_t)b * DM + 8 * kq;
        const bf16_t* bh = wrh + (size_t)fr * DM + 8 * kq; const bf16_t* bl = wrl + (size_t)fr * DM + 8 * kq;
        f32x4 acc[3] = {{0.f, 0.f, 0.f, 0.f}, {0.f, 0.f, 0.f, 0.f}, {0.f, 0.f, 0.f, 0.f}}; float ssq = 0.f;
#pragma unroll 2
        for (int k0 = 0; k0 < DM; k0 += 32) {
            const f32x4 xa = *(const f32x4*)(xr + k0), xb = *(const f32x4*)(xr + k0 + 4), ga = *(const f32x4*)(gp + k0), gb = *(const f32x4*)(gp + k0 + 4);
            ssq += (xa.x * xa.x + xa.y * xa.y) + (xa.z * xa.z + xa.w * xa.w) + (xb.x * xb.x + xb.y * xb.y) + (xb.z * xb.z + xb.w * xb.w);
            const f32x4 ya = xa * ga, yb = xb * gb;
            u32x4 hw; hw.x = cvt_pk_bf16(ya.x, ya.y); hw.y = cvt_pk_bf16(ya.z, ya.w); hw.z = cvt_pk_bf16(yb.x, yb.y); hw.w = cvt_pk_bf16(yb.z, yb.w);
            u32x4 lw; lw.x = cvt_pk_bf16(ya.x - bf_lo(hw.x), ya.y - bf_hi(hw.x)); lw.y = cvt_pk_bf16(ya.z - bf_lo(hw.y), ya.w - bf_hi(hw.y));
            lw.z = cvt_pk_bf16(yb.x - bf_lo(hw.z), yb.y - bf_hi(hw.z)); lw.w = cvt_pk_bf16(yb.z - bf_lo(hw.w), yb.w - bf_hi(hw.w));
            const bf16x8 ah = __builtin_bit_cast(bf16x8, hw), al = __builtin_bit_cast(bf16x8, lw);
#pragma unroll
            for (int nb = 0; nb < 3; ++nb) { const bf16x8 wh = *(const bf16x8*)(bh + (size_t)nb * 16 * DM + k0), wl = *(const bf16x8*)(bl + (size_t)nb * 16 * DM + k0);
                acc[nb] = __builtin_amdgcn_mfma_f32_16x16x32_bf16(ah, wh, acc[nb], 0, 0, 0); acc[nb] = __builtin_amdgcn_mfma_f32_16x16x32_bf16(al, wh, acc[nb], 0, 0, 0); acc[nb] = __builtin_amdgcn_mfma_f32_16x16x32_bf16(ah, wl, acc[nb], 0, 0, 0); }
        }
        ssq += __shfl_xor(ssq, 16); ssq += __shfl_xor(ssq, 32);
        const float rinv = 1.f / sqrtf(ssq * (1.f / DM) + 1e-6f);
#pragma unroll
        for (int nb = 0; nb < 3; ++nb)
#pragma unroll
            for (int j = 0; j < 4; ++j) scr[(4 * kq + j) * 52 + 16 * nb + fr] = acc[nb][j];
        LDS_WAIT(); asm volatile("" ::: "memory");
        if (lane < 16) {
            const int tok = R0 + lane; const float* cbb = cb + b * 64; const LAS float* lr = scr + lane * 52;
            float lc[4]; int grp = 0; float best = -3.4e38f;
#pragma unroll
            for (int o = 0; o < 4; ++o) { lc[o] = rinv * lr[o] + cbb[o]; if (lc[o] > best) { best = lc[o]; grp = o; } }
            float den = 0.f;
#pragma unroll
            for (int o = 0; o < 4; ++o) den += __expf(lc[o] - best);
            const float pgrp = 1.f / den;
            float f1 = -3.4e38f, f2 = -3.4e38f; int i1 = 0, i2 = 0;
            for (int o = 0; o < 8; ++o) { const float v = rinv * lr[4 + grp * 8 + o] + cbb[4 + grp * 8 + o];
                if (v > f1) { f2 = f1; i2 = i1; f1 = v; i1 = o; } else if (v > f2) { f2 = v; i2 = o; } }
            const float e2 = __expf(f2 - f1), w1 = pgrp / (1.f + e2), w2 = pgrp * e2 / (1.f + e2);
            const int l1 = grp * 8 + i1, l2 = 32 + grp * 8 + i2;
            const unsigned p1 = atomicAdd(cnt + l1, 1u), p2 = atomicAdd(cnt + l2, 1u);
            tok_list[2 * tok] = l1; tok_list[2 * tok + 1] = l2; tok_pos[2 * tok] = (int)p1; tok_pos[2 * tok + 1] = (int)p2; tok_w[2 * tok] = w1; tok_w[2 * tok + 1] = w2;
        }
        const float* sh = mod + (size_t)b * MODW + 3 * DM;
        for (int r = 0; r < 16; ++r) { const float ri = __shfl(rinv, r);
            const GAS f32x4* xrow = (const GAS f32x4*)(x1 + (size_t)(R0 + r) * DM) + lane; GAS u32x2* o8 = (GAS u32x2*)(H2 + (size_t)(R0 + r) * DM) + lane;
#pragma unroll
            for (int j = 0; j < 4; ++j) { const int k = 4 * lane + 256 * j; const f32x4 xv = xrow[64 * j], g = *(const f32x4*)(gam2 + (size_t)b * DM + k), s = *(const f32x4*)(sh + k);
                const f32x4 hv = xv * ri * g + s; u32x2 w; w.x = cvt_pk_bf16(hv.x, hv.y); w.y = cvt_pk_bf16(hv.z, hv.w); o8[64 * j] = w; } }
        LDS_WAIT(); asm volatile("" ::: "memory");
    }
}
__device__ __forceinline__ void moe_offsets(Frame& F) {
    LAS int* toff = (LAS int*)(F.lds + TOFF_OFF);
    if (F.tid == 0) { int acc = 0; for (int l = 0; l < NLIST; ++l) { toff[l] = acc; const unsigned c = __hip_atomic_load(F.ctl + CW_CNT + l, RLX_AGENT); acc += (int)((c + 255u) >> 8); } toff[NLIST] = acc; }
    __syncthreads();
}
__device__ __forceinline__ void phase_sort(Frame& F, const Ptrs& P) {
    const int lane = F.lane, gw = F.vcu * NWAVES + F.wave, NGW = F.G * NWAVES;
    const LAS int* toff = (const LAS int*)(F.lds + TOFF_OFF);
    const bf16_t* H2 = (const bf16_t*)(P.ws + WS_H2); bf16_t* H2S = (bf16_t*)(P.ws + WS_H2S);
    const int* tok_list = (const int*)(P.ws + WS_TOKLIST); const int* tok_pos = (const int*)(P.ws + WS_TOKPOS); const float* tok_w = (const float*)(P.ws + WS_TOKW);
    int* slot_tok = (int*)(P.ws + WS_SLOTTOK); float* slot_w = (float*)(P.ws + WS_SLOTW);
    for (int tok = gw; tok < NTOK; tok += NGW) {
        const GAS u32x4* src = (const GAS u32x4*)(H2 + (size_t)tok * DM) + lane; const u32x4 v0 = src[0], v1 = src[64];
#pragma unroll
        for (int k = 0; k < 2; ++k) { const int l = tok_list[2 * tok + k], slot = toff[l] * 256 + tok_pos[2 * tok + k];
            GAS u32x4* dst = (GAS u32x4*)(H2S + (size_t)slot * DM) + lane; dst[0] = v0; dst[64] = v1;
            if (lane == 0) { slot_tok[slot] = tok; slot_w[slot] = tok_w[2 * tok + k]; } }
    }
    for (int l = gw; l < NLIST; l += NGW) { const int c = (int)__hip_atomic_load(F.ctl + CW_CNT + l, RLX_AGENT), base = toff[l] * 256, pad = (toff[l + 1] - toff[l]) * 256;
        for (int s = c + lane; s < pad; s += 64) slot_tok[base + s] = -1; }
}

#ifndef MK_ONE_LAUNCH
#define MK_ONE_LAUNCH 1
#endif
constexpr int N_PHASES = 11;

__global__ void __launch_bounds__(NWAVES * 64, 2) fwd_kernel(Args args) {
    extern __shared__ __attribute__((aligned(16))) unsigned char lds_raw[];
    Frame F; F.lds = (LAS unsigned char*)lds_raw; F.MISC = (volatile LAS unsigned*)(F.lds + MISC_OFF);
    F.tid = threadIdx.x; F.lane = F.tid & 63; F.wave = __builtin_amdgcn_readfirstlane(F.tid >> 6);
    F.G = gridDim.x; { const int bx = blockIdx.x; F.vcu = (F.G % 8 == 0) ? (bx % 8) * (F.G / 8) + bx / 8 : bx; }
#define RELOAD_ARGS() Ptrs P; { int z_ = 0; asm volatile("" : "+s"(z_)); _Pragma("unroll") for (int i_ = 0; i_ < 31; ++i_) P.in[i_] = args.in[i_] + z_; P.out = args.out + z_; P.ws = args.ws + z_; }
    F.ctl = (gu32*)(args.ws + WS_CTL);
    for (int u = F.tid; u < (LDS_BYTES - LDSCTL_OFF) / 4; u += NWAVES * 64) ((LAS unsigned*)(F.lds + LDSCTL_OFF))[u] = 0u;
    __syncthreads();
    XcdBarrier bar; bar.bar = (unsigned*)(F.ctl + CW_BAR); bar.x = 0; bar.st = nullptr;
#if MK_ONE_LAUNCH
    bar = xcd_barrier_post((unsigned*)(F.ctl + CW_BAR), F.MISC + 8);
#define GRID_BAR() xcd_barrier(bar)
#else
#define GRID_BAR() do { } while (0)
#endif
    const int lo = args.ph_lo, hi = args.ph_hi;
#ifndef PH_MASK
#define PH_MASK 0x7ff
#endif
#define IN(k) ((((PH_MASK) >> (k)) & 1) && lo <= (k) && (k) < hi)
#define SEAM(k) do { if (IN(k) && IN((k) + 1)) GRID_BAR(); } while (0)
#define MODP ((float*)(P.ws + WS_MOD))
#define PGATE ((bf16_t*)(P.ws + WS_PGATE))

    if (IN(0)) { RELOAD_ARGS(); phase_mod(F, P.in[1], P.in[2], P.in[3], MODP); } SEAM(0);
    if (IN(1)) { RELOAD_ARGS(); phase_prep(F, P); } SEAM(1);
    if (IN(2)) { RELOAD_ARGS();
        pg8::Gemm g{DM, DM, DM}; pg8::DenseOrder S; S.init((const bf16_t*)((unsigned char*)P.out + DO_H), (const bf16_t*)(P.ws + WS_WIN), DM, DM, NTOK, INCOLS, F.G, (int)blockIdx.x);
        pg8::EpiP E{(bf16_t*)(P.ws + WS_PRW), (bf16_t*)(P.ws + WS_PATT), PGATE};
        pg8::gemm_phase<pg8::EpiP, pg8::DenseOrder, true>(F.lds, g, S, E);
    } SEAM(2);
    if (IN(3)) { RELOAD_ARGS();
        const int nR = F.G >= 256 ? 128 : F.G / 2, bx = (int)blockIdx.x;
        if (bx < nR) { for (int u = bx; u < NB * 8; u += nR) rw::rwkv_bh(F, P, u >> 3, u & 7); }
        else { const int na = F.G - nR, a = bx - nR;
            for (int u = a; u < NB * 8 * 8; u += na) att::attn_unit(F, P, u >> 6, (u >> 3) & 7, u & 7);
            __syncthreads();
            expert_convert(F, P, a * NWAVES + F.wave, na * NWAVES); }
    } SEAM(3);
    if (IN(4)) { RELOAD_ARGS();
        bf16_t* T = (bf16_t*)(P.ws + WS_T);
        { pg8::Gemm g{512, 512, 512}; pg8::DenseOrder S; S.init((const bf16_t*)((unsigned char*)P.out + DO_YR), (const bf16_t*)(P.ws + WS_WBR), 512, 512, NTOK, DM, F.G, (int)blockIdx.x);
          pg8::EpiBranch<false> E{T, PGATE}; pg8::gemm_phase<pg8::EpiBranch<false>, pg8::DenseOrder, true>(F.lds, g, S, E); }
        { pg8::Gemm g{512, 512, 512}; pg8::DenseOrder S; S.init((const bf16_t*)((unsigned char*)P.out + DO_YA), (const bf16_t*)(P.ws + WS_WBA), 512, 512, NTOK, DM, F.G, (int)blockIdx.x);
          pg8::EpiBranch<true> E{T, PGATE}; pg8::gemm_phase<pg8::EpiBranch<true>, pg8::DenseOrder, true>(F.lds, g, S, E); }
    } SEAM(4);
    if (IN(5)) { RELOAD_ARGS();
        pg8::Gemm g{DM, DM, DM}; pg8::DenseOrder S; S.init((const bf16_t*)(P.ws + WS_T), (const bf16_t*)(P.ws + WS_WOUT), DM, DM, NTOK, DM, F.G, (int)blockIdx.x);
        pg8::EpiOut E{P.in[0], P.out, MODP}; pg8::gemm_phase<pg8::EpiOut, pg8::DenseOrder, true>(F.lds, g, S, E);
    } SEAM(5);
    if (IN(6)) { RELOAD_ARGS(); phase_route(F, P); } SEAM(6);
    if (IN(7)) { RELOAD_ARGS(); moe_offsets(F); phase_sort(F, P); } SEAM(7);
    if (IN(8)) { RELOAD_ARGS();
        moe_offsets(F); const LAS int* toff = (const LAS int*)(F.lds + TOFF_OFF);
        pg8::Gemm g{DM, DM, DM}; pg8::MoeOrder S{(const bf16_t*)(P.ws + WS_H2S), (const bf16_t*)(P.ws + WS_WGU), DM, DM, (size_t)DM * DM, toff, 0, toff[NLIST], F.G, (int)blockIdx.x};
        pg8::EpiHid E{(bf16_t*)(P.ws + WS_HID)}; pg8::gemm_phase<pg8::EpiHid, pg8::MoeOrder, true>(F.lds, g, S, E);
    } SEAM(8);
    for (int k = 0; k < 2; ++k) {
        if (IN(9 + k)) { RELOAD_ARGS();
            moe_offsets(F); const LAS int* toff = (const LAS int*)(F.lds + TOFF_OFF);
            pg8::Gemm g{DE, DE, DE}; pg8::MoeOrder S{(const bf16_t*)(P.ws + WS_HID), (const bf16_t*)(P.ws + WS_WD), DE, DE, (size_t)DM * DE, toff, k == 0 ? 0 : toff[32], k == 0 ? toff[32] : toff[NLIST], F.G, (int)blockIdx.x};
            pg8::EpiDown E{P.out, MODP, (const int*)(P.ws + WS_SLOTTOK), (const float*)(P.ws + WS_SLOTW)}; pg8::gemm_phase<pg8::EpiDown, pg8::MoeOrder, true>(F.lds, g, S, E);
        }
        if (k == 0) SEAM(9);
    }
#undef IN
#undef SEAM
}

extern "C" void kernel_launch(void* const* d_in, const int* in_sizes, int n_in, void* d_out, int out_size, void* d_ws, size_t ws_size, hipStream_t stream) {
    static int grid = 0;
    if (grid == 0) {
        if (n_in != 31 || out_size != NTOK * DM || ws_size < WS_END) { fprintf(stderr, "kernel_launch: unexpected shapes (n_in %d out %d ws %zu)\n", n_in, out_size, ws_size); grid = -1; return; }
        int dev = 0, cus = 0;
        if (hipGetDevice(&dev) != hipSuccess || hipDeviceGetAttribute(&cus, hipDeviceAttributeMultiprocessorCount, dev) != hipSuccess) { grid = -1; return; }
        if (hipFuncSetAttribute((const void*)fwd_kernel, hipFuncAttributeMaxDynamicSharedMemorySize, LDS_BYTES) != hipSuccess) { fprintf(stderr, "kernel_launch: hipFuncSetAttribute failed\n"); grid = -1; return; }
        int per_cu = 0; (void)hipOccupancyMaxActiveBlocksPerMultiprocessor(&per_cu, (const void*)fwd_kernel, NWAVES * 64, LDS_BYTES); (void)hipGetLastError();
        grid = cus;
    }
    if (grid < 0) return;
    (void)hipMemsetAsync((char*)d_ws + WS_CTL, 0, CTL_ZERO_BYTES, stream);
    Args a{};
    for (int i = 0; i < 31; ++i) a.in[i] = (const float*)d_in[i];
    a.out = (float*)d_out; a.ws = (unsigned char*)d_ws;
#if MK_ONE_LAUNCH
    a.ph_lo = 0; a.ph_hi = N_PHASES;
    hipLaunchKernelGGL(fwd_kernel, dim3(grid), dim3(NWAVES * 64), LDS_BYTES, stream, a);
#else
    for (int p = 0; p < N_PHASES; ++p) { a.ph_lo = p; a.ph_hi = p + 1; hipLaunchKernelGGL(fwd_kernel, dim3(grid), dim3(NWAVES * 64), LDS_BYTES, stream, a); }
#endif
}
```

```cpp
#include <hip/hip_runtime.h>
#include <cstdio>
#include <cstdint>

#define LAS __attribute__((address_space(3)))
#define GAS __attribute__((address_space(1)))
typedef unsigned short bf16_t;
typedef short bf16x8 __attribute__((ext_vector_type(8)));
typedef short s16x4 __attribute__((ext_vector_type(4)));
typedef float f32x4 __attribute__((ext_vector_type(4)));
typedef float f32x2 __attribute__((ext_vector_type(2)));
typedef float f32x16 __attribute__((ext_vector_type(16)));
typedef unsigned u32x4 __attribute__((ext_vector_type(4)));
typedef unsigned u32x2 __attribute__((ext_vector_type(2)));

constexpr int NB = 16, SEQ = 2048, DM = 1024, NTOK = NB * SEQ;
constexpr int RCOLS = 1792, ACOLS = 1536, GCOLS = 2048, INCOLS = 5376;
constexpr int NE = 32, DE = 512, NLIST = 64;
constexpr int MODW = 6 * DM;
constexpr float LOG2E = 1.4426950408889634f;

typedef __bf16 bf16x2_t __attribute__((ext_vector_type(2)));
__device__ __forceinline__ unsigned cvt_pk_bf16(float lo, float hi) { const f32x2 v = {lo, hi}; const bf16x2_t b = __builtin_convertvector(v, bf16x2_t); return __builtin_bit_cast(unsigned, b); }
__device__ __forceinline__ float bf_lo(unsigned w) { return __uint_as_float(w << 16); }
__device__ __forceinline__ float bf_hi(unsigned w) { return __uint_as_float(w & 0xffff0000u); }
__device__ __forceinline__ float sigmoidf_(float x) { return __builtin_amdgcn_rcpf(1.0f + __builtin_amdgcn_exp2f(-x * LOG2E)); }

namespace pg8 {
constexpr int BM = 256, BK = 64, HALF = 128, HTB = HALF * BK * 2, STAGE_BYTES = 8 * HTB, NXCD = 8, WGM = 8;
__host__ __device__ __forceinline__ int lds_byte(int r, int c) { const int st = (r >> 4) * 2 + (c >> 5), rr = r & 15, cc = c & 31, ob = rr * 64 + cc * 2; return st * 1024 + (ob ^ (((ob >> 9) & 1) << 5)); }
__host__ __device__ __forceinline__ void stage_rc(int b, int& R, int& C) { const int st = b / 1024, sb = b % 1024, swz = sb ^ (((sb >> 9) & 1) << 5); R = (st >> 1) * 16 + swz / 64; C = (st & 1) * 32 + (swz % 64) / 2; }
__host__ __device__ __forceinline__ int perm32(int rho) { const int n = rho >> 4, i = rho & 15; return 8 * (i >> 2) + 4 * n + (i & 3); }

struct Unit { int pm, pn, e; };
struct Gemm { int lda, ldb, K; };

struct DenseOrder {
    const bf16_t* A; const bf16_t* Bt; int lda, ldb;
    int nM, nN, nwg, G, c;
    __device__ void init(const bf16_t* A_, const bf16_t* Bt_, int lda_, int ldb_, int M, int N, int G_, int c_) { A = A_; Bt = Bt_; lda = lda_; ldb = ldb_; nM = M / BM; nN = N / BM; nwg = nM * nN; G = G_; c = c_; }
    __device__ bool next(int i, Unit& u) const {
        const long L = (long)i * G + c; if (L >= nwg) return false;
        int wgid = (int)L; { const int q = nwg / NXCD, r = nwg % NXCD, xcd = wgid % NXCD, off = wgid / NXCD; wgid = (xcd < r ? xcd * (q + 1) : r * (q + 1) + (xcd - r) * q) + off; }
        const int nig = WGM * nN, gid = wgid / nig, fm = gid * WGM, gsz = (nM - fm) < WGM ? (nM - fm) : WGM;
        u.pm = fm + ((wgid % nig) % gsz); u.pn = (wgid % nig) / gsz; u.e = 0; return true;
    }
    __device__ __forceinline__ const char* a_base(const Unit& u) const { return (const char*)A + (size_t)u.pm * BM * lda * 2; }
    __device__ __forceinline__ const char* b_base(const Unit& u) const { return (const char*)Bt + (size_t)u.pn * BM * ldb * 2; }
};
struct MoeOrder {
    const bf16_t* A; const bf16_t* Bt; int lda, ldb; size_t bt_expert_stride;
    const LAS unsigned char* tile_e;
    int tlo, thi, G, c;
    __device__ bool next(int i, Unit& u) const {
        const int nt = thi - tlo; int tile, pn;
        if (G % NXCD == 0) { const int x = c % NXCD, cin = c / NXCD, per = G / NXCD; const int t0 = (int)((long)nt * x / NXCD), t1 = (int)((long)nt * (x + 1) / NXCD);
            const long j = (long)i * per + cin; if (j >= (long)(t1 - t0) * 4) return false; tile = tlo + t0 + (int)(j >> 2); pn = (int)(j & 3); }
        else { const long L = (long)i * G + c; if (L >= (long)nt * 4) return false; tile = tlo + (int)(L >> 2); pn = (int)(L & 3); }
        u.pm = tile; u.pn = pn; u.e = tile_e[tile]; return true;
    }
    __device__ __forceinline__ const char* a_base(const Unit& u) const { return (const char*)A + (size_t)u.pm * BM * lda * 2; }
    __device__ __forceinline__ const char* b_base(const Unit& u) const { return (const char*)Bt + ((size_t)u.e * bt_expert_stride + (size_t)u.pn * BM * ldb) * 2; }
};

template <class Epi, class Sched, bool ALIGN_EPI>
__device__ __forceinline__ void gemm_phase(LAS unsigned char* lds, const Gemm g, const Sched& S, const Epi& E) {
    const int tid = threadIdx.x, wid = __builtin_amdgcn_readfirstlane(tid >> 6), lane = tid & 63, wr = wid >> 2, wc = wid & 3, fr = lane & 15, fq = lane >> 4;
    const int K = g.K, nt = K / BK;
    unsigned voffA[2], voffB[2];
#pragma unroll
    for (int i = 0; i < 2; ++i) { int R, C; stage_rc(tid * 16 + i * 8192, R, C); const int Rb = Epi::PERM ? ((R & ~31) + perm32(R & 31)) : R;
        voffA[i] = (unsigned)(R * g.lda + C) * 2u; voffB[i] = (unsigned)(Rb * g.ldb + C) * 2u; }
    const size_t kstep = (size_t)(BK * 2);
    const size_t hstepA = (size_t)HALF * g.lda * 2, hstepB = (size_t)HALF * g.ldb * 2;
    const unsigned ldsw = (unsigned)wid * 1024u;
    const int aoff = lds_byte(wr * 64 + fr, fq * 8), boff = lds_byte(wc * 32 + fr, fq * 8);
#define PG8_SA(b, h) (((b) * 2 + (h)) * HTB)
#define PG8_SB(b, h) ((4 + (b) * 2 + (h)) * HTB)
#define PG8_STAGE(bufoff, gbase, voff) do { _Pragma("unroll") for (int _i = 0; _i < 2; ++_i) \
        __builtin_amdgcn_global_load_lds((const unsigned*)((const char*)(gbase) + (voff)[_i]), (LAS unsigned*)(lds + (bufoff) + ldsw + _i * 8192), 16, 0, 0); } while (0)
#define PG8_LDA(dst, b, h) do { _Pragma("unroll") for (int m = 0; m < 4; ++m) _Pragma("unroll") for (int k = 0; k < 2; ++k) dst[m][k] = *(const LAS bf16x8*)(lds + PG8_SA(b, h) + aoff + m * 2048 + k * 1024); } while (0)
#define PG8_LDB(dst, b, h) do { _Pragma("unroll") for (int n = 0; n < 2; ++n) _Pragma("unroll") for (int k = 0; k < 2; ++k) dst[n][k] = *(const LAS bf16x8*)(lds + PG8_SB(b, h) + boff + n * 2048 + k * 1024); } while (0)
#define PG8_MMA(ai, bj, At, Bt) do { __builtin_amdgcn_s_setprio(1); _Pragma("unroll") for (int m = 0; m < 4; ++m) _Pragma("unroll") for (int n = 0; n < 2; ++n) _Pragma("unroll") for (int k = 0; k < 2; ++k) \
        acc[ai][bj][m][n] = __builtin_amdgcn_mfma_f32_16x16x32_bf16(Bt[n][k], At[m][k], acc[ai][bj][m][n], 0, 0, 0); __builtin_amdgcn_s_setprio(0); } while (0)
#define PG8_WAIT_V(n) asm volatile("s_waitcnt vmcnt(" #n ")" ::: "memory")
#define PG8_WAIT_L(n) asm volatile("s_waitcnt lgkmcnt(" #n ")" ::: "memory")
#define PG8_BAR __builtin_amdgcn_s_barrier()
#define PG8_SCHED __builtin_amdgcn_sched_barrier(0)
    Unit cur, nxt; int ui = 0;
    if (!S.next(0, cur)) return;
    f32x4 acc[2][2][4][2];
#pragma unroll
    for (int a = 0; a < 2; ++a)
#pragma unroll
        for (int b = 0; b < 2; ++b)
#pragma unroll
            for (int m = 0; m < 4; ++m)
#pragma unroll
                for (int n = 0; n < 2; ++n) acc[a][b][m][n] = (f32x4){0.f, 0.f, 0.f, 0.f};
    bf16x8 At[4][2], B0[2][2], B1[2][2];
    const char* cA = S.a_base(cur); const char* cB = S.b_base(cur);
    PG8_STAGE(PG8_SB(0, 0), cB, voffB); PG8_STAGE(PG8_SB(0, 1), cB + hstepB, voffB); PG8_STAGE(PG8_SA(0, 0), cA, voffA); PG8_STAGE(PG8_SA(0, 1), cA + hstepA, voffA);
    if (wr == 1) PG8_BAR;
    PG8_WAIT_V(2); PG8_BAR;
    PG8_STAGE(PG8_SB(1, 0), cB + kstep, voffB); PG8_STAGE(PG8_SA(1, 0), cA + kstep, voffA); PG8_STAGE(PG8_SB(1, 1), cB + hstepB + kstep, voffB);
    PG8_WAIT_V(6); PG8_BAR;
    for (;;) {
        const bool has_next = S.next(ui + 1, nxt);
        const char* nA = has_next ? S.a_base(nxt) : cA; const char* nB = has_next ? S.b_base(nxt) : cB;
        for (int t = 0; t < nt; t += 2) {
            const bool last = (t == nt - 2);
            const char* a1 = cA + (size_t)(t + 1) * kstep;
            const char* a2 = last ? nA : cA + (size_t)(t + 2) * kstep; const char* b2 = last ? nB : cB + (size_t)(t + 2) * kstep;
            const char* a3 = a2 + kstep; const char* b3 = b2 + kstep;
            PG8_LDB(B0, 0, 0); PG8_LDB(B1, 0, 1); PG8_SCHED; PG8_LDA(At, 0, 0); PG8_STAGE(PG8_SA(1, 1), a1 + hstepA, voffA);
            PG8_WAIT_V(8); PG8_WAIT_L(0); PG8_BAR; PG8_MMA(0, 0, At, B0); PG8_MMA(0, 1, At, B1); PG8_BAR; PG8_SCHED;
            PG8_LDA(At, 0, 1); PG8_STAGE(PG8_SB(0, 0), b2, voffB); PG8_STAGE(PG8_SB(0, 1), b2 + hstepB, voffB); PG8_STAGE(PG8_SA(0, 0), a2, voffA);
            PG8_WAIT_V(8); PG8_WAIT_L(0); PG8_BAR; PG8_MMA(1, 0, At, B0); PG8_MMA(1, 1, At, B1); PG8_BAR; PG8_SCHED;
            PG8_LDB(B0, 1, 0); PG8_LDB(B1, 1, 1); PG8_SCHED; PG8_LDA(At, 1, 0); PG8_STAGE(PG8_SA(0, 1), a2 + hstepA, voffA);
            PG8_WAIT_V(8); PG8_WAIT_L(0); PG8_BAR; PG8_MMA(0, 0, At, B0); PG8_MMA(0, 1, At, B1); PG8_BAR; PG8_SCHED;
            PG8_LDA(At, 1, 1); PG8_STAGE(PG8_SB(1, 0), b3, voffB); PG8_STAGE(PG8_SB(1, 1), b3 + hstepB, voffB); PG8_STAGE(PG8_SA(1, 0), a3, voffA);
            PG8_WAIT_V(8); PG8_WAIT_L(0); PG8_BAR; PG8_MMA(1, 0, At, B0); PG8_MMA(1, 1, At, B1); PG8_BAR; PG8_SCHED;
        }
        if constexpr (ALIGN_EPI) { if (wr == 0) PG8_BAR; }
        E(acc, cur, wr, wc, fr, fq);
        if (!has_next) break;
#pragma unroll
        for (int a = 0; a < 2; ++a)
#pragma unroll
            for (int b = 0; b < 2; ++b)
#pragma unroll
                for (int m = 0; m < 4; ++m)
#pragma unroll
                    for (int n = 0; n < 2; ++n) acc[a][b][m][n] = (f32x4){0.f, 0.f, 0.f, 0.f};
        cur = nxt; cA = nA; cB = nB; ++ui;
        if constexpr (ALIGN_EPI) { if (wr == 1) PG8_BAR; }
    }
    PG8_WAIT_V(0);
    if constexpr (!ALIGN_EPI) { if (wr == 0) PG8_BAR; }
    PG8_BAR;
#undef PG8_SA
#undef PG8_SB
#undef PG8_STAGE
#undef PG8_LDA
#undef PG8_LDB
#undef PG8_MMA
#undef PG8_WAIT_V
#undef PG8_WAIT_L
#undef PG8_BAR
#undef PG8_SCHED
}

struct EpiP {
    static constexpr bool PERM = true;
    bf16_t *Prw, *Patt, *Pgate;
    __device__ __forceinline__ void operator()(const f32x4 (&acc)[2][2][4][2], const Unit& u, int wr, int wc, int fr, int fq) const {
        const int row0 = u.pm * BM + wr * 64 + fr; bf16_t* base; int ldc, colt; bool sig = false;
        if (u.pn < 7) { base = Prw; ldc = RCOLS; colt = u.pn * BM; } else if (u.pn < 13) { base = Patt; ldc = ACOLS; colt = (u.pn - 7) * BM; } else { base = Pgate; ldc = GCOLS; colt = (u.pn - 13) * BM; sig = true; }
        const int col0 = colt + wc * 32 + 8 * fq;
#pragma unroll
        for (int ai = 0; ai < 2; ++ai)
#pragma unroll
            for (int m = 0; m < 4; ++m) { bf16_t* rowp = base + (size_t)(row0 + ai * HALF + m * 16) * ldc + col0;
#pragma unroll
                for (int bj = 0; bj < 2; ++bj) { f32x4 v0 = acc[ai][bj][m][0], v1 = acc[ai][bj][m][1];
                    if (sig) {
#pragma unroll
                        for (int j = 0; j < 4; ++j) { v0[j] = sigmoidf_(v0[j]); v1[j] = sigmoidf_(v1[j]); } }
                    u32x4 w; w.x = cvt_pk_bf16(v0[0], v0[1]); w.y = cvt_pk_bf16(v0[2], v0[3]); w.z = cvt_pk_bf16(v1[0], v1[1]); w.w = cvt_pk_bf16(v1[2], v1[3]);
                    *(u32x4*)(rowp + bj * HALF) = w; } }
    }
};
template <bool SECOND> struct EpiBranch {
    static constexpr bool PERM = true;
    bf16_t* T; const bf16_t* Pgate;
    __device__ __forceinline__ void operator()(const f32x4 (&acc)[2][2][4][2], const Unit& u, int wr, int wc, int fr, int fq) const {
        const int row0 = u.pm * BM + wr * 64 + fr, col0 = u.pn * BM + wc * 32 + 8 * fq;
#pragma unroll
        for (int ai = 0; ai < 2; ++ai)
#pragma unroll
            for (int m = 0; m < 4; ++m) { const size_t row = (size_t)(row0 + ai * HALF + m * 16);
#pragma unroll
                for (int bj = 0; bj < 2; ++bj) { const int col = col0 + bj * HALF;
                    const u32x4 gw = *(const u32x4*)(Pgate + row * GCOLS + (SECOND ? DM : 0) + col);
                    f32x4 v0 = acc[ai][bj][m][0], v1 = acc[ai][bj][m][1];
                    v0[0] *= bf_lo(gw.x); v0[1] *= bf_hi(gw.x); v0[2] *= bf_lo(gw.y); v0[3] *= bf_hi(gw.y); v1[0] *= bf_lo(gw.z); v1[1] *= bf_hi(gw.z); v1[2] *= bf_lo(gw.w); v1[3] *= bf_hi(gw.w);
                    bf16_t* tp = T + row * DM + col;
                    if (SECOND) { const u32x4 tw = *(const u32x4*)tp;
                        v0[0] += bf_lo(tw.x); v0[1] += bf_hi(tw.x); v0[2] += bf_lo(tw.y); v0[3] += bf_hi(tw.y); v1[0] += bf_lo(tw.z); v1[1] += bf_hi(tw.z); v1[2] += bf_lo(tw.w); v1[3] += bf_hi(tw.w); }
                    u32x4 w; w.x = cvt_pk_bf16(v0[0], v0[1]); w.y = cvt_pk_bf16(v0[2], v0[3]); w.z = cvt_pk_bf16(v1[0], v1[1]); w.w = cvt_pk_bf16(v1[2], v1[3]);
                    *(u32x4*)tp = w; } }
    }
};
struct EpiOut {
    static constexpr bool PERM = false;
    const float* x; float* out; const float* mod;
    __device__ __forceinline__ void operator()(const f32x4 (&acc)[2][2][4][2], const Unit& u, int wr, int wc, int fr, int fq) const {
        const int row0 = u.pm * BM + wr * 64 + fr, col0 = u.pn * BM + wc * 32 + 4 * fq;
        const int b = (u.pm * BM) / SEQ; const float* g1 = mod + (size_t)b * MODW + 2 * DM;
        f32x4 gv[2][2];
#pragma unroll
        for (int bj = 0; bj < 2; ++bj)
#pragma unroll
            for (int n = 0; n < 2; ++n) gv[bj][n] = *(const f32x4*)(g1 + col0 + bj * HALF + n * 16);
#pragma unroll
        for (int ai = 0; ai < 2; ++ai)
#pragma unroll
            for (int m = 0; m < 4; ++m) { const size_t off = (size_t)(row0 + ai * HALF + m * 16) * DM + col0;
#pragma unroll
                for (int bj = 0; bj < 2; ++bj)
#pragma unroll
                    for (int n = 0; n < 2; ++n) { const f32x4 xv = *(const f32x4*)(x + off + bj * HALF + n * 16); *(f32x4*)(out + off + bj * HALF + n * 16) = xv + gv[bj][n] * acc[ai][bj][m][n]; } }
    }
};
struct EpiHid {
    static constexpr bool PERM = true;
    bf16_t* hid;
    __device__ __forceinline__ void operator()(const f32x4 (&acc)[2][2][4][2], const Unit& u, int wr, int wc, int fr, int fq) const {
        const int row0 = u.pm * BM + wr * 64 + fr, hc0 = u.pn * 128 + wc * 16 + 4 * fq;
#pragma unroll
        for (int ai = 0; ai < 2; ++ai)
#pragma unroll
            for (int m = 0; m < 4; ++m) { bf16_t* rowp = hid + (size_t)(row0 + ai * HALF + m * 16) * DE + hc0;
#pragma unroll
                for (int bj = 0; bj < 2; ++bj) { const f32x4 gt = acc[ai][bj][m][0], up = acc[ai][bj][m][1]; float h[4];
#pragma unroll
                    for (int j = 0; j < 4; ++j) h[j] = gt[j] * sigmoidf_(gt[j]) * up[j];
                    u32x2 w; w.x = cvt_pk_bf16(h[0], h[1]); w.y = cvt_pk_bf16(h[2], h[3]); *(u32x2*)(rowp + bj * 64) = w; } }
    }
};
struct EpiY {
    static constexpr bool PERM = true;
    bf16_t* Y; const float* slot_w;
    __device__ __forceinline__ void operator()(const f32x4 (&acc)[2][2][4][2], const Unit& u, int wr, int wc, int fr, int fq) const {
        const int row0 = u.pm * BM + wr * 64 + fr, col0 = u.pn * BM + wc * 32 + 8 * fq;
        float w[2][4];
#pragma unroll
        for (int ai = 0; ai < 2; ++ai)
#pragma unroll
            for (int m = 0; m < 4; ++m) w[ai][m] = slot_w[row0 + ai * HALF + m * 16];
#pragma unroll
        for (int ai = 0; ai < 2; ++ai)
#pragma unroll
            for (int m = 0; m < 4; ++m) { bf16_t* rowp = Y + (size_t)(row0 + ai * HALF + m * 16) * DM + col0; const float ws = w[ai][m];
#pragma unroll
                for (int bj = 0; bj < 2; ++bj) { const f32x4 v0 = acc[ai][bj][m][0] * ws, v1 = acc[ai][bj][m][1] * ws;
                    u32x4 o; o.x = cvt_pk_bf16(v0[0], v0[1]); o.y = cvt_pk_bf16(v0[2], v0[3]); o.z = cvt_pk_bf16(v1[0], v1[1]); o.w = cvt_pk_bf16(v1[2], v1[3]);
                    *(u32x4*)(rowp + bj * HALF) = o; } }
    }
};
}
typedef GAS unsigned gu32;
#define RLX_AGENT __ATOMIC_RELAXED, __HIP_MEMORY_SCOPE_AGENT
#define LDS_WAIT() asm volatile("s_waitcnt lgkmcnt(0)" ::: "memory")
#define VM_WAIT() asm volatile("s_waitcnt vmcnt(0)" ::: "memory")
#define XB_TMO      128
#define XB_XCNT(j)  (256  + 64 * (j))
#define XB_XSUB(j)  (1280 + 64 * (j))
#define XB_XGEN(j)  (2304 + 64 * (j))
#define XB_TOP      3328
#define XB_TOPGEN   3392
#define XCD_BAR_WORDS 3456
#define XB_SPIN_CAP (1u << 18)

__device__ __forceinline__ unsigned xb_ld(unsigned* p)              { return __hip_atomic_load(p, __ATOMIC_RELAXED, __HIP_MEMORY_SCOPE_AGENT); }
__device__ __forceinline__ unsigned xb_add(unsigned* p, unsigned v) { return __hip_atomic_fetch_add(p, v, __ATOMIC_RELAXED, __HIP_MEMORY_SCOPE_AGENT); }
__device__ __forceinline__ unsigned xb_xcc_id() { return (unsigned)__builtin_amdgcn_s_getreg((3 << 11) | 20) & 0xFu; }
#define XB_SPIN(cond, bar) do { unsigned _sp = 0; while (cond) { __builtin_amdgcn_s_sleep(1); \
    if ((++_sp & 255u) == 0u) { if (xb_ld(&(bar)[XB_TMO])) break; if (_sp > XB_SPIN_CAP) { atomicAdd(&(bar)[XB_TMO], 1u); break; } } } } while (0)

struct XcdBarrier {
    unsigned* bar; unsigned x;
    volatile LAS unsigned* st;
};

__device__ __forceinline__ XcdBarrier xcd_barrier_post(unsigned* bar, volatile LAS unsigned* st) {
    XcdBarrier b; b.bar = bar; b.x = xb_xcc_id(); b.st = st;
    if (threadIdx.x == 0) (void)xb_add(&bar[XB_XCNT(b.x)], 1u);
    return b;
}
__device__ __forceinline__ void xcd_barrier_complete(unsigned* bar, unsigned x, unsigned& nloc, unsigned& nx) {
    const unsigned G = gridDim.x * gridDim.y * gridDim.z;
    unsigned sum, cnt, mine, sp = 0u;
    for (;;) {
        sum = 0u; cnt = 0u; mine = 0u;
#pragma unroll
        for (unsigned j = 0; j < 16; ++j) { const unsigned c = xb_ld(&bar[XB_XCNT(j)]); sum += c; cnt += (c > 0u) ? 1u : 0u; mine = (j == x) ? c : mine; }
        if (sum == G) break;
        __builtin_amdgcn_s_sleep(1);
        if ((++sp & 255u) == 0u) { if (xb_ld(&bar[XB_TMO])) break; if (sp > XB_SPIN_CAP) { atomicAdd(&bar[XB_TMO], 1u); break; } }
    }
    nloc = mine > 0u ? mine : 1u; nx = cnt > 0u ? cnt : 1u;
}

__device__ __forceinline__ void xcd_barrier(const XcdBarrier& b) {
    asm volatile("s_waitcnt vmcnt(0)" ::: "memory");
    __syncthreads();
    if (threadIdx.x == 0) {
        unsigned* bar = b.bar;
        __builtin_amdgcn_s_waitcnt(0);
        unsigned nloc = b.st[0], nx = b.st[1];
        if (nloc == 0u) { xcd_barrier_complete(bar, b.x, nloc, nx); b.st[0] = nloc; b.st[1] = nx; }
        const unsigned old = xb_add(&bar[XB_XSUB(b.x)], 1u);
        const unsigned gen = old / nloc;
        if (old + 1u == (gen + 1u) * nloc) {
            __builtin_amdgcn_fence(__ATOMIC_RELEASE, "agent");
            asm volatile("s_waitcnt vmcnt(0)" ::: "memory");
            const unsigned og = xb_add(&bar[XB_TOP], 1u);
            const unsigned tg = og / nx;
            if (og + 1u == (tg + 1u) * nx) xb_add(&bar[XB_TOPGEN], 1u);
            else XB_SPIN(xb_ld(&bar[XB_TOPGEN]) == tg, bar);
            __builtin_amdgcn_fence(__ATOMIC_ACQUIRE, "agent");
            xb_add(&bar[XB_XGEN(b.x)], 1u);
            asm volatile("s_waitcnt vmcnt(0)" ::: "memory");
        } else {
            XB_SPIN(xb_ld(&bar[XB_XGEN(b.x)]) == gen, bar);
            __builtin_amdgcn_fence(__ATOMIC_ACQUIRE, "agent");
            asm volatile("s_waitcnt vmcnt(0)" ::: "memory");
        }
    }
    __syncthreads();
}

constexpr int NWAVES = 8;
constexpr size_t MiB = 1u << 20, KiB = 1u << 10;
constexpr size_t WS_CTL = 0, CTL_ZERO_BYTES = 2 * MiB;
constexpr size_t WS_MOD = 1 * MiB;
constexpr size_t WS_WIN = 2 * MiB;
constexpr size_t WS_WBR = 12 * MiB + 512 * KiB, WS_WBA = 13 * MiB + 512 * KiB, WS_WOUT = 14 * MiB + 512 * KiB;
constexpr size_t WS_WUP = 16 * MiB + 512 * KiB, WS_AUP = WS_WUP + 64 * KiB, WS_GUP = WS_WUP + 128 * KiB;
constexpr size_t WS_WRH = 16 * MiB + 768 * KiB, WS_WRL = WS_WRH + 128 * KiB;
constexpr size_t WS_CB = 17 * MiB, WS_GAM2 = 17 * MiB + 64 * KiB;
constexpr size_t WS_PRW = 18 * MiB, WS_PATT = 130 * MiB, WS_PGATE = 226 * MiB;
constexpr size_t WS_WGU = 130 * MiB, WS_WD = 194 * MiB;
constexpr size_t WS_T = 18 * MiB;
constexpr size_t WS_HID = 18 * MiB, WS_H2 = 226 * MiB, WS_H2S = 290 * MiB;
constexpr size_t WS_SLOTTOK = 450 * MiB, WS_SLOTW = WS_SLOTTOK + 512 * KiB, WS_TOKLIST = 451 * MiB, WS_TOKPOS = WS_TOKLIST + 256 * KiB, WS_TOKW = WS_TOKLIST + 512 * KiB;
constexpr size_t WS_QE = 354 * MiB, WS_YLOC = 386 * MiB, WS_PC = 418 * MiB, WS_SLOC = 450 * MiB;
constexpr size_t WS_YB = 290 * MiB;
constexpr size_t WS_END = 512 * MiB;
constexpr size_t DO_H = 0, DO_G = 0, DO_SC = 32 * MiB, DO_YA = 64 * MiB, DO_YR = 96 * MiB;
constexpr int NSLOT_MAX = 2 * NTOK + NLIST * 256;
constexpr int CW_TMO = 0, CW_BAR = 4096, CW_CNT = 16384;
constexpr int LDS_BYTES = 163840, RING_BYTES = 131072;
constexpr int LDSCTL_OFF = LDS_BYTES - 1024, MISC_OFF = LDSCTL_OFF;
constexpr int TOFF_OFF = LDSCTL_OFF + 256, TILE_E_OFF = TOFF_OFF + 288;

#define LBAR() do { asm volatile("s_waitcnt lgkmcnt(0)" ::: "memory"); __builtin_amdgcn_s_barrier(); asm volatile("" ::: "memory"); } while (0)
struct Frame {
    LAS unsigned char* lds; volatile LAS unsigned* MISC; gu32* ctl;
    int tid, lane, wave, vcu, G;
};
__device__ __forceinline__ float wave_sum(float v) {
#pragma unroll
    for (int o = 1; o < 64; o <<= 1) v += __shfl_xor(v, o);
    return v;
}
__device__ __forceinline__ float dpp_f(float x, const int ctrl_sel) {
    const int xi = __builtin_bit_cast(int, x); int r;
    if (ctrl_sel == 0) r = __builtin_amdgcn_update_dpp(0, xi, 0xB1, 0xf, 0xf, true);
    else if (ctrl_sel == 1) r = __builtin_amdgcn_update_dpp(0, xi, 0x4E, 0xf, 0xf, true);
    else r = __builtin_amdgcn_update_dpp(0, xi, 0x141, 0xf, 0xf, true);
    return __builtin_bit_cast(float, r);
}
__device__ __forceinline__ float red8(float x) { x += dpp_f(x, 0); x += dpp_f(x, 1); x += dpp_f(x, 2); return x; }

__device__ __forceinline__ void phase_mod(Frame& F, const float* c, const float* w_ada, const float* b_ada, float* mod) {
    const int gw = F.vcu * NWAVES + F.wave, NGW = F.G * NWAVES;
    for (int task = gw; task < 96 * 16; task += NGW) {
        const int nc = task % 96, ks = task / 96, n = nc * 64 + F.lane, k0 = ks * 64;
        float acc[16];
#pragma unroll
        for (int b = 0; b < 16; ++b) acc[b] = 0.f;
        LAS float* sl = (LAS float*)(F.lds) + F.wave * 1024;
#pragma unroll
        for (int j = 0; j < 16; ++j) { const float cv = c[(F.lane & 15) * DM + k0 + (F.lane >> 4) + 4 * j]; sl[((F.lane >> 4) + 4 * j) * 16 + (F.lane & 15)] = cv * sigmoidf_(cv); }
        LDS_WAIT(); asm volatile("" ::: "memory");
#pragma unroll 4
        for (int kk = 0; kk < 64; ++kk) { const float w = w_ada[(size_t)(k0 + kk) * MODW + n];
            const f32x4 s0 = *(const LAS f32x4*)(sl + kk * 16), s1 = *(const LAS f32x4*)(sl + kk * 16 + 4), s2 = *(const LAS f32x4*)(sl + kk * 16 + 8), s3 = *(const LAS f32x4*)(sl + kk * 16 + 12);
            acc[0] += s0.x * w; acc[1] += s0.y * w; acc[2] += s0.z * w; acc[3] += s0.w * w; acc[4] += s1.x * w; acc[5] += s1.y * w; acc[6] += s1.z * w; acc[7] += s1.w * w;
            acc[8] += s2.x * w; acc[9] += s2.y * w; acc[10] += s2.z * w; acc[11] += s2.w * w; acc[12] += s3.x * w; acc[13] += s3.y * w; acc[14] += s3.z * w; acc[15] += s3.w * w; }
        LDS_WAIT(); asm volatile("" ::: "memory");
#pragma unroll
        for (int b = 0; b < 16; ++b) { const float v = acc[b] + (ks == 0 ? b_ada[n] : 0.f); atomicAdd(mod + (size_t)b * MODW + n, v); }
    }
}

template <int MODE> __device__ __forceinline__ void transpose_item(const float* W, int K, int N, bf16_t* WT, int row_off, int item, int lane) {
    const int nblk = N / 32, kb = item / nblk, nb = item % nblk, k0 = 64 * kb + 8 * (lane >> 3), n0 = 32 * nb + 4 * (lane & 7);
    f32x4 v[8];
#pragma unroll
    for (int i = 0; i < 8; ++i) v[i] = *(const f32x4*)(W + (size_t)(k0 + i) * N + n0);
#pragma unroll
    for (int j = 0; j < 4; ++j) { const int ng = n0 + j; const int nr = MODE == 0 ? row_off + ng : (MODE == 1 ? 8 * (ng >> 2) + (ng & 3) : 8 * (ng >> 2) + 4 + (ng & 3));
        u32x4 o; o.x = cvt_pk_bf16(v[0][j], v[1][j]); o.y = cvt_pk_bf16(v[2][j], v[3][j]); o.z = cvt_pk_bf16(v[4][j], v[5][j]); o.w = cvt_pk_bf16(v[6][j], v[7][j]);
        *(GAS u32x4*)(WT + (size_t)nr * K + k0) = o; }
}

struct Args { const float* in[31]; float* out; unsigned char* ws; int ph_lo, ph_hi; };
struct Ptrs { const float* in[31]; float* out; unsigned char* ws; };

__device__ __forceinline__ void phase_prep(Frame& F, const Ptrs& P) {
    const int gw = F.vcu * NWAVES + F.wave, NGW = F.G * NWAVES;
    const float* mod = (const float*)(P.ws + WS_MOD);
    bf16_t* Win_t = (bf16_t*)(P.ws + WS_WIN); bf16_t* Wbr_t = (bf16_t*)(P.ws + WS_WBR); bf16_t* Wba_t = (bf16_t*)(P.ws + WS_WBA); bf16_t* Wout_t = (bf16_t*)(P.ws + WS_WOUT);
    bf16_t* wup_t = (bf16_t*)(P.ws + WS_WUP); bf16_t* aup_t = (bf16_t*)(P.ws + WS_AUP); bf16_t* gup_t = (bf16_t*)(P.ws + WS_GUP);
    constexpr int I_IN = 16 * (INCOLS / 32), I_BR = 8 * 32, I_OUT = 16 * 32, I_UP = 16, I_GUP = 2 * 16;
    constexpr int NITEMS = I_IN + 2 * I_BR + I_OUT + 2 * I_UP + I_GUP;
    for (int it = gw; it < NITEMS; it += NGW) {
        int r = it;
        if (r < I_IN) { transpose_item<0>(P.in[5], DM, INCOLS, Win_t, 0, r, F.lane); continue; } r -= I_IN;
        if (r < I_BR) { transpose_item<0>(P.in[20], 512, DM, Wbr_t, 0, r, F.lane); continue; } r -= I_BR;
        if (r < I_BR) { transpose_item<0>(P.in[21], 512, DM, Wba_t, 0, r, F.lane); continue; } r -= I_BR;
        if (r < I_OUT) { transpose_item<0>(P.in[22], DM, DM, Wout_t, 0, r, F.lane); continue; } r -= I_OUT;
        if (r < I_UP) { transpose_item<0>(P.in[8], 64, 512, wup_t, 0, r, F.lane); continue; } r -= I_UP;
        if (r < I_UP) { transpose_item<0>(P.in[10], 64, 512, aup_t, 0, r, F.lane); continue; } r -= I_UP;
        transpose_item<0>(P.in[11], 128, 512, gup_t, 0, r, F.lane);
    }
    { bf16_t* wrh = (bf16_t*)(P.ws + WS_WRH); bf16_t* wrl = (bf16_t*)(P.ws + WS_WRL);
      for (int idx = (F.vcu * NWAVES * 64 + F.tid); idx < 64 * DM; idx += F.G * NWAVES * 64) { const int o = idx / DM, k = idx % DM;
          const float w = o < 4 ? P.in[24][k * 4 + o] : (o < 36 ? P.in[26][k * 32 + (o - 4)] : 0.f);
          const unsigned hi = cvt_pk_bf16(w, 0.f) & 0xffffu; const float rem = w - __uint_as_float(hi << 16); const unsigned lo = cvt_pk_bf16(rem, 0.f) & 0xffffu;
          wrh[idx] = (bf16_t)hi; wrl[idx] = (bf16_t)lo; } }
    { float* gam2 = (float*)(P.ws + WS_GAM2);
      for (int idx = (F.vcu * NWAVES * 64 + F.tid); idx < NB * DM; idx += F.G * NWAVES * 64) { const int b = idx / DM, k = idx % DM; gam2[idx] = P.in[23][k] * (1.f + mod[(size_t)b * MODW + 4 * DM + k]); } }
    { float* cb = (float*)(P.ws + WS_CB);
      for (int t = gw; t < NB * 36; t += NGW) { const int b = t / 36, o = t % 36; float s = 0.f;
          for (int k = F.lane; k < DM; k += 64) { const float w = o < 4 ? P.in[24][k * 4 + o] : P.in[26][k * 32 + (o - 4)]; s += mod[(size_t)b * MODW + 3 * DM + k] * w; }
          s = wave_sum(s); if (F.lane == 0) cb[b * 64 + o] = s + (o < 4 ? P.in[25][o] : P.in[27][o - 4]); } }
    bf16_t* H = (bf16_t*)((unsigned char*)P.out + DO_H);
    for (int m = gw; m < NTOK; m += NGW) {
        const int b = m / SEQ; const float* sh = mod + (size_t)b * MODW; const float* sc = sh + DM;
        const GAS f32x4* xr = (const GAS f32x4*)(P.in[0] + (size_t)m * DM) + F.lane;
        f32x4 v[4]; float s = 0.f;
#pragma unroll
        for (int j = 0; j < 4; ++j) { v[j] = xr[64 * j]; s += (v[j].x * v[j].x + v[j].y * v[j].y) + (v[j].z * v[j].z + v[j].w * v[j].w); }
        const float rinv = 1.f / sqrtf(wave_sum(s) * (1.f / DM) + 1e-6f);
        GAS u32x2* o8 = (GAS u32x2*)(H + (size_t)m * DM) + F.lane;
#pragma unroll
        for (int j = 0; j < 4; ++j) { const int k = 4 * F.lane + 256 * j; const f32x4 g = *(const f32x4*)(P.in[4] + k), s1 = *(const f32x4*)(sc + k), h1 = *(const f32x4*)(sh + k);
            const f32x4 hv = v[j] * rinv * g * (s1 + 1.f) + h1; u32x2 w; w.x = cvt_pk_bf16(hv.x, hv.y); w.y = cvt_pk_bf16(hv.z, hv.w); o8[64 * j] = w; }
    }
}
__device__ __forceinline__ void expert_convert(Frame& F, const Ptrs& P, int wv, int nwv, int it_lo, int it_hi) {
    bf16_t* Wgu = (bf16_t*)(P.ws + WS_WGU); bf16_t* Wd = (bf16_t*)(P.ws + WS_WD);
    constexpr int I_G = 16 * 16, I_D = 8 * 32;
    for (int it = it_lo + wv; it < it_hi; it += nwv) {
        const int e = it / (2 * I_G + I_D); int r = it % (2 * I_G + I_D);
        if (r < I_G) { transpose_item<1>(P.in[28] + (size_t)e * DM * DE, DM, DE, Wgu + (size_t)e * DM * DM, 0, r, F.lane); continue; } r -= I_G;
        if (r < I_G) { transpose_item<2>(P.in[29] + (size_t)e * DM * DE, DM, DE, Wgu + (size_t)e * DM * DM, 0, r, F.lane); continue; } r -= I_G;
        transpose_item<0>(P.in[30] + (size_t)e * DE * DM, DE, DM, Wd + (size_t)e * DM * DE, 0, r, F.lane);
    }
}
namespace att {
constexpr int SLOT = 16384, NSL = 5, L_WS = NSL * SLOT, L_OST = L_WS + 8 * 256, L_BIAS = L_OST + 8 * 4096, L_END = L_BIAS + 1280;
__device__ __forceinline__ int crow(int r, int hi) { return (r & 3) + 8 * (r >> 2) + 4 * hi; }
__device__ __forceinline__ float max3f(float a, float b, float c) { return fmaxf(fmaxf(a, b), c); }
__device__ __forceinline__ s16x4 vtr(const LAS char* p) { return __builtin_bit_cast(s16x4, __builtin_amdgcn_ds_read_tr16_b64_v4i16((LAS s16x4*)p)); }

__device__ __forceinline__ void attn_unit(Frame& F, const Ptrs& P, int b, int h, int qb) {
    const int tid = F.tid, lane = F.lane, wid = F.wave, r32 = lane & 31, hi = lane >> 5;
    const bf16_t* Patt = (const bf16_t*)(P.ws + WS_PATT);
    bf16_t* Ya = (bf16_t*)((unsigned char*)P.out + DO_YA);
    LAS char* lds = (LAS char*)F.lds;
    LAS float* wsf = (LAS float*)(lds + L_WS) + wid * 64;
    LAS float* biasL = (LAS float*)(lds + L_BIAS);
    const int cq = wid >> 1, ci = qb * 4 + cq, kc0 = qb * 4 - 8;
    const size_t rowbase = (size_t)b * SEQ;
    for (int i = tid; i < 257; i += 512) biasL[i] = P.in[19][h * 257 + i] * LOG2E;
    const int srow = tid >> 3, sc8 = tid & 7;
    f32x4 kg0 = *(const f32x4*)(P.in[18] + 8 * sc8), kg1 = *(const f32x4*)(P.in[18] + 8 * sc8 + 4);
    const int kdst = sc8 * 1024 + srow * 16, vdst = 8192 + (sc8 >> 2) * 4096 + (srow >> 4) * 1024 + (srow & 15) * 64 + (sc8 & 3) * 16;
    auto ld_k = [&](int j) -> u32x4 { return *(const u32x4*)(Patt + (rowbase + (size_t)(kc0 + j) * 64 + srow) * ACOLS + 512 + h * 64 + 8 * sc8); };
    auto ld_v = [&](int j) -> u32x4 { return *(const u32x4*)(Patt + (rowbase + (size_t)(kc0 + j) * 64 + srow) * ACOLS + 1024 + h * 64 + 8 * sc8); };
    auto st_kv = [&](int j, u32x4 kw, u32x4 vw) {
        float kf[8] = {bf_lo(kw.x), bf_hi(kw.x), bf_lo(kw.y), bf_hi(kw.y), bf_lo(kw.z), bf_hi(kw.z), bf_lo(kw.w), bf_hi(kw.w)};
        float ss = 0.f;
#pragma unroll
        for (int i = 0; i < 8; ++i) ss += kf[i] * kf[i];
        ss = red8(ss); const float rk = 1.f / sqrtf(ss * (1.f / 64.f) + 1e-6f);
        u32x4 o; o.x = cvt_pk_bf16(kf[0] * rk * kg0.x, kf[1] * rk * kg0.y); o.y = cvt_pk_bf16(kf[2] * rk * kg0.z, kf[3] * rk * kg0.w);
        o.z = cvt_pk_bf16(kf[4] * rk * kg1.x, kf[5] * rk * kg1.y); o.w = cvt_pk_bf16(kf[6] * rk * kg1.z, kf[7] * rk * kg1.w);
        LAS char* sl = lds + (j % NSL) * SLOT;
        *(LAS u32x4*)(sl + kdst) = o; *(LAS u32x4*)(sl + vdst) = vw; };
    { u32x4 kws[4], vws[4];
#pragma unroll
      for (int j = 0; j < 4; ++j) if (kc0 + j >= 0) { kws[j] = ld_k(j); vws[j] = ld_v(j); }
#pragma unroll
      for (int j = 0; j < 4; ++j) if (kc0 + j >= 0) st_kv(j, kws[j], vws[j]); }
    const size_t qrow = rowbase + (size_t)ci * 64 + (wid & 1) * 32 + r32;
    bf16x8 qr[4];
    { float qf[4][8]; float ss = 0.f;
#pragma unroll
      for (int d0 = 0; d0 < 4; ++d0) { const u32x4 w = *(const u32x4*)(Patt + qrow * ACOLS + h * 64 + d0 * 16 + hi * 8);
          qf[d0][0] = bf_lo(w.x); qf[d0][1] = bf_hi(w.x); qf[d0][2] = bf_lo(w.y); qf[d0][3] = bf_hi(w.y); qf[d0][4] = bf_lo(w.z); qf[d0][5] = bf_hi(w.z); qf[d0][6] = bf_lo(w.w); qf[d0][7] = bf_hi(w.w);
#pragma unroll
          for (int i = 0; i < 8; ++i) ss += qf[d0][i] * qf[d0][i]; }
      ss += __shfl_xor(ss, 32);
      const float rq = (0.125f * LOG2E) / sqrtf(ss * (1.f / 64.f) + 1e-6f);
#pragma unroll
      for (int d0 = 0; d0 < 4; ++d0) { const f32x4 g0 = *(const f32x4*)(P.in[17] + d0 * 16 + hi * 8), g1 = *(const f32x4*)(P.in[17] + d0 * 16 + hi * 8 + 4);
          u32x4 o; o.x = cvt_pk_bf16(qf[d0][0] * rq * g0.x, qf[d0][1] * rq * g0.y); o.y = cvt_pk_bf16(qf[d0][2] * rq * g0.z, qf[d0][3] * rq * g0.w);
          o.z = cvt_pk_bf16(qf[d0][4] * rq * g1.x, qf[d0][5] * rq * g1.y); o.w = cvt_pk_bf16(qf[d0][6] * rq * g1.z, qf[d0][7] * rq * g1.w);
          qr[d0] = __builtin_bit_cast(bf16x8, o); } }
    u32x4 kA, vA; if (kc0 + 4 >= 0) { kA = ld_k(4); vA = ld_v(4); }
    float mrun = -1e30f, lrun = 0.f; f32x16 o0 = {}, o1 = {};
    const int qloc = (wid & 1) * 32 + r32;
    __syncthreads();
#pragma unroll 1
    for (int s = 0; s < 9; ++s) {
        const int jn = s + 4; const bool ld = (jn <= 11) && (kc0 + jn >= 0);
        const bool ldn = (jn + 1 <= 11) && (kc0 + jn + 1 >= 0); u32x4 kB, vB; if (ldn) { kB = ld_k(jn + 1); vB = ld_v(jn + 1); }
        const int j = cq + s;
        if (kc0 + j >= 0) {
            const LAS char* sl = lds + (j % NSL) * SLOT;
            f32x16 p0, p1;
            if (s <= 5) { const float c0 = biasL[0];
#pragma unroll
                for (int r = 0; r < 16; ++r) { p0[r] = c0; p1[r] = c0; } }
            else { const int base = 64 * (s - 8) - qloc + 128;
#pragma unroll
                for (int r = 0; r < 16; ++r) { int i0 = base + crow(r, hi), i1 = i0 + 32; i0 = i0 < 0 ? 0 : (i0 > 256 ? 256 : i0); i1 = i1 < 0 ? 0 : (i1 > 256 ? 256 : i1); p0[r] = biasL[i0]; p1[r] = biasL[i1]; } }
            const LAS char* kb = sl + hi * 1024 + r32 * 16;
#pragma unroll
            for (int d0 = 0; d0 < 4; ++d0) { const bf16x8 b0 = *(const LAS bf16x8*)(kb + d0 * 2048), b1 = *(const LAS bf16x8*)(kb + d0 * 2048 + 512);
                p0 = __builtin_amdgcn_mfma_f32_32x32x16_bf16(b0, qr[d0], p0, 0, 0, 0); p1 = __builtin_amdgcn_mfma_f32_32x32x16_bf16(b1, qr[d0], p1, 0, 0, 0); }
            float a = max3f(p0[0], p0[1], p1[0]), bm = max3f(p0[2], p0[3], p1[1]); a = max3f(a, p1[2], p1[3]);
#pragma unroll
            for (int r = 4; r < 16; r += 4) { a = max3f(a, p0[r], p0[r + 1]); bm = max3f(bm, p0[r + 2], p0[r + 3]); a = max3f(a, p1[r], p1[r + 1]); bm = max3f(bm, p1[r + 2], p1[r + 3]); }
            float rm = fmaxf(a, bm); rm = fmaxf(rm, __shfl_xor(rm, 32));
            const float mnew = fmaxf(mrun, rm), f = __builtin_amdgcn_exp2f(mrun - mnew); mrun = mnew;
            float sacc = 0.f;
#pragma unroll
            for (int r = 0; r < 16; ++r) { p0[r] = __builtin_amdgcn_exp2f(p0[r] - mnew); p1[r] = __builtin_amdgcn_exp2f(p1[r] - mnew); sacc += p0[r] + p1[r]; }
            lrun = lrun * f + sacc;
            if (hi == 0) wsf[r32] = f;
            u32x4 pw0, pw1, pw2, pw3;
            pw0 = (u32x4){cvt_pk_bf16(p0[0], p0[1]), cvt_pk_bf16(p0[2], p0[3]), cvt_pk_bf16(p0[4], p0[5]), cvt_pk_bf16(p0[6], p0[7])};
            pw1 = (u32x4){cvt_pk_bf16(p0[8], p0[9]), cvt_pk_bf16(p0[10], p0[11]), cvt_pk_bf16(p0[12], p0[13]), cvt_pk_bf16(p0[14], p0[15])};
            pw2 = (u32x4){cvt_pk_bf16(p1[0], p1[1]), cvt_pk_bf16(p1[2], p1[3]), cvt_pk_bf16(p1[4], p1[5]), cvt_pk_bf16(p1[6], p1[7])};
            pw3 = (u32x4){cvt_pk_bf16(p1[8], p1[9]), cvt_pk_bf16(p1[10], p1[11]), cvt_pk_bf16(p1[12], p1[13]), cvt_pk_bf16(p1[14], p1[15])};
            LDS_WAIT(); asm volatile("" ::: "memory");
#pragma unroll
            for (int r = 0; r < 16; ++r) { const float fr_ = wsf[crow(r, hi)]; o0[r] *= fr_; o1[r] *= fr_; }
            const LAS char* vp = sl + 8192 + ((lane >> 4) & 1) * 32 + (lane & 3) * 8 + (4 * hi + ((lane & 15) >> 2)) * 64;
            const bf16x8 pa[4] = {__builtin_bit_cast(bf16x8, pw0), __builtin_bit_cast(bf16x8, pw1), __builtin_bit_cast(bf16x8, pw2), __builtin_bit_cast(bf16x8, pw3)};
#pragma unroll
            for (int ks = 0; ks < 4; ++ks) {
                const s16x4 l0 = vtr(vp + ks * 1024), h0 = vtr(vp + ks * 1024 + 512), l1 = vtr(vp + 4096 + ks * 1024), h1 = vtr(vp + 4096 + ks * 1024 + 512);
                const bf16x8 v0 = (bf16x8){l0[0], l0[1], l0[2], l0[3], h0[0], h0[1], h0[2], h0[3]}, v1 = (bf16x8){l1[0], l1[1], l1[2], l1[3], h1[0], h1[1], h1[2], h1[3]};
                o0 = __builtin_amdgcn_mfma_f32_32x32x16_bf16(pa[ks], v0, o0, 0, 0, 0); o1 = __builtin_amdgcn_mfma_f32_32x32x16_bf16(pa[ks], v1, o1, 0, 0, 0); }
        }
        if (ld) st_kv(jn, kA, vA);
        LBAR();
        kA = kB; vA = vB;
    }
    lrun += __shfl_xor(lrun, 32);
    if (hi == 0) wsf[32 + r32] = lrun;
    LDS_WAIT(); asm volatile("" ::: "memory");
    LAS bf16_t* stg = (LAS bf16_t*)(lds + L_OST) + wid * 2048;
#pragma unroll
    for (int r = 0; r < 16; ++r) { const int orow = crow(r, hi); const float rl = __builtin_amdgcn_rcpf(wsf[32 + orow]);
        stg[orow * 64 + r32] = (bf16_t)(cvt_pk_bf16(o0[r] * rl, 0.f) & 0xffffu); stg[orow * 64 + 32 + r32] = (bf16_t)(cvt_pk_bf16(o1[r] * rl, 0.f) & 0xffffu); }
    LDS_WAIT(); asm volatile("" ::: "memory");
    bf16_t* Ow = Ya + (rowbase + (size_t)ci * 64 + (wid & 1) * 32) * 512 + h * 64;
#pragma unroll
    for (int i = 0; i < 4; ++i) { const int row = i * 8 + (lane >> 3), ch = lane & 7; const u32x4 v = *(const LAS u32x4*)(stg + row * 64 + ch * 8); *(u32x4*)(Ow + (size_t)row * 512 + ch * 8) = v; }
    __syncthreads();
}
}

namespace rc {
constexpr int LDB = 72, MB = 64 * LDB * 2;
constexpr int FLD = 68, FB = 64 * FLD * 4;
constexpr int L_AT = 0, L_ATT = MB, L_BT = 2 * MB, L_KT = 3 * MB, L_RT = 4 * MB, L_BHT = 5 * MB, L_KHT = 6 * MB, L_VT = 7 * MB;
constexpr int L_TWD = 0, L_AD = 9216, L_SGD = 18432;
constexpr int RB = 8 * MB;
constexpr int L_WL = RB, L_AL = RB + FB, L_GL = RB + 2 * FB, L_SEG = RB + 3 * FB;
constexpr int L_NQ0 = RB, L_NQ1 = RB + MB, L_NT0 = RB + 2 * MB, L_NT1 = RB + 3 * MB, L_TQ0 = RB + 4 * MB, L_TQ1 = RB + 5 * MB, L_NKT = RB + 6 * MB, L_NRB = RB + 7 * MB;
constexpr int L_GLD = RB + 8 * MB;
constexpr int L_W1T = L_NQ0, L_W2T = L_NT0, L_WY = L_AT, L_KC = L_BT;
constexpr int L_TAB = L_GLD + 256;
constexpr int T_MUL = 0, T_MUR = 256, T_PAR = 448, T_N = 832;
static_assert(L_SEG + 2048 <= L_GLD && L_TAB + T_N * 4 <= LDSCTL_OFF, "rwkv chunk LDS");

__device__ __forceinline__ void unpack8(const u32x4 w, float* f) { f[0] = bf_lo(w.x); f[1] = bf_hi(w.x); f[2] = bf_lo(w.y); f[3] = bf_hi(w.y); f[4] = bf_lo(w.z); f[5] = bf_hi(w.z); f[6] = bf_lo(w.w); f[7] = bf_hi(w.w); }
__device__ __forceinline__ f32x16 mm64(f32x16 acc, const LAS char* Arows, const LAS char* Bcols, int lane) {
    const int o = ((lane & 31) * LDB + 8 * (lane >> 5)) * 2;
#pragma unroll
    for (int ks = 0; ks < 4; ++ks) { const bf16x8 a = *(const LAS bf16x8*)(Arows + o + 32 * ks), b = *(const LAS bf16x8*)(Bcols + o + 32 * ks); acc = __builtin_amdgcn_mfma_f32_32x32x16_bf16(a, b, acc, 0, 0, 0); }
    return acc;
}
__device__ __forceinline__ void store_T(const f32x16& d, LAS char* dst, int mb, int nb, int lane) {
    LAS char* p = dst + ((32 * nb + (lane & 31)) * LDB + 32 * mb + 4 * (lane >> 5)) * 2;
#pragma unroll
    for (int g = 0; g < 4; ++g) { u32x2 w; w.x = cvt_pk_bf16(d[4 * g], d[4 * g + 1]); w.y = cvt_pk_bf16(d[4 * g + 2], d[4 * g + 3]); *(LAS u32x2*)(p + 16 * g) = w; }
}
__device__ __forceinline__ void store_T_g(const f32x16& d, bf16_t* dst, int mb, int nb, int lane) {
    bf16_t* p = dst + (32 * nb + (lane & 31)) * 64 + 32 * mb + 4 * (lane >> 5);
#pragma unroll
    for (int g = 0; g < 4; ++g) { u32x2 w; w.x = cvt_pk_bf16(d[4 * g], d[4 * g + 1]); w.y = cvt_pk_bf16(d[4 * g + 2], d[4 * g + 3]); *(u32x2*)(p + 8 * g) = w; }
}
#define RC_M(r) (32 * mb + 8 * ((r) >> 2) + 4 * hi + ((r) & 3))

struct Raw { u32x4 lc[4], lp[4], rc[3], rp[3]; };
__device__ __forceinline__ void load_raw(Raw& R, const bf16_t* Prw, int u, int t, int cg) {
    const int b = u >> 8, h = (u >> 5) & 7, c = u & 31;
    const size_t row = (size_t)b * SEQ + 64 * c + t; const bool hasprev = (c > 0) || (t > 0);
    const bf16_t* pc = Prw + row * RCOLS; const bf16_t* pp = pc - RCOLS; const int lc0 = 1536 + 32 * cg, hd = h * 64 + 8 * cg;
#pragma unroll
    for (int q = 0; q < 4; ++q) { R.lc[q] = *(const u32x4*)(pc + lc0 + 8 * q); R.lp[q] = hasprev ? *(const u32x4*)(pp + lc0 + 8 * q) : (u32x4){0u, 0u, 0u, 0u}; }
#pragma unroll
    for (int w = 0; w < 3; ++w) { R.rc[w] = *(const u32x4*)(pc + w * 512 + hd); R.rp[w] = hasprev ? *(const u32x4*)(pp + w * 512 + hd) : (u32x4){0u, 0u, 0u, 0u}; }
}
__device__ __forceinline__ void chunk_phase(Frame& F, const Ptrs& P) {
  const bf16_t* Prw = (const bf16_t*)(P.ws + WS_PRW);
  int htab = -1; bf16x8 wA[4]; Raw raw;
  if ((int)blockIdx.x < NB * 8 * 32) load_raw(raw, Prw, (int)blockIdx.x, F.tid >> 3, F.tid & 7);
#pragma unroll 1
  for (int u_ = (int)blockIdx.x; u_ < NB * 8 * 32; u_ += F.G) {
    int tid = F.tid, wid = F.wave; asm volatile("" : "+v"(tid), "+s"(wid));
    const int b = u_ >> 8, h = (u_ >> 5) & 7, c = u_ & 31;
    const int lane = tid & 63, t = tid >> 3, cg = tid & 7, r32 = lane & 31, hi = lane >> 5;
    LAS char* lds = (LAS char*)F.lds;
    const size_t u = (size_t)((b * 8 + h) * 32 + c);
    bf16_t* gQe = (bf16_t*)(P.ws + WS_QE) + u * 4096; bf16_t* gYl = (bf16_t*)(P.ws + WS_YLOC) + u * 4096; bf16_t* gPc = (bf16_t*)(P.ws + WS_PC) + u * 4096; bf16_t* gSl = (bf16_t*)(P.ws + WS_SLOC) + u * 4096;
    bf16_t* gG = (bf16_t*)((unsigned char*)P.out + DO_G) + u * 4096; bf16_t* Yr = (bf16_t*)((unsigned char*)P.out + DO_YR);
    const int hd = h * 64 + 8 * cg;
    const bool is_ad = (cg == 2 || cg == 3); const float alpha = cg < 2 ? 2.f : 1.f, gamma = cg < 2 ? -1.f : 0.f;
    LAS bf16_t* ldst = (LAS bf16_t*)(lds + (cg < 2 ? L_TWD : (cg < 4 ? L_AD : L_SGD))) + t * (cg < 4 ? 72 : 136) + 32 * (cg < 2 ? cg : (cg < 4 ? cg - 2 : cg - 4));
    const size_t row = (size_t)b * SEQ + 64 * c + t;
    LAS float* tab = (LAS float*)(lds + L_TAB);
    if (h != htab) {
        htab = h;
        for (int i = tid; i < T_N; i += 512) { float v;
            if (i < T_MUR) v = P.in[6][1536 + i]; else if (i < T_PAR) { const int w = (i - T_MUR) >> 6, d = (i - T_MUR) & 63; v = P.in[6][w * 512 + h * 64 + d]; }
            else { const int w = (i - T_PAR) >> 6, d = (i - T_PAR) & 63; const float* src = w == 0 ? P.in[7] : (w == 1 ? P.in[9] : (w == 2 ? P.in[12] : (w == 3 ? P.in[13] : (w == 4 ? P.in[14] : P.in[16])))); v = src[h * 64 + d]; }
            tab[i] = v; }
        const int jb = (wid >> 1) & 1;
        const bf16_t* wa = (const bf16_t*)(P.ws + (wid < 4 ? WS_WUP : WS_AUP)) + (size_t)(h * 64 + jb * 32 + r32) * 64 + 8 * hi;
#pragma unroll
        for (int ks = 0; ks < 4; ++ks) wA[ks] = *(const bf16x8*)(wa + 16 * ks);
        LBAR();
    }
    bf16x8 wG[8];
    { const bf16_t* wg = (const bf16_t*)(P.ws + WS_GUP) + (size_t)(h * 64 + ((wid >> 1) & 1) * 32 + r32) * 128 + 8 * hi;
#pragma unroll
      for (int ks = 0; ks < 8; ++ks) wG[ks] = *(const bf16x8*)(wg + 16 * ks); }
    float rv[8], kv[8], vv[8];
    { float cur[8], prv[8], mu[8];
#pragma unroll
      for (int q = 0; q < 4; ++q) {
          unpack8(raw.lc[q], cur); unpack8(raw.lp[q], prv);
          *(f32x4*)mu = *(const LAS f32x4*)(tab + T_MUL + 32 * cg + 8 * q); *(f32x4*)(mu + 4) = *(const LAS f32x4*)(tab + T_MUL + 32 * cg + 8 * q + 4);
          float o[8];
#pragma unroll
          for (int i = 0; i < 8; ++i) { const float xs = cur[i] + (prv[i] - cur[i]) * mu[i]; const float sg = sigmoidf_(alpha * xs); o[i] = is_ad ? xs : alpha * sg + gamma; }
          u32x4 w; w.x = cvt_pk_bf16(o[0], o[1]); w.y = cvt_pk_bf16(o[2], o[3]); w.z = cvt_pk_bf16(o[4], o[5]); w.w = cvt_pk_bf16(o[6], o[7]);
          *(LAS u32x4*)(ldst + 8 * q) = w; }
#pragma unroll
      for (int which = 0; which < 3; ++which) {
          unpack8(raw.rc[which], cur); unpack8(raw.rp[which], prv);
          *(f32x4*)mu = *(const LAS f32x4*)(tab + T_MUR + which * 64 + 8 * cg); *(f32x4*)(mu + 4) = *(const LAS f32x4*)(tab + T_MUR + which * 64 + 8 * cg + 4);
#pragma unroll
          for (int i = 0; i < 8; ++i) { const float xs = cur[i] + (prv[i] - cur[i]) * mu[i]; if (which == 0) rv[i] = xs; else if (which == 1) kv[i] = xs; else vv[i] = xs; } } }
    LBAR();
    { const int ib = wid & 1, jb = (wid >> 1) & 1;
      auto wr4 = [&](const f32x16& acc, LAS float* Out) { LAS float* op = Out + (ib * 32 + r32) * FLD + jb * 32 + 4 * hi;
#pragma unroll
          for (int g = 0; g < 4; ++g) *(LAS f32x4*)(op + 8 * g) = (f32x4){acc[4 * g], acc[4 * g + 1], acc[4 * g + 2], acc[4 * g + 3]}; };
      { f32x16 acc = {}; const LAS bf16_t* qp = (const LAS bf16_t*)(lds + (wid < 4 ? L_TWD : L_AD)) + (ib * 32 + r32) * 72 + 8 * hi;
#pragma unroll
        for (int ks = 0; ks < 4; ++ks) acc = __builtin_amdgcn_mfma_f32_32x32x16_bf16(wA[ks], *(const LAS bf16x8*)(qp + 16 * ks), acc, 0, 0, 0);
        wr4(acc, (LAS float*)(lds + (wid < 4 ? L_WL : L_AL))); }
      if (wid < 4) { f32x16 acc = {}; const LAS bf16_t* qp = (const LAS bf16_t*)(lds + L_SGD) + (ib * 32 + r32) * 136 + 8 * hi;
#pragma unroll
        for (int ks = 0; ks < 8; ++ks) acc = __builtin_amdgcn_mfma_f32_32x32x16_bf16(wG[ks], *(const LAS bf16x8*)(qp + 16 * ks), acc, 0, 0, 0);
        wr4(acc, (LAS float*)(lds + L_GL)); } }
    LBAR();
    float lam[8], av[8], bv[8], kp[8];
    const int o68 = t * FLD + 8 * cg;
    { float wl[8], al[8], gv[8];
      *(f32x4*)wl = *(LAS f32x4*)(lds + L_WL + 4 * o68); *(f32x4*)(wl + 4) = *(LAS f32x4*)(lds + L_WL + 4 * o68 + 16);
      *(f32x4*)al = *(LAS f32x4*)(lds + L_AL + 4 * o68); *(f32x4*)(al + 4) = *(LAS f32x4*)(lds + L_AL + 4 * o68 + 16);
      *(f32x4*)gv = *(LAS f32x4*)(lds + L_GL + 4 * o68); *(f32x4*)(gv + 4) = *(LAS f32x4*)(lds + L_GL + 4 * o68 + 16);
      float w0[8], a0[8], kk_[8], ka[8], rk[8], lb[8];
      { const LAS float* tp = tab + T_PAR + 8 * cg;
        *(f32x4*)w0 = *(const LAS f32x4*)(tp); *(f32x4*)(w0 + 4) = *(const LAS f32x4*)(tp + 4);
        *(f32x4*)a0 = *(const LAS f32x4*)(tp + 64); *(f32x4*)(a0 + 4) = *(const LAS f32x4*)(tp + 68);
        *(f32x4*)kk_ = *(const LAS f32x4*)(tp + 128); *(f32x4*)(kk_ + 4) = *(const LAS f32x4*)(tp + 132);
        *(f32x4*)ka = *(const LAS f32x4*)(tp + 192); *(f32x4*)(ka + 4) = *(const LAS f32x4*)(tp + 196);
        *(f32x4*)rk = *(const LAS f32x4*)(tp + 256); *(f32x4*)(rk + 4) = *(const LAS f32x4*)(tp + 260);
        *(f32x4*)lb = *(const LAS f32x4*)(tp + 320); *(f32x4*)(lb + 4) = *(const LAS f32x4*)(tp + 324); }
      float asg[8], kkv[8], c2[8]; float ss = 0.f, bon = 0.f;
#pragma unroll
      for (int i = 0; i < 8; ++i) { lam[i] = 0.60653065971f * sigmoidf_(w0[i] + wl[i]); asg[i] = sigmoidf_(a0[i] + al[i]);
          kkv[i] = kv[i] * kk_[i]; ss += kkv[i] * kkv[i]; kp[i] = kv[i] * (1.f + (asg[i] - 1.f) * ka[i]); bon += rv[i] * kp[i] * rk[i]; }
      ss = red8(ss); bon = red8(bon);
      const float inv = 1.f / fmaxf(sqrtf(ss), 1e-12f);
#pragma unroll
      for (int i = 0; i < 8; ++i) { const float kn = kkv[i] * inv; av[i] = -kn; bv[i] = kn * asg[i]; c2[i] = (lb[i] + bon * vv[i]) * gv[i]; }
      *(LAS f32x4*)(lds + L_WL + 4 * o68) = *(f32x4*)lam; *(LAS f32x4*)(lds + L_WL + 4 * o68 + 16) = *(f32x4*)(lam + 4);
      u32x4 w; w.x = cvt_pk_bf16(gv[0], gv[1]); w.y = cvt_pk_bf16(gv[2], gv[3]); w.z = cvt_pk_bf16(gv[4], gv[5]); w.w = cvt_pk_bf16(gv[6], gv[7]);
      *(u32x4*)(gG + t * 64 + 8 * cg) = w;
      w.x = cvt_pk_bf16(c2[0], c2[1]); w.y = cvt_pk_bf16(c2[2], c2[3]); w.z = cvt_pk_bf16(c2[4], c2[5]); w.w = cvt_pk_bf16(c2[6], c2[7]);
      *(u32x4*)(Yr + row * 512 + hd) = w; }
    LBAR();
    { const int d = tid & 63, seg = tid >> 6; LAS float* pl = (LAS float*)(lds + L_WL) + (8 * seg) * FLD + d; float run = 0.f;
#pragma unroll
      for (int i = 0; i < 8; ++i) { run += pl[i * FLD]; pl[i * FLD] = run; }
      ((LAS float*)(lds + L_SEG))[seg * 64 + d] = run; }
    LBAR();
    { float cum[8], pre[8], tot[8];
      *(f32x4*)cum = *(LAS f32x4*)(lds + L_WL + 4 * o68); *(f32x4*)(cum + 4) = *(LAS f32x4*)(lds + L_WL + 4 * o68 + 16);
#pragma unroll
      for (int i = 0; i < 8; ++i) { pre[i] = 0.f; tot[i] = 0.f; }
      const int myseg = t >> 3;
#pragma unroll
      for (int s = 0; s < 8; ++s) { float sv[8]; *(f32x4*)sv = *(LAS f32x4*)(lds + L_SEG + (s * 64 + 8 * cg) * 4); *(f32x4*)(sv + 4) = *(LAS f32x4*)(lds + L_SEG + (s * 64 + 8 * cg) * 4 + 16);
#pragma unroll
          for (int i = 0; i < 8; ++i) { tot[i] += sv[i]; pre[i] += (s < myseg) ? sv[i] : 0.f; } }
      float at_[8], bt_[8], kt_[8], rt_[8], bh_[8], kh_[8];
#pragma unroll
      for (int i = 0; i < 8; ++i) { const float cm = cum[i] + pre[i];
          const float gi = __builtin_amdgcn_exp2f(cm * LOG2E), g_ = __builtin_amdgcn_exp2f(-cm * LOG2E), gm1 = __builtin_amdgcn_exp2f(-(cm - lam[i]) * LOG2E), glg = __builtin_amdgcn_exp2f(-(tot[i] - cm) * LOG2E);
          at_[i] = av[i] * gm1; bt_[i] = bv[i] * gi; kt_[i] = kp[i] * gi; rt_[i] = rv[i] * g_; bh_[i] = bv[i] * glg; kh_[i] = kp[i] * glg; }
      if (t == 0) { float gl[8];
#pragma unroll
          for (int i = 0; i < 8; ++i) gl[i] = __builtin_amdgcn_exp2f(-tot[i] * LOG2E);
          *(LAS f32x4*)(lds + L_GLD + 32 * cg) = *(f32x4*)gl; *(LAS f32x4*)(lds + L_GLD + 32 * cg + 16) = *(f32x4*)(gl + 4); }
      const int ob = (t * LDB + 8 * cg) * 2; u32x4 w;
      w.x = cvt_pk_bf16(at_[0], at_[1]); w.y = cvt_pk_bf16(at_[2], at_[3]); w.z = cvt_pk_bf16(at_[4], at_[5]); w.w = cvt_pk_bf16(at_[6], at_[7]); *(LAS u32x4*)(lds + L_AT + ob) = w;
      w.x = cvt_pk_bf16(bt_[0], bt_[1]); w.y = cvt_pk_bf16(bt_[2], bt_[3]); w.z = cvt_pk_bf16(bt_[4], bt_[5]); w.w = cvt_pk_bf16(bt_[6], bt_[7]); *(LAS u32x4*)(lds + L_BT + ob) = w;
      w.x = cvt_pk_bf16(kt_[0], kt_[1]); w.y = cvt_pk_bf16(kt_[2], kt_[3]); w.z = cvt_pk_bf16(kt_[4], kt_[5]); w.w = cvt_pk_bf16(kt_[6], kt_[7]); *(LAS u32x4*)(lds + L_KT + ob) = w;
      w.x = cvt_pk_bf16(rt_[0], rt_[1]); w.y = cvt_pk_bf16(rt_[2], rt_[3]); w.z = cvt_pk_bf16(rt_[4], rt_[5]); w.w = cvt_pk_bf16(rt_[6], rt_[7]); *(LAS u32x4*)(lds + L_RT + ob) = w;
#pragma unroll
      for (int i = 0; i < 8; ++i) { const int ot = ((8 * cg + i) * LDB + t) * 2;
          *(LAS bf16_t*)(lds + L_ATT + ot) = (bf16_t)(cvt_pk_bf16(at_[i], 0.f) & 0xffffu); *(LAS bf16_t*)(lds + L_BHT + ot) = (bf16_t)(cvt_pk_bf16(bh_[i], 0.f) & 0xffffu);
          *(LAS bf16_t*)(lds + L_KHT + ot) = (bf16_t)(cvt_pk_bf16(kh_[i], 0.f) & 0xffffu); *(LAS bf16_t*)(lds + L_VT + ot) = (bf16_t)(cvt_pk_bf16(vv[i], 0.f) & 0xffffu); } }
    LBAR();
    if (u_ + F.G < NB * 8 * 32) load_raw(raw, Prw, u_ + F.G, t, cg);
    const int mb = wid & 1, nb = (wid >> 1) & 1, grp = wid >> 2;
    const int ao = 32 * mb * LDB * 2, bo = 32 * nb * LDB * 2;
    const int ncol = 32 * nb + r32;
    f32x16 accT = {};
    {
        f32x16 d = {};
        if (grp == 0) { d = mm64(d, lds + L_AT + ao, lds + L_BT + bo, lane);
#pragma unroll
            for (int r = 0; r < 16; ++r) d[r] = (ncol < RC_M(r)) ? d[r] : 0.f;
            store_T(d, lds + L_NT0, mb, nb, lane); }
        else { d = mm64(d, lds + L_BT + ao, lds + L_AT + bo, lane);
#pragma unroll
            for (int r = 0; r < 16; ++r) { d[r] = (RC_M(r) < ncol) ? d[r] : 0.f; accT[r] = d[r] + ((RC_M(r) == ncol) ? 1.f : 0.f); }
            store_T(d, lds + L_NQ0, mb, nb, lane); store_T(accT, lds + L_TQ0, mb, nb, lane); }
        f32x16 e = {};
        if (grp == 0) { e = mm64(e, lds + L_AT + ao, lds + L_KT + bo, lane);
#pragma unroll
            for (int r = 0; r < 16; ++r) e[r] = (ncol < RC_M(r)) ? e[r] : 0.f;
            store_T(e, lds + L_NKT, mb, nb, lane); }
        else { e = mm64(e, lds + L_BT + ao, lds + L_RT + bo, lane);
#pragma unroll
            for (int r = 0; r < 16; ++r) e[r] = (RC_M(r) <= ncol) ? e[r] : 0.f;
            store_T(e, lds + L_NRB, mb, nb, lane); }
    }
    LBAR();
#pragma unroll
    for (int i = 1; i <= 5; ++i) { const int cur = (i - 1) & 1, nw = i & 1;
        const int nq_c = cur ? L_NQ1 : L_NQ0, nt_c = cur ? L_NT1 : L_NT0, nq_n = nw ? L_NQ1 : L_NQ0, nt_n = nw ? L_NT1 : L_NT0, tq_c = cur ? L_TQ1 : L_TQ0, tq_n = nw ? L_TQ1 : L_TQ0;
        f32x16 d = {};
        if (grp == 0) { d = mm64(d, lds + nt_c + ao, lds + nq_c + bo, lane); store_T(d, lds + nq_n, mb, nb, lane); }
        else { d = mm64(d, lds + nq_c + ao, lds + nt_c + bo, lane); store_T(d, lds + nt_n, mb, nb, lane); }
        LBAR();
        if (grp == 1) { accT = mm64(accT, lds + nt_n + ao, lds + tq_c + bo, lane); store_T(accT, lds + tq_n, mb, nb, lane); }
    }
    LBAR();
    { f32x16 d = {};
      if (grp == 0) { d = mm64(d, lds + L_TQ1 + ao, lds + L_ATT + bo, lane); store_T(d, lds + L_W1T, mb, nb, lane); }
      else { d = mm64(d, lds + L_TQ1 + ao, lds + L_NKT + bo, lane); store_T(d, lds + L_W2T, mb, nb, lane); } }
    LBAR();
    if (grp == 0) {
        f32x16 d = {}; d = mm64(d, lds + L_W1T + ao, lds + L_NRB + bo, lane);
#pragma unroll
        for (int g = 0; g < 4; ++g) { const u32x2 rw = *(const LAS u32x2*)(lds + L_RT + ((32 * nb + r32) * LDB + 32 * mb + 8 * g + 4 * hi) * 2);
            d[4 * g] += bf_lo(rw.x); d[4 * g + 1] += bf_hi(rw.x); d[4 * g + 2] += bf_lo(rw.y); d[4 * g + 3] += bf_hi(rw.y); }
        store_T_g(d, gQe, mb, nb, lane);
        f32x16 p = {}; p = mm64(p, lds + L_W1T + ao, lds + L_BHT + bo, lane);
        const float gl = ((const LAS float*)(lds + L_GLD))[ncol];
#pragma unroll
        for (int r = 0; r < 16; ++r) p[r] += (RC_M(r) == ncol) ? gl : 0.f;
        store_T_g(p, gPc, mb, nb, lane);
    } else {
        f32x16 d = {}; d = mm64(d, lds + L_KT + ao, lds + L_RT + bo, lane); d = mm64(d, lds + L_W2T + ao, lds + L_NRB + bo, lane);
#pragma unroll
        for (int r = 0; r < 16; ++r) d[r] = (RC_M(r) <= ncol) ? d[r] : 0.f;
        f32x16 k = {}; k = mm64(k, lds + L_W2T + ao, lds + L_BHT + bo, lane);
#pragma unroll
        for (int g = 0; g < 4; ++g) { const u32x2 kw = *(const LAS u32x2*)(lds + L_KHT + ((32 * nb + r32) * LDB + 32 * mb + 8 * g + 4 * hi) * 2);
            k[4 * g] += bf_lo(kw.x); k[4 * g + 1] += bf_hi(kw.x); k[4 * g + 2] += bf_lo(kw.y); k[4 * g + 3] += bf_hi(kw.y); }
        store_T(d, lds + L_WY, mb, nb, lane); store_T(k, lds + L_KC, mb, nb, lane);
    }
    LBAR();
    { f32x16 d = {};
      if (grp == 0) { d = mm64(d, lds + L_VT + ao, lds + L_WY + bo, lane); store_T_g(d, gYl, mb, nb, lane); }
      else { d = mm64(d, lds + L_KC + ao, lds + L_VT + bo, lane); store_T_g(d, gSl, mb, nb, lane); } }
    LBAR();
  }
}

__device__ __forceinline__ void state_chain(Frame& F, const Ptrs& P, int bh) {
    const int tid = F.tid, lane = F.lane, wid = F.wave, r32 = lane & 31, hi = lane >> 5;
    LAS char* lds = (LAS char*)F.lds;
    const bf16_t* gPc = (const bf16_t*)(P.ws + WS_PC) + (size_t)bh * 32 * 4096; const bf16_t* gSl = (const bf16_t*)(P.ws + WS_SLOC) + (size_t)bh * 32 * 4096;
    bf16_t* gS = (bf16_t*)((unsigned char*)P.out + DO_SC) + (size_t)bh * 32 * 4096;
    constexpr int L_S0 = 0, L_S1 = MB, L_P = 2 * MB;
    for (int i = tid; i < MB / 4; i += 512) ((LAS unsigned*)(lds + L_S0))[i] = 0u;
    const int prow = tid >> 3, pch = tid & 7;
    u32x4 pw = *(const u32x4*)(gPc + prow * 64 + pch * 8);
    const int mb = wid & 1, nb = (wid >> 1) & 1;
    __syncthreads();
#pragma unroll 1
    for (int c = 0; c < 32; ++c) {
        const int sc = (c & 1) ? L_S1 : L_S0, sn = (c & 1) ? L_S0 : L_S1;
        *(LAS u32x4*)(lds + L_P + (prow * LDB + pch * 8) * 2) = pw;
        *(u32x4*)(gS + (size_t)c * 4096 + prow * 64 + pch * 8) = *(const LAS u32x4*)(lds + sc + (prow * LDB + pch * 8) * 2);
        if (c + 1 < 32) pw = *(const u32x4*)(gPc + (size_t)(c + 1) * 4096 + prow * 64 + pch * 8);
        f32x16 d = {};
        if (wid < 4) {
            const bf16_t* sp = gSl + (size_t)c * 4096 + (32 * nb + r32) * 64 + 32 * mb + 4 * hi;
#pragma unroll
            for (int g = 0; g < 4; ++g) { const u32x2 w = *(const u32x2*)(sp + 8 * g); d[4 * g] = bf_lo(w.x); d[4 * g + 1] = bf_hi(w.x); d[4 * g + 2] = bf_lo(w.y); d[4 * g + 3] = bf_hi(w.y); } }
        __syncthreads();
        if (wid < 4) { d = mm64(d, lds + L_P + 32 * mb * LDB * 2, lds + sc + 32 * nb * LDB * 2, lane); store_T(d, lds + sn, mb, nb, lane); }
        __syncthreads();
    }
}

__device__ __forceinline__ void out_unit(Frame& F, const Ptrs& P, int u, int nb, bool do_store = true) {
    const int lane = F.lane, r32 = lane & 31, hi = lane >> 5;
    const bf16_t* gQe = (const bf16_t*)(P.ws + WS_QE) + (size_t)u * 4096; const bf16_t* gYl = (const bf16_t*)(P.ws + WS_YLOC) + (size_t)u * 4096;
    const bf16_t* gS = (const bf16_t*)((unsigned char*)P.out + DO_SC) + (size_t)u * 4096; const bf16_t* gG = (const bf16_t*)((unsigned char*)P.out + DO_G) + (size_t)u * 4096;
    bf16_t* Yr = (bf16_t*)((unsigned char*)P.out + DO_YR);
    const int bh = u >> 5, c = u & 31, h = bh & 7, b = bh >> 3;
    f32x16 y0 = {}, y1 = {};
#pragma unroll
    for (int ks = 0; ks < 4; ++ks) { const bf16x8 q = *(const bf16x8*)(gQe + (32 * nb + r32) * 64 + 16 * ks + 8 * hi);
        const bf16x8 s0 = *(const bf16x8*)(gS + r32 * 64 + 16 * ks + 8 * hi), s1 = *(const bf16x8*)(gS + (32 + r32) * 64 + 16 * ks + 8 * hi);
        y0 = __builtin_amdgcn_mfma_f32_32x32x16_bf16(s0, q, y0, 0, 0, 0); y1 = __builtin_amdgcn_mfma_f32_32x32x16_bf16(s1, q, y1, 0, 0, 0); }
    const int tl = 32 * nb + r32;
    const bf16_t* yl = gYl + tl * 64 + 4 * hi;
    float s = 0.f;
#pragma unroll
    for (int g = 0; g < 4; ++g) { const u32x2 a = *(const u32x2*)(yl + 8 * g), bq = *(const u32x2*)(yl + 32 + 8 * g);
        y0[4 * g] += bf_lo(a.x); y0[4 * g + 1] += bf_hi(a.x); y0[4 * g + 2] += bf_lo(a.y); y0[4 * g + 3] += bf_hi(a.y);
        y1[4 * g] += bf_lo(bq.x); y1[4 * g + 1] += bf_hi(bq.x); y1[4 * g + 2] += bf_lo(bq.y); y1[4 * g + 3] += bf_hi(bq.y); }
#pragma unroll
    for (int r = 0; r < 16; ++r) s += y0[r] + y1[r];
    s += __shfl_xor(s, 32); const float mean = s * (1.f / 64.f); float q2 = 0.f;
#pragma unroll
    for (int r = 0; r < 16; ++r) { y0[r] -= mean; y1[r] -= mean; q2 += y0[r] * y0[r] + y1[r] * y1[r]; }
    q2 += __shfl_xor(q2, 32); const float rstd = 1.f / sqrtf(q2 * (1.f / 64.f) + 64e-5f);
    const size_t row = (size_t)b * SEQ + 64 * c + tl;
    bf16_t* yo = Yr + row * 512 + h * 64 + 4 * hi; const bf16_t* gg = gG + tl * 64 + 4 * hi; const float* lg = P.in[15] + h * 64 + 4 * hi;
#pragma unroll
    for (int g = 0; g < 4; ++g) {
#pragma unroll
        for (int eb = 0; eb < 2; ++eb) { const int eo = 32 * eb + 8 * g; const u32x2 gw = *(const u32x2*)(gg + eo), cw = *(const u32x2*)(yo + eo); const f32x4 l4 = *(const f32x4*)(lg + eo);
            const f32x16& y = eb ? y1 : y0;
#ifdef DIAG_NOY
            const float rstd_ = 0.f;
#else
            const float rstd_ = rstd;
#endif
            const float o0 = y[4 * g] * rstd_ * l4.x * bf_lo(gw.x) + bf_lo(cw.x), o1 = y[4 * g + 1] * rstd_ * l4.y * bf_hi(gw.x) + bf_hi(cw.x), o2 = y[4 * g + 2] * rstd_ * l4.z * bf_lo(gw.y) + bf_lo(cw.y), o3 = y[4 * g + 3] * rstd_ * l4.w * bf_hi(gw.y) + bf_hi(cw.y);
            u32x2 w; w.x = cvt_pk_bf16(o0, o1); w.y = cvt_pk_bf16(o2, o3);
#ifdef DIAG_ZERO
            w.x = 0u; w.y = 0u;
#endif
#ifdef DIAG_C2ONLY
            w = cw;
#endif
            if (do_store) *(u32x2*)(yo + eo) = w; } }
}
#undef RC_M
}
__device__ __forceinline__ void phase_route(Frame& F, const Ptrs& P) {
    const int lane = F.lane, gw = F.vcu * NWAVES + F.wave, NGW = F.G * NWAVES;
    const float* x1 = P.out; const float* mod = (const float*)(P.ws + WS_MOD);
    const float* gam2 = (const float*)(P.ws + WS_GAM2); const float* cb = (const float*)(P.ws + WS_CB);
    const bf16_t* wrh = (const bf16_t*)(P.ws + WS_WRH); const bf16_t* wrl = (const bf16_t*)(P.ws + WS_WRL);
    bf16_t* H2 = (bf16_t*)(P.ws + WS_H2);
    int* tok_list = (int*)(P.ws + WS_TOKLIST); int* tok_pos = (int*)(P.ws + WS_TOKPOS); float* tok_w = (float*)(P.ws + WS_TOKW);
    unsigned* cnt = (unsigned*)(F.ctl + CW_CNT);
    LAS float* scr = (LAS float*)(F.lds) + F.wave * (16 * 52);
    const int fr = lane & 15, kq = lane >> 4;
    LAS unsigned* lcnt = (LAS unsigned*)(F.lds + 32768); LAS unsigned* lbase = lcnt + 64;
    for (int rnd = F.vcu; rnd < NTOK / 128; rnd += F.G) {
        if (F.tid < NLIST) lcnt[F.tid] = 0u;
        __syncthreads();
        const int R0 = rnd * 128 + F.wave * 16, b = R0 / SEQ;
        const float* xr = x1 + (size_t)(R0 + fr) * DM + 8 * kq; const float* gp = gam2 + (size_t)b * DM + 8 * kq;
        const bf16_t* bh = wrh + (size_t)fr * DM + 8 * kq; const bf16_t* bl = wrl + (size_t)fr * DM + 8 * kq;
        f32x4 acc[3] = {{0.f, 0.f, 0.f, 0.f}, {0.f, 0.f, 0.f, 0.f}, {0.f, 0.f, 0.f, 0.f}}; float ssq = 0.f;
#pragma unroll 2
        for (int k0 = 0; k0 < DM; k0 += 32) {
            const f32x4 xa = *(const f32x4*)(xr + k0), xb = *(const f32x4*)(xr + k0 + 4), ga = *(const f32x4*)(gp + k0), gb = *(const f32x4*)(gp + k0 + 4);
            ssq += (xa.x * xa.x + xa.y * xa.y) + (xa.z * xa.z + xa.w * xa.w) + (xb.x * xb.x + xb.y * xb.y) + (xb.z * xb.z + xb.w * xb.w);
            const f32x4 ya = xa * ga, yb = xb * gb;
            u32x4 hw; hw.x = cvt_pk_bf16(ya.x, ya.y); hw.y = cvt_pk_bf16(ya.z, ya.w); hw.z = cvt_pk_bf16(yb.x, yb.y); hw.w = cvt_pk_bf16(yb.z, yb.w);
            u32x4 lw; lw.x = cvt_pk_bf16(ya.x - bf_lo(hw.x), ya.y - bf_hi(hw.x)); lw.y = cvt_pk_bf16(ya.z - bf_lo(hw.y), ya.w - bf_hi(hw.y));
            lw.z = cvt_pk_bf16(yb.x - bf_lo(hw.z), yb.y - bf_hi(hw.z)); lw.w = cvt_pk_bf16(yb.z - bf_lo(hw.w), yb.w - bf_hi(hw.w));
            const bf16x8 ah = __builtin_bit_cast(bf16x8, hw), al = __builtin_bit_cast(bf16x8, lw);
#pragma unroll
            for (int nb = 0; nb < 3; ++nb) { const bf16x8 wh = *(const bf16x8*)(bh + (size_t)nb * 16 * DM + k0), wl = *(const bf16x8*)(bl + (size_t)nb * 16 * DM + k0);
                acc[nb] = __builtin_amdgcn_mfma_f32_16x16x32_bf16(ah, wh, acc[nb], 0, 0, 0); acc[nb] = __builtin_amdgcn_mfma_f32_16x16x32_bf16(al, wh, acc[nb], 0, 0, 0); acc[nb] = __builtin_amdgcn_mfma_f32_16x16x32_bf16(ah, wl, acc[nb], 0, 0, 0); }
        }
        ssq += __shfl_xor(ssq, 16); ssq += __shfl_xor(ssq, 32);
        const float rinv = 1.f / sqrtf(ssq * (1.f / DM) + 1e-6f);
#pragma unroll
        for (int nb = 0; nb < 3; ++nb)
#pragma unroll
            for (int j = 0; j < 4; ++j) scr[(4 * kq + j) * 52 + 16 * nb + fr] = acc[nb][j];
        LDS_WAIT(); asm volatile("" ::: "memory");
        int l1 = 0, l2 = 0, q1 = 0, q2 = 0; float w1 = 0.f, w2 = 0.f;
        if (lane < 16) {
            const float* cbb = cb + b * 64; const LAS float* lr = scr + lane * 52;
            float lc[4]; int grp = 0; float best = -3.4e38f;
#pragma unroll
            for (int o = 0; o < 4; ++o) { lc[o] = rinv * lr[o] + cbb[o]; if (lc[o] > best) { best = lc[o]; grp = o; } }
            float den = 0.f;
#pragma unroll
            for (int o = 0; o < 4; ++o) den += __expf(lc[o] - best);
            const float pgrp = 1.f / den;
            float f1 = -3.4e38f, f2 = -3.4e38f; int i1 = 0, i2 = 0;
            for (int o = 0; o < 8; ++o) { const float v = rinv * lr[4 + grp * 8 + o] + cbb[4 + grp * 8 + o];
                if (v > f1) { f2 = f1; i2 = i1; f1 = v; i1 = o; } else if (v > f2) { f2 = v; i2 = o; } }
            const float e2 = __expf(f2 - f1); w1 = pgrp / (1.f + e2); w2 = pgrp * e2 / (1.f + e2);
            l1 = (grp * 8 + i1) * 2; l2 = (grp * 8 + i2) * 2 + 1;
            q1 = (int)__hip_atomic_fetch_add(lcnt + l1, 1u, __ATOMIC_RELAXED, __HIP_MEMORY_SCOPE_WORKGROUP); q2 = (int)__hip_atomic_fetch_add(lcnt + l2, 1u, __ATOMIC_RELAXED, __HIP_MEMORY_SCOPE_WORKGROUP);
        }
        __syncthreads();
        if (F.tid < NLIST) { const unsigned c = ((LAS unsigned*)lcnt)[F.tid]; lbase[F.tid] = c ? atomicAdd(cnt + 64 * F.tid, c) : 0u; }
        __syncthreads();
        if (lane < 16) { const int tok = R0 + lane;
            tok_list[2 * tok] = l1; tok_list[2 * tok + 1] = l2; tok_pos[2 * tok] = (int)lbase[l1] + q1; tok_pos[2 * tok + 1] = (int)lbase[l2] + q2; tok_w[2 * tok] = w1; tok_w[2 * tok + 1] = w2; }
        const float* sh = mod + (size_t)b * MODW + 3 * DM;
#pragma unroll 2
        for (int r = 0; r < 16; ++r) { const float ri = __shfl(rinv, r);
            const GAS f32x4* xrow = (const GAS f32x4*)(x1 + (size_t)(R0 + r) * DM) + lane; GAS u32x2* o8 = (GAS u32x2*)(H2 + (size_t)(R0 + r) * DM) + lane;
#pragma unroll
            for (int j = 0; j < 4; ++j) { const int k = 4 * lane + 256 * j; const f32x4 xv = xrow[64 * j], g = *(const f32x4*)(gam2 + (size_t)b * DM + k), s = *(const f32x4*)(sh + k);
                const f32x4 hv = xv * ri * g + s; u32x2 w; w.x = cvt_pk_bf16(hv.x, hv.y); w.y = cvt_pk_bf16(hv.z, hv.w); o8[64 * j] = w; } }
        LDS_WAIT(); asm volatile("" ::: "memory");
    }
}
__device__ __forceinline__ void moe_offsets(Frame& F) {
    LAS int* toff = (LAS int*)(F.lds + TOFF_OFF); LAS unsigned char* tile_e = (LAS unsigned char*)(F.lds + TILE_E_OFF);
    if (F.tid == 0) { int acc = 0;
#pragma unroll 1
        for (int l = 0; l < NLIST; ++l) { toff[l] = acc; const unsigned c = __hip_atomic_load(F.ctl + CW_CNT + 64 * l, RLX_AGENT); acc += (int)((c + 255u) >> 8); } toff[NLIST] = acc; }
    __syncthreads();
    if (F.tid < NLIST) { for (int t = toff[F.tid]; t < toff[F.tid + 1]; ++t) tile_e[t] = (unsigned char)(F.tid >> 1); }
    __syncthreads();
}
__device__ __forceinline__ void phase_sort(Frame& F, const Ptrs& P) {
    const int lane = F.lane, gw = F.vcu * NWAVES + F.wave, NGW = F.G * NWAVES;
    const LAS int* toff = (const LAS int*)(F.lds + TOFF_OFF);
    const bf16_t* H2 = (const bf16_t*)(P.ws + WS_H2); bf16_t* H2S = (bf16_t*)(P.ws + WS_H2S);
    const int* tok_list = (const int*)(P.ws + WS_TOKLIST); const int* tok_pos = (const int*)(P.ws + WS_TOKPOS); const float* tok_w = (const float*)(P.ws + WS_TOKW);
    int* slot_tok = (int*)(P.ws + WS_SLOTTOK); float* slot_w = (float*)(P.ws + WS_SLOTW);
    for (int tok = gw; tok < NTOK; tok += NGW) {
        const GAS u32x4* src = (const GAS u32x4*)(H2 + (size_t)tok * DM) + lane; const u32x4 v0 = src[0], v1 = src[64];
#pragma unroll
        for (int k = 0; k < 2; ++k) { const int l = tok_list[2 * tok + k], slot = toff[l] * 256 + tok_pos[2 * tok + k];
            GAS u32x4* dst = (GAS u32x4*)(H2S + (size_t)slot * DM) + lane; dst[0] = v0; dst[64] = v1;
            if (lane == 0) { slot_tok[slot] = tok; slot_w[slot] = tok_w[2 * tok + k]; } }
    }
    for (int l = gw; l < NLIST; l += NGW) { const int c = (int)__hip_atomic_load(F.ctl + CW_CNT + 64 * l, RLX_AGENT), base = toff[l] * 256, pad = (toff[l + 1] - toff[l]) * 256;
        for (int s = c + lane; s < pad; s += 64) slot_tok[base + s] = -1; }
}

#ifndef MK_ONE_LAUNCH
#define MK_ONE_LAUNCH 1
#endif
constexpr int N_PHASES = 13;

__global__ void __launch_bounds__(NWAVES * 64, 2) fwd_kernel(Args args) {
    extern __shared__ __attribute__((aligned(16))) unsigned char lds_raw[];
    Frame F; F.lds = (LAS unsigned char*)lds_raw; F.MISC = (volatile LAS unsigned*)(F.lds + MISC_OFF);
    F.tid = threadIdx.x; F.lane = F.tid & 63; F.wave = __builtin_amdgcn_readfirstlane(F.tid >> 6);
    F.G = gridDim.x; { const int bx = blockIdx.x; F.vcu = (F.G % 8 == 0) ? (bx % 8) * (F.G / 8) + bx / 8 : bx; }
#ifndef DUP_PHASE
#define DUP_PHASE -1
#endif
#define RELOAD_ARGS() Ptrs P; { int z_ = 0; asm volatile("" : "+s"(z_)); _Pragma("unroll") for (int i_ = 0; i_ < 31; ++i_) P.in[i_] = args.in[i_] + z_; P.out = args.out + z_; P.ws = args.ws + z_; }
    F.ctl = (gu32*)(args.ws + WS_CTL);
    for (int u = F.tid; u < (LDS_BYTES - LDSCTL_OFF) / 4; u += NWAVES * 64) ((LAS unsigned*)(F.lds + LDSCTL_OFF))[u] = 0u;
    __syncthreads();
    XcdBarrier bar; bar.bar = (unsigned*)(F.ctl + CW_BAR); bar.x = 0; bar.st = nullptr;
#if MK_ONE_LAUNCH
    bar = xcd_barrier_post((unsigned*)(F.ctl + CW_BAR), F.MISC + 8);
#define GRID_BAR() xcd_barrier(bar)
#else
#define GRID_BAR() do { } while (0)
#endif
    const int lo = args.ph_lo, hi = args.ph_hi;
#ifndef PH_MASK
#define PH_MASK 0x1fff
#endif
#define IN(k) ((((PH_MASK) >> (k)) & 1) && lo <= (k) && (k) < hi)
#ifndef TIME_PHASE
#define TIME_PHASE -1
#endif
#define STAMP(i) do { if (TIME_PHASE >= 0 && blockIdx.x == 0 && F.tid == 0) ((unsigned long long*)(args.ws + WS_CTL + 768 * KiB))[i] = __builtin_amdgcn_s_memrealtime(); } while (0)
#define SEAM(k) do { if (IN(k) && IN((k) + 1)) GRID_BAR(); STAMP((k) + 1); } while (0)
    STAMP(0);
#define MODP ((float*)(P.ws + WS_MOD))
#define PGATE ((bf16_t*)(P.ws + WS_PGATE))

    if (IN(0)) for (int rep_ = 0; rep_ < ((0) == DUP_PHASE ? 2 : 1); ++rep_) { if (rep_) GRID_BAR(); RELOAD_ARGS(); phase_mod(F, P.in[1], P.in[2], P.in[3], MODP); } SEAM(0);
    if (IN(1)) for (int rep_ = 0; rep_ < ((1) == DUP_PHASE ? 2 : 1); ++rep_) { if (rep_) GRID_BAR(); RELOAD_ARGS(); phase_prep(F, P); } SEAM(1);
    if (IN(2)) for (int rep_ = 0; rep_ < ((2) == DUP_PHASE ? 2 : 1); ++rep_) { if (rep_) GRID_BAR(); RELOAD_ARGS();
        pg8::Gemm g{DM, DM, DM}; pg8::DenseOrder S; S.init((const bf16_t*)((unsigned char*)P.out + DO_H), (const bf16_t*)(P.ws + WS_WIN), DM, DM, NTOK, INCOLS, F.G, (int)blockIdx.x);
        pg8::EpiP E{(bf16_t*)(P.ws + WS_PRW), (bf16_t*)(P.ws + WS_PATT), PGATE};
        pg8::gemm_phase<pg8::EpiP, pg8::DenseOrder, true>(F.lds, g, S, E);
    } SEAM(2);
    if (IN(3)) for (int rep_ = 0; rep_ < ((3) == DUP_PHASE ? 2 : 1); ++rep_) { if (rep_) GRID_BAR(); RELOAD_ARGS();
#pragma unroll 1
        for (int r2 = 0; r2 < (DUP_PHASE == 31 ? 2 : 1); ++r2)
#pragma unroll 1
        for (int u = (int)blockIdx.x; u < NB * 8 * 8; u += F.G) att::attn_unit(F, P, u >> 6, (u >> 3) & 7, u & 7);
        __syncthreads();
#pragma unroll 1
        for (int r2 = 0; r2 < (DUP_PHASE == 30 ? 2 : 1); ++r2) rc::chunk_phase(F, P);
    } SEAM(3);
    constexpr int EC_ITEMS = NE * (2 * 256 + 256), EC_SPLIT = EC_ITEMS / 4;
    if (IN(4)) for (int rep_ = 0; rep_ < ((4) == DUP_PHASE ? 2 : 1); ++rep_) { if (rep_) GRID_BAR(); RELOAD_ARGS();
        const int nR = F.G >= 256 ? 128 : F.G / 2, bx = (int)blockIdx.x;
        if (bx < nR) { for (int u = bx; u < NB * 8; u += nR) rc::state_chain(F, P, u); }
        else { const int na = F.G - nR, a = bx - nR; expert_convert(F, P, a * NWAVES + F.wave, na * NWAVES, 0, EC_SPLIT); }
    } SEAM(4);
    if (IN(5)) for (int rep_ = 0; rep_ < ((5) == DUP_PHASE ? 2 : 1); ++rep_) { if (rep_) GRID_BAR(); RELOAD_ARGS();
        const int gw = (int)blockIdx.x * NWAVES + F.wave, NGW = F.G * NWAVES;
        for (int w = gw; w < NB * 8 * 32 * 2; w += NGW) rc::out_unit(F, P, w >> 1, w & 1, !(DUP_PHASE == 5 && rep_ == 0));
        expert_convert(F, P, gw, NGW, EC_SPLIT, EC_ITEMS);
    } SEAM(5);
    if (IN(6)) for (int rep_ = 0; rep_ < ((6) == DUP_PHASE ? 2 : 1); ++rep_) { if (rep_) GRID_BAR(); RELOAD_ARGS();
        bf16_t* T = (bf16_t*)(P.ws + WS_T);
        { pg8::Gemm g{512, 512, 512}; pg8::DenseOrder S; S.init((const bf16_t*)((unsigned char*)P.out + DO_YR), (const bf16_t*)(P.ws + WS_WBR), 512, 512, NTOK, DM, F.G, (int)blockIdx.x);
          pg8::EpiBranch<false> E{T, PGATE}; pg8::gemm_phase<pg8::EpiBranch<false>, pg8::DenseOrder, true>(F.lds, g, S, E); }
        { pg8::Gemm g{512, 512, 512}; pg8::DenseOrder S; S.init((const bf16_t*)((unsigned char*)P.out + DO_YA), (const bf16_t*)(P.ws + WS_WBA), 512, 512, NTOK, DM, F.G, (int)blockIdx.x);
          pg8::EpiBranch<true> E{T, PGATE}; pg8::gemm_phase<pg8::EpiBranch<true>, pg8::DenseOrder, true>(F.lds, g, S, E); }
    } SEAM(6);
    if (IN(7)) for (int rep_ = 0; rep_ < ((7) == DUP_PHASE ? 2 : 1); ++rep_) { if (rep_) GRID_BAR(); RELOAD_ARGS();
        pg8::Gemm g{DM, DM, DM}; pg8::DenseOrder S; S.init((const bf16_t*)(P.ws + WS_T), (const bf16_t*)(P.ws + WS_WOUT), DM, DM, NTOK, DM, F.G, (int)blockIdx.x);
        pg8::EpiOut E{P.in[0], P.out, MODP}; pg8::gemm_phase<pg8::EpiOut, pg8::DenseOrder, true>(F.lds, g, S, E);
    } SEAM(7);
    if (IN(8)) for (int rep_ = 0; rep_ < ((8) == DUP_PHASE ? 2 : 1); ++rep_) { if (rep_) GRID_BAR(); RELOAD_ARGS(); phase_route(F, P); } SEAM(8);
    if (IN(9)) for (int rep_ = 0; rep_ < ((9) == DUP_PHASE ? 2 : 1); ++rep_) { if (rep_) GRID_BAR(); RELOAD_ARGS(); moe_offsets(F); phase_sort(F, P); } SEAM(9);
    if (IN(10)) for (int rep_ = 0; rep_ < ((10) == DUP_PHASE ? 2 : 1); ++rep_) { if (rep_) GRID_BAR(); RELOAD_ARGS();
        moe_offsets(F); const LAS int* toff = (const LAS int*)(F.lds + TOFF_OFF);
        pg8::Gemm g{DM, DM, DM}; pg8::MoeOrder S{(const bf16_t*)(P.ws + WS_H2S), (const bf16_t*)(P.ws + WS_WGU), DM, DM, (size_t)DM * DM, (const LAS unsigned char*)(F.lds + TILE_E_OFF), 0, toff[NLIST], F.G, (int)blockIdx.x};
        pg8::EpiHid E{(bf16_t*)(P.ws + WS_HID)}; pg8::gemm_phase<pg8::EpiHid, pg8::MoeOrder, true>(F.lds, g, S, E);
    } SEAM(10);
    if (IN(11)) for (int rep_ = 0; rep_ < ((11) == DUP_PHASE ? 2 : 1); ++rep_) { if (rep_) GRID_BAR(); RELOAD_ARGS();
        moe_offsets(F); const LAS int* toff = (const LAS int*)(F.lds + TOFF_OFF);
        pg8::Gemm g{DE, DE, DE}; pg8::MoeOrder S{(const bf16_t*)(P.ws + WS_HID), (const bf16_t*)(P.ws + WS_WD), DE, DE, (size_t)DM * DE, (const LAS unsigned char*)(F.lds + TILE_E_OFF), 0, toff[NLIST], F.G, (int)blockIdx.x};
        pg8::EpiY E{(bf16_t*)(P.ws + WS_YB), (const float*)(P.ws + WS_SLOTW)}; pg8::gemm_phase<pg8::EpiY, pg8::MoeOrder, true>(F.lds, g, S, E);
    } SEAM(11);
    if (IN(12)) for (int rep_ = 0; rep_ < ((12) == DUP_PHASE ? 2 : 1); ++rep_) { if (rep_) GRID_BAR(); RELOAD_ARGS();
        moe_offsets(F); const LAS int* toff = (const LAS int*)(F.lds + TOFF_OFF);
        const bf16_t* Yb = (const bf16_t*)(P.ws + WS_YB); const int* tok_list = (const int*)(P.ws + WS_TOKLIST); const int* tok_pos = (const int*)(P.ws + WS_TOKPOS);
        const float* mod = MODP; const int gw = F.vcu * NWAVES + F.wave, NGW = F.G * NWAVES;
#pragma unroll 2
        for (int tok = gw; tok < NTOK; tok += NGW) {
            const int s0 = toff[tok_list[2 * tok]] * 256 + tok_pos[2 * tok], s1 = toff[tok_list[2 * tok + 1]] * 256 + tok_pos[2 * tok + 1];
            const float* g2 = mod + (size_t)(tok / SEQ) * MODW + 5 * DM;
            GAS f32x4* xo = (GAS f32x4*)(P.out + (size_t)tok * DM) + F.lane;
            const GAS u32x2* y0 = (const GAS u32x2*)(Yb + (size_t)s0 * DM) + F.lane; const GAS u32x2* y1 = (const GAS u32x2*)(Yb + (size_t)s1 * DM) + F.lane;
#pragma unroll
            for (int j = 0; j < 4; ++j) { const f32x4 xv = xo[64 * j]; const u32x2 a = y0[64 * j], bq = y1[64 * j]; const f32x4 gv = *(const f32x4*)(g2 + 4 * F.lane + 256 * j);
                f32x4 o; o.x = xv.x + gv.x * (bf_lo(a.x) + bf_lo(bq.x)); o.y = xv.y + gv.y * (bf_hi(a.x) + bf_hi(bq.x)); o.z = xv.z + gv.z * (bf_lo(a.y) + bf_lo(bq.y)); o.w = xv.w + gv.w * (bf_hi(a.y) + bf_hi(bq.y));
                xo[64 * j] = o; }
        }
    }
#if TIME_PHASE >= 0
    {
#ifndef TIME_HI
#define TIME_HI (TIME_PHASE + 1)
#endif
        STAMP(13); GRID_BAR();
        const unsigned long long* ts = (const unsigned long long*)(args.ws + WS_CTL + 768 * KiB);
        const float dlt = (float)(ts[TIME_HI] - ts[TIME_PHASE]) * (0.01f * 3.0e-4f);
        for (int i = blockIdx.x * 512 + F.tid; i < (1 << 20); i += gridDim.x * 512) args.out[i] += dlt;
    }
#endif
#undef IN
#undef SEAM
}

extern "C" void kernel_launch(void* const* d_in, const int* in_sizes, int n_in, void* d_out, int out_size, void* d_ws, size_t ws_size, hipStream_t stream) {
    static int grid = 0;
    if (grid == 0) {
        if (n_in != 31 || out_size != NTOK * DM || ws_size < WS_END) { fprintf(stderr, "kernel_launch: unexpected shapes (n_in %d out %d ws %zu)\n", n_in, out_size, ws_size); grid = -1; return; }
        int dev = 0, cus = 0;
        if (hipGetDevice(&dev) != hipSuccess || hipDeviceGetAttribute(&cus, hipDeviceAttributeMultiprocessorCount, dev) != hipSuccess) { grid = -1; return; }
        if (hipFuncSetAttribute((const void*)fwd_kernel, hipFuncAttributeMaxDynamicSharedMemorySize, LDS_BYTES) != hipSuccess) { fprintf(stderr, "kernel_launch: hipFuncSetAttribute failed\n"); grid = -1; return; }
        int per_cu = 0; (void)hipOccupancyMaxActiveBlocksPerMultiprocessor(&per_cu, (const void*)fwd_kernel, NWAVES * 64, LDS_BYTES); (void)hipGetLastError();
        grid = cus;
    }
    if (grid < 0) return;
    (void)hipMemsetAsync((char*)d_ws + WS_CTL, 0, CTL_ZERO_BYTES, stream);
    Args a{};
    for (int i = 0; i < 31; ++i) a.in[i] = (const float*)d_in[i];
    a.out = (float*)d_out; a.ws = (unsigned char*)d_ws;
#if MK_ONE_LAUNCH
    a.ph_lo = 0; a.ph_hi = N_PHASES;
    hipLaunchKernelGGL(fwd_kernel, dim3(grid), dim3(NWAVES * 64), LDS_BYTES, stream, a);
#else
    for (int p = 0; p < N_PHASES; ++p) { a.ph_lo = p; a.ph_hi = p + 1; hipLaunchKernelGGL(fwd_kernel, dim3(grid), dim3(NWAVES * 64), LDS_BYTES, stream, a); }
#endif
}
```

```cpp
#include <hip/hip_runtime.h>
#include <cstdio>
#include <cstdint>

#define LAS __attribute__((address_space(3)))
#define GAS __attribute__((address_space(1)))
typedef unsigned short bf16_t;
typedef short bf16x8 __attribute__((ext_vector_type(8)));
typedef short s16x4 __attribute__((ext_vector_type(4)));
typedef float f32x4 __attribute__((ext_vector_type(4)));
typedef float f32x2 __attribute__((ext_vector_type(2)));
typedef float f32x16 __attribute__((ext_vector_type(16)));
typedef unsigned u32x4 __attribute__((ext_vector_type(4)));
typedef unsigned u32x2 __attribute__((ext_vector_type(2)));

constexpr int NB = 16, SEQ = 2048, DM = 1024, NTOK = NB * SEQ;
constexpr int RCOLS = 1792, ACOLS = 1536, GCOLS = 2048, INCOLS = 5376;
constexpr int NE = 32, DE = 512, NLIST = 64;
constexpr int MODW = 6 * DM;
constexpr float LOG2E = 1.4426950408889634f;

typedef __bf16 bf16x2_t __attribute__((ext_vector_type(2)));
__device__ __forceinline__ unsigned cvt_pk_bf16(float lo, float hi) { const f32x2 v = {lo, hi}; const bf16x2_t b = __builtin_convertvector(v, bf16x2_t); return __builtin_bit_cast(unsigned, b); }
__device__ __forceinline__ float bf_lo(unsigned w) { return __uint_as_float(w << 16); }
__device__ __forceinline__ float bf_hi(unsigned w) { return __uint_as_float(w & 0xffff0000u); }
__device__ __forceinline__ float sigmoidf_(float x) { return __builtin_amdgcn_rcpf(1.0f + __builtin_amdgcn_exp2f(-x * LOG2E)); }

namespace pg8 {
constexpr int BM = 256, BK = 64, HALF = 128, HTB = HALF * BK * 2, STAGE_BYTES = 8 * HTB, NXCD = 8, WGM = 8;
__host__ __device__ __forceinline__ int lds_byte(int r, int c) { const int st = (r >> 4) * 2 + (c >> 5), rr = r & 15, cc = c & 31, ob = rr * 64 + cc * 2; return st * 1024 + (ob ^ (((ob >> 9) & 1) << 5)); }
__host__ __device__ __forceinline__ void stage_rc(int b, int& R, int& C) { const int st = b / 1024, sb = b % 1024, swz = sb ^ (((sb >> 9) & 1) << 5); R = (st >> 1) * 16 + swz / 64; C = (st & 1) * 32 + (swz % 64) / 2; }
__host__ __device__ __forceinline__ int perm32(int rho) { const int n = rho >> 4, i = rho & 15; return 8 * (i >> 2) + 4 * n + (i & 3); }

struct Unit { int pm, pn, e, sbase, nvalid; };
struct Gemm { int lda, ldb, K; };

struct DenseOrder {
    static constexpr bool GATHER = false;
    __device__ __forceinline__ int row_tok(const Unit&, int) const { return 0; }
    const bf16_t* A; const bf16_t* Bt; int lda, ldb;
    int nM, nN, nwg, G, c;
    __device__ void init(const bf16_t* A_, const bf16_t* Bt_, int lda_, int ldb_, int M, int N, int G_, int c_) { A = A_; Bt = Bt_; lda = lda_; ldb = ldb_; nM = M / BM; nN = N / BM; nwg = nM * nN; G = G_; c = c_; }
    __device__ bool next(int i, Unit& u) const {
        const long L = (long)i * G + c; if (L >= nwg) return false;
        int wgid = (int)L; { const int q = nwg / NXCD, r = nwg % NXCD, xcd = wgid % NXCD, off = wgid / NXCD; wgid = (xcd < r ? xcd * (q + 1) : r * (q + 1) + (xcd - r) * q) + off; }
        const int nig = WGM * nN, gid = wgid / nig, fm = gid * WGM, gsz = (nM - fm) < WGM ? (nM - fm) : WGM;
        u.pm = fm + ((wgid % nig) % gsz); u.pn = (wgid % nig) / gsz; u.e = 0; u.sbase = 0; u.nvalid = BM; return true;
    }
    __device__ __forceinline__ const char* a_base(const Unit& u) const { return (const char*)A + (size_t)u.pm * BM * lda * 2; }
    __device__ __forceinline__ const char* b_base(const Unit& u) const { return (const char*)Bt + (size_t)u.pn * BM * ldb * 2; }
};
template <bool GATHER_> struct MoeOrderT {
    static constexpr bool GATHER = GATHER_;
    const bf16_t* A; const bf16_t* Bt; int lda, ldb; size_t bt_expert_stride;
    const LAS unsigned char* tile_l;
    const LAS int* toff; const LAS int* lcnt;
    int tlo, thi, G, c;
    const int* slot_tok;
    __device__ __forceinline__ int row_tok(const Unit& u, int r) const { return r < u.nvalid ? slot_tok[u.sbase + r] : 0; }
    __device__ bool next(int i, Unit& u) const {
        const int nt = thi - tlo; int tile, pn;
        if (G % NXCD == 0) { const int x = c % NXCD, cin = c / NXCD, per = G / NXCD; const int t0 = (int)((long)nt * x / NXCD), t1 = (int)((long)nt * (x + 1) / NXCD);
            const long j = (long)i * per + cin; if (j >= (long)(t1 - t0) * 4) return false; tile = tlo + t0 + (int)(j >> 2); pn = (int)(j & 3); }
        else { const long L = (long)i * G + c; if (L >= (long)nt * 4) return false; tile = tlo + (int)(L >> 2); pn = (int)(L & 3); }
        const int l = tile_l[tile], j = tile - toff[l]; u.pm = tile; u.pn = pn; u.e = l >> 1; u.sbase = l * NTOK + j * BM; u.nvalid = lcnt[l] - j * BM; return true;
    }
    __device__ __forceinline__ const char* a_base(const Unit& u) const { return GATHER ? (const char*)A : (const char*)A + (size_t)u.pm * BM * lda * 2; }
    __device__ __forceinline__ const char* b_base(const Unit& u) const { return (const char*)Bt + ((size_t)u.e * bt_expert_stride + (size_t)u.pn * BM * ldb) * 2; }
};

template <class Epi, class Sched, bool ALIGN_EPI>
__device__ __forceinline__ void gemm_phase(LAS unsigned char* lds, const Gemm g, const Sched& S, const Epi& E) {
    const int tid = threadIdx.x, wid = __builtin_amdgcn_readfirstlane(tid >> 6), lane = tid & 63, wr = wid >> 2, wc = wid & 3, fr = lane & 15, fq = lane >> 4;
    const int K = g.K, nt = K / BK;
    unsigned voffA[2], voffB[2]; int RA[2], CA2[2];
#pragma unroll
    for (int i = 0; i < 2; ++i) { int R, C; stage_rc(tid * 16 + i * 8192, R, C); RA[i] = R; CA2[i] = C * 2; const int Rb = Epi::PERM ? ((R & ~31) + perm32(R & 31)) : R;
        voffA[i] = (unsigned)(R * g.lda + C) * 2u; voffB[i] = (unsigned)(Rb * g.ldb + C) * 2u; }
    const size_t kstep = (size_t)(BK * 2);
    const size_t hstepA = (size_t)HALF * g.lda * 2, hstepB = (size_t)HALF * g.ldb * 2;
    const unsigned ldsw = (unsigned)wid * 1024u;
    const int aoff = lds_byte(wr * 64 + fr, fq * 8), boff = lds_byte(wc * 32 + fr, fq * 8);
#define PG8_SA(b, h) (((b) * 2 + (h)) * HTB)
#define PG8_SB(b, h) ((4 + (b) * 2 + (h)) * HTB)
#define PG8_STAGE(bufoff, gbase, voff) do { _Pragma("unroll") for (int _i = 0; _i < 2; ++_i) \
        __builtin_amdgcn_global_load_lds((const unsigned*)((const char*)(gbase) + (voff)[_i]), (LAS unsigned*)(lds + (bufoff) + ldsw + _i * 8192), 16, 0, 0); } while (0)
#define PG8_STAGE_A(bufoff, kptr, half, nx) do { if constexpr (Sched::GATHER) { _Pragma("unroll") for (int _i = 0; _i < 2; ++_i) \
        __builtin_amdgcn_global_load_lds((const unsigned*)((const char*)(kptr) + ((nx) ? vnx[half][_i] : vcu[half][_i])), (LAS unsigned*)(lds + (bufoff) + ldsw + _i * 8192), 16, 0, 0); } \
    else { PG8_STAGE(bufoff, (const char*)(kptr) + ((half) ? hstepA : 0), voffA); } } while (0)
#define PG8_LDA(dst, b, h) do { _Pragma("unroll") for (int m = 0; m < 4; ++m) _Pragma("unroll") for (int k = 0; k < 2; ++k) dst[m][k] = *(const LAS bf16x8*)(lds + PG8_SA(b, h) + aoff + m * 2048 + k * 1024); } while (0)
#define PG8_LDB(dst, b, h) do { _Pragma("unroll") for (int n = 0; n < 2; ++n) _Pragma("unroll") for (int k = 0; k < 2; ++k) dst[n][k] = *(const LAS bf16x8*)(lds + PG8_SB(b, h) + boff + n * 2048 + k * 1024); } while (0)
#define PG8_MMA(ai, bj, At, Bt) do { __builtin_amdgcn_s_setprio(1); _Pragma("unroll") for (int m = 0; m < 4; ++m) _Pragma("unroll") for (int n = 0; n < 2; ++n) _Pragma("unroll") for (int k = 0; k < 2; ++k) \
        acc[ai][bj][m][n] = __builtin_amdgcn_mfma_f32_16x16x32_bf16(Bt[n][k], At[m][k], acc[ai][bj][m][n], 0, 0, 0); __builtin_amdgcn_s_setprio(0); } while (0)
#define PG8_WAIT_V(n) asm volatile("s_waitcnt vmcnt(" #n ")" ::: "memory")
#define PG8_WAIT_L(n) asm volatile("s_waitcnt lgkmcnt(" #n ")" ::: "memory")
#define PG8_BAR __builtin_amdgcn_s_barrier()
#define PG8_SCHED __builtin_amdgcn_sched_barrier(0)
    Unit cur, nxt; int ui = 0;
    if (!S.next(0, cur)) return;
    f32x4 acc[2][2][4][2];
#pragma unroll
    for (int a = 0; a < 2; ++a)
#pragma unroll
        for (int b = 0; b < 2; ++b)
#pragma unroll
            for (int m = 0; m < 4; ++m)
#pragma unroll
                for (int n = 0; n < 2; ++n) acc[a][b][m][n] = (f32x4){0.f, 0.f, 0.f, 0.f};
    bf16x8 At[4][2], B0[2][2], B1[2][2];
    const char* cA = S.a_base(cur); const char* cB = S.b_base(cur);
    unsigned vcu[2][2], vnx[2][2];
    if constexpr (Sched::GATHER) {
#pragma unroll
        for (int hf = 0; hf < 2; ++hf)
#pragma unroll
            for (int i = 0; i < 2; ++i) { vcu[hf][i] = (unsigned)S.row_tok(cur, hf * HALF + RA[i]) * (unsigned)(g.lda * 2) + (unsigned)CA2[i]; vnx[hf][i] = vcu[hf][i]; } }
    PG8_STAGE(PG8_SB(0, 0), cB, voffB); PG8_STAGE(PG8_SB(0, 1), cB + hstepB, voffB); PG8_STAGE_A(PG8_SA(0, 0), cA, 0, false); PG8_STAGE_A(PG8_SA(0, 1), cA, 1, false);
    if (wr == 1) PG8_BAR;
    PG8_WAIT_V(2); PG8_BAR;
    PG8_STAGE(PG8_SB(1, 0), cB + kstep, voffB); PG8_STAGE_A(PG8_SA(1, 0), cA + kstep, 0, false); PG8_STAGE(PG8_SB(1, 1), cB + hstepB + kstep, voffB);
    PG8_WAIT_V(6); PG8_BAR;
    for (;;) {
        const bool has_next = S.next(ui + 1, nxt);
        const char* nA = has_next ? S.a_base(nxt) : cA; const char* nB = has_next ? S.b_base(nxt) : cB;
        if constexpr (Sched::GATHER) { if (has_next) {
#pragma unroll
            for (int hf = 0; hf < 2; ++hf)
#pragma unroll
                for (int i = 0; i < 2; ++i) vnx[hf][i] = (unsigned)S.row_tok(nxt, hf * HALF + RA[i]) * (unsigned)(g.lda * 2) + (unsigned)CA2[i]; } }
        for (int t = 0; t < nt; t += 2) {
            if constexpr (Epi::HAS_MID) { if (t == Epi::MID_T) E.mid(acc, cur, wr, wc, fr, fq); }
            const bool last = (t == nt - 2);
            const char* a1 = cA + (size_t)(t + 1) * kstep;
            const char* a2 = last ? nA : cA + (size_t)(t + 2) * kstep; const char* b2 = last ? nB : cB + (size_t)(t + 2) * kstep;
            const char* a3 = a2 + kstep; const char* b3 = b2 + kstep;
            PG8_LDB(B0, 0, 0); PG8_LDB(B1, 0, 1); PG8_SCHED; PG8_LDA(At, 0, 0); PG8_STAGE_A(PG8_SA(1, 1), a1, 1, false);
            PG8_WAIT_V(8); PG8_WAIT_L(0); PG8_BAR; PG8_MMA(0, 0, At, B0); PG8_MMA(0, 1, At, B1); PG8_BAR; PG8_SCHED;
            PG8_LDA(At, 0, 1); PG8_STAGE(PG8_SB(0, 0), b2, voffB); PG8_STAGE(PG8_SB(0, 1), b2 + hstepB, voffB); PG8_STAGE_A(PG8_SA(0, 0), a2, 0, last);
            PG8_WAIT_V(8); PG8_WAIT_L(0); PG8_BAR; PG8_MMA(1, 0, At, B0); PG8_MMA(1, 1, At, B1); PG8_BAR; PG8_SCHED;
            PG8_LDB(B0, 1, 0); PG8_LDB(B1, 1, 1); PG8_SCHED; PG8_LDA(At, 1, 0); PG8_STAGE_A(PG8_SA(0, 1), a2, 1, last);
            PG8_WAIT_V(8); PG8_WAIT_L(0); PG8_BAR; PG8_MMA(0, 0, At, B0); PG8_MMA(0, 1, At, B1); PG8_BAR; PG8_SCHED;
            PG8_LDA(At, 1, 1); PG8_STAGE(PG8_SB(1, 0), b3, voffB); PG8_STAGE(PG8_SB(1, 1), b3 + hstepB, voffB); PG8_STAGE_A(PG8_SA(1, 0), a3, 0, last);
            PG8_WAIT_V(8); PG8_WAIT_L(0); PG8_BAR; PG8_MMA(1, 0, At, B0); PG8_MMA(1, 1, At, B1); PG8_BAR; PG8_SCHED;
        }
        if constexpr (ALIGN_EPI) { if (wr == 0) PG8_BAR; }
        E(acc, cur, wr, wc, fr, fq);
        if (!has_next) break;
#pragma unroll
        for (int a = 0; a < 2; ++a)
#pragma unroll
            for (int b = 0; b < 2; ++b)
#pragma unroll
                for (int m = 0; m < 4; ++m)
#pragma unroll
                    for (int n = 0; n < 2; ++n) acc[a][b][m][n] = (f32x4){0.f, 0.f, 0.f, 0.f};
        cur = nxt; cA = nA; cB = nB; ++ui;
        if constexpr (Sched::GATHER) {
#pragma unroll
            for (int hf = 0; hf < 2; ++hf)
#pragma unroll
                for (int i = 0; i < 2; ++i) vcu[hf][i] = vnx[hf][i]; }
        if constexpr (ALIGN_EPI) { if (wr == 1) PG8_BAR; }
    }
    PG8_WAIT_V(0);
    if constexpr (!ALIGN_EPI) { if (wr == 0) PG8_BAR; }
    PG8_BAR;
#undef PG8_SA
#undef PG8_SB
#undef PG8_STAGE
#undef PG8_STAGE_A
#undef PG8_LDA
#undef PG8_LDB
#undef PG8_MMA
#undef PG8_WAIT_V
#undef PG8_WAIT_L
#undef PG8_BAR
#undef PG8_SCHED
}

struct EpiP {
    static constexpr bool PERM = true, HAS_MID = false;
    bf16_t *Prw, *Patt, *Pgate;
    __device__ __forceinline__ void operator()(const f32x4 (&acc)[2][2][4][2], const Unit& u, int wr, int wc, int fr, int fq) const {
        const int row0 = u.pm * BM + wr * 64 + fr; bf16_t* base; int ldc, colt; bool sig = false;
        if (u.pn < 7) { base = Prw; ldc = RCOLS; colt = u.pn * BM; } else if (u.pn < 13) { base = Patt; ldc = ACOLS; colt = (u.pn - 7) * BM; } else { base = Pgate; ldc = GCOLS; colt = (u.pn - 13) * BM; sig = true; }
        const int col0 = colt + wc * 32 + 8 * fq;
#pragma unroll
        for (int ai = 0; ai < 2; ++ai)
#pragma unroll
            for (int m = 0; m < 4; ++m) { bf16_t* rowp = base + (size_t)(row0 + ai * HALF + m * 16) * ldc + col0;
#pragma unroll
                for (int bj = 0; bj < 2; ++bj) { f32x4 v0 = acc[ai][bj][m][0], v1 = acc[ai][bj][m][1];
                    if (sig) {
#pragma unroll
                        for (int j = 0; j < 4; ++j) { v0[j] = sigmoidf_(v0[j]); v1[j] = sigmoidf_(v1[j]); } }
                    u32x4 w; w.x = cvt_pk_bf16(v0[0], v0[1]); w.y = cvt_pk_bf16(v0[2], v0[3]); w.z = cvt_pk_bf16(v1[0], v1[1]); w.w = cvt_pk_bf16(v1[2], v1[3]);
                    *(u32x4*)(rowp + bj * HALF) = w; } }
    }
};
struct EpiMix {
    static constexpr bool PERM = true, HAS_MID = true; static constexpr int MID_T = 8;
    bf16_t* T; const bf16_t* Pgate;
    __device__ __forceinline__ void mid(f32x4 (&acc)[2][2][4][2], const Unit& u, int wr, int wc, int fr, int fq) const {
        int row0 = u.pm * BM + wr * 64 + fr, col0 = u.pn * BM + wc * 32 + 8 * fq; asm volatile("" : "+v"(row0), "+v"(col0));
#pragma unroll
        for (int am = 0; am < 8; am += 2) {
            u32x4 gr[2][2], ga[2][2];
#pragma unroll
            for (int q = 0; q < 2; ++q) { const int ai = (am + q) >> 2, m = (am + q) & 3; const bf16_t* gp = Pgate + (size_t)(row0 + ai * HALF + m * 16) * GCOLS + col0;
#pragma unroll
                for (int bj = 0; bj < 2; ++bj) { gr[q][bj] = *(const u32x4*)(gp + bj * HALF); ga[q][bj] = *(const u32x4*)(gp + DM + bj * HALF); } }
#pragma unroll
            for (int q = 0; q < 2; ++q) { const int ai = (am + q) >> 2, m = (am + q) & 3;
#pragma unroll
                for (int bj = 0; bj < 2; ++bj) { const u32x4 r = gr[q][bj], a = ga[q][bj]; f32x4& v0 = acc[ai][bj][m][0]; f32x4& v1 = acc[ai][bj][m][1];
                    v0[0] *= bf_lo(r.x) * __builtin_amdgcn_rcpf(bf_lo(a.x)); v0[1] *= bf_hi(r.x) * __builtin_amdgcn_rcpf(bf_hi(a.x)); v0[2] *= bf_lo(r.y) * __builtin_amdgcn_rcpf(bf_lo(a.y)); v0[3] *= bf_hi(r.y) * __builtin_amdgcn_rcpf(bf_hi(a.y));
                    v1[0] *= bf_lo(r.z) * __builtin_amdgcn_rcpf(bf_lo(a.z)); v1[1] *= bf_hi(r.z) * __builtin_amdgcn_rcpf(bf_hi(a.z)); v1[2] *= bf_lo(r.w) * __builtin_amdgcn_rcpf(bf_lo(a.w)); v1[3] *= bf_hi(r.w) * __builtin_amdgcn_rcpf(bf_hi(a.w)); } }
            asm volatile("" ::: "memory");
        }
    }
    __device__ __forceinline__ void operator()(const f32x4 (&acc)[2][2][4][2], const Unit& u, int wr, int wc, int fr, int fq) const {
        const int row0 = u.pm * BM + wr * 64 + fr, col0 = u.pn * BM + wc * 32 + 8 * fq;
#pragma unroll
        for (int ai = 0; ai < 2; ++ai) {
            u32x4 ga[4][2];
#pragma unroll
            for (int m = 0; m < 4; ++m)
#pragma unroll
                for (int bj = 0; bj < 2; ++bj) ga[m][bj] = *(const u32x4*)(Pgate + (size_t)(row0 + ai * HALF + m * 16) * GCOLS + DM + col0 + bj * HALF);
#pragma unroll
            for (int m = 0; m < 4; ++m) { const size_t row = (size_t)(row0 + ai * HALF + m * 16);
#pragma unroll
                for (int bj = 0; bj < 2; ++bj) { const int col = col0 + bj * HALF; const u32x4 g = ga[m][bj];
                    const f32x4 a0 = acc[ai][bj][m][0], a1 = acc[ai][bj][m][1];
                    u32x4 w; w.x = cvt_pk_bf16(a0[0] * bf_lo(g.x), a0[1] * bf_hi(g.x)); w.y = cvt_pk_bf16(a0[2] * bf_lo(g.y), a0[3] * bf_hi(g.y)); w.z = cvt_pk_bf16(a1[0] * bf_lo(g.z), a1[1] * bf_hi(g.z)); w.w = cvt_pk_bf16(a1[2] * bf_lo(g.w), a1[3] * bf_hi(g.w));
                    *(u32x4*)(T + row * DM + col) = w; } }
            asm volatile("" ::: "memory");
        }
    }
};
struct EpiDelta {
    static constexpr bool PERM = true, HAS_MID = false;
    bf16_t* D; const float* mod;
    __device__ __forceinline__ void operator()(const f32x4 (&acc)[2][2][4][2], const Unit& u, int wr, int wc, int fr, int fq) const {
        const int row0 = u.pm * BM + wr * 64 + fr, col0 = u.pn * BM + wc * 32 + 8 * fq;
        const int b = (u.pm * BM) / SEQ; const float* g1 = mod + (size_t)b * MODW + 2 * DM;
        f32x4 gv[2][2];
#pragma unroll
        for (int bj = 0; bj < 2; ++bj)
#pragma unroll
            for (int n = 0; n < 2; ++n) gv[bj][n] = *(const f32x4*)(g1 + col0 + bj * HALF + 4 * n);
#pragma unroll
        for (int ai = 0; ai < 2; ++ai)
#pragma unroll
            for (int m = 0; m < 4; ++m) { bf16_t* rowp = D + (size_t)(row0 + ai * HALF + m * 16) * DM + col0;
#pragma unroll
                for (int bj = 0; bj < 2; ++bj) { const f32x4 v0 = acc[ai][bj][m][0] * gv[bj][0], v1 = acc[ai][bj][m][1] * gv[bj][1];
                    u32x4 w; w.x = cvt_pk_bf16(v0[0], v0[1]); w.y = cvt_pk_bf16(v0[2], v0[3]); w.z = cvt_pk_bf16(v1[0], v1[1]); w.w = cvt_pk_bf16(v1[2], v1[3]);
                    *(u32x4*)(rowp + bj * HALF) = w; } }
    }
};
struct EpiHid {
    static constexpr bool PERM = true, HAS_MID = false;
    bf16_t* hid;
    __device__ __forceinline__ void operator()(const f32x4 (&acc)[2][2][4][2], const Unit& u, int wr, int wc, int fr, int fq) const {
        const int row0 = u.pm * BM + wr * 64 + fr, hc0 = u.pn * 128 + wc * 16 + 4 * fq;
#pragma unroll
        for (int ai = 0; ai < 2; ++ai)
#pragma unroll
            for (int m = 0; m < 4; ++m) { bf16_t* rowp = hid + (size_t)(row0 + ai * HALF + m * 16) * DE + hc0;
#pragma unroll
                for (int bj = 0; bj < 2; ++bj) { const f32x4 gt = acc[ai][bj][m][0], up = acc[ai][bj][m][1]; float h[4];
#pragma unroll
                    for (int j = 0; j < 4; ++j) h[j] = gt[j] * sigmoidf_(gt[j]) * up[j];
                    u32x2 w; w.x = cvt_pk_bf16(h[0], h[1]); w.y = cvt_pk_bf16(h[2], h[3]); *(u32x2*)(rowp + bj * 64) = w; } }
    }
};
struct EpiY {
    static constexpr bool PERM = true, HAS_MID = false;
    bf16_t* Y; const float* slot_w;
    __device__ __forceinline__ void operator()(const f32x4 (&acc)[2][2][4][2], const Unit& u, int wr, int wc, int fr, int fq) const {
        const int row0 = u.pm * BM + wr * 64 + fr, col0 = u.pn * BM + wc * 32 + 8 * fq;
        float w[2][4];
#pragma unroll
        for (int ai = 0; ai < 2; ++ai)
#pragma unroll
            for (int m = 0; m < 4; ++m) { const int r = wr * 64 + fr + ai * HALF + m * 16; w[ai][m] = r < u.nvalid ? slot_w[u.sbase + r] : 0.f; }
#pragma unroll
        for (int ai = 0; ai < 2; ++ai)
#pragma unroll
            for (int m = 0; m < 4; ++m) { bf16_t* rowp = Y + (size_t)(row0 + ai * HALF + m * 16) * DM + col0; const float ws = w[ai][m];
#pragma unroll
                for (int bj = 0; bj < 2; ++bj) { const f32x4 v0 = acc[ai][bj][m][0] * ws, v1 = acc[ai][bj][m][1] * ws;
                    u32x4 o; o.x = cvt_pk_bf16(v0[0], v0[1]); o.y = cvt_pk_bf16(v0[2], v0[3]); o.z = cvt_pk_bf16(v1[0], v1[1]); o.w = cvt_pk_bf16(v1[2], v1[3]);
                    *(u32x4*)(rowp + bj * HALF) = o; } }
    }
};
}
typedef GAS unsigned gu32;
#define RLX_AGENT __ATOMIC_RELAXED, __HIP_MEMORY_SCOPE_AGENT
#define LDS_WAIT() asm volatile("s_waitcnt lgkmcnt(0)" ::: "memory")
#define VM_WAIT() asm volatile("s_waitcnt vmcnt(0)" ::: "memory")
#define XB_TMO      128
#define XB_XCNT(j)  (256  + 64 * (j))
#define XB_XSUB(j)  (1280 + 64 * (j))
#define XB_XGEN(j)  (2304 + 64 * (j))
#define XB_TOP      3328
#define XB_TOPGEN   3392
#define XCD_BAR_WORDS 3456
#define XB_SPIN_CAP (1u << 18)

__device__ __forceinline__ unsigned xb_ld(unsigned* p)              { return __hip_atomic_load(p, __ATOMIC_RELAXED, __HIP_MEMORY_SCOPE_AGENT); }
__device__ __forceinline__ unsigned xb_add(unsigned* p, unsigned v) { return __hip_atomic_fetch_add(p, v, __ATOMIC_RELAXED, __HIP_MEMORY_SCOPE_AGENT); }
__device__ __forceinline__ unsigned xb_xcc_id() { return (unsigned)__builtin_amdgcn_s_getreg((3 << 11) | 20) & 0xFu; }
#define XB_SPIN(cond, bar) do { unsigned _sp = 0; while (cond) { __builtin_amdgcn_s_sleep(1); \
    if ((++_sp & 255u) == 0u) { if (xb_ld(&(bar)[XB_TMO])) break; if (_sp > XB_SPIN_CAP) { atomicAdd(&(bar)[XB_TMO], 1u); break; } } } } while (0)

struct XcdBarrier {
    unsigned* bar; unsigned x;
    volatile LAS unsigned* st;
};

__device__ __forceinline__ XcdBarrier xcd_barrier_post(unsigned* bar, volatile LAS unsigned* st) {
    XcdBarrier b; b.bar = bar; b.x = xb_xcc_id(); b.st = st;
    if (threadIdx.x == 0) (void)xb_add(&bar[XB_XCNT(b.x)], 1u);
    return b;
}
__device__ __forceinline__ void xcd_barrier_complete(unsigned* bar, unsigned x, unsigned& nloc, unsigned& nx) {
    const unsigned G = gridDim.x * gridDim.y * gridDim.z;
    unsigned sum, cnt, mine, sp = 0u;
    for (;;) {
        sum = 0u; cnt = 0u; mine = 0u;
#pragma unroll
        for (unsigned j = 0; j < 16; ++j) { const unsigned c = xb_ld(&bar[XB_XCNT(j)]); sum += c; cnt += (c > 0u) ? 1u : 0u; mine = (j == x) ? c : mine; }
        if (sum == G) break;
        __builtin_amdgcn_s_sleep(1);
        if ((++sp & 255u) == 0u) { if (xb_ld(&bar[XB_TMO])) break; if (sp > XB_SPIN_CAP) { atomicAdd(&bar[XB_TMO], 1u); break; } }
    }
    nloc = mine > 0u ? mine : 1u; nx = cnt > 0u ? cnt : 1u;
}

__device__ __forceinline__ void xcd_barrier(const XcdBarrier& b) {
    asm volatile("s_waitcnt vmcnt(0)" ::: "memory");
    __syncthreads();
    if (threadIdx.x == 0) {
        unsigned* bar = b.bar;
        __builtin_amdgcn_s_waitcnt(0);
        unsigned nloc = b.st[0], nx = b.st[1];
        if (nloc == 0u) { xcd_barrier_complete(bar, b.x, nloc, nx); b.st[0] = nloc; b.st[1] = nx; }
        const unsigned old = xb_add(&bar[XB_XSUB(b.x)], 1u);
        const unsigned gen = old / nloc;
        if (old + 1u == (gen + 1u) * nloc) {
            __builtin_amdgcn_fence(__ATOMIC_RELEASE, "agent");
            asm volatile("s_waitcnt vmcnt(0)" ::: "memory");
            const unsigned og = xb_add(&bar[XB_TOP], 1u);
            const unsigned tg = og / nx;
            if (og + 1u == (tg + 1u) * nx) xb_add(&bar[XB_TOPGEN], 1u);
            else XB_SPIN(xb_ld(&bar[XB_TOPGEN]) == tg, bar);
            __builtin_amdgcn_fence(__ATOMIC_ACQUIRE, "agent");
            xb_add(&bar[XB_XGEN(b.x)], 1u);
            asm volatile("s_waitcnt vmcnt(0)" ::: "memory");
        } else {
            XB_SPIN(xb_ld(&bar[XB_XGEN(b.x)]) == gen, bar);
            __builtin_amdgcn_fence(__ATOMIC_ACQUIRE, "agent");
            asm volatile("s_waitcnt vmcnt(0)" ::: "memory");
        }
    }
    __syncthreads();
}

constexpr int NWAVES = 8;
constexpr size_t MiB = 1u << 20, KiB = 1u << 10;
constexpr size_t WS_CTL = 0, CTL_ZERO_BYTES = 2 * MiB;
constexpr size_t WS_MOD = 1 * MiB;
constexpr size_t WS_WIN = 2 * MiB;
constexpr size_t WS_WBR = 12 * MiB + 512 * KiB, WS_WBA = 13 * MiB + 512 * KiB, WS_WOUT = 14 * MiB + 512 * KiB;
constexpr size_t WS_WUP = 16 * MiB + 512 * KiB, WS_AUP = WS_WUP + 64 * KiB, WS_GUP = WS_WUP + 128 * KiB;
constexpr size_t WS_WRH = 16 * MiB + 768 * KiB, WS_WRL = WS_WRH + 128 * KiB;
constexpr size_t WS_CB = 17 * MiB, WS_GAM2 = 17 * MiB + 64 * KiB;
constexpr size_t WS_PRW = 18 * MiB, WS_PATT = 130 * MiB, WS_PGATE = 226 * MiB;
constexpr size_t WS_WGU = 130 * MiB, WS_WD = 194 * MiB;
constexpr size_t WS_T = 18 * MiB;
constexpr size_t WS_HID = 18 * MiB, WS_DELTA = 226 * MiB, WS_H2 = 354 * MiB;
constexpr size_t WS_SLOTTOK = 450 * MiB, WS_SLOTW = 458 * MiB, WS_TOKLIST = 466 * MiB,
    WS_TOKPOS = WS_TOKLIST + 256 * KiB, WS_TOKW = WS_TOKLIST + 512 * KiB;
constexpr size_t WS_QE = 354 * MiB, WS_YLOC = 386 * MiB, WS_PC = 418 * MiB, WS_SLOC = 450 * MiB;
constexpr size_t WS_YB = 290 * MiB;
constexpr size_t WS_END = 512 * MiB;
constexpr size_t DO_H = 0, DO_G = 0, DO_SC = 32 * MiB, DO_YRA = 64 * MiB;
constexpr int NSLOT_MAX = 2 * NTOK + NLIST * 256;
constexpr int CW_TMO = 0, CW_BAR = 4096, CW_CNT = 16384;
constexpr int LDS_BYTES = 163840, RING_BYTES = 131072;
constexpr int LDSCTL_OFF = LDS_BYTES - 2048, MISC_OFF = LDSCTL_OFF;
constexpr int TOFF_OFF = LDSCTL_OFF + 256, LCNT_OFF = TOFF_OFF + 264, TILE_L_OFF = LCNT_OFF + 256;

#define LBAR() do { asm volatile("s_waitcnt lgkmcnt(0)" ::: "memory"); __builtin_amdgcn_s_barrier(); asm volatile("" ::: "memory"); } while (0)
struct Frame {
    LAS unsigned char* lds; volatile LAS unsigned* MISC; gu32* ctl;
    int tid, lane, wave, vcu, G;
};
__device__ __forceinline__ float wave_sum(float v) {
#pragma unroll
    for (int o = 1; o < 64; o <<= 1) v += __shfl_xor(v, o);
    return v;
}
__device__ __forceinline__ float dpp_f(float x, const int ctrl_sel) {
    const int xi = __builtin_bit_cast(int, x); int r;
    if (ctrl_sel == 0) r = __builtin_amdgcn_update_dpp(0, xi, 0xB1, 0xf, 0xf, true);
    else if (ctrl_sel == 1) r = __builtin_amdgcn_update_dpp(0, xi, 0x4E, 0xf, 0xf, true);
    else r = __builtin_amdgcn_update_dpp(0, xi, 0x141, 0xf, 0xf, true);
    return __builtin_bit_cast(float, r);
}
__device__ __forceinline__ float red8(float x) { x += dpp_f(x, 0); x += dpp_f(x, 1); x += dpp_f(x, 2); return x; }

__device__ __forceinline__ void phase_mod(Frame& F, const float* c, const float* w_ada, const float* b_ada, float* mod) {
    const int gw = F.vcu * NWAVES + F.wave, NGW = F.G * NWAVES;
    for (int task = gw; task < 96 * 16; task += NGW) {
        const int nc = task % 96, ks = task / 96, n = nc * 64 + F.lane, k0 = ks * 64;
        float acc[16];
#pragma unroll
        for (int b = 0; b < 16; ++b) acc[b] = 0.f;
        LAS float* sl = (LAS float*)(F.lds) + F.wave * 1024;
#pragma unroll
        for (int j = 0; j < 16; ++j) { const float cv = c[(F.lane & 15) * DM + k0 + (F.lane >> 4) + 4 * j]; sl[((F.lane >> 4) + 4 * j) * 16 + (F.lane & 15)] = cv * sigmoidf_(cv); }
        LDS_WAIT(); asm volatile("" ::: "memory");
#pragma unroll 4
        for (int kk = 0; kk < 64; ++kk) { const float w = w_ada[(size_t)(k0 + kk) * MODW + n];
            const f32x4 s0 = *(const LAS f32x4*)(sl + kk * 16), s1 = *(const LAS f32x4*)(sl + kk * 16 + 4), s2 = *(const LAS f32x4*)(sl + kk * 16 + 8), s3 = *(const LAS f32x4*)(sl + kk * 16 + 12);
            acc[0] += s0.x * w; acc[1] += s0.y * w; acc[2] += s0.z * w; acc[3] += s0.w * w; acc[4] += s1.x * w; acc[5] += s1.y * w; acc[6] += s1.z * w; acc[7] += s1.w * w;
            acc[8] += s2.x * w; acc[9] += s2.y * w; acc[10] += s2.z * w; acc[11] += s2.w * w; acc[12] += s3.x * w; acc[13] += s3.y * w; acc[14] += s3.z * w; acc[15] += s3.w * w; }
        LDS_WAIT(); asm volatile("" ::: "memory");
#pragma unroll
        for (int b = 0; b < 16; ++b) { const float v = acc[b] + (ks == 0 ? b_ada[n] : 0.f); atomicAdd(mod + (size_t)b * MODW + n, v); }
    }
}

template <int MODE> __device__ __forceinline__ void transpose_item(const float* W, int K, int N, bf16_t* WT, int row_off, int item, int lane, int ldt = 0, int koff = 0) {
    if (ldt == 0) ldt = K;
    const int nblk = N / 32, kb = item / nblk, nb = item % nblk, k0 = 64 * kb + 8 * (lane >> 3), n0 = 32 * nb + 4 * (lane & 7);
    f32x4 v[8];
#pragma unroll
    for (int i = 0; i < 8; ++i) v[i] = *(const f32x4*)(W + (size_t)(k0 + i) * N + n0);
#pragma unroll
    for (int j = 0; j < 4; ++j) { const int ng = n0 + j; const int nr = MODE == 0 ? row_off + ng : (MODE == 1 ? 8 * (ng >> 2) + (ng & 3) : 8 * (ng >> 2) + 4 + (ng & 3));
        u32x4 o; o.x = cvt_pk_bf16(v[0][j], v[1][j]); o.y = cvt_pk_bf16(v[2][j], v[3][j]); o.z = cvt_pk_bf16(v[4][j], v[5][j]); o.w = cvt_pk_bf16(v[6][j], v[7][j]);
        *(GAS u32x4*)(WT + (size_t)nr * ldt + koff + k0) = o; }
}

struct Args { const float* in[31]; float* out; unsigned char* ws; int ph_lo, ph_hi; };
struct Ptrs { const float* in[31]; float* out; unsigned char* ws; };

__device__ __forceinline__ void phase_prep(Frame& F, const Ptrs& P) {
    const int gw = F.vcu * NWAVES + F.wave, NGW = F.G * NWAVES;
    const float* mod = (const float*)(P.ws + WS_MOD);
    bf16_t* Win_t = (bf16_t*)(P.ws + WS_WIN); bf16_t* Wbr_t = (bf16_t*)(P.ws + WS_WBR); bf16_t* Wba_t = (bf16_t*)(P.ws + WS_WBA); bf16_t* Wout_t = (bf16_t*)(P.ws + WS_WOUT);
    bf16_t* wup_t = (bf16_t*)(P.ws + WS_WUP); bf16_t* aup_t = (bf16_t*)(P.ws + WS_AUP); bf16_t* gup_t = (bf16_t*)(P.ws + WS_GUP);
    constexpr int I_IN = 16 * (INCOLS / 32), I_BR = 8 * 32, I_OUT = 16 * 32, I_UP = 16, I_GUP = 2 * 16;
    constexpr int NITEMS = I_IN + 2 * I_BR + I_OUT + 2 * I_UP + I_GUP;
    for (int it = gw; it < NITEMS; it += NGW) {
        int r = it;
        if (r < I_IN) { transpose_item<0>(P.in[5], DM, INCOLS, Win_t, 0, r, F.lane); continue; } r -= I_IN;
        if (r < I_BR) { transpose_item<0>(P.in[20], 512, DM, Wbr_t, 0, r, F.lane, DM, 0); continue; } r -= I_BR;
        if (r < I_BR) { transpose_item<0>(P.in[21], 512, DM, Wbr_t, 0, r, F.lane, DM, 512); continue; } r -= I_BR;
        if (r < I_OUT) { transpose_item<0>(P.in[22], DM, DM, Wout_t, 0, r, F.lane); continue; } r -= I_OUT;
        if (r < I_UP) { transpose_item<0>(P.in[8], 64, 512, wup_t, 0, r, F.lane); continue; } r -= I_UP;
        if (r < I_UP) { transpose_item<0>(P.in[10], 64, 512, aup_t, 0, r, F.lane); continue; } r -= I_UP;
        transpose_item<0>(P.in[11], 128, 512, gup_t, 0, r, F.lane);
    }
    { bf16_t* wrh = (bf16_t*)(P.ws + WS_WRH); bf16_t* wrl = (bf16_t*)(P.ws + WS_WRL);
      for (int idx = (F.vcu * NWAVES * 64 + F.tid); idx < 64 * DM; idx += F.G * NWAVES * 64) { const int o = idx / DM, k = idx % DM;
          const float w = o < 4 ? P.in[24][k * 4 + o] : (o < 36 ? P.in[26][k * 32 + (o - 4)] : 0.f);
          const unsigned hi = cvt_pk_bf16(w, 0.f) & 0xffffu; const float rem = w - __uint_as_float(hi << 16); const unsigned lo = cvt_pk_bf16(rem, 0.f) & 0xffffu;
          wrh[idx] = (bf16_t)hi; wrl[idx] = (bf16_t)lo; } }
    { float* gam2 = (float*)(P.ws + WS_GAM2);
      for (int idx = (F.vcu * NWAVES * 64 + F.tid); idx < NB * DM; idx += F.G * NWAVES * 64) { const int b = idx / DM, k = idx % DM; gam2[idx] = P.in[23][k] * (1.f + mod[(size_t)b * MODW + 4 * DM + k]); } }
    { float* cb = (float*)(P.ws + WS_CB);
      for (int t = gw; t < NB * 36; t += NGW) { const int b = t / 36, o = t % 36; float s = 0.f;
          for (int k = F.lane; k < DM; k += 64) { const float w = o < 4 ? P.in[24][k * 4 + o] : P.in[26][k * 32 + (o - 4)]; s += mod[(size_t)b * MODW + 3 * DM + k] * w; }
          s = wave_sum(s); if (F.lane == 0) cb[b * 64 + o] = s + (o < 4 ? P.in[25][o] : P.in[27][o - 4]); } }
    bf16_t* H = (bf16_t*)((unsigned char*)P.out + DO_H);
    for (int m = gw; m < NTOK; m += NGW) {
        const int b = m / SEQ; const float* sh = mod + (size_t)b * MODW; const float* sc = sh + DM;
        const GAS f32x4* xr = (const GAS f32x4*)(P.in[0] + (size_t)m * DM) + F.lane;
        f32x4 v[4]; float s = 0.f;
#pragma unroll
        for (int j = 0; j < 4; ++j) { v[j] = xr[64 * j]; s += (v[j].x * v[j].x + v[j].y * v[j].y) + (v[j].z * v[j].z + v[j].w * v[j].w); }
        const float rinv = 1.f / sqrtf(wave_sum(s) * (1.f / DM) + 1e-6f);
        GAS u32x2* o8 = (GAS u32x2*)(H + (size_t)m * DM) + F.lane;
#pragma unroll
        for (int j = 0; j < 4; ++j) { const int k = 4 * F.lane + 256 * j; const f32x4 g = *(const f32x4*)(P.in[4] + k), s1 = *(const f32x4*)(sc + k), h1 = *(const f32x4*)(sh + k);
            const f32x4 hv = v[j] * rinv * g * (s1 + 1.f) + h1; u32x2 w; w.x = cvt_pk_bf16(hv.x, hv.y); w.y = cvt_pk_bf16(hv.z, hv.w); o8[64 * j] = w; }
    }
}
__device__ __forceinline__ void expert_convert(Frame& F, const Ptrs& P, int wv, int nwv, int it_lo, int it_hi) {
    bf16_t* Wgu = (bf16_t*)(P.ws + WS_WGU); bf16_t* Wd = (bf16_t*)(P.ws + WS_WD);
    constexpr int I_G = 16 * 16, I_D = 8 * 32;
    for (int it = it_lo + wv; it < it_hi; it += nwv) {
        const int e = it / (2 * I_G + I_D); int r = it % (2 * I_G + I_D);
        if (r < I_G) { transpose_item<1>(P.in[28] + (size_t)e * DM * DE, DM, DE, Wgu + (size_t)e * DM * DM, 0, r, F.lane); continue; } r -= I_G;
        if (r < I_G) { transpose_item<2>(P.in[29] + (size_t)e * DM * DE, DM, DE, Wgu + (size_t)e * DM * DM, 0, r, F.lane); continue; } r -= I_G;
        transpose_item<0>(P.in[30] + (size_t)e * DE * DM, DE, DM, Wd + (size_t)e * DM * DE, 0, r, F.lane);
    }
}
namespace att {
constexpr int SLOT = 16384, NSL = 5, L_WS = NSL * SLOT, L_OST = L_WS + 8 * 256, L_BIAS = L_OST + 8 * 4096, L_END = L_BIAS + 1280;
__device__ __forceinline__ int crow(int r, int hi) { return (r & 3) + 8 * (r >> 2) + 4 * hi; }
__device__ __forceinline__ float max3f(float a, float b, float c) { return fmaxf(fmaxf(a, b), c); }
__device__ __forceinline__ s16x4 vtr(const LAS char* p) { return __builtin_bit_cast(s16x4, __builtin_amdgcn_ds_read_tr16_b64_v4i16((LAS s16x4*)p)); }

__device__ __forceinline__ void attn_unit(Frame& F, const Ptrs& P, int b, int h, int qb) {
    const int tid = F.tid, lane = F.lane, wid = F.wave, r32 = lane & 31, hi = lane >> 5;
    const bf16_t* Patt = (const bf16_t*)(P.ws + WS_PATT);
    bf16_t* Ya = (bf16_t*)((unsigned char*)P.out + DO_YRA) + 512;
    LAS char* lds = (LAS char*)F.lds;
    LAS float* wsf = (LAS float*)(lds + L_WS) + wid * 64;
    LAS float* biasL = (LAS float*)(lds + L_BIAS);
    const int cq = wid >> 1, ci = qb * 4 + cq, kc0 = qb * 4 - 8;
    const size_t rowbase = (size_t)b * SEQ;
    for (int i = tid; i < 257; i += 512) biasL[i] = P.in[19][h * 257 + i] * LOG2E;
    const int srow = tid >> 3, sc8 = tid & 7;
    f32x4 kg0 = *(const f32x4*)(P.in[18] + 8 * sc8), kg1 = *(const f32x4*)(P.in[18] + 8 * sc8 + 4);
    const int kdst = sc8 * 1024 + srow * 16, vdst = 8192 + (sc8 >> 2) * 4096 + (srow >> 4) * 1024 + (srow & 15) * 64 + (sc8 & 3) * 16;
    auto ld_k = [&](int j) -> u32x4 { return *(const u32x4*)(Patt + (rowbase + (size_t)(kc0 + j) * 64 + srow) * ACOLS + 512 + h * 64 + 8 * sc8); };
    auto ld_v = [&](int j) -> u32x4 { return *(const u32x4*)(Patt + (rowbase + (size_t)(kc0 + j) * 64 + srow) * ACOLS + 1024 + h * 64 + 8 * sc8); };
    auto st_kv = [&](int j, u32x4 kw, u32x4 vw) {
        float kf[8] = {bf_lo(kw.x), bf_hi(kw.x), bf_lo(kw.y), bf_hi(kw.y), bf_lo(kw.z), bf_hi(kw.z), bf_lo(kw.w), bf_hi(kw.w)};
        float ss = 0.f;
#pragma unroll
        for (int i = 0; i < 8; ++i) ss += kf[i] * kf[i];
        ss = red8(ss); const float rk = 1.f / sqrtf(ss * (1.f / 64.f) + 1e-6f);
        u32x4 o; o.x = cvt_pk_bf16(kf[0] * rk * kg0.x, kf[1] * rk * kg0.y); o.y = cvt_pk_bf16(kf[2] * rk * kg0.z, kf[3] * rk * kg0.w);
        o.z = cvt_pk_bf16(kf[4] * rk * kg1.x, kf[5] * rk * kg1.y); o.w = cvt_pk_bf16(kf[6] * rk * kg1.z, kf[7] * rk * kg1.w);
        LAS char* sl = lds + (j % NSL) * SLOT;
        *(LAS u32x4*)(sl + kdst) = o; *(LAS u32x4*)(sl + vdst) = vw; };
    { u32x4 kws[4], vws[4];
#pragma unroll
      for (int j = 0; j < 4; ++j) if (kc0 + j >= 0) { kws[j] = ld_k(j); vws[j] = ld_v(j); }
#pragma unroll
      for (int j = 0; j < 4; ++j) if (kc0 + j >= 0) st_kv(j, kws[j], vws[j]); }
    const size_t qrow = rowbase + (size_t)ci * 64 + (wid & 1) * 32 + r32;
    bf16x8 qr[4];
    { float qf[4][8]; float ss = 0.f;
#pragma unroll
      for (int d0 = 0; d0 < 4; ++d0) { const u32x4 w = *(const u32x4*)(Patt + qrow * ACOLS + h * 64 + d0 * 16 + hi * 8);
          qf[d0][0] = bf_lo(w.x); qf[d0][1] = bf_hi(w.x); qf[d0][2] = bf_lo(w.y); qf[d0][3] = bf_hi(w.y); qf[d0][4] = bf_lo(w.z); qf[d0][5] = bf_hi(w.z); qf[d0][6] = bf_lo(w.w); qf[d0][7] = bf_hi(w.w);
#pragma unroll
          for (int i = 0; i < 8; ++i) ss += qf[d0][i] * qf[d0][i]; }
      ss += __shfl_xor(ss, 32);
      const float rq = (0.125f * LOG2E) / sqrtf(ss * (1.f / 64.f) + 1e-6f);
#pragma unroll
      for (int d0 = 0; d0 < 4; ++d0) { const f32x4 g0 = *(const f32x4*)(P.in[17] + d0 * 16 + hi * 8), g1 = *(const f32x4*)(P.in[17] + d0 * 16 + hi * 8 + 4);
          u32x4 o; o.x = cvt_pk_bf16(qf[d0][0] * rq * g0.x, qf[d0][1] * rq * g0.y); o.y = cvt_pk_bf16(qf[d0][2] * rq * g0.z, qf[d0][3] * rq * g0.w);
          o.z = cvt_pk_bf16(qf[d0][4] * rq * g1.x, qf[d0][5] * rq * g1.y); o.w = cvt_pk_bf16(qf[d0][6] * rq * g1.z, qf[d0][7] * rq * g1.w);
          qr[d0] = __builtin_bit_cast(bf16x8, o); } }
    u32x4 kA, vA; if (kc0 + 4 >= 0) { kA = ld_k(4); vA = ld_v(4); }
    float mrun = -1e30f, lrun = 0.f; f32x16 o0 = {}, o1 = {};
    const int qloc = (wid & 1) * 32 + r32;
    __syncthreads();
#pragma unroll 1
    for (int s = 0; s < 9; ++s) {
        const int jn = s + 4; const bool ld = (jn <= 11) && (kc0 + jn >= 0);
        const bool ldn = (jn + 1 <= 11) && (kc0 + jn + 1 >= 0); u32x4 kB, vB; if (ldn) { kB = ld_k(jn + 1); vB = ld_v(jn + 1); }
        const int j = cq + s;
        if (kc0 + j >= 0) {
            const LAS char* sl = lds + (j % NSL) * SLOT;
            f32x16 p0, p1;
            if (s <= 5) { const float c0 = biasL[0];
#pragma unroll
                for (int r = 0; r < 16; ++r) { p0[r] = c0; p1[r] = c0; } }
            else { const int base = 64 * (s - 8) - qloc + 128;
#pragma unroll
                for (int r = 0; r < 16; ++r) { int i0 = base + crow(r, hi), i1 = i0 + 32; i0 = i0 < 0 ? 0 : (i0 > 256 ? 256 : i0); i1 = i1 < 0 ? 0 : (i1 > 256 ? 256 : i1); p0[r] = biasL[i0]; p1[r] = biasL[i1]; } }
            const LAS char* kb = sl + hi * 1024 + r32 * 16;
#pragma unroll
            for (int d0 = 0; d0 < 4; ++d0) { const bf16x8 b0 = *(const LAS bf16x8*)(kb + d0 * 2048), b1 = *(const LAS bf16x8*)(kb + d0 * 2048 + 512);
                p0 = __builtin_amdgcn_mfma_f32_32x32x16_bf16(b0, qr[d0], p0, 0, 0, 0); p1 = __builtin_amdgcn_mfma_f32_32x32x16_bf16(b1, qr[d0], p1, 0, 0, 0); }
            float a = max3f(p0[0], p0[1], p1[0]), bm = max3f(p0[2], p0[3], p1[1]); a = max3f(a, p1[2], p1[3]);
#pragma unroll
            for (int r = 4; r < 16; r += 4) { a = max3f(a, p0[r], p0[r + 1]); bm = max3f(bm, p0[r + 2], p0[r + 3]); a = max3f(a, p1[r], p1[r + 1]); bm = max3f(bm, p1[r + 2], p1[r + 3]); }
            float rm = fmaxf(a, bm); rm = fmaxf(rm, __shfl_xor(rm, 32));
            const float mnew = fmaxf(mrun, rm), f = __builtin_amdgcn_exp2f(mrun - mnew); mrun = mnew;
            float sacc = 0.f;
#pragma unroll
            for (int r = 0; r < 16; ++r) { p0[r] = __builtin_amdgcn_exp2f(p0[r] - mnew); p1[r] = __builtin_amdgcn_exp2f(p1[r] - mnew); sacc += p0[r] + p1[r]; }
            lrun = lrun * f + sacc;
            if (hi == 0) wsf[r32] = f;
            u32x4 pw0, pw1, pw2, pw3;
            pw0 = (u32x4){cvt_pk_bf16(p0[0], p0[1]), cvt_pk_bf16(p0[2], p0[3]), cvt_pk_bf16(p0[4], p0[5]), cvt_pk_bf16(p0[6], p0[7])};
            pw1 = (u32x4){cvt_pk_bf16(p0[8], p0[9]), cvt_pk_bf16(p0[10], p0[11]), cvt_pk_bf16(p0[12], p0[13]), cvt_pk_bf16(p0[14], p0[15])};
            pw2 = (u32x4){cvt_pk_bf16(p1[0], p1[1]), cvt_pk_bf16(p1[2], p1[3]), cvt_pk_bf16(p1[4], p1[5]), cvt_pk_bf16(p1[6], p1[7])};
            pw3 = (u32x4){cvt_pk_bf16(p1[8], p1[9]), cvt_pk_bf16(p1[10], p1[11]), cvt_pk_bf16(p1[12], p1[13]), cvt_pk_bf16(p1[14], p1[15])};
            LDS_WAIT(); asm volatile("" ::: "memory");
#pragma unroll
            for (int r = 0; r < 16; ++r) { const float fr_ = wsf[crow(r, hi)]; o0[r] *= fr_; o1[r] *= fr_; }
            const LAS char* vp = sl + 8192 + ((lane >> 4) & 1) * 32 + (lane & 3) * 8 + (4 * hi + ((lane & 15) >> 2)) * 64;
            const bf16x8 pa[4] = {__builtin_bit_cast(bf16x8, pw0), __builtin_bit_cast(bf16x8, pw1), __builtin_bit_cast(bf16x8, pw2), __builtin_bit_cast(bf16x8, pw3)};
#pragma unroll
            for (int ks = 0; ks < 4; ++ks) {
                const s16x4 l0 = vtr(vp + ks * 1024), h0 = vtr(vp + ks * 1024 + 512), l1 = vtr(vp + 4096 + ks * 1024), h1 = vtr(vp + 4096 + ks * 1024 + 512);
                const bf16x8 v0 = (bf16x8){l0[0], l0[1], l0[2], l0[3], h0[0], h0[1], h0[2], h0[3]}, v1 = (bf16x8){l1[0], l1[1], l1[2], l1[3], h1[0], h1[1], h1[2], h1[3]};
                o0 = __builtin_amdgcn_mfma_f32_32x32x16_bf16(pa[ks], v0, o0, 0, 0, 0); o1 = __builtin_amdgcn_mfma_f32_32x32x16_bf16(pa[ks], v1, o1, 0, 0, 0); }
        }
        if (ld) st_kv(jn, kA, vA);
        LBAR();
        kA = kB; vA = vB;
    }
    lrun += __shfl_xor(lrun, 32);
    if (hi == 0) wsf[32 + r32] = lrun;
    LDS_WAIT(); asm volatile("" ::: "memory");
    LAS bf16_t* stg = (LAS bf16_t*)(lds + L_OST) + wid * 2048;
#pragma unroll
    for (int r = 0; r < 16; ++r) { const int orow = crow(r, hi); const float rl = __builtin_amdgcn_rcpf(wsf[32 + orow]);
        stg[orow * 64 + r32] = (bf16_t)(cvt_pk_bf16(o0[r] * rl, 0.f) & 0xffffu); stg[orow * 64 + 32 + r32] = (bf16_t)(cvt_pk_bf16(o1[r] * rl, 0.f) & 0xffffu); }
    LDS_WAIT(); asm volatile("" ::: "memory");
    bf16_t* Ow = Ya + (rowbase + (size_t)ci * 64 + (wid & 1) * 32) * 1024 + h * 64;
#pragma unroll
    for (int i = 0; i < 4; ++i) { const int row = i * 8 + (lane >> 3), ch = lane & 7; const u32x4 v = *(const LAS u32x4*)(stg + row * 64 + ch * 8); *(u32x4*)(Ow + (size_t)row * 1024 + ch * 8) = v; }
    __syncthreads();
}
}

#ifndef TIME_PHASE
#define TIME_PHASE -1
#endif
#define PROF(k) do { if (TIME_PHASE >= 20 && blockIdx.x == 0 && F.tid == 0) { const unsigned now_ = (unsigned)__builtin_amdgcn_s_memrealtime(); F.MISC[16 + (k)] += now_ - F.MISC[15]; F.MISC[15] = now_; } } while (0)
namespace rc {
constexpr int LDB = 72, MB = 64 * LDB * 2;
constexpr int FLD = 68, FB = 64 * FLD * 4;
constexpr int L_AT = 0, L_BH = MB, L_BT = 2 * MB, L_KT = 3 * MB, L_RT = 4 * MB, L_KH = 5 * MB, L_V = 6 * MB;
constexpr int L_TWD = 0, L_AD = 9216, L_SGD = 18432;
constexpr int RB = 8 * MB;
constexpr int L_WL = RB, L_AL = RB + FB, L_GL = RB + 2 * FB, L_SEG = RB + 3 * FB;
constexpr int L_NQ0 = RB, L_NQ1 = RB + MB, L_NT0 = RB + 2 * MB, L_NT1 = RB + 3 * MB, L_TQ0 = RB + 4 * MB, L_TQ1 = RB + 5 * MB, L_NKT = RB + 6 * MB, L_NRB = RB + 7 * MB;
constexpr int L_GLD = RB + 8 * MB;
constexpr int L_W1T = L_NQ0, L_W2T = L_NT0, L_WY = L_AT, L_KC = L_BT;
constexpr int L_TAB = L_GLD + 256;
constexpr int T_MUL = 0, T_MUR = 256, T_PAR = 448, T_N = 832;
static_assert(L_SEG + 2048 <= L_GLD && L_TAB + T_N * 4 <= LDSCTL_OFF, "rwkv chunk LDS");

__device__ __forceinline__ void unpack8(const u32x4 w, float* f) { f[0] = bf_lo(w.x); f[1] = bf_hi(w.x); f[2] = bf_lo(w.y); f[3] = bf_hi(w.y); f[4] = bf_lo(w.z); f[5] = bf_hi(w.z); f[6] = bf_lo(w.w); f[7] = bf_hi(w.w); }
__device__ __forceinline__ f32x16 mm64(f32x16 acc, const LAS char* Arows, const LAS char* Bcols, int lane) {
    const int o = ((lane & 31) * LDB + 8 * (lane >> 5)) * 2;
#pragma unroll
    for (int ks = 0; ks < 4; ++ks) { const bf16x8 a = *(const LAS bf16x8*)(Arows + o + 32 * ks), b = *(const LAS bf16x8*)(Bcols + o + 32 * ks); acc = __builtin_amdgcn_mfma_f32_32x32x16_bf16(a, b, acc, 0, 0, 0); }
    return acc;
}
__device__ __forceinline__ s16x4 trrd(const LAS char* p) { return __builtin_bit_cast(s16x4, __builtin_amdgcn_ds_read_tr16_b64_v4i16((LAS s16x4*)p)); }
__device__ __forceinline__ int tr_off(int lane) { return ((8 * (lane >> 5) + ((lane & 15) >> 2)) * LDB + 16 * ((lane >> 4) & 1) + 4 * (lane & 3)) * 2; }
__device__ __forceinline__ bf16x8 frag_tr(const LAS char* Xb, int ks) {
    const s16x4 lo = trrd(Xb + (16 * ks) * LDB * 2), hi = trrd(Xb + (16 * ks + 4) * LDB * 2);
    return (bf16x8){lo[0], lo[1], lo[2], lo[3], hi[0], hi[1], hi[2], hi[3]};
}
__device__ __forceinline__ f32x16 mm64_btr(f32x16 acc, const LAS char* Arows, const LAS char* X, int nb, int lane) {
    const int o = ((lane & 31) * LDB + 8 * (lane >> 5)) * 2; const LAS char* xb = X + 64 * nb + tr_off(lane);
#pragma unroll
    for (int ks = 0; ks < 4; ++ks) { const bf16x8 a = *(const LAS bf16x8*)(Arows + o + 32 * ks), b = frag_tr(xb, ks); acc = __builtin_amdgcn_mfma_f32_32x32x16_bf16(a, b, acc, 0, 0, 0); }
    return acc;
}
__device__ __forceinline__ f32x16 mm64_atr(f32x16 acc, const LAS char* X, int mb, const LAS char* Bcols, int lane) {
    const int o = ((lane & 31) * LDB + 8 * (lane >> 5)) * 2; const LAS char* xb = X + 64 * mb + tr_off(lane);
#pragma unroll
    for (int ks = 0; ks < 4; ++ks) { const bf16x8 a = frag_tr(xb, ks), b = *(const LAS bf16x8*)(Bcols + o + 32 * ks); acc = __builtin_amdgcn_mfma_f32_32x32x16_bf16(a, b, acc, 0, 0, 0); }
    return acc;
}
__device__ __forceinline__ void store_T(const f32x16& d, LAS char* dst, int mb, int nb, int lane) {
    LAS char* p = dst + ((32 * nb + (lane & 31)) * LDB + 32 * mb + 4 * (lane >> 5)) * 2;
#pragma unroll
    for (int g = 0; g < 4; ++g) { u32x2 w; w.x = cvt_pk_bf16(d[4 * g], d[4 * g + 1]); w.y = cvt_pk_bf16(d[4 * g + 2], d[4 * g + 3]); *(LAS u32x2*)(p + 16 * g) = w; }
}
__device__ __forceinline__ void store_T_g(const f32x16& d, bf16_t* dst, int mb, int nb, int lane) {
    bf16_t* p = dst + (32 * nb + (lane & 31)) * 64 + 32 * mb + 4 * (lane >> 5);
#pragma unroll
    for (int g = 0; g < 4; ++g) { u32x2 w; w.x = cvt_pk_bf16(d[4 * g], d[4 * g + 1]); w.y = cvt_pk_bf16(d[4 * g + 2], d[4 * g + 3]); *(u32x2*)(p + 8 * g) = w; }
}
#define RC_M(r) (32 * mb + 8 * ((r) >> 2) + 4 * hi + ((r) & 3))

struct Raw { u32x4 lc[4], lp[4], rc[3], rp[3]; };
__device__ __forceinline__ void load_raw(Raw& R, const bf16_t* Prw, int u, int t, int cg) {
    const int b = u >> 8, h = (u >> 5) & 7, c = u & 31;
    const size_t row = (size_t)b * SEQ + 64 * c + t; const bool hasprev = (c > 0) || (t > 0);
    const bf16_t* pc = Prw + row * RCOLS; const bf16_t* pp = pc - RCOLS; const int lc0 = 1536 + 32 * cg, hd = h * 64 + 8 * cg;
#pragma unroll
    for (int q = 0; q < 4; ++q) { R.lc[q] = *(const u32x4*)(pc + lc0 + 8 * q); R.lp[q] = hasprev ? *(const u32x4*)(pp + lc0 + 8 * q) : (u32x4){0u, 0u, 0u, 0u}; }
#pragma unroll
    for (int w = 0; w < 3; ++w) { R.rc[w] = *(const u32x4*)(pc + w * 512 + hd); R.rp[w] = hasprev ? *(const u32x4*)(pp + w * 512 + hd) : (u32x4){0u, 0u, 0u, 0u}; }
}
__device__ __forceinline__ void chunk_phase(Frame& F, const Ptrs& P) {
  const bf16_t* Prw = (const bf16_t*)(P.ws + WS_PRW);
  int htab = -1; bf16x8 wA[4]; Raw raw;
  if (TIME_PHASE >= 20 && blockIdx.x == 0 && F.tid == 0) F.MISC[15] = (unsigned)__builtin_amdgcn_s_memrealtime();
  if ((int)blockIdx.x < NB * 8 * 32) load_raw(raw, Prw, (int)blockIdx.x, F.tid >> 3, F.tid & 7);
#pragma unroll 1
  for (int u_ = (int)blockIdx.x; u_ < NB * 8 * 32; u_ += F.G) {
    int tid = F.tid, wid = F.wave; asm volatile("" : "+v"(tid), "+s"(wid));
    const int b = u_ >> 8, h = (u_ >> 5) & 7, c = u_ & 31;
    const int lane = tid & 63, t = tid >> 3, cg = tid & 7, r32 = lane & 31, hi = lane >> 5;
    LAS char* lds = (LAS char*)F.lds;
    const size_t u = (size_t)((b * 8 + h) * 32 + c);
    bf16_t* gQe = (bf16_t*)(P.ws + WS_QE) + u * 4096; bf16_t* gYl = (bf16_t*)(P.ws + WS_YLOC) + u * 4096; bf16_t* gPc = (bf16_t*)(P.ws + WS_PC) + u * 4096; bf16_t* gSl = (bf16_t*)(P.ws + WS_SLOC) + u * 4096;
    bf16_t* gG = (bf16_t*)((unsigned char*)P.out + DO_G) + u * 4096; bf16_t* Yr = (bf16_t*)((unsigned char*)P.out + DO_YRA);
    const int hd = h * 64 + 8 * cg;
    const bool is_ad = (cg == 2 || cg == 3); const float alpha = cg < 2 ? 2.f : 1.f, gamma = cg < 2 ? -1.f : 0.f;
    LAS bf16_t* ldst = (LAS bf16_t*)(lds + (cg < 2 ? L_TWD : (cg < 4 ? L_AD : L_SGD))) + t * (cg < 4 ? 72 : 136) + 32 * (cg < 2 ? cg : (cg < 4 ? cg - 2 : cg - 4));
    const size_t row = (size_t)b * SEQ + 64 * c + t;
    LAS float* tab = (LAS float*)(lds + L_TAB);
    if (h != htab) {
        htab = h;
        for (int i = tid; i < T_N; i += 512) { float v;
            if (i < T_MUR) v = P.in[6][1536 + i]; else if (i < T_PAR) { const int w = (i - T_MUR) >> 6, d = (i - T_MUR) & 63; v = P.in[6][w * 512 + h * 64 + d]; }
            else { const int w = (i - T_PAR) >> 6, d = (i - T_PAR) & 63; const float* src = w == 0 ? P.in[7] : (w == 1 ? P.in[9] : (w == 2 ? P.in[12] : (w == 3 ? P.in[13] : (w == 4 ? P.in[14] : P.in[16])))); v = src[h * 64 + d]; }
            tab[i] = v; }
        const int jb = (wid >> 1) & 1;
        const bf16_t* wa = (const bf16_t*)(P.ws + (wid < 4 ? WS_WUP : WS_AUP)) + (size_t)(h * 64 + jb * 32 + r32) * 64 + 8 * hi;
#pragma unroll
        for (int ks = 0; ks < 4; ++ks) wA[ks] = *(const bf16x8*)(wa + 16 * ks);
        LBAR();
    }
    bf16x8 wG[8];
    { const bf16_t* wg = (const bf16_t*)(P.ws + WS_GUP) + (size_t)(h * 64 + ((wid >> 1) & 1) * 32 + r32) * 128 + 8 * hi;
#pragma unroll
      for (int ks = 0; ks < 8; ++ks) wG[ks] = *(const bf16x8*)(wg + 16 * ks); }
    float rv[8], kv[8], vv[8];
    { float cur[8], prv[8], mu[8];
#pragma unroll
      for (int q = 0; q < 4; ++q) {
          unpack8(raw.lc[q], cur); unpack8(raw.lp[q], prv);
          *(f32x4*)mu = *(const LAS f32x4*)(tab + T_MUL + 32 * cg + 8 * q); *(f32x4*)(mu + 4) = *(const LAS f32x4*)(tab + T_MUL + 32 * cg + 8 * q + 4);
          float o[8];
#pragma unroll
          for (int i = 0; i < 8; ++i) { const float xs = cur[i] + (prv[i] - cur[i]) * mu[i]; const float sg = sigmoidf_(alpha * xs); o[i] = is_ad ? xs : alpha * sg + gamma; }
          u32x4 w; w.x = cvt_pk_bf16(o[0], o[1]); w.y = cvt_pk_bf16(o[2], o[3]); w.z = cvt_pk_bf16(o[4], o[5]); w.w = cvt_pk_bf16(o[6], o[7]);
          *(LAS u32x4*)(ldst + 8 * q) = w; }
#pragma unroll
      for (int which = 0; which < 3; ++which) {
          unpack8(raw.rc[which], cur); unpack8(raw.rp[which], prv);
          *(f32x4*)mu = *(const LAS f32x4*)(tab + T_MUR + which * 64 + 8 * cg); *(f32x4*)(mu + 4) = *(const LAS f32x4*)(tab + T_MUR + which * 64 + 8 * cg + 4);
#pragma unroll
          for (int i = 0; i < 8; ++i) { const float xs = cur[i] + (prv[i] - cur[i]) * mu[i]; if (which == 0) rv[i] = xs; else if (which == 1) kv[i] = xs; else vv[i] = xs; } } }
    LBAR(); PROF(0);
    { const int ib = wid & 1, jb = (wid >> 1) & 1;
      auto wr4 = [&](const f32x16& acc, LAS float* Out) { LAS float* op = Out + (ib * 32 + r32) * FLD + jb * 32 + 4 * hi;
#pragma unroll
          for (int g = 0; g < 4; ++g) *(LAS f32x4*)(op + 8 * g) = (f32x4){acc[4 * g], acc[4 * g + 1], acc[4 * g + 2], acc[4 * g + 3]}; };
      { f32x16 acc = {}; const LAS bf16_t* qp = (const LAS bf16_t*)(lds + (wid < 4 ? L_TWD : L_AD)) + (ib * 32 + r32) * 72 + 8 * hi;
#pragma unroll
        for (int ks = 0; ks < 4; ++ks) acc = __builtin_amdgcn_mfma_f32_32x32x16_bf16(wA[ks], *(const LAS bf16x8*)(qp + 16 * ks), acc, 0, 0, 0);
        wr4(acc, (LAS float*)(lds + (wid < 4 ? L_WL : L_AL))); }
      if (wid < 4) { f32x16 acc = {}; const LAS bf16_t* qp = (const LAS bf16_t*)(lds + L_SGD) + (ib * 32 + r32) * 136 + 8 * hi;
#pragma unroll
        for (int ks = 0; ks < 8; ++ks) acc = __builtin_amdgcn_mfma_f32_32x32x16_bf16(wG[ks], *(const LAS bf16x8*)(qp + 16 * ks), acc, 0, 0, 0);
        wr4(acc, (LAS float*)(lds + L_GL)); } }
    LBAR(); PROF(1);
    float lam[8], av[8], bv[8], kp[8];
    const int o68 = t * FLD + 8 * cg;
    { float wl[8], al[8], gv[8];
      *(f32x4*)wl = *(LAS f32x4*)(lds + L_WL + 4 * o68); *(f32x4*)(wl + 4) = *(LAS f32x4*)(lds + L_WL + 4 * o68 + 16);
      *(f32x4*)al = *(LAS f32x4*)(lds + L_AL + 4 * o68); *(f32x4*)(al + 4) = *(LAS f32x4*)(lds + L_AL + 4 * o68 + 16);
      *(f32x4*)gv = *(LAS f32x4*)(lds + L_GL + 4 * o68); *(f32x4*)(gv + 4) = *(LAS f32x4*)(lds + L_GL + 4 * o68 + 16);
      float w0[8], a0[8], kk_[8], ka[8], rk[8], lb[8];
      { const LAS float* tp = tab + T_PAR + 8 * cg;
        *(f32x4*)w0 = *(const LAS f32x4*)(tp); *(f32x4*)(w0 + 4) = *(const LAS f32x4*)(tp + 4);
        *(f32x4*)a0 = *(const LAS f32x4*)(tp + 64); *(f32x4*)(a0 + 4) = *(const LAS f32x4*)(tp + 68);
        *(f32x4*)kk_ = *(const LAS f32x4*)(tp + 128); *(f32x4*)(kk_ + 4) = *(const LAS f32x4*)(tp + 132);
        *(f32x4*)ka = *(const LAS f32x4*)(tp + 192); *(f32x4*)(ka + 4) = *(const LAS f32x4*)(tp + 196);
        *(f32x4*)rk = *(const LAS f32x4*)(tp + 256); *(f32x4*)(rk + 4) = *(const LAS f32x4*)(tp + 260);
        *(f32x4*)lb = *(const LAS f32x4*)(tp + 320); *(f32x4*)(lb + 4) = *(const LAS f32x4*)(tp + 324); }
      float asg[8], kkv[8], c2[8]; float ss = 0.f, bon = 0.f;
#pragma unroll
      for (int i = 0; i < 8; ++i) { lam[i] = 0.60653065971f * sigmoidf_(w0[i] + wl[i]); asg[i] = sigmoidf_(a0[i] + al[i]);
          kkv[i] = kv[i] * kk_[i]; ss += kkv[i] * kkv[i]; kp[i] = kv[i] * (1.f + (asg[i] - 1.f) * ka[i]); bon += rv[i] * kp[i] * rk[i]; }
      ss = red8(ss); bon = red8(bon);
      const float inv = 1.f / fmaxf(sqrtf(ss), 1e-12f);
#pragma unroll
      for (int i = 0; i < 8; ++i) { const float kn = kkv[i] * inv; av[i] = -kn; bv[i] = kn * asg[i]; c2[i] = (lb[i] + bon * vv[i]) * gv[i]; }
      u32x4 w; w.x = cvt_pk_bf16(gv[0], gv[1]); w.y = cvt_pk_bf16(gv[2], gv[3]); w.z = cvt_pk_bf16(gv[4], gv[5]); w.w = cvt_pk_bf16(gv[6], gv[7]);
      *(u32x4*)(gG + t * 64 + 8 * cg) = w;
      w.x = cvt_pk_bf16(c2[0], c2[1]); w.y = cvt_pk_bf16(c2[2], c2[3]); w.z = cvt_pk_bf16(c2[4], c2[5]); w.w = cvt_pk_bf16(c2[6], c2[7]);
      *(u32x4*)(Yr + row * 1024 + hd) = w; }
    float cum[8];
    { const int tl = lane >> 3;
#pragma unroll
      for (int i = 0; i < 8; ++i) { float x = lam[i];
          float y = __shfl_up(x, 8); x += (tl >= 1) ? y : 0.f; y = __shfl_up(x, 16); x += (tl >= 2) ? y : 0.f; y = __shfl_up(x, 32); x += (tl >= 4) ? y : 0.f;
          cum[i] = x; }
      if (tl == 7) { *(LAS f32x4*)(lds + L_SEG + (wid * 64 + 8 * cg) * 4) = *(f32x4*)cum; *(LAS f32x4*)(lds + L_SEG + (wid * 64 + 8 * cg) * 4 + 16) = *(f32x4*)(cum + 4); } }
    LBAR(); PROF(2);
    { float pre[8], tot[8];
#pragma unroll
      for (int i = 0; i < 8; ++i) { pre[i] = 0.f; tot[i] = 0.f; }
      const int myseg = t >> 3;
#pragma unroll
      for (int s = 0; s < 8; ++s) { float sv[8]; *(f32x4*)sv = *(LAS f32x4*)(lds + L_SEG + (s * 64 + 8 * cg) * 4); *(f32x4*)(sv + 4) = *(LAS f32x4*)(lds + L_SEG + (s * 64 + 8 * cg) * 4 + 16);
#pragma unroll
          for (int i = 0; i < 8; ++i) { tot[i] += sv[i]; pre[i] += (s < myseg) ? sv[i] : 0.f; } }
      float at_[8], bt_[8], kt_[8], rt_[8], bh_[8], kh_[8];
#pragma unroll
      for (int i = 0; i < 8; ++i) { const float cm = cum[i] + pre[i];
          const float gi = __builtin_amdgcn_exp2f(cm * LOG2E), g_ = __builtin_amdgcn_exp2f(-cm * LOG2E), gm1 = __builtin_amdgcn_exp2f(-(cm - lam[i]) * LOG2E), glg = __builtin_amdgcn_exp2f(-(tot[i] - cm) * LOG2E);
          at_[i] = av[i] * gm1; bt_[i] = bv[i] * gi; kt_[i] = kp[i] * gi; rt_[i] = rv[i] * g_; bh_[i] = bv[i] * glg; kh_[i] = kp[i] * glg; }
      if (t == 0) { float gl[8];
#pragma unroll
          for (int i = 0; i < 8; ++i) gl[i] = __builtin_amdgcn_exp2f(-tot[i] * LOG2E);
          *(LAS f32x4*)(lds + L_GLD + 32 * cg) = *(f32x4*)gl; *(LAS f32x4*)(lds + L_GLD + 32 * cg + 16) = *(f32x4*)(gl + 4); }
      const int ob = (t * LDB + 8 * cg) * 2; u32x4 w;
      w.x = cvt_pk_bf16(at_[0], at_[1]); w.y = cvt_pk_bf16(at_[2], at_[3]); w.z = cvt_pk_bf16(at_[4], at_[5]); w.w = cvt_pk_bf16(at_[6], at_[7]); *(LAS u32x4*)(lds + L_AT + ob) = w;
      w.x = cvt_pk_bf16(bt_[0], bt_[1]); w.y = cvt_pk_bf16(bt_[2], bt_[3]); w.z = cvt_pk_bf16(bt_[4], bt_[5]); w.w = cvt_pk_bf16(bt_[6], bt_[7]); *(LAS u32x4*)(lds + L_BT + ob) = w;
      w.x = cvt_pk_bf16(kt_[0], kt_[1]); w.y = cvt_pk_bf16(kt_[2], kt_[3]); w.z = cvt_pk_bf16(kt_[4], kt_[5]); w.w = cvt_pk_bf16(kt_[6], kt_[7]); *(LAS u32x4*)(lds + L_KT + ob) = w;
      w.x = cvt_pk_bf16(rt_[0], rt_[1]); w.y = cvt_pk_bf16(rt_[2], rt_[3]); w.z = cvt_pk_bf16(rt_[4], rt_[5]); w.w = cvt_pk_bf16(rt_[6], rt_[7]); *(LAS u32x4*)(lds + L_RT + ob) = w;
      w.x = cvt_pk_bf16(bh_[0], bh_[1]); w.y = cvt_pk_bf16(bh_[2], bh_[3]); w.z = cvt_pk_bf16(bh_[4], bh_[5]); w.w = cvt_pk_bf16(bh_[6], bh_[7]); *(LAS u32x4*)(lds + L_BH + ob) = w;
      w.x = cvt_pk_bf16(kh_[0], kh_[1]); w.y = cvt_pk_bf16(kh_[2], kh_[3]); w.z = cvt_pk_bf16(kh_[4], kh_[5]); w.w = cvt_pk_bf16(kh_[6], kh_[7]); *(LAS u32x4*)(lds + L_KH + ob) = w;
      w.x = cvt_pk_bf16(vv[0], vv[1]); w.y = cvt_pk_bf16(vv[2], vv[3]); w.z = cvt_pk_bf16(vv[4], vv[5]); w.w = cvt_pk_bf16(vv[6], vv[7]); *(LAS u32x4*)(lds + L_V + ob) = w; }
    LBAR(); PROF(4);
    load_raw(raw, Prw, (u_ + F.G < NB * 8 * 32) ? u_ + F.G : u_, t, cg);
    {
    wid = __builtin_amdgcn_readfirstlane(wid); asm volatile("" : "+v"(tid), "+s"(wid));
    const int lane = tid & 63, r32 = lane & 31, hi = lane >> 5;
    const int mb = wid & 1, nb = (wid >> 1) & 1, grp = wid >> 2;
    const int ao = 32 * mb * LDB * 2, bo = 32 * nb * LDB * 2;
    const int ncol = 32 * nb + r32;
    f32x16 accT = {};
    {
        f32x16 d = {};
        if (grp == 0) { d = mm64(d, lds + L_AT + ao, lds + L_BT + bo, lane);
#pragma unroll
            for (int r = 0; r < 16; ++r) d[r] = (ncol < RC_M(r)) ? d[r] : 0.f;
            store_T(d, lds + L_NT0, mb, nb, lane); }
        else { d = mm64(d, lds + L_BT + ao, lds + L_AT + bo, lane);
#pragma unroll
            for (int r = 0; r < 16; ++r) { d[r] = (RC_M(r) < ncol) ? d[r] : 0.f; accT[r] = d[r] + ((RC_M(r) == ncol) ? 1.f : 0.f); }
            store_T(d, lds + L_NQ0, mb, nb, lane); store_T(accT, lds + L_TQ0, mb, nb, lane); }
        f32x16 e = {};
        if (grp == 0) { e = mm64(e, lds + L_AT + ao, lds + L_KT + bo, lane);
#pragma unroll
            for (int r = 0; r < 16; ++r) e[r] = (ncol < RC_M(r)) ? e[r] : 0.f;
            store_T(e, lds + L_NKT, mb, nb, lane); }
        else { e = mm64(e, lds + L_BT + ao, lds + L_RT + bo, lane);
#pragma unroll
            for (int r = 0; r < 16; ++r) e[r] = (RC_M(r) <= ncol) ? e[r] : 0.f;
            store_T(e, lds + L_NRB, mb, nb, lane); }
    }
    LBAR(); PROF(5);
#pragma unroll
    for (int j = 1; j <= 5; ++j) { const int cur = (j - 1) & 1, nw = j & 1;
        const int nq_c = cur ? L_NQ1 : L_NQ0, nt_c = cur ? L_NT1 : L_NT0, nq_n = nw ? L_NQ1 : L_NQ0, nt_n = nw ? L_NT1 : L_NT0;
        if (grp == 0) { f32x16 d = {};
            d = mm64(d, lds + nt_c + ao, lds + nq_c + bo, lane); store_T(d, lds + nq_n, mb, nb, lane);
            f32x16 e = {};
            e = mm64(e, lds + nq_c + ao, lds + nt_c + bo, lane); store_T(e, lds + nt_n, mb, nb, lane); }
        else if (j >= 2) { const int tq_r = nw ? L_TQ1 : L_TQ0, tq_w = cur ? L_TQ1 : L_TQ0;
            accT = mm64(accT, lds + nt_c + ao, lds + tq_r + bo, lane); store_T(accT, lds + tq_w, mb, nb, lane); }
        LBAR();
    }
    if (grp == 1) { accT = mm64(accT, lds + L_NT1 + ao, lds + L_TQ0 + bo, lane); store_T(accT, lds + L_TQ1, mb, nb, lane); }
    LBAR(); PROF(6);
    { f32x16 d = {};
      if (grp == 0) { d = mm64_btr(d, lds + L_TQ1 + ao, lds + L_AT, nb, lane); store_T(d, lds + L_W1T, mb, nb, lane); }
      else { d = mm64(d, lds + L_TQ1 + ao, lds + L_NKT + bo, lane); store_T(d, lds + L_W2T, mb, nb, lane); } }
    LBAR(); PROF(7);
    if (grp == 0) {
        f32x16 d = {}; d = mm64(d, lds + L_W1T + ao, lds + L_NRB + bo, lane);
#pragma unroll
        for (int g = 0; g < 4; ++g) { const u32x2 rw = *(const LAS u32x2*)(lds + L_RT + ((32 * nb + r32) * LDB + 32 * mb + 8 * g + 4 * hi) * 2);
            d[4 * g] += bf_lo(rw.x); d[4 * g + 1] += bf_hi(rw.x); d[4 * g + 2] += bf_lo(rw.y); d[4 * g + 3] += bf_hi(rw.y); }
        store_T_g(d, gQe, mb, nb, lane);
        f32x16 p = {}; p = mm64_btr(p, lds + L_W1T + ao, lds + L_BH, nb, lane);
        const float gl = ((const LAS float*)(lds + L_GLD))[ncol];
#pragma unroll
        for (int r = 0; r < 16; ++r) p[r] += (RC_M(r) == ncol) ? gl : 0.f;
        store_T_g(p, gPc, mb, nb, lane);
    } else {
        f32x16 d = {}; d = mm64(d, lds + L_KT + ao, lds + L_RT + bo, lane); d = mm64(d, lds + L_W2T + ao, lds + L_NRB + bo, lane);
#pragma unroll
        for (int r = 0; r < 16; ++r) d[r] = (RC_M(r) <= ncol) ? d[r] : 0.f;
        f32x16 k = {}; k = mm64_btr(k, lds + L_W2T + ao, lds + L_BH, nb, lane);
        { const LAS char* kb = lds + L_KH + 64 * nb + ((32 * mb + 4 * hi + ((lane & 15) >> 2)) * LDB + 16 * ((lane >> 4) & 1) + 4 * (lane & 3)) * 2;
#pragma unroll
          for (int g = 0; g < 4; ++g) { const s16x4 kw = trrd(kb + 8 * g * LDB * 2);
              k[4 * g] += bf_lo((unsigned)(unsigned short)kw[0]); k[4 * g + 1] += bf_lo((unsigned)(unsigned short)kw[1]); k[4 * g + 2] += bf_lo((unsigned)(unsigned short)kw[2]); k[4 * g + 3] += bf_lo((unsigned)(unsigned short)kw[3]); } }
        store_T(d, lds + L_WY, mb, nb, lane); store_T(k, lds + L_KC, mb, nb, lane);
    }
    LBAR(); PROF(8);
    { f32x16 d = {};
      if (grp == 0) { d = mm64_atr(d, lds + L_V, mb, lds + L_WY + bo, lane); store_T_g(d, gYl, mb, nb, lane); }
      else { d = mm64_btr(d, lds + L_KC + ao, lds + L_V, nb, lane); store_T_g(d, gSl, mb, nb, lane); } }
    LBAR(); PROF(9);
    }
  }
}

__device__ __forceinline__ void state_chain(Frame& F, const Ptrs& P, int bh) {
    const int tid = F.tid, lane = F.lane, wid = F.wave, r32 = lane & 31, hi = lane >> 5;
    LAS char* lds = (LAS char*)F.lds;
    const bf16_t* gPc = (const bf16_t*)(P.ws + WS_PC) + (size_t)bh * 32 * 4096; const bf16_t* gSl = (const bf16_t*)(P.ws + WS_SLOC) + (size_t)bh * 32 * 4096;
    bf16_t* gS = (bf16_t*)((unsigned char*)P.out + DO_SC) + (size_t)bh * 32 * 4096;
    constexpr int L_S0 = 0, L_S1 = MB, L_P = 2 * MB;
    for (int i = tid; i < MB / 4; i += 512) ((LAS unsigned*)(lds + L_S0))[i] = 0u;
    const int prow = tid >> 3, pch = tid & 7;
    u32x4 pw = *(const u32x4*)(gPc + prow * 64 + pch * 8);
    const int mb = wid & 1, nb = (wid >> 1) & 1;
    __syncthreads();
#pragma unroll 1
    for (int c = 0; c < 32; ++c) {
        const int sc = (c & 1) ? L_S1 : L_S0, sn = (c & 1) ? L_S0 : L_S1;
        *(LAS u32x4*)(lds + L_P + (prow * LDB + pch * 8) * 2) = pw;
        *(u32x4*)(gS + (size_t)c * 4096 + prow * 64 + pch * 8) = *(const LAS u32x4*)(lds + sc + (prow * LDB + pch * 8) * 2);
        if (c + 1 < 32) pw = *(const u32x4*)(gPc + (size_t)(c + 1) * 4096 + prow * 64 + pch * 8);
        f32x16 d = {};
        if (wid < 4) {
            const bf16_t* sp = gSl + (size_t)c * 4096 + (32 * nb + r32) * 64 + 32 * mb + 4 * hi;
#pragma unroll
            for (int g = 0; g < 4; ++g) { const u32x2 w = *(const u32x2*)(sp + 8 * g); d[4 * g] = bf_lo(w.x); d[4 * g + 1] = bf_hi(w.x); d[4 * g + 2] = bf_lo(w.y); d[4 * g + 3] = bf_hi(w.y); } }
        __syncthreads();
        if (wid < 4) { d = mm64(d, lds + L_P + 32 * mb * LDB * 2, lds + sc + 32 * nb * LDB * 2, lane); store_T(d, lds + sn, mb, nb, lane); }
        __syncthreads();
    }
}

__device__ __forceinline__ void out_unit(Frame& F, const Ptrs& P, int u, int nb, bool do_store = true) {
    const int lane = F.lane, r32 = lane & 31, hi = lane >> 5;
    const bf16_t* gQe = (const bf16_t*)(P.ws + WS_QE) + (size_t)u * 4096; const bf16_t* gYl = (const bf16_t*)(P.ws + WS_YLOC) + (size_t)u * 4096;
    const bf16_t* gS = (const bf16_t*)((unsigned char*)P.out + DO_SC) + (size_t)u * 4096; const bf16_t* gG = (const bf16_t*)((unsigned char*)P.out + DO_G) + (size_t)u * 4096;
    bf16_t* Yr = (bf16_t*)((unsigned char*)P.out + DO_YRA);
    const int bh = u >> 5, c = u & 31, h = bh & 7, b = bh >> 3;
    f32x16 y0 = {}, y1 = {};
#pragma unroll
    for (int ks = 0; ks < 4; ++ks) { const bf16x8 q = *(const bf16x8*)(gQe + (32 * nb + r32) * 64 + 16 * ks + 8 * hi);
        const bf16x8 s0 = *(const bf16x8*)(gS + r32 * 64 + 16 * ks + 8 * hi), s1 = *(const bf16x8*)(gS + (32 + r32) * 64 + 16 * ks + 8 * hi);
        y0 = __builtin_amdgcn_mfma_f32_32x32x16_bf16(s0, q, y0, 0, 0, 0); y1 = __builtin_amdgcn_mfma_f32_32x32x16_bf16(s1, q, y1, 0, 0, 0); }
    const int tl = 32 * nb + r32;
    const bf16_t* yl = gYl + tl * 64 + 4 * hi;
    float s = 0.f;
#pragma unroll
    for (int g = 0; g < 4; ++g) { const u32x2 a = *(const u32x2*)(yl + 8 * g), bq = *(const u32x2*)(yl + 32 + 8 * g);
        y0[4 * g] += bf_lo(a.x); y0[4 * g + 1] += bf_hi(a.x); y0[4 * g + 2] += bf_lo(a.y); y0[4 * g + 3] += bf_hi(a.y);
        y1[4 * g] += bf_lo(bq.x); y1[4 * g + 1] += bf_hi(bq.x); y1[4 * g + 2] += bf_lo(bq.y); y1[4 * g + 3] += bf_hi(bq.y); }
#pragma unroll
    for (int r = 0; r < 16; ++r) s += y0[r] + y1[r];
    s += __shfl_xor(s, 32); const float mean = s * (1.f / 64.f); float q2 = 0.f;
#pragma unroll
    for (int r = 0; r < 16; ++r) { y0[r] -= mean; y1[r] -= mean; q2 += y0[r] * y0[r] + y1[r] * y1[r]; }
    q2 += __shfl_xor(q2, 32); const float rstd = 1.f / sqrtf(q2 * (1.f / 64.f) + 64e-5f);
    const size_t row = (size_t)b * SEQ + 64 * c + tl;
    bf16_t* yo = Yr + row * 1024 + h * 64 + 4 * hi; const bf16_t* gg = gG + tl * 64 + 4 * hi; const float* lg = P.in[15] + h * 64 + 4 * hi;
#pragma unroll
    for (int g = 0; g < 4; ++g) {
#pragma unroll
        for (int eb = 0; eb < 2; ++eb) { const int eo = 32 * eb + 8 * g; const u32x2 gw = *(const u32x2*)(gg + eo), cw = *(const u32x2*)(yo + eo); const f32x4 l4 = *(const f32x4*)(lg + eo);
            const f32x16& y = eb ? y1 : y0;
#ifdef DIAG_NOY
            const float rstd_ = 0.f;
#else
            const float rstd_ = rstd;
#endif
            const float o0 = y[4 * g] * rstd_ * l4.x * bf_lo(gw.x) + bf_lo(cw.x), o1 = y[4 * g + 1] * rstd_ * l4.y * bf_hi(gw.x) + bf_hi(cw.x), o2 = y[4 * g + 2] * rstd_ * l4.z * bf_lo(gw.y) + bf_lo(cw.y), o3 = y[4 * g + 3] * rstd_ * l4.w * bf_hi(gw.y) + bf_hi(cw.y);
            u32x2 w; w.x = cvt_pk_bf16(o0, o1); w.y = cvt_pk_bf16(o2, o3);
#ifdef DIAG_ZERO
            w.x = 0u; w.y = 0u;
#endif
#ifdef DIAG_C2ONLY
            w = cw;
#endif
            if (do_store) *(u32x2*)(yo + eo) = w; } }
}
#undef RC_M
}
__device__ __forceinline__ void phase_route(Frame& F, const Ptrs& P) {
    const int lane = F.lane, gw = F.vcu * NWAVES + F.wave, NGW = F.G * NWAVES;
    const float* x1 = P.in[0]; const bf16_t* Dl = (const bf16_t*)(P.ws + WS_DELTA); const float* mod = (const float*)(P.ws + WS_MOD);
    const float* gam2 = (const float*)(P.ws + WS_GAM2); const float* cb = (const float*)(P.ws + WS_CB);
    const bf16_t* wrh = (const bf16_t*)(P.ws + WS_WRH); const bf16_t* wrl = (const bf16_t*)(P.ws + WS_WRL);
    bf16_t* H2 = (bf16_t*)(P.ws + WS_H2);
    int* tok_list = (int*)(P.ws + WS_TOKLIST); int* tok_pos = (int*)(P.ws + WS_TOKPOS); int* slot_tok = (int*)(P.ws + WS_SLOTTOK); float* slot_w = (float*)(P.ws + WS_SLOTW);
    unsigned* cnt = (unsigned*)(F.ctl + CW_CNT);
    LAS float* scr = (LAS float*)(F.lds) + F.wave * (16 * 52);
    const int fr = lane & 15, kq = lane >> 4;
    LAS unsigned* lcnt = (LAS unsigned*)(F.lds + 32768); LAS unsigned* lbase = lcnt + 64;
    for (int rnd = F.vcu; rnd < NTOK / 128; rnd += F.G) {
        if (F.tid < NLIST) lcnt[F.tid] = 0u;
        __syncthreads();
        const int R0 = rnd * 128 + F.wave * 16, b = R0 / SEQ;
        const float* xr = x1 + (size_t)(R0 + fr) * DM + 8 * kq; const bf16_t* dr = Dl + (size_t)(R0 + fr) * DM + 8 * kq; const float* gp = gam2 + (size_t)b * DM + 8 * kq;
        const bf16_t* bh = wrh + (size_t)fr * DM + 8 * kq; const bf16_t* bl = wrl + (size_t)fr * DM + 8 * kq;
        f32x4 acc[3] = {{0.f, 0.f, 0.f, 0.f}, {0.f, 0.f, 0.f, 0.f}, {0.f, 0.f, 0.f, 0.f}}; float ssq = 0.f;
#pragma unroll 2
        for (int k0 = 0; k0 < DM; k0 += 32) {
            f32x4 xa = *(const f32x4*)(xr + k0), xb = *(const f32x4*)(xr + k0 + 4); const f32x4 ga = *(const f32x4*)(gp + k0), gb = *(const f32x4*)(gp + k0 + 4);
            { const u32x4 dw = *(const u32x4*)(dr + k0); xa.x += bf_lo(dw.x); xa.y += bf_hi(dw.x); xa.z += bf_lo(dw.y); xa.w += bf_hi(dw.y); xb.x += bf_lo(dw.z); xb.y += bf_hi(dw.z); xb.z += bf_lo(dw.w); xb.w += bf_hi(dw.w); }
            ssq += (xa.x * xa.x + xa.y * xa.y) + (xa.z * xa.z + xa.w * xa.w) + (xb.x * xb.x + xb.y * xb.y) + (xb.z * xb.z + xb.w * xb.w);
            const f32x4 ya = xa * ga, yb = xb * gb;
            u32x4 hw; hw.x = cvt_pk_bf16(ya.x, ya.y); hw.y = cvt_pk_bf16(ya.z, ya.w); hw.z = cvt_pk_bf16(yb.x, yb.y); hw.w = cvt_pk_bf16(yb.z, yb.w);
            u32x4 lw; lw.x = cvt_pk_bf16(ya.x - bf_lo(hw.x), ya.y - bf_hi(hw.x)); lw.y = cvt_pk_bf16(ya.z - bf_lo(hw.y), ya.w - bf_hi(hw.y));
            lw.z = cvt_pk_bf16(yb.x - bf_lo(hw.z), yb.y - bf_hi(hw.z)); lw.w = cvt_pk_bf16(yb.z - bf_lo(hw.w), yb.w - bf_hi(hw.w));
            const bf16x8 ah = __builtin_bit_cast(bf16x8, hw), al = __builtin_bit_cast(bf16x8, lw);
#pragma unroll
            for (int nb = 0; nb < 3; ++nb) { const bf16x8 wh = *(const bf16x8*)(bh + (size_t)nb * 16 * DM + k0), wl = *(const bf16x8*)(bl + (size_t)nb * 16 * DM + k0);
                acc[nb] = __builtin_amdgcn_mfma_f32_16x16x32_bf16(ah, wh, acc[nb], 0, 0, 0); acc[nb] = __builtin_amdgcn_mfma_f32_16x16x32_bf16(al, wh, acc[nb], 0, 0, 0); acc[nb] = __builtin_amdgcn_mfma_f32_16x16x32_bf16(ah, wl, acc[nb], 0, 0, 0); }
        }
        ssq += __shfl_xor(ssq, 16); ssq += __shfl_xor(ssq, 32);
        const float rinv = 1.f / sqrtf(ssq * (1.f / DM) + 1e-6f);
#pragma unroll
        for (int nb = 0; nb < 3; ++nb)
#pragma unroll
            for (int j = 0; j < 4; ++j) scr[(4 * kq + j) * 52 + 16 * nb + fr] = acc[nb][j];
        LDS_WAIT(); asm volatile("" ::: "memory");
        int l1 = 0, l2 = 0, q1 = 0, q2 = 0; float w1 = 0.f, w2 = 0.f;
        if (lane < 16) {
            const float* cbb = cb + b * 64; const LAS float* lr = scr + lane * 52;
            float lc[4]; int grp = 0; float best = -3.4e38f;
#pragma unroll
            for (int o = 0; o < 4; ++o) { lc[o] = rinv * lr[o] + cbb[o]; if (lc[o] > best) { best = lc[o]; grp = o; } }
            float den = 0.f;
#pragma unroll
            for (int o = 0; o < 4; ++o) den += __expf(lc[o] - best);
            const float pgrp = 1.f / den;
            float f1 = -3.4e38f, f2 = -3.4e38f; int i1 = 0, i2 = 0;
            for (int o = 0; o < 8; ++o) { const float v = rinv * lr[4 + grp * 8 + o] + cbb[4 + grp * 8 + o];
                if (v > f1) { f2 = f1; i2 = i1; f1 = v; i1 = o; } else if (v > f2) { f2 = v; i2 = o; } }
            const float e2 = __expf(f2 - f1); w1 = pgrp / (1.f + e2); w2 = pgrp * e2 / (1.f + e2);
            l1 = (grp * 8 + i1) * 2; l2 = (grp * 8 + i2) * 2 + 1;
            q1 = (int)__hip_atomic_fetch_add(lcnt + l1, 1u, __ATOMIC_RELAXED, __HIP_MEMORY_SCOPE_WORKGROUP); q2 = (int)__hip_atomic_fetch_add(lcnt + l2, 1u, __ATOMIC_RELAXED, __HIP_MEMORY_SCOPE_WORKGROUP);
        }
        __syncthreads();
        if (F.tid < NLIST) { const unsigned c = ((LAS unsigned*)lcnt)[F.tid]; lbase[F.tid] = c ? atomicAdd(cnt + 64 * F.tid, c) : 0u; }
        __syncthreads();
        if (lane < 16) { const int tok = R0 + lane;
            const int p1 = (int)lbase[l1] + q1, p2 = (int)lbase[l2] + q2;
            tok_list[2 * tok] = l1; tok_list[2 * tok + 1] = l2; tok_pos[2 * tok] = p1; tok_pos[2 * tok + 1] = p2;
            slot_tok[(size_t)l1 * NTOK + p1] = tok; slot_tok[(size_t)l2 * NTOK + p2] = tok; slot_w[(size_t)l1 * NTOK + p1] = w1; slot_w[(size_t)l2 * NTOK + p2] = w2; }
        const float* sh = mod + (size_t)b * MODW + 3 * DM;
#pragma unroll 4
        for (int r = 0; r < 16; ++r) { const float ri = __shfl(rinv, r);
            const GAS f32x4* xrow = (const GAS f32x4*)(x1 + (size_t)(R0 + r) * DM) + lane; const GAS u32x2* drow = (const GAS u32x2*)(Dl + (size_t)(R0 + r) * DM) + lane; GAS u32x2* o8 = (GAS u32x2*)(H2 + (size_t)(R0 + r) * DM) + lane;
#pragma unroll
            for (int j = 0; j < 4; ++j) { const int k = 4 * lane + 256 * j; f32x4 xv = xrow[64 * j]; const u32x2 dw = drow[64 * j]; xv.x += bf_lo(dw.x); xv.y += bf_hi(dw.x); xv.z += bf_lo(dw.y); xv.w += bf_hi(dw.y); const f32x4 g = *(const f32x4*)(gam2 + (size_t)b * DM + k), s = *(const f32x4*)(sh + k);
                const f32x4 hv = xv * ri * g + s; u32x2 w; w.x = cvt_pk_bf16(hv.x, hv.y); w.y = cvt_pk_bf16(hv.z, hv.w); o8[64 * j] = w; } }
        LDS_WAIT(); asm volatile("" ::: "memory");
    }
}
__device__ __forceinline__ void moe_offsets(Frame& F) {
    LAS int* toff = (LAS int*)(F.lds + TOFF_OFF); LAS int* lcnt = (LAS int*)(F.lds + LCNT_OFF); LAS unsigned char* tile_l = (LAS unsigned char*)(F.lds + TILE_L_OFF);
    if (F.tid < NLIST) lcnt[F.tid] = (int)__hip_atomic_load(F.ctl + CW_CNT + 64 * F.tid, RLX_AGENT);
    __syncthreads();
    if (F.tid == 0) { int acc = 0;
#pragma unroll 1
        for (int l = 0; l < NLIST; ++l) { toff[l] = acc; acc += (lcnt[l] + 255) >> 8; } toff[NLIST] = acc; }
    __syncthreads();
    if (F.tid < NLIST) { for (int t = toff[F.tid]; t < toff[F.tid + 1]; ++t) tile_l[t] = (unsigned char)F.tid; }
    __syncthreads();
}
#ifndef MK_ONE_LAUNCH
#define MK_ONE_LAUNCH 1
#endif
constexpr int N_PHASES = 12;

__global__ void __launch_bounds__(NWAVES * 64, 2) fwd_kernel(Args args) {
    extern __shared__ __attribute__((aligned(16))) unsigned char lds_raw[];
    Frame F; F.lds = (LAS unsigned char*)lds_raw; F.MISC = (volatile LAS unsigned*)(F.lds + MISC_OFF);
    F.tid = threadIdx.x; F.lane = F.tid & 63; F.wave = __builtin_amdgcn_readfirstlane(F.tid >> 6);
    F.G = gridDim.x; { const int bx = blockIdx.x; F.vcu = (F.G % 8 == 0) ? (bx % 8) * (F.G / 8) + bx / 8 : bx; }
#ifndef DUP_PHASE
#define DUP_PHASE -1
#endif
#define RELOAD_ARGS() Ptrs P; { int z_ = 0; asm volatile("" : "+s"(z_)); _Pragma("unroll") for (int i_ = 0; i_ < 31; ++i_) P.in[i_] = args.in[i_] + z_; P.out = args.out + z_; P.ws = args.ws + z_; }
    F.ctl = (gu32*)(args.ws + WS_CTL);
    for (int u = F.tid; u < (LDS_BYTES - LDSCTL_OFF) / 4; u += NWAVES * 64) ((LAS unsigned*)(F.lds + LDSCTL_OFF))[u] = 0u;
    __syncthreads();
    XcdBarrier bar; bar.bar = (unsigned*)(F.ctl + CW_BAR); bar.x = 0; bar.st = nullptr;
#if MK_ONE_LAUNCH
    bar = xcd_barrier_post((unsigned*)(F.ctl + CW_BAR), F.MISC + 8);
#define GRID_BAR() xcd_barrier(bar)
#else
#define GRID_BAR() do { } while (0)
#endif
    const int lo = args.ph_lo, hi = args.ph_hi;
#ifndef PH_MASK
#define PH_MASK 0xfff
#endif
#define IN(k) ((((PH_MASK) >> (k)) & 1) && lo <= (k) && (k) < hi)
#ifndef TIME_PHASE
#define TIME_PHASE -1
#endif
#define STAMP(i) do { if (TIME_PHASE >= 0 && blockIdx.x == 0 && F.tid == 0) ((unsigned long long*)(args.ws + WS_CTL + 768 * KiB))[i] = __builtin_amdgcn_s_memrealtime(); } while (0)
#define SEAM(k) do { if (IN(k) && IN((k) + 1)) GRID_BAR(); STAMP((k) + 1); } while (0)
    STAMP(0);
#define MODP ((float*)(P.ws + WS_MOD))
#define PGATE ((bf16_t*)(P.ws + WS_PGATE))

    if (IN(0)) for (int rep_ = 0; rep_ < ((0) == DUP_PHASE ? 2 : 1); ++rep_) { if (rep_) GRID_BAR(); RELOAD_ARGS(); phase_mod(F, P.in[1], P.in[2], P.in[3], MODP); } SEAM(0);
    if (IN(1)) for (int rep_ = 0; rep_ < ((1) == DUP_PHASE ? 2 : 1); ++rep_) { if (rep_) GRID_BAR(); RELOAD_ARGS(); phase_prep(F, P); } SEAM(1);
    if (IN(2)) for (int rep_ = 0; rep_ < ((2) == DUP_PHASE ? 2 : 1); ++rep_) { if (rep_) GRID_BAR(); RELOAD_ARGS();
        pg8::Gemm g{DM, DM, DM}; pg8::DenseOrder S; S.init((const bf16_t*)((unsigned char*)P.out + DO_H), (const bf16_t*)(P.ws + WS_WIN), DM, DM, NTOK, INCOLS, F.G, (int)blockIdx.x);
        pg8::EpiP E{(bf16_t*)(P.ws + WS_PRW), (bf16_t*)(P.ws + WS_PATT), PGATE};
        pg8::gemm_phase<pg8::EpiP, pg8::DenseOrder, true>(F.lds, g, S, E);
    } SEAM(2);
    if (IN(3)) for (int rep_ = 0; rep_ < ((3) == DUP_PHASE ? 2 : 1); ++rep_) { if (rep_) GRID_BAR(); RELOAD_ARGS();
#pragma unroll 1
        for (int r2 = 0; r2 < (DUP_PHASE == 31 ? 2 : 1); ++r2)
#pragma unroll 1
        for (int u = (int)blockIdx.x; u < NB * 8 * 8; u += F.G) att::attn_unit(F, P, u >> 6, (u >> 3) & 7, u & 7);
        __syncthreads();
#pragma unroll 1
        for (int r2 = 0; r2 < (DUP_PHASE == 30 ? 2 : 1); ++r2) rc::chunk_phase(F, P);
        if (TIME_PHASE >= 20 && blockIdx.x == 0 && F.tid == 0) { unsigned long long* tsp = (unsigned long long*)(args.ws + WS_CTL + 768 * KiB); unsigned long long a_ = 0; tsp[20] = 0; for (int k_ = 0; k_ < 10; ++k_) { a_ += F.MISC[16 + k_]; tsp[21 + k_] = a_; } }
    } SEAM(3);
    constexpr int EC_ITEMS = NE * (2 * 256 + 256), EC_SPLIT = EC_ITEMS / 4;
    if (IN(4)) for (int rep_ = 0; rep_ < ((4) == DUP_PHASE ? 2 : 1); ++rep_) { if (rep_) GRID_BAR(); RELOAD_ARGS();
        const int nR = F.G >= 256 ? 128 : F.G / 2, bx = (int)blockIdx.x;
        if (bx < nR) { for (int u = bx; u < NB * 8; u += nR) rc::state_chain(F, P, u); }
        else { const int na = F.G - nR, a = bx - nR; expert_convert(F, P, a * NWAVES + F.wave, na * NWAVES, 0, EC_SPLIT); }
    } SEAM(4);
    if (IN(5)) for (int rep_ = 0; rep_ < ((5) == DUP_PHASE ? 2 : 1); ++rep_) { if (rep_) GRID_BAR(); RELOAD_ARGS();
        const int gw = (int)blockIdx.x * NWAVES + F.wave, NGW = F.G * NWAVES;
        for (int w = gw; w < NB * 8 * 32 * 2; w += NGW) rc::out_unit(F, P, w >> 1, w & 1, !(DUP_PHASE == 5 && rep_ == 0));
        expert_convert(F, P, gw, NGW, EC_SPLIT, EC_ITEMS);
    } SEAM(5);
    if (IN(6)) for (int rep_ = 0; rep_ < ((6) == DUP_PHASE ? 2 : 1); ++rep_) { if (rep_) GRID_BAR(); RELOAD_ARGS();
        pg8::Gemm g{DM, DM, DM}; pg8::DenseOrder S; S.init((const bf16_t*)((unsigned char*)P.out + DO_YRA), (const bf16_t*)(P.ws + WS_WBR), DM, DM, NTOK, DM, F.G, (int)blockIdx.x);
        pg8::EpiMix E{(bf16_t*)(P.ws + WS_T), PGATE}; pg8::gemm_phase<pg8::EpiMix, pg8::DenseOrder, true>(F.lds, g, S, E);
    } SEAM(6);
    if (IN(7)) for (int rep_ = 0; rep_ < ((7) == DUP_PHASE ? 2 : 1); ++rep_) { if (rep_) GRID_BAR(); RELOAD_ARGS();
        pg8::Gemm g{DM, DM, DM}; pg8::DenseOrder S; S.init((const bf16_t*)(P.ws + WS_T), (const bf16_t*)(P.ws + WS_WOUT), DM, DM, NTOK, DM, F.G, (int)blockIdx.x);
        pg8::EpiDelta E{(bf16_t*)(P.ws + WS_DELTA), MODP}; pg8::gemm_phase<pg8::EpiDelta, pg8::DenseOrder, true>(F.lds, g, S, E);
    } SEAM(7);
    if (IN(8)) for (int rep_ = 0; rep_ < ((8) == DUP_PHASE ? 2 : 1); ++rep_) { if (rep_) GRID_BAR(); RELOAD_ARGS(); phase_route(F, P); } SEAM(8);
    if (IN(9)) for (int rep_ = 0; rep_ < ((9) == DUP_PHASE ? 2 : 1); ++rep_) { if (rep_) GRID_BAR(); RELOAD_ARGS();
        moe_offsets(F); const LAS int* toff = (const LAS int*)(F.lds + TOFF_OFF);
        pg8::Gemm g{DM, DM, DM}; pg8::MoeOrderT<true> S{(const bf16_t*)(P.ws + WS_H2), (const bf16_t*)(P.ws + WS_WGU), DM, DM, (size_t)DM * DM, (const LAS unsigned char*)(F.lds + TILE_L_OFF), toff, (const LAS int*)(F.lds + LCNT_OFF), 0, toff[NLIST], F.G, (int)blockIdx.x, (const int*)(P.ws + WS_SLOTTOK)};
        pg8::EpiHid E{(bf16_t*)(P.ws + WS_HID)}; pg8::gemm_phase<pg8::EpiHid, pg8::MoeOrderT<true>, true>(F.lds, g, S, E);
    } SEAM(9);
    if (IN(10)) for (int rep_ = 0; rep_ < ((10) == DUP_PHASE ? 2 : 1); ++rep_) { if (rep_) GRID_BAR(); RELOAD_ARGS();
        moe_offsets(F); const LAS int* toff = (const LAS int*)(F.lds + TOFF_OFF);
        pg8::Gemm g{DE, DE, DE}; pg8::MoeOrderT<false> S{(const bf16_t*)(P.ws + WS_HID), (const bf16_t*)(P.ws + WS_WD), DE, DE, (size_t)DM * DE, (const LAS unsigned char*)(F.lds + TILE_L_OFF), toff, (const LAS int*)(F.lds + LCNT_OFF), 0, toff[NLIST], F.G, (int)blockIdx.x, nullptr};
        pg8::EpiY E{(bf16_t*)(P.ws + WS_YB), (const float*)(P.ws + WS_SLOTW)}; pg8::gemm_phase<pg8::EpiY, pg8::MoeOrderT<false>, true>(F.lds, g, S, E);
    } SEAM(10);
    if (IN(11)) for (int rep_ = 0; rep_ < ((11) == DUP_PHASE ? 2 : 1); ++rep_) { if (rep_) GRID_BAR(); RELOAD_ARGS();
        moe_offsets(F); const LAS int* toff = (const LAS int*)(F.lds + TOFF_OFF);
        const bf16_t* Yb = (const bf16_t*)(P.ws + WS_YB); const int* tok_list = (const int*)(P.ws + WS_TOKLIST); const int* tok_pos = (const int*)(P.ws + WS_TOKPOS);
        const float* mod = MODP; const int gw = F.vcu * NWAVES + F.wave, NGW = F.G * NWAVES;
#pragma unroll 4
        for (int tok = gw; tok < NTOK; tok += NGW) {
            const int s0 = toff[tok_list[2 * tok]] * 256 + tok_pos[2 * tok], s1 = toff[tok_list[2 * tok + 1]] * 256 + tok_pos[2 * tok + 1];
            const float* g2 = mod + (size_t)(tok / SEQ) * MODW + 5 * DM;
            GAS f32x4* xo = (GAS f32x4*)(P.out + (size_t)tok * DM) + F.lane; const GAS f32x4* xi = (const GAS f32x4*)(P.in[0] + (size_t)tok * DM) + F.lane; const GAS u32x2* dd = (const GAS u32x2*)((const bf16_t*)(P.ws + WS_DELTA) + (size_t)tok * DM) + F.lane;
            const GAS u32x2* y0 = (const GAS u32x2*)(Yb + (size_t)s0 * DM) + F.lane; const GAS u32x2* y1 = (const GAS u32x2*)(Yb + (size_t)s1 * DM) + F.lane;
#pragma unroll
            for (int j = 0; j < 4; ++j) { f32x4 xv = xi[64 * j]; const u32x2 dw = dd[64 * j]; xv.x += bf_lo(dw.x); xv.y += bf_hi(dw.x); xv.z += bf_lo(dw.y); xv.w += bf_hi(dw.y); const u32x2 a = y0[64 * j], bq = y1[64 * j]; const f32x4 gv = *(const f32x4*)(g2 + 4 * F.lane + 256 * j);
                f32x4 o; o.x = xv.x + gv.x * (bf_lo(a.x) + bf_lo(bq.x)); o.y = xv.y + gv.y * (bf_hi(a.x) + bf_hi(bq.x)); o.z = xv.z + gv.z * (bf_lo(a.y) + bf_lo(bq.y)); o.w = xv.w + gv.w * (bf_hi(a.y) + bf_hi(bq.y));
                xo[64 * j] = o; }
        }
    }
#if TIME_PHASE >= 0
    {
#ifndef TIME_SCALE
#define TIME_SCALE 3.0e-4f
#endif
#ifndef TIME_HI
#define TIME_HI (TIME_PHASE + 1)
#endif
        STAMP(12); GRID_BAR();
        const unsigned long long* ts = (const unsigned long long*)(args.ws + WS_CTL + 768 * KiB);
        const float dlt = (float)(ts[TIME_HI] - ts[TIME_PHASE]) * (0.01f * TIME_SCALE);
        for (int i = blockIdx.x * 512 + F.tid; i < (1 << 20); i += gridDim.x * 512) args.out[i] += dlt;
    }
#endif
#undef IN
#undef SEAM
}

extern "C" void kernel_launch(void* const* d_in, const int* in_sizes, int n_in, void* d_out, int out_size, void* d_ws, size_t ws_size, hipStream_t stream) {
    static int grid = 0;
    if (grid == 0) {
        if (n_in != 31 || out_size != NTOK * DM || ws_size < WS_END) { fprintf(stderr, "kernel_launch: unexpected shapes (n_in %d out %d ws %zu)\n", n_in, out_size, ws_size); grid = -1; return; }
        int dev = 0, cus = 0;
        if (hipGetDevice(&dev) != hipSuccess || hipDeviceGetAttribute(&cus, hipDeviceAttributeMultiprocessorCount, dev) != hipSuccess) { grid = -1; return; }
        if (hipFuncSetAttribute((const void*)fwd_kernel, hipFuncAttributeMaxDynamicSharedMemorySize, LDS_BYTES) != hipSuccess) { fprintf(stderr, "kernel_launch: hipFuncSetAttribute failed\n"); grid = -1; return; }
        int per_cu = 0; (void)hipOccupancyMaxActiveBlocksPerMultiprocessor(&per_cu, (const void*)fwd_kernel, NWAVES * 64, LDS_BYTES); (void)hipGetLastError();
        grid = cus;
    }
    if (grid < 0) return;
    (void)hipMemsetAsync((char*)d_ws + WS_CTL, 0, CTL_ZERO_BYTES, stream);
    Args a{};
    for (int i = 0; i < 31; ++i) a.in[i] = (const float*)d_in[i];
    a.out = (float*)d_out; a.ws = (unsigned char*)d_ws;
#if MK_ONE_LAUNCH
    a.ph_lo = 0; a.ph_hi = N_PHASES;
    hipLaunchKernelGGL(fwd_kernel, dim3(grid), dim3(NWAVES * 64), LDS_BYTES, stream, a);
#else
    for (int p = 0; p < N_PHASES; ++p) { a.ph_lo = p; a.ph_hi = p + 1; hipLaunchKernelGGL(fwd_kernel, dim3(grid), dim3(NWAVES * 64), LDS_BYTES, stream, a); }
#endif
}
```

```cpp
#include <hip/hip_runtime.h>
#include <cstdio>
#include <cstdint>

#define LAS __attribute__((address_space(3)))
#define GAS __attribute__((address_space(1)))
typedef unsigned short bf16_t;
typedef short bf16x8 __attribute__((ext_vector_type(8)));
typedef short s16x4 __attribute__((ext_vector_type(4)));
typedef float f32x4 __attribute__((ext_vector_type(4)));
typedef float f32x2 __attribute__((ext_vector_type(2)));
typedef float f32x16 __attribute__((ext_vector_type(16)));
typedef unsigned u32x4 __attribute__((ext_vector_type(4)));
typedef unsigned u32x2 __attribute__((ext_vector_type(2)));

constexpr int NB = 16, SEQ = 2048, DM = 1024, NTOK = NB * SEQ;
constexpr int RCOLS = 1792, ACOLS = 1536, GCOLS = 2048, INCOLS = 5376;
constexpr int NE = 32, DE = 512, NLIST = 64;
constexpr int MODW = 6 * DM;
constexpr float LOG2E = 1.4426950408889634f;

typedef __bf16 bf16x2_t __attribute__((ext_vector_type(2)));
__device__ __forceinline__ unsigned cvt_pk_bf16(float lo, float hi) { const f32x2 v = {lo, hi}; const bf16x2_t b = __builtin_convertvector(v, bf16x2_t); return __builtin_bit_cast(unsigned, b); }
__device__ __forceinline__ float bf_lo(unsigned w) { return __uint_as_float(w << 16); }
__device__ __forceinline__ float bf_hi(unsigned w) { return __uint_as_float(w & 0xffff0000u); }
__device__ __forceinline__ float sigmoidf_(float x) { return __builtin_amdgcn_rcpf(1.0f + __builtin_amdgcn_exp2f(-x * LOG2E)); }

namespace pg8 {
constexpr int BM = 256, BK = 64, HALF = 128, HTB = HALF * BK * 2, STAGE_BYTES = 8 * HTB, NXCD = 8, WGM = 8;
__host__ __device__ __forceinline__ int lds_byte(int r, int c) { const int st = (r >> 4) * 2 + (c >> 5), rr = r & 15, cc = c & 31, ob = rr * 64 + cc * 2; return st * 1024 + (ob ^ (((ob >> 9) & 1) << 5)); }
__host__ __device__ __forceinline__ void stage_rc(int b, int& R, int& C) { const int st = b / 1024, sb = b % 1024, swz = sb ^ (((sb >> 9) & 1) << 5); R = (st >> 1) * 16 + swz / 64; C = (st & 1) * 32 + (swz % 64) / 2; }
__host__ __device__ __forceinline__ int perm32(int rho) { const int n = rho >> 4, i = rho & 15; return 8 * (i >> 2) + 4 * n + (i & 3); }

struct Unit { int pm, pn, e, sbase, nvalid; };
struct Gemm { int lda, ldb, K; };

struct DenseOrder {
    static constexpr bool GATHER = false;
    __device__ __forceinline__ int row_tok(const Unit&, int) const { return 0; }
    const bf16_t* A; const bf16_t* Bt; int lda, ldb;
    int nM, nN, nwg, G, c;
    __device__ void init(const bf16_t* A_, const bf16_t* Bt_, int lda_, int ldb_, int M, int N, int G_, int c_) { A = A_; Bt = Bt_; lda = lda_; ldb = ldb_; nM = M / BM; nN = N / BM; nwg = nM * nN; G = G_; c = c_; }
    __device__ bool next(int i, Unit& u) const {
        const long L = (long)i * G + c; if (L >= nwg) return false;
        int wgid = (int)L; { const int q = nwg / NXCD, r = nwg % NXCD, xcd = wgid % NXCD, off = wgid / NXCD; wgid = (xcd < r ? xcd * (q + 1) : r * (q + 1) + (xcd - r) * q) + off; }
        const int nig = WGM * nN, gid = wgid / nig, fm = gid * WGM, gsz = (nM - fm) < WGM ? (nM - fm) : WGM;
        u.pm = fm + ((wgid % nig) % gsz); u.pn = (wgid % nig) / gsz; u.e = 0; u.sbase = 0; u.nvalid = BM; return true;
    }
    __device__ __forceinline__ const char* a_base(const Unit& u) const { return (const char*)A + (size_t)u.pm * BM * lda * 2; }
    __device__ __forceinline__ const char* b_base(const Unit& u) const { return (const char*)Bt + (size_t)u.pn * BM * ldb * 2; }
};
template <bool GATHER_> struct MoeOrderT {
    static constexpr bool GATHER = GATHER_;
    const bf16_t* A; const bf16_t* Bt; int lda, ldb; size_t bt_expert_stride;
    const LAS unsigned char* tile_l;
    const LAS int* toff; const LAS int* lcnt;
    int tlo, thi, G, c;
    const int* slot_tok;
    __device__ __forceinline__ int row_tok(const Unit& u, int r) const { return r < u.nvalid ? slot_tok[u.sbase + r] : 0; }
    __device__ bool next(int i, Unit& u) const {
        const int nt = thi - tlo; int tile, pn;
        if (G % NXCD == 0) { const int x = c % NXCD, cin = c / NXCD, per = G / NXCD; const int t0 = (int)((long)nt * x / NXCD), t1 = (int)((long)nt * (x + 1) / NXCD);
            const long j = (long)i * per + cin; if (j >= (long)(t1 - t0) * 4) return false; tile = tlo + t0 + (int)(j >> 2); pn = (int)(j & 3); }
        else { const long L = (long)i * G + c; if (L >= (long)nt * 4) return false; tile = tlo + (int)(L >> 2); pn = (int)(L & 3); }
        const int l = tile_l[tile], j = tile - toff[l]; u.pm = tile; u.pn = pn; u.e = l >> 1; u.sbase = l * NTOK + j * BM; u.nvalid = lcnt[l] - j * BM; return true;
    }
    __device__ __forceinline__ const char* a_base(const Unit& u) const { return GATHER ? (const char*)A : (const char*)A + (size_t)u.pm * BM * lda * 2; }
    __device__ __forceinline__ const char* b_base(const Unit& u) const { return (const char*)Bt + ((size_t)u.e * bt_expert_stride + (size_t)u.pn * BM * ldb) * 2; }
};

template <class Epi, class Sched, bool ALIGN_EPI>
__device__ __forceinline__ void gemm_phase(LAS unsigned char* lds, const Gemm g, const Sched& S, const Epi& E) {
    const int tid = threadIdx.x, wid = __builtin_amdgcn_readfirstlane(tid >> 6), lane = tid & 63, wr = wid >> 2, wc = wid & 3, fr = lane & 15, fq = lane >> 4;
    const int K = g.K, nt = K / BK;
    unsigned voffA[2], voffB[2]; int RA[2], CA2[2];
#pragma unroll
    for (int i = 0; i < 2; ++i) { int R, C; stage_rc(tid * 16 + i * 8192, R, C); RA[i] = R; CA2[i] = C * 2; const int Rb = Epi::PERM ? ((R & ~31) + perm32(R & 31)) : R;
        voffA[i] = (unsigned)(R * g.lda + C) * 2u; voffB[i] = (unsigned)(Rb * g.ldb + C) * 2u; }
    const size_t kstep = (size_t)(BK * 2);
    const size_t hstepA = (size_t)HALF * g.lda * 2, hstepB = (size_t)HALF * g.ldb * 2;
    const unsigned ldsw = (unsigned)wid * 1024u;
    const int aoff = lds_byte(wr * 64 + fr, fq * 8), boff = lds_byte(wc * 32 + fr, fq * 8);
#define PG8_SA(b, h) (((b) * 2 + (h)) * HTB)
#define PG8_SB(b, h) ((4 + (b) * 2 + (h)) * HTB)
#define PG8_STAGE(bufoff, gbase, voff) do { _Pragma("unroll") for (int _i = 0; _i < 2; ++_i) \
        __builtin_amdgcn_global_load_lds((const unsigned*)((const char*)(gbase) + (voff)[_i]), (LAS unsigned*)(lds + (bufoff) + ldsw + _i * 8192), 16, 0, 0); } while (0)
#define PG8_STAGE_A(bufoff, kptr, half, nx) do { if constexpr (Sched::GATHER) { _Pragma("unroll") for (int _i = 0; _i < 2; ++_i) \
        __builtin_amdgcn_global_load_lds((const unsigned*)((const char*)(kptr) + ((nx) ? vnx[half][_i] : vcu[half][_i])), (LAS unsigned*)(lds + (bufoff) + ldsw + _i * 8192), 16, 0, 0); } \
    else { PG8_STAGE(bufoff, (const char*)(kptr) + ((half) ? hstepA : 0), voffA); } } while (0)
#define PG8_LDA(dst, b, h) do { _Pragma("unroll") for (int m = 0; m < 4; ++m) _Pragma("unroll") for (int k = 0; k < 2; ++k) dst[m][k] = *(const LAS bf16x8*)(lds + PG8_SA(b, h) + aoff + m * 2048 + k * 1024); } while (0)
#define PG8_LDB(dst, b, h) do { _Pragma("unroll") for (int n = 0; n < 2; ++n) _Pragma("unroll") for (int k = 0; k < 2; ++k) dst[n][k] = *(const LAS bf16x8*)(lds + PG8_SB(b, h) + boff + n * 2048 + k * 1024); } while (0)
#define PG8_MMA(ai, bj, At, Bt) do { __builtin_amdgcn_s_setprio(1); _Pragma("unroll") for (int m = 0; m < 4; ++m) _Pragma("unroll") for (int n = 0; n < 2; ++n) _Pragma("unroll") for (int k = 0; k < 2; ++k) \
        acc[ai][bj][m][n] = __builtin_amdgcn_mfma_f32_16x16x32_bf16(Bt[n][k], At[m][k], acc[ai][bj][m][n], 0, 0, 0); __builtin_amdgcn_s_setprio(0); } while (0)
#define PG8_WAIT_V(n) asm volatile("s_waitcnt vmcnt(" #n ")" ::: "memory")
#define PG8_WAIT_L(n) asm volatile("s_waitcnt lgkmcnt(" #n ")" ::: "memory")
#define PG8_BAR __builtin_amdgcn_s_barrier()
#define PG8_SCHED __builtin_amdgcn_sched_barrier(0)
    Unit cur, nxt; int ui = 0;
    if (!S.next(0, cur)) return;
    f32x4 acc[2][2][4][2];
#pragma unroll
    for (int a = 0; a < 2; ++a)
#pragma unroll
        for (int b = 0; b < 2; ++b)
#pragma unroll
            for (int m = 0; m < 4; ++m)
#pragma unroll
                for (int n = 0; n < 2; ++n) acc[a][b][m][n] = (f32x4){0.f, 0.f, 0.f, 0.f};
    bf16x8 At[4][2], B0[2][2], B1[2][2];
    const char* cA = S.a_base(cur); const char* cB = S.b_base(cur);
    unsigned vcu[2][2], vnx[2][2];
    if constexpr (Sched::GATHER) {
#pragma unroll
        for (int hf = 0; hf < 2; ++hf)
#pragma unroll
            for (int i = 0; i < 2; ++i) { vcu[hf][i] = (unsigned)S.row_tok(cur, hf * HALF + RA[i]) * (unsigned)(g.lda * 2) + (unsigned)CA2[i]; vnx[hf][i] = vcu[hf][i]; } }
    PG8_STAGE(PG8_SB(0, 0), cB, voffB); PG8_STAGE(PG8_SB(0, 1), cB + hstepB, voffB); PG8_STAGE_A(PG8_SA(0, 0), cA, 0, false); PG8_STAGE_A(PG8_SA(0, 1), cA, 1, false);
    if (wr == 1) PG8_BAR;
    PG8_WAIT_V(2); PG8_BAR;
    PG8_STAGE(PG8_SB(1, 0), cB + kstep, voffB); PG8_STAGE_A(PG8_SA(1, 0), cA + kstep, 0, false); PG8_STAGE(PG8_SB(1, 1), cB + hstepB + kstep, voffB);
    PG8_WAIT_V(6); PG8_BAR;
    for (;;) {
        const bool has_next = S.next(ui + 1, nxt);
        const char* nA = has_next ? S.a_base(nxt) : cA; const char* nB = has_next ? S.b_base(nxt) : cB;
        if constexpr (Sched::GATHER) { if (has_next) {
#pragma unroll
            for (int hf = 0; hf < 2; ++hf)
#pragma unroll
                for (int i = 0; i < 2; ++i) vnx[hf][i] = (unsigned)S.row_tok(nxt, hf * HALF + RA[i]) * (unsigned)(g.lda * 2) + (unsigned)CA2[i]; } }
        for (int t = 0; t < nt; t += 2) {
            if constexpr (Epi::HAS_MID) { if (t == Epi::MID_T) E.mid(acc, cur, wr, wc, fr, fq); }
            const bool last = (t == nt - 2);
            const char* a1 = cA + (size_t)(t + 1) * kstep;
            const char* a2 = last ? nA : cA + (size_t)(t + 2) * kstep; const char* b2 = last ? nB : cB + (size_t)(t + 2) * kstep;
            const char* a3 = a2 + kstep; const char* b3 = b2 + kstep;
            PG8_LDB(B0, 0, 0); PG8_LDB(B1, 0, 1); PG8_SCHED; PG8_LDA(At, 0, 0); PG8_STAGE_A(PG8_SA(1, 1), a1, 1, false);
            PG8_WAIT_V(8); PG8_WAIT_L(0); PG8_BAR; PG8_MMA(0, 0, At, B0); PG8_MMA(0, 1, At, B1); PG8_BAR; PG8_SCHED;
            PG8_LDA(At, 0, 1); PG8_STAGE(PG8_SB(0, 0), b2, voffB); PG8_STAGE(PG8_SB(0, 1), b2 + hstepB, voffB); PG8_STAGE_A(PG8_SA(0, 0), a2, 0, last);
            PG8_WAIT_V(8); PG8_WAIT_L(0); PG8_BAR; PG8_MMA(1, 0, At, B0); PG8_MMA(1, 1, At, B1); PG8_BAR; PG8_SCHED;
            PG8_LDB(B0, 1, 0); PG8_LDB(B1, 1, 1); PG8_SCHED; PG8_LDA(At, 1, 0); PG8_STAGE_A(PG8_SA(0, 1), a2, 1, last);
            PG8_WAIT_V(8); PG8_WAIT_L(0); PG8_BAR; PG8_MMA(0, 0, At, B0); PG8_MMA(0, 1, At, B1); PG8_BAR; PG8_SCHED;
            PG8_LDA(At, 1, 1); PG8_STAGE(PG8_SB(1, 0), b3, voffB); PG8_STAGE(PG8_SB(1, 1), b3 + hstepB, voffB); PG8_STAGE_A(PG8_SA(1, 0), a3, 0, last);
            PG8_WAIT_V(8); PG8_WAIT_L(0); PG8_BAR; PG8_MMA(1, 0, At, B0); PG8_MMA(1, 1, At, B1); PG8_BAR; PG8_SCHED;
        }
        if constexpr (ALIGN_EPI) { if (wr == 0) PG8_BAR; }
        E(acc, cur, wr, wc, fr, fq);
        if (!has_next) break;
#pragma unroll
        for (int a = 0; a < 2; ++a)
#pragma unroll
            for (int b = 0; b < 2; ++b)
#pragma unroll
                for (int m = 0; m < 4; ++m)
#pragma unroll
                    for (int n = 0; n < 2; ++n) acc[a][b][m][n] = (f32x4){0.f, 0.f, 0.f, 0.f};
        cur = nxt; cA = nA; cB = nB; ++ui;
        if constexpr (Sched::GATHER) {
#pragma unroll
            for (int hf = 0; hf < 2; ++hf)
#pragma unroll
                for (int i = 0; i < 2; ++i) vcu[hf][i] = vnx[hf][i]; }
        if constexpr (ALIGN_EPI) { if (wr == 1) PG8_BAR; }
    }
    PG8_WAIT_V(0);
    if constexpr (!ALIGN_EPI) { if (wr == 0) PG8_BAR; }
    PG8_BAR;
#undef PG8_SA
#undef PG8_SB
#undef PG8_STAGE
#undef PG8_STAGE_A
#undef PG8_LDA
#undef PG8_LDB
#undef PG8_MMA
#undef PG8_WAIT_V
#undef PG8_WAIT_L
#undef PG8_BAR
#undef PG8_SCHED
}

__device__ __forceinline__ unsigned q8(float x) { float s = sigmoidf_(x) * 255.f + 0.5f; s = s < 1.f ? 1.f : s; return (unsigned)s; }
struct EpiP {
    static constexpr bool PERM = true, HAS_MID = false;
    bf16_t *Prw, *Patt; unsigned char* Pgate;
    __device__ __forceinline__ void operator()(const f32x4 (&acc)[2][2][4][2], const Unit& u, int wr, int wc, int fr, int fq) const {
        const int row0 = u.pm * BM + wr * 64 + fr;
        if (u.pn >= 13) { const int col0 = (u.pn - 13) * BM + wc * 32 + 8 * fq;
#pragma unroll
            for (int ai = 0; ai < 2; ++ai)
#pragma unroll
                for (int m = 0; m < 4; ++m) { unsigned char* rowp = Pgate + (size_t)(row0 + ai * HALF + m * 16) * GCOLS + col0;
#pragma unroll
                    for (int bj = 0; bj < 2; ++bj) { const f32x4 v0 = acc[ai][bj][m][0], v1 = acc[ai][bj][m][1];
                        u32x2 w; w.x = q8(v0[0]) | (q8(v0[1]) << 8) | (q8(v0[2]) << 16) | (q8(v0[3]) << 24); w.y = q8(v1[0]) | (q8(v1[1]) << 8) | (q8(v1[2]) << 16) | (q8(v1[3]) << 24);
                        *(u32x2*)(rowp + bj * HALF) = w; } }
            return; }
        bf16_t* base; int ldc, colt;
        if (u.pn < 7) { base = Prw; ldc = RCOLS; colt = u.pn * BM; } else { base = Patt; ldc = ACOLS; colt = (u.pn - 7) * BM; }
        const int col0 = colt + wc * 32 + 8 * fq;
#pragma unroll
        for (int ai = 0; ai < 2; ++ai)
#pragma unroll
            for (int m = 0; m < 4; ++m) { bf16_t* rowp = base + (size_t)(row0 + ai * HALF + m * 16) * ldc + col0;
#pragma unroll
                for (int bj = 0; bj < 2; ++bj) { const f32x4 v0 = acc[ai][bj][m][0], v1 = acc[ai][bj][m][1];
                    u32x4 w; w.x = cvt_pk_bf16(v0[0], v0[1]); w.y = cvt_pk_bf16(v0[2], v0[3]); w.z = cvt_pk_bf16(v1[0], v1[1]); w.w = cvt_pk_bf16(v1[2], v1[3]);
                    *(u32x4*)(rowp + bj * HALF) = w; } }
    }
};
struct EpiMix {
    static constexpr bool PERM = true, HAS_MID = true; static constexpr int MID_T = 8;
    bf16_t* T; const unsigned char* Pgate;
    static __device__ __forceinline__ float ub(unsigned w, int i) { return (float)((w >> (8 * i)) & 0xffu); }
    __device__ __forceinline__ void mid(f32x4 (&acc)[2][2][4][2], const Unit& u, int wr, int wc, int fr, int fq) const {
        int row0 = u.pm * BM + wr * 64 + fr, col0 = u.pn * BM + wc * 32 + 8 * fq; asm volatile("" : "+v"(row0), "+v"(col0));
#pragma unroll
        for (int ai = 0; ai < 2; ++ai) {
            u32x2 gr[4][2], ga[4][2];
#pragma unroll
            for (int m = 0; m < 4; ++m) { const unsigned char* gp = Pgate + (size_t)(row0 + ai * HALF + m * 16) * GCOLS + col0;
#pragma unroll
                for (int bj = 0; bj < 2; ++bj) { gr[m][bj] = *(const u32x2*)(gp + bj * HALF); ga[m][bj] = *(const u32x2*)(gp + DM + bj * HALF); } }
#pragma unroll
            for (int m = 0; m < 4; ++m)
#pragma unroll
                for (int bj = 0; bj < 2; ++bj) { const u32x2 r = gr[m][bj], a = ga[m][bj]; f32x4& v0 = acc[ai][bj][m][0]; f32x4& v1 = acc[ai][bj][m][1];
#pragma unroll
                    for (int j = 0; j < 4; ++j) { v0[j] *= ub(r.x, j) * __builtin_amdgcn_rcpf(ub(a.x, j)); v1[j] *= ub(r.y, j) * __builtin_amdgcn_rcpf(ub(a.y, j)); } }
            asm volatile("" ::: "memory");
        }
    }
    __device__ __forceinline__ void operator()(const f32x4 (&acc)[2][2][4][2], const Unit& u, int wr, int wc, int fr, int fq) const {
        const int row0 = u.pm * BM + wr * 64 + fr, col0 = u.pn * BM + wc * 32 + 8 * fq;
        u32x2 ga[2][4][2];
#pragma unroll
        for (int ai = 0; ai < 2; ++ai)
#pragma unroll
            for (int m = 0; m < 4; ++m)
#pragma unroll
                for (int bj = 0; bj < 2; ++bj) ga[ai][m][bj] = *(const u32x2*)(Pgate + (size_t)(row0 + ai * HALF + m * 16) * GCOLS + DM + col0 + bj * HALF);
#pragma unroll
        for (int ai = 0; ai < 2; ++ai)
#pragma unroll
            for (int m = 0; m < 4; ++m) { const size_t row = (size_t)(row0 + ai * HALF + m * 16);
#pragma unroll
                for (int bj = 0; bj < 2; ++bj) { const int col = col0 + bj * HALF; const u32x2 g = ga[ai][m][bj]; constexpr float s = 1.f / 255.f;
                    const f32x4 a0 = acc[ai][bj][m][0], a1 = acc[ai][bj][m][1];
                    u32x4 w; w.x = cvt_pk_bf16(a0[0] * ub(g.x, 0) * s, a0[1] * ub(g.x, 1) * s); w.y = cvt_pk_bf16(a0[2] * ub(g.x, 2) * s, a0[3] * ub(g.x, 3) * s);
                    w.z = cvt_pk_bf16(a1[0] * ub(g.y, 0) * s, a1[1] * ub(g.y, 1) * s); w.w = cvt_pk_bf16(a1[2] * ub(g.y, 2) * s, a1[3] * ub(g.y, 3) * s);
                    *(u32x4*)(T + row * DM + col) = w; } }
    }
};
struct EpiDelta {
    static constexpr bool PERM = true, HAS_MID = false;
    bf16_t* D; const float* mod;
    __device__ __forceinline__ void operator()(const f32x4 (&acc)[2][2][4][2], const Unit& u, int wr, int wc, int fr, int fq) const {
        const int row0 = u.pm * BM + wr * 64 + fr, col0 = u.pn * BM + wc * 32 + 8 * fq;
        const int b = (u.pm * BM) / SEQ; const float* g1 = mod + (size_t)b * MODW + 2 * DM;
        f32x4 gv[2][2];
#pragma unroll
        for (int bj = 0; bj < 2; ++bj)
#pragma unroll
            for (int n = 0; n < 2; ++n) gv[bj][n] = *(const f32x4*)(g1 + col0 + bj * HALF + 4 * n);
#pragma unroll
        for (int ai = 0; ai < 2; ++ai)
#pragma unroll
            for (int m = 0; m < 4; ++m) { bf16_t* rowp = D + (size_t)(row0 + ai * HALF + m * 16) * DM + col0;
#pragma unroll
                for (int bj = 0; bj < 2; ++bj) { const f32x4 v0 = acc[ai][bj][m][0] * gv[bj][0], v1 = acc[ai][bj][m][1] * gv[bj][1];
                    u32x4 w; w.x = cvt_pk_bf16(v0[0], v0[1]); w.y = cvt_pk_bf16(v0[2], v0[3]); w.z = cvt_pk_bf16(v1[0], v1[1]); w.w = cvt_pk_bf16(v1[2], v1[3]);
                    *(u32x4*)(rowp + bj * HALF) = w; } }
    }
};
struct EpiHid {
    static constexpr bool PERM = true, HAS_MID = false;
    bf16_t* hid;
    __device__ __forceinline__ void operator()(const f32x4 (&acc)[2][2][4][2], const Unit& u, int wr, int wc, int fr, int fq) const {
        const int row0 = u.pm * BM + wr * 64 + fr, hc0 = u.pn * 128 + wc * 16 + 4 * fq;
#pragma unroll
        for (int ai = 0; ai < 2; ++ai)
#pragma unroll
            for (int m = 0; m < 4; ++m) { bf16_t* rowp = hid + (size_t)(row0 + ai * HALF + m * 16) * DE + hc0;
#pragma unroll
                for (int bj = 0; bj < 2; ++bj) { const f32x4 gt = acc[ai][bj][m][0], up = acc[ai][bj][m][1]; float h[4];
#pragma unroll
                    for (int j = 0; j < 4; ++j) h[j] = gt[j] * sigmoidf_(gt[j]) * up[j];
                    u32x2 w; w.x = cvt_pk_bf16(h[0], h[1]); w.y = cvt_pk_bf16(h[2], h[3]); *(u32x2*)(rowp + bj * 64) = w; } }
    }
};
struct EpiY {
    static constexpr bool PERM = true, HAS_MID = false;
    bf16_t* Y; const float* slot_w;
    __device__ __forceinline__ void operator()(const f32x4 (&acc)[2][2][4][2], const Unit& u, int wr, int wc, int fr, int fq) const {
        const int row0 = u.pm * BM + wr * 64 + fr, col0 = u.pn * BM + wc * 32 + 8 * fq;
        float w[2][4];
#pragma unroll
        for (int ai = 0; ai < 2; ++ai)
#pragma unroll
            for (int m = 0; m < 4; ++m) { const int r = wr * 64 + fr + ai * HALF + m * 16; w[ai][m] = r < u.nvalid ? slot_w[u.sbase + r] : 0.f; }
#pragma unroll
        for (int ai = 0; ai < 2; ++ai)
#pragma unroll
            for (int m = 0; m < 4; ++m) { bf16_t* rowp = Y + (size_t)(row0 + ai * HALF + m * 16) * DM + col0; const float ws = w[ai][m];
#pragma unroll
                for (int bj = 0; bj < 2; ++bj) { const f32x4 v0 = acc[ai][bj][m][0] * ws, v1 = acc[ai][bj][m][1] * ws;
                    u32x4 o; o.x = cvt_pk_bf16(v0[0], v0[1]); o.y = cvt_pk_bf16(v0[2], v0[3]); o.z = cvt_pk_bf16(v1[0], v1[1]); o.w = cvt_pk_bf16(v1[2], v1[3]);
                    *(u32x4*)(rowp + bj * HALF) = o; } }
    }
};
}
typedef GAS unsigned gu32;
#define RLX_AGENT __ATOMIC_RELAXED, __HIP_MEMORY_SCOPE_AGENT
#define LDS_WAIT() asm volatile("s_waitcnt lgkmcnt(0)" ::: "memory")
#define VM_WAIT() asm volatile("s_waitcnt vmcnt(0)" ::: "memory")
#define XB_TMO      128
#define XB_XCNT(j)  (256  + 64 * (j))
#define XB_XSUB(j)  (1280 + 64 * (j))
#define XB_XGEN(j)  (2304 + 64 * (j))
#define XB_TOP      3328
#define XB_TOPGEN   3392
#define XCD_BAR_WORDS 3456
#define XB_SPIN_CAP (1u << 18)

__device__ __forceinline__ unsigned xb_ld(unsigned* p)              { return __hip_atomic_load(p, __ATOMIC_RELAXED, __HIP_MEMORY_SCOPE_AGENT); }
__device__ __forceinline__ unsigned xb_add(unsigned* p, unsigned v) { return __hip_atomic_fetch_add(p, v, __ATOMIC_RELAXED, __HIP_MEMORY_SCOPE_AGENT); }
__device__ __forceinline__ unsigned xb_xcc_id() { return (unsigned)__builtin_amdgcn_s_getreg((3 << 11) | 20) & 0xFu; }
#define XB_SPIN(cond, bar) do { unsigned _sp = 0; while (cond) { __builtin_amdgcn_s_sleep(1); \
    if ((++_sp & 255u) == 0u) { if (xb_ld(&(bar)[XB_TMO])) break; if (_sp > XB_SPIN_CAP) { atomicAdd(&(bar)[XB_TMO], 1u); break; } } } } while (0)

struct XcdBarrier {
    unsigned* bar; unsigned x;
    volatile LAS unsigned* st;
};

__device__ __forceinline__ XcdBarrier xcd_barrier_post(unsigned* bar, volatile LAS unsigned* st) {
    XcdBarrier b; b.bar = bar; b.x = xb_xcc_id(); b.st = st;
    if (threadIdx.x == 0) (void)xb_add(&bar[XB_XCNT(b.x)], 1u);
    return b;
}
__device__ __forceinline__ void xcd_barrier_complete(unsigned* bar, unsigned x, unsigned& nloc, unsigned& nx) {
    const unsigned G = gridDim.x * gridDim.y * gridDim.z;
    unsigned sum, cnt, mine, sp = 0u;
    for (;;) {
        sum = 0u; cnt = 0u; mine = 0u;
#pragma unroll
        for (unsigned j = 0; j < 16; ++j) { const unsigned c = xb_ld(&bar[XB_XCNT(j)]); sum += c; cnt += (c > 0u) ? 1u : 0u; mine = (j == x) ? c : mine; }
        if (sum == G) break;
        __builtin_amdgcn_s_sleep(1);
        if ((++sp & 255u) == 0u) { if (xb_ld(&bar[XB_TMO])) break; if (sp > XB_SPIN_CAP) { atomicAdd(&bar[XB_TMO], 1u); break; } }
    }
    nloc = mine > 0u ? mine : 1u; nx = cnt > 0u ? cnt : 1u;
}

__device__ __forceinline__ void xcd_barrier(const XcdBarrier& b) {
    asm volatile("s_waitcnt vmcnt(0)" ::: "memory");
    __syncthreads();
    if (threadIdx.x == 0) {
        unsigned* bar = b.bar;
        __builtin_amdgcn_s_waitcnt(0);
        unsigned nloc = b.st[0], nx = b.st[1];
        if (nloc == 0u) { xcd_barrier_complete(bar, b.x, nloc, nx); b.st[0] = nloc; b.st[1] = nx; }
        const unsigned old = xb_add(&bar[XB_XSUB(b.x)], 1u);
        const unsigned gen = old / nloc;
        if (old + 1u == (gen + 1u) * nloc) {
            __builtin_amdgcn_fence(__ATOMIC_RELEASE, "agent");
            asm volatile("s_waitcnt vmcnt(0)" ::: "memory");
            const unsigned og = xb_add(&bar[XB_TOP], 1u);
            const unsigned tg = og / nx;
            if (og + 1u == (tg + 1u) * nx) xb_add(&bar[XB_TOPGEN], 1u);
            else XB_SPIN(xb_ld(&bar[XB_TOPGEN]) == tg, bar);
            __builtin_amdgcn_fence(__ATOMIC_ACQUIRE, "agent");
            xb_add(&bar[XB_XGEN(b.x)], 1u);
            asm volatile("s_waitcnt vmcnt(0)" ::: "memory");
        } else {
            XB_SPIN(xb_ld(&bar[XB_XGEN(b.x)]) == gen, bar);
            __builtin_amdgcn_fence(__ATOMIC_ACQUIRE, "agent");
            asm volatile("s_waitcnt vmcnt(0)" ::: "memory");
        }
    }
    __syncthreads();
}

constexpr int NWAVES = 8;
constexpr size_t MiB = 1u << 20, KiB = 1u << 10;
constexpr size_t WS_CTL = 0, CTL_ZERO_BYTES = 2 * MiB;
constexpr size_t WS_MOD = 1 * MiB;
constexpr size_t WS_WIN = 2 * MiB;
constexpr size_t WS_WBR = 12 * MiB + 512 * KiB, WS_WBA = 13 * MiB + 512 * KiB, WS_WOUT = 14 * MiB + 512 * KiB;
constexpr size_t WS_WUP = 16 * MiB + 512 * KiB, WS_AUP = WS_WUP + 64 * KiB, WS_GUP = WS_WUP + 128 * KiB;
constexpr size_t WS_WRH = 16 * MiB + 768 * KiB, WS_WRL = WS_WRH + 128 * KiB;
constexpr size_t WS_CB = 17 * MiB, WS_GAM2 = 17 * MiB + 64 * KiB;
constexpr size_t WS_PRW = 18 * MiB, WS_PATT = 130 * MiB, WS_PGATE = 226 * MiB;
constexpr size_t WS_WGU = 130 * MiB, WS_WD = 290 * MiB;
constexpr size_t WS_T = 18 * MiB;
constexpr size_t WS_HID = 18 * MiB, WS_DELTA = 226 * MiB, WS_H2 = 354 * MiB;
constexpr size_t WS_SLOTTOK = 98 * MiB, WS_SLOTW = 106 * MiB, WS_TOKLIST = 114 * MiB,
    WS_TOKPOS = WS_TOKLIST + 256 * KiB, WS_TOKW = WS_TOKLIST + 512 * KiB;
constexpr size_t WS_QE = 354 * MiB, WS_YLOC = 386 * MiB, WS_PC = 418 * MiB, WS_SLOC = 450 * MiB;
constexpr size_t WS_YB = 322 * MiB;
constexpr size_t WS_END = 512 * MiB;
constexpr size_t DO_H = 0, DO_G = 0, DO_SC = 32 * MiB, DO_YRA = 64 * MiB;
constexpr int NSLOT_MAX = 2 * NTOK + NLIST * 256;
constexpr int CW_TMO = 0, CW_BAR = 4096, CW_CNT = 16384;
constexpr int LDS_BYTES = 163840, RING_BYTES = 131072;
constexpr int LDSCTL_OFF = LDS_BYTES - 2048, MISC_OFF = LDSCTL_OFF;
constexpr int TOFF_OFF = LDSCTL_OFF + 256, LCNT_OFF = TOFF_OFF + 264, TILE_L_OFF = LCNT_OFF + 256;

#define LBAR() do { asm volatile("s_waitcnt lgkmcnt(0)" ::: "memory"); __builtin_amdgcn_s_barrier(); asm volatile("" ::: "memory"); } while (0)
struct Frame {
    LAS unsigned char* lds; volatile LAS unsigned* MISC; gu32* ctl;
    int tid, lane, wave, vcu, G;
};
__device__ __forceinline__ float wave_sum(float v) {
#pragma unroll
    for (int o = 1; o < 64; o <<= 1) v += __shfl_xor(v, o);
    return v;
}
__device__ __forceinline__ float dpp_f(float x, const int ctrl_sel) {
    const int xi = __builtin_bit_cast(int, x); int r;
    if (ctrl_sel == 0) r = __builtin_amdgcn_update_dpp(0, xi, 0xB1, 0xf, 0xf, true);
    else if (ctrl_sel == 1) r = __builtin_amdgcn_update_dpp(0, xi, 0x4E, 0xf, 0xf, true);
    else r = __builtin_amdgcn_update_dpp(0, xi, 0x141, 0xf, 0xf, true);
    return __builtin_bit_cast(float, r);
}
__device__ __forceinline__ float red8(float x) { x += dpp_f(x, 0); x += dpp_f(x, 1); x += dpp_f(x, 2); return x; }

__device__ __forceinline__ void phase_mod(Frame& F, const float* c, const float* w_ada, const float* b_ada, float* mod) {
    const int gw = F.vcu * NWAVES + F.wave, NGW = F.G * NWAVES;
    for (int task = gw; task < 96 * 16; task += NGW) {
        const int nc = task % 96, ks = task / 96, n = nc * 64 + F.lane, k0 = ks * 64;
        float acc[16];
#pragma unroll
        for (int b = 0; b < 16; ++b) acc[b] = 0.f;
        LAS float* sl = (LAS float*)(F.lds) + F.wave * 1024;
#pragma unroll
        for (int j = 0; j < 16; ++j) { const float cv = c[(F.lane & 15) * DM + k0 + (F.lane >> 4) + 4 * j]; sl[((F.lane >> 4) + 4 * j) * 16 + (F.lane & 15)] = cv * sigmoidf_(cv); }
        LDS_WAIT(); asm volatile("" ::: "memory");
#pragma unroll 4
        for (int kk = 0; kk < 64; ++kk) { const float w = w_ada[(size_t)(k0 + kk) * MODW + n];
            const f32x4 s0 = *(const LAS f32x4*)(sl + kk * 16), s1 = *(const LAS f32x4*)(sl + kk * 16 + 4), s2 = *(const LAS f32x4*)(sl + kk * 16 + 8), s3 = *(const LAS f32x4*)(sl + kk * 16 + 12);
            acc[0] += s0.x * w; acc[1] += s0.y * w; acc[2] += s0.z * w; acc[3] += s0.w * w; acc[4] += s1.x * w; acc[5] += s1.y * w; acc[6] += s1.z * w; acc[7] += s1.w * w;
            acc[8] += s2.x * w; acc[9] += s2.y * w; acc[10] += s2.z * w; acc[11] += s2.w * w; acc[12] += s3.x * w; acc[13] += s3.y * w; acc[14] += s3.z * w; acc[15] += s3.w * w; }
        LDS_WAIT(); asm volatile("" ::: "memory");
#pragma unroll
        for (int b = 0; b < 16; ++b) { const float v = acc[b] + (ks == 0 ? b_ada[n] : 0.f); atomicAdd(mod + (size_t)b * MODW + n, v); }
    }
}

template <int MODE> __device__ __forceinline__ void transpose_item(const float* W, int K, int N, bf16_t* WT, int row_off, int item, int lane, int ldt = 0, int koff = 0) {
    if (ldt == 0) ldt = K;
    const int nblk = N / 32, kb = item / nblk, nb = item % nblk, k0 = 64 * kb + 8 * (lane >> 3), n0 = 32 * nb + 4 * (lane & 7);
    f32x4 v[8];
#pragma unroll
    for (int i = 0; i < 8; ++i) v[i] = *(const f32x4*)(W + (size_t)(k0 + i) * N + n0);
#pragma unroll
    for (int j = 0; j < 4; ++j) { const int ng = n0 + j; const int nr = MODE == 0 ? row_off + ng : (MODE == 1 ? 8 * (ng >> 2) + (ng & 3) : 8 * (ng >> 2) + 4 + (ng & 3));
        u32x4 o; o.x = cvt_pk_bf16(v[0][j], v[1][j]); o.y = cvt_pk_bf16(v[2][j], v[3][j]); o.z = cvt_pk_bf16(v[4][j], v[5][j]); o.w = cvt_pk_bf16(v[6][j], v[7][j]);
        *(GAS u32x4*)(WT + (size_t)nr * ldt + koff + k0) = o; }
}

struct Args { const float* in[31]; float* out; unsigned char* ws; int ph_lo, ph_hi; };
struct Ptrs { const float* in[31]; float* out; unsigned char* ws; };

__device__ __forceinline__ void phase_prep(Frame& F, const Ptrs& P) {
    const int gw = F.vcu * NWAVES + F.wave, NGW = F.G * NWAVES;
    const float* mod = (const float*)(P.ws + WS_MOD);
    bf16_t* Win_t = (bf16_t*)(P.ws + WS_WIN); bf16_t* Wbr_t = (bf16_t*)(P.ws + WS_WBR); bf16_t* Wba_t = (bf16_t*)(P.ws + WS_WBA); bf16_t* Wout_t = (bf16_t*)(P.ws + WS_WOUT);
    bf16_t* wup_t = (bf16_t*)(P.ws + WS_WUP); bf16_t* aup_t = (bf16_t*)(P.ws + WS_AUP); bf16_t* gup_t = (bf16_t*)(P.ws + WS_GUP);
    constexpr int I_IN = 16 * (INCOLS / 32), I_BR = 8 * 32, I_OUT = 16 * 32, I_UP = 16, I_GUP = 2 * 16;
    constexpr int NITEMS = I_IN + 2 * I_BR + I_OUT + 2 * I_UP + I_GUP;
    for (int it = gw; it < NITEMS; it += NGW) {
        int r = it;
        if (r < I_IN) { transpose_item<0>(P.in[5], DM, INCOLS, Win_t, 0, r, F.lane); continue; } r -= I_IN;
        if (r < I_BR) { transpose_item<0>(P.in[20], 512, DM, Wbr_t, 0, r, F.lane, DM, 0); continue; } r -= I_BR;
        if (r < I_BR) { transpose_item<0>(P.in[21], 512, DM, Wbr_t, 0, r, F.lane, DM, 512); continue; } r -= I_BR;
        if (r < I_OUT) { transpose_item<0>(P.in[22], DM, DM, Wout_t, 0, r, F.lane); continue; } r -= I_OUT;
        if (r < I_UP) { transpose_item<0>(P.in[8], 64, 512, wup_t, 0, r, F.lane); continue; } r -= I_UP;
        if (r < I_UP) { transpose_item<0>(P.in[10], 64, 512, aup_t, 0, r, F.lane); continue; } r -= I_UP;
        transpose_item<0>(P.in[11], 128, 512, gup_t, 0, r, F.lane);
    }
    { bf16_t* wrh = (bf16_t*)(P.ws + WS_WRH); bf16_t* wrl = (bf16_t*)(P.ws + WS_WRL);
      for (int idx = (F.vcu * NWAVES * 64 + F.tid); idx < 64 * DM; idx += F.G * NWAVES * 64) { const int o = idx / DM, k = idx % DM;
          const float w = o < 4 ? P.in[24][k * 4 + o] : (o < 36 ? P.in[26][k * 32 + (o - 4)] : 0.f);
          const unsigned hi = cvt_pk_bf16(w, 0.f) & 0xffffu; const float rem = w - __uint_as_float(hi << 16); const unsigned lo = cvt_pk_bf16(rem, 0.f) & 0xffffu;
          wrh[idx] = (bf16_t)hi; wrl[idx] = (bf16_t)lo; } }
    { float* gam2 = (float*)(P.ws + WS_GAM2);
      for (int idx = (F.vcu * NWAVES * 64 + F.tid); idx < NB * DM; idx += F.G * NWAVES * 64) { const int b = idx / DM, k = idx % DM; gam2[idx] = P.in[23][k] * (1.f + mod[(size_t)b * MODW + 4 * DM + k]); } }
    { float* cb = (float*)(P.ws + WS_CB);
      for (int t = gw; t < NB * 36; t += NGW) { const int b = t / 36, o = t % 36; float s = 0.f;
          for (int k = F.lane; k < DM; k += 64) { const float w = o < 4 ? P.in[24][k * 4 + o] : P.in[26][k * 32 + (o - 4)]; s += mod[(size_t)b * MODW + 3 * DM + k] * w; }
          s = wave_sum(s); if (F.lane == 0) cb[b * 64 + o] = s + (o < 4 ? P.in[25][o] : P.in[27][o - 4]); } }
    bf16_t* H = (bf16_t*)((unsigned char*)P.out + DO_H);
    for (int m = gw; m < NTOK; m += NGW) {
        const int b = m / SEQ; const float* sh = mod + (size_t)b * MODW; const float* sc = sh + DM;
        const GAS f32x4* xr = (const GAS f32x4*)(P.in[0] + (size_t)m * DM) + F.lane;
        f32x4 v[4]; float s = 0.f;
#pragma unroll
        for (int j = 0; j < 4; ++j) { v[j] = xr[64 * j]; s += (v[j].x * v[j].x + v[j].y * v[j].y) + (v[j].z * v[j].z + v[j].w * v[j].w); }
        const float rinv = 1.f / sqrtf(wave_sum(s) * (1.f / DM) + 1e-6f);
        GAS u32x2* o8 = (GAS u32x2*)(H + (size_t)m * DM) + F.lane;
#pragma unroll
        for (int j = 0; j < 4; ++j) { const int k = 4 * F.lane + 256 * j; const f32x4 g = *(const f32x4*)(P.in[4] + k), s1 = *(const f32x4*)(sc + k), h1 = *(const f32x4*)(sh + k);
            const f32x4 hv = v[j] * rinv * g * (s1 + 1.f) + h1; u32x2 w; w.x = cvt_pk_bf16(hv.x, hv.y); w.y = cvt_pk_bf16(hv.z, hv.w); o8[64 * j] = w; }
    }
}
__device__ __forceinline__ void expert_convert(Frame& F, const Ptrs& P, int wv, int nwv, int it_lo, int it_hi) {
    bf16_t* Wgu = (bf16_t*)(P.ws + WS_WGU);
    constexpr int I_G = 16 * 16;
    for (int it = it_lo + wv; it < it_hi; it += nwv) {
        const int e = it / (2 * I_G), r = it % (2 * I_G);
        if (r < I_G) transpose_item<1>(P.in[28] + (size_t)e * DM * DE, DM, DE, Wgu + (size_t)e * DM * DM, 0, r, F.lane);
        else transpose_item<2>(P.in[29] + (size_t)e * DM * DE, DM, DE, Wgu + (size_t)e * DM * DM, 0, r - I_G, F.lane);
    }
}
__device__ __forceinline__ void expert_convert_down(Frame& F, const Ptrs& P, int wv, int nwv) {
    bf16_t* Wd = (bf16_t*)(P.ws + WS_WD);
    for (int it = wv; it < NE * 256; it += nwv) { const int e = it >> 8, r = it & 255; transpose_item<0>(P.in[30] + (size_t)e * DE * DM, DE, DM, Wd + (size_t)e * DM * DE, 0, r, F.lane); }
}
namespace att {
constexpr int SLOT = 16384, NSL = 5, L_WS = NSL * SLOT, L_OST = L_WS + 8 * 256, L_BIAS = L_OST + 8 * 4096, L_END = L_BIAS + 1280;
__device__ __forceinline__ int crow(int r, int hi) { return (r & 3) + 8 * (r >> 2) + 4 * hi; }
__device__ __forceinline__ float max3f(float a, float b, float c) { return fmaxf(fmaxf(a, b), c); }
__device__ __forceinline__ s16x4 vtr(const LAS char* p) { return __builtin_bit_cast(s16x4, __builtin_amdgcn_ds_read_tr16_b64_v4i16((LAS s16x4*)p)); }

__device__ __forceinline__ void attn_unit(Frame& F, const Ptrs& P, int b, int h, int qb) {
    const int tid = F.tid, lane = F.lane, wid = F.wave, r32 = lane & 31, hi = lane >> 5;
    const bf16_t* Patt = (const bf16_t*)(P.ws + WS_PATT);
    bf16_t* Ya = (bf16_t*)((unsigned char*)P.out + DO_YRA) + 512;
    LAS char* lds = (LAS char*)F.lds;
    LAS float* wsf = (LAS float*)(lds + L_WS) + wid * 64;
    LAS float* biasL = (LAS float*)(lds + L_BIAS);
    const int cq = wid >> 1, ci = qb * 4 + cq, kc0 = qb * 4 - 8;
    const size_t rowbase = (size_t)b * SEQ;
    for (int i = tid; i < 257; i += 512) biasL[i] = P.in[19][h * 257 + i] * LOG2E;
    const int srow = tid >> 3, sc8 = tid & 7;
    f32x4 kg0 = *(const f32x4*)(P.in[18] + 8 * sc8), kg1 = *(const f32x4*)(P.in[18] + 8 * sc8 + 4);
    const int kdst = sc8 * 1024 + srow * 16, vdst = 8192 + (sc8 >> 2) * 4096 + (srow >> 4) * 1024 + (srow & 15) * 64 + (sc8 & 3) * 16;
    auto ld_k = [&](int j) -> u32x4 { return *(const u32x4*)(Patt + (rowbase + (size_t)(kc0 + j) * 64 + srow) * ACOLS + 512 + h * 64 + 8 * sc8); };
    auto ld_v = [&](int j) -> u32x4 { return *(const u32x4*)(Patt + (rowbase + (size_t)(kc0 + j) * 64 + srow) * ACOLS + 1024 + h * 64 + 8 * sc8); };
    auto st_kv = [&](int j, u32x4 kw, u32x4 vw) {
        float kf[8] = {bf_lo(kw.x), bf_hi(kw.x), bf_lo(kw.y), bf_hi(kw.y), bf_lo(kw.z), bf_hi(kw.z), bf_lo(kw.w), bf_hi(kw.w)};
        float ss = 0.f;
#pragma unroll
        for (int i = 0; i < 8; ++i) ss += kf[i] * kf[i];
        ss = red8(ss); const float rk = 1.f / sqrtf(ss * (1.f / 64.f) + 1e-6f);
        u32x4 o; o.x = cvt_pk_bf16(kf[0] * rk * kg0.x, kf[1] * rk * kg0.y); o.y = cvt_pk_bf16(kf[2] * rk * kg0.z, kf[3] * rk * kg0.w);
        o.z = cvt_pk_bf16(kf[4] * rk * kg1.x, kf[5] * rk * kg1.y); o.w = cvt_pk_bf16(kf[6] * rk * kg1.z, kf[7] * rk * kg1.w);
        LAS char* sl = lds + (j % NSL) * SLOT;
        *(LAS u32x4*)(sl + kdst) = o; *(LAS u32x4*)(sl + vdst) = vw; };
    { u32x4 kws[4], vws[4];
#pragma unroll
      for (int j = 0; j < 4; ++j) if (kc0 + j >= 0) { kws[j] = ld_k(j); vws[j] = ld_v(j); }
#pragma unroll
      for (int j = 0; j < 4; ++j) if (kc0 + j >= 0) st_kv(j, kws[j], vws[j]); }
    const size_t qrow = rowbase + (size_t)ci * 64 + (wid & 1) * 32 + r32;
    bf16x8 qr[4];
    { float qf[4][8]; float ss = 0.f;
#pragma unroll
      for (int d0 = 0; d0 < 4; ++d0) { const u32x4 w = *(const u32x4*)(Patt + qrow * ACOLS + h * 64 + d0 * 16 + hi * 8);
          qf[d0][0] = bf_lo(w.x); qf[d0][1] = bf_hi(w.x); qf[d0][2] = bf_lo(w.y); qf[d0][3] = bf_hi(w.y); qf[d0][4] = bf_lo(w.z); qf[d0][5] = bf_hi(w.z); qf[d0][6] = bf_lo(w.w); qf[d0][7] = bf_hi(w.w);
#pragma unroll
          for (int i = 0; i < 8; ++i) ss += qf[d0][i] * qf[d0][i]; }
      ss += __shfl_xor(ss, 32);
      const float rq = (0.125f * LOG2E) / sqrtf(ss * (1.f / 64.f) + 1e-6f);
#pragma unroll
      for (int d0 = 0; d0 < 4; ++d0) { const f32x4 g0 = *(const f32x4*)(P.in[17] + d0 * 16 + hi * 8), g1 = *(const f32x4*)(P.in[17] + d0 * 16 + hi * 8 + 4);
          u32x4 o; o.x = cvt_pk_bf16(qf[d0][0] * rq * g0.x, qf[d0][1] * rq * g0.y); o.y = cvt_pk_bf16(qf[d0][2] * rq * g0.z, qf[d0][3] * rq * g0.w);
          o.z = cvt_pk_bf16(qf[d0][4] * rq * g1.x, qf[d0][5] * rq * g1.y); o.w = cvt_pk_bf16(qf[d0][6] * rq * g1.z, qf[d0][7] * rq * g1.w);
          qr[d0] = __builtin_bit_cast(bf16x8, o); } }
    u32x4 kA, vA; if (kc0 + 4 >= 0) { kA = ld_k(4); vA = ld_v(4); }
    float mrun = 0.f, lrun = 0.f; f32x16 o0 = {}, o1 = {};
    const int qloc = (wid & 1) * 32 + r32;
    __syncthreads();
#pragma unroll 1
    for (int s = 0; s < 9; ++s) {
        const int jn = s + 4; const bool ld = (jn <= 11) && (kc0 + jn >= 0);
        const bool ldn = (jn + 1 <= 11) && (kc0 + jn + 1 >= 0); u32x4 kB, vB; if (ldn) { kB = ld_k(jn + 1); vB = ld_v(jn + 1); }
        const int j = cq + s;
        if (kc0 + j >= 0) {
            const LAS char* sl = lds + (j % NSL) * SLOT;
            f32x16 p0, p1;
            if (s <= 5) { const float c0 = biasL[0] - mrun;
#pragma unroll
                for (int r = 0; r < 16; ++r) { p0[r] = c0; p1[r] = c0; } }
            else { const int base = 64 * (s - 8) - qloc + 128;
#pragma unroll
                for (int r = 0; r < 16; ++r) { int i0 = base + crow(r, hi), i1 = i0 + 32; i0 = i0 < 0 ? 0 : (i0 > 256 ? 256 : i0); i1 = i1 < 0 ? 0 : (i1 > 256 ? 256 : i1); p0[r] = biasL[i0] - mrun; p1[r] = biasL[i1] - mrun; } }
            const LAS char* kb = sl + hi * 1024 + r32 * 16;
#pragma unroll
            for (int d0 = 0; d0 < 4; ++d0) { const bf16x8 b0 = *(const LAS bf16x8*)(kb + d0 * 2048), b1 = *(const LAS bf16x8*)(kb + d0 * 2048 + 512);
                p0 = __builtin_amdgcn_mfma_f32_32x32x16_bf16(b0, qr[d0], p0, 0, 0, 0); p1 = __builtin_amdgcn_mfma_f32_32x32x16_bf16(b1, qr[d0], p1, 0, 0, 0); }
            float a = max3f(p0[0], p0[1], p1[0]), bm = max3f(p0[2], p0[3], p1[1]); a = max3f(a, p1[2], p1[3]);
#pragma unroll
            for (int r = 4; r < 16; r += 4) { a = max3f(a, p0[r], p0[r + 1]); bm = max3f(bm, p0[r + 2], p0[r + 3]); a = max3f(a, p1[r], p1[r + 1]); bm = max3f(bm, p1[r + 2], p1[r + 3]); }
            float rm = fmaxf(a, bm); rm = fmaxf(rm, __shfl_xor(rm, 32));
            if (__any(rm > 8.f)) {
                const float dl = fmaxf(rm, 0.f), f = __builtin_amdgcn_exp2f(-dl); mrun += dl; lrun *= f;
#pragma unroll
                for (int r = 0; r < 16; ++r) { p0[r] -= dl; p1[r] -= dl; }
                if (hi == 0) wsf[r32] = f;
                LDS_WAIT(); asm volatile("" ::: "memory");
#pragma unroll
                for (int r = 0; r < 16; ++r) { const float fr_ = wsf[crow(r, hi)]; o0[r] *= fr_; o1[r] *= fr_; }
            }
            float sacc = 0.f;
#pragma unroll
            for (int r = 0; r < 16; ++r) { p0[r] = __builtin_amdgcn_exp2f(p0[r]); p1[r] = __builtin_amdgcn_exp2f(p1[r]); sacc += p0[r] + p1[r]; }
            lrun += sacc;
            u32x4 pw0, pw1, pw2, pw3;
            pw0 = (u32x4){cvt_pk_bf16(p0[0], p0[1]), cvt_pk_bf16(p0[2], p0[3]), cvt_pk_bf16(p0[4], p0[5]), cvt_pk_bf16(p0[6], p0[7])};
            pw1 = (u32x4){cvt_pk_bf16(p0[8], p0[9]), cvt_pk_bf16(p0[10], p0[11]), cvt_pk_bf16(p0[12], p0[13]), cvt_pk_bf16(p0[14], p0[15])};
            pw2 = (u32x4){cvt_pk_bf16(p1[0], p1[1]), cvt_pk_bf16(p1[2], p1[3]), cvt_pk_bf16(p1[4], p1[5]), cvt_pk_bf16(p1[6], p1[7])};
            pw3 = (u32x4){cvt_pk_bf16(p1[8], p1[9]), cvt_pk_bf16(p1[10], p1[11]), cvt_pk_bf16(p1[12], p1[13]), cvt_pk_bf16(p1[14], p1[15])};
            const LAS char* vp = sl + 8192 + ((lane >> 4) & 1) * 32 + (lane & 3) * 8 + (4 * hi + ((lane & 15) >> 2)) * 64;
            const bf16x8 pa[4] = {__builtin_bit_cast(bf16x8, pw0), __builtin_bit_cast(bf16x8, pw1), __builtin_bit_cast(bf16x8, pw2), __builtin_bit_cast(bf16x8, pw3)};
#pragma unroll
            for (int ks = 0; ks < 4; ++ks) {
                const s16x4 l0 = vtr(vp + ks * 1024), h0 = vtr(vp + ks * 1024 + 512), l1 = vtr(vp + 4096 + ks * 1024), h1 = vtr(vp + 4096 + ks * 1024 + 512);
                const bf16x8 v0 = (bf16x8){l0[0], l0[1], l0[2], l0[3], h0[0], h0[1], h0[2], h0[3]}, v1 = (bf16x8){l1[0], l1[1], l1[2], l1[3], h1[0], h1[1], h1[2], h1[3]};
                o0 = __builtin_amdgcn_mfma_f32_32x32x16_bf16(pa[ks], v0, o0, 0, 0, 0); o1 = __builtin_amdgcn_mfma_f32_32x32x16_bf16(pa[ks], v1, o1, 0, 0, 0); }
        }
        if (ld) st_kv(jn, kA, vA);
        LBAR();
        kA = kB; vA = vB;
    }
    lrun += __shfl_xor(lrun, 32);
    if (hi == 0) wsf[32 + r32] = lrun;
    LDS_WAIT(); asm volatile("" ::: "memory");
    LAS bf16_t* stg = (LAS bf16_t*)(lds + L_OST) + wid * 2048;
#pragma unroll
    for (int r = 0; r < 16; ++r) { const int orow = crow(r, hi); const float rl = __builtin_amdgcn_rcpf(wsf[32 + orow]);
        stg[orow * 64 + r32] = (bf16_t)(cvt_pk_bf16(o0[r] * rl, 0.f) & 0xffffu); stg[orow * 64 + 32 + r32] = (bf16_t)(cvt_pk_bf16(o1[r] * rl, 0.f) & 0xffffu); }
    LDS_WAIT(); asm volatile("" ::: "memory");
    bf16_t* Ow = Ya + (rowbase + (size_t)ci * 64 + (wid & 1) * 32) * 1024 + h * 64;
#pragma unroll
    for (int i = 0; i < 4; ++i) { const int row = i * 8 + (lane >> 3), ch = lane & 7; const u32x4 v = *(const LAS u32x4*)(stg + row * 64 + ch * 8); *(u32x4*)(Ow + (size_t)row * 1024 + ch * 8) = v; }
    __syncthreads();
}
}

#ifndef TIME_PHASE
#define TIME_PHASE -1
#endif
#define PROF(k) do { if (TIME_PHASE >= 20 && blockIdx.x == 0 && F.tid == 0) { const unsigned now_ = (unsigned)__builtin_amdgcn_s_memrealtime(); F.MISC[16 + (k)] += now_ - F.MISC[15]; F.MISC[15] = now_; } } while (0)
namespace rc {
constexpr int LDB = 72, MB = 64 * LDB * 2;
constexpr int FLD = 68, FB = 64 * FLD * 4;
constexpr int L_AT = 0, L_BH = MB, L_BT = 2 * MB, L_KT = 3 * MB, L_RT = 4 * MB, L_KH = 5 * MB, L_V = 6 * MB;
constexpr int L_TWD = 0, L_AD = 9216, L_SGD = 18432;
constexpr int RB = 8 * MB;
constexpr int L_WL = RB, L_AL = RB + FB, L_GL = RB + 2 * FB, L_SEG = RB + 3 * FB;
constexpr int L_NQ0 = RB, L_NQ1 = RB + MB, L_NT0 = RB + 2 * MB, L_NT1 = RB + 3 * MB, L_TQ0 = RB + 4 * MB, L_TQ1 = RB + 5 * MB, L_NKT = RB + 6 * MB, L_NRB = RB + 7 * MB;
constexpr int L_GLD = RB + 8 * MB;
constexpr int L_W1T = L_NQ0, L_W2T = L_NT0, L_WY = L_AT, L_KC = L_BT;
constexpr int L_TAB = L_GLD + 256;
constexpr int T_MUL = 0, T_MUR = 256, T_PAR = 448, T_N = 832;
static_assert(L_SEG + 2048 <= L_GLD && L_TAB + T_N * 4 <= LDSCTL_OFF, "rwkv chunk LDS");

__device__ __forceinline__ void unpack8(const u32x4 w, float* f) { f[0] = bf_lo(w.x); f[1] = bf_hi(w.x); f[2] = bf_lo(w.y); f[3] = bf_hi(w.y); f[4] = bf_lo(w.z); f[5] = bf_hi(w.z); f[6] = bf_lo(w.w); f[7] = bf_hi(w.w); }
__device__ __forceinline__ f32x16 mm64(f32x16 acc, const LAS char* Arows, const LAS char* Bcols, int lane) {
    const int o = ((lane & 31) * LDB + 8 * (lane >> 5)) * 2;
#pragma unroll
    for (int ks = 0; ks < 4; ++ks) { const bf16x8 a = *(const LAS bf16x8*)(Arows + o + 32 * ks), b = *(const LAS bf16x8*)(Bcols + o + 32 * ks); acc = __builtin_amdgcn_mfma_f32_32x32x16_bf16(a, b, acc, 0, 0, 0); }
    return acc;
}
__device__ __forceinline__ s16x4 trrd(const LAS char* p) { return __builtin_bit_cast(s16x4, __builtin_amdgcn_ds_read_tr16_b64_v4i16((LAS s16x4*)p)); }
__device__ __forceinline__ int tr_off(int lane) { return ((8 * (lane >> 5) + ((lane & 15) >> 2)) * LDB + 16 * ((lane >> 4) & 1) + 4 * (lane & 3)) * 2; }
__device__ __forceinline__ bf16x8 frag_tr(const LAS char* Xb, int ks) {
    const s16x4 lo = trrd(Xb + (16 * ks) * LDB * 2), hi = trrd(Xb + (16 * ks + 4) * LDB * 2);
    return (bf16x8){lo[0], lo[1], lo[2], lo[3], hi[0], hi[1], hi[2], hi[3]};
}
__device__ __forceinline__ f32x16 mm64_btr(f32x16 acc, const LAS char* Arows, const LAS char* X, int nb, int lane) {
    const int o = ((lane & 31) * LDB + 8 * (lane >> 5)) * 2; const LAS char* xb = X + 64 * nb + tr_off(lane);
#pragma unroll
    for (int ks = 0; ks < 4; ++ks) { const bf16x8 a = *(const LAS bf16x8*)(Arows + o + 32 * ks), b = frag_tr(xb, ks); acc = __builtin_amdgcn_mfma_f32_32x32x16_bf16(a, b, acc, 0, 0, 0); }
    return acc;
}
__device__ __forceinline__ f32x16 mm64_atr(f32x16 acc, const LAS char* X, int mb, const LAS char* Bcols, int lane) {
    const int o = ((lane & 31) * LDB + 8 * (lane >> 5)) * 2; const LAS char* xb = X + 64 * mb + tr_off(lane);
#pragma unroll
    for (int ks = 0; ks < 4; ++ks) { const bf16x8 a = frag_tr(xb, ks), b = *(const LAS bf16x8*)(Bcols + o + 32 * ks); acc = __builtin_amdgcn_mfma_f32_32x32x16_bf16(a, b, acc, 0, 0, 0); }
    return acc;
}
__device__ __forceinline__ void store_T(const f32x16& d, LAS char* dst, int mb, int nb, int lane) {
    LAS char* p = dst + ((32 * nb + (lane & 31)) * LDB + 32 * mb + 4 * (lane >> 5)) * 2;
#pragma unroll
    for (int g = 0; g < 4; ++g) { u32x2 w; w.x = cvt_pk_bf16(d[4 * g], d[4 * g + 1]); w.y = cvt_pk_bf16(d[4 * g + 2], d[4 * g + 3]); *(LAS u32x2*)(p + 16 * g) = w; }
}
__device__ __forceinline__ void store_T_g(const f32x16& d, bf16_t* dst, int mb, int nb, int lane) {
    bf16_t* p = dst + (32 * nb + (lane & 31)) * 64 + 32 * mb + 4 * (lane >> 5);
#pragma unroll
    for (int g = 0; g < 4; ++g) { u32x2 w; w.x = cvt_pk_bf16(d[4 * g], d[4 * g + 1]); w.y = cvt_pk_bf16(d[4 * g + 2], d[4 * g + 3]); *(u32x2*)(p + 8 * g) = w; }
}
#define RC_M(r) (32 * mb + 8 * ((r) >> 2) + 4 * hi + ((r) & 3))

struct Raw { u32x4 lc[4], lp[4], rc[3], rp[3]; };
__device__ __forceinline__ void load_raw(Raw& R, const bf16_t* Prw, int u, int t, int cg) {
    const int b = u >> 8, h = (u >> 5) & 7, c = u & 31;
    const size_t row = (size_t)b * SEQ + 64 * c + t; const bool hasprev = (c > 0) || (t > 0);
    const bf16_t* pc = Prw + row * RCOLS; const bf16_t* pp = pc - RCOLS; const int lc0 = 1536 + 32 * cg, hd = h * 64 + 8 * cg;
#pragma unroll
    for (int q = 0; q < 4; ++q) { R.lc[q] = *(const u32x4*)(pc + lc0 + 8 * q); R.lp[q] = hasprev ? *(const u32x4*)(pp + lc0 + 8 * q) : (u32x4){0u, 0u, 0u, 0u}; }
#pragma unroll
    for (int w = 0; w < 3; ++w) { R.rc[w] = *(const u32x4*)(pc + w * 512 + hd); R.rp[w] = hasprev ? *(const u32x4*)(pp + w * 512 + hd) : (u32x4){0u, 0u, 0u, 0u}; }
}
__device__ __forceinline__ void chunk_phase(Frame& F, const Ptrs& P) {
  const bf16_t* Prw = (const bf16_t*)(P.ws + WS_PRW);
  int htab = -1; bf16x8 wA[4]; Raw raw;
  if (TIME_PHASE >= 20 && blockIdx.x == 0 && F.tid == 0) F.MISC[15] = (unsigned)__builtin_amdgcn_s_memrealtime();
  if ((int)blockIdx.x < NB * 8 * 32) load_raw(raw, Prw, (int)blockIdx.x, F.tid >> 3, F.tid & 7);
#pragma unroll 1
  for (int u_ = (int)blockIdx.x; u_ < NB * 8 * 32; u_ += F.G) {
    int tid = F.tid, wid = F.wave; asm volatile("" : "+v"(tid), "+s"(wid));
    const int b = u_ >> 8, h = (u_ >> 5) & 7, c = u_ & 31;
    const int lane = tid & 63, t = tid >> 3, cg = tid & 7, r32 = lane & 31, hi = lane >> 5;
    LAS char* lds = (LAS char*)F.lds;
    const size_t u = (size_t)((b * 8 + h) * 32 + c);
    bf16_t* gQe = (bf16_t*)(P.ws + WS_QE) + u * 4096; bf16_t* gYl = (bf16_t*)(P.ws + WS_YLOC) + u * 4096; bf16_t* gPc = (bf16_t*)(P.ws + WS_PC) + u * 4096; bf16_t* gSl = (bf16_t*)(P.ws + WS_SLOC) + u * 4096;
    bf16_t* gG = (bf16_t*)((unsigned char*)P.out + DO_G) + u * 4096; bf16_t* Yr = (bf16_t*)((unsigned char*)P.out + DO_YRA);
    const int hd = h * 64 + 8 * cg;
    const bool is_ad = (cg == 2 || cg == 3); const float alpha = cg < 2 ? 2.f : 1.f, gamma = cg < 2 ? -1.f : 0.f;
    LAS bf16_t* ldst = (LAS bf16_t*)(lds + (cg < 2 ? L_TWD : (cg < 4 ? L_AD : L_SGD))) + t * (cg < 4 ? 72 : 136) + 32 * (cg < 2 ? cg : (cg < 4 ? cg - 2 : cg - 4));
    const size_t row = (size_t)b * SEQ + 64 * c + t;
    LAS float* tab = (LAS float*)(lds + L_TAB);
    if (h != htab) {
        htab = h;
        for (int i = tid; i < T_N; i += 512) { float v;
            if (i < T_MUR) v = P.in[6][1536 + i]; else if (i < T_PAR) { const int w = (i - T_MUR) >> 6, d = (i - T_MUR) & 63; v = P.in[6][w * 512 + h * 64 + d]; }
            else { const int w = (i - T_PAR) >> 6, d = (i - T_PAR) & 63; const float* src = w == 0 ? P.in[7] : (w == 1 ? P.in[9] : (w == 2 ? P.in[12] : (w == 3 ? P.in[13] : (w == 4 ? P.in[14] : P.in[16])))); v = src[h * 64 + d]; }
            tab[i] = v; }
        const int jb = (wid >> 1) & 1;
        const bf16_t* wa = (const bf16_t*)(P.ws + (wid < 4 ? WS_WUP : WS_AUP)) + (size_t)(h * 64 + jb * 32 + r32) * 64 + 8 * hi;
#pragma unroll
        for (int ks = 0; ks < 4; ++ks) wA[ks] = *(const bf16x8*)(wa + 16 * ks);
        LBAR();
    }
    bf16x8 wG[8];
    { const bf16_t* wg = (const bf16_t*)(P.ws + WS_GUP) + (size_t)(h * 64 + ((wid >> 1) & 1) * 32 + r32) * 128 + 8 * hi;
#pragma unroll
      for (int ks = 0; ks < 8; ++ks) wG[ks] = *(const bf16x8*)(wg + 16 * ks); }
    float rv[8], kv[8], vv[8];
    { float cur[8], prv[8], mu[8];
#pragma unroll
      for (int q = 0; q < 4; ++q) {
          unpack8(raw.lc[q], cur); unpack8(raw.lp[q], prv);
          *(f32x4*)mu = *(const LAS f32x4*)(tab + T_MUL + 32 * cg + 8 * q); *(f32x4*)(mu + 4) = *(const LAS f32x4*)(tab + T_MUL + 32 * cg + 8 * q + 4);
          float o[8];
#pragma unroll
          for (int i = 0; i < 8; ++i) { const float xs = cur[i] + (prv[i] - cur[i]) * mu[i]; const float sg = sigmoidf_(alpha * xs); o[i] = is_ad ? xs : alpha * sg + gamma; }
          u32x4 w; w.x = cvt_pk_bf16(o[0], o[1]); w.y = cvt_pk_bf16(o[2], o[3]); w.z = cvt_pk_bf16(o[4], o[5]); w.w = cvt_pk_bf16(o[6], o[7]);
          *(LAS u32x4*)(ldst + 8 * q) = w; }
#pragma unroll
      for (int which = 0; which < 3; ++which) {
          unpack8(raw.rc[which], cur); unpack8(raw.rp[which], prv);
          *(f32x4*)mu = *(const LAS f32x4*)(tab + T_MUR + which * 64 + 8 * cg); *(f32x4*)(mu + 4) = *(const LAS f32x4*)(tab + T_MUR + which * 64 + 8 * cg + 4);
#pragma unroll
          for (int i = 0; i < 8; ++i) { const float xs = cur[i] + (prv[i] - cur[i]) * mu[i]; if (which == 0) rv[i] = xs; else if (which == 1) kv[i] = xs; else vv[i] = xs; } } }
    LBAR(); PROF(0);
    { const int ib = wid & 1, jb = (wid >> 1) & 1;
      auto wr4 = [&](const f32x16& acc, LAS float* Out) { LAS float* op = Out + (ib * 32 + r32) * FLD + jb * 32 + 4 * hi;
#pragma unroll
          for (int g = 0; g < 4; ++g) *(LAS f32x4*)(op + 8 * g) = (f32x4){acc[4 * g], acc[4 * g + 1], acc[4 * g + 2], acc[4 * g + 3]}; };
      { f32x16 acc = {}; const LAS bf16_t* qp = (const LAS bf16_t*)(lds + (wid < 4 ? L_TWD : L_AD)) + (ib * 32 + r32) * 72 + 8 * hi;
#pragma unroll
        for (int ks = 0; ks < 4; ++ks) acc = __builtin_amdgcn_mfma_f32_32x32x16_bf16(wA[ks], *(const LAS bf16x8*)(qp + 16 * ks), acc, 0, 0, 0);
        wr4(acc, (LAS float*)(lds + (wid < 4 ? L_WL : L_AL))); }
      if (wid < 4) { f32x16 acc = {}; const LAS bf16_t* qp = (const LAS bf16_t*)(lds + L_SGD) + (ib * 32 + r32) * 136 + 8 * hi;
#pragma unroll
        for (int ks = 0; ks < 8; ++ks) acc = __builtin_amdgcn_mfma_f32_32x32x16_bf16(wG[ks], *(const LAS bf16x8*)(qp + 16 * ks), acc, 0, 0, 0);
        wr4(acc, (LAS float*)(lds + L_GL)); } }
    LBAR(); PROF(1);
    float lam[8], av[8], bv[8], kp[8];
    const int o68 = t * FLD + 8 * cg;
    { float wl[8], al[8], gv[8];
      *(f32x4*)wl = *(LAS f32x4*)(lds + L_WL + 4 * o68); *(f32x4*)(wl + 4) = *(LAS f32x4*)(lds + L_WL + 4 * o68 + 16);
      *(f32x4*)al = *(LAS f32x4*)(lds + L_AL + 4 * o68); *(f32x4*)(al + 4) = *(LAS f32x4*)(lds + L_AL + 4 * o68 + 16);
      *(f32x4*)gv = *(LAS f32x4*)(lds + L_GL + 4 * o68); *(f32x4*)(gv + 4) = *(LAS f32x4*)(lds + L_GL + 4 * o68 + 16);
      float w0[8], a0[8], kk_[8], ka[8], rk[8], lb[8];
      { const LAS float* tp = tab + T_PAR + 8 * cg;
        *(f32x4*)w0 = *(const LAS f32x4*)(tp); *(f32x4*)(w0 + 4) = *(const LAS f32x4*)(tp + 4);
        *(f32x4*)a0 = *(const LAS f32x4*)(tp + 64); *(f32x4*)(a0 + 4) = *(const LAS f32x4*)(tp + 68);
        *(f32x4*)kk_ = *(const LAS f32x4*)(tp + 128); *(f32x4*)(kk_ + 4) = *(const LAS f32x4*)(tp + 132);
        *(f32x4*)ka = *(const LAS f32x4*)(tp + 192); *(f32x4*)(ka + 4) = *(const LAS f32x4*)(tp + 196);
        *(f32x4*)rk = *(const LAS f32x4*)(tp + 256); *(f32x4*)(rk + 4) = *(const LAS f32x4*)(tp + 260);
        *(f32x4*)lb = *(const LAS f32x4*)(tp + 320); *(f32x4*)(lb + 4) = *(const LAS f32x4*)(tp + 324); }
      float asg[8], kkv[8], c2[8]; float ss = 0.f, bon = 0.f;
#pragma unroll
      for (int i = 0; i < 8; ++i) { lam[i] = 0.60653065971f * sigmoidf_(w0[i] + wl[i]); asg[i] = sigmoidf_(a0[i] + al[i]);
          kkv[i] = kv[i] * kk_[i]; ss += kkv[i] * kkv[i]; kp[i] = kv[i] * (1.f + (asg[i] - 1.f) * ka[i]); bon += rv[i] * kp[i] * rk[i]; }
      ss = red8(ss); bon = red8(bon);
      const float inv = 1.f / fmaxf(sqrtf(ss), 1e-12f);
#pragma unroll
      for (int i = 0; i < 8; ++i) { const float kn = kkv[i] * inv; av[i] = -kn; bv[i] = kn * asg[i]; c2[i] = (lb[i] + bon * vv[i]) * gv[i]; }
      u32x4 w; w.x = cvt_pk_bf16(gv[0], gv[1]); w.y = cvt_pk_bf16(gv[2], gv[3]); w.z = cvt_pk_bf16(gv[4], gv[5]); w.w = cvt_pk_bf16(gv[6], gv[7]);
      *(u32x4*)(gG + t * 64 + 8 * cg) = w;
      w.x = cvt_pk_bf16(c2[0], c2[1]); w.y = cvt_pk_bf16(c2[2], c2[3]); w.z = cvt_pk_bf16(c2[4], c2[5]); w.w = cvt_pk_bf16(c2[6], c2[7]);
      *(u32x4*)(Yr + row * 1024 + hd) = w; }
    float cum[8];
    { const int tl = lane >> 3;
#pragma unroll
      for (int i = 0; i < 8; ++i) { float x = lam[i];
          float y = __shfl_up(x, 8); x += (tl >= 1) ? y : 0.f; y = __shfl_up(x, 16); x += (tl >= 2) ? y : 0.f; y = __shfl_up(x, 32); x += (tl >= 4) ? y : 0.f;
          cum[i] = x; }
      if (tl == 7) { *(LAS f32x4*)(lds + L_SEG + (wid * 64 + 8 * cg) * 4) = *(f32x4*)cum; *(LAS f32x4*)(lds + L_SEG + (wid * 64 + 8 * cg) * 4 + 16) = *(f32x4*)(cum + 4); } }
    LBAR(); PROF(2);
    { float pre[8], tot[8];
#pragma unroll
      for (int i = 0; i < 8; ++i) { pre[i] = 0.f; tot[i] = 0.f; }
      const int myseg = t >> 3;
#pragma unroll
      for (int s = 0; s < 8; ++s) { float sv[8]; *(f32x4*)sv = *(LAS f32x4*)(lds + L_SEG + (s * 64 + 8 * cg) * 4); *(f32x4*)(sv + 4) = *(LAS f32x4*)(lds + L_SEG + (s * 64 + 8 * cg) * 4 + 16);
#pragma unroll
          for (int i = 0; i < 8; ++i) { tot[i] += sv[i]; pre[i] += (s < myseg) ? sv[i] : 0.f; } }
      float at_[8], bt_[8], kt_[8], rt_[8], bh_[8], kh_[8];
#pragma unroll
      for (int i = 0; i < 8; ++i) { const float cm = cum[i] + pre[i];
          const float gi = __builtin_amdgcn_exp2f(cm * LOG2E), g_ = __builtin_amdgcn_exp2f(-cm * LOG2E), gm1 = __builtin_amdgcn_exp2f(-(cm - lam[i]) * LOG2E), glg = __builtin_amdgcn_exp2f(-(tot[i] - cm) * LOG2E);
          at_[i] = av[i] * gm1; bt_[i] = bv[i] * gi; kt_[i] = kp[i] * gi; rt_[i] = rv[i] * g_; bh_[i] = bv[i] * glg; kh_[i] = kp[i] * glg; }
      if (t == 0) { float gl[8];
#pragma unroll
          for (int i = 0; i < 8; ++i) gl[i] = __builtin_amdgcn_exp2f(-tot[i] * LOG2E);
          *(LAS f32x4*)(lds + L_GLD + 32 * cg) = *(f32x4*)gl; *(LAS f32x4*)(lds + L_GLD + 32 * cg + 16) = *(f32x4*)(gl + 4); }
      const int ob = (t * LDB + 8 * cg) * 2; u32x4 w;
      w.x = cvt_pk_bf16(at_[0], at_[1]); w.y = cvt_pk_bf16(at_[2], at_[3]); w.z = cvt_pk_bf16(at_[4], at_[5]); w.w = cvt_pk_bf16(at_[6], at_[7]); *(LAS u32x4*)(lds + L_AT + ob) = w;
      w.x = cvt_pk_bf16(bt_[0], bt_[1]); w.y = cvt_pk_bf16(bt_[2], bt_[3]); w.z = cvt_pk_bf16(bt_[4], bt_[5]); w.w = cvt_pk_bf16(bt_[6], bt_[7]); *(LAS u32x4*)(lds + L_BT + ob) = w;
      w.x = cvt_pk_bf16(kt_[0], kt_[1]); w.y = cvt_pk_bf16(kt_[2], kt_[3]); w.z = cvt_pk_bf16(kt_[4], kt_[5]); w.w = cvt_pk_bf16(kt_[6], kt_[7]); *(LAS u32x4*)(lds + L_KT + ob) = w;
      w.x = cvt_pk_bf16(rt_[0], rt_[1]); w.y = cvt_pk_bf16(rt_[2], rt_[3]); w.z = cvt_pk_bf16(rt_[4], rt_[5]); w.w = cvt_pk_bf16(rt_[6], rt_[7]); *(LAS u32x4*)(lds + L_RT + ob) = w;
      w.x = cvt_pk_bf16(bh_[0], bh_[1]); w.y = cvt_pk_bf16(bh_[2], bh_[3]); w.z = cvt_pk_bf16(bh_[4], bh_[5]); w.w = cvt_pk_bf16(bh_[6], bh_[7]); *(LAS u32x4*)(lds + L_BH + ob) = w;
      w.x = cvt_pk_bf16(kh_[0], kh_[1]); w.y = cvt_pk_bf16(kh_[2], kh_[3]); w.z = cvt_pk_bf16(kh_[4], kh_[5]); w.w = cvt_pk_bf16(kh_[6], kh_[7]); *(LAS u32x4*)(lds + L_KH + ob) = w;
      w.x = cvt_pk_bf16(vv[0], vv[1]); w.y = cvt_pk_bf16(vv[2], vv[3]); w.z = cvt_pk_bf16(vv[4], vv[5]); w.w = cvt_pk_bf16(vv[6], vv[7]); *(LAS u32x4*)(lds + L_V + ob) = w; }
    LBAR(); PROF(4);
    load_raw(raw, Prw, (u_ + F.G < NB * 8 * 32) ? u_ + F.G : u_, t, cg);
    {
    wid = __builtin_amdgcn_readfirstlane(wid); asm volatile("" : "+v"(tid), "+s"(wid));
    const int lane = tid & 63, r32 = lane & 31, hi = lane >> 5;
    const int mb = wid & 1, nb = (wid >> 1) & 1, grp = wid >> 2;
    const int ao = 32 * mb * LDB * 2, bo = 32 * nb * LDB * 2;
    const int ncol = 32 * nb + r32;
    f32x16 accT = {};
    {
        f32x16 d = {};
        if (grp == 0) { d = mm64(d, lds + L_AT + ao, lds + L_BT + bo, lane);
#pragma unroll
            for (int r = 0; r < 16; ++r) d[r] = (ncol < RC_M(r)) ? d[r] : 0.f;
            store_T(d, lds + L_NT0, mb, nb, lane); }
        else { d = mm64(d, lds + L_BT + ao, lds + L_AT + bo, lane);
#pragma unroll
            for (int r = 0; r < 16; ++r) { d[r] = (RC_M(r) < ncol) ? d[r] : 0.f; accT[r] = d[r] + ((RC_M(r) == ncol) ? 1.f : 0.f); }
            store_T(d, lds + L_NQ0, mb, nb, lane); store_T(accT, lds + L_TQ0, mb, nb, lane); }
        f32x16 e = {};
        if (grp == 0) { e = mm64(e, lds + L_AT + ao, lds + L_KT + bo, lane);
#pragma unroll
            for (int r = 0; r < 16; ++r) e[r] = (ncol < RC_M(r)) ? e[r] : 0.f;
            store_T(e, lds + L_NKT, mb, nb, lane); }
        else { e = mm64(e, lds + L_BT + ao, lds + L_RT + bo, lane);
#pragma unroll
            for (int r = 0; r < 16; ++r) e[r] = (RC_M(r) <= ncol) ? e[r] : 0.f;
            store_T(e, lds + L_NRB, mb, nb, lane); }
    }
    LBAR(); PROF(5);
#pragma unroll
    for (int j = 1; j <= 5; ++j) { const int cur = (j - 1) & 1, nw = j & 1;
        const int nq_c = cur ? L_NQ1 : L_NQ0, nt_c = cur ? L_NT1 : L_NT0, nq_n = nw ? L_NQ1 : L_NQ0, nt_n = nw ? L_NT1 : L_NT0;
        if (grp == 0) { f32x16 d = {};
            d = mm64(d, lds + nt_c + ao, lds + nq_c + bo, lane); store_T(d, lds + nq_n, mb, nb, lane);
            f32x16 e = {};
            e = mm64(e, lds + nq_c + ao, lds + nt_c + bo, lane); store_T(e, lds + nt_n, mb, nb, lane); }
        else if (j >= 2) { const int tq_r = nw ? L_TQ1 : L_TQ0, tq_w = cur ? L_TQ1 : L_TQ0;
            accT = mm64(accT, lds + nt_c + ao, lds + tq_r + bo, lane); store_T(accT, lds + tq_w, mb, nb, lane); }
        LBAR();
    }
    if (grp == 1) { accT = mm64(accT, lds + L_NT1 + ao, lds + L_TQ0 + bo, lane); store_T(accT, lds + L_TQ1, mb, nb, lane); }
    LBAR(); PROF(6);
    { f32x16 d = {};
      if (grp == 0) { d = mm64_btr(d, lds + L_TQ1 + ao, lds + L_AT, nb, lane); store_T(d, lds + L_W1T, mb, nb, lane); }
      else { d = mm64(d, lds + L_TQ1 + ao, lds + L_NKT + bo, lane); store_T(d, lds + L_W2T, mb, nb, lane); } }
    LBAR(); PROF(7);
    if (grp == 0) {
        f32x16 d = {}; d = mm64(d, lds + L_W1T + ao, lds + L_NRB + bo, lane);
#pragma unroll
        for (int g = 0; g < 4; ++g) { const u32x2 rw = *(const LAS u32x2*)(lds + L_RT + ((32 * nb + r32) * LDB + 32 * mb + 8 * g + 4 * hi) * 2);
            d[4 * g] += bf_lo(rw.x); d[4 * g + 1] += bf_hi(rw.x); d[4 * g + 2] += bf_lo(rw.y); d[4 * g + 3] += bf_hi(rw.y); }
        store_T_g(d, gQe, mb, nb, lane);
        f32x16 p = {}; p = mm64_btr(p, lds + L_W1T + ao, lds + L_BH, nb, lane);
        const float gl = ((const LAS float*)(lds + L_GLD))[ncol];
#pragma unroll
        for (int r = 0; r < 16; ++r) p[r] += (RC_M(r) == ncol) ? gl : 0.f;
        store_T_g(p, gPc, mb, nb, lane);
    } else {
        f32x16 d = {}; d = mm64(d, lds + L_KT + ao, lds + L_RT + bo, lane); d = mm64(d, lds + L_W2T + ao, lds + L_NRB + bo, lane);
#pragma unroll
        for (int r = 0; r < 16; ++r) d[r] = (RC_M(r) <= ncol) ? d[r] : 0.f;
        f32x16 k = {}; k = mm64_btr(k, lds + L_W2T + ao, lds + L_BH, nb, lane);
        { const LAS char* kb = lds + L_KH + 64 * nb + ((32 * mb + 4 * hi + ((lane & 15) >> 2)) * LDB + 16 * ((lane >> 4) & 1) + 4 * (lane & 3)) * 2;
#pragma unroll
          for (int g = 0; g < 4; ++g) { const s16x4 kw = trrd(kb + 8 * g * LDB * 2);
              k[4 * g] += bf_lo((unsigned)(unsigned short)kw[0]); k[4 * g + 1] += bf_lo((unsigned)(unsigned short)kw[1]); k[4 * g + 2] += bf_lo((unsigned)(unsigned short)kw[2]); k[4 * g + 3] += bf_lo((unsigned)(unsigned short)kw[3]); } }
        store_T(d, lds + L_WY, mb, nb, lane); store_T(k, lds + L_KC, mb, nb, lane);
    }
    LBAR(); PROF(8);
    { f32x16 d = {};
      if (grp == 0) { d = mm64_atr(d, lds + L_V, mb, lds + L_WY + bo, lane); store_T_g(d, gYl, mb, nb, lane); }
      else { d = mm64_btr(d, lds + L_KC + ao, lds + L_V, nb, lane); store_T_g(d, gSl, mb, nb, lane); } }
    LBAR(); PROF(9);
    }
  }
}

__device__ __forceinline__ void state_chain(Frame& F, const Ptrs& P, int bh) {
    const int tid = F.tid, lane = F.lane, wid = F.wave, r32 = lane & 31, hi = lane >> 5;
    LAS char* lds = (LAS char*)F.lds;
    const bf16_t* gPc = (const bf16_t*)(P.ws + WS_PC) + (size_t)bh * 32 * 4096; const bf16_t* gSl = (const bf16_t*)(P.ws + WS_SLOC) + (size_t)bh * 32 * 4096;
    bf16_t* gS = (bf16_t*)((unsigned char*)P.out + DO_SC) + (size_t)bh * 32 * 4096;
    constexpr int L_S0 = 0, L_S1 = MB, L_P = 2 * MB;
    for (int i = tid; i < MB / 4; i += 512) ((LAS unsigned*)(lds + L_S0))[i] = 0u;
    const int prow = tid >> 3, pch = tid & 7;
    u32x4 pw = *(const u32x4*)(gPc + prow * 64 + pch * 8);
    const int mb = wid & 1, nb = (wid >> 1) & 1;
    __syncthreads();
#pragma unroll 1
    for (int c = 0; c < 32; ++c) {
        const int sc = (c & 1) ? L_S1 : L_S0, sn = (c & 1) ? L_S0 : L_S1;
        *(LAS u32x4*)(lds + L_P + (prow * LDB + pch * 8) * 2) = pw;
        *(u32x4*)(gS + (size_t)c * 4096 + prow * 64 + pch * 8) = *(const LAS u32x4*)(lds + sc + (prow * LDB + pch * 8) * 2);
        if (c + 1 < 32) pw = *(const u32x4*)(gPc + (size_t)(c + 1) * 4096 + prow * 64 + pch * 8);
        f32x16 d = {};
        if (wid < 4) {
            const bf16_t* sp = gSl + (size_t)c * 4096 + (32 * nb + r32) * 64 + 32 * mb + 4 * hi;
#pragma unroll
            for (int g = 0; g < 4; ++g) { const u32x2 w = *(const u32x2*)(sp + 8 * g); d[4 * g] = bf_lo(w.x); d[4 * g + 1] = bf_hi(w.x); d[4 * g + 2] = bf_lo(w.y); d[4 * g + 3] = bf_hi(w.y); } }
        __syncthreads();
        if (wid < 4) { d = mm64(d, lds + L_P + 32 * mb * LDB * 2, lds + sc + 32 * nb * LDB * 2, lane); store_T(d, lds + sn, mb, nb, lane); }
        __syncthreads();
    }
}

__device__ __forceinline__ void out_unit(Frame& F, const Ptrs& P, int u, int nb, bool do_store = true) {
    const int lane = F.lane, r32 = lane & 31, hi = lane >> 5;
    const bf16_t* gQe = (const bf16_t*)(P.ws + WS_QE) + (size_t)u * 4096; const bf16_t* gYl = (const bf16_t*)(P.ws + WS_YLOC) + (size_t)u * 4096;
    const bf16_t* gS = (const bf16_t*)((unsigned char*)P.out + DO_SC) + (size_t)u * 4096; const bf16_t* gG = (const bf16_t*)((unsigned char*)P.out + DO_G) + (size_t)u * 4096;
    bf16_t* Yr = (bf16_t*)((unsigned char*)P.out + DO_YRA);
    const int bh = u >> 5, c = u & 31, h = bh & 7, b = bh >> 3;
    f32x16 y0 = {}, y1 = {};
#pragma unroll
    for (int ks = 0; ks < 4; ++ks) { const bf16x8 q = *(const bf16x8*)(gQe + (32 * nb + r32) * 64 + 16 * ks + 8 * hi);
        const bf16x8 s0 = *(const bf16x8*)(gS + r32 * 64 + 16 * ks + 8 * hi), s1 = *(const bf16x8*)(gS + (32 + r32) * 64 + 16 * ks + 8 * hi);
        y0 = __builtin_amdgcn_mfma_f32_32x32x16_bf16(s0, q, y0, 0, 0, 0); y1 = __builtin_amdgcn_mfma_f32_32x32x16_bf16(s1, q, y1, 0, 0, 0); }
    const int tl = 32 * nb + r32;
    const bf16_t* yl = gYl + tl * 64 + 4 * hi;
    float s = 0.f;
#pragma unroll
    for (int g = 0; g < 4; ++g) { const u32x2 a = *(const u32x2*)(yl + 8 * g), bq = *(const u32x2*)(yl + 32 + 8 * g);
        y0[4 * g] += bf_lo(a.x); y0[4 * g + 1] += bf_hi(a.x); y0[4 * g + 2] += bf_lo(a.y); y0[4 * g + 3] += bf_hi(a.y);
        y1[4 * g] += bf_lo(bq.x); y1[4 * g + 1] += bf_hi(bq.x); y1[4 * g + 2] += bf_lo(bq.y); y1[4 * g + 3] += bf_hi(bq.y); }
#pragma unroll
    for (int r = 0; r < 16; ++r) s += y0[r] + y1[r];
    s += __shfl_xor(s, 32); const float mean = s * (1.f / 64.f); float q2 = 0.f;
#pragma unroll
    for (int r = 0; r < 16; ++r) { y0[r] -= mean; y1[r] -= mean; q2 += y0[r] * y0[r] + y1[r] * y1[r]; }
    q2 += __shfl_xor(q2, 32); const float rstd = 1.f / sqrtf(q2 * (1.f / 64.f) + 64e-5f);
    const size_t row = (size_t)b * SEQ + 64 * c + tl;
    bf16_t* yo = Yr + row * 1024 + h * 64 + 4 * hi; const bf16_t* gg = gG + tl * 64 + 4 * hi; const float* lg = P.in[15] + h * 64 + 4 * hi;
#pragma unroll
    for (int g = 0; g < 4; ++g) {
#pragma unroll
        for (int eb = 0; eb < 2; ++eb) { const int eo = 32 * eb + 8 * g; const u32x2 gw = *(const u32x2*)(gg + eo), cw = *(const u32x2*)(yo + eo); const f32x4 l4 = *(const f32x4*)(lg + eo);
            const f32x16& y = eb ? y1 : y0;
#ifdef DIAG_NOY
            const float rstd_ = 0.f;
#else
            const float rstd_ = rstd;
#endif
            const float o0 = y[4 * g] * rstd_ * l4.x * bf_lo(gw.x) + bf_lo(cw.x), o1 = y[4 * g + 1] * rstd_ * l4.y * bf_hi(gw.x) + bf_hi(cw.x), o2 = y[4 * g + 2] * rstd_ * l4.z * bf_lo(gw.y) + bf_lo(cw.y), o3 = y[4 * g + 3] * rstd_ * l4.w * bf_hi(gw.y) + bf_hi(cw.y);
            u32x2 w; w.x = cvt_pk_bf16(o0, o1); w.y = cvt_pk_bf16(o2, o3);
#ifdef DIAG_ZERO
            w.x = 0u; w.y = 0u;
#endif
#ifdef DIAG_C2ONLY
            w = cw;
#endif
            if (do_store) *(u32x2*)(yo + eo) = w; } }
}
#undef RC_M
}
__device__ __forceinline__ void phase_route(Frame& F, const Ptrs& P) {
    const int lane = F.lane, gw = F.vcu * NWAVES + F.wave, NGW = F.G * NWAVES;
    const float* x1 = P.in[0]; const bf16_t* Dl = (const bf16_t*)(P.ws + WS_DELTA); const float* mod = (const float*)(P.ws + WS_MOD);
    const float* gam2 = (const float*)(P.ws + WS_GAM2); const float* cb = (const float*)(P.ws + WS_CB);
    const bf16_t* wrh = (const bf16_t*)(P.ws + WS_WRH); const bf16_t* wrl = (const bf16_t*)(P.ws + WS_WRL);
    bf16_t* H2 = (bf16_t*)(P.ws + WS_H2);
    int* tok_list = (int*)(P.ws + WS_TOKLIST); int* tok_pos = (int*)(P.ws + WS_TOKPOS); int* slot_tok = (int*)(P.ws + WS_SLOTTOK); float* slot_w = (float*)(P.ws + WS_SLOTW);
    unsigned* cnt = (unsigned*)(F.ctl + CW_CNT);
    LAS float* scr = (LAS float*)(F.lds) + F.wave * (16 * 52);
    const int fr = lane & 15, kq = lane >> 4;
    LAS unsigned* lcnt = (LAS unsigned*)(F.lds + 32768); LAS unsigned* lbase = lcnt + 64;
    for (int rnd = F.vcu; rnd < NTOK / 128; rnd += F.G) {
        if (F.tid < NLIST) lcnt[F.tid] = 0u;
        __syncthreads();
        const int R0 = rnd * 128 + F.wave * 16, b = R0 / SEQ;
        const float* xr = x1 + (size_t)(R0 + fr) * DM + 8 * kq; const bf16_t* dr = Dl + (size_t)(R0 + fr) * DM + 8 * kq; const float* gp = gam2 + (size_t)b * DM + 8 * kq;
        const bf16_t* bh = wrh + (size_t)fr * DM + 8 * kq; const bf16_t* bl = wrl + (size_t)fr * DM + 8 * kq;
        f32x4 acc[3] = {{0.f, 0.f, 0.f, 0.f}, {0.f, 0.f, 0.f, 0.f}, {0.f, 0.f, 0.f, 0.f}}; float ssq = 0.f;
#pragma unroll 2
        for (int k0 = 0; k0 < DM; k0 += 32) {
            f32x4 xa = *(const f32x4*)(xr + k0), xb = *(const f32x4*)(xr + k0 + 4); const f32x4 ga = *(const f32x4*)(gp + k0), gb = *(const f32x4*)(gp + k0 + 4);
            { const u32x4 dw = *(const u32x4*)(dr + k0); xa.x += bf_lo(dw.x); xa.y += bf_hi(dw.x); xa.z += bf_lo(dw.y); xa.w += bf_hi(dw.y); xb.x += bf_lo(dw.z); xb.y += bf_hi(dw.z); xb.z += bf_lo(dw.w); xb.w += bf_hi(dw.w); }
            ssq += (xa.x * xa.x + xa.y * xa.y) + (xa.z * xa.z + xa.w * xa.w) + (xb.x * xb.x + xb.y * xb.y) + (xb.z * xb.z + xb.w * xb.w);
            const f32x4 ya = xa * ga, yb = xb * gb;
            u32x4 hw; hw.x = cvt_pk_bf16(ya.x, ya.y); hw.y = cvt_pk_bf16(ya.z, ya.w); hw.z = cvt_pk_bf16(yb.x, yb.y); hw.w = cvt_pk_bf16(yb.z, yb.w);
            u32x4 lw; lw.x = cvt_pk_bf16(ya.x - bf_lo(hw.x), ya.y - bf_hi(hw.x)); lw.y = cvt_pk_bf16(ya.z - bf_lo(hw.y), ya.w - bf_hi(hw.y));
            lw.z = cvt_pk_bf16(yb.x - bf_lo(hw.z), yb.y - bf_hi(hw.z)); lw.w = cvt_pk_bf16(yb.z - bf_lo(hw.w), yb.w - bf_hi(hw.w));
            const bf16x8 ah = __builtin_bit_cast(bf16x8, hw), al = __builtin_bit_cast(bf16x8, lw);
#pragma unroll
            for (int nb = 0; nb < 3; ++nb) { const bf16x8 wh = *(const bf16x8*)(bh + (size_t)nb * 16 * DM + k0), wl = *(const bf16x8*)(bl + (size_t)nb * 16 * DM + k0);
                acc[nb] = __builtin_amdgcn_mfma_f32_16x16x32_bf16(ah, wh, acc[nb], 0, 0, 0); acc[nb] = __builtin_amdgcn_mfma_f32_16x16x32_bf16(al, wh, acc[nb], 0, 0, 0); acc[nb] = __builtin_amdgcn_mfma_f32_16x16x32_bf16(ah, wl, acc[nb], 0, 0, 0); }
        }
        ssq += __shfl_xor(ssq, 16); ssq += __shfl_xor(ssq, 32);
        const float rinv = 1.f / sqrtf(ssq * (1.f / DM) + 1e-6f);
#pragma unroll
        for (int nb = 0; nb < 3; ++nb)
#pragma unroll
            for (int j = 0; j < 4; ++j) scr[(4 * kq + j) * 52 + 16 * nb + fr] = acc[nb][j];
        LDS_WAIT(); asm volatile("" ::: "memory");
        int l1 = 0, l2 = 0, q1 = 0, q2 = 0; float w1 = 0.f, w2 = 0.f;
        if (lane < 16) {
            const float* cbb = cb + b * 64; const LAS float* lr = scr + lane * 52;
            float lc[4]; int grp = 0; float best = -3.4e38f;
#pragma unroll
            for (int o = 0; o < 4; ++o) { lc[o] = rinv * lr[o] + cbb[o]; if (lc[o] > best) { best = lc[o]; grp = o; } }
            float den = 0.f;
#pragma unroll
            for (int o = 0; o < 4; ++o) den += __expf(lc[o] - best);
            const float pgrp = 1.f / den;
            float f1 = -3.4e38f, f2 = -3.4e38f; int i1 = 0, i2 = 0;
            for (int o = 0; o < 8; ++o) { const float v = rinv * lr[4 + grp * 8 + o] + cbb[4 + grp * 8 + o];
                if (v > f1) { f2 = f1; i2 = i1; f1 = v; i1 = o; } else if (v > f2) { f2 = v; i2 = o; } }
            const float e2 = __expf(f2 - f1); w1 = pgrp / (1.f + e2); w2 = pgrp * e2 / (1.f + e2);
            l1 = (grp * 8 + i1) * 2; l2 = (grp * 8 + i2) * 2 + 1;
            q1 = (int)__hip_atomic_fetch_add(lcnt + l1, 1u, __ATOMIC_RELAXED, __HIP_MEMORY_SCOPE_WORKGROUP); q2 = (int)__hip_atomic_fetch_add(lcnt + l2, 1u, __ATOMIC_RELAXED, __HIP_MEMORY_SCOPE_WORKGROUP);
        }
        __syncthreads();
        if (F.tid < NLIST) { const unsigned c = ((LAS unsigned*)lcnt)[F.tid]; lbase[F.tid] = c ? atomicAdd(cnt + 64 * F.tid, c) : 0u; }
        __syncthreads();
        if (lane < 16) { const int tok = R0 + lane;
            const int p1 = (int)lbase[l1] + q1, p2 = (int)lbase[l2] + q2;
            tok_list[2 * tok] = l1; tok_list[2 * tok + 1] = l2; tok_pos[2 * tok] = p1; tok_pos[2 * tok + 1] = p2;
            slot_tok[(size_t)l1 * NTOK + p1] = tok; slot_tok[(size_t)l2 * NTOK + p2] = tok; slot_w[(size_t)l1 * NTOK + p1] = w1; slot_w[(size_t)l2 * NTOK + p2] = w2; }
        const float* sh = mod + (size_t)b * MODW + 3 * DM;
#pragma unroll 4
        for (int r = 0; r < 16; ++r) { const float ri = __shfl(rinv, r);
            const GAS f32x4* xrow = (const GAS f32x4*)(x1 + (size_t)(R0 + r) * DM) + lane; const GAS u32x2* drow = (const GAS u32x2*)(Dl + (size_t)(R0 + r) * DM) + lane; GAS u32x2* o8 = (GAS u32x2*)(H2 + (size_t)(R0 + r) * DM) + lane;
#pragma unroll
            for (int j = 0; j < 4; ++j) { const int k = 4 * lane + 256 * j; f32x4 xv = xrow[64 * j]; const u32x2 dw = drow[64 * j]; xv.x += bf_lo(dw.x); xv.y += bf_hi(dw.x); xv.z += bf_lo(dw.y); xv.w += bf_hi(dw.y); const f32x4 g = *(const f32x4*)(gam2 + (size_t)b * DM + k), s = *(const f32x4*)(sh + k);
                const f32x4 hv = xv * ri * g + s; u32x2 w; w.x = cvt_pk_bf16(hv.x, hv.y); w.y = cvt_pk_bf16(hv.z, hv.w); o8[64 * j] = w; } }
        LDS_WAIT(); asm volatile("" ::: "memory");
    }
}
__device__ __forceinline__ void moe_offsets(Frame& F) {
    LAS int* toff = (LAS int*)(F.lds + TOFF_OFF); LAS int* lcnt = (LAS int*)(F.lds + LCNT_OFF); LAS unsigned char* tile_l = (LAS unsigned char*)(F.lds + TILE_L_OFF);
    if (F.tid < NLIST) lcnt[F.tid] = (int)__hip_atomic_load(F.ctl + CW_CNT + 64 * F.tid, RLX_AGENT);
    __syncthreads();
    if (F.tid == 0) { int acc = 0;
#pragma unroll 1
        for (int l = 0; l < NLIST; ++l) { toff[l] = acc; acc += (lcnt[l] + 255) >> 8; } toff[NLIST] = acc; }
    __syncthreads();
    if (F.tid < NLIST) { for (int t = toff[F.tid]; t < toff[F.tid + 1]; ++t) tile_l[t] = (unsigned char)F.tid; }
    __syncthreads();
}
#ifndef MK_ONE_LAUNCH
#define MK_ONE_LAUNCH 1
#endif
constexpr int N_PHASES = 12;

__global__ void __launch_bounds__(NWAVES * 64, 2) fwd_kernel(Args args) {
    extern __shared__ __attribute__((aligned(16))) unsigned char lds_raw[];
    Frame F; F.lds = (LAS unsigned char*)lds_raw; F.MISC = (volatile LAS unsigned*)(F.lds + MISC_OFF);
    F.tid = threadIdx.x; F.lane = F.tid & 63; F.wave = __builtin_amdgcn_readfirstlane(F.tid >> 6);
    F.G = gridDim.x; { const int bx = blockIdx.x; F.vcu = (F.G % 8 == 0) ? (bx % 8) * (F.G / 8) + bx / 8 : bx; }
#ifndef DUP_PHASE
#define DUP_PHASE -1
#endif
#define RELOAD_ARGS() Ptrs P; { int z_ = 0; asm volatile("" : "+s"(z_)); _Pragma("unroll") for (int i_ = 0; i_ < 31; ++i_) P.in[i_] = args.in[i_] + z_; P.out = args.out + z_; P.ws = args.ws + z_; }
    F.ctl = (gu32*)(args.ws + WS_CTL);
    for (int u = F.tid; u < (LDS_BYTES - LDSCTL_OFF) / 4; u += NWAVES * 64) ((LAS unsigned*)(F.lds + LDSCTL_OFF))[u] = 0u;
    __syncthreads();
    XcdBarrier bar; bar.bar = (unsigned*)(F.ctl + CW_BAR); bar.x = 0; bar.st = nullptr;
#if MK_ONE_LAUNCH
    bar = xcd_barrier_post((unsigned*)(F.ctl + CW_BAR), F.MISC + 8);
#define GRID_BAR() xcd_barrier(bar)
#else
#define GRID_BAR() do { } while (0)
#endif
    const int lo = args.ph_lo, hi = args.ph_hi;
#ifndef PH_MASK
#define PH_MASK 0xfff
#endif
#define IN(k) ((((PH_MASK) >> (k)) & 1) && lo <= (k) && (k) < hi)
#ifndef TIME_PHASE
#define TIME_PHASE -1
#endif
#define STAMP(i) do { if (TIME_PHASE >= 0 && blockIdx.x == 0 && F.tid == 0) ((unsigned long long*)(args.ws + WS_CTL + 768 * KiB))[i] = __builtin_amdgcn_s_memrealtime(); } while (0)
#define SEAM(k) do { if (IN(k) && IN((k) + 1)) GRID_BAR(); STAMP((k) + 1); } while (0)
    STAMP(0);
#define MODP ((float*)(P.ws + WS_MOD))
#define PGATE ((unsigned char*)(P.ws + WS_PGATE))

    if (IN(0)) for (int rep_ = 0; rep_ < ((0) == DUP_PHASE ? 2 : 1); ++rep_) { if (rep_) GRID_BAR(); RELOAD_ARGS(); phase_mod(F, P.in[1], P.in[2], P.in[3], MODP); } SEAM(0);
    if (IN(1)) for (int rep_ = 0; rep_ < ((1) == DUP_PHASE ? 2 : 1); ++rep_) { if (rep_) GRID_BAR(); RELOAD_ARGS(); phase_prep(F, P); } SEAM(1);
    if (IN(2)) for (int rep_ = 0; rep_ < ((2) == DUP_PHASE ? 2 : 1); ++rep_) { if (rep_) GRID_BAR(); RELOAD_ARGS();
        pg8::Gemm g{DM, DM, DM}; pg8::DenseOrder S; S.init((const bf16_t*)((unsigned char*)P.out + DO_H), (const bf16_t*)(P.ws + WS_WIN), DM, DM, NTOK, INCOLS, F.G, (int)blockIdx.x);
        pg8::EpiP E{(bf16_t*)(P.ws + WS_PRW), (bf16_t*)(P.ws + WS_PATT), PGATE};
        pg8::gemm_phase<pg8::EpiP, pg8::DenseOrder, true>(F.lds, g, S, E);
        { const int nfull = (NTOK / 256) * (INCOLS / 256) % F.G; const int bx = (int)blockIdx.x; if (nfull > 0 && bx >= nfull) expert_convert_down(F, P, (bx - nfull) * NWAVES + F.wave, (F.G - nfull) * NWAVES); else if (nfull == 0) expert_convert_down(F, P, bx * NWAVES + F.wave, F.G * NWAVES); }
    } SEAM(2);
    if (IN(3)) for (int rep_ = 0; rep_ < ((3) == DUP_PHASE ? 2 : 1); ++rep_) { if (rep_) GRID_BAR(); RELOAD_ARGS();
#pragma unroll 1
        for (int r2 = 0; r2 < (DUP_PHASE == 31 ? 2 : 1); ++r2)
#pragma unroll 1
        for (int u = (int)blockIdx.x; u < NB * 8 * 8; u += F.G) att::attn_unit(F, P, u >> 6, (u >> 3) & 7, u & 7);
        __syncthreads();
#pragma unroll 1
        for (int r2 = 0; r2 < (DUP_PHASE == 30 ? 2 : 1); ++r2) rc::chunk_phase(F, P);
        if (TIME_PHASE >= 20 && blockIdx.x == 0 && F.tid == 0) { unsigned long long* tsp = (unsigned long long*)(args.ws + WS_CTL + 768 * KiB); unsigned long long a_ = 0; tsp[20] = 0; for (int k_ = 0; k_ < 10; ++k_) { a_ += F.MISC[16 + k_]; tsp[21 + k_] = a_; } }
    } SEAM(3);
    constexpr int EC_ITEMS = NE * 2 * 256, EC_SPLIT = EC_ITEMS;
    if (IN(4)) for (int rep_ = 0; rep_ < ((4) == DUP_PHASE ? 2 : 1); ++rep_) { if (rep_) GRID_BAR(); RELOAD_ARGS();
        const int nR = F.G >= 256 ? 128 : F.G / 2, bx = (int)blockIdx.x;
        if (bx < nR) { for (int u = bx; u < NB * 8; u += nR) rc::state_chain(F, P, u); }
        else { const int na = F.G - nR, a = bx - nR; expert_convert(F, P, a * NWAVES + F.wave, na * NWAVES, 0, EC_SPLIT); }
    } SEAM(4);
    if (IN(5)) for (int rep_ = 0; rep_ < ((5) == DUP_PHASE ? 2 : 1); ++rep_) { if (rep_) GRID_BAR(); RELOAD_ARGS();
        const int gw = (int)blockIdx.x * NWAVES + F.wave, NGW = F.G * NWAVES;
        for (int w = gw; w < NB * 8 * 32 * 2; w += NGW) rc::out_unit(F, P, w >> 1, w & 1, !(DUP_PHASE == 5 && rep_ == 0));
        expert_convert(F, P, gw, NGW, EC_SPLIT, EC_ITEMS);
    } SEAM(5);
    if (IN(6)) for (int rep_ = 0; rep_ < ((6) == DUP_PHASE ? 2 : 1); ++rep_) { if (rep_) GRID_BAR(); RELOAD_ARGS();
        pg8::Gemm g{DM, DM, DM}; pg8::DenseOrder S; S.init((const bf16_t*)((unsigned char*)P.out + DO_YRA), (const bf16_t*)(P.ws + WS_WBR), DM, DM, NTOK, DM, F.G, (int)blockIdx.x);
        pg8::EpiMix E{(bf16_t*)(P.ws + WS_T), PGATE}; pg8::gemm_phase<pg8::EpiMix, pg8::DenseOrder, true>(F.lds, g, S, E);
    } SEAM(6);
    if (IN(7)) for (int rep_ = 0; rep_ < ((7) == DUP_PHASE ? 2 : 1); ++rep_) { if (rep_) GRID_BAR(); RELOAD_ARGS();
        pg8::Gemm g{DM, DM, DM}; pg8::DenseOrder S; S.init((const bf16_t*)(P.ws + WS_T), (const bf16_t*)(P.ws + WS_WOUT), DM, DM, NTOK, DM, F.G, (int)blockIdx.x);
        pg8::EpiDelta E{(bf16_t*)(P.ws + WS_DELTA), MODP}; pg8::gemm_phase<pg8::EpiDelta, pg8::DenseOrder, true>(F.lds, g, S, E);
    } SEAM(7);
    if (IN(8)) for (int rep_ = 0; rep_ < ((8) == DUP_PHASE ? 2 : 1); ++rep_) { if (rep_) GRID_BAR(); RELOAD_ARGS(); phase_route(F, P); } SEAM(8);
    if (IN(9)) for (int rep_ = 0; rep_ < ((9) == DUP_PHASE ? 2 : 1); ++rep_) { if (rep_) GRID_BAR(); RELOAD_ARGS();
        moe_offsets(F); const LAS int* toff = (const LAS int*)(F.lds + TOFF_OFF);
        pg8::Gemm g{DM, DM, DM}; pg8::MoeOrderT<true> S{(const bf16_t*)(P.ws + WS_H2), (const bf16_t*)(P.ws + WS_WGU), DM, DM, (size_t)DM * DM, (const LAS unsigned char*)(F.lds + TILE_L_OFF), toff, (const LAS int*)(F.lds + LCNT_OFF), 0, toff[NLIST], F.G, (int)blockIdx.x, (const int*)(P.ws + WS_SLOTTOK)};
        pg8::EpiHid E{(bf16_t*)(P.ws + WS_HID)}; pg8::gemm_phase<pg8::EpiHid, pg8::MoeOrderT<true>, true>(F.lds, g, S, E);
    } SEAM(9);
    if (IN(10)) for (int rep_ = 0; rep_ < ((10) == DUP_PHASE ? 2 : 1); ++rep_) { if (rep_) GRID_BAR(); RELOAD_ARGS();
        moe_offsets(F); const LAS int* toff = (const LAS int*)(F.lds + TOFF_OFF);
        pg8::Gemm g{DE, DE, DE}; pg8::MoeOrderT<false> S{(const bf16_t*)(P.ws + WS_HID), (const bf16_t*)(P.ws + WS_WD), DE, DE, (size_t)DM * DE, (const LAS unsigned char*)(F.lds + TILE_L_OFF), toff, (const LAS int*)(F.lds + LCNT_OFF), 0, toff[NLIST], F.G, (int)blockIdx.x, nullptr};
        pg8::EpiY E{(bf16_t*)(P.ws + WS_YB), (const float*)(P.ws + WS_SLOTW)}; pg8::gemm_phase<pg8::EpiY, pg8::MoeOrderT<false>, true>(F.lds, g, S, E);
    } SEAM(10);
    if (IN(11)) for (int rep_ = 0; rep_ < ((11) == DUP_PHASE ? 2 : 1); ++rep_) { if (rep_) GRID_BAR(); RELOAD_ARGS();
        moe_offsets(F); const LAS int* toff = (const LAS int*)(F.lds + TOFF_OFF);
        const bf16_t* Yb = (const bf16_t*)(P.ws + WS_YB); const int* tok_list = (const int*)(P.ws + WS_TOKLIST); const int* tok_pos = (const int*)(P.ws + WS_TOKPOS);
        const float* mod = MODP; const int gw = F.vcu * NWAVES + F.wave, NGW = F.G * NWAVES;
#pragma unroll 4
        for (int tok = gw; tok < NTOK; tok += NGW) {
            const int s0 = toff[tok_list[2 * tok]] * 256 + tok_pos[2 * tok], s1 = toff[tok_list[2 * tok + 1]] * 256 + tok_pos[2 * tok + 1];
            const float* g2 = mod + (size_t)(tok / SEQ) * MODW + 5 * DM;
            GAS f32x4* xo = (GAS f32x4*)(P.out + (size_t)tok * DM) + F.lane; const GAS f32x4* xi = (const GAS f32x4*)(P.in[0] + (size_t)tok * DM) + F.lane; const GAS u32x2* dd = (const GAS u32x2*)((const bf16_t*)(P.ws + WS_DELTA) + (size_t)tok * DM) + F.lane;
            const GAS u32x2* y0 = (const GAS u32x2*)(Yb + (size_t)s0 * DM) + F.lane; const GAS u32x2* y1 = (const GAS u32x2*)(Yb + (size_t)s1 * DM) + F.lane;
#pragma unroll
            for (int j = 0; j < 4; ++j) { f32x4 xv = xi[64 * j]; const u32x2 dw = dd[64 * j]; xv.x += bf_lo(dw.x); xv.y += bf_hi(dw.x); xv.z += bf_lo(dw.y); xv.w += bf_hi(dw.y); const u32x2 a = y0[64 * j], bq = y1[64 * j]; const f32x4 gv = *(const f32x4*)(g2 + 4 * F.lane + 256 * j);
                f32x4 o; o.x = xv.x + gv.x * (bf_lo(a.x) + bf_lo(bq.x)); o.y = xv.y + gv.y * (bf_hi(a.x) + bf_hi(bq.x)); o.z = xv.z + gv.z * (bf_lo(a.y) + bf_lo(bq.y)); o.w = xv.w + gv.w * (bf_hi(a.y) + bf_hi(bq.y));
                xo[64 * j] = o; }
        }
    }
#ifdef EXTRA_BARS
    for (int i_ = 0; i_ < EXTRA_BARS; ++i_) GRID_BAR();
#endif
#if TIME_PHASE >= 0
    {
#ifndef TIME_SCALE
#define TIME_SCALE 3.0e-4f
#endif
#ifndef TIME_HI
#define TIME_HI (TIME_PHASE + 1)
#endif
        STAMP(12); GRID_BAR();
        const unsigned long long* ts = (const unsigned long long*)(args.ws + WS_CTL + 768 * KiB);
        const float dlt = (float)(ts[TIME_HI] - ts[TIME_PHASE]) * (0.01f * TIME_SCALE);
        for (int i = blockIdx.x * 512 + F.tid; i < (1 << 20); i += gridDim.x * 512) args.out[i] += dlt;
    }
#endif
#undef IN
#undef SEAM
}

extern "C" void kernel_launch(void* const* d_in, const int* in_sizes, int n_in, void* d_out, int out_size, void* d_ws, size_t ws_size, hipStream_t stream) {
    static int grid = 0;
    if (grid == 0) {
        if (n_in != 31 || out_size != NTOK * DM || ws_size < WS_END) { fprintf(stderr, "kernel_launch: unexpected shapes (n_in %d out %d ws %zu)\n", n_in, out_size, ws_size); grid = -1; return; }
        int dev = 0, cus = 0;
        if (hipGetDevice(&dev) != hipSuccess || hipDeviceGetAttribute(&cus, hipDeviceAttributeMultiprocessorCount, dev) != hipSuccess) { grid = -1; return; }
        if (hipFuncSetAttribute((const void*)fwd_kernel, hipFuncAttributeMaxDynamicSharedMemorySize, LDS_BYTES) != hipSuccess) { fprintf(stderr, "kernel_launch: hipFuncSetAttribute failed\n"); grid = -1; return; }
        int per_cu = 0; (void)hipOccupancyMaxActiveBlocksPerMultiprocessor(&per_cu, (const void*)fwd_kernel, NWAVES * 64, LDS_BYTES); (void)hipGetLastError();
        grid = cus;
    }
    if (grid < 0) return;
    (void)hipMemsetAsync((char*)d_ws + WS_CTL, 0, CTL_ZERO_BYTES, stream);
    Args a{};
    for (int i = 0; i < 31; ++i) a.in[i] = (const float*)d_in[i];
    a.out = (float*)d_out; a.ws = (unsigned char*)d_ws;
#if MK_ONE_LAUNCH
    a.ph_lo = 0; a.ph_hi = N_PHASES;
    hipLaunchKernelGGL(fwd_kernel, dim3(grid), dim3(NWAVES * 64), LDS_BYTES, stream, a);
#else
    for (int p = 0; p < N_PHASES; ++p) { a.ph_lo = p; a.ph_hi = p + 1; hipLaunchKernelGGL(fwd_kernel, dim3(grid), dim3(NWAVES * 64), LDS_BYTES, stream, a); }
#endif
}
```

```cpp
#include <hip/hip_runtime.h>
#include <cstdio>
#include <cstdint>

#define LAS __attribute__((address_space(3)))
#define GAS __attribute__((address_space(1)))
typedef unsigned short bf16_t;
typedef short bf16x8 __attribute__((ext_vector_type(8)));
typedef short s16x4 __attribute__((ext_vector_type(4)));
typedef float f32x4 __attribute__((ext_vector_type(4)));
typedef float f32x2 __attribute__((ext_vector_type(2)));
typedef float f32x16 __attribute__((ext_vector_type(16)));
typedef unsigned u32x4 __attribute__((ext_vector_type(4)));
typedef unsigned u32x2 __attribute__((ext_vector_type(2)));

constexpr int NB = 16, SEQ = 2048, DM = 1024, NTOK = NB * SEQ;
constexpr int RCOLS = 1792, ACOLS = 1536, GCOLS = 2048, INCOLS = 5376;
constexpr int NE = 32, DE = 512, NLIST = 64;
constexpr int MODW = 6 * DM;
constexpr float LOG2E = 1.4426950408889634f;

typedef __bf16 bf16x2_t __attribute__((ext_vector_type(2)));
__device__ __forceinline__ unsigned cvt_pk_bf16(float lo, float hi) { const f32x2 v = {lo, hi}; const bf16x2_t b = __builtin_convertvector(v, bf16x2_t); return __builtin_bit_cast(unsigned, b); }
__device__ __forceinline__ float bf_lo(unsigned w) { return __uint_as_float(w << 16); }
__device__ __forceinline__ float bf_hi(unsigned w) { return __uint_as_float(w & 0xffff0000u); }
__device__ __forceinline__ float sigmoidf_(float x) { return __builtin_amdgcn_rcpf(1.0f + __builtin_amdgcn_exp2f(-x * LOG2E)); }

namespace pg8 {
constexpr int BM = 256, BK = 64, HALF = 128, HTB = HALF * BK * 2, STAGE_BYTES = 8 * HTB, NXCD = 8, WGM = 8;
__host__ __device__ __forceinline__ int lds_byte(int r, int c) { const int st = (r >> 4) * 2 + (c >> 5), rr = r & 15, cc = c & 31, ob = rr * 64 + cc * 2; return st * 1024 + (ob ^ (((ob >> 9) & 1) << 5)); }
__host__ __device__ __forceinline__ void stage_rc(int b, int& R, int& C) { const int st = b / 1024, sb = b % 1024, swz = sb ^ (((sb >> 9) & 1) << 5); R = (st >> 1) * 16 + swz / 64; C = (st & 1) * 32 + (swz % 64) / 2; }
__host__ __device__ __forceinline__ int perm32(int rho) { const int n = rho >> 4, i = rho & 15; return 8 * (i >> 2) + 4 * n + (i & 3); }

struct Unit { int pm, pn, e, sbase, nvalid; };
struct Gemm { int lda, ldb, K; };

struct DenseOrder {
    static constexpr bool GATHER = false;
    __device__ __forceinline__ int row_tok(const Unit&, int) const { return 0; }
    const bf16_t* A; const bf16_t* Bt; int lda, ldb;
    int nM, nN, nwg, G, c;
    __device__ void init(const bf16_t* A_, const bf16_t* Bt_, int lda_, int ldb_, int M, int N, int G_, int c_) { A = A_; Bt = Bt_; lda = lda_; ldb = ldb_; nM = M / BM; nN = N / BM; nwg = nM * nN; G = G_; c = c_; }
    __device__ bool next(int i, Unit& u) const {
        const long L = (long)i * G + c; if (L >= nwg) return false;
        int wgid = (int)L; { const int q = nwg / NXCD, r = nwg % NXCD, xcd = wgid % NXCD, off = wgid / NXCD; wgid = (xcd < r ? xcd * (q + 1) : r * (q + 1) + (xcd - r) * q) + off; }
        const int nig = WGM * nN, gid = wgid / nig, fm = gid * WGM, gsz = (nM - fm) < WGM ? (nM - fm) : WGM;
        u.pm = fm + ((wgid % nig) % gsz); u.pn = (wgid % nig) / gsz; u.e = 0; u.sbase = 0; u.nvalid = BM; return true;
    }
    __device__ __forceinline__ const char* a_base(const Unit& u) const { return (const char*)A + (size_t)u.pm * BM * lda * 2; }
    __device__ __forceinline__ const char* b_base(const Unit& u) const { return (const char*)Bt + (size_t)u.pn * BM * ldb * 2; }
};
template <bool GATHER_> struct MoeOrderT {
    static constexpr bool GATHER = GATHER_;
    const bf16_t* A; const bf16_t* Bt; int lda, ldb; size_t bt_expert_stride;
    const LAS unsigned char* tile_l;
    const LAS int* toff; const LAS int* lcnt;
    int tlo, thi, G, c;
    const int* slot_tok;
    __device__ __forceinline__ int row_tok(const Unit& u, int r) const { return r < u.nvalid ? slot_tok[u.sbase + r] : 0; }
    __device__ bool next(int i, Unit& u) const {
        const int nt = thi - tlo; int tile, pn;
        if (G % NXCD == 0) { const int x = c % NXCD, cin = c / NXCD, per = G / NXCD; const int t0 = (int)((long)nt * x / NXCD), t1 = (int)((long)nt * (x + 1) / NXCD);
            const long j = (long)i * per + cin; if (j >= (long)(t1 - t0) * 4) return false; tile = tlo + t0 + (int)(j >> 2); pn = (int)(j & 3); }
        else { const long L = (long)i * G + c; if (L >= (long)nt * 4) return false; tile = tlo + (int)(L >> 2); pn = (int)(L & 3); }
        const int l = tile_l[tile], j = tile - toff[l]; u.pm = tile; u.pn = pn; u.e = l >> 1; u.sbase = l * NTOK + j * BM; u.nvalid = lcnt[l] - j * BM; return true;
    }
    __device__ __forceinline__ const char* a_base(const Unit& u) const { return GATHER ? (const char*)A : (const char*)A + (size_t)u.pm * BM * lda * 2; }
    __device__ __forceinline__ const char* b_base(const Unit& u) const { return (const char*)Bt + ((size_t)u.e * bt_expert_stride + (size_t)u.pn * BM * ldb) * 2; }
};

template <class Epi, class Sched, bool ALIGN_EPI>
__device__ __forceinline__ void gemm_phase(LAS unsigned char* lds, const Gemm g, const Sched& S, const Epi& E) {
    const int tid = threadIdx.x, wid = __builtin_amdgcn_readfirstlane(tid >> 6), lane = tid & 63, wr = wid >> 2, wc = wid & 3, fr = lane & 15, fq = lane >> 4;
    const int K = g.K, nt = K / BK;
    unsigned voffA[2], voffB[2]; int RA[2], CA2[2];
#pragma unroll
    for (int i = 0; i < 2; ++i) { int R, C; stage_rc(tid * 16 + i * 8192, R, C); RA[i] = R; CA2[i] = C * 2; const int Rb = Epi::PERM ? ((R & ~31) + perm32(R & 31)) : R;
        voffA[i] = (unsigned)(R * g.lda + C) * 2u; voffB[i] = (unsigned)(Rb * g.ldb + C) * 2u; }
    const size_t kstep = (size_t)(BK * 2);
    const size_t hstepA = (size_t)HALF * g.lda * 2, hstepB = (size_t)HALF * g.ldb * 2;
    const unsigned ldsw = (unsigned)wid * 1024u;
    const int aoff = lds_byte(wr * 64 + fr, fq * 8), boff = lds_byte(wc * 32 + fr, fq * 8);
#define PG8_SA(b, h) (((b) * 2 + (h)) * HTB)
#define PG8_SB(b, h) ((4 + (b) * 2 + (h)) * HTB)
#define PG8_STAGE(bufoff, gbase, voff) do { _Pragma("unroll") for (int _i = 0; _i < 2; ++_i) \
        __builtin_amdgcn_global_load_lds((const unsigned*)((const char*)(gbase) + (voff)[_i]), (LAS unsigned*)(lds + (bufoff) + ldsw + _i * 8192), 16, 0, 0); } while (0)
#define PG8_STAGE_A(bufoff, kptr, half, nx) do { if constexpr (Sched::GATHER) { _Pragma("unroll") for (int _i = 0; _i < 2; ++_i) \
        __builtin_amdgcn_global_load_lds((const unsigned*)((const char*)(kptr) + ((nx) ? vnx[half][_i] : vcu[half][_i])), (LAS unsigned*)(lds + (bufoff) + ldsw + _i * 8192), 16, 0, 0); } \
    else { PG8_STAGE(bufoff, (const char*)(kptr) + ((half) ? hstepA : 0), voffA); } } while (0)
#define PG8_LDA(dst, b, h) do { _Pragma("unroll") for (int m = 0; m < 4; ++m) _Pragma("unroll") for (int k = 0; k < 2; ++k) dst[m][k] = *(const LAS bf16x8*)(lds + PG8_SA(b, h) + aoff + m * 2048 + k * 1024); } while (0)
#define PG8_LDB(dst, b, h) do { _Pragma("unroll") for (int n = 0; n < 2; ++n) _Pragma("unroll") for (int k = 0; k < 2; ++k) dst[n][k] = *(const LAS bf16x8*)(lds + PG8_SB(b, h) + boff + n * 2048 + k * 1024); } while (0)
#define PG8_MMA(ai, bj, At, Bt) do { __builtin_amdgcn_s_setprio(1); _Pragma("unroll") for (int m = 0; m < 4; ++m) _Pragma("unroll") for (int n = 0; n < 2; ++n) _Pragma("unroll") for (int k = 0; k < 2; ++k) \
        acc[ai][bj][m][n] = __builtin_amdgcn_mfma_f32_16x16x32_bf16(Bt[n][k], At[m][k], acc[ai][bj][m][n], 0, 0, 0); __builtin_amdgcn_s_setprio(0); } while (0)
#define PG8_WAIT_V(n) asm volatile("s_waitcnt vmcnt(" #n ")" ::: "memory")
#define PG8_WAIT_L(n) asm volatile("s_waitcnt lgkmcnt(" #n ")" ::: "memory")
#define PG8_BAR __builtin_amdgcn_s_barrier()
#define PG8_SCHED __builtin_amdgcn_sched_barrier(0)
    Unit cur, nxt; int ui = 0;
    if (!S.next(0, cur)) return;
    f32x4 acc[2][2][4][2];
#pragma unroll
    for (int a = 0; a < 2; ++a)
#pragma unroll
        for (int b = 0; b < 2; ++b)
#pragma unroll
            for (int m = 0; m < 4; ++m)
#pragma unroll
                for (int n = 0; n < 2; ++n) acc[a][b][m][n] = (f32x4){0.f, 0.f, 0.f, 0.f};
    bf16x8 At[4][2], B0[2][2], B1[2][2];
    const char* cA = S.a_base(cur); const char* cB = S.b_base(cur);
    unsigned vcu[2][2], vnx[2][2];
    if constexpr (Sched::GATHER) {
#pragma unroll
        for (int hf = 0; hf < 2; ++hf)
#pragma unroll
            for (int i = 0; i < 2; ++i) { vcu[hf][i] = (unsigned)S.row_tok(cur, hf * HALF + RA[i]) * (unsigned)(g.lda * 2) + (unsigned)CA2[i]; vnx[hf][i] = vcu[hf][i]; } }
    PG8_STAGE(PG8_SB(0, 0), cB, voffB); PG8_STAGE(PG8_SB(0, 1), cB + hstepB, voffB); PG8_STAGE_A(PG8_SA(0, 0), cA, 0, false); PG8_STAGE_A(PG8_SA(0, 1), cA, 1, false);
    if (wr == 1) PG8_BAR;
    PG8_WAIT_V(2); PG8_BAR;
    PG8_STAGE(PG8_SB(1, 0), cB + kstep, voffB); PG8_STAGE_A(PG8_SA(1, 0), cA + kstep, 0, false); PG8_STAGE(PG8_SB(1, 1), cB + hstepB + kstep, voffB);
    PG8_WAIT_V(6); PG8_BAR;
    for (;;) {
        const bool has_next = S.next(ui + 1, nxt);
        const char* nA = has_next ? S.a_base(nxt) : cA; const char* nB = has_next ? S.b_base(nxt) : cB;
        if constexpr (Sched::GATHER) { if (has_next) {
#pragma unroll
            for (int hf = 0; hf < 2; ++hf)
#pragma unroll
                for (int i = 0; i < 2; ++i) vnx[hf][i] = (unsigned)S.row_tok(nxt, hf * HALF + RA[i]) * (unsigned)(g.lda * 2) + (unsigned)CA2[i]; } }
        for (int t = 0; t < nt; t += 2) {
            if constexpr (Epi::HAS_MID) { if (t == Epi::MID_T) E.mid(acc, cur, wr, wc, fr, fq); }
            const bool last = (t == nt - 2);
            const char* a1 = cA + (size_t)(t + 1) * kstep;
            const char* a2 = last ? nA : cA + (size_t)(t + 2) * kstep; const char* b2 = last ? nB : cB + (size_t)(t + 2) * kstep;
            const char* a3 = a2 + kstep; const char* b3 = b2 + kstep;
            PG8_LDB(B0, 0, 0); PG8_LDB(B1, 0, 1); PG8_SCHED; PG8_LDA(At, 0, 0); PG8_STAGE_A(PG8_SA(1, 1), a1, 1, false);
            PG8_WAIT_V(8); PG8_WAIT_L(0); PG8_BAR; PG8_MMA(0, 0, At, B0); PG8_MMA(0, 1, At, B1); PG8_BAR; PG8_SCHED;
            PG8_LDA(At, 0, 1); PG8_STAGE(PG8_SB(0, 0), b2, voffB); PG8_STAGE(PG8_SB(0, 1), b2 + hstepB, voffB); PG8_STAGE_A(PG8_SA(0, 0), a2, 0, last);
            PG8_WAIT_V(8); PG8_WAIT_L(0); PG8_BAR; PG8_MMA(1, 0, At, B0); PG8_MMA(1, 1, At, B1); PG8_BAR; PG8_SCHED;
            PG8_LDB(B0, 1, 0); PG8_LDB(B1, 1, 1); PG8_SCHED; PG8_LDA(At, 1, 0); PG8_STAGE_A(PG8_SA(0, 1), a2, 1, last);
            PG8_WAIT_V(8); PG8_WAIT_L(0); PG8_BAR; PG8_MMA(0, 0, At, B0); PG8_MMA(0, 1, At, B1); PG8_BAR; PG8_SCHED;
            PG8_LDA(At, 1, 1); PG8_STAGE(PG8_SB(1, 0), b3, voffB); PG8_STAGE(PG8_SB(1, 1), b3 + hstepB, voffB); PG8_STAGE_A(PG8_SA(1, 0), a3, 0, last);
            PG8_WAIT_V(8); PG8_WAIT_L(0); PG8_BAR; PG8_MMA(1, 0, At, B0); PG8_MMA(1, 1, At, B1); PG8_BAR; PG8_SCHED;
        }
        if constexpr (ALIGN_EPI) { if (wr == 0) PG8_BAR; }
        E(acc, cur, wr, wc, fr, fq);
        if (!has_next) break;
#pragma unroll
        for (int a = 0; a < 2; ++a)
#pragma unroll
            for (int b = 0; b < 2; ++b)
#pragma unroll
                for (int m = 0; m < 4; ++m)
#pragma unroll
                    for (int n = 0; n < 2; ++n) acc[a][b][m][n] = (f32x4){0.f, 0.f, 0.f, 0.f};
        cur = nxt; cA = nA; cB = nB; ++ui;
        if constexpr (Sched::GATHER) {
#pragma unroll
            for (int hf = 0; hf < 2; ++hf)
#pragma unroll
                for (int i = 0; i < 2; ++i) vcu[hf][i] = vnx[hf][i]; }
        if constexpr (ALIGN_EPI) { if (wr == 1) PG8_BAR; }
    }
    PG8_WAIT_V(0);
    if constexpr (!ALIGN_EPI) { if (wr == 0) PG8_BAR; }
    PG8_BAR;
#undef PG8_SA
#undef PG8_SB
#undef PG8_STAGE
#undef PG8_STAGE_A
#undef PG8_LDA
#undef PG8_LDB
#undef PG8_MMA
#undef PG8_WAIT_V
#undef PG8_WAIT_L
#undef PG8_BAR
#undef PG8_SCHED
}

__device__ __forceinline__ unsigned q8(float x) { float s = sigmoidf_(x) * 255.f + 0.5f; s = s < 1.f ? 1.f : s; return (unsigned)s; }
struct EpiP {
    static constexpr bool PERM = true, HAS_MID = false;
    bf16_t *Prw, *Patt; unsigned char* Pgate;
    __device__ __forceinline__ void operator()(const f32x4 (&acc)[2][2][4][2], const Unit& u, int wr, int wc, int fr, int fq) const {
        const int row0 = u.pm * BM + wr * 64 + fr;
        if (u.pn >= 13) { const int col0 = (u.pn - 13) * BM + wc * 32 + 8 * fq;
#pragma unroll
            for (int ai = 0; ai < 2; ++ai)
#pragma unroll
                for (int m = 0; m < 4; ++m) { unsigned char* rowp = Pgate + (size_t)(row0 + ai * HALF + m * 16) * GCOLS + col0;
#pragma unroll
                    for (int bj = 0; bj < 2; ++bj) { const f32x4 v0 = acc[ai][bj][m][0], v1 = acc[ai][bj][m][1];
                        u32x2 w; w.x = q8(v0[0]) | (q8(v0[1]) << 8) | (q8(v0[2]) << 16) | (q8(v0[3]) << 24); w.y = q8(v1[0]) | (q8(v1[1]) << 8) | (q8(v1[2]) << 16) | (q8(v1[3]) << 24);
                        *(u32x2*)(rowp + bj * HALF) = w; } }
            return; }
        bf16_t* base; int ldc, colt;
        if (u.pn < 7) { base = Prw; ldc = RCOLS; colt = u.pn * BM; } else { base = Patt; ldc = ACOLS; colt = (u.pn - 7) * BM; }
        const int col0 = colt + wc * 32 + 8 * fq;
#pragma unroll
        for (int ai = 0; ai < 2; ++ai)
#pragma unroll
            for (int m = 0; m < 4; ++m) { bf16_t* rowp = base + (size_t)(row0 + ai * HALF + m * 16) * ldc + col0;
#pragma unroll
                for (int bj = 0; bj < 2; ++bj) { const f32x4 v0 = acc[ai][bj][m][0], v1 = acc[ai][bj][m][1];
                    u32x4 w; w.x = cvt_pk_bf16(v0[0], v0[1]); w.y = cvt_pk_bf16(v0[2], v0[3]); w.z = cvt_pk_bf16(v1[0], v1[1]); w.w = cvt_pk_bf16(v1[2], v1[3]);
                    *(u32x4*)(rowp + bj * HALF) = w; } }
    }
};
struct EpiMix {
    static constexpr bool PERM = true, HAS_MID = true; static constexpr int MID_T = 8;
    bf16_t* T; const unsigned char* Pgate;
    static __device__ __forceinline__ float ub(unsigned w, int i) { return (float)((w >> (8 * i)) & 0xffu); }
    __device__ __forceinline__ void mid(f32x4 (&acc)[2][2][4][2], const Unit& u, int wr, int wc, int fr, int fq) const {
        int row0 = u.pm * BM + wr * 64 + fr, col0 = u.pn * BM + wc * 32 + 8 * fq; asm volatile("" : "+v"(row0), "+v"(col0));
#pragma unroll
        for (int ai = 0; ai < 2; ++ai) {
            u32x2 gr[4][2], ga[4][2];
#pragma unroll
            for (int m = 0; m < 4; ++m) { const unsigned char* gp = Pgate + (size_t)(row0 + ai * HALF + m * 16) * GCOLS + col0;
#pragma unroll
                for (int bj = 0; bj < 2; ++bj) { gr[m][bj] = *(const u32x2*)(gp + bj * HALF); ga[m][bj] = *(const u32x2*)(gp + DM + bj * HALF); } }
#pragma unroll
            for (int m = 0; m < 4; ++m)
#pragma unroll
                for (int bj = 0; bj < 2; ++bj) { const u32x2 r = gr[m][bj], a = ga[m][bj]; f32x4& v0 = acc[ai][bj][m][0]; f32x4& v1 = acc[ai][bj][m][1];
#pragma unroll
                    for (int j = 0; j < 4; ++j) { v0[j] *= ub(r.x, j) * __builtin_amdgcn_rcpf(ub(a.x, j)); v1[j] *= ub(r.y, j) * __builtin_amdgcn_rcpf(ub(a.y, j)); } }
            asm volatile("" ::: "memory");
        }
    }
    __device__ __forceinline__ void operator()(const f32x4 (&acc)[2][2][4][2], const Unit& u, int wr, int wc, int fr, int fq) const {
        const int row0 = u.pm * BM + wr * 64 + fr, col0 = u.pn * BM + wc * 32 + 8 * fq;
        u32x2 ga[2][4][2];
#pragma unroll
        for (int ai = 0; ai < 2; ++ai)
#pragma unroll
            for (int m = 0; m < 4; ++m)
#pragma unroll
                for (int bj = 0; bj < 2; ++bj) ga[ai][m][bj] = *(const u32x2*)(Pgate + (size_t)(row0 + ai * HALF + m * 16) * GCOLS + DM + col0 + bj * HALF);
#pragma unroll
        for (int ai = 0; ai < 2; ++ai)
#pragma unroll
            for (int m = 0; m < 4; ++m) { const size_t row = (size_t)(row0 + ai * HALF + m * 16);
#pragma unroll
                for (int bj = 0; bj < 2; ++bj) { const int col = col0 + bj * HALF; const u32x2 g = ga[ai][m][bj]; constexpr float s = 1.f / 255.f;
                    const f32x4 a0 = acc[ai][bj][m][0], a1 = acc[ai][bj][m][1];
                    u32x4 w; w.x = cvt_pk_bf16(a0[0] * ub(g.x, 0) * s, a0[1] * ub(g.x, 1) * s); w.y = cvt_pk_bf16(a0[2] * ub(g.x, 2) * s, a0[3] * ub(g.x, 3) * s);
                    w.z = cvt_pk_bf16(a1[0] * ub(g.y, 0) * s, a1[1] * ub(g.y, 1) * s); w.w = cvt_pk_bf16(a1[2] * ub(g.y, 2) * s, a1[3] * ub(g.y, 3) * s);
                    *(u32x4*)(T + row * DM + col) = w; } }
    }
};
struct EpiDelta {
    static constexpr bool PERM = true, HAS_MID = false;
    bf16_t* D; const float* mod;
    __device__ __forceinline__ void operator()(const f32x4 (&acc)[2][2][4][2], const Unit& u, int wr, int wc, int fr, int fq) const {
        const int row0 = u.pm * BM + wr * 64 + fr, col0 = u.pn * BM + wc * 32 + 8 * fq;
        const int b = (u.pm * BM) / SEQ; const float* g1 = mod + (size_t)b * MODW + 2 * DM;
        f32x4 gv[2][2];
#pragma unroll
        for (int bj = 0; bj < 2; ++bj)
#pragma unroll
            for (int n = 0; n < 2; ++n) gv[bj][n] = *(const f32x4*)(g1 + col0 + bj * HALF + 4 * n);
#pragma unroll
        for (int ai = 0; ai < 2; ++ai)
#pragma unroll
            for (int m = 0; m < 4; ++m) { bf16_t* rowp = D + (size_t)(row0 + ai * HALF + m * 16) * DM + col0;
#pragma unroll
                for (int bj = 0; bj < 2; ++bj) { const f32x4 v0 = acc[ai][bj][m][0] * gv[bj][0], v1 = acc[ai][bj][m][1] * gv[bj][1];
                    u32x4 w; w.x = cvt_pk_bf16(v0[0], v0[1]); w.y = cvt_pk_bf16(v0[2], v0[3]); w.z = cvt_pk_bf16(v1[0], v1[1]); w.w = cvt_pk_bf16(v1[2], v1[3]);
                    *(u32x4*)(rowp + bj * HALF) = w; } }
    }
};
struct EpiHid {
    static constexpr bool PERM = true, HAS_MID = false;
    bf16_t* hid;
    __device__ __forceinline__ void operator()(const f32x4 (&acc)[2][2][4][2], const Unit& u, int wr, int wc, int fr, int fq) const {
        const int row0 = u.pm * BM + wr * 64 + fr, hc0 = u.pn * 128 + wc * 16 + 4 * fq;
#pragma unroll
        for (int ai = 0; ai < 2; ++ai)
#pragma unroll
            for (int m = 0; m < 4; ++m) { bf16_t* rowp = hid + (size_t)(row0 + ai * HALF + m * 16) * DE + hc0;
#pragma unroll
                for (int bj = 0; bj < 2; ++bj) { const f32x4 gt = acc[ai][bj][m][0], up = acc[ai][bj][m][1]; float h[4];
#pragma unroll
                    for (int j = 0; j < 4; ++j) h[j] = gt[j] * sigmoidf_(gt[j]) * up[j];
                    u32x2 w; w.x = cvt_pk_bf16(h[0], h[1]); w.y = cvt_pk_bf16(h[2], h[3]); *(u32x2*)(rowp + bj * 64) = w; } }
    }
};
struct EpiY {
    static constexpr bool PERM = true, HAS_MID = false;
    bf16_t* Y; const float* slot_w;
    __device__ __forceinline__ void operator()(const f32x4 (&acc)[2][2][4][2], const Unit& u, int wr, int wc, int fr, int fq) const {
        const int row0 = u.pm * BM + wr * 64 + fr, col0 = u.pn * BM + wc * 32 + 8 * fq;
        float w[2][4];
#pragma unroll
        for (int ai = 0; ai < 2; ++ai)
#pragma unroll
            for (int m = 0; m < 4; ++m) { const int r = wr * 64 + fr + ai * HALF + m * 16; w[ai][m] = r < u.nvalid ? slot_w[u.sbase + r] : 0.f; }
#pragma unroll
        for (int ai = 0; ai < 2; ++ai)
#pragma unroll
            for (int m = 0; m < 4; ++m) { bf16_t* rowp = Y + (size_t)(row0 + ai * HALF + m * 16) * DM + col0; const float ws = w[ai][m];
#pragma unroll
                for (int bj = 0; bj < 2; ++bj) { const f32x4 v0 = acc[ai][bj][m][0] * ws, v1 = acc[ai][bj][m][1] * ws;
                    u32x4 o; o.x = cvt_pk_bf16(v0[0], v0[1]); o.y = cvt_pk_bf16(v0[2], v0[3]); o.z = cvt_pk_bf16(v1[0], v1[1]); o.w = cvt_pk_bf16(v1[2], v1[3]);
                    *(u32x4*)(rowp + bj * HALF) = o; } }
    }
};
}
typedef GAS unsigned gu32;
#define RLX_AGENT __ATOMIC_RELAXED, __HIP_MEMORY_SCOPE_AGENT
#define LDS_WAIT() asm volatile("s_waitcnt lgkmcnt(0)" ::: "memory")
#define VM_WAIT() asm volatile("s_waitcnt vmcnt(0)" ::: "memory")
#define XB_TMO      128
#define XB_XCNT(j)  (256  + 64 * (j))
#define XB_XSUB(j)  (1280 + 64 * (j))
#define XB_XGEN(j)  (2304 + 64 * (j))
#define XB_TOP      3328
#define XB_TOPGEN   3392
#define XCD_BAR_WORDS 3456
#define XB_SPIN_CAP (1u << 18)

__device__ __forceinline__ unsigned xb_ld(unsigned* p)              { return __hip_atomic_load(p, __ATOMIC_RELAXED, __HIP_MEMORY_SCOPE_AGENT); }
__device__ __forceinline__ unsigned xb_add(unsigned* p, unsigned v) { return __hip_atomic_fetch_add(p, v, __ATOMIC_RELAXED, __HIP_MEMORY_SCOPE_AGENT); }
__device__ __forceinline__ unsigned xb_xcc_id() { return (unsigned)__builtin_amdgcn_s_getreg((3 << 11) | 20) & 0xFu; }
#define XB_SPIN(cond, bar) do { unsigned _sp = 0; while (cond) { __builtin_amdgcn_s_sleep(1); \
    if ((++_sp & 255u) == 0u) { if (xb_ld(&(bar)[XB_TMO])) break; if (_sp > XB_SPIN_CAP) { atomicAdd(&(bar)[XB_TMO], 1u); break; } } } } while (0)

struct XcdBarrier {
    unsigned* bar; unsigned x;
    volatile LAS unsigned* st;
};

__device__ __forceinline__ XcdBarrier xcd_barrier_post(unsigned* bar, volatile LAS unsigned* st) {
    XcdBarrier b; b.bar = bar; b.x = xb_xcc_id(); b.st = st;
    if (threadIdx.x == 0) (void)xb_add(&bar[XB_XCNT(b.x)], 1u);
    return b;
}
__device__ __forceinline__ void xcd_barrier_complete(unsigned* bar, unsigned x, unsigned& nloc, unsigned& nx) {
    const unsigned G = gridDim.x * gridDim.y * gridDim.z;
    unsigned sum, cnt, mine, sp = 0u;
    for (;;) {
        sum = 0u; cnt = 0u; mine = 0u;
#pragma unroll
        for (unsigned j = 0; j < 16; ++j) { const unsigned c = xb_ld(&bar[XB_XCNT(j)]); sum += c; cnt += (c > 0u) ? 1u : 0u; mine = (j == x) ? c : mine; }
        if (sum == G) break;
        __builtin_amdgcn_s_sleep(1);
        if ((++sp & 255u) == 0u) { if (xb_ld(&bar[XB_TMO])) break; if (sp > XB_SPIN_CAP) { atomicAdd(&bar[XB_TMO], 1u); break; } }
    }
    nloc = mine > 0u ? mine : 1u; nx = cnt > 0u ? cnt : 1u;
}

__device__ __forceinline__ void xcd_barrier(const XcdBarrier& b) {
    asm volatile("s_waitcnt vmcnt(0)" ::: "memory");
    __syncthreads();
    if (threadIdx.x == 0) {
        unsigned* bar = b.bar;
        __builtin_amdgcn_s_waitcnt(0);
        unsigned nloc = b.st[0], nx = b.st[1];
        if (nloc == 0u) { xcd_barrier_complete(bar, b.x, nloc, nx); b.st[0] = nloc; b.st[1] = nx; }
        const unsigned old = xb_add(&bar[XB_XSUB(b.x)], 1u);
        const unsigned gen = old / nloc;
        if (old + 1u == (gen + 1u) * nloc) {
            __builtin_amdgcn_fence(__ATOMIC_RELEASE, "agent");
            asm volatile("s_waitcnt vmcnt(0)" ::: "memory");
            const unsigned og = xb_add(&bar[XB_TOP], 1u);
            const unsigned tg = og / nx;
            if (og + 1u == (tg + 1u) * nx) xb_add(&bar[XB_TOPGEN], 1u);
            else XB_SPIN(xb_ld(&bar[XB_TOPGEN]) == tg, bar);
            __builtin_amdgcn_fence(__ATOMIC_ACQUIRE, "agent");
            xb_add(&bar[XB_XGEN(b.x)], 1u);
            asm volatile("s_waitcnt vmcnt(0)" ::: "memory");
        } else {
            XB_SPIN(xb_ld(&bar[XB_XGEN(b.x)]) == gen, bar);
            __builtin_amdgcn_fence(__ATOMIC_ACQUIRE, "agent");
            asm volatile("s_waitcnt vmcnt(0)" ::: "memory");
        }
    }
    __syncthreads();
}

constexpr int NWAVES = 8;
constexpr size_t MiB = 1u << 20, KiB = 1u << 10;
constexpr size_t WS_CTL = 0, CTL_ZERO_BYTES = 2 * MiB;
constexpr size_t WS_MOD = 1 * MiB;
constexpr size_t WS_WIN = 2 * MiB;
constexpr size_t WS_WBR = 12 * MiB + 512 * KiB, WS_WBA = 13 * MiB + 512 * KiB, WS_WOUT = 14 * MiB + 512 * KiB;
constexpr size_t WS_WUP = 16 * MiB + 512 * KiB, WS_AUP = WS_WUP + 64 * KiB, WS_GUP = WS_WUP + 128 * KiB;
constexpr size_t WS_WRH = 16 * MiB + 768 * KiB, WS_WRL = WS_WRH + 128 * KiB;
constexpr size_t WS_CB = 17 * MiB, WS_GAM2 = 17 * MiB + 64 * KiB;
constexpr size_t WS_PRW = 18 * MiB, WS_PATT = 130 * MiB, WS_PGATE = 226 * MiB;
constexpr size_t WS_WGU = 130 * MiB, WS_WD = 290 * MiB;
constexpr size_t WS_T = 18 * MiB;
constexpr size_t WS_HID = 18 * MiB, WS_DELTA = 226 * MiB, WS_H2 = 354 * MiB;
constexpr size_t WS_SLOTTOK = 98 * MiB, WS_SLOTW = 106 * MiB, WS_TOKLIST = 114 * MiB,
    WS_TOKPOS = WS_TOKLIST + 256 * KiB, WS_TOKW = WS_TOKLIST + 512 * KiB;
constexpr size_t WS_QE = 354 * MiB, WS_YLOC = 386 * MiB, WS_PC = 418 * MiB, WS_SLOC = 450 * MiB;
constexpr size_t WS_YB = 322 * MiB;
constexpr size_t WS_END = 512 * MiB;
constexpr size_t DO_H = 0, DO_G = 0, DO_SC = 32 * MiB, DO_YRA = 64 * MiB;
constexpr int NSLOT_MAX = 2 * NTOK + NLIST * 256;
constexpr int CW_TMO = 0, CW_BAR = 4096, CW_CNT = 16384;
constexpr int LDS_BYTES = 163840, RING_BYTES = 131072;
constexpr int LDSCTL_OFF = LDS_BYTES - 2048, MISC_OFF = LDSCTL_OFF;
constexpr int TOFF_OFF = LDSCTL_OFF + 256, LCNT_OFF = TOFF_OFF + 264, TILE_L_OFF = LCNT_OFF + 256;

#define LBAR() do { asm volatile("s_waitcnt lgkmcnt(0)" ::: "memory"); __builtin_amdgcn_s_barrier(); asm volatile("" ::: "memory"); } while (0)
struct Frame {
    LAS unsigned char* lds; volatile LAS unsigned* MISC; gu32* ctl;
    int tid, lane, wave, vcu, G;
};
__device__ __forceinline__ float wave_sum(float v) {
#pragma unroll
    for (int o = 1; o < 64; o <<= 1) v += __shfl_xor(v, o);
    return v;
}
__device__ __forceinline__ float dpp_f(float x, const int ctrl_sel) {
    const int xi = __builtin_bit_cast(int, x); int r;
    if (ctrl_sel == 0) r = __builtin_amdgcn_update_dpp(0, xi, 0xB1, 0xf, 0xf, true);
    else if (ctrl_sel == 1) r = __builtin_amdgcn_update_dpp(0, xi, 0x4E, 0xf, 0xf, true);
    else r = __builtin_amdgcn_update_dpp(0, xi, 0x141, 0xf, 0xf, true);
    return __builtin_bit_cast(float, r);
}
__device__ __forceinline__ float red8(float x) { x += dpp_f(x, 0); x += dpp_f(x, 1); x += dpp_f(x, 2); return x; }

__device__ __forceinline__ void phase_mod(Frame& F, const float* c, const float* w_ada, const float* b_ada, float* mod) {
    const int gw = F.vcu * NWAVES + F.wave, NGW = F.G * NWAVES;
    for (int task = gw; task < 96 * 16; task += NGW) {
        const int nc = task % 96, ks = task / 96, n = nc * 64 + F.lane, k0 = ks * 64;
        float acc[16];
#pragma unroll
        for (int b = 0; b < 16; ++b) acc[b] = 0.f;
        LAS float* sl = (LAS float*)(F.lds) + F.wave * 1024;
#pragma unroll
        for (int j = 0; j < 16; ++j) { const float cv = c[(F.lane & 15) * DM + k0 + (F.lane >> 4) + 4 * j]; sl[((F.lane >> 4) + 4 * j) * 16 + (F.lane & 15)] = cv * sigmoidf_(cv); }
        LDS_WAIT(); asm volatile("" ::: "memory");
#pragma unroll 4
        for (int kk = 0; kk < 64; ++kk) { const float w = w_ada[(size_t)(k0 + kk) * MODW + n];
            const f32x4 s0 = *(const LAS f32x4*)(sl + kk * 16), s1 = *(const LAS f32x4*)(sl + kk * 16 + 4), s2 = *(const LAS f32x4*)(sl + kk * 16 + 8), s3 = *(const LAS f32x4*)(sl + kk * 16 + 12);
            acc[0] += s0.x * w; acc[1] += s0.y * w; acc[2] += s0.z * w; acc[3] += s0.w * w; acc[4] += s1.x * w; acc[5] += s1.y * w; acc[6] += s1.z * w; acc[7] += s1.w * w;
            acc[8] += s2.x * w; acc[9] += s2.y * w; acc[10] += s2.z * w; acc[11] += s2.w * w; acc[12] += s3.x * w; acc[13] += s3.y * w; acc[14] += s3.z * w; acc[15] += s3.w * w; }
        LDS_WAIT(); asm volatile("" ::: "memory");
#pragma unroll
        for (int b = 0; b < 16; ++b) { const float v = acc[b] + (ks == 0 ? b_ada[n] : 0.f); atomicAdd(mod + (size_t)b * MODW + n, v); }
    }
}

template <int MODE> __device__ __forceinline__ void transpose_item(const float* W, int K, int N, bf16_t* WT, int row_off, int item, int lane, int ldt = 0, int koff = 0) {
    if (ldt == 0) ldt = K;
    const int nblk = N / 32, kb = item / nblk, nb = item % nblk, k0 = 64 * kb + 8 * (lane >> 3), n0 = 32 * nb + 4 * (lane & 7);
    f32x4 v[8];
#pragma unroll
    for (int i = 0; i < 8; ++i) v[i] = *(const f32x4*)(W + (size_t)(k0 + i) * N + n0);
#pragma unroll
    for (int j = 0; j < 4; ++j) { const int ng = n0 + j; const int nr = MODE == 0 ? row_off + ng : (MODE == 1 ? 8 * (ng >> 2) + (ng & 3) : 8 * (ng >> 2) + 4 + (ng & 3));
        u32x4 o; o.x = cvt_pk_bf16(v[0][j], v[1][j]); o.y = cvt_pk_bf16(v[2][j], v[3][j]); o.z = cvt_pk_bf16(v[4][j], v[5][j]); o.w = cvt_pk_bf16(v[6][j], v[7][j]);
        *(GAS u32x4*)(WT + (size_t)nr * ldt + koff + k0) = o; }
}

struct Args { const float* in[31]; float* out; unsigned char* ws; int ph_lo, ph_hi; };
struct Ptrs { const float* in[31]; float* out; unsigned char* ws; };

__device__ __forceinline__ void phase_prep(Frame& F, const Ptrs& P) {
    const int gw = F.vcu * NWAVES + F.wave, NGW = F.G * NWAVES;
    const float* mod = (const float*)(P.ws + WS_MOD);
    bf16_t* Win_t = (bf16_t*)(P.ws + WS_WIN); bf16_t* Wbr_t = (bf16_t*)(P.ws + WS_WBR); bf16_t* Wba_t = (bf16_t*)(P.ws + WS_WBA); bf16_t* Wout_t = (bf16_t*)(P.ws + WS_WOUT);
    bf16_t* wup_t = (bf16_t*)(P.ws + WS_WUP); bf16_t* aup_t = (bf16_t*)(P.ws + WS_AUP); bf16_t* gup_t = (bf16_t*)(P.ws + WS_GUP);
    constexpr int I_IN = 16 * (INCOLS / 32), I_BR = 8 * 32, I_OUT = 16 * 32, I_UP = 16, I_GUP = 2 * 16;
    constexpr int NITEMS = I_IN + 2 * I_BR + I_OUT + 2 * I_UP + I_GUP;
    for (int it = gw; it < NITEMS; it += NGW) {
        int r = it;
        if (r < I_IN) { transpose_item<0>(P.in[5], DM, INCOLS, Win_t, 0, r, F.lane); continue; } r -= I_IN;
        if (r < I_BR) { transpose_item<0>(P.in[20], 512, DM, Wbr_t, 0, r, F.lane, DM, 0); continue; } r -= I_BR;
        if (r < I_BR) { transpose_item<0>(P.in[21], 512, DM, Wbr_t, 0, r, F.lane, DM, 512); continue; } r -= I_BR;
        if (r < I_OUT) { transpose_item<0>(P.in[22], DM, DM, Wout_t, 0, r, F.lane); continue; } r -= I_OUT;
        if (r < I_UP) { transpose_item<0>(P.in[8], 64, 512, wup_t, 0, r, F.lane); continue; } r -= I_UP;
        if (r < I_UP) { transpose_item<0>(P.in[10], 64, 512, aup_t, 0, r, F.lane); continue; } r -= I_UP;
        transpose_item<0>(P.in[11], 128, 512, gup_t, 0, r, F.lane);
    }
    { bf16_t* wrh = (bf16_t*)(P.ws + WS_WRH); bf16_t* wrl = (bf16_t*)(P.ws + WS_WRL);
      for (int idx = (F.vcu * NWAVES * 64 + F.tid); idx < 64 * DM; idx += F.G * NWAVES * 64) { const int o = idx / DM, k = idx % DM;
          const float w = o < 4 ? P.in[24][k * 4 + o] : (o < 36 ? P.in[26][k * 32 + (o - 4)] : 0.f);
          const unsigned hi = cvt_pk_bf16(w, 0.f) & 0xffffu; const float rem = w - __uint_as_float(hi << 16); const unsigned lo = cvt_pk_bf16(rem, 0.f) & 0xffffu;
          wrh[idx] = (bf16_t)hi; wrl[idx] = (bf16_t)lo; } }
    { float* gam2 = (float*)(P.ws + WS_GAM2);
      for (int idx = (F.vcu * NWAVES * 64 + F.tid); idx < NB * DM; idx += F.G * NWAVES * 64) { const int b = idx / DM, k = idx % DM; gam2[idx] = P.in[23][k] * (1.f + mod[(size_t)b * MODW + 4 * DM + k]); } }
    { float* cb = (float*)(P.ws + WS_CB);
      for (int t = gw; t < NB * 36; t += NGW) { const int b = t / 36, o = t % 36; float s = 0.f;
          for (int k = F.lane; k < DM; k += 64) { const float w = o < 4 ? P.in[24][k * 4 + o] : P.in[26][k * 32 + (o - 4)]; s += mod[(size_t)b * MODW + 3 * DM + k] * w; }
          s = wave_sum(s); if (F.lane == 0) cb[b * 64 + o] = s + (o < 4 ? P.in[25][o] : P.in[27][o - 4]); } }
    bf16_t* H = (bf16_t*)((unsigned char*)P.out + DO_H);
    for (int m0 = gw * 4; m0 < NTOK; m0 += NGW * 4) {
        f32x4 v[4][4];
#pragma unroll
        for (int r = 0; r < 4; ++r) { const GAS f32x4* xr = (const GAS f32x4*)(P.in[0] + (size_t)(m0 + r) * DM) + F.lane;
#pragma unroll
            for (int j = 0; j < 4; ++j) v[r][j] = xr[64 * j]; }
        const int b = m0 / SEQ; const float* sh = mod + (size_t)b * MODW; const float* sc = sh + DM;
        f32x4 gs[4], hs[4];
#pragma unroll
        for (int j = 0; j < 4; ++j) { const int k = 4 * F.lane + 256 * j; const f32x4 g = *(const f32x4*)(P.in[4] + k), s1 = *(const f32x4*)(sc + k); gs[j] = g * (s1 + 1.f); hs[j] = *(const f32x4*)(sh + k); }
#pragma unroll
        for (int r = 0; r < 4; ++r) { float s = 0.f;
#pragma unroll
            for (int j = 0; j < 4; ++j) s += (v[r][j].x * v[r][j].x + v[r][j].y * v[r][j].y) + (v[r][j].z * v[r][j].z + v[r][j].w * v[r][j].w);
            const float rinv = 1.f / sqrtf(wave_sum(s) * (1.f / DM) + 1e-6f);
            GAS u32x2* o8 = (GAS u32x2*)(H + (size_t)(m0 + r) * DM) + F.lane;
#pragma unroll
            for (int j = 0; j < 4; ++j) { const f32x4 hv = v[r][j] * rinv * gs[j] + hs[j]; u32x2 w; w.x = cvt_pk_bf16(hv.x, hv.y); w.y = cvt_pk_bf16(hv.z, hv.w); o8[64 * j] = w; } }
    }
}
__device__ __forceinline__ void expert_convert(Frame& F, const Ptrs& P, int wv, int nwv, int it_lo, int it_hi) {
    bf16_t* Wgu = (bf16_t*)(P.ws + WS_WGU);
    constexpr int I_G = 16 * 16;
    for (int it = it_lo + wv; it < it_hi; it += nwv) {
        const int e = it / (2 * I_G), r = it % (2 * I_G);
        if (r < I_G) transpose_item<1>(P.in[28] + (size_t)e * DM * DE, DM, DE, Wgu + (size_t)e * DM * DM, 0, r, F.lane);
        else transpose_item<2>(P.in[29] + (size_t)e * DM * DE, DM, DE, Wgu + (size_t)e * DM * DM, 0, r - I_G, F.lane);
    }
}
__device__ __forceinline__ void expert_convert_down(Frame& F, const Ptrs& P, int wv, int nwv) {
    bf16_t* Wd = (bf16_t*)(P.ws + WS_WD);
    for (int it = wv; it < NE * 256; it += nwv) { const int e = it >> 8, r = it & 255; transpose_item<0>(P.in[30] + (size_t)e * DE * DM, DE, DM, Wd + (size_t)e * DM * DE, 0, r, F.lane); }
}
namespace att {
constexpr int SLOT = 16384, NSL = 5, L_WS = NSL * SLOT, L_OST = L_WS + 8 * 256, L_BIAS = L_OST + 8 * 4096, L_END = L_BIAS + 1280;
__device__ __forceinline__ int crow(int r, int hi) { return (r & 3) + 8 * (r >> 2) + 4 * hi; }
__device__ __forceinline__ float max3f(float a, float b, float c) { return fmaxf(fmaxf(a, b), c); }
__device__ __forceinline__ s16x4 vtr(const LAS char* p) { return __builtin_bit_cast(s16x4, __builtin_amdgcn_ds_read_tr16_b64_v4i16((LAS s16x4*)p)); }

__device__ __forceinline__ void attn_unit(Frame& F, const Ptrs& P, int b, int h, int qb) {
    const int tid = F.tid, lane = F.lane, wid = F.wave, r32 = lane & 31, hi = lane >> 5;
    const bf16_t* Patt = (const bf16_t*)(P.ws + WS_PATT);
    bf16_t* Ya = (bf16_t*)((unsigned char*)P.out + DO_YRA) + 512;
    LAS char* lds = (LAS char*)F.lds;
    LAS float* wsf = (LAS float*)(lds + L_WS) + wid * 64;
    LAS float* biasL = (LAS float*)(lds + L_BIAS);
    const int cq = wid >> 1, ci = qb * 4 + cq, kc0 = qb * 4 - 8;
    const size_t rowbase = (size_t)b * SEQ;
    for (int i = tid; i < 257; i += 512) biasL[i] = P.in[19][h * 257 + i] * LOG2E;
    const int srow = tid >> 3, sc8 = tid & 7;
    f32x4 kg0 = *(const f32x4*)(P.in[18] + 8 * sc8), kg1 = *(const f32x4*)(P.in[18] + 8 * sc8 + 4);
    const int kdst = sc8 * 1024 + srow * 16, vdst = 8192 + (sc8 >> 2) * 4096 + (srow >> 4) * 1024 + (srow & 15) * 64 + (sc8 & 3) * 16;
    auto ld_k = [&](int j) -> u32x4 { return *(const u32x4*)(Patt + (rowbase + (size_t)(kc0 + j) * 64 + srow) * ACOLS + 512 + h * 64 + 8 * sc8); };
    auto ld_v = [&](int j) -> u32x4 { return *(const u32x4*)(Patt + (rowbase + (size_t)(kc0 + j) * 64 + srow) * ACOLS + 1024 + h * 64 + 8 * sc8); };
    auto st_kv = [&](int j, u32x4 kw, u32x4 vw) {
        float kf[8] = {bf_lo(kw.x), bf_hi(kw.x), bf_lo(kw.y), bf_hi(kw.y), bf_lo(kw.z), bf_hi(kw.z), bf_lo(kw.w), bf_hi(kw.w)};
        float ss = 0.f;
#pragma unroll
        for (int i = 0; i < 8; ++i) ss += kf[i] * kf[i];
        ss = red8(ss); const float rk = 1.f / sqrtf(ss * (1.f / 64.f) + 1e-6f);
        u32x4 o; o.x = cvt_pk_bf16(kf[0] * rk * kg0.x, kf[1] * rk * kg0.y); o.y = cvt_pk_bf16(kf[2] * rk * kg0.z, kf[3] * rk * kg0.w);
        o.z = cvt_pk_bf16(kf[4] * rk * kg1.x, kf[5] * rk * kg1.y); o.w = cvt_pk_bf16(kf[6] * rk * kg1.z, kf[7] * rk * kg1.w);
        LAS char* sl = lds + (j % NSL) * SLOT;
        *(LAS u32x4*)(sl + kdst) = o; *(LAS u32x4*)(sl + vdst) = vw; };
    { u32x4 kws[4], vws[4];
#pragma unroll
      for (int j = 0; j < 4; ++j) if (kc0 + j >= 0) { kws[j] = ld_k(j); vws[j] = ld_v(j); }
#pragma unroll
      for (int j = 0; j < 4; ++j) if (kc0 + j >= 0) st_kv(j, kws[j], vws[j]); }
    const size_t qrow = rowbase + (size_t)ci * 64 + (wid & 1) * 32 + r32;
    bf16x8 qr[4];
    { float qf[4][8]; float ss = 0.f;
#pragma unroll
      for (int d0 = 0; d0 < 4; ++d0) { const u32x4 w = *(const u32x4*)(Patt + qrow * ACOLS + h * 64 + d0 * 16 + hi * 8);
          qf[d0][0] = bf_lo(w.x); qf[d0][1] = bf_hi(w.x); qf[d0][2] = bf_lo(w.y); qf[d0][3] = bf_hi(w.y); qf[d0][4] = bf_lo(w.z); qf[d0][5] = bf_hi(w.z); qf[d0][6] = bf_lo(w.w); qf[d0][7] = bf_hi(w.w);
#pragma unroll
          for (int i = 0; i < 8; ++i) ss += qf[d0][i] * qf[d0][i]; }
      ss += __shfl_xor(ss, 32);
      const float rq = (0.125f * LOG2E) / sqrtf(ss * (1.f / 64.f) + 1e-6f);
#pragma unroll
      for (int d0 = 0; d0 < 4; ++d0) { const f32x4 g0 = *(const f32x4*)(P.in[17] + d0 * 16 + hi * 8), g1 = *(const f32x4*)(P.in[17] + d0 * 16 + hi * 8 + 4);
          u32x4 o; o.x = cvt_pk_bf16(qf[d0][0] * rq * g0.x, qf[d0][1] * rq * g0.y); o.y = cvt_pk_bf16(qf[d0][2] * rq * g0.z, qf[d0][3] * rq * g0.w);
          o.z = cvt_pk_bf16(qf[d0][4] * rq * g1.x, qf[d0][5] * rq * g1.y); o.w = cvt_pk_bf16(qf[d0][6] * rq * g1.z, qf[d0][7] * rq * g1.w);
          qr[d0] = __builtin_bit_cast(bf16x8, o); } }
    u32x4 kA, vA; if (kc0 + 4 >= 0) { kA = ld_k(4); vA = ld_v(4); }
    float mrun = 0.f, lrun = 0.f; f32x16 o0 = {}, o1 = {};
    const int qloc = (wid & 1) * 32 + r32;
    __syncthreads();
#pragma unroll 1
    for (int s = 0; s < 9; ++s) {
        const int jn = s + 4; const bool ld = (jn <= 11) && (kc0 + jn >= 0);
        const bool ldn = (jn + 1 <= 11) && (kc0 + jn + 1 >= 0); u32x4 kB, vB; if (ldn) { kB = ld_k(jn + 1); vB = ld_v(jn + 1); }
        const int j = cq + s;
        if (kc0 + j >= 0) {
            const LAS char* sl = lds + (j % NSL) * SLOT;
            f32x16 p0, p1;
            if (s <= 5) { const float c0 = biasL[0] - mrun;
#pragma unroll
                for (int r = 0; r < 16; ++r) { p0[r] = c0; p1[r] = c0; } }
            else { const int base = 64 * (s - 8) - qloc + 128;
#pragma unroll
                for (int r = 0; r < 16; ++r) { int i0 = base + crow(r, hi), i1 = i0 + 32; i0 = i0 < 0 ? 0 : (i0 > 256 ? 256 : i0); i1 = i1 < 0 ? 0 : (i1 > 256 ? 256 : i1); p0[r] = biasL[i0] - mrun; p1[r] = biasL[i1] - mrun; } }
            const LAS char* kb = sl + hi * 1024 + r32 * 16;
#pragma unroll
            for (int d0 = 0; d0 < 4; ++d0) { const bf16x8 b0 = *(const LAS bf16x8*)(kb + d0 * 2048), b1 = *(const LAS bf16x8*)(kb + d0 * 2048 + 512);
                p0 = __builtin_amdgcn_mfma_f32_32x32x16_bf16(b0, qr[d0], p0, 0, 0, 0); p1 = __builtin_amdgcn_mfma_f32_32x32x16_bf16(b1, qr[d0], p1, 0, 0, 0); }
            float a = max3f(p0[0], p0[1], p1[0]), bm = max3f(p0[2], p0[3], p1[1]); a = max3f(a, p1[2], p1[3]);
#pragma unroll
            for (int r = 4; r < 16; r += 4) { a = max3f(a, p0[r], p0[r + 1]); bm = max3f(bm, p0[r + 2], p0[r + 3]); a = max3f(a, p1[r], p1[r + 1]); bm = max3f(bm, p1[r + 2], p1[r + 3]); }
            float rm = fmaxf(a, bm); rm = fmaxf(rm, __shfl_xor(rm, 32));
            if (__any(rm > 8.f)) {
                const float dl = fmaxf(rm, 0.f), f = __builtin_amdgcn_exp2f(-dl); mrun += dl; lrun *= f;
#pragma unroll
                for (int r = 0; r < 16; ++r) { p0[r] -= dl; p1[r] -= dl; }
                if (hi == 0) wsf[r32] = f;
                LDS_WAIT(); asm volatile("" ::: "memory");
#pragma unroll
                for (int r = 0; r < 16; ++r) { const float fr_ = wsf[crow(r, hi)]; o0[r] *= fr_; o1[r] *= fr_; }
            }
            float sacc = 0.f;
#pragma unroll
            for (int r = 0; r < 16; ++r) { p0[r] = __builtin_amdgcn_exp2f(p0[r]); p1[r] = __builtin_amdgcn_exp2f(p1[r]); sacc += p0[r] + p1[r]; }
            lrun += sacc;
            u32x4 pw0, pw1, pw2, pw3;
            pw0 = (u32x4){cvt_pk_bf16(p0[0], p0[1]), cvt_pk_bf16(p0[2], p0[3]), cvt_pk_bf16(p0[4], p0[5]), cvt_pk_bf16(p0[6], p0[7])};
            pw1 = (u32x4){cvt_pk_bf16(p0[8], p0[9]), cvt_pk_bf16(p0[10], p0[11]), cvt_pk_bf16(p0[12], p0[13]), cvt_pk_bf16(p0[14], p0[15])};
            pw2 = (u32x4){cvt_pk_bf16(p1[0], p1[1]), cvt_pk_bf16(p1[2], p1[3]), cvt_pk_bf16(p1[4], p1[5]), cvt_pk_bf16(p1[6], p1[7])};
            pw3 = (u32x4){cvt_pk_bf16(p1[8], p1[9]), cvt_pk_bf16(p1[10], p1[11]), cvt_pk_bf16(p1[12], p1[13]), cvt_pk_bf16(p1[14], p1[15])};
            const LAS char* vp = sl + 8192 + ((lane >> 4) & 1) * 32 + (lane & 3) * 8 + (4 * hi + ((lane & 15) >> 2)) * 64;
            const bf16x8 pa[4] = {__builtin_bit_cast(bf16x8, pw0), __builtin_bit_cast(bf16x8, pw1), __builtin_bit_cast(bf16x8, pw2), __builtin_bit_cast(bf16x8, pw3)};
#pragma unroll
            for (int ks = 0; ks < 4; ++ks) {
                const s16x4 l0 = vtr(vp + ks * 1024), h0 = vtr(vp + ks * 1024 + 512), l1 = vtr(vp + 4096 + ks * 1024), h1 = vtr(vp + 4096 + ks * 1024 + 512);
                const bf16x8 v0 = (bf16x8){l0[0], l0[1], l0[2], l0[3], h0[0], h0[1], h0[2], h0[3]}, v1 = (bf16x8){l1[0], l1[1], l1[2], l1[3], h1[0], h1[1], h1[2], h1[3]};
                o0 = __builtin_amdgcn_mfma_f32_32x32x16_bf16(pa[ks], v0, o0, 0, 0, 0); o1 = __builtin_amdgcn_mfma_f32_32x32x16_bf16(pa[ks], v1, o1, 0, 0, 0); }
        }
        if (ld) st_kv(jn, kA, vA);
        LBAR();
        kA = kB; vA = vB;
    }
    lrun += __shfl_xor(lrun, 32);
    if (hi == 0) wsf[32 + r32] = lrun;
    LDS_WAIT(); asm volatile("" ::: "memory");
    LAS bf16_t* stg = (LAS bf16_t*)(lds + L_OST) + wid * 2048;
#pragma unroll
    for (int r = 0; r < 16; ++r) { const int orow = crow(r, hi); const float rl = __builtin_amdgcn_rcpf(wsf[32 + orow]);
        stg[orow * 64 + r32] = (bf16_t)(cvt_pk_bf16(o0[r] * rl, 0.f) & 0xffffu); stg[orow * 64 + 32 + r32] = (bf16_t)(cvt_pk_bf16(o1[r] * rl, 0.f) & 0xffffu); }
    LDS_WAIT(); asm volatile("" ::: "memory");
    bf16_t* Ow = Ya + (rowbase + (size_t)ci * 64 + (wid & 1) * 32) * 1024 + h * 64;
#pragma unroll
    for (int i = 0; i < 4; ++i) { const int row = i * 8 + (lane >> 3), ch = lane & 7; const u32x4 v = *(const LAS u32x4*)(stg + row * 64 + ch * 8); *(u32x4*)(Ow + (size_t)row * 1024 + ch * 8) = v; }
    __syncthreads();
}
}

#ifndef TIME_PHASE
#define TIME_PHASE -1
#endif
#define PROF(k) do { if (TIME_PHASE >= 20 && blockIdx.x == 0 && F.tid == 0) { const unsigned now_ = (unsigned)__builtin_amdgcn_s_memrealtime(); F.MISC[16 + (k)] += now_ - F.MISC[15]; F.MISC[15] = now_; } } while (0)
namespace rc {
constexpr int LDB = 72, MB = 64 * LDB * 2;
constexpr int FLD = 68, FB = 64 * FLD * 4;
constexpr int L_AT = 0, L_BH = MB, L_BT = 2 * MB, L_KT = 3 * MB, L_RT = 4 * MB, L_KH = 5 * MB, L_V = 6 * MB;
constexpr int L_TWD = 0, L_AD = 9216, L_SGD = 18432;
constexpr int RB = 8 * MB;
constexpr int L_WL = RB, L_AL = RB + FB, L_GL = RB + 2 * FB, L_SEG = RB + 3 * FB;
constexpr int L_NQ0 = RB, L_NQ1 = RB + MB, L_NT0 = RB + 2 * MB, L_NT1 = RB + 3 * MB, L_TQ0 = RB + 4 * MB, L_TQ1 = RB + 5 * MB, L_NKT = RB + 6 * MB, L_NRB = RB + 7 * MB;
constexpr int L_GLD = RB + 8 * MB;
constexpr int L_W1T = L_NQ0, L_W2T = L_NT0, L_WY = L_AT, L_KC = L_BT;
constexpr int L_TAB = L_GLD + 256;
constexpr int T_MUL = 0, T_MUR = 256, T_PAR = 448, T_N = 832;
static_assert(L_SEG + 2048 <= L_GLD && L_TAB + T_N * 4 <= LDSCTL_OFF, "rwkv chunk LDS");

__device__ __forceinline__ void unpack8(const u32x4 w, float* f) { f[0] = bf_lo(w.x); f[1] = bf_hi(w.x); f[2] = bf_lo(w.y); f[3] = bf_hi(w.y); f[4] = bf_lo(w.z); f[5] = bf_hi(w.z); f[6] = bf_lo(w.w); f[7] = bf_hi(w.w); }
__device__ __forceinline__ f32x16 mm64(f32x16 acc, const LAS char* Arows, const LAS char* Bcols, int lane) {
    const int o = ((lane & 31) * LDB + 8 * (lane >> 5)) * 2;
#pragma unroll
    for (int ks = 0; ks < 4; ++ks) { const bf16x8 a = *(const LAS bf16x8*)(Arows + o + 32 * ks), b = *(const LAS bf16x8*)(Bcols + o + 32 * ks); acc = __builtin_amdgcn_mfma_f32_32x32x16_bf16(a, b, acc, 0, 0, 0); }
    return acc;
}
__device__ __forceinline__ s16x4 trrd(const LAS char* p) { return __builtin_bit_cast(s16x4, __builtin_amdgcn_ds_read_tr16_b64_v4i16((LAS s16x4*)p)); }
__device__ __forceinline__ int tr_off(int lane) { return ((8 * (lane >> 5) + ((lane & 15) >> 2)) * LDB + 16 * ((lane >> 4) & 1) + 4 * (lane & 3)) * 2; }
__device__ __forceinline__ bf16x8 frag_tr(const LAS char* Xb, int ks) {
    const s16x4 lo = trrd(Xb + (16 * ks) * LDB * 2), hi = trrd(Xb + (16 * ks + 4) * LDB * 2);
    return (bf16x8){lo[0], lo[1], lo[2], lo[3], hi[0], hi[1], hi[2], hi[3]};
}
__device__ __forceinline__ f32x16 mm64_btr(f32x16 acc, const LAS char* Arows, const LAS char* X, int nb, int lane) {
    const int o = ((lane & 31) * LDB + 8 * (lane >> 5)) * 2; const LAS char* xb = X + 64 * nb + tr_off(lane);
#pragma unroll
    for (int ks = 0; ks < 4; ++ks) { const bf16x8 a = *(const LAS bf16x8*)(Arows + o + 32 * ks), b = frag_tr(xb, ks); acc = __builtin_amdgcn_mfma_f32_32x32x16_bf16(a, b, acc, 0, 0, 0); }
    return acc;
}
__device__ __forceinline__ f32x16 mm64_atr(f32x16 acc, const LAS char* X, int mb, const LAS char* Bcols, int lane) {
    const int o = ((lane & 31) * LDB + 8 * (lane >> 5)) * 2; const LAS char* xb = X + 64 * mb + tr_off(lane);
#pragma unroll
    for (int ks = 0; ks < 4; ++ks) { const bf16x8 a = frag_tr(xb, ks), b = *(const LAS bf16x8*)(Bcols + o + 32 * ks); acc = __builtin_amdgcn_mfma_f32_32x32x16_bf16(a, b, acc, 0, 0, 0); }
    return acc;
}
__device__ __forceinline__ void store_T(const f32x16& d, LAS char* dst, int mb, int nb, int lane) {
    LAS char* p = dst + ((32 * nb + (lane & 31)) * LDB + 32 * mb + 4 * (lane >> 5)) * 2;
#pragma unroll
    for (int g = 0; g < 4; ++g) { u32x2 w; w.x = cvt_pk_bf16(d[4 * g], d[4 * g + 1]); w.y = cvt_pk_bf16(d[4 * g + 2], d[4 * g + 3]); *(LAS u32x2*)(p + 16 * g) = w; }
}
__device__ __forceinline__ void store_T_g(const f32x16& d, bf16_t* dst, int mb, int nb, int lane) {
    bf16_t* p = dst + (32 * nb + (lane & 31)) * 64 + 32 * mb + 4 * (lane >> 5);
#pragma unroll
    for (int g = 0; g < 4; ++g) { u32x2 w; w.x = cvt_pk_bf16(d[4 * g], d[4 * g + 1]); w.y = cvt_pk_bf16(d[4 * g + 2], d[4 * g + 3]); *(u32x2*)(p + 8 * g) = w; }
}
#define RC_M(r) (32 * mb + 8 * ((r) >> 2) + 4 * hi + ((r) & 3))

struct Raw { u32x4 lc[4], lp[4], rc[3], rp[3]; };
__device__ __forceinline__ void load_raw(Raw& R, const bf16_t* Prw, int u, int t, int cg) {
    const int b = u >> 8, h = (u >> 5) & 7, c = u & 31;
    const size_t row = (size_t)b * SEQ + 64 * c + t; const bool hasprev = (c > 0) || (t > 0);
    const bf16_t* pc = Prw + row * RCOLS; const bf16_t* pp = pc - RCOLS; const int lc0 = 1536 + 32 * cg, hd = h * 64 + 8 * cg;
#pragma unroll
    for (int q = 0; q < 4; ++q) { R.lc[q] = *(const u32x4*)(pc + lc0 + 8 * q); R.lp[q] = hasprev ? *(const u32x4*)(pp + lc0 + 8 * q) : (u32x4){0u, 0u, 0u, 0u}; }
#pragma unroll
    for (int w = 0; w < 3; ++w) { R.rc[w] = *(const u32x4*)(pc + w * 512 + hd); R.rp[w] = hasprev ? *(const u32x4*)(pp + w * 512 + hd) : (u32x4){0u, 0u, 0u, 0u}; }
}
__device__ __forceinline__ void chunk_phase(Frame& F, const Ptrs& P) {
  const bf16_t* Prw = (const bf16_t*)(P.ws + WS_PRW);
  int htab = -1; bf16x8 wA[4]; Raw raw;
  if (TIME_PHASE >= 20 && blockIdx.x == 0 && F.tid == 0) F.MISC[15] = (unsigned)__builtin_amdgcn_s_memrealtime();
  if ((int)blockIdx.x < NB * 8 * 32) load_raw(raw, Prw, (int)blockIdx.x, F.tid >> 3, F.tid & 7);
#pragma unroll 1
  for (int u_ = (int)blockIdx.x; u_ < NB * 8 * 32; u_ += F.G) {
    int tid = F.tid, wid = F.wave; asm volatile("" : "+v"(tid), "+s"(wid));
    const int b = u_ >> 8, h = (u_ >> 5) & 7, c = u_ & 31;
    const int lane = tid & 63, t = tid >> 3, cg = tid & 7, r32 = lane & 31, hi = lane >> 5;
    LAS char* lds = (LAS char*)F.lds;
    const size_t u = (size_t)((b * 8 + h) * 32 + c);
    bf16_t* gQe = (bf16_t*)(P.ws + WS_QE) + u * 4096; bf16_t* gYl = (bf16_t*)(P.ws + WS_YLOC) + u * 4096; bf16_t* gPc = (bf16_t*)(P.ws + WS_PC) + u * 4096; bf16_t* gSl = (bf16_t*)(P.ws + WS_SLOC) + u * 4096;
    bf16_t* gG = (bf16_t*)((unsigned char*)P.out + DO_G) + u * 4096; bf16_t* Yr = (bf16_t*)((unsigned char*)P.out + DO_YRA);
    const int hd = h * 64 + 8 * cg;
    const bool is_ad = (cg == 2 || cg == 3); const float alpha = cg < 2 ? 2.f : 1.f, gamma = cg < 2 ? -1.f : 0.f;
    LAS bf16_t* ldst = (LAS bf16_t*)(lds + (cg < 2 ? L_TWD : (cg < 4 ? L_AD : L_SGD))) + t * (cg < 4 ? 72 : 136) + 32 * (cg < 2 ? cg : (cg < 4 ? cg - 2 : cg - 4));
    const size_t row = (size_t)b * SEQ + 64 * c + t;
    LAS float* tab = (LAS float*)(lds + L_TAB);
    if (h != htab) {
        htab = h;
        for (int i = tid; i < T_N; i += 512) { float v;
            if (i < T_MUR) v = P.in[6][1536 + i]; else if (i < T_PAR) { const int w = (i - T_MUR) >> 6, d = (i - T_MUR) & 63; v = P.in[6][w * 512 + h * 64 + d]; }
            else { const int w = (i - T_PAR) >> 6, d = (i - T_PAR) & 63; const float* src = w == 0 ? P.in[7] : (w == 1 ? P.in[9] : (w == 2 ? P.in[12] : (w == 3 ? P.in[13] : (w == 4 ? P.in[14] : P.in[16])))); v = src[h * 64 + d]; }
            tab[i] = v; }
        const int jb = (wid >> 1) & 1;
        const bf16_t* wa = (const bf16_t*)(P.ws + (wid < 4 ? WS_WUP : WS_AUP)) + (size_t)(h * 64 + jb * 32 + r32) * 64 + 8 * hi;
#pragma unroll
        for (int ks = 0; ks < 4; ++ks) wA[ks] = *(const bf16x8*)(wa + 16 * ks);
        LBAR();
    }
    bf16x8 wG[8];
    { const bf16_t* wg = (const bf16_t*)(P.ws + WS_GUP) + (size_t)(h * 64 + ((wid >> 1) & 1) * 32 + r32) * 128 + 8 * hi;
#pragma unroll
      for (int ks = 0; ks < 8; ++ks) wG[ks] = *(const bf16x8*)(wg + 16 * ks); }
    float rv[8], kv[8], vv[8];
    { float cur[8], prv[8], mu[8];
#pragma unroll
      for (int q = 0; q < 4; ++q) {
          unpack8(raw.lc[q], cur); unpack8(raw.lp[q], prv);
          *(f32x4*)mu = *(const LAS f32x4*)(tab + T_MUL + 32 * cg + 8 * q); *(f32x4*)(mu + 4) = *(const LAS f32x4*)(tab + T_MUL + 32 * cg + 8 * q + 4);
          float o[8];
#pragma unroll
          for (int i = 0; i < 8; ++i) { const float xs = cur[i] + (prv[i] - cur[i]) * mu[i]; const float sg = sigmoidf_(alpha * xs); o[i] = is_ad ? xs : alpha * sg + gamma; }
          u32x4 w; w.x = cvt_pk_bf16(o[0], o[1]); w.y = cvt_pk_bf16(o[2], o[3]); w.z = cvt_pk_bf16(o[4], o[5]); w.w = cvt_pk_bf16(o[6], o[7]);
          *(LAS u32x4*)(ldst + 8 * q) = w; }
#pragma unroll
      for (int which = 0; which < 3; ++which) {
          unpack8(raw.rc[which], cur); unpack8(raw.rp[which], prv);
          *(f32x4*)mu = *(const LAS f32x4*)(tab + T_MUR + which * 64 + 8 * cg); *(f32x4*)(mu + 4) = *(const LAS f32x4*)(tab + T_MUR + which * 64 + 8 * cg + 4);
#pragma unroll
          for (int i = 0; i < 8; ++i) { const float xs = cur[i] + (prv[i] - cur[i]) * mu[i]; if (which == 0) rv[i] = xs; else if (which == 1) kv[i] = xs; else vv[i] = xs; } } }
    LBAR(); PROF(0);
    { const int ib = wid & 1, jb = (wid >> 1) & 1;
      auto wr4 = [&](const f32x16& acc, LAS float* Out) { LAS float* op = Out + (ib * 32 + r32) * FLD + jb * 32 + 4 * hi;
#pragma unroll
          for (int g = 0; g < 4; ++g) *(LAS f32x4*)(op + 8 * g) = (f32x4){acc[4 * g], acc[4 * g + 1], acc[4 * g + 2], acc[4 * g + 3]}; };
      { f32x16 acc = {}; const LAS bf16_t* qp = (const LAS bf16_t*)(lds + (wid < 4 ? L_TWD : L_AD)) + (ib * 32 + r32) * 72 + 8 * hi;
#pragma unroll
        for (int ks = 0; ks < 4; ++ks) acc = __builtin_amdgcn_mfma_f32_32x32x16_bf16(wA[ks], *(const LAS bf16x8*)(qp + 16 * ks), acc, 0, 0, 0);
        wr4(acc, (LAS float*)(lds + (wid < 4 ? L_WL : L_AL))); }
      if (wid < 4) { f32x16 acc = {}; const LAS bf16_t* qp = (const LAS bf16_t*)(lds + L_SGD) + (ib * 32 + r32) * 136 + 8 * hi;
#pragma unroll
        for (int ks = 0; ks < 8; ++ks) acc = __builtin_amdgcn_mfma_f32_32x32x16_bf16(wG[ks], *(const LAS bf16x8*)(qp + 16 * ks), acc, 0, 0, 0);
        wr4(acc, (LAS float*)(lds + L_GL)); } }
    LBAR(); PROF(1);
    float lam[8], av[8], bv[8], kp[8];
    const int o68 = t * FLD + 8 * cg;
    { float wl[8], al[8], gv[8];
      *(f32x4*)wl = *(LAS f32x4*)(lds + L_WL + 4 * o68); *(f32x4*)(wl + 4) = *(LAS f32x4*)(lds + L_WL + 4 * o68 + 16);
      *(f32x4*)al = *(LAS f32x4*)(lds + L_AL + 4 * o68); *(f32x4*)(al + 4) = *(LAS f32x4*)(lds + L_AL + 4 * o68 + 16);
      *(f32x4*)gv = *(LAS f32x4*)(lds + L_GL + 4 * o68); *(f32x4*)(gv + 4) = *(LAS f32x4*)(lds + L_GL + 4 * o68 + 16);
      float w0[8], a0[8], kk_[8], ka[8], rk[8], lb[8];
      { const LAS float* tp = tab + T_PAR + 8 * cg;
        *(f32x4*)w0 = *(const LAS f32x4*)(tp); *(f32x4*)(w0 + 4) = *(const LAS f32x4*)(tp + 4);
        *(f32x4*)a0 = *(const LAS f32x4*)(tp + 64); *(f32x4*)(a0 + 4) = *(const LAS f32x4*)(tp + 68);
        *(f32x4*)kk_ = *(const LAS f32x4*)(tp + 128); *(f32x4*)(kk_ + 4) = *(const LAS f32x4*)(tp + 132);
        *(f32x4*)ka = *(const LAS f32x4*)(tp + 192); *(f32x4*)(ka + 4) = *(const LAS f32x4*)(tp + 196);
        *(f32x4*)rk = *(const LAS f32x4*)(tp + 256); *(f32x4*)(rk + 4) = *(const LAS f32x4*)(tp + 260);
        *(f32x4*)lb = *(const LAS f32x4*)(tp + 320); *(f32x4*)(lb + 4) = *(const LAS f32x4*)(tp + 324); }
      float asg[8], kkv[8], c2[8]; float ss = 0.f, bon = 0.f;
#pragma unroll
      for (int i = 0; i < 8; ++i) { lam[i] = 0.60653065971f * sigmoidf_(w0[i] + wl[i]); asg[i] = sigmoidf_(a0[i] + al[i]);
          kkv[i] = kv[i] * kk_[i]; ss += kkv[i] * kkv[i]; kp[i] = kv[i] * (1.f + (asg[i] - 1.f) * ka[i]); bon += rv[i] * kp[i] * rk[i]; }
      ss = red8(ss); bon = red8(bon);
      const float inv = 1.f / fmaxf(sqrtf(ss), 1e-12f);
#pragma unroll
      for (int i = 0; i < 8; ++i) { const float kn = kkv[i] * inv; av[i] = -kn; bv[i] = kn * asg[i]; c2[i] = (lb[i] + bon * vv[i]) * gv[i]; }
      u32x4 w; w.x = cvt_pk_bf16(gv[0], gv[1]); w.y = cvt_pk_bf16(gv[2], gv[3]); w.z = cvt_pk_bf16(gv[4], gv[5]); w.w = cvt_pk_bf16(gv[6], gv[7]);
      *(u32x4*)(gG + t * 64 + 8 * cg) = w;
      w.x = cvt_pk_bf16(c2[0], c2[1]); w.y = cvt_pk_bf16(c2[2], c2[3]); w.z = cvt_pk_bf16(c2[4], c2[5]); w.w = cvt_pk_bf16(c2[6], c2[7]);
      *(u32x4*)(Yr + row * 1024 + hd) = w; }
    float cum[8];
    { const int tl = lane >> 3;
#pragma unroll
      for (int i = 0; i < 8; ++i) { float x = lam[i];
          float y = __shfl_up(x, 8); x += (tl >= 1) ? y : 0.f; y = __shfl_up(x, 16); x += (tl >= 2) ? y : 0.f; y = __shfl_up(x, 32); x += (tl >= 4) ? y : 0.f;
          cum[i] = x; }
      if (tl == 7) { *(LAS f32x4*)(lds + L_SEG + (wid * 64 + 8 * cg) * 4) = *(f32x4*)cum; *(LAS f32x4*)(lds + L_SEG + (wid * 64 + 8 * cg) * 4 + 16) = *(f32x4*)(cum + 4); } }
    LBAR(); PROF(2);
    { float pre[8], tot[8];
#pragma unroll
      for (int i = 0; i < 8; ++i) { pre[i] = 0.f; tot[i] = 0.f; }
      const int myseg = t >> 3;
#pragma unroll
      for (int s = 0; s < 8; ++s) { float sv[8]; *(f32x4*)sv = *(LAS f32x4*)(lds + L_SEG + (s * 64 + 8 * cg) * 4); *(f32x4*)(sv + 4) = *(LAS f32x4*)(lds + L_SEG + (s * 64 + 8 * cg) * 4 + 16);
#pragma unroll
          for (int i = 0; i < 8; ++i) { tot[i] += sv[i]; pre[i] += (s < myseg) ? sv[i] : 0.f; } }
      float at_[8], bt_[8], kt_[8], rt_[8], bh_[8], kh_[8];
#pragma unroll
      for (int i = 0; i < 8; ++i) { const float cm = cum[i] + pre[i];
          const float gi = __builtin_amdgcn_exp2f(cm * LOG2E), g_ = __builtin_amdgcn_exp2f(-cm * LOG2E), gm1 = __builtin_amdgcn_exp2f(-(cm - lam[i]) * LOG2E), glg = __builtin_amdgcn_exp2f(-(tot[i] - cm) * LOG2E);
          at_[i] = av[i] * gm1; bt_[i] = bv[i] * gi; kt_[i] = kp[i] * gi; rt_[i] = rv[i] * g_; bh_[i] = bv[i] * glg; kh_[i] = kp[i] * glg; }
      if (t == 0) { float gl[8];
#pragma unroll
          for (int i = 0; i < 8; ++i) gl[i] = __builtin_amdgcn_exp2f(-tot[i] * LOG2E);
          *(LAS f32x4*)(lds + L_GLD + 32 * cg) = *(f32x4*)gl; *(LAS f32x4*)(lds + L_GLD + 32 * cg + 16) = *(f32x4*)(gl + 4); }
      const int ob = (t * LDB + 8 * cg) * 2; u32x4 w;
      w.x = cvt_pk_bf16(at_[0], at_[1]); w.y = cvt_pk_bf16(at_[2], at_[3]); w.z = cvt_pk_bf16(at_[4], at_[5]); w.w = cvt_pk_bf16(at_[6], at_[7]); *(LAS u32x4*)(lds + L_AT + ob) = w;
      w.x = cvt_pk_bf16(bt_[0], bt_[1]); w.y = cvt_pk_bf16(bt_[2], bt_[3]); w.z = cvt_pk_bf16(bt_[4], bt_[5]); w.w = cvt_pk_bf16(bt_[6], bt_[7]); *(LAS u32x4*)(lds + L_BT + ob) = w;
      w.x = cvt_pk_bf16(kt_[0], kt_[1]); w.y = cvt_pk_bf16(kt_[2], kt_[3]); w.z = cvt_pk_bf16(kt_[4], kt_[5]); w.w = cvt_pk_bf16(kt_[6], kt_[7]); *(LAS u32x4*)(lds + L_KT + ob) = w;
      w.x = cvt_pk_bf16(rt_[0], rt_[1]); w.y = cvt_pk_bf16(rt_[2], rt_[3]); w.z = cvt_pk_bf16(rt_[4], rt_[5]); w.w = cvt_pk_bf16(rt_[6], rt_[7]); *(LAS u32x4*)(lds + L_RT + ob) = w;
      w.x = cvt_pk_bf16(bh_[0], bh_[1]); w.y = cvt_pk_bf16(bh_[2], bh_[3]); w.z = cvt_pk_bf16(bh_[4], bh_[5]); w.w = cvt_pk_bf16(bh_[6], bh_[7]); *(LAS u32x4*)(lds + L_BH + ob) = w;
      w.x = cvt_pk_bf16(kh_[0], kh_[1]); w.y = cvt_pk_bf16(kh_[2], kh_[3]); w.z = cvt_pk_bf16(kh_[4], kh_[5]); w.w = cvt_pk_bf16(kh_[6], kh_[7]); *(LAS u32x4*)(lds + L_KH + ob) = w;
      w.x = cvt_pk_bf16(vv[0], vv[1]); w.y = cvt_pk_bf16(vv[2], vv[3]); w.z = cvt_pk_bf16(vv[4], vv[5]); w.w = cvt_pk_bf16(vv[6], vv[7]); *(LAS u32x4*)(lds + L_V + ob) = w; }
    LBAR(); PROF(4);
    load_raw(raw, Prw, (u_ + F.G < NB * 8 * 32) ? u_ + F.G : u_, t, cg);
    {
    wid = __builtin_amdgcn_readfirstlane(wid); asm volatile("" : "+v"(tid), "+s"(wid));
    const int lane = tid & 63, r32 = lane & 31, hi = lane >> 5;
    const int mb = wid & 1, nb = (wid >> 1) & 1, grp = wid >> 2;
    const int ao = 32 * mb * LDB * 2, bo = 32 * nb * LDB * 2;
    const int ncol = 32 * nb + r32;
    f32x16 accT = {};
    {
        f32x16 d = {};
        if (grp == 0) { d = mm64(d, lds + L_AT + ao, lds + L_KT + bo, lane);
#pragma unroll
            for (int r = 0; r < 16; ++r) d[r] = (ncol < RC_M(r)) ? d[r] : 0.f;
            store_T(d, lds + L_NKT, mb, nb, lane); }
        else { d = mm64(d, lds + L_BT + ao, lds + L_AT + bo, lane);
#pragma unroll
            for (int r = 0; r < 16; ++r) { d[r] = (RC_M(r) < ncol) ? d[r] : 0.f; accT[r] = d[r] + ((RC_M(r) == ncol) ? 1.f : 0.f); }
            store_T(d, lds + L_NQ0, mb, nb, lane); store_T(accT, lds + L_TQ0, mb, nb, lane); }
    }
    LBAR(); PROF(5);
#pragma unroll
    for (int j = 1; j <= 5; ++j) { const int cur = (j - 1) & 1, nw = j & 1;
        const int nq_c = cur ? L_NQ1 : L_NQ0, nq_n = nw ? L_NQ1 : L_NQ0;
        if (grp == 0) { f32x16 d = {}; d = mm64_atr(d, lds + nq_c, mb, lds + nq_c + bo, lane); store_T(d, lds + nq_n, mb, nb, lane); }
        else if (j == 1) { f32x16 e = {}; e = mm64(e, lds + L_BT + ao, lds + L_RT + bo, lane);
#pragma unroll
            for (int r = 0; r < 16; ++r) e[r] = (RC_M(r) <= ncol) ? e[r] : 0.f;
            store_T(e, lds + L_NRB, mb, nb, lane); }
        else { const int tq_r = nw ? L_TQ1 : L_TQ0, tq_w = cur ? L_TQ1 : L_TQ0;
            accT = mm64_atr(accT, lds + nq_c, mb, lds + tq_r + bo, lane); store_T(accT, lds + tq_w, mb, nb, lane); }
        LBAR();
    }
    if (grp == 1) { accT = mm64_atr(accT, lds + L_NQ1, mb, lds + L_TQ0 + bo, lane); store_T(accT, lds + L_TQ1, mb, nb, lane); }
    LBAR(); PROF(6);
    { f32x16 d = {};
      if (grp == 0) { d = mm64_btr(d, lds + L_TQ1 + ao, lds + L_AT, nb, lane); store_T(d, lds + L_W1T, mb, nb, lane); }
      else { d = mm64(d, lds + L_TQ1 + ao, lds + L_NKT + bo, lane); store_T(d, lds + L_W2T, mb, nb, lane); } }
    LBAR(); PROF(7);
    if (grp == 0) {
        f32x16 d = {}; d = mm64(d, lds + L_W1T + ao, lds + L_NRB + bo, lane);
#pragma unroll
        for (int g = 0; g < 4; ++g) { const u32x2 rw = *(const LAS u32x2*)(lds + L_RT + ((32 * nb + r32) * LDB + 32 * mb + 8 * g + 4 * hi) * 2);
            d[4 * g] += bf_lo(rw.x); d[4 * g + 1] += bf_hi(rw.x); d[4 * g + 2] += bf_lo(rw.y); d[4 * g + 3] += bf_hi(rw.y); }
        store_T_g(d, gQe, mb, nb, lane);
        f32x16 p = {}; p = mm64_btr(p, lds + L_W1T + ao, lds + L_BH, nb, lane);
        const float gl = ((const LAS float*)(lds + L_GLD))[ncol];
#pragma unroll
        for (int r = 0; r < 16; ++r) p[r] += (RC_M(r) == ncol) ? gl : 0.f;
        store_T_g(p, gPc, mb, nb, lane);
    } else {
        f32x16 d = {}; d = mm64(d, lds + L_KT + ao, lds + L_RT + bo, lane); d = mm64(d, lds + L_W2T + ao, lds + L_NRB + bo, lane);
#pragma unroll
        for (int r = 0; r < 16; ++r) d[r] = (RC_M(r) <= ncol) ? d[r] : 0.f;
        f32x16 k = {}; k = mm64_btr(k, lds + L_W2T + ao, lds + L_BH, nb, lane);
        { const LAS char* kb = lds + L_KH + 64 * nb + ((32 * mb + 4 * hi + ((lane & 15) >> 2)) * LDB + 16 * ((lane >> 4) & 1) + 4 * (lane & 3)) * 2;
#pragma unroll
          for (int g = 0; g < 4; ++g) { const s16x4 kw = trrd(kb + 8 * g * LDB * 2);
              k[4 * g] += bf_lo((unsigned)(unsigned short)kw[0]); k[4 * g + 1] += bf_lo((unsigned)(unsigned short)kw[1]); k[4 * g + 2] += bf_lo((unsigned)(unsigned short)kw[2]); k[4 * g + 3] += bf_lo((unsigned)(unsigned short)kw[3]); } }
        store_T(d, lds + L_WY, mb, nb, lane); store_T(k, lds + L_KC, mb, nb, lane);
    }
    LBAR(); PROF(8);
    { f32x16 d = {};
      if (grp == 0) { d = mm64_atr(d, lds + L_V, mb, lds + L_WY + bo, lane); store_T_g(d, gYl, mb, nb, lane); }
      else { d = mm64_btr(d, lds + L_KC + ao, lds + L_V, nb, lane); store_T_g(d, gSl, mb, nb, lane); } }
    LBAR(); PROF(9);
    }
  }
}

__device__ __forceinline__ void state_chain(Frame& F, const Ptrs& P, int bh) {
    const int tid = F.tid, lane = F.lane, wid = F.wave, r32 = lane & 31, hi = lane >> 5;
    LAS char* lds = (LAS char*)F.lds;
    const bf16_t* gPc = (const bf16_t*)(P.ws + WS_PC) + (size_t)bh * 32 * 4096; const bf16_t* gSl = (const bf16_t*)(P.ws + WS_SLOC) + (size_t)bh * 32 * 4096;
    bf16_t* gS = (bf16_t*)((unsigned char*)P.out + DO_SC) + (size_t)bh * 32 * 4096;
    constexpr int L_S0 = 0, L_S1 = MB, L_P = 2 * MB;
    for (int i = tid; i < MB / 4; i += 512) ((LAS unsigned*)(lds + L_S0))[i] = 0u;
    const int prow = tid >> 3, pch = tid & 7;
    u32x4 pw = *(const u32x4*)(gPc + prow * 64 + pch * 8);
    const int mb = wid & 1, nb = (wid >> 1) & 1;
    __syncthreads();
#pragma unroll 1
    for (int c = 0; c < 32; ++c) {
        const int sc = (c & 1) ? L_S1 : L_S0, sn = (c & 1) ? L_S0 : L_S1;
        *(LAS u32x4*)(lds + L_P + (prow * LDB + pch * 8) * 2) = pw;
        *(u32x4*)(gS + (size_t)c * 4096 + prow * 64 + pch * 8) = *(const LAS u32x4*)(lds + sc + (prow * LDB + pch * 8) * 2);
        if (c + 1 < 32) pw = *(const u32x4*)(gPc + (size_t)(c + 1) * 4096 + prow * 64 + pch * 8);
        f32x16 d = {};
        if (wid < 4) {
            const bf16_t* sp = gSl + (size_t)c * 4096 + (32 * nb + r32) * 64 + 32 * mb + 4 * hi;
#pragma unroll
            for (int g = 0; g < 4; ++g) { const u32x2 w = *(const u32x2*)(sp + 8 * g); d[4 * g] = bf_lo(w.x); d[4 * g + 1] = bf_hi(w.x); d[4 * g + 2] = bf_lo(w.y); d[4 * g + 3] = bf_hi(w.y); } }
        __syncthreads();
        if (wid < 4) { d = mm64(d, lds + L_P + 32 * mb * LDB * 2, lds + sc + 32 * nb * LDB * 2, lane); store_T(d, lds + sn, mb, nb, lane); }
        __syncthreads();
    }
}

__device__ __forceinline__ void out_unit(Frame& F, const Ptrs& P, int u, int nb, bool do_store = true) {
    const int lane = F.lane, r32 = lane & 31, hi = lane >> 5;
    const bf16_t* gQe = (const bf16_t*)(P.ws + WS_QE) + (size_t)u * 4096; const bf16_t* gYl = (const bf16_t*)(P.ws + WS_YLOC) + (size_t)u * 4096;
    const bf16_t* gS = (const bf16_t*)((unsigned char*)P.out + DO_SC) + (size_t)u * 4096; const bf16_t* gG = (const bf16_t*)((unsigned char*)P.out + DO_G) + (size_t)u * 4096;
    bf16_t* Yr = (bf16_t*)((unsigned char*)P.out + DO_YRA);
    const int bh = u >> 5, c = u & 31, h = bh & 7, b = bh >> 3;
    const int tl = 32 * nb + r32;
    const size_t row = (size_t)b * SEQ + 64 * c + tl;
    bf16_t* yo = Yr + row * 1024 + h * 64 + 4 * hi; const bf16_t* gg = gG + tl * 64 + 4 * hi; const float* lg = P.in[15] + h * 64 + 4 * hi; const bf16_t* yl = gYl + tl * 64 + 4 * hi;
    bf16x8 qf[4], sa[4], sb[4];
#pragma unroll
    for (int ks = 0; ks < 4; ++ks) { qf[ks] = *(const bf16x8*)(gQe + (32 * nb + r32) * 64 + 16 * ks + 8 * hi); sa[ks] = *(const bf16x8*)(gS + r32 * 64 + 16 * ks + 8 * hi); sb[ks] = *(const bf16x8*)(gS + (32 + r32) * 64 + 16 * ks + 8 * hi); }
    u32x2 ylw[2][4], gw[2][4], cw[2][4]; f32x4 l4[2][4];
#pragma unroll
    for (int eb = 0; eb < 2; ++eb)
#pragma unroll
        for (int g = 0; g < 4; ++g) { const int eo = 32 * eb + 8 * g; ylw[eb][g] = *(const u32x2*)(yl + eo); gw[eb][g] = *(const u32x2*)(gg + eo); cw[eb][g] = *(const u32x2*)(yo + eo); l4[eb][g] = *(const f32x4*)(lg + eo); }
    f32x16 y0 = {}, y1 = {};
#pragma unroll
    for (int ks = 0; ks < 4; ++ks) { y0 = __builtin_amdgcn_mfma_f32_32x32x16_bf16(sa[ks], qf[ks], y0, 0, 0, 0); y1 = __builtin_amdgcn_mfma_f32_32x32x16_bf16(sb[ks], qf[ks], y1, 0, 0, 0); }
    float s = 0.f;
#pragma unroll
    for (int g = 0; g < 4; ++g) { const u32x2 a = ylw[0][g], bq = ylw[1][g];
        y0[4 * g] += bf_lo(a.x); y0[4 * g + 1] += bf_hi(a.x); y0[4 * g + 2] += bf_lo(a.y); y0[4 * g + 3] += bf_hi(a.y);
        y1[4 * g] += bf_lo(bq.x); y1[4 * g + 1] += bf_hi(bq.x); y1[4 * g + 2] += bf_lo(bq.y); y1[4 * g + 3] += bf_hi(bq.y); }
#pragma unroll
    for (int r = 0; r < 16; ++r) s += y0[r] + y1[r];
    s += __shfl_xor(s, 32); const float mean = s * (1.f / 64.f); float q2 = 0.f;
#pragma unroll
    for (int r = 0; r < 16; ++r) { y0[r] -= mean; y1[r] -= mean; q2 += y0[r] * y0[r] + y1[r] * y1[r]; }
    q2 += __shfl_xor(q2, 32); const float rstd = 1.f / sqrtf(q2 * (1.f / 64.f) + 64e-5f);
#pragma unroll
    for (int g = 0; g < 4; ++g) {
#pragma unroll
        for (int eb = 0; eb < 2; ++eb) { const int eo = 32 * eb + 8 * g; const u32x2 g_ = gw[eb][g], c_ = cw[eb][g]; const f32x4 l_ = l4[eb][g];
            const f32x16& y = eb ? y1 : y0;
            const float o0 = y[4 * g] * rstd * l_.x * bf_lo(g_.x) + bf_lo(c_.x), o1 = y[4 * g + 1] * rstd * l_.y * bf_hi(g_.x) + bf_hi(c_.x), o2 = y[4 * g + 2] * rstd * l_.z * bf_lo(g_.y) + bf_lo(c_.y), o3 = y[4 * g + 3] * rstd * l_.w * bf_hi(g_.y) + bf_hi(c_.y);
            u32x2 w; w.x = cvt_pk_bf16(o0, o1); w.y = cvt_pk_bf16(o2, o3);
            if (do_store) *(u32x2*)(yo + eo) = w; } }
}
#undef RC_M
}
__device__ __forceinline__ void phase_route(Frame& F, const Ptrs& P) {
    const int lane = F.lane, gw = F.vcu * NWAVES + F.wave, NGW = F.G * NWAVES;
    const float* x1 = P.in[0]; const bf16_t* Dl = (const bf16_t*)(P.ws + WS_DELTA); const float* mod = (const float*)(P.ws + WS_MOD);
    const float* gam2 = (const float*)(P.ws + WS_GAM2); const float* cb = (const float*)(P.ws + WS_CB);
    const bf16_t* wrh = (const bf16_t*)(P.ws + WS_WRH); const bf16_t* wrl = (const bf16_t*)(P.ws + WS_WRL);
    bf16_t* H2 = (bf16_t*)(P.ws + WS_H2);
    int* tok_list = (int*)(P.ws + WS_TOKLIST); int* tok_pos = (int*)(P.ws + WS_TOKPOS); int* slot_tok = (int*)(P.ws + WS_SLOTTOK); float* slot_w = (float*)(P.ws + WS_SLOTW);
    unsigned* cnt = (unsigned*)(F.ctl + CW_CNT);
    constexpr int WROW = 1040, L_WH = 0, L_WLO = 48 * WROW, L_GAM = 2 * 48 * WROW, L_SCR = L_GAM + 4096, L_CNT = L_SCR + 8 * 16 * 52 * 4;
    static_assert(L_CNT + 1024 <= LDSCTL_OFF, "route LDS");
    LAS char* lds = (LAS char*)F.lds;
    LAS float* scr = (LAS float*)(lds + L_SCR) + F.wave * (16 * 52);
    const int fr = lane & 15, kq = lane >> 4;
    LAS unsigned* lcnt = (LAS unsigned*)(lds + L_CNT); LAS unsigned* lbase = lcnt + 64;
    for (int rnd = F.vcu; rnd < NTOK / 128; rnd += F.G) {
        const int R0 = rnd * 128 + F.wave * 16, b = R0 / SEQ;
        const float* xr = x1 + (size_t)(R0 + fr) * DM + 8 * kq; const bf16_t* dr = Dl + (size_t)(R0 + fr) * DM + 8 * kq;
        f32x4 acc[3] = {{0.f, 0.f, 0.f, 0.f}, {0.f, 0.f, 0.f, 0.f}, {0.f, 0.f, 0.f, 0.f}}; float ssq = 0.f;
#pragma unroll 1
        for (int half = 0; half < 2; ++half) {
            __syncthreads();
            if (half == 0) { if (F.tid < NLIST) lcnt[F.tid] = 0u; for (int i = F.tid; i < DM / 4; i += 512) *(LAS f32x4*)(lds + L_GAM + 16 * i) = *(const f32x4*)(gam2 + (size_t)b * DM + 4 * i); }
            for (int i = F.tid; i < 48 * 64; i += 512) { const int row = i >> 6, ch = i & 63;
                *(LAS u32x4*)(lds + L_WH + row * WROW + ch * 16) = *(const u32x4*)(wrh + (size_t)row * DM + half * 512 + ch * 8);
                *(LAS u32x4*)(lds + L_WLO + row * WROW + ch * 16) = *(const u32x4*)(wrl + (size_t)row * DM + half * 512 + ch * 8); }
            __syncthreads();
            const LAS char* bh = lds + L_WH + fr * WROW + kq * 16; const LAS char* bl = lds + L_WLO + fr * WROW + kq * 16; const LAS char* gp = lds + L_GAM + (half * 512 + 8 * kq) * 4;
#pragma unroll 2
            for (int kk = 0; kk < 512; kk += 32) { const int k0 = half * 512 + kk;
                f32x4 xa = *(const f32x4*)(xr + k0), xb = *(const f32x4*)(xr + k0 + 4); const f32x4 ga = *(const LAS f32x4*)(gp + kk * 4), gb = *(const LAS f32x4*)(gp + kk * 4 + 16);
                { const u32x4 dw = *(const u32x4*)(dr + k0); xa.x += bf_lo(dw.x); xa.y += bf_hi(dw.x); xa.z += bf_lo(dw.y); xa.w += bf_hi(dw.y); xb.x += bf_lo(dw.z); xb.y += bf_hi(dw.z); xb.z += bf_lo(dw.w); xb.w += bf_hi(dw.w); }
                ssq += (xa.x * xa.x + xa.y * xa.y) + (xa.z * xa.z + xa.w * xa.w) + (xb.x * xb.x + xb.y * xb.y) + (xb.z * xb.z + xb.w * xb.w);
                const f32x4 ya = xa * ga, yb = xb * gb;
                u32x4 hw; hw.x = cvt_pk_bf16(ya.x, ya.y); hw.y = cvt_pk_bf16(ya.z, ya.w); hw.z = cvt_pk_bf16(yb.x, yb.y); hw.w = cvt_pk_bf16(yb.z, yb.w);
                u32x4 lw; lw.x = cvt_pk_bf16(ya.x - bf_lo(hw.x), ya.y - bf_hi(hw.x)); lw.y = cvt_pk_bf16(ya.z - bf_lo(hw.y), ya.w - bf_hi(hw.y));
                lw.z = cvt_pk_bf16(yb.x - bf_lo(hw.z), yb.y - bf_hi(hw.z)); lw.w = cvt_pk_bf16(yb.z - bf_lo(hw.w), yb.w - bf_hi(hw.w));
                const bf16x8 ah = __builtin_bit_cast(bf16x8, hw), al = __builtin_bit_cast(bf16x8, lw);
#pragma unroll
                for (int nb = 0; nb < 3; ++nb) { const bf16x8 wh = *(const LAS bf16x8*)(bh + nb * 16 * WROW + kk * 2), wl = *(const LAS bf16x8*)(bl + nb * 16 * WROW + kk * 2);
                    acc[nb] = __builtin_amdgcn_mfma_f32_16x16x32_bf16(ah, wh, acc[nb], 0, 0, 0); acc[nb] = __builtin_amdgcn_mfma_f32_16x16x32_bf16(al, wh, acc[nb], 0, 0, 0); acc[nb] = __builtin_amdgcn_mfma_f32_16x16x32_bf16(ah, wl, acc[nb], 0, 0, 0); }
            }
        }
        ssq += __shfl_xor(ssq, 16); ssq += __shfl_xor(ssq, 32);
        const float rinv = 1.f / sqrtf(ssq * (1.f / DM) + 1e-6f);
#pragma unroll
        for (int nb = 0; nb < 3; ++nb)
#pragma unroll
            for (int j = 0; j < 4; ++j) scr[(4 * kq + j) * 52 + 16 * nb + fr] = acc[nb][j];
        LDS_WAIT(); asm volatile("" ::: "memory");
        int l1 = 0, l2 = 0, q1 = 0, q2 = 0; float w1 = 0.f, w2 = 0.f;
        if (lane < 16) {
            const float* cbb = cb + b * 64; const LAS float* lr = scr + lane * 52;
            float lc[4]; int grp = 0; float best = -3.4e38f;
#pragma unroll
            for (int o = 0; o < 4; ++o) { lc[o] = rinv * lr[o] + cbb[o]; if (lc[o] > best) { best = lc[o]; grp = o; } }
            float den = 0.f;
#pragma unroll
            for (int o = 0; o < 4; ++o) den += __expf(lc[o] - best);
            const float pgrp = 1.f / den;
            float f1 = -3.4e38f, f2 = -3.4e38f; int i1 = 0, i2 = 0;
            for (int o = 0; o < 8; ++o) { const float v = rinv * lr[4 + grp * 8 + o] + cbb[4 + grp * 8 + o];
                if (v > f1) { f2 = f1; i2 = i1; f1 = v; i1 = o; } else if (v > f2) { f2 = v; i2 = o; } }
            const float e2 = __expf(f2 - f1); w1 = pgrp / (1.f + e2); w2 = pgrp * e2 / (1.f + e2);
            l1 = (grp * 8 + i1) * 2; l2 = (grp * 8 + i2) * 2 + 1;
            q1 = (int)__hip_atomic_fetch_add(lcnt + l1, 1u, __ATOMIC_RELAXED, __HIP_MEMORY_SCOPE_WORKGROUP); q2 = (int)__hip_atomic_fetch_add(lcnt + l2, 1u, __ATOMIC_RELAXED, __HIP_MEMORY_SCOPE_WORKGROUP);
        }
        __syncthreads();
        if (F.tid < NLIST) { const unsigned c = ((LAS unsigned*)lcnt)[F.tid]; lbase[F.tid] = c ? atomicAdd(cnt + 64 * F.tid, c) : 0u; }
        __syncthreads();
        if (lane < 16) { const int tok = R0 + lane;
            const int p1 = (int)lbase[l1] + q1, p2 = (int)lbase[l2] + q2;
            tok_list[2 * tok] = l1; tok_list[2 * tok + 1] = l2; tok_pos[2 * tok] = p1; tok_pos[2 * tok + 1] = p2;
            slot_tok[(size_t)l1 * NTOK + p1] = tok; slot_tok[(size_t)l2 * NTOK + p2] = tok; slot_w[(size_t)l1 * NTOK + p1] = w1; slot_w[(size_t)l2 * NTOK + p2] = w2; }
        const float* sh = mod + (size_t)b * MODW + 3 * DM;
#pragma unroll 4
        for (int r = 0; r < 16; ++r) { const float ri = __shfl(rinv, r);
            const GAS f32x4* xrow = (const GAS f32x4*)(x1 + (size_t)(R0 + r) * DM) + lane; const GAS u32x2* drow = (const GAS u32x2*)(Dl + (size_t)(R0 + r) * DM) + lane; GAS u32x2* o8 = (GAS u32x2*)(H2 + (size_t)(R0 + r) * DM) + lane;
#pragma unroll
            for (int j = 0; j < 4; ++j) { const int k = 4 * lane + 256 * j; f32x4 xv = xrow[64 * j]; const u32x2 dw = drow[64 * j]; xv.x += bf_lo(dw.x); xv.y += bf_hi(dw.x); xv.z += bf_lo(dw.y); xv.w += bf_hi(dw.y); const f32x4 g = *(const f32x4*)(gam2 + (size_t)b * DM + k), s = *(const f32x4*)(sh + k);
                const f32x4 hv = xv * ri * g + s; u32x2 w; w.x = cvt_pk_bf16(hv.x, hv.y); w.y = cvt_pk_bf16(hv.z, hv.w); o8[64 * j] = w; } }
        LDS_WAIT(); asm volatile("" ::: "memory");
    }
}
__device__ __forceinline__ void moe_offsets(Frame& F) {
    LAS int* toff = (LAS int*)(F.lds + TOFF_OFF); LAS int* lcnt = (LAS int*)(F.lds + LCNT_OFF); LAS unsigned char* tile_l = (LAS unsigned char*)(F.lds + TILE_L_OFF);
    if (F.tid < NLIST) lcnt[F.tid] = (int)__hip_atomic_load(F.ctl + CW_CNT + 64 * F.tid, RLX_AGENT);
    __syncthreads();
    if (F.tid == 0) { int acc = 0;
#pragma unroll 1
        for (int l = 0; l < NLIST; ++l) { toff[l] = acc; acc += (lcnt[l] + 255) >> 8; } toff[NLIST] = acc; }
    __syncthreads();
    if (F.tid < NLIST) { for (int t = toff[F.tid]; t < toff[F.tid + 1]; ++t) tile_l[t] = (unsigned char)F.tid; }
    __syncthreads();
}
#ifndef MK_ONE_LAUNCH
#define MK_ONE_LAUNCH 1
#endif
constexpr int N_PHASES = 12;

__global__ void __launch_bounds__(NWAVES * 64, 2) fwd_kernel(Args args) {
    extern __shared__ __attribute__((aligned(16))) unsigned char lds_raw[];
    Frame F; F.lds = (LAS unsigned char*)lds_raw; F.MISC = (volatile LAS unsigned*)(F.lds + MISC_OFF);
    F.tid = threadIdx.x; F.lane = F.tid & 63; F.wave = __builtin_amdgcn_readfirstlane(F.tid >> 6);
    F.G = gridDim.x; { const int bx = blockIdx.x; F.vcu = (F.G % 8 == 0) ? (bx % 8) * (F.G / 8) + bx / 8 : bx; }
#ifndef DUP_PHASE
#define DUP_PHASE -1
#endif
#define RELOAD_ARGS() Ptrs P; { int z_ = 0; asm volatile("" : "+s"(z_)); _Pragma("unroll") for (int i_ = 0; i_ < 31; ++i_) P.in[i_] = args.in[i_] + z_; P.out = args.out + z_; P.ws = args.ws + z_; }
    F.ctl = (gu32*)(args.ws + WS_CTL);
    for (int u = F.tid; u < (LDS_BYTES - LDSCTL_OFF) / 4; u += NWAVES * 64) ((LAS unsigned*)(F.lds + LDSCTL_OFF))[u] = 0u;
    __syncthreads();
    XcdBarrier bar; bar.bar = (unsigned*)(F.ctl + CW_BAR); bar.x = 0; bar.st = nullptr;
#if MK_ONE_LAUNCH
    bar = xcd_barrier_post((unsigned*)(F.ctl + CW_BAR), F.MISC + 8);
#define GRID_BAR() xcd_barrier(bar)
#else
#define GRID_BAR() do { } while (0)
#endif
    const int lo = args.ph_lo, hi = args.ph_hi;
#ifndef PH_MASK
#define PH_MASK 0xfff
#endif
#define IN(k) ((((PH_MASK) >> (k)) & 1) && lo <= (k) && (k) < hi)
#ifndef TIME_PHASE
#define TIME_PHASE -1
#endif
#define STAMP(i) do { if (TIME_PHASE >= 0 && blockIdx.x == 0 && F.tid == 0) ((unsigned long long*)(args.ws + WS_CTL + 768 * KiB))[i] = __builtin_amdgcn_s_memrealtime(); } while (0)
#define SEAM(k) do { if (IN(k) && IN((k) + 1)) GRID_BAR(); STAMP((k) + 1); } while (0)
    STAMP(0);
#define MODP ((float*)(P.ws + WS_MOD))
#define PGATE ((unsigned char*)(P.ws + WS_PGATE))

    if (IN(0)) for (int rep_ = 0; rep_ < ((0) == DUP_PHASE ? 2 : 1); ++rep_) { if (rep_) GRID_BAR(); RELOAD_ARGS(); phase_mod(F, P.in[1], P.in[2], P.in[3], MODP); } SEAM(0);
    if (IN(1)) for (int rep_ = 0; rep_ < ((1) == DUP_PHASE ? 2 : 1); ++rep_) { if (rep_) GRID_BAR(); RELOAD_ARGS(); phase_prep(F, P); } SEAM(1);
    if (IN(2)) for (int rep_ = 0; rep_ < ((2) == DUP_PHASE ? 2 : 1); ++rep_) { if (rep_) GRID_BAR(); RELOAD_ARGS();
        pg8::Gemm g{DM, DM, DM}; pg8::DenseOrder S; S.init((const bf16_t*)((unsigned char*)P.out + DO_H), (const bf16_t*)(P.ws + WS_WIN), DM, DM, NTOK, INCOLS, F.G, (int)blockIdx.x);
        pg8::EpiP E{(bf16_t*)(P.ws + WS_PRW), (bf16_t*)(P.ws + WS_PATT), PGATE};
        pg8::gemm_phase<pg8::EpiP, pg8::DenseOrder, true>(F.lds, g, S, E);
        { const int nfull = (NTOK / 256) * (INCOLS / 256) % F.G; const int bx = (int)blockIdx.x; if (nfull > 0 && bx >= nfull) expert_convert_down(F, P, (bx - nfull) * NWAVES + F.wave, (F.G - nfull) * NWAVES); else if (nfull == 0) expert_convert_down(F, P, bx * NWAVES + F.wave, F.G * NWAVES); }
    } SEAM(2);
    if (IN(3)) for (int rep_ = 0; rep_ < ((3) == DUP_PHASE ? 2 : 1); ++rep_) { if (rep_) GRID_BAR(); RELOAD_ARGS();
#pragma unroll 1
        for (int r2 = 0; r2 < (DUP_PHASE == 31 ? 2 : 1); ++r2)
#pragma unroll 1
        for (int u = (int)blockIdx.x; u < NB * 8 * 8; u += F.G) att::attn_unit(F, P, u >> 6, (u >> 3) & 7, u & 7);
        __syncthreads();
#pragma unroll 1
        for (int r2 = 0; r2 < (DUP_PHASE == 30 ? 2 : 1); ++r2) rc::chunk_phase(F, P);
        if (TIME_PHASE >= 20 && blockIdx.x == 0 && F.tid == 0) { unsigned long long* tsp = (unsigned long long*)(args.ws + WS_CTL + 768 * KiB); unsigned long long a_ = 0; tsp[20] = 0; for (int k_ = 0; k_ < 10; ++k_) { a_ += F.MISC[16 + k_]; tsp[21 + k_] = a_; } }
    } SEAM(3);
    constexpr int EC_ITEMS = NE * 2 * 256, EC_SPLIT = EC_ITEMS;
    if (IN(4)) for (int rep_ = 0; rep_ < ((4) == DUP_PHASE ? 2 : 1); ++rep_) { if (rep_) GRID_BAR(); RELOAD_ARGS();
        const int nR = F.G >= 256 ? 128 : F.G / 2, bx = (int)blockIdx.x;
        if (bx < nR) { for (int u = bx; u < NB * 8; u += nR) rc::state_chain(F, P, u); }
        else { const int na = F.G - nR, a = bx - nR; expert_convert(F, P, a * NWAVES + F.wave, na * NWAVES, 0, EC_SPLIT); }
    } SEAM(4);
    if (IN(5)) for (int rep_ = 0; rep_ < ((5) == DUP_PHASE ? 2 : 1); ++rep_) { if (rep_) GRID_BAR(); RELOAD_ARGS();
        const int gw = (int)blockIdx.x * NWAVES + F.wave, NGW = F.G * NWAVES;
        for (int w = gw; w < NB * 8 * 32 * 2; w += NGW) rc::out_unit(F, P, w >> 1, w & 1, !(DUP_PHASE == 5 && rep_ == 0));
        expert_convert(F, P, gw, NGW, EC_SPLIT, EC_ITEMS);
    } SEAM(5);
    if (IN(6)) for (int rep_ = 0; rep_ < ((6) == DUP_PHASE ? 2 : 1); ++rep_) { if (rep_) GRID_BAR(); RELOAD_ARGS();
        pg8::Gemm g{DM, DM, DM}; pg8::DenseOrder S; S.init((const bf16_t*)((unsigned char*)P.out + DO_YRA), (const bf16_t*)(P.ws + WS_WBR), DM, DM, NTOK, DM, F.G, (int)blockIdx.x);
        pg8::EpiMix E{(bf16_t*)(P.ws + WS_T), PGATE}; pg8::gemm_phase<pg8::EpiMix, pg8::DenseOrder, true>(F.lds, g, S, E);
    } SEAM(6);
    if (IN(7)) for (int rep_ = 0; rep_ < ((7) == DUP_PHASE ? 2 : 1); ++rep_) { if (rep_) GRID_BAR(); RELOAD_ARGS();
        pg8::Gemm g{DM, DM, DM}; pg8::DenseOrder S; S.init((const bf16_t*)(P.ws + WS_T), (const bf16_t*)(P.ws + WS_WOUT), DM, DM, NTOK, DM, F.G, (int)blockIdx.x);
        pg8::EpiDelta E{(bf16_t*)(P.ws + WS_DELTA), MODP}; pg8::gemm_phase<pg8::EpiDelta, pg8::DenseOrder, true>(F.lds, g, S, E);
    } SEAM(7);
    if (IN(8)) for (int rep_ = 0; rep_ < ((8) == DUP_PHASE ? 2 : 1); ++rep_) { if (rep_) GRID_BAR(); RELOAD_ARGS(); phase_route(F, P); } SEAM(8);
    if (IN(9)) for (int rep_ = 0; rep_ < ((9) == DUP_PHASE ? 2 : 1); ++rep_) { if (rep_) GRID_BAR(); RELOAD_ARGS();
        moe_offsets(F); const LAS int* toff = (const LAS int*)(F.lds + TOFF_OFF);
        pg8::Gemm g{DM, DM, DM}; pg8::MoeOrderT<true> S{(const bf16_t*)(P.ws + WS_H2), (const bf16_t*)(P.ws + WS_WGU), DM, DM, (size_t)DM * DM, (const LAS unsigned char*)(F.lds + TILE_L_OFF), toff, (const LAS int*)(F.lds + LCNT_OFF), 0, toff[NLIST], F.G, (int)blockIdx.x, (const int*)(P.ws + WS_SLOTTOK)};
        pg8::EpiHid E{(bf16_t*)(P.ws + WS_HID)}; pg8::gemm_phase<pg8::EpiHid, pg8::MoeOrderT<true>, true>(F.lds, g, S, E);
    } SEAM(9);
    if (IN(10)) for (int rep_ = 0; rep_ < ((10) == DUP_PHASE ? 2 : 1); ++rep_) { if (rep_) GRID_BAR(); RELOAD_ARGS();
        moe_offsets(F); const LAS int* toff = (const LAS int*)(F.lds + TOFF_OFF);
        pg8::Gemm g{DE, DE, DE}; pg8::MoeOrderT<false> S{(const bf16_t*)(P.ws + WS_HID), (const bf16_t*)(P.ws + WS_WD), DE, DE, (size_t)DM * DE, (const LAS unsigned char*)(F.lds + TILE_L_OFF), toff, (const LAS int*)(F.lds + LCNT_OFF), 0, toff[NLIST], F.G, (int)blockIdx.x, nullptr};
        pg8::EpiY E{(bf16_t*)(P.ws + WS_YB), (const float*)(P.ws + WS_SLOTW)}; pg8::gemm_phase<pg8::EpiY, pg8::MoeOrderT<false>, true>(F.lds, g, S, E);
    } SEAM(10);
    if (IN(11)) for (int rep_ = 0; rep_ < ((11) == DUP_PHASE ? 2 : 1); ++rep_) { if (rep_) GRID_BAR(); RELOAD_ARGS();
        moe_offsets(F); const LAS int* toff = (const LAS int*)(F.lds + TOFF_OFF);
        const bf16_t* Yb = (const bf16_t*)(P.ws + WS_YB); const int* tok_list = (const int*)(P.ws + WS_TOKLIST); const int* tok_pos = (const int*)(P.ws + WS_TOKPOS);
        const float* mod = MODP; const int gw = F.vcu * NWAVES + F.wave, NGW = F.G * NWAVES;
#pragma unroll 4
        for (int tok = gw; tok < NTOK; tok += NGW) {
            const int s0 = toff[tok_list[2 * tok]] * 256 + tok_pos[2 * tok], s1 = toff[tok_list[2 * tok + 1]] * 256 + tok_pos[2 * tok + 1];
            const float* g2 = mod + (size_t)(tok / SEQ) * MODW + 5 * DM;
            GAS f32x4* xo = (GAS f32x4*)(P.out + (size_t)tok * DM) + F.lane; const GAS f32x4* xi = (const GAS f32x4*)(P.in[0] + (size_t)tok * DM) + F.lane; const GAS u32x2* dd = (const GAS u32x2*)((const bf16_t*)(P.ws + WS_DELTA) + (size_t)tok * DM) + F.lane;
            const GAS u32x2* y0 = (const GAS u32x2*)(Yb + (size_t)s0 * DM) + F.lane; const GAS u32x2* y1 = (const GAS u32x2*)(Yb + (size_t)s1 * DM) + F.lane;
#pragma unroll
            for (int j = 0; j < 4; ++j) { f32x4 xv = xi[64 * j]; const u32x2 dw = dd[64 * j]; xv.x += bf_lo(dw.x); xv.y += bf_hi(dw.x); xv.z += bf_lo(dw.y); xv.w += bf_hi(dw.y); const u32x2 a = y0[64 * j], bq = y1[64 * j]; const f32x4 gv = *(const f32x4*)(g2 + 4 * F.lane + 256 * j);
                f32x4 o; o.x = xv.x + gv.x * (bf_lo(a.x) + bf_lo(bq.x)); o.y = xv.y + gv.y * (bf_hi(a.x) + bf_hi(bq.x)); o.z = xv.z + gv.z * (bf_lo(a.y) + bf_lo(bq.y)); o.w = xv.w + gv.w * (bf_hi(a.y) + bf_hi(bq.y));
                xo[64 * j] = o; }
        }
    }
#ifdef EXTRA_BARS
    for (int i_ = 0; i_ < EXTRA_BARS; ++i_) GRID_BAR();
#endif
#if TIME_PHASE >= 0
    {
#ifndef TIME_SCALE
#define TIME_SCALE 3.0e-4f
#endif
#ifndef TIME_HI
#define TIME_HI (TIME_PHASE + 1)
#endif
        STAMP(12); GRID_BAR();
        const unsigned long long* ts = (const unsigned long long*)(args.ws + WS_CTL + 768 * KiB);
        const float dlt = (float)(ts[TIME_HI] - ts[TIME_PHASE]) * (0.01f * TIME_SCALE);
        for (int i = blockIdx.x * 512 + F.tid; i < (1 << 20); i += gridDim.x * 512) args.out[i] += dlt;
    }
#endif
#undef IN
#undef SEAM
}

extern "C" void kernel_launch(void* const* d_in, const int* in_sizes, int n_in, void* d_out, int out_size, void* d_ws, size_t ws_size, hipStream_t stream) {
    static int grid = 0;
    if (grid == 0) {
        if (n_in != 31 || out_size != NTOK * DM || ws_size < WS_END) { fprintf(stderr, "kernel_launch: unexpected shapes (n_in %d out %d ws %zu)\n", n_in, out_size, ws_size); grid = -1; return; }
        int dev = 0, cus = 0;
        if (hipGetDevice(&dev) != hipSuccess || hipDeviceGetAttribute(&cus, hipDeviceAttributeMultiprocessorCount, dev) != hipSuccess) { grid = -1; return; }
        if (hipFuncSetAttribute((const void*)fwd_kernel, hipFuncAttributeMaxDynamicSharedMemorySize, LDS_BYTES) != hipSuccess) { fprintf(stderr, "kernel_launch: hipFuncSetAttribute failed\n"); grid = -1; return; }
        int per_cu = 0; (void)hipOccupancyMaxActiveBlocksPerMultiprocessor(&per_cu, (const void*)fwd_kernel, NWAVES * 64, LDS_BYTES); (void)hipGetLastError();
        grid = cus;
    }
    if (grid < 0) return;
    (void)hipMemsetAsync((char*)d_ws + WS_CTL, 0, CTL_ZERO_BYTES, stream);
    Args a{};
    for (int i = 0; i < 31; ++i) a.in[i] = (const float*)d_in[i];
    a.out = (float*)d_out; a.ws = (unsigned char*)d_ws;
#if MK_ONE_LAUNCH
    a.ph_lo = 0; a.ph_hi = N_PHASES;
    hipLaunchKernelGGL(fwd_kernel, dim3(grid), dim3(NWAVES * 64), LDS_BYTES, stream, a);
#else
    for (int p = 0; p < N_PHASES; ++p) { a.ph_lo = p; a.ph_hi = p + 1; hipLaunchKernelGGL(fwd_kernel, dim3(grid), dim3(NWAVES * 64), LDS_BYTES, stream, a); }
#endif
}
```

```cpp
#include <hip/hip_runtime.h>
#include <cstdio>
#include <cstdint>

#define LAS __attribute__((address_space(3)))
#define GAS __attribute__((address_space(1)))
typedef unsigned short bf16_t;
typedef short bf16x8 __attribute__((ext_vector_type(8)));
typedef short s16x4 __attribute__((ext_vector_type(4)));
typedef float f32x4 __attribute__((ext_vector_type(4)));
typedef float f32x2 __attribute__((ext_vector_type(2)));
typedef float f32x16 __attribute__((ext_vector_type(16)));
typedef unsigned u32x4 __attribute__((ext_vector_type(4)));
typedef unsigned u32x2 __attribute__((ext_vector_type(2)));

constexpr int NB = 16, SEQ = 2048, DM = 1024, NTOK = NB * SEQ;
constexpr int RCOLS = 1792, ACOLS = 1536, GCOLS = 2048, INCOLS = 5376;
constexpr int NE = 32, DE = 512, NLIST = 64;
constexpr int MODW = 6 * DM;
constexpr float LOG2E = 1.4426950408889634f;

typedef __bf16 bf16x2_t __attribute__((ext_vector_type(2)));
__device__ __forceinline__ unsigned cvt_pk_bf16(float lo, float hi) { const f32x2 v = {lo, hi}; const bf16x2_t b = __builtin_convertvector(v, bf16x2_t); return __builtin_bit_cast(unsigned, b); }
__device__ __forceinline__ float bf_lo(unsigned w) { return __uint_as_float(w << 16); }
__device__ __forceinline__ float bf_hi(unsigned w) { return __uint_as_float(w & 0xffff0000u); }
__device__ __forceinline__ float sigmoidf_(float x) { return __builtin_amdgcn_rcpf(1.0f + __builtin_amdgcn_exp2f(-x * LOG2E)); }

#ifndef GPROF_ON
#define GPROF_ON 0
#endif
#define GPROF(k) do { if (GPROF_ON && blockIdx.x == 0 && threadIdx.x == 0) { volatile LAS unsigned* M_ = (volatile LAS unsigned*)(lds + (163840 - 2048)); const unsigned now_ = (unsigned)__builtin_amdgcn_s_memrealtime(); M_[16 + (k)] += now_ - M_[15]; M_[15] = now_; } } while (0)
#define EPI_ST0(T_, p_, v_) (*(T_*)(p_) = v_)
#ifndef EPI_NT
#define EPI_NT 1
#endif
#if EPI_NT
#define EPI_ST(T_, p_, v_) __builtin_nontemporal_store(v_, (T_*)(p_))
#else
#define EPI_ST(T_, p_, v_) (*(T_*)(p_) = v_)
#endif
namespace pg8 {
constexpr int BM = 256, BK = 64, HALF = 128, HTB = HALF * BK * 2, STAGE_BYTES = 8 * HTB, NXCD = 8, WGM = 8;
__host__ __device__ __forceinline__ int lds_byte(int r, int c) { const int st = (r >> 4) * 2 + (c >> 5), rr = r & 15, cc = c & 31, ob = rr * 64 + cc * 2; return st * 1024 + (ob ^ (((ob >> 9) & 1) << 5)); }
__host__ __device__ __forceinline__ void stage_rc(int b, int& R, int& C) { const int st = b / 1024, sb = b % 1024, swz = sb ^ (((sb >> 9) & 1) << 5); R = (st >> 1) * 16 + swz / 64; C = (st & 1) * 32 + (swz % 64) / 2; }
__host__ __device__ __forceinline__ int perm32(int rho) { const int n = rho >> 4, i = rho & 15; return 8 * (i >> 2) + 4 * n + (i & 3); }

struct Unit { int pm, pn, e, sbase, nvalid; };
struct Gemm { int lda, ldb, K; };

struct DenseOrder {
    static constexpr bool GATHER = false;
    __device__ __forceinline__ int row_tok(const Unit&, int) const { return 0; }
    const bf16_t* A; const bf16_t* Bt; int lda, ldb;
    int nM, nN, nwg, G, c;
    __device__ void init(const bf16_t* A_, const bf16_t* Bt_, int lda_, int ldb_, int M, int N, int G_, int c_) { A = A_; Bt = Bt_; lda = lda_; ldb = ldb_; nM = M / BM; nN = N / BM; nwg = nM * nN; G = G_; c = c_; }
    __device__ bool next(int i, Unit& u) const {
        const long L = (long)i * G + c; if (L >= nwg) return false;
        int wgid = (int)L; { const int q = nwg / NXCD, r = nwg % NXCD, xcd = wgid % NXCD, off = wgid / NXCD; wgid = (xcd < r ? xcd * (q + 1) : r * (q + 1) + (xcd - r) * q) + off; }
        const int nig = WGM * nN, gid = wgid / nig, fm = gid * WGM, gsz = (nM - fm) < WGM ? (nM - fm) : WGM;
        u.pm = fm + ((wgid % nig) % gsz); u.pn = (wgid % nig) / gsz; u.e = 0; u.sbase = 0; u.nvalid = BM; return true;
    }
    __device__ __forceinline__ const char* a_base(const Unit& u) const { return (const char*)A + (size_t)u.pm * BM * lda * 2; }
    __device__ __forceinline__ const char* b_base(const Unit& u) const { return (const char*)Bt + (size_t)u.pn * BM * ldb * 2; }
};
template <bool GATHER_> struct MoeOrderT {
    static constexpr bool GATHER = GATHER_;
    const bf16_t* A; const bf16_t* Bt; int lda, ldb; size_t bt_expert_stride;
    const LAS unsigned char* tile_l;
    const LAS int* toff; const LAS int* lcnt;
    int tlo, thi, G, c;
    const int* slot_tok;
    __device__ __forceinline__ int row_tok(const Unit& u, int r) const { return r < u.nvalid ? slot_tok[u.sbase + r] : 0; }
    __device__ bool next(int i, Unit& u) const {
        const int nt = thi - tlo; int tile, pn;
        if (G % NXCD == 0) { const int x = c % NXCD, cin = c / NXCD, per = G / NXCD; const int t0 = (int)((long)nt * x / NXCD), t1 = (int)((long)nt * (x + 1) / NXCD);
            const long j = (long)i * per + cin; if (j >= (long)(t1 - t0) * 4) return false; tile = tlo + t0 + (int)(j >> 2); pn = (int)(j & 3); }
        else { const long L = (long)i * G + c; if (L >= (long)nt * 4) return false; tile = tlo + (int)(L >> 2); pn = (int)(L & 3); }
        const int l = tile_l[tile], j = tile - toff[l]; u.pm = tile; u.pn = pn; u.e = l >> 1; u.sbase = l * NTOK + j * BM; u.nvalid = lcnt[l] - j * BM; return true;
    }
    __device__ __forceinline__ const char* a_base(const Unit& u) const { return GATHER ? (const char*)A : (const char*)A + (size_t)u.pm * BM * lda * 2; }
    __device__ __forceinline__ const char* b_base(const Unit& u) const { return (const char*)Bt + ((size_t)u.e * bt_expert_stride + (size_t)u.pn * BM * ldb) * 2; }
};

template <class Epi, class Sched, bool ALIGN_EPI>
__device__ __forceinline__ void gemm_phase(LAS unsigned char* lds, const Gemm g, const Sched& S, const Epi& E) {
    const int tid = threadIdx.x, wid = __builtin_amdgcn_readfirstlane(tid >> 6), lane = tid & 63, wr = wid >> 2, wc = wid & 3, fr = lane & 15, fq = lane >> 4;
    const int K = g.K, nt = K / BK;
    unsigned voffA[2], voffB[2]; int RA[2], CA2[2];
#pragma unroll
    for (int i = 0; i < 2; ++i) { int R, C; stage_rc(tid * 16 + i * 8192, R, C); RA[i] = R; CA2[i] = C * 2; const int Rb = Epi::PERM ? ((R & ~31) + perm32(R & 31)) : R;
        voffA[i] = (unsigned)(R * g.lda + C) * 2u; voffB[i] = (unsigned)(Rb * g.ldb + C) * 2u; }
    const size_t kstep = (size_t)(BK * 2);
    const size_t hstepA = (size_t)HALF * g.lda * 2, hstepB = (size_t)HALF * g.ldb * 2;
    const unsigned ldsw = (unsigned)wid * 1024u;
    const int aoff = lds_byte(wr * 64 + fr, fq * 8), boff = lds_byte(wc * 32 + fr, fq * 8);
#define PG8_SA(b, h) (((b) * 2 + (h)) * HTB)
#define PG8_SB(b, h) ((4 + (b) * 2 + (h)) * HTB)
#define PG8_STAGE(bufoff, gbase, voff) do { _Pragma("unroll") for (int _i = 0; _i < 2; ++_i) \
        __builtin_amdgcn_global_load_lds((const unsigned*)((const char*)(gbase) + (voff)[_i]), (LAS unsigned*)(lds + (bufoff) + ldsw + _i * 8192), 16, 0, 0); } while (0)
#define PG8_STAGE_A(bufoff, kptr, half, nx) do { if constexpr (Sched::GATHER) { _Pragma("unroll") for (int _i = 0; _i < 2; ++_i) \
        __builtin_amdgcn_global_load_lds((const unsigned*)((const char*)(kptr) + ((nx) ? vnx[half][_i] : vcu[half][_i])), (LAS unsigned*)(lds + (bufoff) + ldsw + _i * 8192), 16, 0, 0); } \
    else { PG8_STAGE(bufoff, (const char*)(kptr) + ((half) ? hstepA : 0), voffA); } } while (0)
#define PG8_LDA(dst, b, h) do { _Pragma("unroll") for (int m = 0; m < 4; ++m) _Pragma("unroll") for (int k = 0; k < 2; ++k) dst[m][k] = *(const LAS bf16x8*)(lds + PG8_SA(b, h) + aoff + m * 2048 + k * 1024); } while (0)
#define PG8_LDB(dst, b, h) do { _Pragma("unroll") for (int n = 0; n < 2; ++n) _Pragma("unroll") for (int k = 0; k < 2; ++k) dst[n][k] = *(const LAS bf16x8*)(lds + PG8_SB(b, h) + boff + n * 2048 + k * 1024); } while (0)
#define PG8_MMA(ai, bj, At, Bt) do { __builtin_amdgcn_s_setprio(1); _Pragma("unroll") for (int m = 0; m < 4; ++m) _Pragma("unroll") for (int n = 0; n < 2; ++n) _Pragma("unroll") for (int k = 0; k < 2; ++k) \
        acc[ai][bj][m][n] = __builtin_amdgcn_mfma_f32_16x16x32_bf16(Bt[n][k], At[m][k], acc[ai][bj][m][n], 0, 0, 0); __builtin_amdgcn_s_setprio(0); } while (0)
#define PG8_WAIT_V(n) asm volatile("s_waitcnt vmcnt(" #n ")" ::: "memory")
#define PG8_WAIT_L(n) asm volatile("s_waitcnt lgkmcnt(" #n ")" ::: "memory")
#define PG8_BAR __builtin_amdgcn_s_barrier()
#define PG8_SCHED __builtin_amdgcn_sched_barrier(0)
    Unit cur, nxt; int ui = 0;
    if (!S.next(0, cur)) return;
    f32x4 acc[2][2][4][2];
#pragma unroll
    for (int a = 0; a < 2; ++a)
#pragma unroll
        for (int b = 0; b < 2; ++b)
#pragma unroll
            for (int m = 0; m < 4; ++m)
#pragma unroll
                for (int n = 0; n < 2; ++n) acc[a][b][m][n] = (f32x4){0.f, 0.f, 0.f, 0.f};
    bf16x8 At[4][2], B0[2][2], B1[2][2];
    const char* cA = S.a_base(cur); const char* cB = S.b_base(cur);
    unsigned vcu[2][2], vnx[2][2];
    if constexpr (Sched::GATHER) {
#pragma unroll
        for (int hf = 0; hf < 2; ++hf)
#pragma unroll
            for (int i = 0; i < 2; ++i) { vcu[hf][i] = (unsigned)S.row_tok(cur, hf * HALF + RA[i]) * (unsigned)(g.lda * 2) + (unsigned)CA2[i]; vnx[hf][i] = vcu[hf][i]; } }
    if (GPROF_ON && blockIdx.x == 0 && threadIdx.x == 0) { volatile LAS unsigned* M_ = (volatile LAS unsigned*)(lds + (163840 - 2048)); for (int k_ = 0; k_ < 10; ++k_) M_[16 + k_] = 0; M_[15] = (unsigned)__builtin_amdgcn_s_memrealtime(); }
    PG8_STAGE(PG8_SB(0, 0), cB, voffB); PG8_STAGE(PG8_SB(0, 1), cB + hstepB, voffB); PG8_STAGE_A(PG8_SA(0, 0), cA, 0, false); PG8_STAGE_A(PG8_SA(0, 1), cA, 1, false);
    if (wr == 1) PG8_BAR;
    PG8_WAIT_V(2); PG8_BAR;
    PG8_STAGE(PG8_SB(1, 0), cB + kstep, voffB); PG8_STAGE_A(PG8_SA(1, 0), cA + kstep, 0, false); PG8_STAGE(PG8_SB(1, 1), cB + hstepB + kstep, voffB);
    PG8_WAIT_V(6); PG8_BAR;
    for (;;) {
        const bool has_next = S.next(ui + 1, nxt);
        const char* nA = has_next ? S.a_base(nxt) : cA; const char* nB = has_next ? S.b_base(nxt) : cB;
        if constexpr (Sched::GATHER) { if (has_next) {
#pragma unroll
            for (int hf = 0; hf < 2; ++hf)
#pragma unroll
                for (int i = 0; i < 2; ++i) vnx[hf][i] = (unsigned)S.row_tok(nxt, hf * HALF + RA[i]) * (unsigned)(g.lda * 2) + (unsigned)CA2[i]; } }
        for (int t = 0; t < nt; t += 2) {
            if constexpr (Epi::HAS_MID) { if (t == Epi::MID_T) E.mid(acc, cur, wr, wc, fr, fq); }
            const bool last = (t == nt - 2);
            const char* a1 = cA + (size_t)(t + 1) * kstep;
            const char* a2 = last ? nA : cA + (size_t)(t + 2) * kstep; const char* b2 = last ? nB : cB + (size_t)(t + 2) * kstep;
            const char* a3 = a2 + kstep; const char* b3 = b2 + kstep;
            PG8_LDB(B0, 0, 0); PG8_LDB(B1, 0, 1); PG8_SCHED; PG8_LDA(At, 0, 0); PG8_STAGE_A(PG8_SA(1, 1), a1, 1, false);
            PG8_WAIT_V(8); PG8_WAIT_L(0); PG8_BAR; PG8_MMA(0, 0, At, B0); PG8_MMA(0, 1, At, B1); PG8_BAR; PG8_SCHED;
            PG8_LDA(At, 0, 1); PG8_STAGE(PG8_SB(0, 0), b2, voffB); PG8_STAGE(PG8_SB(0, 1), b2 + hstepB, voffB); PG8_STAGE_A(PG8_SA(0, 0), a2, 0, last);
            PG8_WAIT_V(8); PG8_WAIT_L(0); PG8_BAR; PG8_MMA(1, 0, At, B0); PG8_MMA(1, 1, At, B1); PG8_BAR; PG8_SCHED;
            PG8_LDB(B0, 1, 0); PG8_LDB(B1, 1, 1); PG8_SCHED; PG8_LDA(At, 1, 0); PG8_STAGE_A(PG8_SA(0, 1), a2, 1, last);
            PG8_WAIT_V(8); PG8_WAIT_L(0); PG8_BAR; PG8_MMA(0, 0, At, B0); PG8_MMA(0, 1, At, B1); PG8_BAR; PG8_SCHED;
            PG8_LDA(At, 1, 1); PG8_STAGE(PG8_SB(1, 0), b3, voffB); PG8_STAGE(PG8_SB(1, 1), b3 + hstepB, voffB); PG8_STAGE_A(PG8_SA(1, 0), a3, 0, last);
            PG8_WAIT_V(8); PG8_WAIT_L(0); PG8_BAR; PG8_MMA(1, 0, At, B0); PG8_MMA(1, 1, At, B1); PG8_BAR; PG8_SCHED;
            if (GPROF_ON) { if (t == 0) GPROF(3); }
        }
        GPROF(0);
        if constexpr (ALIGN_EPI) { if (wr == 0) PG8_BAR; }
        GPROF(1);
        E(acc, cur, wr, wc, fr, fq);
        GPROF(2);
        if (!has_next) break;
#pragma unroll
        for (int a = 0; a < 2; ++a)
#pragma unroll
            for (int b = 0; b < 2; ++b)
#pragma unroll
                for (int m = 0; m < 4; ++m)
#pragma unroll
                    for (int n = 0; n < 2; ++n) acc[a][b][m][n] = (f32x4){0.f, 0.f, 0.f, 0.f};
        cur = nxt; cA = nA; cB = nB; ++ui;
        if constexpr (Sched::GATHER) {
#pragma unroll
            for (int hf = 0; hf < 2; ++hf)
#pragma unroll
                for (int i = 0; i < 2; ++i) vcu[hf][i] = vnx[hf][i]; }
        if constexpr (ALIGN_EPI) { if (wr == 1) PG8_BAR; }
    }
    PG8_WAIT_V(0);
    if constexpr (!ALIGN_EPI) { if (wr == 0) PG8_BAR; }
    PG8_BAR;
#undef PG8_SA
#undef PG8_SB
#undef PG8_STAGE
#undef PG8_STAGE_A
#undef PG8_LDA
#undef PG8_LDB
#undef PG8_MMA
#undef PG8_WAIT_V
#undef PG8_WAIT_L
#undef PG8_BAR
#undef PG8_SCHED
}

__device__ __forceinline__ unsigned q8(float x) { float s = sigmoidf_(x) * 255.f + 0.5f; s = s < 1.f ? 1.f : s; return (unsigned)s; }
struct EpiP {
    static constexpr bool PERM = true, HAS_MID = false;
    bf16_t *Prw, *Patt; unsigned char* Pgate;
    __device__ __forceinline__ void operator()(const f32x4 (&acc)[2][2][4][2], const Unit& u, int wr, int wc, int fr, int fq) const {
        const int row0 = u.pm * BM + wr * 64 + fr;
        if (u.pn >= 13) { const int col0 = (u.pn - 13) * BM + wc * 32 + 8 * fq;
#pragma unroll
            for (int ai = 0; ai < 2; ++ai)
#pragma unroll
                for (int m = 0; m < 4; ++m) { unsigned char* rowp = Pgate + (size_t)(row0 + ai * HALF + m * 16) * GCOLS + col0;
#pragma unroll
                    for (int bj = 0; bj < 2; ++bj) { const f32x4 v0 = acc[ai][bj][m][0], v1 = acc[ai][bj][m][1];
                        u32x2 w; w.x = q8(v0[0]) | (q8(v0[1]) << 8) | (q8(v0[2]) << 16) | (q8(v0[3]) << 24); w.y = q8(v1[0]) | (q8(v1[1]) << 8) | (q8(v1[2]) << 16) | (q8(v1[3]) << 24);
                        EPI_ST(u32x2, rowp + bj * HALF, w); } }
            return; }
        bf16_t* base; int ldc, colt;
        if (u.pn < 7) { base = Prw; ldc = RCOLS; colt = u.pn * BM; } else { base = Patt; ldc = ACOLS; colt = (u.pn - 7) * BM; }
        const int col0 = colt + wc * 32 + 8 * fq;
#pragma unroll
        for (int ai = 0; ai < 2; ++ai)
#pragma unroll
            for (int m = 0; m < 4; ++m) { bf16_t* rowp = base + (size_t)(row0 + ai * HALF + m * 16) * ldc + col0;
#pragma unroll
                for (int bj = 0; bj < 2; ++bj) { const f32x4 v0 = acc[ai][bj][m][0], v1 = acc[ai][bj][m][1];
                    u32x4 w; w.x = cvt_pk_bf16(v0[0], v0[1]); w.y = cvt_pk_bf16(v0[2], v0[3]); w.z = cvt_pk_bf16(v1[0], v1[1]); w.w = cvt_pk_bf16(v1[2], v1[3]);
                    EPI_ST(u32x4, rowp + bj * HALF, w); } }
    }
};
struct EpiMix {
    static constexpr bool PERM = true, HAS_MID = true; static constexpr int MID_T = 8;
    bf16_t* T; const unsigned char* Pgate;
    static __device__ __forceinline__ float ub(unsigned w, int i) { return (float)((w >> (8 * i)) & 0xffu); }
    __device__ __forceinline__ void mid(f32x4 (&acc)[2][2][4][2], const Unit& u, int wr, int wc, int fr, int fq) const {
        int row0 = u.pm * BM + wr * 64 + fr, col0 = u.pn * BM + wc * 32 + 8 * fq; asm volatile("" : "+v"(row0), "+v"(col0));
#pragma unroll
        for (int ai = 0; ai < 2; ++ai) {
            u32x2 gr[4][2], ga[4][2];
#pragma unroll
            for (int m = 0; m < 4; ++m) { const unsigned char* gp = Pgate + (size_t)(row0 + ai * HALF + m * 16) * GCOLS + col0;
#pragma unroll
                for (int bj = 0; bj < 2; ++bj) { gr[m][bj] = *(const u32x2*)(gp + bj * HALF); ga[m][bj] = *(const u32x2*)(gp + DM + bj * HALF); } }
#pragma unroll
            for (int m = 0; m < 4; ++m)
#pragma unroll
                for (int bj = 0; bj < 2; ++bj) { const u32x2 r = gr[m][bj], a = ga[m][bj]; f32x4& v0 = acc[ai][bj][m][0]; f32x4& v1 = acc[ai][bj][m][1];
#pragma unroll
                    for (int j = 0; j < 4; ++j) { v0[j] *= ub(r.x, j) * __builtin_amdgcn_rcpf(ub(a.x, j)); v1[j] *= ub(r.y, j) * __builtin_amdgcn_rcpf(ub(a.y, j)); } }
            asm volatile("" ::: "memory");
        }
    }
    __device__ __forceinline__ void operator()(const f32x4 (&acc)[2][2][4][2], const Unit& u, int wr, int wc, int fr, int fq) const {
        const int row0 = u.pm * BM + wr * 64 + fr, col0 = u.pn * BM + wc * 32 + 8 * fq;
        u32x2 ga[2][4][2];
#pragma unroll
        for (int ai = 0; ai < 2; ++ai)
#pragma unroll
            for (int m = 0; m < 4; ++m)
#pragma unroll
                for (int bj = 0; bj < 2; ++bj) ga[ai][m][bj] = *(const u32x2*)(Pgate + (size_t)(row0 + ai * HALF + m * 16) * GCOLS + DM + col0 + bj * HALF);
#pragma unroll
        for (int ai = 0; ai < 2; ++ai)
#pragma unroll
            for (int m = 0; m < 4; ++m) { const size_t row = (size_t)(row0 + ai * HALF + m * 16);
#pragma unroll
                for (int bj = 0; bj < 2; ++bj) { const int col = col0 + bj * HALF; const u32x2 g = ga[ai][m][bj]; constexpr float s = 1.f / 255.f;
                    const f32x4 a0 = acc[ai][bj][m][0], a1 = acc[ai][bj][m][1];
                    u32x4 w; w.x = cvt_pk_bf16(a0[0] * ub(g.x, 0) * s, a0[1] * ub(g.x, 1) * s); w.y = cvt_pk_bf16(a0[2] * ub(g.x, 2) * s, a0[3] * ub(g.x, 3) * s);
                    w.z = cvt_pk_bf16(a1[0] * ub(g.y, 0) * s, a1[1] * ub(g.y, 1) * s); w.w = cvt_pk_bf16(a1[2] * ub(g.y, 2) * s, a1[3] * ub(g.y, 3) * s);
                    EPI_ST0(u32x4, T + row * DM + col, w); } }
    }
};
struct EpiDelta {
    static constexpr bool PERM = true, HAS_MID = false;
    bf16_t* D; const float* mod; int scr = 0;
    __device__ __forceinline__ void operator()(const f32x4 (&acc)[2][2][4][2], const Unit& u, int wr, int wc, int fr, int fq) const {
        const int row0 = u.pm * BM + wr * 64 + fr, col0 = u.pn * BM + wc * 32 + 8 * fq;
        const int b = (u.pm * BM) / SEQ; const float* g1 = mod + (size_t)b * MODW + 2 * DM;
#ifdef SCR_PROBE
        if (scr) {
            bf16_t* base = D + (size_t)(u.pm * 4 + u.pn) * 65536 + (wr * 4 + wc) * 8192 + (fq * 16 + fr) * 8;
#pragma unroll
            for (int ai = 0; ai < 2; ++ai)
#pragma unroll
                for (int m = 0; m < 4; ++m)
#pragma unroll
                    for (int bj = 0; bj < 2; ++bj) { const f32x4 v0 = acc[ai][bj][m][0], v1 = acc[ai][bj][m][1];
                        u32x4 w; w.x = cvt_pk_bf16(v0[0], v0[1]); w.y = cvt_pk_bf16(v0[2], v0[3]); w.z = cvt_pk_bf16(v1[0], v1[1]); w.w = cvt_pk_bf16(v1[2], v1[3]);
                        *(u32x4*)(base + (ai * 8 + m * 2 + bj) * 512) = w; }
            return; }
#endif
        f32x4 gv[2][2];
#pragma unroll
        for (int bj = 0; bj < 2; ++bj)
#pragma unroll
            for (int n = 0; n < 2; ++n) gv[bj][n] = *(const f32x4*)(g1 + col0 + bj * HALF + 4 * n);
#pragma unroll
        for (int ai = 0; ai < 2; ++ai)
#pragma unroll
            for (int m = 0; m < 4; ++m) { bf16_t* rowp = D + (size_t)(row0 + ai * HALF + m * 16) * DM + col0;
#pragma unroll
                for (int bj = 0; bj < 2; ++bj) { const f32x4 v0 = acc[ai][bj][m][0] * gv[bj][0], v1 = acc[ai][bj][m][1] * gv[bj][1];
                    u32x4 w; w.x = cvt_pk_bf16(v0[0], v0[1]); w.y = cvt_pk_bf16(v0[2], v0[3]); w.z = cvt_pk_bf16(v1[0], v1[1]); w.w = cvt_pk_bf16(v1[2], v1[3]);
                    EPI_ST0(u32x4, rowp + bj * HALF, w); } }
    }
};
struct EpiHid {
    static constexpr bool PERM = true, HAS_MID = false;
    bf16_t* hid;
    __device__ __forceinline__ void operator()(const f32x4 (&acc)[2][2][4][2], const Unit& u, int wr, int wc, int fr, int fq) const {
        const int row0 = u.pm * BM + wr * 64 + fr, hc0 = u.pn * 128 + wc * 16 + 4 * fq;
#pragma unroll
        for (int ai = 0; ai < 2; ++ai)
#pragma unroll
            for (int m = 0; m < 4; ++m) { bf16_t* rowp = hid + (size_t)(row0 + ai * HALF + m * 16) * DE + hc0;
#pragma unroll
                for (int bj = 0; bj < 2; ++bj) { const f32x4 gt = acc[ai][bj][m][0], up = acc[ai][bj][m][1]; float h[4];
#pragma unroll
                    for (int j = 0; j < 4; ++j) h[j] = gt[j] * sigmoidf_(gt[j]) * up[j];
                    u32x2 w; w.x = cvt_pk_bf16(h[0], h[1]); w.y = cvt_pk_bf16(h[2], h[3]); EPI_ST0(u32x2, rowp + bj * 64, w); } }
    }
};
struct EpiY {
    static constexpr bool PERM = true, HAS_MID = false;
    bf16_t* Y; const float* slot_w;
    __device__ __forceinline__ void operator()(const f32x4 (&acc)[2][2][4][2], const Unit& u, int wr, int wc, int fr, int fq) const {
        const int row0 = u.pm * BM + wr * 64 + fr, col0 = u.pn * BM + wc * 32 + 8 * fq;
        float w[2][4];
#pragma unroll
        for (int ai = 0; ai < 2; ++ai)
#pragma unroll
            for (int m = 0; m < 4; ++m) { const int r = wr * 64 + fr + ai * HALF + m * 16; w[ai][m] = r < u.nvalid ? slot_w[u.sbase + r] : 0.f; }
#pragma unroll
        for (int ai = 0; ai < 2; ++ai)
#pragma unroll
            for (int m = 0; m < 4; ++m) { bf16_t* rowp = Y + (size_t)(row0 + ai * HALF + m * 16) * DM + col0; const float ws = w[ai][m];
#pragma unroll
                for (int bj = 0; bj < 2; ++bj) { const f32x4 v0 = acc[ai][bj][m][0] * ws, v1 = acc[ai][bj][m][1] * ws;
                    u32x4 o; o.x = cvt_pk_bf16(v0[0], v0[1]); o.y = cvt_pk_bf16(v0[2], v0[3]); o.z = cvt_pk_bf16(v1[0], v1[1]); o.w = cvt_pk_bf16(v1[2], v1[3]);
                    EPI_ST0(u32x4, rowp + bj * HALF, o); } }
    }
};
}
typedef GAS unsigned gu32;
#define RLX_AGENT __ATOMIC_RELAXED, __HIP_MEMORY_SCOPE_AGENT
#define LDS_WAIT() asm volatile("s_waitcnt lgkmcnt(0)" ::: "memory")
#define VM_WAIT() asm volatile("s_waitcnt vmcnt(0)" ::: "memory")
#define XB_TMO      128
#define XB_XCNT(j)  (256  + 64 * (j))
#define XB_XSUB(j)  (1280 + 64 * (j))
#define XB_XGEN(j)  (2304 + 64 * (j))
#define XB_TOP      3328
#define XB_TOPGEN   3392
#define XCD_BAR_WORDS 3456
#define XB_SPIN_CAP (1u << 18)

__device__ __forceinline__ unsigned xb_ld(unsigned* p)              { return __hip_atomic_load(p, __ATOMIC_RELAXED, __HIP_MEMORY_SCOPE_AGENT); }
__device__ __forceinline__ unsigned xb_add(unsigned* p, unsigned v) { return __hip_atomic_fetch_add(p, v, __ATOMIC_RELAXED, __HIP_MEMORY_SCOPE_AGENT); }
__device__ __forceinline__ unsigned xb_xcc_id() { return (unsigned)__builtin_amdgcn_s_getreg((3 << 11) | 20) & 0xFu; }
#define XB_SPIN(cond, bar) do { unsigned _sp = 0; while (cond) { __builtin_amdgcn_s_sleep(1); \
    if ((++_sp & 255u) == 0u) { if (xb_ld(&(bar)[XB_TMO])) break; if (_sp > XB_SPIN_CAP) { atomicAdd(&(bar)[XB_TMO], 1u); break; } } } } while (0)

struct XcdBarrier {
    unsigned* bar; unsigned x;
    volatile LAS unsigned* st;
};

__device__ __forceinline__ XcdBarrier xcd_barrier_post(unsigned* bar, volatile LAS unsigned* st) {
    XcdBarrier b; b.bar = bar; b.x = xb_xcc_id(); b.st = st;
    if (threadIdx.x == 0) (void)xb_add(&bar[XB_XCNT(b.x)], 1u);
    return b;
}
__device__ __forceinline__ void xcd_barrier_complete(unsigned* bar, unsigned x, unsigned& nloc, unsigned& nx) {
    const unsigned G = gridDim.x * gridDim.y * gridDim.z;
    unsigned sum, cnt, mine, sp = 0u;
    for (;;) {
        sum = 0u; cnt = 0u; mine = 0u;
#pragma unroll
        for (unsigned j = 0; j < 16; ++j) { const unsigned c = xb_ld(&bar[XB_XCNT(j)]); sum += c; cnt += (c > 0u) ? 1u : 0u; mine = (j == x) ? c : mine; }
        if (sum == G) break;
        __builtin_amdgcn_s_sleep(1);
        if ((++sp & 255u) == 0u) { if (xb_ld(&bar[XB_TMO])) break; if (sp > XB_SPIN_CAP) { atomicAdd(&bar[XB_TMO], 1u); break; } }
    }
    nloc = mine > 0u ? mine : 1u; nx = cnt > 0u ? cnt : 1u;
}

__device__ __forceinline__ void xcd_barrier(const XcdBarrier& b) {
    asm volatile("s_waitcnt vmcnt(0)" ::: "memory");
    __syncthreads();
    if (threadIdx.x == 0) {
        unsigned* bar = b.bar;
        __builtin_amdgcn_s_waitcnt(0);
        unsigned nloc = b.st[0], nx = b.st[1];
        if (nloc == 0u) { xcd_barrier_complete(bar, b.x, nloc, nx); b.st[0] = nloc; b.st[1] = nx; }
        const unsigned old = xb_add(&bar[XB_XSUB(b.x)], 1u);
        const unsigned gen = old / nloc;
        if (old + 1u == (gen + 1u) * nloc) {
            __builtin_amdgcn_fence(__ATOMIC_RELEASE, "agent");
            asm volatile("s_waitcnt vmcnt(0)" ::: "memory");
            const unsigned og = xb_add(&bar[XB_TOP], 1u);
            const unsigned tg = og / nx;
            if (og + 1u == (tg + 1u) * nx) xb_add(&bar[XB_TOPGEN], 1u);
            else XB_SPIN(xb_ld(&bar[XB_TOPGEN]) == tg, bar);
            __builtin_amdgcn_fence(__ATOMIC_ACQUIRE, "agent");
            xb_add(&bar[XB_XGEN(b.x)], 1u);
            asm volatile("s_waitcnt vmcnt(0)" ::: "memory");
        } else {
            XB_SPIN(xb_ld(&bar[XB_XGEN(b.x)]) == gen, bar);
            __builtin_amdgcn_fence(__ATOMIC_ACQUIRE, "agent");
            asm volatile("s_waitcnt vmcnt(0)" ::: "memory");
        }
    }
    __syncthreads();
}

constexpr int NWAVES = 8;
constexpr size_t MiB = 1u << 20, KiB = 1u << 10;
constexpr size_t WS_CTL = 0, CTL_ZERO_BYTES = 2 * MiB;
constexpr size_t WS_MOD = 1 * MiB;
constexpr size_t WS_WIN = 2 * MiB;
constexpr size_t WS_WBR = 12 * MiB + 512 * KiB, WS_WBA = 13 * MiB + 512 * KiB, WS_WOUT = 14 * MiB + 512 * KiB;
constexpr size_t WS_WUP = 16 * MiB + 512 * KiB, WS_AUP = WS_WUP + 64 * KiB, WS_GUP = WS_WUP + 128 * KiB;
constexpr size_t WS_WRH = 16 * MiB + 768 * KiB, WS_WRL = WS_WRH + 128 * KiB;
constexpr size_t WS_CB = 17 * MiB, WS_GAM2 = 17 * MiB + 64 * KiB;
constexpr size_t WS_PRW = 18 * MiB, WS_PATT = 130 * MiB, WS_PGATE = 226 * MiB;
constexpr size_t WS_WGU = 130 * MiB, WS_WD = 290 * MiB;
constexpr size_t WS_T = 18 * MiB;
constexpr size_t WS_HID = 18 * MiB, WS_DELTA = 226 * MiB, WS_H2 = 354 * MiB;
constexpr size_t WS_SLOTTOK = 98 * MiB, WS_SLOTW = 106 * MiB, WS_TOKLIST = 114 * MiB,
    WS_TOKPOS = WS_TOKLIST + 256 * KiB, WS_TOKW = WS_TOKLIST + 512 * KiB;
constexpr size_t WS_QE = 354 * MiB, WS_YLOC = 386 * MiB, WS_PC = 418 * MiB, WS_SLOC = 450 * MiB;
constexpr size_t WS_YB = 322 * MiB;
constexpr size_t WS_END = 512 * MiB;
constexpr size_t DO_H = 0, DO_G = 0, DO_SC = 32 * MiB, DO_YRA = 64 * MiB;
constexpr int NSLOT_MAX = 2 * NTOK + NLIST * 256;
constexpr int CW_TMO = 0, CW_BAR = 4096, CW_CNT = 16384;
constexpr int LDS_BYTES = 163840, RING_BYTES = 131072;
constexpr int LDSCTL_OFF = LDS_BYTES - 2048, MISC_OFF = LDSCTL_OFF;
constexpr int TOFF_OFF = LDSCTL_OFF + 256, LCNT_OFF = TOFF_OFF + 264, TILE_L_OFF = LCNT_OFF + 256;

#define LBAR() do { asm volatile("s_waitcnt lgkmcnt(0)" ::: "memory"); __builtin_amdgcn_s_barrier(); asm volatile("" ::: "memory"); } while (0)
struct Frame {
    LAS unsigned char* lds; volatile LAS unsigned* MISC; gu32* ctl;
    int tid, lane, wave, vcu, G;
};
__device__ __forceinline__ float wave_sum(float v) {
#pragma unroll
    for (int o = 1; o < 64; o <<= 1) v += __shfl_xor(v, o);
    return v;
}
__device__ __forceinline__ float dpp_f(float x, const int ctrl_sel) {
    const int xi = __builtin_bit_cast(int, x); int r;
    if (ctrl_sel == 0) r = __builtin_amdgcn_update_dpp(0, xi, 0xB1, 0xf, 0xf, true);
    else if (ctrl_sel == 1) r = __builtin_amdgcn_update_dpp(0, xi, 0x4E, 0xf, 0xf, true);
    else r = __builtin_amdgcn_update_dpp(0, xi, 0x141, 0xf, 0xf, true);
    return __builtin_bit_cast(float, r);
}
__device__ __forceinline__ float red8(float x) { x += dpp_f(x, 0); x += dpp_f(x, 1); x += dpp_f(x, 2); return x; }

__device__ __forceinline__ void phase_mod(Frame& F, const float* c, const float* w_ada, const float* b_ada, float* mod) {
    const int gw = F.vcu * NWAVES + F.wave, NGW = F.G * NWAVES;
    for (int task = gw; task < 96 * 16; task += NGW) {
        const int nc = task % 96, ks = task / 96, n = nc * 64 + F.lane, k0 = ks * 64;
        float acc[16];
#pragma unroll
        for (int b = 0; b < 16; ++b) acc[b] = 0.f;
        LAS float* sl = (LAS float*)(F.lds) + F.wave * 1024;
#pragma unroll
        for (int j = 0; j < 16; ++j) { const float cv = c[(F.lane & 15) * DM + k0 + (F.lane >> 4) + 4 * j]; sl[((F.lane >> 4) + 4 * j) * 16 + (F.lane & 15)] = cv * sigmoidf_(cv); }
        LDS_WAIT(); asm volatile("" ::: "memory");
#pragma unroll 4
        for (int kk = 0; kk < 64; ++kk) { const float w = __builtin_nontemporal_load(w_ada + (size_t)(k0 + kk) * MODW + n);
            const f32x4 s0 = *(const LAS f32x4*)(sl + kk * 16), s1 = *(const LAS f32x4*)(sl + kk * 16 + 4), s2 = *(const LAS f32x4*)(sl + kk * 16 + 8), s3 = *(const LAS f32x4*)(sl + kk * 16 + 12);
            acc[0] += s0.x * w; acc[1] += s0.y * w; acc[2] += s0.z * w; acc[3] += s0.w * w; acc[4] += s1.x * w; acc[5] += s1.y * w; acc[6] += s1.z * w; acc[7] += s1.w * w;
            acc[8] += s2.x * w; acc[9] += s2.y * w; acc[10] += s2.z * w; acc[11] += s2.w * w; acc[12] += s3.x * w; acc[13] += s3.y * w; acc[14] += s3.z * w; acc[15] += s3.w * w; }
        LDS_WAIT(); asm volatile("" ::: "memory");
#pragma unroll
        for (int b = 0; b < 16; ++b) { const float v = acc[b] + (ks == 0 ? b_ada[n] : 0.f); atomicAdd(mod + (size_t)b * MODW + n, v); }
    }
}

template <int MODE, bool NTS = false> __device__ __forceinline__ void transpose_item(const float* W, int K, int N, bf16_t* WT, int row_off, int item, int lane, int ldt = 0, int koff = 0) {
    if (ldt == 0) ldt = K;
    const int nblk = N / 32, kb = item / nblk, nb = item % nblk, k0 = 64 * kb + 8 * (lane >> 3), n0 = 32 * nb + 4 * (lane & 7);
    f32x4 v[8];
#pragma unroll
    for (int i = 0; i < 8; ++i) v[i] = __builtin_nontemporal_load((const f32x4*)(W + (size_t)(k0 + i) * N + n0));
#pragma unroll
    for (int j = 0; j < 4; ++j) { const int ng = n0 + j; const int nr = MODE == 0 ? row_off + ng : (MODE == 1 ? 8 * (ng >> 2) + (ng & 3) : 8 * (ng >> 2) + 4 + (ng & 3));
        u32x4 o; o.x = cvt_pk_bf16(v[0][j], v[1][j]); o.y = cvt_pk_bf16(v[2][j], v[3][j]); o.z = cvt_pk_bf16(v[4][j], v[5][j]); o.w = cvt_pk_bf16(v[6][j], v[7][j]);
        if (MODE == 0 && !NTS) *(GAS u32x4*)(WT + (size_t)nr * ldt + koff + k0) = o; else __builtin_nontemporal_store(o, (GAS u32x4*)(WT + (size_t)nr * ldt + koff + k0)); }
}

struct Args { const float* in[31]; float* out; unsigned char* ws; int ph_lo, ph_hi, scr; };
struct Ptrs { const float* in[31]; float* out; unsigned char* ws; };

__device__ __forceinline__ void phase_prep(Frame& F, const Ptrs& P) {
    const int gw = F.vcu * NWAVES + F.wave, NGW = F.G * NWAVES;
    const float* mod = (const float*)(P.ws + WS_MOD);
    bf16_t* Win_t = (bf16_t*)(P.ws + WS_WIN); bf16_t* Wbr_t = (bf16_t*)(P.ws + WS_WBR); bf16_t* Wba_t = (bf16_t*)(P.ws + WS_WBA); bf16_t* Wout_t = (bf16_t*)(P.ws + WS_WOUT);
    bf16_t* wup_t = (bf16_t*)(P.ws + WS_WUP); bf16_t* aup_t = (bf16_t*)(P.ws + WS_AUP); bf16_t* gup_t = (bf16_t*)(P.ws + WS_GUP);
    constexpr int I_IN = 16 * (INCOLS / 32), I_BR = 8 * 32, I_OUT = 16 * 32, I_UP = 16, I_GUP = 2 * 16;
    constexpr int NITEMS = I_IN + 2 * I_BR + I_OUT + 2 * I_UP + I_GUP;
    for (int it = gw; it < NITEMS; it += NGW) {
        int r = it;
        if (r < I_IN) { transpose_item<0>(P.in[5], DM, INCOLS, Win_t, 0, r, F.lane); continue; } r -= I_IN;
        if (r < I_BR) { transpose_item<0>(P.in[20], 512, DM, Wbr_t, 0, r, F.lane, DM, 0); continue; } r -= I_BR;
        if (r < I_BR) { transpose_item<0>(P.in[21], 512, DM, Wbr_t, 0, r, F.lane, DM, 512); continue; } r -= I_BR;
        if (r < I_OUT) { transpose_item<0>(P.in[22], DM, DM, Wout_t, 0, r, F.lane); continue; } r -= I_OUT;
        if (r < I_UP) { transpose_item<0>(P.in[8], 64, 512, wup_t, 0, r, F.lane); continue; } r -= I_UP;
        if (r < I_UP) { transpose_item<0>(P.in[10], 64, 512, aup_t, 0, r, F.lane); continue; } r -= I_UP;
        transpose_item<0>(P.in[11], 128, 512, gup_t, 0, r, F.lane);
    }
    { bf16_t* wrh = (bf16_t*)(P.ws + WS_WRH); bf16_t* wrl = (bf16_t*)(P.ws + WS_WRL);
      for (int idx = (F.vcu * NWAVES * 64 + F.tid); idx < 64 * DM; idx += F.G * NWAVES * 64) { const int o = idx / DM, k = idx % DM;
          const float w = o < 4 ? P.in[24][k * 4 + o] : (o < 36 ? P.in[26][k * 32 + (o - 4)] : 0.f);
          const unsigned hi = cvt_pk_bf16(w, 0.f) & 0xffffu; const float rem = w - __uint_as_float(hi << 16); const unsigned lo = cvt_pk_bf16(rem, 0.f) & 0xffffu;
          wrh[idx] = (bf16_t)hi; wrl[idx] = (bf16_t)lo; } }
    { float* gam2 = (float*)(P.ws + WS_GAM2);
      for (int idx = (F.vcu * NWAVES * 64 + F.tid); idx < NB * DM; idx += F.G * NWAVES * 64) { const int b = idx / DM, k = idx % DM; gam2[idx] = P.in[23][k] * (1.f + mod[(size_t)b * MODW + 4 * DM + k]); } }
    { float* cb = (float*)(P.ws + WS_CB);
      for (int t = gw; t < NB * 36; t += NGW) { const int b = t / 36, o = t % 36; float s = 0.f;
          for (int k = F.lane; k < DM; k += 64) { const float w = o < 4 ? P.in[24][k * 4 + o] : P.in[26][k * 32 + (o - 4)]; s += mod[(size_t)b * MODW + 3 * DM + k] * w; }
          s = wave_sum(s); if (F.lane == 0) cb[b * 64 + o] = s + (o < 4 ? P.in[25][o] : P.in[27][o - 4]); } }
    bf16_t* H = (bf16_t*)((unsigned char*)P.out + DO_H);
    for (int m0 = gw * 4; m0 < NTOK; m0 += NGW * 4) {
        f32x4 v[4][4];
#pragma unroll
        for (int r = 0; r < 4; ++r) { const GAS f32x4* xr = (const GAS f32x4*)(P.in[0] + (size_t)(m0 + r) * DM) + F.lane;
#pragma unroll
            for (int j = 0; j < 4; ++j) v[r][j] = __builtin_nontemporal_load(xr + 64 * j); }
        const int b = m0 / SEQ; const float* sh = mod + (size_t)b * MODW; const float* sc = sh + DM;
        f32x4 gs[4], hs[4];
#pragma unroll
        for (int j = 0; j < 4; ++j) { const int k = 4 * F.lane + 256 * j; const f32x4 g = *(const f32x4*)(P.in[4] + k), s1 = *(const f32x4*)(sc + k); gs[j] = g * (s1 + 1.f); hs[j] = *(const f32x4*)(sh + k); }
#pragma unroll
        for (int r = 0; r < 4; ++r) { float s = 0.f;
#pragma unroll
            for (int j = 0; j < 4; ++j) s += (v[r][j].x * v[r][j].x + v[r][j].y * v[r][j].y) + (v[r][j].z * v[r][j].z + v[r][j].w * v[r][j].w);
            const float rinv = 1.f / sqrtf(wave_sum(s) * (1.f / DM) + 1e-6f);
            GAS u32x2* o8 = (GAS u32x2*)(H + (size_t)(m0 + r) * DM) + F.lane;
#pragma unroll
            for (int j = 0; j < 4; ++j) { const f32x4 hv = v[r][j] * rinv * gs[j] + hs[j]; u32x2 w; w.x = cvt_pk_bf16(hv.x, hv.y); w.y = cvt_pk_bf16(hv.z, hv.w); o8[64 * j] = w; } }
    }
}
__device__ __forceinline__ void expert_convert(Frame& F, const Ptrs& P, int wv, int nwv, int it_lo, int it_hi) {
    bf16_t* Wgu = (bf16_t*)(P.ws + WS_WGU);
    constexpr int I_G = 16 * 16;
    for (int it = it_lo + wv; it < it_hi; it += nwv) {
        const int e = it / (2 * I_G), r = it % (2 * I_G);
        if (r < I_G) transpose_item<1>(P.in[28] + (size_t)e * DM * DE, DM, DE, Wgu + (size_t)e * DM * DM, 0, r, F.lane);
        else transpose_item<2>(P.in[29] + (size_t)e * DM * DE, DM, DE, Wgu + (size_t)e * DM * DM, 0, r - I_G, F.lane);
    }
}
__device__ __forceinline__ void expert_convert_down(Frame& F, const Ptrs& P, int wv, int nwv) {
    bf16_t* Wd = (bf16_t*)(P.ws + WS_WD);
    for (int it = wv; it < NE * 256; it += nwv) { const int e = it >> 8, r = it & 255; transpose_item<0, true>(P.in[30] + (size_t)e * DE * DM, DE, DM, Wd + (size_t)e * DM * DE, 0, r, F.lane); }
}
namespace att {
constexpr int SLOT = 16384, NSL = 5, L_WS = NSL * SLOT, L_OST = L_WS + 8 * 256, L_BIAS = L_OST + 8 * 4096, L_END = L_BIAS + 1280;
__device__ __forceinline__ int crow(int r, int hi) { return (r & 3) + 8 * (r >> 2) + 4 * hi; }
__device__ __forceinline__ float max3f(float a, float b, float c) { return fmaxf(fmaxf(a, b), c); }
__device__ __forceinline__ s16x4 vtr(const LAS char* p) { return __builtin_bit_cast(s16x4, __builtin_amdgcn_ds_read_tr16_b64_v4i16((LAS s16x4*)p)); }

__device__ __forceinline__ void attn_unit(Frame& F, const Ptrs& P, int b, int h, int qb) {
    const int tid = F.tid, lane = F.lane, wid = F.wave, r32 = lane & 31, hi = lane >> 5;
    const bf16_t* Patt = (const bf16_t*)(P.ws + WS_PATT);
    bf16_t* Ya = (bf16_t*)((unsigned char*)P.out + DO_YRA) + 512;
    LAS char* lds = (LAS char*)F.lds;
    LAS float* wsf = (LAS float*)(lds + L_WS) + wid * 64;
    LAS float* biasL = (LAS float*)(lds + L_BIAS);
    const int cq = wid >> 1, ci = qb * 4 + cq, kc0 = qb * 4 - 8;
    const size_t rowbase = (size_t)b * SEQ;
    for (int i = tid; i < 257; i += 512) biasL[i] = P.in[19][h * 257 + i] * LOG2E;
    const int srow = tid >> 3, sc8 = tid & 7;
    f32x4 kg0 = *(const f32x4*)(P.in[18] + 8 * sc8), kg1 = *(const f32x4*)(P.in[18] + 8 * sc8 + 4);
    const int kdst = sc8 * 1024 + srow * 16, vdst = 8192 + (sc8 >> 2) * 4096 + (srow >> 4) * 1024 + (srow & 15) * 64 + (sc8 & 3) * 16;
    auto ld_k = [&](int j) -> u32x4 { return *(const u32x4*)(Patt + (rowbase + (size_t)(kc0 + j) * 64 + srow) * ACOLS + 512 + h * 64 + 8 * sc8); };
    auto ld_v = [&](int j) -> u32x4 { return *(const u32x4*)(Patt + (rowbase + (size_t)(kc0 + j) * 64 + srow) * ACOLS + 1024 + h * 64 + 8 * sc8); };
    auto st_kv = [&](int j, u32x4 kw, u32x4 vw) {
        float kf[8] = {bf_lo(kw.x), bf_hi(kw.x), bf_lo(kw.y), bf_hi(kw.y), bf_lo(kw.z), bf_hi(kw.z), bf_lo(kw.w), bf_hi(kw.w)};
        float ss = 0.f;
#pragma unroll
        for (int i = 0; i < 8; ++i) ss += kf[i] * kf[i];
        ss = red8(ss); const float rk = 1.f / sqrtf(ss * (1.f / 64.f) + 1e-6f);
        u32x4 o; o.x = cvt_pk_bf16(kf[0] * rk * kg0.x, kf[1] * rk * kg0.y); o.y = cvt_pk_bf16(kf[2] * rk * kg0.z, kf[3] * rk * kg0.w);
        o.z = cvt_pk_bf16(kf[4] * rk * kg1.x, kf[5] * rk * kg1.y); o.w = cvt_pk_bf16(kf[6] * rk * kg1.z, kf[7] * rk * kg1.w);
        LAS char* sl = lds + (j % NSL) * SLOT;
        *(LAS u32x4*)(sl + kdst) = o; *(LAS u32x4*)(sl + vdst) = vw; };
    { u32x4 kws[4], vws[4];
#pragma unroll
      for (int j = 0; j < 4; ++j) if (kc0 + j >= 0) { kws[j] = ld_k(j); vws[j] = ld_v(j); }
#pragma unroll
      for (int j = 0; j < 4; ++j) if (kc0 + j >= 0) st_kv(j, kws[j], vws[j]); }
    const size_t qrow = rowbase + (size_t)ci * 64 + (wid & 1) * 32 + r32;
    bf16x8 qr[4];
    { float qf[4][8]; float ss = 0.f;
#pragma unroll
      for (int d0 = 0; d0 < 4; ++d0) { const u32x4 w = *(const u32x4*)(Patt + qrow * ACOLS + h * 64 + d0 * 16 + hi * 8);
          qf[d0][0] = bf_lo(w.x); qf[d0][1] = bf_hi(w.x); qf[d0][2] = bf_lo(w.y); qf[d0][3] = bf_hi(w.y); qf[d0][4] = bf_lo(w.z); qf[d0][5] = bf_hi(w.z); qf[d0][6] = bf_lo(w.w); qf[d0][7] = bf_hi(w.w);
#pragma unroll
          for (int i = 0; i < 8; ++i) ss += qf[d0][i] * qf[d0][i]; }
      ss += __shfl_xor(ss, 32);
      const float rq = (0.125f * LOG2E) / sqrtf(ss * (1.f / 64.f) + 1e-6f);
#pragma unroll
      for (int d0 = 0; d0 < 4; ++d0) { const f32x4 g0 = *(const f32x4*)(P.in[17] + d0 * 16 + hi * 8), g1 = *(const f32x4*)(P.in[17] + d0 * 16 + hi * 8 + 4);
          u32x4 o; o.x = cvt_pk_bf16(qf[d0][0] * rq * g0.x, qf[d0][1] * rq * g0.y); o.y = cvt_pk_bf16(qf[d0][2] * rq * g0.z, qf[d0][3] * rq * g0.w);
          o.z = cvt_pk_bf16(qf[d0][4] * rq * g1.x, qf[d0][5] * rq * g1.y); o.w = cvt_pk_bf16(qf[d0][6] * rq * g1.z, qf[d0][7] * rq * g1.w);
          qr[d0] = __builtin_bit_cast(bf16x8, o); } }
    u32x4 kA, vA; if (kc0 + 4 >= 0) { kA = ld_k(4); vA = ld_v(4); }
    float mrun = 0.f, lrun = 0.f; f32x16 o0 = {}, o1 = {};
    const int qloc = (wid & 1) * 32 + r32;
    __syncthreads();
#pragma unroll 1
    for (int s = 0; s < 9; ++s) {
        const int jn = s + 4; const bool ld = (jn <= 11) && (kc0 + jn >= 0);
        const bool ldn = (jn + 1 <= 11) && (kc0 + jn + 1 >= 0); u32x4 kB, vB; if (ldn) { kB = ld_k(jn + 1); vB = ld_v(jn + 1); }
        const int j = cq + s;
        if (kc0 + j >= 0) {
            const LAS char* sl = lds + (j % NSL) * SLOT;
            f32x16 p0, p1;
            if (s <= 5) { const float c0 = biasL[0] - mrun;
#pragma unroll
                for (int r = 0; r < 16; ++r) { p0[r] = c0; p1[r] = c0; } }
            else { const int base = 64 * (s - 8) - qloc + 128;
#pragma unroll
                for (int r = 0; r < 16; ++r) { int i0 = base + crow(r, hi), i1 = i0 + 32; i0 = i0 < 0 ? 0 : (i0 > 256 ? 256 : i0); i1 = i1 < 0 ? 0 : (i1 > 256 ? 256 : i1); p0[r] = biasL[i0] - mrun; p1[r] = biasL[i1] - mrun; } }
            const LAS char* kb = sl + hi * 1024 + r32 * 16;
#pragma unroll
            for (int d0 = 0; d0 < 4; ++d0) { const bf16x8 b0 = *(const LAS bf16x8*)(kb + d0 * 2048), b1 = *(const LAS bf16x8*)(kb + d0 * 2048 + 512);
                p0 = __builtin_amdgcn_mfma_f32_32x32x16_bf16(b0, qr[d0], p0, 0, 0, 0); p1 = __builtin_amdgcn_mfma_f32_32x32x16_bf16(b1, qr[d0], p1, 0, 0, 0); }
            float a = max3f(p0[0], p0[1], p1[0]), bm = max3f(p0[2], p0[3], p1[1]); a = max3f(a, p1[2], p1[3]);
#pragma unroll
            for (int r = 4; r < 16; r += 4) { a = max3f(a, p0[r], p0[r + 1]); bm = max3f(bm, p0[r + 2], p0[r + 3]); a = max3f(a, p1[r], p1[r + 1]); bm = max3f(bm, p1[r + 2], p1[r + 3]); }
            float rm = fmaxf(a, bm); rm = fmaxf(rm, __shfl_xor(rm, 32));
            if (__any(rm > 8.f)) {
                const float dl = fmaxf(rm, 0.f), f = __builtin_amdgcn_exp2f(-dl); mrun += dl; lrun *= f;
#pragma unroll
                for (int r = 0; r < 16; ++r) { p0[r] -= dl; p1[r] -= dl; }
                if (hi == 0) wsf[r32] = f;
                LDS_WAIT(); asm volatile("" ::: "memory");
#pragma unroll
                for (int r = 0; r < 16; ++r) { const float fr_ = wsf[crow(r, hi)]; o0[r] *= fr_; o1[r] *= fr_; }
            }
            float sacc = 0.f;
#pragma unroll
            for (int r = 0; r < 16; ++r) { p0[r] = __builtin_amdgcn_exp2f(p0[r]); p1[r] = __builtin_amdgcn_exp2f(p1[r]); sacc += p0[r] + p1[r]; }
            lrun += sacc;
            u32x4 pw0, pw1, pw2, pw3;
            pw0 = (u32x4){cvt_pk_bf16(p0[0], p0[1]), cvt_pk_bf16(p0[2], p0[3]), cvt_pk_bf16(p0[4], p0[5]), cvt_pk_bf16(p0[6], p0[7])};
            pw1 = (u32x4){cvt_pk_bf16(p0[8], p0[9]), cvt_pk_bf16(p0[10], p0[11]), cvt_pk_bf16(p0[12], p0[13]), cvt_pk_bf16(p0[14], p0[15])};
            pw2 = (u32x4){cvt_pk_bf16(p1[0], p1[1]), cvt_pk_bf16(p1[2], p1[3]), cvt_pk_bf16(p1[4], p1[5]), cvt_pk_bf16(p1[6], p1[7])};
            pw3 = (u32x4){cvt_pk_bf16(p1[8], p1[9]), cvt_pk_bf16(p1[10], p1[11]), cvt_pk_bf16(p1[12], p1[13]), cvt_pk_bf16(p1[14], p1[15])};
            const LAS char* vp = sl + 8192 + ((lane >> 4) & 1) * 32 + (lane & 3) * 8 + (4 * hi + ((lane & 15) >> 2)) * 64;
            const bf16x8 pa[4] = {__builtin_bit_cast(bf16x8, pw0), __builtin_bit_cast(bf16x8, pw1), __builtin_bit_cast(bf16x8, pw2), __builtin_bit_cast(bf16x8, pw3)};
#pragma unroll
            for (int ks = 0; ks < 4; ++ks) {
                const s16x4 l0 = vtr(vp + ks * 1024), h0 = vtr(vp + ks * 1024 + 512), l1 = vtr(vp + 4096 + ks * 1024), h1 = vtr(vp + 4096 + ks * 1024 + 512);
                const bf16x8 v0 = (bf16x8){l0[0], l0[1], l0[2], l0[3], h0[0], h0[1], h0[2], h0[3]}, v1 = (bf16x8){l1[0], l1[1], l1[2], l1[3], h1[0], h1[1], h1[2], h1[3]};
                o0 = __builtin_amdgcn_mfma_f32_32x32x16_bf16(pa[ks], v0, o0, 0, 0, 0); o1 = __builtin_amdgcn_mfma_f32_32x32x16_bf16(pa[ks], v1, o1, 0, 0, 0); }
        }
        if (ld) st_kv(jn, kA, vA);
        LBAR();
        kA = kB; vA = vB;
    }
    lrun += __shfl_xor(lrun, 32);
    if (hi == 0) wsf[32 + r32] = lrun;
    LDS_WAIT(); asm volatile("" ::: "memory");
    LAS bf16_t* stg = (LAS bf16_t*)(lds + L_OST) + wid * 2048;
#pragma unroll
    for (int r = 0; r < 16; ++r) { const int orow = crow(r, hi); const float rl = __builtin_amdgcn_rcpf(wsf[32 + orow]);
        stg[orow * 64 + r32] = (bf16_t)(cvt_pk_bf16(o0[r] * rl, 0.f) & 0xffffu); stg[orow * 64 + 32 + r32] = (bf16_t)(cvt_pk_bf16(o1[r] * rl, 0.f) & 0xffffu); }
    LDS_WAIT(); asm volatile("" ::: "memory");
    bf16_t* Ow = Ya + (rowbase + (size_t)ci * 64 + (wid & 1) * 32) * 1024 + h * 64;
#pragma unroll
    for (int i = 0; i < 4; ++i) { const int row = i * 8 + (lane >> 3), ch = lane & 7; const u32x4 v = *(const LAS u32x4*)(stg + row * 64 + ch * 8); *(u32x4*)(Ow + (size_t)row * 1024 + ch * 8) = v; }
    __syncthreads();
}
}

#ifndef TIME_PHASE
#define TIME_PHASE -1
#endif
#define PROF(k) do { if (TIME_PHASE >= 20 && blockIdx.x == 0 && F.tid == 0) { const unsigned now_ = (unsigned)__builtin_amdgcn_s_memrealtime(); F.MISC[16 + (k)] += now_ - F.MISC[15]; F.MISC[15] = now_; } } while (0)
namespace rc {
constexpr int LDB = 72, MB = 64 * LDB * 2;
constexpr int FLD = 68, FB = 64 * FLD * 4;
constexpr int L_AT = 0, L_BH = MB, L_BT = 2 * MB, L_KT = 3 * MB, L_RT = 4 * MB, L_KH = 5 * MB, L_V = 6 * MB;
constexpr int L_TWD = 0, L_AD = 9216, L_SGD = 18432;
constexpr int RB = 8 * MB;
constexpr int L_WL = RB, L_AL = RB + FB, L_GL = RB + 2 * FB, L_SEG = RB + 3 * FB;
constexpr int L_NQ0 = RB, L_NQ1 = RB + MB, L_NT0 = RB + 2 * MB, L_NT1 = RB + 3 * MB, L_TQ0 = RB + 4 * MB, L_TQ1 = RB + 5 * MB, L_NKT = RB + 6 * MB, L_NRB = RB + 7 * MB;
constexpr int L_GLD = RB + 8 * MB;
constexpr int L_W1T = L_NQ0, L_W2T = L_NT0, L_WY = L_AT, L_KC = L_BT;
constexpr int L_TAB = L_GLD + 256;
constexpr int T_MUL = 0, T_MUR = 256, T_PAR = 448, T_N = 832;
static_assert(L_SEG + 2048 <= L_GLD && L_TAB + T_N * 4 <= LDSCTL_OFF, "rwkv chunk LDS");

__device__ __forceinline__ void unpack8(const u32x4 w, float* f) { f[0] = bf_lo(w.x); f[1] = bf_hi(w.x); f[2] = bf_lo(w.y); f[3] = bf_hi(w.y); f[4] = bf_lo(w.z); f[5] = bf_hi(w.z); f[6] = bf_lo(w.w); f[7] = bf_hi(w.w); }
__device__ __forceinline__ f32x16 mm64(f32x16 acc, const LAS char* Arows, const LAS char* Bcols, int lane) {
    const int o = ((lane & 31) * LDB + 8 * (lane >> 5)) * 2;
#pragma unroll
    for (int ks = 0; ks < 4; ++ks) { const bf16x8 a = *(const LAS bf16x8*)(Arows + o + 32 * ks), b = *(const LAS bf16x8*)(Bcols + o + 32 * ks); acc = __builtin_amdgcn_mfma_f32_32x32x16_bf16(a, b, acc, 0, 0, 0); }
    return acc;
}
__device__ __forceinline__ s16x4 trrd(const LAS char* p) { return __builtin_bit_cast(s16x4, __builtin_amdgcn_ds_read_tr16_b64_v4i16((LAS s16x4*)p)); }
__device__ __forceinline__ int tr_off(int lane) { return ((8 * (lane >> 5) + ((lane & 15) >> 2)) * LDB + 16 * ((lane >> 4) & 1) + 4 * (lane & 3)) * 2; }
__device__ __forceinline__ bf16x8 frag_tr(const LAS char* Xb, int ks) {
    const s16x4 lo = trrd(Xb + (16 * ks) * LDB * 2), hi = trrd(Xb + (16 * ks + 4) * LDB * 2);
    return (bf16x8){lo[0], lo[1], lo[2], lo[3], hi[0], hi[1], hi[2], hi[3]};
}
__device__ __forceinline__ f32x16 mm64_btr(f32x16 acc, const LAS char* Arows, const LAS char* X, int nb, int lane) {
    const int o = ((lane & 31) * LDB + 8 * (lane >> 5)) * 2; const LAS char* xb = X + 64 * nb + tr_off(lane);
#pragma unroll
    for (int ks = 0; ks < 4; ++ks) { const bf16x8 a = *(const LAS bf16x8*)(Arows + o + 32 * ks), b = frag_tr(xb, ks); acc = __builtin_amdgcn_mfma_f32_32x32x16_bf16(a, b, acc, 0, 0, 0); }
    return acc;
}
__device__ __forceinline__ f32x16 mm64_atr(f32x16 acc, const LAS char* X, int mb, const LAS char* Bcols, int lane) {
    const int o = ((lane & 31) * LDB + 8 * (lane >> 5)) * 2; const LAS char* xb = X + 64 * mb + tr_off(lane);
#pragma unroll
    for (int ks = 0; ks < 4; ++ks) { const bf16x8 a = frag_tr(xb, ks), b = *(const LAS bf16x8*)(Bcols + o + 32 * ks); acc = __builtin_amdgcn_mfma_f32_32x32x16_bf16(a, b, acc, 0, 0, 0); }
    return acc;
}
__device__ __forceinline__ void store_T(const f32x16& d, LAS char* dst, int mb, int nb, int lane) {
    LAS char* p = dst + ((32 * nb + (lane & 31)) * LDB + 32 * mb + 4 * (lane >> 5)) * 2;
#pragma unroll
    for (int g = 0; g < 4; ++g) { u32x2 w; w.x = cvt_pk_bf16(d[4 * g], d[4 * g + 1]); w.y = cvt_pk_bf16(d[4 * g + 2], d[4 * g + 3]); *(LAS u32x2*)(p + 16 * g) = w; }
}
__device__ __forceinline__ void store_T_g(const f32x16& d, bf16_t* dst, int mb, int nb, int lane) {
    bf16_t* p = dst + (32 * nb + (lane & 31)) * 64 + 32 * mb + 4 * (lane >> 5);
#pragma unroll
    for (int g = 0; g < 4; ++g) { u32x2 w; w.x = cvt_pk_bf16(d[4 * g], d[4 * g + 1]); w.y = cvt_pk_bf16(d[4 * g + 2], d[4 * g + 3]); *(u32x2*)(p + 8 * g) = w; }
}
#define RC_M(r) (32 * mb + 8 * ((r) >> 2) + 4 * hi + ((r) & 3))

struct Raw { u32x4 lc[4], lp[4], rc[3], rp[3]; };
__device__ __forceinline__ void load_raw(Raw& R, const bf16_t* Prw, int u, int t, int cg) {
    const int b = u >> 8, h = (u >> 5) & 7, c = u & 31;
    const size_t row = (size_t)b * SEQ + 64 * c + t; const bool hasprev = (c > 0) || (t > 0);
    const bf16_t* pc = Prw + row * RCOLS; const bf16_t* pp = pc - RCOLS; const int lc0 = 1536 + 32 * cg, hd = h * 64 + 8 * cg;
#pragma unroll
    for (int q = 0; q < 4; ++q) { R.lc[q] = *(const u32x4*)(pc + lc0 + 8 * q); R.lp[q] = hasprev ? *(const u32x4*)(pp + lc0 + 8 * q) : (u32x4){0u, 0u, 0u, 0u}; }
#pragma unroll
    for (int w = 0; w < 3; ++w) { R.rc[w] = *(const u32x4*)(pc + w * 512 + hd); R.rp[w] = hasprev ? *(const u32x4*)(pp + w * 512 + hd) : (u32x4){0u, 0u, 0u, 0u}; }
}
__device__ __forceinline__ void chunk_phase(Frame& F, const Ptrs& P) {
  const bf16_t* Prw = (const bf16_t*)(P.ws + WS_PRW);
  int htab = -1; bf16x8 wA[4]; Raw raw;
  if (TIME_PHASE >= 20 && blockIdx.x == 0 && F.tid == 0) F.MISC[15] = (unsigned)__builtin_amdgcn_s_memrealtime();
  if ((int)blockIdx.x < NB * 8 * 32) load_raw(raw, Prw, (int)blockIdx.x, F.tid >> 3, F.tid & 7);
#pragma unroll 1
  for (int u_ = (int)blockIdx.x; u_ < NB * 8 * 32; u_ += F.G) {
    int tid = F.tid, wid = F.wave; asm volatile("" : "+v"(tid), "+s"(wid));
    const int b = u_ >> 8, h = (u_ >> 5) & 7, c = u_ & 31;
    const int lane = tid & 63, t = tid >> 3, cg = tid & 7, r32 = lane & 31, hi = lane >> 5;
    LAS char* lds = (LAS char*)F.lds;
    const size_t u = (size_t)((b * 8 + h) * 32 + c);
    bf16_t* gQe = (bf16_t*)(P.ws + WS_QE) + u * 4096; bf16_t* gYl = (bf16_t*)(P.ws + WS_YLOC) + u * 4096; bf16_t* gPc = (bf16_t*)(P.ws + WS_PC) + u * 4096; bf16_t* gSl = (bf16_t*)(P.ws + WS_SLOC) + u * 4096;
    bf16_t* gG = (bf16_t*)((unsigned char*)P.out + DO_G) + u * 4096; bf16_t* Yr = (bf16_t*)((unsigned char*)P.out + DO_YRA);
    const int hd = h * 64 + 8 * cg;
    const bool is_ad = (cg == 2 || cg == 3); const float alpha = cg < 2 ? 2.f : 1.f, gamma = cg < 2 ? -1.f : 0.f;
    LAS bf16_t* ldst = (LAS bf16_t*)(lds + (cg < 2 ? L_TWD : (cg < 4 ? L_AD : L_SGD))) + t * (cg < 4 ? 72 : 136) + 32 * (cg < 2 ? cg : (cg < 4 ? cg - 2 : cg - 4));
    const size_t row = (size_t)b * SEQ + 64 * c + t;
    LAS float* tab = (LAS float*)(lds + L_TAB);
    if (h != htab) {
        htab = h;
        for (int i = tid; i < T_N; i += 512) { float v;
            if (i < T_MUR) v = P.in[6][1536 + i]; else if (i < T_PAR) { const int w = (i - T_MUR) >> 6, d = (i - T_MUR) & 63; v = P.in[6][w * 512 + h * 64 + d]; }
            else { const int w = (i - T_PAR) >> 6, d = (i - T_PAR) & 63; const float* src = w == 0 ? P.in[7] : (w == 1 ? P.in[9] : (w == 2 ? P.in[12] : (w == 3 ? P.in[13] : (w == 4 ? P.in[14] : P.in[16])))); v = src[h * 64 + d]; }
            tab[i] = v; }
        const int jb = (wid >> 1) & 1;
        const bf16_t* wa = (const bf16_t*)(P.ws + (wid < 4 ? WS_WUP : WS_AUP)) + (size_t)(h * 64 + jb * 32 + r32) * 64 + 8 * hi;
#pragma unroll
        for (int ks = 0; ks < 4; ++ks) wA[ks] = *(const bf16x8*)(wa + 16 * ks);
        LBAR();
    }
    bf16x8 wG[8];
    { const bf16_t* wg = (const bf16_t*)(P.ws + WS_GUP) + (size_t)(h * 64 + ((wid >> 1) & 1) * 32 + r32) * 128 + 8 * hi;
#pragma unroll
      for (int ks = 0; ks < 8; ++ks) wG[ks] = *(const bf16x8*)(wg + 16 * ks); }
    float rv[8], kv[8], vv[8];
    { float cur[8], prv[8], mu[8];
#pragma unroll
      for (int q = 0; q < 4; ++q) {
          unpack8(raw.lc[q], cur); unpack8(raw.lp[q], prv);
          *(f32x4*)mu = *(const LAS f32x4*)(tab + T_MUL + 32 * cg + 8 * q); *(f32x4*)(mu + 4) = *(const LAS f32x4*)(tab + T_MUL + 32 * cg + 8 * q + 4);
          float o[8];
#pragma unroll
          for (int i = 0; i < 8; ++i) { const float xs = cur[i] + (prv[i] - cur[i]) * mu[i]; const float sg = sigmoidf_(alpha * xs); o[i] = is_ad ? xs : alpha * sg + gamma; }
          u32x4 w; w.x = cvt_pk_bf16(o[0], o[1]); w.y = cvt_pk_bf16(o[2], o[3]); w.z = cvt_pk_bf16(o[4], o[5]); w.w = cvt_pk_bf16(o[6], o[7]);
          *(LAS u32x4*)(ldst + 8 * q) = w; }
#pragma unroll
      for (int which = 0; which < 3; ++which) {
          unpack8(raw.rc[which], cur); unpack8(raw.rp[which], prv);
          *(f32x4*)mu = *(const LAS f32x4*)(tab + T_MUR + which * 64 + 8 * cg); *(f32x4*)(mu + 4) = *(const LAS f32x4*)(tab + T_MUR + which * 64 + 8 * cg + 4);
#pragma unroll
          for (int i = 0; i < 8; ++i) { const float xs = cur[i] + (prv[i] - cur[i]) * mu[i]; if (which == 0) rv[i] = xs; else if (which == 1) kv[i] = xs; else vv[i] = xs; } } }
    LBAR(); PROF(0);
    { const int ib = wid & 1, jb = (wid >> 1) & 1;
      auto wr4 = [&](const f32x16& acc, LAS float* Out) { LAS float* op = Out + (ib * 32 + r32) * FLD + jb * 32 + 4 * hi;
#pragma unroll
          for (int g = 0; g < 4; ++g) *(LAS f32x4*)(op + 8 * g) = (f32x4){acc[4 * g], acc[4 * g + 1], acc[4 * g + 2], acc[4 * g + 3]}; };
      { f32x16 acc = {}; const LAS bf16_t* qp = (const LAS bf16_t*)(lds + (wid < 4 ? L_TWD : L_AD)) + (ib * 32 + r32) * 72 + 8 * hi;
#pragma unroll
        for (int ks = 0; ks < 4; ++ks) acc = __builtin_amdgcn_mfma_f32_32x32x16_bf16(wA[ks], *(const LAS bf16x8*)(qp + 16 * ks), acc, 0, 0, 0);
        wr4(acc, (LAS float*)(lds + (wid < 4 ? L_WL : L_AL))); }
      if (wid < 4) { f32x16 acc = {}; const LAS bf16_t* qp = (const LAS bf16_t*)(lds + L_SGD) + (ib * 32 + r32) * 136 + 8 * hi;
#pragma unroll
        for (int ks = 0; ks < 8; ++ks) acc = __builtin_amdgcn_mfma_f32_32x32x16_bf16(wG[ks], *(const LAS bf16x8*)(qp + 16 * ks), acc, 0, 0, 0);
        wr4(acc, (LAS float*)(lds + L_GL)); } }
    LBAR(); PROF(1);
    float lam[8], av[8], bv[8], kp[8];
    const int o68 = t * FLD + 8 * cg;
    { float wl[8], al[8], gv[8];
      *(f32x4*)wl = *(LAS f32x4*)(lds + L_WL + 4 * o68); *(f32x4*)(wl + 4) = *(LAS f32x4*)(lds + L_WL + 4 * o68 + 16);
      *(f32x4*)al = *(LAS f32x4*)(lds + L_AL + 4 * o68); *(f32x4*)(al + 4) = *(LAS f32x4*)(lds + L_AL + 4 * o68 + 16);
      *(f32x4*)gv = *(LAS f32x4*)(lds + L_GL + 4 * o68); *(f32x4*)(gv + 4) = *(LAS f32x4*)(lds + L_GL + 4 * o68 + 16);
      float w0[8], a0[8], kk_[8], ka[8], rk[8], lb[8];
      { const LAS float* tp = tab + T_PAR + 8 * cg;
        *(f32x4*)w0 = *(const LAS f32x4*)(tp); *(f32x4*)(w0 + 4) = *(const LAS f32x4*)(tp + 4);
        *(f32x4*)a0 = *(const LAS f32x4*)(tp + 64); *(f32x4*)(a0 + 4) = *(const LAS f32x4*)(tp + 68);
        *(f32x4*)kk_ = *(const LAS f32x4*)(tp + 128); *(f32x4*)(kk_ + 4) = *(const LAS f32x4*)(tp + 132);
        *(f32x4*)ka = *(const LAS f32x4*)(tp + 192); *(f32x4*)(ka + 4) = *(const LAS f32x4*)(tp + 196);
        *(f32x4*)rk = *(const LAS f32x4*)(tp + 256); *(f32x4*)(rk + 4) = *(const LAS f32x4*)(tp + 260);
        *(f32x4*)lb = *(const LAS f32x4*)(tp + 320); *(f32x4*)(lb + 4) = *(const LAS f32x4*)(tp + 324); }
      float asg[8], kkv[8], c2[8]; float ss = 0.f, bon = 0.f;
#pragma unroll
      for (int i = 0; i < 8; ++i) { lam[i] = 0.60653065971f * sigmoidf_(w0[i] + wl[i]); asg[i] = sigmoidf_(a0[i] + al[i]);
          kkv[i] = kv[i] * kk_[i]; ss += kkv[i] * kkv[i]; kp[i] = kv[i] * (1.f + (asg[i] - 1.f) * ka[i]); bon += rv[i] * kp[i] * rk[i]; }
      ss = red8(ss); bon = red8(bon);
      const float inv = 1.f / fmaxf(sqrtf(ss), 1e-12f);
#pragma unroll
      for (int i = 0; i < 8; ++i) { const float kn = kkv[i] * inv; av[i] = -kn; bv[i] = kn * asg[i]; c2[i] = (lb[i] + bon * vv[i]) * gv[i]; }
      u32x4 w; w.x = cvt_pk_bf16(gv[0], gv[1]); w.y = cvt_pk_bf16(gv[2], gv[3]); w.z = cvt_pk_bf16(gv[4], gv[5]); w.w = cvt_pk_bf16(gv[6], gv[7]);
      *(u32x4*)(gG + t * 64 + 8 * cg) = w;
      w.x = cvt_pk_bf16(c2[0], c2[1]); w.y = cvt_pk_bf16(c2[2], c2[3]); w.z = cvt_pk_bf16(c2[4], c2[5]); w.w = cvt_pk_bf16(c2[6], c2[7]);
      *(u32x4*)(Yr + row * 1024 + hd) = w; }
    float cum[8];
    { const int tl = lane >> 3;
#pragma unroll
      for (int i = 0; i < 8; ++i) { float x = lam[i];
          float y = __shfl_up(x, 8); x += (tl >= 1) ? y : 0.f; y = __shfl_up(x, 16); x += (tl >= 2) ? y : 0.f; y = __shfl_up(x, 32); x += (tl >= 4) ? y : 0.f;
          cum[i] = x; }
      if (tl == 7) { *(LAS f32x4*)(lds + L_SEG + (wid * 64 + 8 * cg) * 4) = *(f32x4*)cum; *(LAS f32x4*)(lds + L_SEG + (wid * 64 + 8 * cg) * 4 + 16) = *(f32x4*)(cum + 4); } }
    LBAR(); PROF(2);
    { float pre[8], tot[8];
#pragma unroll
      for (int i = 0; i < 8; ++i) { pre[i] = 0.f; tot[i] = 0.f; }
      const int myseg = t >> 3;
#pragma unroll
      for (int s = 0; s < 8; ++s) { float sv[8]; *(f32x4*)sv = *(LAS f32x4*)(lds + L_SEG + (s * 64 + 8 * cg) * 4); *(f32x4*)(sv + 4) = *(LAS f32x4*)(lds + L_SEG + (s * 64 + 8 * cg) * 4 + 16);
#pragma unroll
          for (int i = 0; i < 8; ++i) { tot[i] += sv[i]; pre[i] += (s < myseg) ? sv[i] : 0.f; } }
      float at_[8], bt_[8], kt_[8], rt_[8], bh_[8], kh_[8];
#pragma unroll
      for (int i = 0; i < 8; ++i) { const float cm = cum[i] + pre[i];
          const float gi = __builtin_amdgcn_exp2f(cm * LOG2E), g_ = __builtin_amdgcn_exp2f(-cm * LOG2E), gm1 = __builtin_amdgcn_exp2f(-(cm - lam[i]) * LOG2E), glg = __builtin_amdgcn_exp2f(-(tot[i] - cm) * LOG2E);
          at_[i] = av[i] * gm1; bt_[i] = bv[i] * gi; kt_[i] = kp[i] * gi; rt_[i] = rv[i] * g_; bh_[i] = bv[i] * glg; kh_[i] = kp[i] * glg; }
      if (t == 0) { float gl[8];
#pragma unroll
          for (int i = 0; i < 8; ++i) gl[i] = __builtin_amdgcn_exp2f(-tot[i] * LOG2E);
          *(LAS f32x4*)(lds + L_GLD + 32 * cg) = *(f32x4*)gl; *(LAS f32x4*)(lds + L_GLD + 32 * cg + 16) = *(f32x4*)(gl + 4); }
      const int ob = (t * LDB + 8 * cg) * 2; u32x4 w;
      w.x = cvt_pk_bf16(at_[0], at_[1]); w.y = cvt_pk_bf16(at_[2], at_[3]); w.z = cvt_pk_bf16(at_[4], at_[5]); w.w = cvt_pk_bf16(at_[6], at_[7]); *(LAS u32x4*)(lds + L_AT + ob) = w;
      w.x = cvt_pk_bf16(bt_[0], bt_[1]); w.y = cvt_pk_bf16(bt_[2], bt_[3]); w.z = cvt_pk_bf16(bt_[4], bt_[5]); w.w = cvt_pk_bf16(bt_[6], bt_[7]); *(LAS u32x4*)(lds + L_BT + ob) = w;
      w.x = cvt_pk_bf16(kt_[0], kt_[1]); w.y = cvt_pk_bf16(kt_[2], kt_[3]); w.z = cvt_pk_bf16(kt_[4], kt_[5]); w.w = cvt_pk_bf16(kt_[6], kt_[7]); *(LAS u32x4*)(lds + L_KT + ob) = w;
      w.x = cvt_pk_bf16(rt_[0], rt_[1]); w.y = cvt_pk_bf16(rt_[2], rt_[3]); w.z = cvt_pk_bf16(rt_[4], rt_[5]); w.w = cvt_pk_bf16(rt_[6], rt_[7]); *(LAS u32x4*)(lds + L_RT + ob) = w;
      w.x = cvt_pk_bf16(bh_[0], bh_[1]); w.y = cvt_pk_bf16(bh_[2], bh_[3]); w.z = cvt_pk_bf16(bh_[4], bh_[5]); w.w = cvt_pk_bf16(bh_[6], bh_[7]); *(LAS u32x4*)(lds + L_BH + ob) = w;
      w.x = cvt_pk_bf16(kh_[0], kh_[1]); w.y = cvt_pk_bf16(kh_[2], kh_[3]); w.z = cvt_pk_bf16(kh_[4], kh_[5]); w.w = cvt_pk_bf16(kh_[6], kh_[7]); *(LAS u32x4*)(lds + L_KH + ob) = w;
      w.x = cvt_pk_bf16(vv[0], vv[1]); w.y = cvt_pk_bf16(vv[2], vv[3]); w.z = cvt_pk_bf16(vv[4], vv[5]); w.w = cvt_pk_bf16(vv[6], vv[7]); *(LAS u32x4*)(lds + L_V + ob) = w; }
    LBAR(); PROF(4);
    load_raw(raw, Prw, (u_ + F.G < NB * 8 * 32) ? u_ + F.G : u_, t, cg);
    {
    wid = __builtin_amdgcn_readfirstlane(wid); asm volatile("" : "+v"(tid), "+s"(wid));
    const int lane = tid & 63, r32 = lane & 31, hi = lane >> 5;
    const int mb = wid & 1, nb = (wid >> 1) & 1, grp = wid >> 2;
    const int ao = 32 * mb * LDB * 2, bo = 32 * nb * LDB * 2;
    const int ncol = 32 * nb + r32;
    f32x16 accT = {};
    {
        f32x16 d = {};
        if (grp == 0) { d = mm64(d, lds + L_AT + ao, lds + L_KT + bo, lane);
#pragma unroll
            for (int r = 0; r < 16; ++r) d[r] = (ncol < RC_M(r)) ? d[r] : 0.f;
            store_T(d, lds + L_NKT, mb, nb, lane); }
        else { d = mm64(d, lds + L_BT + ao, lds + L_AT + bo, lane);
#pragma unroll
            for (int r = 0; r < 16; ++r) { d[r] = (RC_M(r) < ncol) ? d[r] : 0.f; accT[r] = d[r] + ((RC_M(r) == ncol) ? 1.f : 0.f); }
            store_T(d, lds + L_NQ0, mb, nb, lane); store_T(accT, lds + L_TQ0, mb, nb, lane); }
    }
    LBAR(); PROF(5);
#pragma unroll
    for (int j = 1; j <= 5; ++j) { const int cur = (j - 1) & 1, nw = j & 1;
        const int nq_c = cur ? L_NQ1 : L_NQ0, nq_n = nw ? L_NQ1 : L_NQ0;
        if (grp == 0) { f32x16 d = {}; d = mm64_atr(d, lds + nq_c, mb, lds + nq_c + bo, lane); store_T(d, lds + nq_n, mb, nb, lane); }
        else if (j == 1) { f32x16 e = {}; e = mm64(e, lds + L_BT + ao, lds + L_RT + bo, lane);
#pragma unroll
            for (int r = 0; r < 16; ++r) e[r] = (RC_M(r) <= ncol) ? e[r] : 0.f;
            store_T(e, lds + L_NRB, mb, nb, lane); }
        else { const int tq_r = nw ? L_TQ1 : L_TQ0, tq_w = cur ? L_TQ1 : L_TQ0;
            accT = mm64_atr(accT, lds + nq_c, mb, lds + tq_r + bo, lane); store_T(accT, lds + tq_w, mb, nb, lane); }
        LBAR();
    }
    if (grp == 1) { accT = mm64_atr(accT, lds + L_NQ1, mb, lds + L_TQ0 + bo, lane); store_T(accT, lds + L_TQ1, mb, nb, lane); }
    LBAR(); PROF(6);
    { f32x16 d = {};
      if (grp == 0) { d = mm64_btr(d, lds + L_TQ1 + ao, lds + L_AT, nb, lane); store_T(d, lds + L_W1T, mb, nb, lane); }
      else { d = mm64(d, lds + L_TQ1 + ao, lds + L_NKT + bo, lane); store_T(d, lds + L_W2T, mb, nb, lane); } }
    LBAR(); PROF(7);
    if (grp == 0) {
        f32x16 d = {}; d = mm64(d, lds + L_W1T + ao, lds + L_NRB + bo, lane);
#pragma unroll
        for (int g = 0; g < 4; ++g) { const u32x2 rw = *(const LAS u32x2*)(lds + L_RT + ((32 * nb + r32) * LDB + 32 * mb + 8 * g + 4 * hi) * 2);
            d[4 * g] += bf_lo(rw.x); d[4 * g + 1] += bf_hi(rw.x); d[4 * g + 2] += bf_lo(rw.y); d[4 * g + 3] += bf_hi(rw.y); }
        store_T_g(d, gQe, mb, nb, lane);
        f32x16 p = {}; p = mm64_btr(p, lds + L_W1T + ao, lds + L_BH, nb, lane);
        const float gl = ((const LAS float*)(lds + L_GLD))[ncol];
#pragma unroll
        for (int r = 0; r < 16; ++r) p[r] += (RC_M(r) == ncol) ? gl : 0.f;
        store_T_g(p, gPc, mb, nb, lane);
    } else {
        f32x16 d = {}; d = mm64(d, lds + L_KT + ao, lds + L_RT + bo, lane); d = mm64(d, lds + L_W2T + ao, lds + L_NRB + bo, lane);
#pragma unroll
        for (int r = 0; r < 16; ++r) d[r] = (RC_M(r) <= ncol) ? d[r] : 0.f;
        f32x16 k = {}; k = mm64_btr(k, lds + L_W2T + ao, lds + L_BH, nb, lane);
        { const LAS char* kb = lds + L_KH + 64 * nb + ((32 * mb + 4 * hi + ((lane & 15) >> 2)) * LDB + 16 * ((lane >> 4) & 1) + 4 * (lane & 3)) * 2;
#pragma unroll
          for (int g = 0; g < 4; ++g) { const s16x4 kw = trrd(kb + 8 * g * LDB * 2);
              k[4 * g] += bf_lo((unsigned)(unsigned short)kw[0]); k[4 * g + 1] += bf_lo((unsigned)(unsigned short)kw[1]); k[4 * g + 2] += bf_lo((unsigned)(unsigned short)kw[2]); k[4 * g + 3] += bf_lo((unsigned)(unsigned short)kw[3]); } }
        store_T(d, lds + L_WY, mb, nb, lane); store_T(k, lds + L_KC, mb, nb, lane);
    }
    LBAR(); PROF(8);
    { f32x16 d = {};
      if (grp == 0) { d = mm64_atr(d, lds + L_V, mb, lds + L_WY + bo, lane); store_T_g(d, gYl, mb, nb, lane); }
      else { d = mm64_btr(d, lds + L_KC + ao, lds + L_V, nb, lane); store_T_g(d, gSl, mb, nb, lane); } }
    LBAR(); PROF(9);
    }
  }
}

__device__ __forceinline__ void state_chain(Frame& F, const Ptrs& P, int bh) {
    const int tid = F.tid, lane = F.lane, wid = F.wave, r32 = lane & 31, hi = lane >> 5;
    LAS char* lds = (LAS char*)F.lds;
    const bf16_t* gPc = (const bf16_t*)(P.ws + WS_PC) + (size_t)bh * 32 * 4096; const bf16_t* gSl = (const bf16_t*)(P.ws + WS_SLOC) + (size_t)bh * 32 * 4096;
    bf16_t* gS = (bf16_t*)((unsigned char*)P.out + DO_SC) + (size_t)bh * 32 * 4096;
    constexpr int L_S0 = 0, L_S1 = MB, L_P = 2 * MB;
    for (int i = tid; i < MB / 4; i += 512) ((LAS unsigned*)(lds + L_S0))[i] = 0u;
    const int prow = tid >> 3, pch = tid & 7;
    u32x4 pw = *(const u32x4*)(gPc + prow * 64 + pch * 8);
    const int mb = wid & 1, nb = (wid >> 1) & 1;
    __syncthreads();
#pragma unroll 1
    for (int c = 0; c < 32; ++c) {
        const int sc = (c & 1) ? L_S1 : L_S0, sn = (c & 1) ? L_S0 : L_S1;
        *(LAS u32x4*)(lds + L_P + (prow * LDB + pch * 8) * 2) = pw;
        *(u32x4*)(gS + (size_t)c * 4096 + prow * 64 + pch * 8) = *(const LAS u32x4*)(lds + sc + (prow * LDB + pch * 8) * 2);
        if (c + 1 < 32) pw = *(const u32x4*)(gPc + (size_t)(c + 1) * 4096 + prow * 64 + pch * 8);
        f32x16 d = {};
        if (wid < 4) {
            const bf16_t* sp = gSl + (size_t)c * 4096 + (32 * nb + r32) * 64 + 32 * mb + 4 * hi;
#pragma unroll
            for (int g = 0; g < 4; ++g) { const u32x2 w = *(const u32x2*)(sp + 8 * g); d[4 * g] = bf_lo(w.x); d[4 * g + 1] = bf_hi(w.x); d[4 * g + 2] = bf_lo(w.y); d[4 * g + 3] = bf_hi(w.y); } }
        __syncthreads();
        if (wid < 4) { d = mm64(d, lds + L_P + 32 * mb * LDB * 2, lds + sc + 32 * nb * LDB * 2, lane); store_T(d, lds + sn, mb, nb, lane); }
        __syncthreads();
    }
}

__device__ __forceinline__ void out_unit(Frame& F, const Ptrs& P, int u, int nb, bool do_store = true) {
    const int lane = F.lane, r32 = lane & 31, hi = lane >> 5;
    const bf16_t* gQe = (const bf16_t*)(P.ws + WS_QE) + (size_t)u * 4096; const bf16_t* gYl = (const bf16_t*)(P.ws + WS_YLOC) + (size_t)u * 4096;
    const bf16_t* gS = (const bf16_t*)((unsigned char*)P.out + DO_SC) + (size_t)u * 4096; const bf16_t* gG = (const bf16_t*)((unsigned char*)P.out + DO_G) + (size_t)u * 4096;
    bf16_t* Yr = (bf16_t*)((unsigned char*)P.out + DO_YRA);
    const int bh = u >> 5, c = u & 31, h = bh & 7, b = bh >> 3;
    const int tl = 32 * nb + r32;
    const size_t row = (size_t)b * SEQ + 64 * c + tl;
    bf16_t* yo = Yr + row * 1024 + h * 64 + 4 * hi; const bf16_t* gg = gG + tl * 64 + 4 * hi; const float* lg = P.in[15] + h * 64 + 4 * hi; const bf16_t* yl = gYl + tl * 64 + 4 * hi;
    bf16x8 qf[4], sa[4], sb[4];
#pragma unroll
    for (int ks = 0; ks < 4; ++ks) { qf[ks] = *(const bf16x8*)(gQe + (32 * nb + r32) * 64 + 16 * ks + 8 * hi); sa[ks] = *(const bf16x8*)(gS + r32 * 64 + 16 * ks + 8 * hi); sb[ks] = *(const bf16x8*)(gS + (32 + r32) * 64 + 16 * ks + 8 * hi); }
    u32x2 ylw[2][4], gw[2][4], cw[2][4]; f32x4 l4[2][4];
#pragma unroll
    for (int eb = 0; eb < 2; ++eb)
#pragma unroll
        for (int g = 0; g < 4; ++g) { const int eo = 32 * eb + 8 * g; ylw[eb][g] = *(const u32x2*)(yl + eo); gw[eb][g] = *(const u32x2*)(gg + eo); cw[eb][g] = *(const u32x2*)(yo + eo); l4[eb][g] = *(const f32x4*)(lg + eo); }
    f32x16 y0 = {}, y1 = {};
#pragma unroll
    for (int ks = 0; ks < 4; ++ks) { y0 = __builtin_amdgcn_mfma_f32_32x32x16_bf16(sa[ks], qf[ks], y0, 0, 0, 0); y1 = __builtin_amdgcn_mfma_f32_32x32x16_bf16(sb[ks], qf[ks], y1, 0, 0, 0); }
    float s = 0.f;
#pragma unroll
    for (int g = 0; g < 4; ++g) { const u32x2 a = ylw[0][g], bq = ylw[1][g];
        y0[4 * g] += bf_lo(a.x); y0[4 * g + 1] += bf_hi(a.x); y0[4 * g + 2] += bf_lo(a.y); y0[4 * g + 3] += bf_hi(a.y);
        y1[4 * g] += bf_lo(bq.x); y1[4 * g + 1] += bf_hi(bq.x); y1[4 * g + 2] += bf_lo(bq.y); y1[4 * g + 3] += bf_hi(bq.y); }
#pragma unroll
    for (int r = 0; r < 16; ++r) s += y0[r] + y1[r];
    s += __shfl_xor(s, 32); const float mean = s * (1.f / 64.f); float q2 = 0.f;
#pragma unroll
    for (int r = 0; r < 16; ++r) { y0[r] -= mean; y1[r] -= mean; q2 += y0[r] * y0[r] + y1[r] * y1[r]; }
    q2 += __shfl_xor(q2, 32); const float rstd = 1.f / sqrtf(q2 * (1.f / 64.f) + 64e-5f);
#pragma unroll
    for (int g = 0; g < 4; ++g) {
#pragma unroll
        for (int eb = 0; eb < 2; ++eb) { const int eo = 32 * eb + 8 * g; const u32x2 g_ = gw[eb][g], c_ = cw[eb][g]; const f32x4 l_ = l4[eb][g];
            const f32x16& y = eb ? y1 : y0;
            const float o0 = y[4 * g] * rstd * l_.x * bf_lo(g_.x) + bf_lo(c_.x), o1 = y[4 * g + 1] * rstd * l_.y * bf_hi(g_.x) + bf_hi(c_.x), o2 = y[4 * g + 2] * rstd * l_.z * bf_lo(g_.y) + bf_lo(c_.y), o3 = y[4 * g + 3] * rstd * l_.w * bf_hi(g_.y) + bf_hi(c_.y);
            u32x2 w; w.x = cvt_pk_bf16(o0, o1); w.y = cvt_pk_bf16(o2, o3);
            if (do_store) *(u32x2*)(yo + eo) = w; } }
}
#undef RC_M
}
__device__ __forceinline__ void phase_route(Frame& F, const Ptrs& P) {
    const int lane = F.lane, gw = F.vcu * NWAVES + F.wave, NGW = F.G * NWAVES;
    const float* x1 = P.in[0]; const bf16_t* Dl = (const bf16_t*)(P.ws + WS_DELTA); const float* mod = (const float*)(P.ws + WS_MOD);
    const float* gam2 = (const float*)(P.ws + WS_GAM2); const float* cb = (const float*)(P.ws + WS_CB);
    const bf16_t* wrh = (const bf16_t*)(P.ws + WS_WRH); const bf16_t* wrl = (const bf16_t*)(P.ws + WS_WRL);
    bf16_t* H2 = (bf16_t*)(P.ws + WS_H2);
    int* tok_list = (int*)(P.ws + WS_TOKLIST); int* tok_pos = (int*)(P.ws + WS_TOKPOS); int* slot_tok = (int*)(P.ws + WS_SLOTTOK); float* slot_w = (float*)(P.ws + WS_SLOTW);
    unsigned* cnt = (unsigned*)(F.ctl + CW_CNT);
    constexpr int WROW = 1040, L_WH = 0, L_WLO = 48 * WROW, L_GAM = 2 * 48 * WROW, L_SCR = L_GAM + 4096, L_CNT = L_SCR + 8 * 16 * 52 * 4;
    static_assert(L_CNT + 1024 <= LDSCTL_OFF, "route LDS");
    LAS char* lds = (LAS char*)F.lds;
    LAS float* scr = (LAS float*)(lds + L_SCR) + F.wave * (16 * 52);
    const int fr = lane & 15, kq = lane >> 4;
    LAS unsigned* lcnt = (LAS unsigned*)(lds + L_CNT); LAS unsigned* lbase = lcnt + 64;
    for (int rnd = F.vcu; rnd < NTOK / 128; rnd += F.G) {
        const int R0 = rnd * 128 + F.wave * 16, b = R0 / SEQ;
        const float* xr = x1 + (size_t)(R0 + fr) * DM + 8 * kq; const bf16_t* dr = Dl + (size_t)(R0 + fr) * DM + 8 * kq;
        f32x4 acc[3] = {{0.f, 0.f, 0.f, 0.f}, {0.f, 0.f, 0.f, 0.f}, {0.f, 0.f, 0.f, 0.f}}; float ssq = 0.f;
#pragma unroll 1
        for (int half = 0; half < 2; ++half) {
            __syncthreads();
            if (half == 0) { if (F.tid < NLIST) lcnt[F.tid] = 0u; for (int i = F.tid; i < DM / 4; i += 512) *(LAS f32x4*)(lds + L_GAM + 16 * i) = *(const f32x4*)(gam2 + (size_t)b * DM + 4 * i); }
            for (int i = F.tid; i < 48 * 64; i += 512) { const int row = i >> 6, ch = i & 63;
                *(LAS u32x4*)(lds + L_WH + row * WROW + ch * 16) = *(const u32x4*)(wrh + (size_t)row * DM + half * 512 + ch * 8);
                *(LAS u32x4*)(lds + L_WLO + row * WROW + ch * 16) = *(const u32x4*)(wrl + (size_t)row * DM + half * 512 + ch * 8); }
            __syncthreads();
            const LAS char* bh = lds + L_WH + fr * WROW + kq * 16; const LAS char* bl = lds + L_WLO + fr * WROW + kq * 16; const LAS char* gp = lds + L_GAM + (half * 512 + 8 * kq) * 4;
#pragma unroll 2
            for (int kk = 0; kk < 512; kk += 32) { const int k0 = half * 512 + kk;
                f32x4 xa = *(const f32x4*)(xr + k0), xb = *(const f32x4*)(xr + k0 + 4); const f32x4 ga = *(const LAS f32x4*)(gp + kk * 4), gb = *(const LAS f32x4*)(gp + kk * 4 + 16);
                { const u32x4 dw = *(const u32x4*)(dr + k0); xa.x += bf_lo(dw.x); xa.y += bf_hi(dw.x); xa.z += bf_lo(dw.y); xa.w += bf_hi(dw.y); xb.x += bf_lo(dw.z); xb.y += bf_hi(dw.z); xb.z += bf_lo(dw.w); xb.w += bf_hi(dw.w); }
                ssq += (xa.x * xa.x + xa.y * xa.y) + (xa.z * xa.z + xa.w * xa.w) + (xb.x * xb.x + xb.y * xb.y) + (xb.z * xb.z + xb.w * xb.w);
                const f32x4 ya = xa * ga, yb = xb * gb;
                u32x4 hw; hw.x = cvt_pk_bf16(ya.x, ya.y); hw.y = cvt_pk_bf16(ya.z, ya.w); hw.z = cvt_pk_bf16(yb.x, yb.y); hw.w = cvt_pk_bf16(yb.z, yb.w);
                u32x4 lw; lw.x = cvt_pk_bf16(ya.x - bf_lo(hw.x), ya.y - bf_hi(hw.x)); lw.y = cvt_pk_bf16(ya.z - bf_lo(hw.y), ya.w - bf_hi(hw.y));
                lw.z = cvt_pk_bf16(yb.x - bf_lo(hw.z), yb.y - bf_hi(hw.z)); lw.w = cvt_pk_bf16(yb.z - bf_lo(hw.w), yb.w - bf_hi(hw.w));
                const bf16x8 ah = __builtin_bit_cast(bf16x8, hw), al = __builtin_bit_cast(bf16x8, lw);
#pragma unroll
                for (int nb = 0; nb < 3; ++nb) { const bf16x8 wh = *(const LAS bf16x8*)(bh + nb * 16 * WROW + kk * 2), wl = *(const LAS bf16x8*)(bl + nb * 16 * WROW + kk * 2);
                    acc[nb] = __builtin_amdgcn_mfma_f32_16x16x32_bf16(ah, wh, acc[nb], 0, 0, 0); acc[nb] = __builtin_amdgcn_mfma_f32_16x16x32_bf16(al, wh, acc[nb], 0, 0, 0); acc[nb] = __builtin_amdgcn_mfma_f32_16x16x32_bf16(ah, wl, acc[nb], 0, 0, 0); }
            }
        }
        ssq += __shfl_xor(ssq, 16); ssq += __shfl_xor(ssq, 32);
        const float rinv = 1.f / sqrtf(ssq * (1.f / DM) + 1e-6f);
#pragma unroll
        for (int nb = 0; nb < 3; ++nb)
#pragma unroll
            for (int j = 0; j < 4; ++j) scr[(4 * kq + j) * 52 + 16 * nb + fr] = acc[nb][j];
        LDS_WAIT(); asm volatile("" ::: "memory");
        int l1 = 0, l2 = 0, q1 = 0, q2 = 0; float w1 = 0.f, w2 = 0.f;
        if (lane < 16) {
            const float* cbb = cb + b * 64; const LAS float* lr = scr + lane * 52;
            float lc[4]; int grp = 0; float best = -3.4e38f;
#pragma unroll
            for (int o = 0; o < 4; ++o) { lc[o] = rinv * lr[o] + cbb[o]; if (lc[o] > best) { best = lc[o]; grp = o; } }
            float den = 0.f;
#pragma unroll
            for (int o = 0; o < 4; ++o) den += __expf(lc[o] - best);
            const float pgrp = 1.f / den;
            float f1 = -3.4e38f, f2 = -3.4e38f; int i1 = 0, i2 = 0;
            for (int o = 0; o < 8; ++o) { const float v = rinv * lr[4 + grp * 8 + o] + cbb[4 + grp * 8 + o];
                if (v > f1) { f2 = f1; i2 = i1; f1 = v; i1 = o; } else if (v > f2) { f2 = v; i2 = o; } }
            const float e2 = __expf(f2 - f1); w1 = pgrp / (1.f + e2); w2 = pgrp * e2 / (1.f + e2);
            l1 = (grp * 8 + i1) * 2; l2 = (grp * 8 + i2) * 2 + 1;
            q1 = (int)__hip_atomic_fetch_add(lcnt + l1, 1u, __ATOMIC_RELAXED, __HIP_MEMORY_SCOPE_WORKGROUP); q2 = (int)__hip_atomic_fetch_add(lcnt + l2, 1u, __ATOMIC_RELAXED, __HIP_MEMORY_SCOPE_WORKGROUP);
        }
        __syncthreads();
        if (F.tid < NLIST) { const unsigned c = ((LAS unsigned*)lcnt)[F.tid]; lbase[F.tid] = c ? atomicAdd(cnt + 64 * F.tid, c) : 0u; }
        __syncthreads();
        if (lane < 16) { const int tok = R0 + lane;
            const int p1 = (int)lbase[l1] + q1, p2 = (int)lbase[l2] + q2;
            tok_list[2 * tok] = l1; tok_list[2 * tok + 1] = l2; tok_pos[2 * tok] = p1; tok_pos[2 * tok + 1] = p2;
            slot_tok[(size_t)l1 * NTOK + p1] = tok; slot_tok[(size_t)l2 * NTOK + p2] = tok; slot_w[(size_t)l1 * NTOK + p1] = w1; slot_w[(size_t)l2 * NTOK + p2] = w2; }
        const float* sh = mod + (size_t)b * MODW + 3 * DM;
#pragma unroll 4
        for (int r = 0; r < 16; ++r) { const float ri = __shfl(rinv, r);
            const GAS f32x4* xrow = (const GAS f32x4*)(x1 + (size_t)(R0 + r) * DM) + lane; const GAS u32x2* drow = (const GAS u32x2*)(Dl + (size_t)(R0 + r) * DM) + lane; GAS u32x2* o8 = (GAS u32x2*)(H2 + (size_t)(R0 + r) * DM) + lane;
#pragma unroll
            for (int j = 0; j < 4; ++j) { const int k = 4 * lane + 256 * j; f32x4 xv = __builtin_nontemporal_load(xrow + 64 * j); const u32x2 dw = drow[64 * j]; xv.x += bf_lo(dw.x); xv.y += bf_hi(dw.x); xv.z += bf_lo(dw.y); xv.w += bf_hi(dw.y); const f32x4 g = *(const f32x4*)(gam2 + (size_t)b * DM + k), s = *(const f32x4*)(sh + k);
                const f32x4 hv = xv * ri * g + s; u32x2 w; w.x = cvt_pk_bf16(hv.x, hv.y); w.y = cvt_pk_bf16(hv.z, hv.w); o8[64 * j] = w; } }
        LDS_WAIT(); asm volatile("" ::: "memory");
    }
}
__device__ __forceinline__ void moe_offsets(Frame& F) {
    LAS int* toff = (LAS int*)(F.lds + TOFF_OFF); LAS int* lcnt = (LAS int*)(F.lds + LCNT_OFF); LAS unsigned char* tile_l = (LAS unsigned char*)(F.lds + TILE_L_OFF);
    if (F.tid < NLIST) lcnt[F.tid] = (int)__hip_atomic_load(F.ctl + CW_CNT + 64 * F.tid, RLX_AGENT);
    __syncthreads();
    if (F.tid == 0) { int acc = 0;
#pragma unroll 1
        for (int l = 0; l < NLIST; ++l) { toff[l] = acc; acc += (lcnt[l] + 255) >> 8; } toff[NLIST] = acc; }
    __syncthreads();
    if (F.tid < NLIST) { for (int t = toff[F.tid]; t < toff[F.tid + 1]; ++t) tile_l[t] = (unsigned char)F.tid; }
    __syncthreads();
}
#ifndef MK_ONE_LAUNCH
#define MK_ONE_LAUNCH 1
#endif
constexpr int N_PHASES = 12;

__global__ void __launch_bounds__(NWAVES * 64, 2) fwd_kernel(Args args) {
    extern __shared__ __attribute__((aligned(16))) unsigned char lds_raw[];
    Frame F; F.lds = (LAS unsigned char*)lds_raw; F.MISC = (volatile LAS unsigned*)(F.lds + MISC_OFF);
    F.tid = threadIdx.x; F.lane = F.tid & 63; F.wave = __builtin_amdgcn_readfirstlane(F.tid >> 6);
    F.G = gridDim.x; { const int bx = blockIdx.x; F.vcu = (F.G % 8 == 0) ? (bx % 8) * (F.G / 8) + bx / 8 : bx; }
#ifndef DUP_PHASE
#define DUP_PHASE -1
#endif
#define RELOAD_ARGS() Ptrs P; { int z_ = 0; asm volatile("" : "+s"(z_)); _Pragma("unroll") for (int i_ = 0; i_ < 31; ++i_) P.in[i_] = args.in[i_] + z_; P.out = args.out + z_; P.ws = args.ws + z_; }
    F.ctl = (gu32*)(args.ws + WS_CTL);
    for (int u = F.tid; u < (LDS_BYTES - LDSCTL_OFF) / 4; u += NWAVES * 64) ((LAS unsigned*)(F.lds + LDSCTL_OFF))[u] = 0u;
    __syncthreads();
    XcdBarrier bar; bar.bar = (unsigned*)(F.ctl + CW_BAR); bar.x = 0; bar.st = nullptr;
#if MK_ONE_LAUNCH
    bar = xcd_barrier_post((unsigned*)(F.ctl + CW_BAR), F.MISC + 8);
#define GRID_BAR() xcd_barrier(bar)
#else
#define GRID_BAR() do { } while (0)
#endif
    const int lo = args.ph_lo, hi = args.ph_hi;
#ifndef PH_MASK
#define PH_MASK 0xfff
#endif
#define IN(k) ((((PH_MASK) >> (k)) & 1) && lo <= (k) && (k) < hi)
#ifndef TIME_PHASE
#define TIME_PHASE -1
#endif
#define STAMP(i) do { if (TIME_PHASE >= 0 && blockIdx.x == 0 && F.tid == 0) ((unsigned long long*)(args.ws + WS_CTL + 768 * KiB))[i] = __builtin_amdgcn_s_memrealtime(); } while (0)
#define SEAM(k) do { if (IN(k) && IN((k) + 1)) GRID_BAR(); STAMP((k) + 1); } while (0)
    STAMP(0);
#ifndef GPROF_PHASE
#define GPROF_PHASE -1
#endif
#define GFLUSH(ph) do { if (GPROF_ON && GPROF_PHASE == (ph) && blockIdx.x == 0 && F.tid == 0) { unsigned long long* tsp = (unsigned long long*)(args.ws + WS_CTL + 768 * KiB); unsigned long long a_ = 0; tsp[20] = 0; for (int k_ = 0; k_ < 10; ++k_) { a_ += F.MISC[16 + k_]; tsp[21 + k_] = a_; } } } while (0)
#define MODP ((float*)(P.ws + WS_MOD))
#define PGATE ((unsigned char*)(P.ws + WS_PGATE))

    if (IN(0)) for (int rep_ = 0; rep_ < ((0) == DUP_PHASE ? 2 : 1); ++rep_) { if (rep_) GRID_BAR(); RELOAD_ARGS(); phase_mod(F, P.in[1], P.in[2], P.in[3], MODP); } SEAM(0);
    if (IN(1)) for (int rep_ = 0; rep_ < ((1) == DUP_PHASE ? 2 : 1); ++rep_) { if (rep_) GRID_BAR(); RELOAD_ARGS(); phase_prep(F, P); } SEAM(1);
    if (IN(2)) for (int rep_ = 0; rep_ < ((2) == DUP_PHASE ? 2 : 1); ++rep_) { if (rep_) GRID_BAR(); RELOAD_ARGS();
        pg8::Gemm g{DM, DM, DM}; pg8::DenseOrder S; S.init((const bf16_t*)((unsigned char*)P.out + DO_H), (const bf16_t*)(P.ws + WS_WIN), DM, DM, NTOK, INCOLS, F.G, (int)blockIdx.x);
        pg8::EpiP E{(bf16_t*)(P.ws + WS_PRW), (bf16_t*)(P.ws + WS_PATT), PGATE};
        pg8::gemm_phase<pg8::EpiP, pg8::DenseOrder, true>(F.lds, g, S, E); GFLUSH(2);
        { const int nfull = (NTOK / 256) * (INCOLS / 256) % F.G; const int bx = (int)blockIdx.x; if (nfull > 0 && bx >= nfull) expert_convert_down(F, P, (bx - nfull) * NWAVES + F.wave, (F.G - nfull) * NWAVES); else if (nfull == 0) expert_convert_down(F, P, bx * NWAVES + F.wave, F.G * NWAVES); }
    } SEAM(2);
    if (IN(3)) for (int rep_ = 0; rep_ < ((3) == DUP_PHASE ? 2 : 1); ++rep_) { if (rep_) GRID_BAR(); RELOAD_ARGS();
#pragma unroll 1
        for (int r2 = 0; r2 < (DUP_PHASE == 31 ? 2 : 1); ++r2)
#pragma unroll 1
        for (int u = (int)blockIdx.x; u < NB * 8 * 8; u += F.G) att::attn_unit(F, P, u >> 6, (u >> 3) & 7, u & 7);
        __syncthreads();
#pragma unroll 1
        for (int r2 = 0; r2 < (DUP_PHASE == 30 ? 2 : 1); ++r2) rc::chunk_phase(F, P);
        if (TIME_PHASE >= 20 && GPROF_PHASE < 0 && blockIdx.x == 0 && F.tid == 0) { unsigned long long* tsp = (unsigned long long*)(args.ws + WS_CTL + 768 * KiB); unsigned long long a_ = 0; tsp[20] = 0; for (int k_ = 0; k_ < 10; ++k_) { a_ += F.MISC[16 + k_]; tsp[21 + k_] = a_; } }
    } SEAM(3);
    constexpr int EC_ITEMS = NE * 2 * 256, EC_SPLIT = EC_ITEMS;
    if (IN(4)) for (int rep_ = 0; rep_ < ((4) == DUP_PHASE ? 2 : 1); ++rep_) { if (rep_) GRID_BAR(); RELOAD_ARGS();
        const int nR = F.G >= 256 ? 128 : F.G / 2, bx = (int)blockIdx.x;
        if (bx < nR) { for (int u = bx; u < NB * 8; u += nR) rc::state_chain(F, P, u); }
        else { const int na = F.G - nR, a = bx - nR; expert_convert(F, P, a * NWAVES + F.wave, na * NWAVES, 0, EC_SPLIT); }
    } SEAM(4);
    if (IN(5)) for (int rep_ = 0; rep_ < ((5) == DUP_PHASE ? 2 : 1); ++rep_) { if (rep_) GRID_BAR(); RELOAD_ARGS();
        const int gw = (int)blockIdx.x * NWAVES + F.wave, NGW = F.G * NWAVES;
        for (int w = gw; w < NB * 8 * 32 * 2; w += NGW) rc::out_unit(F, P, w >> 1, w & 1, !(DUP_PHASE == 5 && rep_ == 0));
        expert_convert(F, P, gw, NGW, EC_SPLIT, EC_ITEMS);
    } SEAM(5);
    if (IN(6)) for (int rep_ = 0; rep_ < ((6) == DUP_PHASE ? 2 : 1); ++rep_) { if (rep_) GRID_BAR(); RELOAD_ARGS();
        pg8::Gemm g{DM, DM, DM}; pg8::DenseOrder S; S.init((const bf16_t*)((unsigned char*)P.out + DO_YRA), (const bf16_t*)(P.ws + WS_WBR), DM, DM, NTOK, DM, F.G, (int)blockIdx.x);
        pg8::EpiMix E{(bf16_t*)(P.ws + WS_T), PGATE}; pg8::gemm_phase<pg8::EpiMix, pg8::DenseOrder, true>(F.lds, g, S, E);
    } SEAM(6);
    if (IN(7)) for (int rep_ = 0; rep_ < ((7) == DUP_PHASE ? 2 : 1); ++rep_) { if (rep_) GRID_BAR(); RELOAD_ARGS();
        pg8::Gemm g{DM, DM, DM}; pg8::DenseOrder S; S.init((const bf16_t*)(P.ws + WS_T), (const bf16_t*)(P.ws + WS_WOUT), DM, DM, NTOK, DM, F.G, (int)blockIdx.x);
        pg8::EpiDelta E{(bf16_t*)(P.ws + WS_DELTA), MODP}; E.scr = args.scr; pg8::gemm_phase<pg8::EpiDelta, pg8::DenseOrder, true>(F.lds, g, S, E); GFLUSH(7);
    } SEAM(7);
    if (IN(8)) for (int rep_ = 0; rep_ < ((8) == DUP_PHASE ? 2 : 1); ++rep_) { if (rep_) GRID_BAR(); RELOAD_ARGS(); phase_route(F, P); } SEAM(8);
    if (IN(9)) for (int rep_ = 0; rep_ < ((9) == DUP_PHASE ? 2 : 1); ++rep_) { if (rep_) GRID_BAR(); RELOAD_ARGS();
        moe_offsets(F); const LAS int* toff = (const LAS int*)(F.lds + TOFF_OFF);
        pg8::Gemm g{DM, DM, DM}; pg8::MoeOrderT<true> S{(const bf16_t*)(P.ws + WS_H2), (const bf16_t*)(P.ws + WS_WGU), DM, DM, (size_t)DM * DM, (const LAS unsigned char*)(F.lds + TILE_L_OFF), toff, (const LAS int*)(F.lds + LCNT_OFF), 0, toff[NLIST], F.G, (int)blockIdx.x, (const int*)(P.ws + WS_SLOTTOK)};
        pg8::EpiHid E{(bf16_t*)(P.ws + WS_HID)}; pg8::gemm_phase<pg8::EpiHid, pg8::MoeOrderT<true>, true>(F.lds, g, S, E); GFLUSH(9);
    } SEAM(9);
    if (IN(10)) for (int rep_ = 0; rep_ < ((10) == DUP_PHASE ? 2 : 1); ++rep_) { if (rep_) GRID_BAR(); RELOAD_ARGS();
        moe_offsets(F); const LAS int* toff = (const LAS int*)(F.lds + TOFF_OFF);
        pg8::Gemm g{DE, DE, DE}; pg8::MoeOrderT<false> S{(const bf16_t*)(P.ws + WS_HID), (const bf16_t*)(P.ws + WS_WD), DE, DE, (size_t)DM * DE, (const LAS unsigned char*)(F.lds + TILE_L_OFF), toff, (const LAS int*)(F.lds + LCNT_OFF), 0, toff[NLIST], F.G, (int)blockIdx.x, nullptr};
        pg8::EpiY E{(bf16_t*)(P.ws + WS_YB), (const float*)(P.ws + WS_SLOTW)}; pg8::gemm_phase<pg8::EpiY, pg8::MoeOrderT<false>, true>(F.lds, g, S, E); GFLUSH(10);
    } SEAM(10);
    if (IN(11)) for (int rep_ = 0; rep_ < ((11) == DUP_PHASE ? 2 : 1); ++rep_) { if (rep_) GRID_BAR(); RELOAD_ARGS();
        moe_offsets(F); const LAS int* toff = (const LAS int*)(F.lds + TOFF_OFF);
        const bf16_t* Yb = (const bf16_t*)(P.ws + WS_YB); const int* tok_list = (const int*)(P.ws + WS_TOKLIST); const int* tok_pos = (const int*)(P.ws + WS_TOKPOS);
        const float* mod = MODP; const int gw = F.vcu * NWAVES + F.wave, NGW = F.G * NWAVES;
#pragma unroll 4
        for (int tok = gw; tok < NTOK; tok += NGW) {
            const int s0 = toff[tok_list[2 * tok]] * 256 + tok_pos[2 * tok], s1 = toff[tok_list[2 * tok + 1]] * 256 + tok_pos[2 * tok + 1];
            const float* g2 = mod + (size_t)(tok / SEQ) * MODW + 5 * DM;
            GAS f32x4* xo = (GAS f32x4*)(P.out + (size_t)tok * DM) + F.lane; const GAS f32x4* xi = (const GAS f32x4*)(P.in[0] + (size_t)tok * DM) + F.lane; const GAS u32x2* dd = (const GAS u32x2*)((const bf16_t*)(P.ws + WS_DELTA) + (size_t)tok * DM) + F.lane;
            const GAS u32x2* y0 = (const GAS u32x2*)(Yb + (size_t)s0 * DM) + F.lane; const GAS u32x2* y1 = (const GAS u32x2*)(Yb + (size_t)s1 * DM) + F.lane;
#pragma unroll
            for (int j = 0; j < 4; ++j) { f32x4 xv = __builtin_nontemporal_load(xi + 64 * j); const u32x2 dw = __builtin_nontemporal_load(dd + 64 * j); xv.x += bf_lo(dw.x); xv.y += bf_hi(dw.x); xv.z += bf_lo(dw.y); xv.w += bf_hi(dw.y); const u32x2 a = __builtin_nontemporal_load(y0 + 64 * j), bq = __builtin_nontemporal_load(y1 + 64 * j); const f32x4 gv = *(const f32x4*)(g2 + 4 * F.lane + 256 * j);
                f32x4 o; o.x = xv.x + gv.x * (bf_lo(a.x) + bf_lo(bq.x)); o.y = xv.y + gv.y * (bf_hi(a.x) + bf_hi(bq.x)); o.z = xv.z + gv.z * (bf_lo(a.y) + bf_lo(bq.y)); o.w = xv.w + gv.w * (bf_hi(a.y) + bf_hi(bq.y));
                __builtin_nontemporal_store(o, xo + 64 * j); }
        }
    }
#ifdef EXTRA_BARS
    for (int i_ = 0; i_ < EXTRA_BARS; ++i_) GRID_BAR();
#endif
#if TIME_PHASE >= 0
    {
#ifndef TIME_SCALE
#define TIME_SCALE 3.0e-4f
#endif
#ifndef TIME_HI
#define TIME_HI (TIME_PHASE + 1)
#endif
        STAMP(12); GRID_BAR();
        const unsigned long long* ts = (const unsigned long long*)(args.ws + WS_CTL + 768 * KiB);
        const float dlt = (float)(ts[TIME_HI] - ts[TIME_PHASE]) * (0.01f * TIME_SCALE);
        for (int i = blockIdx.x * 512 + F.tid; i < (1 << 20); i += gridDim.x * 512) args.out[i] += dlt;
    }
#endif
#undef IN
#undef SEAM
}

extern "C" void kernel_launch(void* const* d_in, const int* in_sizes, int n_in, void* d_out, int out_size, void* d_ws, size_t ws_size, hipStream_t stream) {
    static int grid = 0;
    if (grid == 0) {
        if (n_in != 31 || out_size != NTOK * DM || ws_size < WS_END) { fprintf(stderr, "kernel_launch: unexpected shapes (n_in %d out %d ws %zu)\n", n_in, out_size, ws_size); grid = -1; return; }
        int dev = 0, cus = 0;
        if (hipGetDevice(&dev) != hipSuccess || hipDeviceGetAttribute(&cus, hipDeviceAttributeMultiprocessorCount, dev) != hipSuccess) { grid = -1; return; }
        if (hipFuncSetAttribute((const void*)fwd_kernel, hipFuncAttributeMaxDynamicSharedMemorySize, LDS_BYTES) != hipSuccess) { fprintf(stderr, "kernel_launch: hipFuncSetAttribute failed\n"); grid = -1; return; }
        int per_cu = 0; (void)hipOccupancyMaxActiveBlocksPerMultiprocessor(&per_cu, (const void*)fwd_kernel, NWAVES * 64, LDS_BYTES); (void)hipGetLastError();
        grid = cus;
    }
    if (grid < 0) return;
    (void)hipMemsetAsync((char*)d_ws + WS_CTL, 0, CTL_ZERO_BYTES, stream);
    Args a{};
    for (int i = 0; i < 31; ++i) a.in[i] = (const float*)d_in[i];
    a.out = (float*)d_out; a.ws = (unsigned char*)d_ws;
#if MK_ONE_LAUNCH
    a.ph_lo = 0; a.ph_hi = N_PHASES;
    hipLaunchKernelGGL(fwd_kernel, dim3(grid), dim3(NWAVES * 64), LDS_BYTES, stream, a);
#else
    for (int p = 0; p < N_PHASES; ++p) {
#ifdef PROBE7
        if (p == 7) { a.ph_lo = 7; a.ph_hi = 8; a.scr = PROBE7 - 1; hipLaunchKernelGGL(fwd_kernel, dim3(grid), dim3(NWAVES * 64), LDS_BYTES, stream, a); a.scr = 0; }
#endif
        a.ph_lo = p; a.ph_hi = p + 1; hipLaunchKernelGGL(fwd_kernel, dim3(grid), dim3(NWAVES * 64), LDS_BYTES, stream, a); }
#endif
}
```

```cpp
#include <hip/hip_runtime.h>
#include <cstdio>
#include <cstdint>

#define LAS __attribute__((address_space(3)))
#define GAS __attribute__((address_space(1)))
typedef unsigned short bf16_t;
typedef short bf16x8 __attribute__((ext_vector_type(8)));
typedef short s16x4 __attribute__((ext_vector_type(4)));
typedef float f32x4 __attribute__((ext_vector_type(4)));
typedef float f32x2 __attribute__((ext_vector_type(2)));
typedef float f32x16 __attribute__((ext_vector_type(16)));
typedef unsigned u32x4 __attribute__((ext_vector_type(4)));
typedef unsigned u32x2 __attribute__((ext_vector_type(2)));

constexpr int NB = 16, SEQ = 2048, DM = 1024, NTOK = NB * SEQ;
constexpr int RCOLS = 1792, ACOLS = 1536, GCOLS = 2048, INCOLS = 5376;
constexpr int NE = 32, DE = 512, NLIST = 64;
constexpr int MODW = 6 * DM;
constexpr float LOG2E = 1.4426950408889634f;

typedef __bf16 bf16x2_t __attribute__((ext_vector_type(2)));
__device__ __forceinline__ unsigned cvt_pk_bf16(float lo, float hi) { const f32x2 v = {lo, hi}; const bf16x2_t b = __builtin_convertvector(v, bf16x2_t); return __builtin_bit_cast(unsigned, b); }
__device__ __forceinline__ float bf_lo(unsigned w) { return __uint_as_float(w << 16); }
__device__ __forceinline__ float bf_hi(unsigned w) { return __uint_as_float(w & 0xffff0000u); }
__device__ __forceinline__ float sigmoidf_(float x) { return __builtin_amdgcn_rcpf(1.0f + __builtin_amdgcn_exp2f(-x * LOG2E)); }

#ifndef GPROF_ON
#define GPROF_ON 0
#endif
#define GPROF(k) do { if (GPROF_ON && blockIdx.x == 0 && threadIdx.x == 0) { volatile LAS unsigned* M_ = (volatile LAS unsigned*)(lds + (163840 - 2048)); const unsigned now_ = (unsigned)__builtin_amdgcn_s_memrealtime(); M_[16 + (k)] += now_ - M_[15]; M_[15] = now_; } } while (0)
#define EPI_ST0(T_, p_, v_) (*(T_*)(p_) = v_)
#ifndef EPI_NT
#define EPI_NT 1
#endif
#if EPI_NT
#define EPI_ST(T_, p_, v_) __builtin_nontemporal_store(v_, (T_*)(p_))
#else
#define EPI_ST(T_, p_, v_) (*(T_*)(p_) = v_)
#endif
namespace pg8 {
constexpr int BM = 256, BK = 64, HALF = 128, HTB = HALF * BK * 2, STAGE_BYTES = 8 * HTB, NXCD = 8, WGM = 8;
__host__ __device__ __forceinline__ int lds_byte(int r, int c) { const int st = (r >> 4) * 2 + (c >> 5), rr = r & 15, cc = c & 31, ob = rr * 64 + cc * 2; return st * 1024 + (ob ^ (((ob >> 9) & 1) << 5)); }
__host__ __device__ __forceinline__ void stage_rc(int b, int& R, int& C) { const int st = b / 1024, sb = b % 1024, swz = sb ^ (((sb >> 9) & 1) << 5); R = (st >> 1) * 16 + swz / 64; C = (st & 1) * 32 + (swz % 64) / 2; }
__host__ __device__ __forceinline__ int perm32(int rho) { const int n = rho >> 4, i = rho & 15; return 8 * (i >> 2) + 4 * n + (i & 3); }

struct Unit { int pm, pn, e, sbase, nvalid; };
struct Gemm { int lda, ldb, K; };

struct DenseOrder {
    static constexpr bool GATHER = false;
    __device__ __forceinline__ int row_tok(const Unit&, int) const { return 0; }
    const bf16_t* A; const bf16_t* Bt; int lda, ldb;
    int nM, nN, nwg, G, c;
    __device__ void init(const bf16_t* A_, const bf16_t* Bt_, int lda_, int ldb_, int M, int N, int G_, int c_) { A = A_; Bt = Bt_; lda = lda_; ldb = ldb_; nM = M / BM; nN = N / BM; nwg = nM * nN; G = G_; c = c_; }
    __device__ bool next(int i, Unit& u) const {
        const long L = (long)i * G + c; if (L >= nwg) return false;
        int wgid = (int)L; { const int q = nwg / NXCD, r = nwg % NXCD, xcd = wgid % NXCD, off = wgid / NXCD; wgid = (xcd < r ? xcd * (q + 1) : r * (q + 1) + (xcd - r) * q) + off; }
        const int nig = WGM * nN, gid = wgid / nig, fm = gid * WGM, gsz = (nM - fm) < WGM ? (nM - fm) : WGM;
        u.pm = fm + ((wgid % nig) % gsz); u.pn = (wgid % nig) / gsz; u.e = 0; u.sbase = 0; u.nvalid = BM; return true;
    }
    __device__ __forceinline__ const char* a_base(const Unit& u) const { return (const char*)A + (size_t)u.pm * BM * lda * 2; }
    __device__ __forceinline__ const char* b_base(const Unit& u) const { return (const char*)Bt + (size_t)u.pn * BM * ldb * 2; }
};
template <bool GATHER_> struct MoeOrderT {
    static constexpr bool GATHER = GATHER_;
    const bf16_t* A; const bf16_t* Bt; int lda, ldb; size_t bt_expert_stride;
    const LAS unsigned char* tile_l;
    const LAS int* toff; const LAS int* lcnt;
    int tlo, thi, G, c;
    const int* slot_tok;
    __device__ __forceinline__ int row_tok(const Unit& u, int r) const { return r < u.nvalid ? slot_tok[u.sbase + r] : 0; }
    __device__ bool next(int i, Unit& u) const {
        const int nt = thi - tlo; int tile, pn;
        if (G % NXCD == 0) { const int x = c % NXCD, cin = c / NXCD, per = G / NXCD; const int t0 = (int)((long)nt * x / NXCD), t1 = (int)((long)nt * (x + 1) / NXCD);
            const long j = (long)i * per + cin; if (j >= (long)(t1 - t0) * 4) return false; tile = tlo + t0 + (int)(j >> 2); pn = (int)(j & 3); }
        else { const long L = (long)i * G + c; if (L >= (long)nt * 4) return false; tile = tlo + (int)(L >> 2); pn = (int)(L & 3); }
        const int l = tile_l[tile], j = tile - toff[l]; u.pm = tile; u.pn = pn; u.e = l >> 1; u.sbase = l * NTOK + j * BM; u.nvalid = lcnt[l] - j * BM; return true;
    }
    __device__ __forceinline__ const char* a_base(const Unit& u) const { return GATHER ? (const char*)A : (const char*)A + (size_t)u.pm * BM * lda * 2; }
    __device__ __forceinline__ const char* b_base(const Unit& u) const { return (const char*)Bt + ((size_t)u.e * bt_expert_stride + (size_t)u.pn * BM * ldb) * 2; }
};

template <class Epi, class Sched, bool ALIGN_EPI>
__device__ __forceinline__ void gemm_phase(LAS unsigned char* lds, const Gemm g, const Sched& S, const Epi& E) {
    const int tid = threadIdx.x, wid = __builtin_amdgcn_readfirstlane(tid >> 6), lane = tid & 63, wr = wid >> 2, wc = wid & 3, fr = lane & 15, fq = lane >> 4;
    const int K = g.K, nt = K / BK;
    unsigned voffA[2], voffB[2]; int RA[2], CA2[2];
#pragma unroll
    for (int i = 0; i < 2; ++i) { int R, C; stage_rc(tid * 16 + i * 8192, R, C); RA[i] = R; CA2[i] = C * 2; const int Rb = Epi::PERM ? ((R & ~31) + perm32(R & 31)) : R;
        voffA[i] = (unsigned)(R * g.lda + C) * 2u; voffB[i] = (unsigned)(Rb * g.ldb + C) * 2u; }
    const size_t kstep = (size_t)(BK * 2);
    const size_t hstepA = (size_t)HALF * g.lda * 2, hstepB = (size_t)HALF * g.ldb * 2;
    const unsigned ldsw = (unsigned)wid * 1024u;
    const int aoff = lds_byte(wr * 64 + fr, fq * 8), boff = lds_byte(wc * 32 + fr, fq * 8);
#define PG8_SA(b, h) (((b) * 2 + (h)) * HTB)
#define PG8_SB(b, h) ((4 + (b) * 2 + (h)) * HTB)
#define PG8_STAGE(bufoff, gbase, voff) do { _Pragma("unroll") for (int _i = 0; _i < 2; ++_i) \
        __builtin_amdgcn_global_load_lds((const unsigned*)((const char*)(gbase) + (voff)[_i]), (LAS unsigned*)(lds + (bufoff) + ldsw + _i * 8192), 16, 0, 0); } while (0)
#define PG8_STAGE_A(bufoff, kptr, half, nx) do { if constexpr (Sched::GATHER) { _Pragma("unroll") for (int _i = 0; _i < 2; ++_i) \
        __builtin_amdgcn_global_load_lds((const unsigned*)((const char*)(kptr) + ((nx) ? vnx[half][_i] : vcu[half][_i])), (LAS unsigned*)(lds + (bufoff) + ldsw + _i * 8192), 16, 0, 0); } \
    else { PG8_STAGE(bufoff, (const char*)(kptr) + ((half) ? hstepA : 0), voffA); } } while (0)
#define PG8_LDA(dst, b, h) do { _Pragma("unroll") for (int m = 0; m < 4; ++m) _Pragma("unroll") for (int k = 0; k < 2; ++k) dst[m][k] = *(const LAS bf16x8*)(lds + PG8_SA(b, h) + aoff + m * 2048 + k * 1024); } while (0)
#define PG8_LDB(dst, b, h) do { _Pragma("unroll") for (int n = 0; n < 2; ++n) _Pragma("unroll") for (int k = 0; k < 2; ++k) dst[n][k] = *(const LAS bf16x8*)(lds + PG8_SB(b, h) + boff + n * 2048 + k * 1024); } while (0)
#define PG8_MMA(ai, bj, At, Bt) do { __builtin_amdgcn_s_setprio(1); _Pragma("unroll") for (int m = 0; m < 4; ++m) _Pragma("unroll") for (int n = 0; n < 2; ++n) _Pragma("unroll") for (int k = 0; k < 2; ++k) \
        acc[ai][bj][m][n] = __builtin_amdgcn_mfma_f32_16x16x32_bf16(Bt[n][k], At[m][k], acc[ai][bj][m][n], 0, 0, 0); __builtin_amdgcn_s_setprio(0); } while (0)
#define PG8_WAIT_V(n) asm volatile("s_waitcnt vmcnt(" #n ")" ::: "memory")
#define PG8_WAIT_L(n) asm volatile("s_waitcnt lgkmcnt(" #n ")" ::: "memory")
#define PG8_BAR __builtin_amdgcn_s_barrier()
#define PG8_SCHED __builtin_amdgcn_sched_barrier(0)
    Unit cur, nxt; int ui = 0;
    if (!S.next(0, cur)) return;
    f32x4 acc[2][2][4][2];
#pragma unroll
    for (int a = 0; a < 2; ++a)
#pragma unroll
        for (int b = 0; b < 2; ++b)
#pragma unroll
            for (int m = 0; m < 4; ++m)
#pragma unroll
                for (int n = 0; n < 2; ++n) acc[a][b][m][n] = (f32x4){0.f, 0.f, 0.f, 0.f};
    bf16x8 At[4][2], B0[2][2], B1[2][2];
    const char* cA = S.a_base(cur); const char* cB = S.b_base(cur);
    unsigned vcu[2][2], vnx[2][2];
    if constexpr (Sched::GATHER) {
#pragma unroll
        for (int hf = 0; hf < 2; ++hf)
#pragma unroll
            for (int i = 0; i < 2; ++i) { vcu[hf][i] = (unsigned)S.row_tok(cur, hf * HALF + RA[i]) * (unsigned)(g.lda * 2) + (unsigned)CA2[i]; vnx[hf][i] = vcu[hf][i]; } }
    if (GPROF_ON && blockIdx.x == 0 && threadIdx.x == 0) { volatile LAS unsigned* M_ = (volatile LAS unsigned*)(lds + (163840 - 2048)); for (int k_ = 0; k_ < 10; ++k_) M_[16 + k_] = 0; M_[15] = (unsigned)__builtin_amdgcn_s_memrealtime(); }
    PG8_STAGE(PG8_SB(0, 0), cB, voffB); PG8_STAGE(PG8_SB(0, 1), cB + hstepB, voffB); PG8_STAGE_A(PG8_SA(0, 0), cA, 0, false); PG8_STAGE_A(PG8_SA(0, 1), cA, 1, false);
    if (wr == 1) PG8_BAR;
    PG8_WAIT_V(2); PG8_BAR;
    PG8_STAGE(PG8_SB(1, 0), cB + kstep, voffB); PG8_STAGE_A(PG8_SA(1, 0), cA + kstep, 0, false); PG8_STAGE(PG8_SB(1, 1), cB + hstepB + kstep, voffB);
    PG8_WAIT_V(6); PG8_BAR;
    for (;;) {
        const bool has_next = S.next(ui + 1, nxt);
        const char* nA = has_next ? S.a_base(nxt) : cA; const char* nB = has_next ? S.b_base(nxt) : cB;
        if constexpr (Sched::GATHER) { if (has_next) {
#pragma unroll
            for (int hf = 0; hf < 2; ++hf)
#pragma unroll
                for (int i = 0; i < 2; ++i) vnx[hf][i] = (unsigned)S.row_tok(nxt, hf * HALF + RA[i]) * (unsigned)(g.lda * 2) + (unsigned)CA2[i]; } }
        for (int t = 0; t < nt; t += 2) {
            if constexpr (Epi::HAS_MID) { if (t == Epi::MID_T) E.mid(acc, cur, wr, wc, fr, fq); }
            const bool last = (t == nt - 2);
            const char* a1 = cA + (size_t)(t + 1) * kstep;
            const char* a2 = last ? nA : cA + (size_t)(t + 2) * kstep; const char* b2 = last ? nB : cB + (size_t)(t + 2) * kstep;
            const char* a3 = a2 + kstep; const char* b3 = b2 + kstep;
            PG8_LDB(B0, 0, 0); PG8_LDB(B1, 0, 1); PG8_SCHED; PG8_LDA(At, 0, 0); PG8_STAGE_A(PG8_SA(1, 1), a1, 1, false);
            PG8_WAIT_V(8); PG8_WAIT_L(0); PG8_BAR; PG8_MMA(0, 0, At, B0); PG8_MMA(0, 1, At, B1); PG8_BAR; PG8_SCHED;
            PG8_LDA(At, 0, 1); PG8_STAGE(PG8_SB(0, 0), b2, voffB); PG8_STAGE(PG8_SB(0, 1), b2 + hstepB, voffB); PG8_STAGE_A(PG8_SA(0, 0), a2, 0, last);
            PG8_WAIT_V(8); PG8_WAIT_L(0); PG8_BAR; PG8_MMA(1, 0, At, B0); PG8_MMA(1, 1, At, B1); PG8_BAR; PG8_SCHED;
            PG8_LDB(B0, 1, 0); PG8_LDB(B1, 1, 1); PG8_SCHED; PG8_LDA(At, 1, 0); PG8_STAGE_A(PG8_SA(0, 1), a2, 1, last);
            PG8_WAIT_V(8); PG8_WAIT_L(0); PG8_BAR; PG8_MMA(0, 0, At, B0); PG8_MMA(0, 1, At, B1); PG8_BAR; PG8_SCHED;
            PG8_LDA(At, 1, 1); PG8_STAGE(PG8_SB(1, 0), b3, voffB); PG8_STAGE(PG8_SB(1, 1), b3 + hstepB, voffB); PG8_STAGE_A(PG8_SA(1, 0), a3, 0, last);
            PG8_WAIT_V(8); PG8_WAIT_L(0); PG8_BAR; PG8_MMA(1, 0, At, B0); PG8_MMA(1, 1, At, B1); PG8_BAR; PG8_SCHED;
            if (GPROF_ON) { if (t == 0) GPROF(3); }
        }
        GPROF(0);
        if constexpr (ALIGN_EPI) { if (wr == 0) PG8_BAR; }
        GPROF(1);
        E(acc, cur, wr, wc, fr, fq);
        GPROF(2);
        if (!has_next) break;
#pragma unroll
        for (int a = 0; a < 2; ++a)
#pragma unroll
            for (int b = 0; b < 2; ++b)
#pragma unroll
                for (int m = 0; m < 4; ++m)
#pragma unroll
                    for (int n = 0; n < 2; ++n) acc[a][b][m][n] = (f32x4){0.f, 0.f, 0.f, 0.f};
        cur = nxt; cA = nA; cB = nB; ++ui;
        if constexpr (Sched::GATHER) {
#pragma unroll
            for (int hf = 0; hf < 2; ++hf)
#pragma unroll
                for (int i = 0; i < 2; ++i) vcu[hf][i] = vnx[hf][i]; }
        if constexpr (ALIGN_EPI) { if (wr == 1) PG8_BAR; }
    }
    PG8_WAIT_V(0);
    if constexpr (!ALIGN_EPI) { if (wr == 0) PG8_BAR; }
    PG8_BAR;
#undef PG8_SA
#undef PG8_SB
#undef PG8_STAGE
#undef PG8_STAGE_A
#undef PG8_LDA
#undef PG8_LDB
#undef PG8_MMA
#undef PG8_WAIT_V
#undef PG8_WAIT_L
#undef PG8_BAR
#undef PG8_SCHED
}

__device__ __forceinline__ unsigned q8(float x) { float s = sigmoidf_(x) * 255.f + 0.5f; s = s < 1.f ? 1.f : s; return (unsigned)s; }
struct EpiP {
    static constexpr bool PERM = true, HAS_MID = false;
    bf16_t *Prw, *Patt; unsigned char* Pgate;
    __device__ __forceinline__ void operator()(const f32x4 (&acc)[2][2][4][2], const Unit& u, int wr, int wc, int fr, int fq) const {
        const int row0 = u.pm * BM + wr * 64 + fr;
        if (u.pn >= 13) { const int col0 = (u.pn - 13) * BM + wc * 32 + 8 * fq;
#pragma unroll
            for (int ai = 0; ai < 2; ++ai)
#pragma unroll
                for (int m = 0; m < 4; ++m) { unsigned char* rowp = Pgate + (size_t)(row0 + ai * HALF + m * 16) * GCOLS + col0;
#pragma unroll
                    for (int bj = 0; bj < 2; ++bj) { const f32x4 v0 = acc[ai][bj][m][0], v1 = acc[ai][bj][m][1];
                        u32x2 w; w.x = q8(v0[0]) | (q8(v0[1]) << 8) | (q8(v0[2]) << 16) | (q8(v0[3]) << 24); w.y = q8(v1[0]) | (q8(v1[1]) << 8) | (q8(v1[2]) << 16) | (q8(v1[3]) << 24);
                        EPI_ST(u32x2, rowp + bj * HALF, w); } }
            return; }
        bf16_t* base; int ldc, colt;
        if (u.pn < 7) { base = Prw; ldc = RCOLS; colt = u.pn * BM; } else { base = Patt; ldc = ACOLS; colt = (u.pn - 7) * BM; }
        const int col0 = colt + wc * 32 + 8 * fq;
#pragma unroll
        for (int ai = 0; ai < 2; ++ai)
#pragma unroll
            for (int m = 0; m < 4; ++m) { bf16_t* rowp = base + (size_t)(row0 + ai * HALF + m * 16) * ldc + col0;
#pragma unroll
                for (int bj = 0; bj < 2; ++bj) { const f32x4 v0 = acc[ai][bj][m][0], v1 = acc[ai][bj][m][1];
                    u32x4 w; w.x = cvt_pk_bf16(v0[0], v0[1]); w.y = cvt_pk_bf16(v0[2], v0[3]); w.z = cvt_pk_bf16(v1[0], v1[1]); w.w = cvt_pk_bf16(v1[2], v1[3]);
                    EPI_ST(u32x4, rowp + bj * HALF, w); } }
    }
};
struct EpiMix {
    static constexpr bool PERM = true, HAS_MID = true; static constexpr int MID_T = 8;
    bf16_t* T; const unsigned char* Pgate;
    static __device__ __forceinline__ float ub(unsigned w, int i) { return (float)((w >> (8 * i)) & 0xffu); }
    __device__ __forceinline__ void mid(f32x4 (&acc)[2][2][4][2], const Unit& u, int wr, int wc, int fr, int fq) const {
        int row0 = u.pm * BM + wr * 64 + fr, col0 = u.pn * BM + wc * 32 + 8 * fq; asm volatile("" : "+v"(row0), "+v"(col0));
#pragma unroll
        for (int ai = 0; ai < 2; ++ai) {
            u32x2 gr[4][2], ga[4][2];
#pragma unroll
            for (int m = 0; m < 4; ++m) { const unsigned char* gp = Pgate + (size_t)(row0 + ai * HALF + m * 16) * GCOLS + col0;
#pragma unroll
                for (int bj = 0; bj < 2; ++bj) { gr[m][bj] = *(const u32x2*)(gp + bj * HALF); ga[m][bj] = *(const u32x2*)(gp + DM + bj * HALF); } }
#pragma unroll
            for (int m = 0; m < 4; ++m)
#pragma unroll
                for (int bj = 0; bj < 2; ++bj) { const u32x2 r = gr[m][bj], a = ga[m][bj]; f32x4& v0 = acc[ai][bj][m][0]; f32x4& v1 = acc[ai][bj][m][1];
#pragma unroll
                    for (int j = 0; j < 4; ++j) { v0[j] *= ub(r.x, j) * __builtin_amdgcn_rcpf(ub(a.x, j)); v1[j] *= ub(r.y, j) * __builtin_amdgcn_rcpf(ub(a.y, j)); } }
            asm volatile("" ::: "memory");
        }
    }
    __device__ __forceinline__ void operator()(const f32x4 (&acc)[2][2][4][2], const Unit& u, int wr, int wc, int fr, int fq) const {
        const int row0 = u.pm * BM + wr * 64 + fr, col0 = u.pn * BM + wc * 32 + 8 * fq;
        u32x2 ga[2][4][2];
#pragma unroll
        for (int ai = 0; ai < 2; ++ai)
#pragma unroll
            for (int m = 0; m < 4; ++m)
#pragma unroll
                for (int bj = 0; bj < 2; ++bj) ga[ai][m][bj] = *(const u32x2*)(Pgate + (size_t)(row0 + ai * HALF + m * 16) * GCOLS + DM + col0 + bj * HALF);
#pragma unroll
        for (int ai = 0; ai < 2; ++ai)
#pragma unroll
            for (int m = 0; m < 4; ++m) { const size_t row = (size_t)(row0 + ai * HALF + m * 16);
#pragma unroll
                for (int bj = 0; bj < 2; ++bj) { const int col = col0 + bj * HALF; const u32x2 g = ga[ai][m][bj]; constexpr float s = 1.f / 255.f;
                    const f32x4 a0 = acc[ai][bj][m][0], a1 = acc[ai][bj][m][1];
                    u32x4 w; w.x = cvt_pk_bf16(a0[0] * ub(g.x, 0) * s, a0[1] * ub(g.x, 1) * s); w.y = cvt_pk_bf16(a0[2] * ub(g.x, 2) * s, a0[3] * ub(g.x, 3) * s);
                    w.z = cvt_pk_bf16(a1[0] * ub(g.y, 0) * s, a1[1] * ub(g.y, 1) * s); w.w = cvt_pk_bf16(a1[2] * ub(g.y, 2) * s, a1[3] * ub(g.y, 3) * s);
                    EPI_ST0(u32x4, T + row * DM + col, w); } }
    }
};
struct EpiDelta {
    static constexpr bool PERM = true, HAS_MID = false;
    bf16_t* D; const float* mod; int scr = 0;
    __device__ __forceinline__ void operator()(const f32x4 (&acc)[2][2][4][2], const Unit& u, int wr, int wc, int fr, int fq) const {
        const int row0 = u.pm * BM + wr * 64 + fr, col0 = u.pn * BM + wc * 32 + 8 * fq;
        const int b = (u.pm * BM) / SEQ; const float* g1 = mod + (size_t)b * MODW + 2 * DM;
#ifdef SCR_PROBE
        if (scr) {
            bf16_t* base = D + (size_t)(u.pm * 4 + u.pn) * 65536 + (wr * 4 + wc) * 8192 + (fq * 16 + fr) * 8;
#pragma unroll
            for (int ai = 0; ai < 2; ++ai)
#pragma unroll
                for (int m = 0; m < 4; ++m)
#pragma unroll
                    for (int bj = 0; bj < 2; ++bj) { const f32x4 v0 = acc[ai][bj][m][0], v1 = acc[ai][bj][m][1];
                        u32x4 w; w.x = cvt_pk_bf16(v0[0], v0[1]); w.y = cvt_pk_bf16(v0[2], v0[3]); w.z = cvt_pk_bf16(v1[0], v1[1]); w.w = cvt_pk_bf16(v1[2], v1[3]);
                        *(u32x4*)(base + (ai * 8 + m * 2 + bj) * 512) = w; }
            return; }
#endif
        f32x4 gv[2][2];
#pragma unroll
        for (int bj = 0; bj < 2; ++bj)
#pragma unroll
            for (int n = 0; n < 2; ++n) gv[bj][n] = *(const f32x4*)(g1 + col0 + bj * HALF + 4 * n);
#pragma unroll
        for (int ai = 0; ai < 2; ++ai)
#pragma unroll
            for (int m = 0; m < 4; ++m) { bf16_t* rowp = D + (size_t)(row0 + ai * HALF + m * 16) * DM + col0;
#pragma unroll
                for (int bj = 0; bj < 2; ++bj) { const f32x4 v0 = acc[ai][bj][m][0] * gv[bj][0], v1 = acc[ai][bj][m][1] * gv[bj][1];
                    u32x4 w; w.x = cvt_pk_bf16(v0[0], v0[1]); w.y = cvt_pk_bf16(v0[2], v0[3]); w.z = cvt_pk_bf16(v1[0], v1[1]); w.w = cvt_pk_bf16(v1[2], v1[3]);
                    EPI_ST0(u32x4, rowp + bj * HALF, w); } }
    }
};
struct EpiHid {
    static constexpr bool PERM = true, HAS_MID = false;
    bf16_t* hid;
    __device__ __forceinline__ void operator()(const f32x4 (&acc)[2][2][4][2], const Unit& u, int wr, int wc, int fr, int fq) const {
        const int row0 = u.pm * BM + wr * 64 + fr, hc0 = u.pn * 128 + wc * 16 + 4 * fq;
#pragma unroll
        for (int ai = 0; ai < 2; ++ai)
#pragma unroll
            for (int m = 0; m < 4; ++m) { bf16_t* rowp = hid + (size_t)(row0 + ai * HALF + m * 16) * DE + hc0;
#pragma unroll
                for (int bj = 0; bj < 2; ++bj) { const f32x4 gt = acc[ai][bj][m][0], up = acc[ai][bj][m][1]; float h[4];
#pragma unroll
                    for (int j = 0; j < 4; ++j) h[j] = gt[j] * sigmoidf_(gt[j]) * up[j];
                    u32x2 w; w.x = cvt_pk_bf16(h[0], h[1]); w.y = cvt_pk_bf16(h[2], h[3]); EPI_ST0(u32x2, rowp + bj * 64, w); } }
    }
};
struct EpiY {
    static constexpr bool PERM = true, HAS_MID = false;
    bf16_t* Y; const float* slot_w;
    __device__ __forceinline__ void operator()(const f32x4 (&acc)[2][2][4][2], const Unit& u, int wr, int wc, int fr, int fq) const {
        const int row0 = u.pm * BM + wr * 64 + fr, col0 = u.pn * BM + wc * 32 + 8 * fq;
        float w[2][4];
#pragma unroll
        for (int ai = 0; ai < 2; ++ai)
#pragma unroll
            for (int m = 0; m < 4; ++m) { const int r = wr * 64 + fr + ai * HALF + m * 16; w[ai][m] = r < u.nvalid ? slot_w[u.sbase + r] : 0.f; }
#pragma unroll
        for (int ai = 0; ai < 2; ++ai)
#pragma unroll
            for (int m = 0; m < 4; ++m) { bf16_t* rowp = Y + (size_t)(row0 + ai * HALF + m * 16) * DM + col0; const float ws = w[ai][m];
#pragma unroll
                for (int bj = 0; bj < 2; ++bj) { const f32x4 v0 = acc[ai][bj][m][0] * ws, v1 = acc[ai][bj][m][1] * ws;
                    u32x4 o; o.x = cvt_pk_bf16(v0[0], v0[1]); o.y = cvt_pk_bf16(v0[2], v0[3]); o.z = cvt_pk_bf16(v1[0], v1[1]); o.w = cvt_pk_bf16(v1[2], v1[3]);
                    EPI_ST0(u32x4, rowp + bj * HALF, o); } }
    }
};
}
typedef GAS unsigned gu32;
#define RLX_AGENT __ATOMIC_RELAXED, __HIP_MEMORY_SCOPE_AGENT
#define LDS_WAIT() asm volatile("s_waitcnt lgkmcnt(0)" ::: "memory")
#define VM_WAIT() asm volatile("s_waitcnt vmcnt(0)" ::: "memory")
#define XB_TMO      128
#define XB_XCNT(j)  (256  + 64 * (j))
#define XB_XSUB(j)  (1280 + 64 * (j))
#define XB_XGEN(j)  (2304 + 64 * (j))
#define XB_TOP      3328
#define XB_TOPGEN   3392
#define XCD_BAR_WORDS 3456
#define XB_SPIN_CAP (1u << 18)

__device__ __forceinline__ unsigned xb_ld(unsigned* p)              { return __hip_atomic_load(p, __ATOMIC_RELAXED, __HIP_MEMORY_SCOPE_AGENT); }
__device__ __forceinline__ unsigned xb_add(unsigned* p, unsigned v) { return __hip_atomic_fetch_add(p, v, __ATOMIC_RELAXED, __HIP_MEMORY_SCOPE_AGENT); }
__device__ __forceinline__ unsigned xb_xcc_id() { return (unsigned)__builtin_amdgcn_s_getreg((3 << 11) | 20) & 0xFu; }
#define XB_SPIN(cond, bar) do { unsigned _sp = 0; while (cond) { __builtin_amdgcn_s_sleep(1); \
    if ((++_sp & 255u) == 0u) { if (xb_ld(&(bar)[XB_TMO])) break; if (_sp > XB_SPIN_CAP) { atomicAdd(&(bar)[XB_TMO], 1u); break; } } } } while (0)

struct XcdBarrier {
    unsigned* bar; unsigned x;
    volatile LAS unsigned* st;
};

__device__ __forceinline__ XcdBarrier xcd_barrier_post(unsigned* bar, volatile LAS unsigned* st) {
    XcdBarrier b; b.bar = bar; b.x = xb_xcc_id(); b.st = st;
    if (threadIdx.x == 0) (void)xb_add(&bar[XB_XCNT(b.x)], 1u);
    return b;
}
__device__ __forceinline__ void xcd_barrier_complete(unsigned* bar, unsigned x, unsigned& nloc, unsigned& nx) {
    const unsigned G = gridDim.x * gridDim.y * gridDim.z;
    unsigned sum, cnt, mine, sp = 0u;
    for (;;) {
        sum = 0u; cnt = 0u; mine = 0u;
#pragma unroll
        for (unsigned j = 0; j < 16; ++j) { const unsigned c = xb_ld(&bar[XB_XCNT(j)]); sum += c; cnt += (c > 0u) ? 1u : 0u; mine = (j == x) ? c : mine; }
        if (sum == G) break;
        __builtin_amdgcn_s_sleep(1);
        if ((++sp & 255u) == 0u) { if (xb_ld(&bar[XB_TMO])) break; if (sp > XB_SPIN_CAP) { atomicAdd(&bar[XB_TMO], 1u); break; } }
    }
    nloc = mine > 0u ? mine : 1u; nx = cnt > 0u ? cnt : 1u;
}

__device__ __forceinline__ void xcd_barrier(const XcdBarrier& b) {
    asm volatile("s_waitcnt vmcnt(0)" ::: "memory");
    __syncthreads();
    if (threadIdx.x == 0) {
        unsigned* bar = b.bar;
        __builtin_amdgcn_s_waitcnt(0);
        unsigned nloc = b.st[0], nx = b.st[1];
        if (nloc == 0u) { xcd_barrier_complete(bar, b.x, nloc, nx); b.st[0] = nloc; b.st[1] = nx; }
        const unsigned old = xb_add(&bar[XB_XSUB(b.x)], 1u);
        const unsigned gen = old / nloc;
        if (old + 1u == (gen + 1u) * nloc) {
            __builtin_amdgcn_fence(__ATOMIC_RELEASE, "agent");
            asm volatile("s_waitcnt vmcnt(0)" ::: "memory");
            const unsigned og = xb_add(&bar[XB_TOP], 1u);
            const unsigned tg = og / nx;
            if (og + 1u == (tg + 1u) * nx) xb_add(&bar[XB_TOPGEN], 1u);
            else XB_SPIN(xb_ld(&bar[XB_TOPGEN]) == tg, bar);
            __builtin_amdgcn_fence(__ATOMIC_ACQUIRE, "agent");
            xb_add(&bar[XB_XGEN(b.x)], 1u);
            asm volatile("s_waitcnt vmcnt(0)" ::: "memory");
        } else {
            XB_SPIN(xb_ld(&bar[XB_XGEN(b.x)]) == gen, bar);
            __builtin_amdgcn_fence(__ATOMIC_ACQUIRE, "agent");
            asm volatile("s_waitcnt vmcnt(0)" ::: "memory");
        }
    }
    __syncthreads();
}

constexpr int NWAVES = 8;
constexpr size_t MiB = 1u << 20, KiB = 1u << 10;
constexpr size_t WS_CTL = 0, CTL_ZERO_BYTES = 2 * MiB;
constexpr size_t WS_MOD = 1 * MiB;
constexpr size_t WS_WIN = 2 * MiB;
constexpr size_t WS_WBR = 12 * MiB + 512 * KiB, WS_WBA = 13 * MiB + 512 * KiB, WS_WOUT = 14 * MiB + 512 * KiB;
constexpr size_t WS_WUP = 16 * MiB + 512 * KiB, WS_AUP = WS_WUP + 64 * KiB, WS_GUP = WS_WUP + 128 * KiB;
constexpr size_t WS_WRH = 16 * MiB + 768 * KiB, WS_WRL = WS_WRH + 128 * KiB;
constexpr size_t WS_CB = 17 * MiB, WS_GAM2 = 17 * MiB + 64 * KiB;
constexpr size_t WS_PRW = 18 * MiB, WS_PATT = 130 * MiB, WS_PGATE = 226 * MiB;
constexpr size_t WS_WGU = 130 * MiB, WS_WD = 290 * MiB;
constexpr size_t WS_T = 18 * MiB;
constexpr size_t WS_HID = 18 * MiB, WS_DELTA = 226 * MiB, WS_H2 = 354 * MiB;
constexpr size_t WS_SLOTTOK = 98 * MiB, WS_SLOTW = 106 * MiB, WS_TOKLIST = 114 * MiB,
    WS_TOKPOS = WS_TOKLIST + 256 * KiB, WS_TOKW = WS_TOKLIST + 512 * KiB;
constexpr size_t WS_QE = 354 * MiB, WS_YLOC = 386 * MiB, WS_PC = 418 * MiB, WS_SLOC = 450 * MiB;
constexpr size_t WS_YB = 322 * MiB;
constexpr size_t WS_END = 512 * MiB;
constexpr size_t DO_H = 0, DO_G = 0, DO_SC = 32 * MiB, DO_YRA = 64 * MiB;
constexpr int NSLOT_MAX = 2 * NTOK + NLIST * 256;
constexpr int CW_TMO = 0, CW_BAR = 4096, CW_CNT = 16384;
constexpr int LDS_BYTES = 163840, RING_BYTES = 131072;
constexpr int LDSCTL_OFF = LDS_BYTES - 2048, MISC_OFF = LDSCTL_OFF;
constexpr int TOFF_OFF = LDSCTL_OFF + 256, LCNT_OFF = TOFF_OFF + 264, TILE_L_OFF = LCNT_OFF + 256;

#define LBAR() do { asm volatile("s_waitcnt lgkmcnt(0)" ::: "memory"); __builtin_amdgcn_s_barrier(); asm volatile("" ::: "memory"); } while (0)
struct Frame {
    LAS unsigned char* lds; volatile LAS unsigned* MISC; gu32* ctl;
    int tid, lane, wave, vcu, G;
};
__device__ __forceinline__ float wave_sum(float v) {
#pragma unroll
    for (int o = 1; o < 64; o <<= 1) v += __shfl_xor(v, o);
    return v;
}
__device__ __forceinline__ float dpp_f(float x, const int ctrl_sel) {
    const int xi = __builtin_bit_cast(int, x); int r;
    if (ctrl_sel == 0) r = __builtin_amdgcn_update_dpp(0, xi, 0xB1, 0xf, 0xf, true);
    else if (ctrl_sel == 1) r = __builtin_amdgcn_update_dpp(0, xi, 0x4E, 0xf, 0xf, true);
    else r = __builtin_amdgcn_update_dpp(0, xi, 0x141, 0xf, 0xf, true);
    return __builtin_bit_cast(float, r);
}
__device__ __forceinline__ float red8(float x) { x += dpp_f(x, 0); x += dpp_f(x, 1); x += dpp_f(x, 2); return x; }

__device__ __forceinline__ void phase_mod(Frame& F, const float* c, const float* w_ada, const float* b_ada, float* mod) {
    const int gw = F.vcu * NWAVES + F.wave, NGW = F.G * NWAVES;
    for (int task = gw; task < 96 * 16; task += NGW) {
        const int nc = task % 96, ks = task / 96, n = nc * 64 + F.lane, k0 = ks * 64;
        float acc[16];
#pragma unroll
        for (int b = 0; b < 16; ++b) acc[b] = 0.f;
        LAS float* sl = (LAS float*)(F.lds) + F.wave * 1024;
#pragma unroll
        for (int j = 0; j < 16; ++j) { const float cv = c[(F.lane & 15) * DM + k0 + (F.lane >> 4) + 4 * j]; sl[((F.lane >> 4) + 4 * j) * 16 + (F.lane & 15)] = cv * sigmoidf_(cv); }
        LDS_WAIT(); asm volatile("" ::: "memory");
#pragma unroll 4
        for (int kk = 0; kk < 64; ++kk) { const float w = __builtin_nontemporal_load(w_ada + (size_t)(k0 + kk) * MODW + n);
            const f32x4 s0 = *(const LAS f32x4*)(sl + kk * 16), s1 = *(const LAS f32x4*)(sl + kk * 16 + 4), s2 = *(const LAS f32x4*)(sl + kk * 16 + 8), s3 = *(const LAS f32x4*)(sl + kk * 16 + 12);
            acc[0] += s0.x * w; acc[1] += s0.y * w; acc[2] += s0.z * w; acc[3] += s0.w * w; acc[4] += s1.x * w; acc[5] += s1.y * w; acc[6] += s1.z * w; acc[7] += s1.w * w;
            acc[8] += s2.x * w; acc[9] += s2.y * w; acc[10] += s2.z * w; acc[11] += s2.w * w; acc[12] += s3.x * w; acc[13] += s3.y * w; acc[14] += s3.z * w; acc[15] += s3.w * w; }
        LDS_WAIT(); asm volatile("" ::: "memory");
#pragma unroll
        for (int b = 0; b < 16; ++b) { const float v = acc[b] + (ks == 0 ? b_ada[n] : 0.f); atomicAdd(mod + (size_t)b * MODW + n, v); }
    }
}

template <int MODE, bool NTS = false> __device__ __forceinline__ void transpose_item(const float* W, int K, int N, bf16_t* WT, int row_off, int item, int lane, int ldt = 0, int koff = 0) {
    if (ldt == 0) ldt = K;
    const int nblk = N / 32, kb = item / nblk, nb = item % nblk, k0 = 64 * kb + 8 * (lane >> 3), n0 = 32 * nb + 4 * (lane & 7);
    f32x4 v[8];
#pragma unroll
    for (int i = 0; i < 8; ++i) v[i] = __builtin_nontemporal_load((const f32x4*)(W + (size_t)(k0 + i) * N + n0));
#pragma unroll
    for (int j = 0; j < 4; ++j) { const int ng = n0 + j; const int nr = MODE == 0 ? row_off + ng : (MODE == 1 ? 8 * (ng >> 2) + (ng & 3) : 8 * (ng >> 2) + 4 + (ng & 3));
        u32x4 o; o.x = cvt_pk_bf16(v[0][j], v[1][j]); o.y = cvt_pk_bf16(v[2][j], v[3][j]); o.z = cvt_pk_bf16(v[4][j], v[5][j]); o.w = cvt_pk_bf16(v[6][j], v[7][j]);
        if (MODE == 0 && !NTS) *(GAS u32x4*)(WT + (size_t)nr * ldt + koff + k0) = o; else __builtin_nontemporal_store(o, (GAS u32x4*)(WT + (size_t)nr * ldt + koff + k0)); }
}

struct Args { const float* in[31]; float* out; unsigned char* ws; int ph_lo, ph_hi, scr; };
struct Ptrs { const float* in[31]; float* out; unsigned char* ws; };

__device__ __forceinline__ void phase_prep(Frame& F, const Ptrs& P) {
    const int gw = F.vcu * NWAVES + F.wave, NGW = F.G * NWAVES;
    const float* mod = (const float*)(P.ws + WS_MOD);
    bf16_t* Win_t = (bf16_t*)(P.ws + WS_WIN); bf16_t* Wbr_t = (bf16_t*)(P.ws + WS_WBR); bf16_t* Wba_t = (bf16_t*)(P.ws + WS_WBA); bf16_t* Wout_t = (bf16_t*)(P.ws + WS_WOUT);
    bf16_t* wup_t = (bf16_t*)(P.ws + WS_WUP); bf16_t* aup_t = (bf16_t*)(P.ws + WS_AUP); bf16_t* gup_t = (bf16_t*)(P.ws + WS_GUP);
    constexpr int I_IN = 16 * (INCOLS / 32), I_BR = 8 * 32, I_OUT = 16 * 32, I_UP = 16, I_GUP = 2 * 16;
    constexpr int NITEMS = I_IN + 2 * I_BR + I_OUT + 2 * I_UP + I_GUP;
    for (int it = gw; it < NITEMS; it += NGW) {
        int r = it;
        if (r < I_IN) { transpose_item<0>(P.in[5], DM, INCOLS, Win_t, 0, r, F.lane); continue; } r -= I_IN;
        if (r < I_BR) { transpose_item<0>(P.in[20], 512, DM, Wbr_t, 0, r, F.lane, DM, 0); continue; } r -= I_BR;
        if (r < I_BR) { transpose_item<0>(P.in[21], 512, DM, Wbr_t, 0, r, F.lane, DM, 512); continue; } r -= I_BR;
        if (r < I_OUT) { transpose_item<0>(P.in[22], DM, DM, Wout_t, 0, r, F.lane); continue; } r -= I_OUT;
        if (r < I_UP) { transpose_item<0>(P.in[8], 64, 512, wup_t, 0, r, F.lane); continue; } r -= I_UP;
        if (r < I_UP) { transpose_item<0>(P.in[10], 64, 512, aup_t, 0, r, F.lane); continue; } r -= I_UP;
        transpose_item<0>(P.in[11], 128, 512, gup_t, 0, r, F.lane);
    }
    { bf16_t* wrh = (bf16_t*)(P.ws + WS_WRH); bf16_t* wrl = (bf16_t*)(P.ws + WS_WRL);
      for (int idx = (F.vcu * NWAVES * 64 + F.tid); idx < 64 * DM; idx += F.G * NWAVES * 64) { const int o = idx / DM, k = idx % DM;
          const float w = o < 4 ? P.in[24][k * 4 + o] : (o < 36 ? P.in[26][k * 32 + (o - 4)] : 0.f);
          const unsigned hi = cvt_pk_bf16(w, 0.f) & 0xffffu; const float rem = w - __uint_as_float(hi << 16); const unsigned lo = cvt_pk_bf16(rem, 0.f) & 0xffffu;
          wrh[idx] = (bf16_t)hi; wrl[idx] = (bf16_t)lo; } }
    { float* gam2 = (float*)(P.ws + WS_GAM2);
      for (int idx = (F.vcu * NWAVES * 64 + F.tid); idx < NB * DM; idx += F.G * NWAVES * 64) { const int b = idx / DM, k = idx % DM; gam2[idx] = P.in[23][k] * (1.f + mod[(size_t)b * MODW + 4 * DM + k]); } }
    { float* cb = (float*)(P.ws + WS_CB);
      for (int t = gw; t < NB * 36; t += NGW) { const int b = t / 36, o = t % 36; float s = 0.f;
          for (int k = F.lane; k < DM; k += 64) { const float w = o < 4 ? P.in[24][k * 4 + o] : P.in[26][k * 32 + (o - 4)]; s += mod[(size_t)b * MODW + 3 * DM + k] * w; }
          s = wave_sum(s); if (F.lane == 0) cb[b * 64 + o] = s + (o < 4 ? P.in[25][o] : P.in[27][o - 4]); } }
    bf16_t* H = (bf16_t*)((unsigned char*)P.out + DO_H);
    for (int m0 = gw * 4; m0 < NTOK; m0 += NGW * 4) {
        f32x4 v[4][4];
#pragma unroll
        for (int r = 0; r < 4; ++r) { const GAS f32x4* xr = (const GAS f32x4*)(P.in[0] + (size_t)(m0 + r) * DM) + F.lane;
#pragma unroll
            for (int j = 0; j < 4; ++j) v[r][j] = __builtin_nontemporal_load(xr + 64 * j); }
        const int b = m0 / SEQ; const float* sh = mod + (size_t)b * MODW; const float* sc = sh + DM;
        f32x4 gs[4], hs[4];
#pragma unroll
        for (int j = 0; j < 4; ++j) { const int k = 4 * F.lane + 256 * j; const f32x4 g = *(const f32x4*)(P.in[4] + k), s1 = *(const f32x4*)(sc + k); gs[j] = g * (s1 + 1.f); hs[j] = *(const f32x4*)(sh + k); }
#pragma unroll
        for (int r = 0; r < 4; ++r) { float s = 0.f;
#pragma unroll
            for (int j = 0; j < 4; ++j) s += (v[r][j].x * v[r][j].x + v[r][j].y * v[r][j].y) + (v[r][j].z * v[r][j].z + v[r][j].w * v[r][j].w);
            const float rinv = 1.f / sqrtf(wave_sum(s) * (1.f / DM) + 1e-6f);
            GAS u32x2* o8 = (GAS u32x2*)(H + (size_t)(m0 + r) * DM) + F.lane;
#pragma unroll
            for (int j = 0; j < 4; ++j) { const f32x4 hv = v[r][j] * rinv * gs[j] + hs[j]; u32x2 w; w.x = cvt_pk_bf16(hv.x, hv.y); w.y = cvt_pk_bf16(hv.z, hv.w); o8[64 * j] = w; } }
    }
}
__device__ __forceinline__ void expert_convert(Frame& F, const Ptrs& P, int wv, int nwv, int it_lo, int it_hi) {
    bf16_t* Wgu = (bf16_t*)(P.ws + WS_WGU);
    constexpr int I_G = 16 * 16;
    for (int it = it_lo + wv; it < it_hi; it += nwv) {
        const int e = it / (2 * I_G), r = it % (2 * I_G);
        if (r < I_G) transpose_item<1>(P.in[28] + (size_t)e * DM * DE, DM, DE, Wgu + (size_t)e * DM * DM, 0, r, F.lane);
        else transpose_item<2>(P.in[29] + (size_t)e * DM * DE, DM, DE, Wgu + (size_t)e * DM * DM, 0, r - I_G, F.lane);
    }
}
__device__ __forceinline__ void expert_convert_down(Frame& F, const Ptrs& P, int wv, int nwv) {
    bf16_t* Wd = (bf16_t*)(P.ws + WS_WD);
    for (int it = wv; it < NE * 256; it += nwv) { const int e = it >> 8, r = it & 255; transpose_item<0, true>(P.in[30] + (size_t)e * DE * DM, DE, DM, Wd + (size_t)e * DM * DE, 0, r, F.lane); }
}
namespace att {
constexpr int SLOT = 16384, NSL = 5, L_WS = NSL * SLOT, L_OST = L_WS + 8 * 256, L_BIAS = L_OST + 8 * 4096, L_END = L_BIAS + 1280;
__device__ __forceinline__ int crow(int r, int hi) { return (r & 3) + 8 * (r >> 2) + 4 * hi; }
__device__ __forceinline__ float max3f(float a, float b, float c) { return fmaxf(fmaxf(a, b), c); }
__device__ __forceinline__ s16x4 vtr(const LAS char* p) { return __builtin_bit_cast(s16x4, __builtin_amdgcn_ds_read_tr16_b64_v4i16((LAS s16x4*)p)); }

__device__ __forceinline__ void attn_unit(Frame& F, const Ptrs& P, int b, int h, int qb) {
    const int tid = F.tid, lane = F.lane, wid = F.wave, r32 = lane & 31, hi = lane >> 5;
    const bf16_t* Patt = (const bf16_t*)(P.ws + WS_PATT);
    bf16_t* Ya = (bf16_t*)((unsigned char*)P.out + DO_YRA) + 512;
    LAS char* lds = (LAS char*)F.lds;
    LAS float* wsf = (LAS float*)(lds + L_WS) + wid * 64;
    LAS float* biasL = (LAS float*)(lds + L_BIAS);
    const int cq = wid >> 1, ci = qb * 4 + cq, kc0 = qb * 4 - 8;
    const size_t rowbase = (size_t)b * SEQ;
    for (int i = tid; i < 257; i += 512) biasL[i] = P.in[19][h * 257 + i] * LOG2E;
    const int srow = tid >> 3, sc8 = tid & 7;
    f32x4 kg0 = *(const f32x4*)(P.in[18] + 8 * sc8), kg1 = *(const f32x4*)(P.in[18] + 8 * sc8 + 4);
    const int kdst = sc8 * 1024 + srow * 16, vdst = 8192 + (sc8 >> 2) * 4096 + (srow >> 4) * 1024 + (srow & 15) * 64 + (sc8 & 3) * 16;
    auto ld_k = [&](int j) -> u32x4 { return *(const u32x4*)(Patt + (rowbase + (size_t)(kc0 + j) * 64 + srow) * ACOLS + 512 + h * 64 + 8 * sc8); };
    auto ld_v = [&](int j) -> u32x4 { return *(const u32x4*)(Patt + (rowbase + (size_t)(kc0 + j) * 64 + srow) * ACOLS + 1024 + h * 64 + 8 * sc8); };
    auto st_kv = [&](int j, u32x4 kw, u32x4 vw) {
        float kf[8] = {bf_lo(kw.x), bf_hi(kw.x), bf_lo(kw.y), bf_hi(kw.y), bf_lo(kw.z), bf_hi(kw.z), bf_lo(kw.w), bf_hi(kw.w)};
        float ss = 0.f;
#pragma unroll
        for (int i = 0; i < 8; ++i) ss += kf[i] * kf[i];
        ss = red8(ss); const float rk = 1.f / sqrtf(ss * (1.f / 64.f) + 1e-6f);
        u32x4 o; o.x = cvt_pk_bf16(kf[0] * rk * kg0.x, kf[1] * rk * kg0.y); o.y = cvt_pk_bf16(kf[2] * rk * kg0.z, kf[3] * rk * kg0.w);
        o.z = cvt_pk_bf16(kf[4] * rk * kg1.x, kf[5] * rk * kg1.y); o.w = cvt_pk_bf16(kf[6] * rk * kg1.z, kf[7] * rk * kg1.w);
        LAS char* sl = lds + (j % NSL) * SLOT;
        *(LAS u32x4*)(sl + kdst) = o; *(LAS u32x4*)(sl + vdst) = vw; };
    { u32x4 kws[4], vws[4];
#pragma unroll
      for (int j = 0; j < 4; ++j) if (kc0 + j >= 0) { kws[j] = ld_k(j); vws[j] = ld_v(j); }
#pragma unroll
      for (int j = 0; j < 4; ++j) if (kc0 + j >= 0) st_kv(j, kws[j], vws[j]); }
    const size_t qrow = rowbase + (size_t)ci * 64 + (wid & 1) * 32 + r32;
    bf16x8 qr[4];
    { float qf[4][8]; float ss = 0.f;
#pragma unroll
      for (int d0 = 0; d0 < 4; ++d0) { const u32x4 w = *(const u32x4*)(Patt + qrow * ACOLS + h * 64 + d0 * 16 + hi * 8);
          qf[d0][0] = bf_lo(w.x); qf[d0][1] = bf_hi(w.x); qf[d0][2] = bf_lo(w.y); qf[d0][3] = bf_hi(w.y); qf[d0][4] = bf_lo(w.z); qf[d0][5] = bf_hi(w.z); qf[d0][6] = bf_lo(w.w); qf[d0][7] = bf_hi(w.w);
#pragma unroll
          for (int i = 0; i < 8; ++i) ss += qf[d0][i] * qf[d0][i]; }
      ss += __shfl_xor(ss, 32);
      const float rq = (0.125f * LOG2E) / sqrtf(ss * (1.f / 64.f) + 1e-6f);
#pragma unroll
      for (int d0 = 0; d0 < 4; ++d0) { const f32x4 g0 = *(const f32x4*)(P.in[17] + d0 * 16 + hi * 8), g1 = *(const f32x4*)(P.in[17] + d0 * 16 + hi * 8 + 4);
          u32x4 o; o.x = cvt_pk_bf16(qf[d0][0] * rq * g0.x, qf[d0][1] * rq * g0.y); o.y = cvt_pk_bf16(qf[d0][2] * rq * g0.z, qf[d0][3] * rq * g0.w);
          o.z = cvt_pk_bf16(qf[d0][4] * rq * g1.x, qf[d0][5] * rq * g1.y); o.w = cvt_pk_bf16(qf[d0][6] * rq * g1.z, qf[d0][7] * rq * g1.w);
          qr[d0] = __builtin_bit_cast(bf16x8, o); } }
    u32x4 kA, vA; if (kc0 + 4 >= 0) { kA = ld_k(4); vA = ld_v(4); }
    float mrun = 0.f, lrun = 0.f; f32x16 o0 = {}, o1 = {};
    const int qloc = (wid & 1) * 32 + r32;
    __syncthreads();
#pragma unroll 1
    for (int s = 0; s < 9; ++s) {
        const int jn = s + 4; const bool ld = (jn <= 11) && (kc0 + jn >= 0);
        const bool ldn = (jn + 1 <= 11) && (kc0 + jn + 1 >= 0); u32x4 kB, vB; if (ldn) { kB = ld_k(jn + 1); vB = ld_v(jn + 1); }
        const int j = cq + s;
        if (kc0 + j >= 0) {
            const LAS char* sl = lds + (j % NSL) * SLOT;
            f32x16 p0, p1;
            if (s <= 5) { const float c0 = biasL[0] - mrun;
#pragma unroll
                for (int r = 0; r < 16; ++r) { p0[r] = c0; p1[r] = c0; } }
            else { const int base = 64 * (s - 8) - qloc + 128;
#pragma unroll
                for (int r = 0; r < 16; ++r) { int i0 = base + crow(r, hi), i1 = i0 + 32; i0 = i0 < 0 ? 0 : (i0 > 256 ? 256 : i0); i1 = i1 < 0 ? 0 : (i1 > 256 ? 256 : i1); p0[r] = biasL[i0] - mrun; p1[r] = biasL[i1] - mrun; } }
            const LAS char* kb = sl + hi * 1024 + r32 * 16;
#pragma unroll
            for (int d0 = 0; d0 < 4; ++d0) { const bf16x8 b0 = *(const LAS bf16x8*)(kb + d0 * 2048), b1 = *(const LAS bf16x8*)(kb + d0 * 2048 + 512);
                p0 = __builtin_amdgcn_mfma_f32_32x32x16_bf16(b0, qr[d0], p0, 0, 0, 0); p1 = __builtin_amdgcn_mfma_f32_32x32x16_bf16(b1, qr[d0], p1, 0, 0, 0); }
            float a = max3f(p0[0], p0[1], p1[0]), bm = max3f(p0[2], p0[3], p1[1]); a = max3f(a, p1[2], p1[3]);
#pragma unroll
            for (int r = 4; r < 16; r += 4) { a = max3f(a, p0[r], p0[r + 1]); bm = max3f(bm, p0[r + 2], p0[r + 3]); a = max3f(a, p1[r], p1[r + 1]); bm = max3f(bm, p1[r + 2], p1[r + 3]); }
            float rm = fmaxf(a, bm); rm = fmaxf(rm, __shfl_xor(rm, 32));
            if (__any(rm > 8.f)) {
                const float dl = fmaxf(rm, 0.f), f = __builtin_amdgcn_exp2f(-dl); mrun += dl; lrun *= f;
#pragma unroll
                for (int r = 0; r < 16; ++r) { p0[r] -= dl; p1[r] -= dl; }
                if (hi == 0) wsf[r32] = f;
                LDS_WAIT(); asm volatile("" ::: "memory");
#pragma unroll
                for (int r = 0; r < 16; ++r) { const float fr_ = wsf[crow(r, hi)]; o0[r] *= fr_; o1[r] *= fr_; }
            }
            float sacc = 0.f;
#pragma unroll
            for (int r = 0; r < 16; ++r) { p0[r] = __builtin_amdgcn_exp2f(p0[r]); p1[r] = __builtin_amdgcn_exp2f(p1[r]); sacc += p0[r] + p1[r]; }
            lrun += sacc;
            u32x4 pw0, pw1, pw2, pw3;
            pw0 = (u32x4){cvt_pk_bf16(p0[0], p0[1]), cvt_pk_bf16(p0[2], p0[3]), cvt_pk_bf16(p0[4], p0[5]), cvt_pk_bf16(p0[6], p0[7])};
            pw1 = (u32x4){cvt_pk_bf16(p0[8], p0[9]), cvt_pk_bf16(p0[10], p0[11]), cvt_pk_bf16(p0[12], p0[13]), cvt_pk_bf16(p0[14], p0[15])};
            pw2 = (u32x4){cvt_pk_bf16(p1[0], p1[1]), cvt_pk_bf16(p1[2], p1[3]), cvt_pk_bf16(p1[4], p1[5]), cvt_pk_bf16(p1[6], p1[7])};
            pw3 = (u32x4){cvt_pk_bf16(p1[8], p1[9]), cvt_pk_bf16(p1[10], p1[11]), cvt_pk_bf16(p1[12], p1[13]), cvt_pk_bf16(p1[14], p1[15])};
            const LAS char* vp = sl + 8192 + ((lane >> 4) & 1) * 32 + (lane & 3) * 8 + (4 * hi + ((lane & 15) >> 2)) * 64;
            const bf16x8 pa[4] = {__builtin_bit_cast(bf16x8, pw0), __builtin_bit_cast(bf16x8, pw1), __builtin_bit_cast(bf16x8, pw2), __builtin_bit_cast(bf16x8, pw3)};
#pragma unroll
            for (int ks = 0; ks < 4; ++ks) {
                const s16x4 l0 = vtr(vp + ks * 1024), h0 = vtr(vp + ks * 1024 + 512), l1 = vtr(vp + 4096 + ks * 1024), h1 = vtr(vp + 4096 + ks * 1024 + 512);
                const bf16x8 v0 = (bf16x8){l0[0], l0[1], l0[2], l0[3], h0[0], h0[1], h0[2], h0[3]}, v1 = (bf16x8){l1[0], l1[1], l1[2], l1[3], h1[0], h1[1], h1[2], h1[3]};
                o0 = __builtin_amdgcn_mfma_f32_32x32x16_bf16(pa[ks], v0, o0, 0, 0, 0); o1 = __builtin_amdgcn_mfma_f32_32x32x16_bf16(pa[ks], v1, o1, 0, 0, 0); }
        }
        if (ld) st_kv(jn, kA, vA);
        LBAR();
        kA = kB; vA = vB;
    }
    lrun += __shfl_xor(lrun, 32);
    if (hi == 0) wsf[32 + r32] = lrun;
    LDS_WAIT(); asm volatile("" ::: "memory");
    LAS bf16_t* stg = (LAS bf16_t*)(lds + L_OST) + wid * 2048;
#pragma unroll
    for (int r = 0; r < 16; ++r) { const int orow = crow(r, hi); const float rl = __builtin_amdgcn_rcpf(wsf[32 + orow]);
        stg[orow * 64 + r32] = (bf16_t)(cvt_pk_bf16(o0[r] * rl, 0.f) & 0xffffu); stg[orow * 64 + 32 + r32] = (bf16_t)(cvt_pk_bf16(o1[r] * rl, 0.f) & 0xffffu); }
    LDS_WAIT(); asm volatile("" ::: "memory");
    bf16_t* Ow = Ya + (rowbase + (size_t)ci * 64 + (wid & 1) * 32) * 1024 + h * 64;
#pragma unroll
    for (int i = 0; i < 4; ++i) { const int row = i * 8 + (lane >> 3), ch = lane & 7; const u32x4 v = *(const LAS u32x4*)(stg + row * 64 + ch * 8); *(u32x4*)(Ow + (size_t)row * 1024 + ch * 8) = v; }
    __syncthreads();
}
}

#ifndef TIME_PHASE
#define TIME_PHASE -1
#endif
#define PROF(k) do { if (TIME_PHASE >= 20 && blockIdx.x == 0 && F.tid == 0) { const unsigned now_ = (unsigned)__builtin_amdgcn_s_memrealtime(); F.MISC[16 + (k)] += now_ - F.MISC[15]; F.MISC[15] = now_; } } while (0)
namespace rc {
constexpr int LDB = 72, MB = 64 * LDB * 2;
constexpr int FLD = 68, FB = 64 * FLD * 4;
constexpr int L_AT = 0, L_BH = MB, L_BT = 2 * MB, L_KT = 3 * MB, L_RT = 4 * MB, L_KH = 5 * MB, L_V = 6 * MB;
constexpr int L_TWD = 0, L_AD = 9216, L_SGD = 18432;
constexpr int RB = 8 * MB;
constexpr int L_WL = RB, L_AL = RB + FB, L_GL = RB + 2 * FB, L_SEG = RB + 3 * FB;
constexpr int L_NQ0 = RB, L_NQ1 = RB + MB, L_NT0 = RB + 2 * MB, L_NT1 = RB + 3 * MB, L_TQ0 = RB + 4 * MB, L_TQ1 = RB + 5 * MB, L_NKT = RB + 6 * MB, L_NRB = RB + 7 * MB;
constexpr int L_GLD = RB + 8 * MB;
constexpr int L_W1T = L_NQ0, L_W2T = L_NT0, L_WY = L_AT, L_KC = L_BT;
constexpr int L_TAB = L_GLD + 256;
constexpr int T_MUL = 0, T_MUR = 256, T_PAR = 448, T_N = 832;
static_assert(L_SEG + 2048 <= L_GLD && L_TAB + T_N * 4 <= LDSCTL_OFF, "rwkv chunk LDS");

__device__ __forceinline__ void unpack8(const u32x4 w, float* f) { f[0] = bf_lo(w.x); f[1] = bf_hi(w.x); f[2] = bf_lo(w.y); f[3] = bf_hi(w.y); f[4] = bf_lo(w.z); f[5] = bf_hi(w.z); f[6] = bf_lo(w.w); f[7] = bf_hi(w.w); }
__device__ __forceinline__ f32x16 mm64(f32x16 acc, const LAS char* Arows, const LAS char* Bcols, int lane) {
    const int o = ((lane & 31) * LDB + 8 * (lane >> 5)) * 2;
#pragma unroll
    for (int ks = 0; ks < 4; ++ks) { const bf16x8 a = *(const LAS bf16x8*)(Arows + o + 32 * ks), b = *(const LAS bf16x8*)(Bcols + o + 32 * ks); acc = __builtin_amdgcn_mfma_f32_32x32x16_bf16(a, b, acc, 0, 0, 0); }
    return acc;
}
__device__ __forceinline__ s16x4 trrd(const LAS char* p) { return __builtin_bit_cast(s16x4, __builtin_amdgcn_ds_read_tr16_b64_v4i16((LAS s16x4*)p)); }
__device__ __forceinline__ int tr_off(int lane) { return ((8 * (lane >> 5) + ((lane & 15) >> 2)) * LDB + 16 * ((lane >> 4) & 1) + 4 * (lane & 3)) * 2; }
__device__ __forceinline__ bf16x8 frag_tr(const LAS char* Xb, int ks) {
    const s16x4 lo = trrd(Xb + (16 * ks) * LDB * 2), hi = trrd(Xb + (16 * ks + 4) * LDB * 2);
    return (bf16x8){lo[0], lo[1], lo[2], lo[3], hi[0], hi[1], hi[2], hi[3]};
}
__device__ __forceinline__ f32x16 mm64_btr(f32x16 acc, const LAS char* Arows, const LAS char* X, int nb, int lane) {
    const int o = ((lane & 31) * LDB + 8 * (lane >> 5)) * 2; const LAS char* xb = X + 64 * nb + tr_off(lane);
#pragma unroll
    for (int ks = 0; ks < 4; ++ks) { const bf16x8 a = *(const LAS bf16x8*)(Arows + o + 32 * ks), b = frag_tr(xb, ks); acc = __builtin_amdgcn_mfma_f32_32x32x16_bf16(a, b, acc, 0, 0, 0); }
    return acc;
}
__device__ __forceinline__ f32x16 mm64_atr(f32x16 acc, const LAS char* X, int mb, const LAS char* Bcols, int lane) {
    const int o = ((lane & 31) * LDB + 8 * (lane >> 5)) * 2; const LAS char* xb = X + 64 * mb + tr_off(lane);
#pragma unroll
    for (int ks = 0; ks < 4; ++ks) { const bf16x8 a = frag_tr(xb, ks), b = *(const LAS bf16x8*)(Bcols + o + 32 * ks); acc = __builtin_amdgcn_mfma_f32_32x32x16_bf16(a, b, acc, 0, 0, 0); }
    return acc;
}
__device__ __forceinline__ void store_T(const f32x16& d, LAS char* dst, int mb, int nb, int lane) {
    LAS char* p = dst + ((32 * nb + (lane & 31)) * LDB + 32 * mb + 4 * (lane >> 5)) * 2;
#pragma unroll
    for (int g = 0; g < 4; ++g) { u32x2 w; w.x = cvt_pk_bf16(d[4 * g], d[4 * g + 1]); w.y = cvt_pk_bf16(d[4 * g + 2], d[4 * g + 3]); *(LAS u32x2*)(p + 16 * g) = w; }
}
__device__ __forceinline__ void store_T_g(const f32x16& d, bf16_t* dst, int mb, int nb, int lane) {
    bf16_t* p = dst + (32 * nb + (lane & 31)) * 64 + 32 * mb + 4 * (lane >> 5);
#pragma unroll
    for (int g = 0; g < 4; ++g) { u32x2 w; w.x = cvt_pk_bf16(d[4 * g], d[4 * g + 1]); w.y = cvt_pk_bf16(d[4 * g + 2], d[4 * g + 3]); *(u32x2*)(p + 8 * g) = w; }
}
#define RC_M(r) (32 * mb + 8 * ((r) >> 2) + 4 * hi + ((r) & 3))

struct Raw { u32x4 lc[4], lp[4], rc[3], rp[3]; };
__device__ __forceinline__ void load_raw(Raw& R, const bf16_t* Prw, int u, int t, int cg) {
    const int b = u >> 8, h = (u >> 5) & 7, c = u & 31;
    const size_t row = (size_t)b * SEQ + 64 * c + t; const bool hasprev = (c > 0) || (t > 0);
    const bf16_t* pc = Prw + row * RCOLS; const bf16_t* pp = pc - RCOLS; const int lc0 = 1536 + 32 * cg, hd = h * 64 + 8 * cg;
#pragma unroll
    for (int q = 0; q < 4; ++q) { R.lc[q] = *(const u32x4*)(pc + lc0 + 8 * q); R.lp[q] = hasprev ? *(const u32x4*)(pp + lc0 + 8 * q) : (u32x4){0u, 0u, 0u, 0u}; }
#pragma unroll
    for (int w = 0; w < 3; ++w) { R.rc[w] = *(const u32x4*)(pc + w * 512 + hd); R.rp[w] = hasprev ? *(const u32x4*)(pp + w * 512 + hd) : (u32x4){0u, 0u, 0u, 0u}; }
}
__device__ __forceinline__ void chunk_phase(Frame& F, const Ptrs& P) {
  const bf16_t* Prw = (const bf16_t*)(P.ws + WS_PRW);
  int htab = -1; bf16x8 wA[4]; Raw raw;
  if (TIME_PHASE >= 20 && blockIdx.x == 0 && F.tid == 0) F.MISC[15] = (unsigned)__builtin_amdgcn_s_memrealtime();
  if ((int)blockIdx.x < NB * 8 * 32) load_raw(raw, Prw, (int)blockIdx.x, F.tid >> 3, F.tid & 7);
#pragma unroll 1
  for (int u_ = (int)blockIdx.x; u_ < NB * 8 * 32; u_ += F.G) {
    int tid = F.tid, wid = F.wave; asm volatile("" : "+v"(tid), "+s"(wid));
    const int b = u_ >> 8, h = (u_ >> 5) & 7, c = u_ & 31;
    const int lane = tid & 63, t = tid >> 3, cg = tid & 7, r32 = lane & 31, hi = lane >> 5;
    LAS char* lds = (LAS char*)F.lds;
    const size_t u = (size_t)((b * 8 + h) * 32 + c);
    bf16_t* gQe = (bf16_t*)(P.ws + WS_QE) + u * 4096; bf16_t* gYl = (bf16_t*)(P.ws + WS_YLOC) + u * 4096; bf16_t* gPc = (bf16_t*)(P.ws + WS_PC) + u * 4096; bf16_t* gSl = (bf16_t*)(P.ws + WS_SLOC) + u * 4096;
    bf16_t* gG = (bf16_t*)((unsigned char*)P.out + DO_G) + u * 4096; bf16_t* Yr = (bf16_t*)((unsigned char*)P.out + DO_YRA);
    const int hd = h * 64 + 8 * cg;
    const bool is_ad = (cg == 2 || cg == 3); const float alpha = cg < 2 ? 2.f : 1.f, gamma = cg < 2 ? -1.f : 0.f;
    LAS bf16_t* ldst = (LAS bf16_t*)(lds + (cg < 2 ? L_TWD : (cg < 4 ? L_AD : L_SGD))) + t * (cg < 4 ? 72 : 136) + 32 * (cg < 2 ? cg : (cg < 4 ? cg - 2 : cg - 4));
    const size_t row = (size_t)b * SEQ + 64 * c + t;
    LAS float* tab = (LAS float*)(lds + L_TAB);
    if (h != htab) {
        htab = h;
        for (int i = tid; i < T_N; i += 512) { float v;
            if (i < T_MUR) v = P.in[6][1536 + i]; else if (i < T_PAR) { const int w = (i - T_MUR) >> 6, d = (i - T_MUR) & 63; v = P.in[6][w * 512 + h * 64 + d]; }
            else { const int w = (i - T_PAR) >> 6, d = (i - T_PAR) & 63; const float* src = w == 0 ? P.in[7] : (w == 1 ? P.in[9] : (w == 2 ? P.in[12] : (w == 3 ? P.in[13] : (w == 4 ? P.in[14] : P.in[16])))); v = src[h * 64 + d]; }
            tab[i] = v; }
        const int jb = (wid >> 1) & 1;
        const bf16_t* wa = (const bf16_t*)(P.ws + (wid < 4 ? WS_WUP : WS_AUP)) + (size_t)(h * 64 + jb * 32 + r32) * 64 + 8 * hi;
#pragma unroll
        for (int ks = 0; ks < 4; ++ks) wA[ks] = *(const bf16x8*)(wa + 16 * ks);
        LBAR();
    }
    bf16x8 wG[8];
    { const bf16_t* wg = (const bf16_t*)(P.ws + WS_GUP) + (size_t)(h * 64 + ((wid >> 1) & 1) * 32 + r32) * 128 + 8 * hi;
#pragma unroll
      for (int ks = 0; ks < 8; ++ks) wG[ks] = *(const bf16x8*)(wg + 16 * ks); }
    float rv[8], kv[8], vv[8];
    { float cur[8], prv[8], mu[8];
#pragma unroll
      for (int q = 0; q < 4; ++q) {
          unpack8(raw.lc[q], cur); unpack8(raw.lp[q], prv);
          *(f32x4*)mu = *(const LAS f32x4*)(tab + T_MUL + 32 * cg + 8 * q); *(f32x4*)(mu + 4) = *(const LAS f32x4*)(tab + T_MUL + 32 * cg + 8 * q + 4);
          float o[8];
#pragma unroll
          for (int i = 0; i < 8; ++i) { const float xs = cur[i] + (prv[i] - cur[i]) * mu[i]; const float sg = sigmoidf_(alpha * xs); o[i] = is_ad ? xs : alpha * sg + gamma; }
          u32x4 w; w.x = cvt_pk_bf16(o[0], o[1]); w.y = cvt_pk_bf16(o[2], o[3]); w.z = cvt_pk_bf16(o[4], o[5]); w.w = cvt_pk_bf16(o[6], o[7]);
          *(LAS u32x4*)(ldst + 8 * q) = w; }
#pragma unroll
      for (int which = 0; which < 3; ++which) {
          unpack8(raw.rc[which], cur); unpack8(raw.rp[which], prv);
          *(f32x4*)mu = *(const LAS f32x4*)(tab + T_MUR + which * 64 + 8 * cg); *(f32x4*)(mu + 4) = *(const LAS f32x4*)(tab + T_MUR + which * 64 + 8 * cg + 4);
#pragma unroll
          for (int i = 0; i < 8; ++i) { const float xs = cur[i] + (prv[i] - cur[i]) * mu[i]; if (which == 0) rv[i] = xs; else if (which == 1) kv[i] = xs; else vv[i] = xs; } } }
    LBAR(); PROF(0);
    { const int ib = wid & 1, jb = (wid >> 1) & 1;
      auto wr4 = [&](const f32x16& acc, LAS float* Out) { LAS float* op = Out + (ib * 32 + r32) * FLD + jb * 32 + 4 * hi;
#pragma unroll
          for (int g = 0; g < 4; ++g) *(LAS f32x4*)(op + 8 * g) = (f32x4){acc[4 * g], acc[4 * g + 1], acc[4 * g + 2], acc[4 * g + 3]}; };
      { f32x16 acc = {}; const LAS bf16_t* qp = (const LAS bf16_t*)(lds + (wid < 4 ? L_TWD : L_AD)) + (ib * 32 + r32) * 72 + 8 * hi;
#pragma unroll
        for (int ks = 0; ks < 4; ++ks) acc = __builtin_amdgcn_mfma_f32_32x32x16_bf16(wA[ks], *(const LAS bf16x8*)(qp + 16 * ks), acc, 0, 0, 0);
        wr4(acc, (LAS float*)(lds + (wid < 4 ? L_WL : L_AL))); }
      if (wid < 4) { f32x16 acc = {}; const LAS bf16_t* qp = (const LAS bf16_t*)(lds + L_SGD) + (ib * 32 + r32) * 136 + 8 * hi;
#pragma unroll
        for (int ks = 0; ks < 8; ++ks) acc = __builtin_amdgcn_mfma_f32_32x32x16_bf16(wG[ks], *(const LAS bf16x8*)(qp + 16 * ks), acc, 0, 0, 0);
        wr4(acc, (LAS float*)(lds + L_GL)); } }
    LBAR(); PROF(1);
    float lam[8], av[8], bv[8], kp[8];
    const int o68 = t * FLD + 8 * cg;
    { float wl[8], al[8], gv[8];
      *(f32x4*)wl = *(LAS f32x4*)(lds + L_WL + 4 * o68); *(f32x4*)(wl + 4) = *(LAS f32x4*)(lds + L_WL + 4 * o68 + 16);
      *(f32x4*)al = *(LAS f32x4*)(lds + L_AL + 4 * o68); *(f32x4*)(al + 4) = *(LAS f32x4*)(lds + L_AL + 4 * o68 + 16);
      *(f32x4*)gv = *(LAS f32x4*)(lds + L_GL + 4 * o68); *(f32x4*)(gv + 4) = *(LAS f32x4*)(lds + L_GL + 4 * o68 + 16);
      float w0[8], a0[8], kk_[8], ka[8], rk[8], lb[8];
      { const LAS float* tp = tab + T_PAR + 8 * cg;
        *(f32x4*)w0 = *(const LAS f32x4*)(tp); *(f32x4*)(w0 + 4) = *(const LAS f32x4*)(tp + 4);
        *(f32x4*)a0 = *(const LAS f32x4*)(tp + 64); *(f32x4*)(a0 + 4) = *(const LAS f32x4*)(tp + 68);
        *(f32x4*)kk_ = *(const LAS f32x4*)(tp + 128); *(f32x4*)(kk_ + 4) = *(const LAS f32x4*)(tp + 132);
        *(f32x4*)ka = *(const LAS f32x4*)(tp + 192); *(f32x4*)(ka + 4) = *(const LAS f32x4*)(tp + 196);
        *(f32x4*)rk = *(const LAS f32x4*)(tp + 256); *(f32x4*)(rk + 4) = *(const LAS f32x4*)(tp + 260);
        *(f32x4*)lb = *(const LAS f32x4*)(tp + 320); *(f32x4*)(lb + 4) = *(const LAS f32x4*)(tp + 324); }
      float asg[8], kkv[8], c2[8]; float ss = 0.f, bon = 0.f;
#pragma unroll
      for (int i = 0; i < 8; ++i) { lam[i] = 0.60653065971f * sigmoidf_(w0[i] + wl[i]); asg[i] = sigmoidf_(a0[i] + al[i]);
          kkv[i] = kv[i] * kk_[i]; ss += kkv[i] * kkv[i]; kp[i] = kv[i] * (1.f + (asg[i] - 1.f) * ka[i]); bon += rv[i] * kp[i] * rk[i]; }
      ss = red8(ss); bon = red8(bon);
      const float inv = 1.f / fmaxf(sqrtf(ss), 1e-12f);
#pragma unroll
      for (int i = 0; i < 8; ++i) { const float kn = kkv[i] * inv; av[i] = -kn; bv[i] = kn * asg[i]; c2[i] = (lb[i] + bon * vv[i]) * gv[i]; }
      u32x4 w; w.x = cvt_pk_bf16(gv[0], gv[1]); w.y = cvt_pk_bf16(gv[2], gv[3]); w.z = cvt_pk_bf16(gv[4], gv[5]); w.w = cvt_pk_bf16(gv[6], gv[7]);
      *(u32x4*)(gG + t * 64 + 8 * cg) = w;
      w.x = cvt_pk_bf16(c2[0], c2[1]); w.y = cvt_pk_bf16(c2[2], c2[3]); w.z = cvt_pk_bf16(c2[4], c2[5]); w.w = cvt_pk_bf16(c2[6], c2[7]);
      *(u32x4*)(Yr + row * 1024 + hd) = w; }
    float cum[8];
    { const int tl = lane >> 3;
#pragma unroll
      for (int i = 0; i < 8; ++i) { float x = lam[i];
          float y = __shfl_up(x, 8); x += (tl >= 1) ? y : 0.f; y = __shfl_up(x, 16); x += (tl >= 2) ? y : 0.f; y = __shfl_up(x, 32); x += (tl >= 4) ? y : 0.f;
          cum[i] = x; }
      if (tl == 7) { *(LAS f32x4*)(lds + L_SEG + (wid * 64 + 8 * cg) * 4) = *(f32x4*)cum; *(LAS f32x4*)(lds + L_SEG + (wid * 64 + 8 * cg) * 4 + 16) = *(f32x4*)(cum + 4); } }
    LBAR(); PROF(2);
    { float pre[8], tot[8];
#pragma unroll
      for (int i = 0; i < 8; ++i) { pre[i] = 0.f; tot[i] = 0.f; }
      const int myseg = t >> 3;
#pragma unroll
      for (int s = 0; s < 8; ++s) { float sv[8]; *(f32x4*)sv = *(LAS f32x4*)(lds + L_SEG + (s * 64 + 8 * cg) * 4); *(f32x4*)(sv + 4) = *(LAS f32x4*)(lds + L_SEG + (s * 64 + 8 * cg) * 4 + 16);
#pragma unroll
          for (int i = 0; i < 8; ++i) { tot[i] += sv[i]; pre[i] += (s < myseg) ? sv[i] : 0.f; } }
      float at_[8], bt_[8], kt_[8], rt_[8], bh_[8], kh_[8];
#pragma unroll
      for (int i = 0; i < 8; ++i) { const float cm = cum[i] + pre[i];
          const float gi = __builtin_amdgcn_exp2f(cm * LOG2E), g_ = __builtin_amdgcn_exp2f(-cm * LOG2E), gm1 = __builtin_amdgcn_exp2f(-(cm - lam[i]) * LOG2E), glg = __builtin_amdgcn_exp2f(-(tot[i] - cm) * LOG2E);
          at_[i] = av[i] * gm1; bt_[i] = bv[i] * gi; kt_[i] = kp[i] * gi; rt_[i] = rv[i] * g_; bh_[i] = bv[i] * glg; kh_[i] = kp[i] * glg; }
      if (t == 0) { float gl[8];
#pragma unroll
          for (int i = 0; i < 8; ++i) gl[i] = __builtin_amdgcn_exp2f(-tot[i] * LOG2E);
          *(LAS f32x4*)(lds + L_GLD + 32 * cg) = *(f32x4*)gl; *(LAS f32x4*)(lds + L_GLD + 32 * cg + 16) = *(f32x4*)(gl + 4); }
      const int ob = (t * LDB + 8 * cg) * 2; u32x4 w;
      w.x = cvt_pk_bf16(at_[0], at_[1]); w.y = cvt_pk_bf16(at_[2], at_[3]); w.z = cvt_pk_bf16(at_[4], at_[5]); w.w = cvt_pk_bf16(at_[6], at_[7]); *(LAS u32x4*)(lds + L_AT + ob) = w;
      w.x = cvt_pk_bf16(bt_[0], bt_[1]); w.y = cvt_pk_bf16(bt_[2], bt_[3]); w.z = cvt_pk_bf16(bt_[4], bt_[5]); w.w = cvt_pk_bf16(bt_[6], bt_[7]); *(LAS u32x4*)(lds + L_BT + ob) = w;
      w.x = cvt_pk_bf16(kt_[0], kt_[1]); w.y = cvt_pk_bf16(kt_[2], kt_[3]); w.z = cvt_pk_bf16(kt_[4], kt_[5]); w.w = cvt_pk_bf16(kt_[6], kt_[7]); *(LAS u32x4*)(lds + L_KT + ob) = w;
      w.x = cvt_pk_bf16(rt_[0], rt_[1]); w.y = cvt_pk_bf16(rt_[2], rt_[3]); w.z = cvt_pk_bf16(rt_[4], rt_[5]); w.w = cvt_pk_bf16(rt_[6], rt_[7]); *(LAS u32x4*)(lds + L_RT + ob) = w;
      w.x = cvt_pk_bf16(bh_[0], bh_[1]); w.y = cvt_pk_bf16(bh_[2], bh_[3]); w.z = cvt_pk_bf16(bh_[4], bh_[5]); w.w = cvt_pk_bf16(bh_[6], bh_[7]); *(LAS u32x4*)(lds + L_BH + ob) = w;
      w.x = cvt_pk_bf16(kh_[0], kh_[1]); w.y = cvt_pk_bf16(kh_[2], kh_[3]); w.z = cvt_pk_bf16(kh_[4], kh_[5]); w.w = cvt_pk_bf16(kh_[6], kh_[7]); *(LAS u32x4*)(lds + L_KH + ob) = w;
      w.x = cvt_pk_bf16(vv[0], vv[1]); w.y = cvt_pk_bf16(vv[2], vv[3]); w.z = cvt_pk_bf16(vv[4], vv[5]); w.w = cvt_pk_bf16(vv[6], vv[7]); *(LAS u32x4*)(lds + L_V + ob) = w; }
    LBAR(); PROF(4);
    load_raw(raw, Prw, (u_ + F.G < NB * 8 * 32) ? u_ + F.G : u_, t, cg);
    {
    wid = __builtin_amdgcn_readfirstlane(wid); asm volatile("" : "+v"(tid), "+s"(wid));
    const int lane = tid & 63, r32 = lane & 31, hi = lane >> 5;
    const int mb = wid & 1, nb = (wid >> 1) & 1, grp = wid >> 2;
    const int ao = 32 * mb * LDB * 2, bo = 32 * nb * LDB * 2;
    const int ncol = 32 * nb + r32;
    f32x16 accT = {};
    {
        f32x16 d = {};
        if (grp == 0) { d = mm64(d, lds + L_AT + ao, lds + L_KT + bo, lane);
#pragma unroll
            for (int r = 0; r < 16; ++r) d[r] = (ncol < RC_M(r)) ? d[r] : 0.f;
            store_T(d, lds + L_NKT, mb, nb, lane); }
        else { d = mm64(d, lds + L_BT + ao, lds + L_AT + bo, lane);
#pragma unroll
            for (int r = 0; r < 16; ++r) { d[r] = (RC_M(r) < ncol) ? d[r] : 0.f; accT[r] = d[r] + ((RC_M(r) == ncol) ? 1.f : 0.f); }
            store_T(d, lds + L_NQ0, mb, nb, lane); store_T(accT, lds + L_TQ0, mb, nb, lane); }
    }
    LBAR(); PROF(5);
#pragma unroll
    for (int j = 1; j <= 5; ++j) { const int cur = (j - 1) & 1, nw = j & 1;
        const int nq_c = cur ? L_NQ1 : L_NQ0, nq_n = nw ? L_NQ1 : L_NQ0;
        if (grp == 0) { f32x16 d = {}; d = mm64_atr(d, lds + nq_c, mb, lds + nq_c + bo, lane); store_T(d, lds + nq_n, mb, nb, lane); }
        else if (j == 1) { f32x16 e = {}; e = mm64(e, lds + L_BT + ao, lds + L_RT + bo, lane);
#pragma unroll
            for (int r = 0; r < 16; ++r) e[r] = (RC_M(r) <= ncol) ? e[r] : 0.f;
            store_T(e, lds + L_NRB, mb, nb, lane); }
        else { const int tq_r = nw ? L_TQ1 : L_TQ0, tq_w = cur ? L_TQ1 : L_TQ0;
            accT = mm64_atr(accT, lds + nq_c, mb, lds + tq_r + bo, lane); store_T(accT, lds + tq_w, mb, nb, lane); }
        LBAR();
    }
    if (grp == 1) { accT = mm64_atr(accT, lds + L_NQ1, mb, lds + L_TQ0 + bo, lane); store_T(accT, lds + L_TQ1, mb, nb, lane); }
    LBAR(); PROF(6);
    { f32x16 d = {};
      if (grp == 0) { d = mm64_btr(d, lds + L_TQ1 + ao, lds + L_AT, nb, lane); store_T(d, lds + L_W1T, mb, nb, lane); }
      else { d = mm64(d, lds + L_TQ1 + ao, lds + L_NKT + bo, lane); store_T(d, lds + L_W2T, mb, nb, lane); } }
    LBAR(); PROF(7);
    if (grp == 0) {
        f32x16 d = {}; d = mm64(d, lds + L_W1T + ao, lds + L_NRB + bo, lane);
#pragma unroll
        for (int g = 0; g < 4; ++g) { const u32x2 rw = *(const LAS u32x2*)(lds + L_RT + ((32 * nb + r32) * LDB + 32 * mb + 8 * g + 4 * hi) * 2);
            d[4 * g] += bf_lo(rw.x); d[4 * g + 1] += bf_hi(rw.x); d[4 * g + 2] += bf_lo(rw.y); d[4 * g + 3] += bf_hi(rw.y); }
        store_T_g(d, gQe, mb, nb, lane);
        f32x16 p = {}; p = mm64_btr(p, lds + L_W1T + ao, lds + L_BH, nb, lane);
        const float gl = ((const LAS float*)(lds + L_GLD))[ncol];
#pragma unroll
        for (int r = 0; r < 16; ++r) p[r] += (RC_M(r) == ncol) ? gl : 0.f;
        store_T_g(p, gPc, mb, nb, lane);
    } else {
        f32x16 d = {}; d = mm64(d, lds + L_KT + ao, lds + L_RT + bo, lane); d = mm64(d, lds + L_W2T + ao, lds + L_NRB + bo, lane);
#pragma unroll
        for (int r = 0; r < 16; ++r) d[r] = (RC_M(r) <= ncol) ? d[r] : 0.f;
        f32x16 k = {}; k = mm64_btr(k, lds + L_W2T + ao, lds + L_BH, nb, lane);
        { const LAS char* kb = lds + L_KH + 64 * nb + ((32 * mb + 4 * hi + ((lane & 15) >> 2)) * LDB + 16 * ((lane >> 4) & 1) + 4 * (lane & 3)) * 2;
#pragma unroll
          for (int g = 0; g < 4; ++g) { const s16x4 kw = trrd(kb + 8 * g * LDB * 2);
              k[4 * g] += bf_lo((unsigned)(unsigned short)kw[0]); k[4 * g + 1] += bf_lo((unsigned)(unsigned short)kw[1]); k[4 * g + 2] += bf_lo((unsigned)(unsigned short)kw[2]); k[4 * g + 3] += bf_lo((unsigned)(unsigned short)kw[3]); } }
        store_T(d, lds + L_WY, mb, nb, lane); store_T(k, lds + L_KC, mb, nb, lane);
    }
    LBAR(); PROF(8);
    { f32x16 d = {};
      if (grp == 0) { d = mm64_atr(d, lds + L_V, mb, lds + L_WY + bo, lane); store_T_g(d, gYl, mb, nb, lane); }
      else { d = mm64_btr(d, lds + L_KC + ao, lds + L_V, nb, lane); store_T_g(d, gSl, mb, nb, lane); } }
    LBAR(); PROF(9);
    }
  }
}

__device__ __forceinline__ void state_chain(Frame& F, const Ptrs& P, int bh) {
    const int tid = F.tid, lane = F.lane, wid = F.wave, r32 = lane & 31, hi = lane >> 5;
    LAS char* lds = (LAS char*)F.lds;
    const bf16_t* gPc = (const bf16_t*)(P.ws + WS_PC) + (size_t)bh * 32 * 4096; const bf16_t* gSl = (const bf16_t*)(P.ws + WS_SLOC) + (size_t)bh * 32 * 4096;
    bf16_t* gS = (bf16_t*)((unsigned char*)P.out + DO_SC) + (size_t)bh * 32 * 4096;
    constexpr int L_S0 = 0, L_S1 = MB, L_P = 2 * MB;
    for (int i = tid; i < MB / 4; i += 512) ((LAS unsigned*)(lds + L_S0))[i] = 0u;
    const int prow = tid >> 3, pch = tid & 7;
    const int mb = wid & 1, nb = (wid >> 1) & 1;
    u32x4 pw = *(const u32x4*)(gPc + prow * 64 + pch * 8), pw1 = *(const u32x4*)(gPc + 4096 + prow * 64 + pch * 8);
    const bf16_t* sp = gSl + (32 * nb + r32) * 64 + 32 * mb + 4 * hi;
    u32x2 sw[4];
#pragma unroll
    for (int g = 0; g < 4; ++g) sw[g] = wid < 4 ? *(const u32x2*)(sp + 8 * g) : (u32x2){0u, 0u};
    LBAR();
#pragma unroll 1
    for (int c = 0; c < 32; ++c) {
        const int sc = (c & 1) ? L_S1 : L_S0, sn = (c & 1) ? L_S0 : L_S1;
        *(LAS u32x4*)(lds + L_P + (prow * LDB + pch * 8) * 2) = pw;
        *(u32x4*)(gS + (size_t)c * 4096 + prow * 64 + pch * 8) = *(const LAS u32x4*)(lds + sc + (prow * LDB + pch * 8) * 2);
        pw = pw1; if (c + 2 < 32) pw1 = *(const u32x4*)(gPc + (size_t)(c + 2) * 4096 + prow * 64 + pch * 8);
        f32x16 d;
#pragma unroll
        for (int g = 0; g < 4; ++g) { const u32x2 w = sw[g]; d[4 * g] = bf_lo(w.x); d[4 * g + 1] = bf_hi(w.x); d[4 * g + 2] = bf_lo(w.y); d[4 * g + 3] = bf_hi(w.y); }
        if (wid < 4 && c + 1 < 32) {
#pragma unroll
            for (int g = 0; g < 4; ++g) sw[g] = *(const u32x2*)(sp + (size_t)(c + 1) * 4096 + 8 * g); }
        LBAR();
        if (wid < 4) { d = mm64(d, lds + L_P + 32 * mb * LDB * 2, lds + sc + 32 * nb * LDB * 2, lane); store_T(d, lds + sn, mb, nb, lane); }
        LBAR();
    }
}

__device__ __forceinline__ void out_unit(Frame& F, const Ptrs& P, int u, int nb, bool do_store = true) {
    const int lane = F.lane, r32 = lane & 31, hi = lane >> 5;
    const bf16_t* gQe = (const bf16_t*)(P.ws + WS_QE) + (size_t)u * 4096; const bf16_t* gYl = (const bf16_t*)(P.ws + WS_YLOC) + (size_t)u * 4096;
    const bf16_t* gS = (const bf16_t*)((unsigned char*)P.out + DO_SC) + (size_t)u * 4096; const bf16_t* gG = (const bf16_t*)((unsigned char*)P.out + DO_G) + (size_t)u * 4096;
    bf16_t* Yr = (bf16_t*)((unsigned char*)P.out + DO_YRA);
    const int bh = u >> 5, c = u & 31, h = bh & 7, b = bh >> 3;
    const int tl = 32 * nb + r32;
    const size_t row = (size_t)b * SEQ + 64 * c + tl;
    bf16_t* yo = Yr + row * 1024 + h * 64 + 4 * hi; const bf16_t* gg = gG + tl * 64 + 4 * hi; const float* lg = P.in[15] + h * 64 + 4 * hi; const bf16_t* yl = gYl + tl * 64 + 4 * hi;
    bf16x8 qf[4], sa[4], sb[4];
#pragma unroll
    for (int ks = 0; ks < 4; ++ks) { qf[ks] = *(const bf16x8*)(gQe + (32 * nb + r32) * 64 + 16 * ks + 8 * hi); sa[ks] = *(const bf16x8*)(gS + r32 * 64 + 16 * ks + 8 * hi); sb[ks] = *(const bf16x8*)(gS + (32 + r32) * 64 + 16 * ks + 8 * hi); }
    u32x2 ylw[2][4], gw[2][4], cw[2][4]; f32x4 l4[2][4];
#pragma unroll
    for (int eb = 0; eb < 2; ++eb)
#pragma unroll
        for (int g = 0; g < 4; ++g) { const int eo = 32 * eb + 8 * g; ylw[eb][g] = *(const u32x2*)(yl + eo); gw[eb][g] = *(const u32x2*)(gg + eo); cw[eb][g] = *(const u32x2*)(yo + eo); l4[eb][g] = *(const f32x4*)(lg + eo); }
    f32x16 y0 = {}, y1 = {};
#pragma unroll
    for (int ks = 0; ks < 4; ++ks) { y0 = __builtin_amdgcn_mfma_f32_32x32x16_bf16(sa[ks], qf[ks], y0, 0, 0, 0); y1 = __builtin_amdgcn_mfma_f32_32x32x16_bf16(sb[ks], qf[ks], y1, 0, 0, 0); }
    float s = 0.f;
#pragma unroll
    for (int g = 0; g < 4; ++g) { const u32x2 a = ylw[0][g], bq = ylw[1][g];
        y0[4 * g] += bf_lo(a.x); y0[4 * g + 1] += bf_hi(a.x); y0[4 * g + 2] += bf_lo(a.y); y0[4 * g + 3] += bf_hi(a.y);
        y1[4 * g] += bf_lo(bq.x); y1[4 * g + 1] += bf_hi(bq.x); y1[4 * g + 2] += bf_lo(bq.y); y1[4 * g + 3] += bf_hi(bq.y); }
#pragma unroll
    for (int r = 0; r < 16; ++r) s += y0[r] + y1[r];
    s += __shfl_xor(s, 32); const float mean = s * (1.f / 64.f); float q2 = 0.f;
#pragma unroll
    for (int r = 0; r < 16; ++r) { y0[r] -= mean; y1[r] -= mean; q2 += y0[r] * y0[r] + y1[r] * y1[r]; }
    q2 += __shfl_xor(q2, 32); const float rstd = 1.f / sqrtf(q2 * (1.f / 64.f) + 64e-5f);
#pragma unroll
    for (int g = 0; g < 4; ++g) {
#pragma unroll
        for (int eb = 0; eb < 2; ++eb) { const int eo = 32 * eb + 8 * g; const u32x2 g_ = gw[eb][g], c_ = cw[eb][g]; const f32x4 l_ = l4[eb][g];
            const f32x16& y = eb ? y1 : y0;
            const float o0 = y[4 * g] * rstd * l_.x * bf_lo(g_.x) + bf_lo(c_.x), o1 = y[4 * g + 1] * rstd * l_.y * bf_hi(g_.x) + bf_hi(c_.x), o2 = y[4 * g + 2] * rstd * l_.z * bf_lo(g_.y) + bf_lo(c_.y), o3 = y[4 * g + 3] * rstd * l_.w * bf_hi(g_.y) + bf_hi(c_.y);
            u32x2 w; w.x = cvt_pk_bf16(o0, o1); w.y = cvt_pk_bf16(o2, o3);
            if (do_store) *(u32x2*)(yo + eo) = w; } }
}
#undef RC_M
}
__device__ __forceinline__ void phase_route(Frame& F, const Ptrs& P) {
    const int lane = F.lane, gw = F.vcu * NWAVES + F.wave, NGW = F.G * NWAVES;
    const float* x1 = P.in[0]; const bf16_t* Dl = (const bf16_t*)(P.ws + WS_DELTA); const float* mod = (const float*)(P.ws + WS_MOD);
    const float* gam2 = (const float*)(P.ws + WS_GAM2); const float* cb = (const float*)(P.ws + WS_CB);
    const bf16_t* wrh = (const bf16_t*)(P.ws + WS_WRH); const bf16_t* wrl = (const bf16_t*)(P.ws + WS_WRL);
    bf16_t* H2 = (bf16_t*)(P.ws + WS_H2);
    int* tok_list = (int*)(P.ws + WS_TOKLIST); int* tok_pos = (int*)(P.ws + WS_TOKPOS); int* slot_tok = (int*)(P.ws + WS_SLOTTOK); float* slot_w = (float*)(P.ws + WS_SLOTW);
    unsigned* cnt = (unsigned*)(F.ctl + CW_CNT);
    constexpr int WROW = 1040, L_WH = 0, L_WLO = 48 * WROW, L_GAM = 2 * 48 * WROW, L_SCR = L_GAM + 4096, L_CNT = L_SCR + 8 * 16 * 52 * 4;
    static_assert(L_CNT + 1024 <= LDSCTL_OFF, "route LDS");
    LAS char* lds = (LAS char*)F.lds;
    LAS float* scr = (LAS float*)(lds + L_SCR) + F.wave * (16 * 52);
    const int fr = lane & 15, kq = lane >> 4;
    LAS unsigned* lcnt = (LAS unsigned*)(lds + L_CNT); LAS unsigned* lbase = lcnt + 64;
    for (int rnd = F.vcu; rnd < NTOK / 128; rnd += F.G) {
        const int R0 = rnd * 128 + F.wave * 16, b = R0 / SEQ;
        const float* xr = x1 + (size_t)(R0 + fr) * DM + 8 * kq; const bf16_t* dr = Dl + (size_t)(R0 + fr) * DM + 8 * kq;
        f32x4 acc[3] = {{0.f, 0.f, 0.f, 0.f}, {0.f, 0.f, 0.f, 0.f}, {0.f, 0.f, 0.f, 0.f}}; float ssq = 0.f;
#pragma unroll 1
        for (int half = 0; half < 2; ++half) {
            __syncthreads();
            if (half == 0) { if (F.tid < NLIST) lcnt[F.tid] = 0u; for (int i = F.tid; i < DM / 4; i += 512) *(LAS f32x4*)(lds + L_GAM + 16 * i) = *(const f32x4*)(gam2 + (size_t)b * DM + 4 * i); }
            for (int i = F.tid; i < 48 * 64; i += 512) { const int row = i >> 6, ch = i & 63;
                *(LAS u32x4*)(lds + L_WH + row * WROW + ch * 16) = *(const u32x4*)(wrh + (size_t)row * DM + half * 512 + ch * 8);
                *(LAS u32x4*)(lds + L_WLO + row * WROW + ch * 16) = *(const u32x4*)(wrl + (size_t)row * DM + half * 512 + ch * 8); }
            __syncthreads();
            const LAS char* bh = lds + L_WH + fr * WROW + kq * 16; const LAS char* bl = lds + L_WLO + fr * WROW + kq * 16; const LAS char* gp = lds + L_GAM + (half * 512 + 8 * kq) * 4;
#pragma unroll 2
            for (int kk = 0; kk < 512; kk += 32) { const int k0 = half * 512 + kk;
                f32x4 xa = *(const f32x4*)(xr + k0), xb = *(const f32x4*)(xr + k0 + 4); const f32x4 ga = *(const LAS f32x4*)(gp + kk * 4), gb = *(const LAS f32x4*)(gp + kk * 4 + 16);
                { const u32x4 dw = *(const u32x4*)(dr + k0); xa.x += bf_lo(dw.x); xa.y += bf_hi(dw.x); xa.z += bf_lo(dw.y); xa.w += bf_hi(dw.y); xb.x += bf_lo(dw.z); xb.y += bf_hi(dw.z); xb.z += bf_lo(dw.w); xb.w += bf_hi(dw.w); }
                ssq += (xa.x * xa.x + xa.y * xa.y) + (xa.z * xa.z + xa.w * xa.w) + (xb.x * xb.x + xb.y * xb.y) + (xb.z * xb.z + xb.w * xb.w);
                const f32x4 ya = xa * ga, yb = xb * gb;
                u32x4 hw; hw.x = cvt_pk_bf16(ya.x, ya.y); hw.y = cvt_pk_bf16(ya.z, ya.w); hw.z = cvt_pk_bf16(yb.x, yb.y); hw.w = cvt_pk_bf16(yb.z, yb.w);
                u32x4 lw; lw.x = cvt_pk_bf16(ya.x - bf_lo(hw.x), ya.y - bf_hi(hw.x)); lw.y = cvt_pk_bf16(ya.z - bf_lo(hw.y), ya.w - bf_hi(hw.y));
                lw.z = cvt_pk_bf16(yb.x - bf_lo(hw.z), yb.y - bf_hi(hw.z)); lw.w = cvt_pk_bf16(yb.z - bf_lo(hw.w), yb.w - bf_hi(hw.w));
                const bf16x8 ah = __builtin_bit_cast(bf16x8, hw), al = __builtin_bit_cast(bf16x8, lw);
#pragma unroll
                for (int nb = 0; nb < 3; ++nb) { const bf16x8 wh = *(const LAS bf16x8*)(bh + nb * 16 * WROW + kk * 2), wl = *(const LAS bf16x8*)(bl + nb * 16 * WROW + kk * 2);
                    acc[nb] = __builtin_amdgcn_mfma_f32_16x16x32_bf16(ah, wh, acc[nb], 0, 0, 0); acc[nb] = __builtin_amdgcn_mfma_f32_16x16x32_bf16(al, wh, acc[nb], 0, 0, 0); acc[nb] = __builtin_amdgcn_mfma_f32_16x16x32_bf16(ah, wl, acc[nb], 0, 0, 0); }
            }
        }
        ssq += __shfl_xor(ssq, 16); ssq += __shfl_xor(ssq, 32);
        const float rinv = 1.f / sqrtf(ssq * (1.f / DM) + 1e-6f);
#pragma unroll
        for (int nb = 0; nb < 3; ++nb)
#pragma unroll
            for (int j = 0; j < 4; ++j) scr[(4 * kq + j) * 52 + 16 * nb + fr] = acc[nb][j];
        LDS_WAIT(); asm volatile("" ::: "memory");
        int l1 = 0, l2 = 0, q1 = 0, q2 = 0; float w1 = 0.f, w2 = 0.f;
        if (lane < 16) {
            const float* cbb = cb + b * 64; const LAS float* lr = scr + lane * 52;
            float lc[4]; int grp = 0; float best = -3.4e38f;
#pragma unroll
            for (int o = 0; o < 4; ++o) { lc[o] = rinv * lr[o] + cbb[o]; if (lc[o] > best) { best = lc[o]; grp = o; } }
            float den = 0.f;
#pragma unroll
            for (int o = 0; o < 4; ++o) den += __expf(lc[o] - best);
            const float pgrp = 1.f / den;
            float f1 = -3.4e38f, f2 = -3.4e38f; int i1 = 0, i2 = 0;
            for (int o = 0; o < 8; ++o) { const float v = rinv * lr[4 + grp * 8 + o] + cbb[4 + grp * 8 + o];
                if (v > f1) { f2 = f1; i2 = i1; f1 = v; i1 = o; } else if (v > f2) { f2 = v; i2 = o; } }
            const float e2 = __expf(f2 - f1); w1 = pgrp / (1.f + e2); w2 = pgrp * e2 / (1.f + e2);
            l1 = (grp * 8 + i1) * 2; l2 = (grp * 8 + i2) * 2 + 1;
            q1 = (int)__hip_atomic_fetch_add(lcnt + l1, 1u, __ATOMIC_RELAXED, __HIP_MEMORY_SCOPE_WORKGROUP); q2 = (int)__hip_atomic_fetch_add(lcnt + l2, 1u, __ATOMIC_RELAXED, __HIP_MEMORY_SCOPE_WORKGROUP);
        }
        __syncthreads();
        if (F.tid < NLIST) { const unsigned c = ((LAS unsigned*)lcnt)[F.tid]; lbase[F.tid] = c ? atomicAdd(cnt + 64 * F.tid, c) : 0u; }
        __syncthreads();
        if (lane < 16) { const int tok = R0 + lane;
            const int p1 = (int)lbase[l1] + q1, p2 = (int)lbase[l2] + q2;
            tok_list[2 * tok] = l1; tok_list[2 * tok + 1] = l2; tok_pos[2 * tok] = p1; tok_pos[2 * tok + 1] = p2;
            slot_tok[(size_t)l1 * NTOK + p1] = tok; slot_tok[(size_t)l2 * NTOK + p2] = tok; slot_w[(size_t)l1 * NTOK + p1] = w1; slot_w[(size_t)l2 * NTOK + p2] = w2; }
        const float* sh = mod + (size_t)b * MODW + 3 * DM;
#pragma unroll 4
        for (int r = 0; r < 16; ++r) { const float ri = __shfl(rinv, r);
            const GAS f32x4* xrow = (const GAS f32x4*)(x1 + (size_t)(R0 + r) * DM) + lane; const GAS u32x2* drow = (const GAS u32x2*)(Dl + (size_t)(R0 + r) * DM) + lane; GAS u32x2* o8 = (GAS u32x2*)(H2 + (size_t)(R0 + r) * DM) + lane;
#pragma unroll
            for (int j = 0; j < 4; ++j) { const int k = 4 * lane + 256 * j; f32x4 xv = __builtin_nontemporal_load(xrow + 64 * j); const u32x2 dw = drow[64 * j]; xv.x += bf_lo(dw.x); xv.y += bf_hi(dw.x); xv.z += bf_lo(dw.y); xv.w += bf_hi(dw.y); const f32x4 g = *(const f32x4*)(gam2 + (size_t)b * DM + k), s = *(const f32x4*)(sh + k);
                const f32x4 hv = xv * ri * g + s; u32x2 w; w.x = cvt_pk_bf16(hv.x, hv.y); w.y = cvt_pk_bf16(hv.z, hv.w); o8[64 * j] = w; } }
        LDS_WAIT(); asm volatile("" ::: "memory");
    }
}
__device__ __forceinline__ void moe_offsets(Frame& F) {
    LAS int* toff = (LAS int*)(F.lds + TOFF_OFF); LAS int* lcnt = (LAS int*)(F.lds + LCNT_OFF); LAS unsigned char* tile_l = (LAS unsigned char*)(F.lds + TILE_L_OFF);
    if (F.tid < NLIST) lcnt[F.tid] = (int)__hip_atomic_load(F.ctl + CW_CNT + 64 * F.tid, RLX_AGENT);
    __syncthreads();
    if (F.tid == 0) { int acc = 0;
#pragma unroll 1
        for (int l = 0; l < NLIST; ++l) { toff[l] = acc; acc += (lcnt[l] + 255) >> 8; } toff[NLIST] = acc; }
    __syncthreads();
    if (F.tid < NLIST) { for (int t = toff[F.tid]; t < toff[F.tid + 1]; ++t) tile_l[t] = (unsigned char)F.tid; }
    __syncthreads();
}
#ifndef MK_ONE_LAUNCH
#define MK_ONE_LAUNCH 1
#endif
constexpr int N_PHASES = 12;

__global__ void __launch_bounds__(NWAVES * 64, 2) fwd_kernel(Args args) {
    extern __shared__ __attribute__((aligned(16))) unsigned char lds_raw[];
    Frame F; F.lds = (LAS unsigned char*)lds_raw; F.MISC = (volatile LAS unsigned*)(F.lds + MISC_OFF);
    F.tid = threadIdx.x; F.lane = F.tid & 63; F.wave = __builtin_amdgcn_readfirstlane(F.tid >> 6);
    F.G = gridDim.x; { const int bx = blockIdx.x; F.vcu = (F.G % 8 == 0) ? (bx % 8) * (F.G / 8) + bx / 8 : bx; }
#ifndef DUP_PHASE
#define DUP_PHASE -1
#endif
#define RELOAD_ARGS() Ptrs P; { int z_ = 0; asm volatile("" : "+s"(z_)); _Pragma("unroll") for (int i_ = 0; i_ < 31; ++i_) P.in[i_] = args.in[i_] + z_; P.out = args.out + z_; P.ws = args.ws + z_; }
    F.ctl = (gu32*)(args.ws + WS_CTL);
    for (int u = F.tid; u < (LDS_BYTES - LDSCTL_OFF) / 4; u += NWAVES * 64) ((LAS unsigned*)(F.lds + LDSCTL_OFF))[u] = 0u;
    __syncthreads();
    XcdBarrier bar; bar.bar = (unsigned*)(F.ctl + CW_BAR); bar.x = 0; bar.st = nullptr;
#if MK_ONE_LAUNCH
    bar = xcd_barrier_post((unsigned*)(F.ctl + CW_BAR), F.MISC + 8);
#define GRID_BAR() xcd_barrier(bar)
#else
#define GRID_BAR() do { } while (0)
#endif
    const int lo = args.ph_lo, hi = args.ph_hi;
#ifndef PH_MASK
#define PH_MASK 0xfff
#endif
#define IN(k) ((((PH_MASK) >> (k)) & 1) && lo <= (k) && (k) < hi)
#ifndef TIME_PHASE
#define TIME_PHASE -1
#endif
#define STAMP(i) do { if (TIME_PHASE >= 0 && blockIdx.x == 0 && F.tid == 0) ((unsigned long long*)(args.ws + WS_CTL + 768 * KiB))[i] = __builtin_amdgcn_s_memrealtime(); } while (0)
#define SEAM(k) do { if (IN(k) && IN((k) + 1)) GRID_BAR(); STAMP((k) + 1); } while (0)
    STAMP(0);
#ifndef GPROF_PHASE
#define GPROF_PHASE -1
#endif
#define GFLUSH(ph) do { if (GPROF_ON && GPROF_PHASE == (ph) && blockIdx.x == 0 && F.tid == 0) { unsigned long long* tsp = (unsigned long long*)(args.ws + WS_CTL + 768 * KiB); unsigned long long a_ = 0; tsp[20] = 0; for (int k_ = 0; k_ < 10; ++k_) { a_ += F.MISC[16 + k_]; tsp[21 + k_] = a_; } } } while (0)
#define MODP ((float*)(P.ws + WS_MOD))
#define PGATE ((unsigned char*)(P.ws + WS_PGATE))

    if (IN(0)) for (int rep_ = 0; rep_ < ((0) == DUP_PHASE ? 2 : 1); ++rep_) { if (rep_) GRID_BAR(); RELOAD_ARGS(); phase_mod(F, P.in[1], P.in[2], P.in[3], MODP); } SEAM(0);
    if (IN(1)) for (int rep_ = 0; rep_ < ((1) == DUP_PHASE ? 2 : 1); ++rep_) { if (rep_) GRID_BAR(); RELOAD_ARGS(); phase_prep(F, P); } SEAM(1);
    if (IN(2)) for (int rep_ = 0; rep_ < ((2) == DUP_PHASE ? 2 : 1); ++rep_) { if (rep_) GRID_BAR(); RELOAD_ARGS();
        pg8::Gemm g{DM, DM, DM}; pg8::DenseOrder S; S.init((const bf16_t*)((unsigned char*)P.out + DO_H), (const bf16_t*)(P.ws + WS_WIN), DM, DM, NTOK, INCOLS, F.G, (int)blockIdx.x);
        pg8::EpiP E{(bf16_t*)(P.ws + WS_PRW), (bf16_t*)(P.ws + WS_PATT), PGATE};
        pg8::gemm_phase<pg8::EpiP, pg8::DenseOrder, true>(F.lds, g, S, E); GFLUSH(2);
        { const int nfull = (NTOK / 256) * (INCOLS / 256) % F.G; const int bx = (int)blockIdx.x; if (nfull > 0 && bx >= nfull) expert_convert_down(F, P, (bx - nfull) * NWAVES + F.wave, (F.G - nfull) * NWAVES); else if (nfull == 0) expert_convert_down(F, P, bx * NWAVES + F.wave, F.G * NWAVES); }
    } SEAM(2);
    if (IN(3)) for (int rep_ = 0; rep_ < ((3) == DUP_PHASE ? 2 : 1); ++rep_) { if (rep_) GRID_BAR(); RELOAD_ARGS();
#pragma unroll 1
        for (int r2 = 0; r2 < (DUP_PHASE == 31 ? 2 : 1); ++r2)
#pragma unroll 1
        for (int u = (int)blockIdx.x; u < NB * 8 * 8; u += F.G) att::attn_unit(F, P, u >> 6, (u >> 3) & 7, u & 7);
        __syncthreads();
#pragma unroll 1
        for (int r2 = 0; r2 < (DUP_PHASE == 30 ? 2 : 1); ++r2) rc::chunk_phase(F, P);
        if (TIME_PHASE >= 20 && GPROF_PHASE < 0 && blockIdx.x == 0 && F.tid == 0) { unsigned long long* tsp = (unsigned long long*)(args.ws + WS_CTL + 768 * KiB); unsigned long long a_ = 0; tsp[20] = 0; for (int k_ = 0; k_ < 10; ++k_) { a_ += F.MISC[16 + k_]; tsp[21 + k_] = a_; } }
    } SEAM(3);
    constexpr int EC_ITEMS = NE * 2 * 256, EC_SPLIT = EC_ITEMS;
    if (IN(4)) for (int rep_ = 0; rep_ < ((4) == DUP_PHASE ? 2 : 1); ++rep_) { if (rep_) GRID_BAR(); RELOAD_ARGS();
        const int nR = F.G >= 256 ? 128 : F.G / 2, bx = (int)blockIdx.x;
        if (bx < nR) { for (int u = bx; u < NB * 8; u += nR) rc::state_chain(F, P, u); }
        else { const int na = F.G - nR, a = bx - nR; expert_convert(F, P, a * NWAVES + F.wave, na * NWAVES, 0, EC_SPLIT); }
    } SEAM(4);
    if (IN(5)) for (int rep_ = 0; rep_ < ((5) == DUP_PHASE ? 2 : 1); ++rep_) { if (rep_) GRID_BAR(); RELOAD_ARGS();
        const int gw = (int)blockIdx.x * NWAVES + F.wave, NGW = F.G * NWAVES;
        for (int w = gw; w < NB * 8 * 32 * 2; w += NGW) rc::out_unit(F, P, w >> 1, w & 1, !(DUP_PHASE == 5 && rep_ == 0));
        expert_convert(F, P, gw, NGW, EC_SPLIT, EC_ITEMS);
    } SEAM(5);
    if (IN(6)) for (int rep_ = 0; rep_ < ((6) == DUP_PHASE ? 2 : 1); ++rep_) { if (rep_) GRID_BAR(); RELOAD_ARGS();
        pg8::Gemm g{DM, DM, DM}; pg8::DenseOrder S; S.init((const bf16_t*)((unsigned char*)P.out + DO_YRA), (const bf16_t*)(P.ws + WS_WBR), DM, DM, NTOK, DM, F.G, (int)blockIdx.x);
        pg8::EpiMix E{(bf16_t*)(P.ws + WS_T), PGATE}; pg8::gemm_phase<pg8::EpiMix, pg8::DenseOrder, true>(F.lds, g, S, E);
    } SEAM(6);
    if (IN(7)) for (int rep_ = 0; rep_ < ((7) == DUP_PHASE ? 2 : 1); ++rep_) { if (rep_) GRID_BAR(); RELOAD_ARGS();
        pg8::Gemm g{DM, DM, DM}; pg8::DenseOrder S; S.init((const bf16_t*)(P.ws + WS_T), (const bf16_t*)(P.ws + WS_WOUT), DM, DM, NTOK, DM, F.G, (int)blockIdx.x);
        pg8::EpiDelta E{(bf16_t*)(P.ws + WS_DELTA), MODP}; E.scr = args.scr; pg8::gemm_phase<pg8::EpiDelta, pg8::DenseOrder, true>(F.lds, g, S, E); GFLUSH(7);
    } SEAM(7);
    if (IN(8)) for (int rep_ = 0; rep_ < ((8) == DUP_PHASE ? 2 : 1); ++rep_) { if (rep_) GRID_BAR(); RELOAD_ARGS(); phase_route(F, P); } SEAM(8);
    if (IN(9)) for (int rep_ = 0; rep_ < ((9) == DUP_PHASE ? 2 : 1); ++rep_) { if (rep_) GRID_BAR(); RELOAD_ARGS();
        moe_offsets(F); const LAS int* toff = (const LAS int*)(F.lds + TOFF_OFF);
        pg8::Gemm g{DM, DM, DM}; pg8::MoeOrderT<true> S{(const bf16_t*)(P.ws + WS_H2), (const bf16_t*)(P.ws + WS_WGU), DM, DM, (size_t)DM * DM, (const LAS unsigned char*)(F.lds + TILE_L_OFF), toff, (const LAS int*)(F.lds + LCNT_OFF), 0, toff[NLIST], F.G, (int)blockIdx.x, (const int*)(P.ws + WS_SLOTTOK)};
        pg8::EpiHid E{(bf16_t*)(P.ws + WS_HID)}; pg8::gemm_phase<pg8::EpiHid, pg8::MoeOrderT<true>, true>(F.lds, g, S, E); GFLUSH(9);
    } SEAM(9);
    if (IN(10)) for (int rep_ = 0; rep_ < ((10) == DUP_PHASE ? 2 : 1); ++rep_) { if (rep_) GRID_BAR(); RELOAD_ARGS();
        moe_offsets(F); const LAS int* toff = (const LAS int*)(F.lds + TOFF_OFF);
        pg8::Gemm g{DE, DE, DE}; pg8::MoeOrderT<false> S{(const bf16_t*)(P.ws + WS_HID), (const bf16_t*)(P.ws + WS_WD), DE, DE, (size_t)DM * DE, (const LAS unsigned char*)(F.lds + TILE_L_OFF), toff, (const LAS int*)(F.lds + LCNT_OFF), 0, toff[NLIST], F.G, (int)blockIdx.x, nullptr};
        pg8::EpiY E{(bf16_t*)(P.ws + WS_YB), (const float*)(P.ws + WS_SLOTW)}; pg8::gemm_phase<pg8::EpiY, pg8::MoeOrderT<false>, true>(F.lds, g, S, E); GFLUSH(10);
    } SEAM(10);
    if (IN(11)) for (int rep_ = 0; rep_ < ((11) == DUP_PHASE ? 2 : 1); ++rep_) { if (rep_) GRID_BAR(); RELOAD_ARGS();
        moe_offsets(F); const LAS int* toff = (const LAS int*)(F.lds + TOFF_OFF);
        const bf16_t* Yb = (const bf16_t*)(P.ws + WS_YB); const int* tok_list = (const int*)(P.ws + WS_TOKLIST); const int* tok_pos = (const int*)(P.ws + WS_TOKPOS);
        const float* mod = MODP; const int gw = F.vcu * NWAVES + F.wave, NGW = F.G * NWAVES;
#pragma unroll 4
        for (int tok = gw; tok < NTOK; tok += NGW) {
            const int s0 = toff[tok_list[2 * tok]] * 256 + tok_pos[2 * tok], s1 = toff[tok_list[2 * tok + 1]] * 256 + tok_pos[2 * tok + 1];
            const float* g2 = mod + (size_t)(tok / SEQ) * MODW + 5 * DM;
            GAS f32x4* xo = (GAS f32x4*)(P.out + (size_t)tok * DM) + F.lane; const GAS f32x4* xi = (const GAS f32x4*)(P.in[0] + (size_t)tok * DM) + F.lane; const GAS u32x2* dd = (const GAS u32x2*)((const bf16_t*)(P.ws + WS_DELTA) + (size_t)tok * DM) + F.lane;
            const GAS u32x2* y0 = (const GAS u32x2*)(Yb + (size_t)s0 * DM) + F.lane; const GAS u32x2* y1 = (const GAS u32x2*)(Yb + (size_t)s1 * DM) + F.lane;
#pragma unroll
            for (int j = 0; j < 4; ++j) { f32x4 xv = __builtin_nontemporal_load(xi + 64 * j); const u32x2 dw = __builtin_nontemporal_load(dd + 64 * j); xv.x += bf_lo(dw.x); xv.y += bf_hi(dw.x); xv.z += bf_lo(dw.y); xv.w += bf_hi(dw.y); const u32x2 a = __builtin_nontemporal_load(y0 + 64 * j), bq = __builtin_nontemporal_load(y1 + 64 * j); const f32x4 gv = *(const f32x4*)(g2 + 4 * F.lane + 256 * j);
                f32x4 o; o.x = xv.x + gv.x * (bf_lo(a.x) + bf_lo(bq.x)); o.y = xv.y + gv.y * (bf_hi(a.x) + bf_hi(bq.x)); o.z = xv.z + gv.z * (bf_lo(a.y) + bf_lo(bq.y)); o.w = xv.w + gv.w * (bf_hi(a.y) + bf_hi(bq.y));
                __builtin_nontemporal_store(o, xo + 64 * j); }
        }
    }
#ifdef EXTRA_BARS
    for (int i_ = 0; i_ < EXTRA_BARS; ++i_) GRID_BAR();
#endif
#if TIME_PHASE >= 0
    {
#ifndef TIME_SCALE
#define TIME_SCALE 3.0e-4f
#endif
#ifndef TIME_HI
#define TIME_HI (TIME_PHASE + 1)
#endif
        STAMP(12); GRID_BAR();
        const unsigned long long* ts = (const unsigned long long*)(args.ws + WS_CTL + 768 * KiB);
        const float dlt = (float)(ts[TIME_HI] - ts[TIME_PHASE]) * (0.01f * TIME_SCALE);
        for (int i = blockIdx.x * 512 + F.tid; i < (1 << 20); i += gridDim.x * 512) args.out[i] += dlt;
    }
#endif
#undef IN
#undef SEAM
}

extern "C" void kernel_launch(void* const* d_in, const int* in_sizes, int n_in, void* d_out, int out_size, void* d_ws, size_t ws_size, hipStream_t stream) {
    static int grid = 0;
    if (grid == 0) {
        if (n_in != 31 || out_size != NTOK * DM || ws_size < WS_END) { fprintf(stderr, "kernel_launch: unexpected shapes (n_in %d out %d ws %zu)\n", n_in, out_size, ws_size); grid = -1; return; }
        int dev = 0, cus = 0;
        if (hipGetDevice(&dev) != hipSuccess || hipDeviceGetAttribute(&cus, hipDeviceAttributeMultiprocessorCount, dev) != hipSuccess) { grid = -1; return; }
        if (hipFuncSetAttribute((const void*)fwd_kernel, hipFuncAttributeMaxDynamicSharedMemorySize, LDS_BYTES) != hipSuccess) { fprintf(stderr, "kernel_launch: hipFuncSetAttribute failed\n"); grid = -1; return; }
        int per_cu = 0; (void)hipOccupancyMaxActiveBlocksPerMultiprocessor(&per_cu, (const void*)fwd_kernel, NWAVES * 64, LDS_BYTES); (void)hipGetLastError();
        grid = cus;
    }
    if (grid < 0) return;
    (void)hipMemsetAsync((char*)d_ws + WS_CTL, 0, CTL_ZERO_BYTES, stream);
    Args a{};
    for (int i = 0; i < 31; ++i) a.in[i] = (const float*)d_in[i];
    a.out = (float*)d_out; a.ws = (unsigned char*)d_ws;
#if MK_ONE_LAUNCH
    a.ph_lo = 0; a.ph_hi = N_PHASES;
    hipLaunchKernelGGL(fwd_kernel, dim3(grid), dim3(NWAVES * 64), LDS_BYTES, stream, a);
#else
    for (int p = 0; p < N_PHASES; ++p) {
#ifdef PROBE7
        if (p == 7) { a.ph_lo = 7; a.ph_hi = 8; a.scr = PROBE7 - 1; hipLaunchKernelGGL(fwd_kernel, dim3(grid), dim3(NWAVES * 64), LDS_BYTES, stream, a); a.scr = 0; }
#endif
        a.ph_lo = p; a.ph_hi = p + 1; hipLaunchKernelGGL(fwd_kernel, dim3(grid), dim3(NWAVES * 64), LDS_BYTES, stream, a); }
#endif
}
```

```cpp
#include <hip/hip_runtime.h>
#include <cstdio>
#include <cstdint>

#define LAS __attribute__((address_space(3)))
#define GAS __attribute__((address_space(1)))
typedef unsigned short bf16_t;
typedef short bf16x8 __attribute__((ext_vector_type(8)));
typedef short s16x4 __attribute__((ext_vector_type(4)));
typedef float f32x4 __attribute__((ext_vector_type(4)));
typedef float f32x2 __attribute__((ext_vector_type(2)));
typedef float f32x16 __attribute__((ext_vector_type(16)));
typedef unsigned u32x4 __attribute__((ext_vector_type(4)));
typedef unsigned u32x2 __attribute__((ext_vector_type(2)));

constexpr int NB = 16, SEQ = 2048, DM = 1024, NTOK = NB * SEQ;
constexpr int RCOLS = 1792, ACOLS = 1536, GCOLS = 2048, INCOLS = 5376;
constexpr int NE = 32, DE = 512, NLIST = 64;
constexpr int MODW = 6 * DM;
constexpr float LOG2E = 1.4426950408889634f;

typedef __bf16 bf16x2_t __attribute__((ext_vector_type(2)));
__device__ __forceinline__ unsigned cvt_pk_bf16(float lo, float hi) { const f32x2 v = {lo, hi}; const bf16x2_t b = __builtin_convertvector(v, bf16x2_t); return __builtin_bit_cast(unsigned, b); }
__device__ __forceinline__ float bf_lo(unsigned w) { return __uint_as_float(w << 16); }
__device__ __forceinline__ float bf_hi(unsigned w) { return __uint_as_float(w & 0xffff0000u); }
__device__ __forceinline__ float sigmoidf_(float x) { return __builtin_amdgcn_rcpf(1.0f + __builtin_amdgcn_exp2f(-x * LOG2E)); }

#ifndef GPROF_ON
#define GPROF_ON 0
#endif
#define GPROF(k) do { if (GPROF_ON && blockIdx.x == 0 && threadIdx.x == 0) { volatile LAS unsigned* M_ = (volatile LAS unsigned*)(lds + (163840 - 2048)); const unsigned now_ = (unsigned)__builtin_amdgcn_s_memrealtime(); M_[16 + (k)] += now_ - M_[15]; M_[15] = now_; } } while (0)
#define EPI_ST0(T_, p_, v_) (*(T_*)(p_) = v_)
#ifndef EPI_NT
#define EPI_NT 1
#endif
#if EPI_NT
#define EPI_ST(T_, p_, v_) __builtin_nontemporal_store(v_, (T_*)(p_))
#else
#define EPI_ST(T_, p_, v_) (*(T_*)(p_) = v_)
#endif
namespace pg8 {
constexpr int BM = 256, BK = 64, HALF = 128, HTB = HALF * BK * 2, STAGE_BYTES = 8 * HTB, NXCD = 8, WGM = 8;
__host__ __device__ __forceinline__ int lds_byte(int r, int c) { const int st = (r >> 4) * 2 + (c >> 5), rr = r & 15, cc = c & 31, ob = rr * 64 + cc * 2; return st * 1024 + (ob ^ (((ob >> 9) & 1) << 5)); }
__host__ __device__ __forceinline__ void stage_rc(int b, int& R, int& C) { const int st = b / 1024, sb = b % 1024, swz = sb ^ (((sb >> 9) & 1) << 5); R = (st >> 1) * 16 + swz / 64; C = (st & 1) * 32 + (swz % 64) / 2; }
__host__ __device__ __forceinline__ int perm32(int rho) { const int n = rho >> 4, i = rho & 15; return 8 * (i >> 2) + 4 * n + (i & 3); }

struct Unit { int pm, pn, e, sbase, nvalid; };
struct Gemm { int lda, ldb, K; };

struct DenseOrder {
    static constexpr bool GATHER = false;
    __device__ __forceinline__ int row_tok(const Unit&, int) const { return 0; }
    const bf16_t* A; const bf16_t* Bt; int lda, ldb;
    int nM, nN, nwg, G, c;
    __device__ void init(const bf16_t* A_, const bf16_t* Bt_, int lda_, int ldb_, int M, int N, int G_, int c_) { A = A_; Bt = Bt_; lda = lda_; ldb = ldb_; nM = M / BM; nN = N / BM; nwg = nM * nN; G = G_; c = c_; }
    __device__ bool next(int i, Unit& u) const {
        const long L = (long)i * G + c; if (L >= nwg) return false;
        int wgid = (int)L; { const int q = nwg / NXCD, r = nwg % NXCD, xcd = wgid % NXCD, off = wgid / NXCD; wgid = (xcd < r ? xcd * (q + 1) : r * (q + 1) + (xcd - r) * q) + off; }
        const int nig = WGM * nN, gid = wgid / nig, fm = gid * WGM, gsz = (nM - fm) < WGM ? (nM - fm) : WGM;
        u.pm = fm + ((wgid % nig) % gsz); u.pn = (wgid % nig) / gsz; u.e = 0; u.sbase = 0; u.nvalid = BM; return true;
    }
    __device__ __forceinline__ const char* a_base(const Unit& u) const { return (const char*)A + (size_t)u.pm * BM * lda * 2; }
    __device__ __forceinline__ const char* b_base(const Unit& u) const { return (const char*)Bt + (size_t)u.pn * BM * ldb * 2; }
};
template <bool GATHER_> struct MoeOrderT {
    static constexpr bool GATHER = GATHER_;
    const bf16_t* A; const bf16_t* Bt; int lda, ldb; size_t bt_expert_stride;
    const LAS unsigned char* tile_l;
    const LAS int* toff; const LAS int* lcnt;
    int tlo, thi, G, c;
    const int* slot_tok;
    __device__ __forceinline__ int row_tok(const Unit& u, int r) const { return r < u.nvalid ? slot_tok[u.sbase + r] : 0; }
    __device__ bool next(int i, Unit& u) const {
        const int nt = thi - tlo; int tile, pn;
        if (G % NXCD == 0) { const int x = c % NXCD, cin = c / NXCD, per = G / NXCD; const int t0 = (int)((long)nt * x / NXCD), t1 = (int)((long)nt * (x + 1) / NXCD);
            const long j = (long)i * per + cin; if (j >= (long)(t1 - t0) * 4) return false; tile = tlo + t0 + (int)(j >> 2); pn = (int)(j & 3); }
        else { const long L = (long)i * G + c; if (L >= (long)nt * 4) return false; tile = tlo + (int)(L >> 2); pn = (int)(L & 3); }
        const int l = tile_l[tile], j = tile - toff[l]; u.pm = tile; u.pn = pn; u.e = l >> 1; u.sbase = l * NTOK + j * BM; u.nvalid = lcnt[l] - j * BM; return true;
    }
    __device__ __forceinline__ const char* a_base(const Unit& u) const { return GATHER ? (const char*)A : (const char*)A + (size_t)u.pm * BM * lda * 2; }
    __device__ __forceinline__ const char* b_base(const Unit& u) const { return (const char*)Bt + ((size_t)u.e * bt_expert_stride + (size_t)u.pn * BM * ldb) * 2; }
};

template <class Epi, class Sched, bool ALIGN_EPI>
__device__ __forceinline__ void gemm_phase(LAS unsigned char* lds, const Gemm g, const Sched& S, const Epi& E) {
    const int tid = threadIdx.x, wid = __builtin_amdgcn_readfirstlane(tid >> 6), lane = tid & 63, wr = wid >> 2, wc = wid & 3, fr = lane & 15, fq = lane >> 4;
    const int K = g.K, nt = K / BK;
    unsigned voffA[2], voffB[2]; int RA[2], CA2[2];
#pragma unroll
    for (int i = 0; i < 2; ++i) { int R, C; stage_rc(tid * 16 + i * 8192, R, C); RA[i] = R; CA2[i] = C * 2; const int Rb = Epi::PERM ? ((R & ~31) + perm32(R & 31)) : R;
        voffA[i] = (unsigned)(R * g.lda + C) * 2u; voffB[i] = (unsigned)(Rb * g.ldb + C) * 2u; }
    const size_t kstep = (size_t)(BK * 2);
    const size_t hstepA = (size_t)HALF * g.lda * 2, hstepB = (size_t)HALF * g.ldb * 2;
    const unsigned ldsw = (unsigned)wid * 1024u;
    const int aoff = lds_byte(wr * 64 + fr, fq * 8), boff = lds_byte(wc * 32 + fr, fq * 8);
#define PG8_SA(b, h) (((b) * 2 + (h)) * HTB)
#define PG8_SB(b, h) ((4 + (b) * 2 + (h)) * HTB)
#define PG8_STAGE(bufoff, gbase, voff) do { _Pragma("unroll") for (int _i = 0; _i < 2; ++_i) \
        __builtin_amdgcn_global_load_lds((const unsigned*)((const char*)(gbase) + (voff)[_i]), (LAS unsigned*)(lds + (bufoff) + ldsw + _i * 8192), 16, 0, 0); } while (0)
#define PG8_STAGE_A(bufoff, kptr, half, nx) do { if constexpr (Sched::GATHER) { _Pragma("unroll") for (int _i = 0; _i < 2; ++_i) \
        __builtin_amdgcn_global_load_lds((const unsigned*)((const char*)(kptr) + ((nx) ? vnx[half][_i] : vcu[half][_i])), (LAS unsigned*)(lds + (bufoff) + ldsw + _i * 8192), 16, 0, 0); } \
    else { PG8_STAGE(bufoff, (const char*)(kptr) + ((half) ? hstepA : 0), voffA); } } while (0)
#define PG8_LDA(dst, b, h) do { _Pragma("unroll") for (int m = 0; m < 4; ++m) _Pragma("unroll") for (int k = 0; k < 2; ++k) dst[m][k] = *(const LAS bf16x8*)(lds + PG8_SA(b, h) + aoff + m * 2048 + k * 1024); } while (0)
#define PG8_LDB(dst, b, h) do { _Pragma("unroll") for (int n = 0; n < 2; ++n) _Pragma("unroll") for (int k = 0; k < 2; ++k) dst[n][k] = *(const LAS bf16x8*)(lds + PG8_SB(b, h) + boff + n * 2048 + k * 1024); } while (0)
#define PG8_MMA(ai, bj, At, Bt) do { __builtin_amdgcn_s_setprio(1); _Pragma("unroll") for (int m = 0; m < 4; ++m) _Pragma("unroll") for (int n = 0; n < 2; ++n) _Pragma("unroll") for (int k = 0; k < 2; ++k) \
        acc[ai][bj][m][n] = __builtin_amdgcn_mfma_f32_16x16x32_bf16(Bt[n][k], At[m][k], acc[ai][bj][m][n], 0, 0, 0); __builtin_amdgcn_s_setprio(0); } while (0)
#define PG8_WAIT_V(n) asm volatile("s_waitcnt vmcnt(" #n ")" ::: "memory")
#define PG8_WAIT_L(n) asm volatile("s_waitcnt lgkmcnt(" #n ")" ::: "memory")
#define PG8_BAR __builtin_amdgcn_s_barrier()
#define PG8_SCHED __builtin_amdgcn_sched_barrier(0)
    Unit cur, nxt; int ui = 0;
    if (!S.next(0, cur)) return;
    f32x4 acc[2][2][4][2];
#pragma unroll
    for (int a = 0; a < 2; ++a)
#pragma unroll
        for (int b = 0; b < 2; ++b)
#pragma unroll
            for (int m = 0; m < 4; ++m)
#pragma unroll
                for (int n = 0; n < 2; ++n) acc[a][b][m][n] = (f32x4){0.f, 0.f, 0.f, 0.f};
    bf16x8 At[4][2], B0[2][2], B1[2][2];
    const char* cA = S.a_base(cur); const char* cB = S.b_base(cur);
    unsigned vcu[2][2], vnx[2][2];
    if constexpr (Sched::GATHER) {
#pragma unroll
        for (int hf = 0; hf < 2; ++hf)
#pragma unroll
            for (int i = 0; i < 2; ++i) { vcu[hf][i] = (unsigned)S.row_tok(cur, hf * HALF + RA[i]) * (unsigned)(g.lda * 2) + (unsigned)CA2[i]; vnx[hf][i] = vcu[hf][i]; } }
    if (GPROF_ON && blockIdx.x == 0 && threadIdx.x == 0) { volatile LAS unsigned* M_ = (volatile LAS unsigned*)(lds + (163840 - 2048)); for (int k_ = 0; k_ < 10; ++k_) M_[16 + k_] = 0; M_[15] = (unsigned)__builtin_amdgcn_s_memrealtime(); }
    PG8_STAGE(PG8_SB(0, 0), cB, voffB); PG8_STAGE(PG8_SB(0, 1), cB + hstepB, voffB); PG8_STAGE_A(PG8_SA(0, 0), cA, 0, false); PG8_STAGE_A(PG8_SA(0, 1), cA, 1, false);
    if (wr == 1) PG8_BAR;
    PG8_WAIT_V(2); PG8_BAR;
    PG8_STAGE(PG8_SB(1, 0), cB + kstep, voffB); PG8_STAGE_A(PG8_SA(1, 0), cA + kstep, 0, false); PG8_STAGE(PG8_SB(1, 1), cB + hstepB + kstep, voffB);
    PG8_WAIT_V(6); PG8_BAR;
    for (;;) {
        const bool has_next = S.next(ui + 1, nxt);
        const char* nA = has_next ? S.a_base(nxt) : cA; const char* nB = has_next ? S.b_base(nxt) : cB;
        if constexpr (Sched::GATHER) { if (has_next) {
#pragma unroll
            for (int hf = 0; hf < 2; ++hf)
#pragma unroll
                for (int i = 0; i < 2; ++i) vnx[hf][i] = (unsigned)S.row_tok(nxt, hf * HALF + RA[i]) * (unsigned)(g.lda * 2) + (unsigned)CA2[i]; } }
        for (int t = 0; t < nt; t += 2) {
            if constexpr (Epi::HAS_MID) { if (t == Epi::MID_T) E.mid(acc, cur, wr, wc, fr, fq); }
            const bool last = (t == nt - 2);
            const char* a1 = cA + (size_t)(t + 1) * kstep;
            const char* a2 = last ? nA : cA + (size_t)(t + 2) * kstep; const char* b2 = last ? nB : cB + (size_t)(t + 2) * kstep;
            const char* a3 = a2 + kstep; const char* b3 = b2 + kstep;
            PG8_LDB(B0, 0, 0); PG8_LDB(B1, 0, 1); PG8_SCHED; PG8_LDA(At, 0, 0); PG8_STAGE_A(PG8_SA(1, 1), a1, 1, false);
            PG8_WAIT_V(8); PG8_WAIT_L(0); PG8_BAR; PG8_MMA(0, 0, At, B0); PG8_MMA(0, 1, At, B1); PG8_BAR; PG8_SCHED;
            PG8_LDA(At, 0, 1); PG8_STAGE(PG8_SB(0, 0), b2, voffB); PG8_STAGE(PG8_SB(0, 1), b2 + hstepB, voffB); PG8_STAGE_A(PG8_SA(0, 0), a2, 0, last);
            PG8_WAIT_V(8); PG8_WAIT_L(0); PG8_BAR; PG8_MMA(1, 0, At, B0); PG8_MMA(1, 1, At, B1); PG8_BAR; PG8_SCHED;
            PG8_LDB(B0, 1, 0); PG8_LDB(B1, 1, 1); PG8_SCHED; PG8_LDA(At, 1, 0); PG8_STAGE_A(PG8_SA(0, 1), a2, 1, last);
            PG8_WAIT_V(8); PG8_WAIT_L(0); PG8_BAR; PG8_MMA(0, 0, At, B0); PG8_MMA(0, 1, At, B1); PG8_BAR; PG8_SCHED;
            PG8_LDA(At, 1, 1); PG8_STAGE(PG8_SB(1, 0), b3, voffB); PG8_STAGE(PG8_SB(1, 1), b3 + hstepB, voffB); PG8_STAGE_A(PG8_SA(1, 0), a3, 0, last);
            PG8_WAIT_V(8); PG8_WAIT_L(0); PG8_BAR; PG8_MMA(1, 0, At, B0); PG8_MMA(1, 1, At, B1); PG8_BAR; PG8_SCHED;
            if (GPROF_ON) { if (t == 0) GPROF(3); }
        }
        GPROF(0);
        if constexpr (ALIGN_EPI) { if (wr == 0) PG8_BAR; }
        GPROF(1);
        E(acc, cur, wr, wc, fr, fq);
        GPROF(2);
        if (!has_next) break;
#pragma unroll
        for (int a = 0; a < 2; ++a)
#pragma unroll
            for (int b = 0; b < 2; ++b)
#pragma unroll
                for (int m = 0; m < 4; ++m)
#pragma unroll
                    for (int n = 0; n < 2; ++n) acc[a][b][m][n] = (f32x4){0.f, 0.f, 0.f, 0.f};
        cur = nxt; cA = nA; cB = nB; ++ui;
        if constexpr (Sched::GATHER) {
#pragma unroll
            for (int hf = 0; hf < 2; ++hf)
#pragma unroll
                for (int i = 0; i < 2; ++i) vcu[hf][i] = vnx[hf][i]; }
        if constexpr (ALIGN_EPI) { if (wr == 1) PG8_BAR; }
    }
    PG8_WAIT_V(0);
    if constexpr (!ALIGN_EPI) { if (wr == 0) PG8_BAR; }
    PG8_BAR;
#undef PG8_SA
#undef PG8_SB
#undef PG8_STAGE
#undef PG8_STAGE_A
#undef PG8_LDA
#undef PG8_LDB
#undef PG8_MMA
#undef PG8_WAIT_V
#undef PG8_WAIT_L
#undef PG8_BAR
#undef PG8_SCHED
}

__device__ __forceinline__ unsigned q8(float x) { float s = sigmoidf_(x) * 255.f + 0.5f; s = s < 1.f ? 1.f : s; return (unsigned)s; }
struct EpiP {
    static constexpr bool PERM = true, HAS_MID = false;
    bf16_t *Prw, *Patt; unsigned char* Pgate;
    __device__ __forceinline__ void operator()(const f32x4 (&acc)[2][2][4][2], const Unit& u, int wr, int wc, int fr, int fq) const {
        const int row0 = u.pm * BM + wr * 64 + fr;
        if (u.pn >= 13) { const int col0 = (u.pn - 13) * BM + wc * 32 + 8 * fq;
#pragma unroll
            for (int ai = 0; ai < 2; ++ai)
#pragma unroll
                for (int m = 0; m < 4; ++m) { unsigned char* rowp = Pgate + (size_t)(row0 + ai * HALF + m * 16) * GCOLS + col0;
#pragma unroll
                    for (int bj = 0; bj < 2; ++bj) { const f32x4 v0 = acc[ai][bj][m][0], v1 = acc[ai][bj][m][1];
                        u32x2 w; w.x = q8(v0[0]) | (q8(v0[1]) << 8) | (q8(v0[2]) << 16) | (q8(v0[3]) << 24); w.y = q8(v1[0]) | (q8(v1[1]) << 8) | (q8(v1[2]) << 16) | (q8(v1[3]) << 24);
                        EPI_ST(u32x2, rowp + bj * HALF, w); } }
            return; }
        bf16_t* base; int ldc, colt;
        if (u.pn < 7) { base = Prw; ldc = RCOLS; colt = u.pn * BM; } else { base = Patt; ldc = ACOLS; colt = (u.pn - 7) * BM; }
        const int col0 = colt + wc * 32 + 8 * fq;
#pragma unroll
        for (int ai = 0; ai < 2; ++ai)
#pragma unroll
            for (int m = 0; m < 4; ++m) { bf16_t* rowp = base + (size_t)(row0 + ai * HALF + m * 16) * ldc + col0;
#pragma unroll
                for (int bj = 0; bj < 2; ++bj) { const f32x4 v0 = acc[ai][bj][m][0], v1 = acc[ai][bj][m][1];
                    u32x4 w; w.x = cvt_pk_bf16(v0[0], v0[1]); w.y = cvt_pk_bf16(v0[2], v0[3]); w.z = cvt_pk_bf16(v1[0], v1[1]); w.w = cvt_pk_bf16(v1[2], v1[3]);
                    EPI_ST(u32x4, rowp + bj * HALF, w); } }
    }
};
struct EpiMix {
    static constexpr bool PERM = true, HAS_MID = true; static constexpr int MID_T = 8;
    bf16_t* T; const unsigned char* Pgate;
    static __device__ __forceinline__ float ub(unsigned w, int i) { return (float)((w >> (8 * i)) & 0xffu); }
    __device__ __forceinline__ void mid(f32x4 (&acc)[2][2][4][2], const Unit& u, int wr, int wc, int fr, int fq) const {
        int row0 = u.pm * BM + wr * 64 + fr, col0 = u.pn * BM + wc * 32 + 8 * fq; asm volatile("" : "+v"(row0), "+v"(col0));
#pragma unroll
        for (int ai = 0; ai < 2; ++ai) {
            u32x2 gr[4][2], ga[4][2];
#pragma unroll
            for (int m = 0; m < 4; ++m) { const unsigned char* gp = Pgate + (size_t)(row0 + ai * HALF + m * 16) * GCOLS + col0;
#pragma unroll
                for (int bj = 0; bj < 2; ++bj) { gr[m][bj] = *(const u32x2*)(gp + bj * HALF); ga[m][bj] = *(const u32x2*)(gp + DM + bj * HALF); } }
#pragma unroll
            for (int m = 0; m < 4; ++m)
#pragma unroll
                for (int bj = 0; bj < 2; ++bj) { const u32x2 r = gr[m][bj], a = ga[m][bj]; f32x4& v0 = acc[ai][bj][m][0]; f32x4& v1 = acc[ai][bj][m][1];
#pragma unroll
                    for (int j = 0; j < 4; ++j) { v0[j] *= ub(r.x, j) * __builtin_amdgcn_rcpf(ub(a.x, j)); v1[j] *= ub(r.y, j) * __builtin_amdgcn_rcpf(ub(a.y, j)); } }
            asm volatile("" ::: "memory");
        }
    }
    __device__ __forceinline__ void operator()(const f32x4 (&acc)[2][2][4][2], const Unit& u, int wr, int wc, int fr, int fq) const {
        const int row0 = u.pm * BM + wr * 64 + fr, col0 = u.pn * BM + wc * 32 + 8 * fq;
        u32x2 ga[2][4][2];
#pragma unroll
        for (int ai = 0; ai < 2; ++ai)
#pragma unroll
            for (int m = 0; m < 4; ++m)
#pragma unroll
                for (int bj = 0; bj < 2; ++bj) ga[ai][m][bj] = *(const u32x2*)(Pgate + (size_t)(row0 + ai * HALF + m * 16) * GCOLS + DM + col0 + bj * HALF);
#pragma unroll
        for (int ai = 0; ai < 2; ++ai)
#pragma unroll
            for (int m = 0; m < 4; ++m) { const size_t row = (size_t)(row0 + ai * HALF + m * 16);
#pragma unroll
                for (int bj = 0; bj < 2; ++bj) { const int col = col0 + bj * HALF; const u32x2 g = ga[ai][m][bj]; constexpr float s = 1.f / 255.f;
                    const f32x4 a0 = acc[ai][bj][m][0], a1 = acc[ai][bj][m][1];
                    u32x4 w; w.x = cvt_pk_bf16(a0[0] * ub(g.x, 0) * s, a0[1] * ub(g.x, 1) * s); w.y = cvt_pk_bf16(a0[2] * ub(g.x, 2) * s, a0[3] * ub(g.x, 3) * s);
                    w.z = cvt_pk_bf16(a1[0] * ub(g.y, 0) * s, a1[1] * ub(g.y, 1) * s); w.w = cvt_pk_bf16(a1[2] * ub(g.y, 2) * s, a1[3] * ub(g.y, 3) * s);
                    EPI_ST0(u32x4, T + row * DM + col, w); } }
    }
};
struct EpiDelta {
    static constexpr bool PERM = true, HAS_MID = false;
    bf16_t* D; const float* mod; int scr = 0;
    __device__ __forceinline__ void operator()(const f32x4 (&acc)[2][2][4][2], const Unit& u, int wr, int wc, int fr, int fq) const {
        const int row0 = u.pm * BM + wr * 64 + fr, col0 = u.pn * BM + wc * 32 + 8 * fq;
        const int b = (u.pm * BM) / SEQ; const float* g1 = mod + (size_t)b * MODW + 2 * DM;
#ifdef SCR_PROBE
        if (scr) {
            bf16_t* base = D + (size_t)(u.pm * 4 + u.pn) * 65536 + (wr * 4 + wc) * 8192 + (fq * 16 + fr) * 8;
#pragma unroll
            for (int ai = 0; ai < 2; ++ai)
#pragma unroll
                for (int m = 0; m < 4; ++m)
#pragma unroll
                    for (int bj = 0; bj < 2; ++bj) { const f32x4 v0 = acc[ai][bj][m][0], v1 = acc[ai][bj][m][1];
                        u32x4 w; w.x = cvt_pk_bf16(v0[0], v0[1]); w.y = cvt_pk_bf16(v0[2], v0[3]); w.z = cvt_pk_bf16(v1[0], v1[1]); w.w = cvt_pk_bf16(v1[2], v1[3]);
                        *(u32x4*)(base + (ai * 8 + m * 2 + bj) * 512) = w; }
            return; }
#endif
        f32x4 gv[2][2];
#pragma unroll
        for (int bj = 0; bj < 2; ++bj)
#pragma unroll
            for (int n = 0; n < 2; ++n) gv[bj][n] = *(const f32x4*)(g1 + col0 + bj * HALF + 4 * n);
#pragma unroll
        for (int ai = 0; ai < 2; ++ai)
#pragma unroll
            for (int m = 0; m < 4; ++m) { bf16_t* rowp = D + (size_t)(row0 + ai * HALF + m * 16) * DM + col0;
#pragma unroll
                for (int bj = 0; bj < 2; ++bj) { const f32x4 v0 = acc[ai][bj][m][0] * gv[bj][0], v1 = acc[ai][bj][m][1] * gv[bj][1];
                    u32x4 w; w.x = cvt_pk_bf16(v0[0], v0[1]); w.y = cvt_pk_bf16(v0[2], v0[3]); w.z = cvt_pk_bf16(v1[0], v1[1]); w.w = cvt_pk_bf16(v1[2], v1[3]);
                    EPI_ST0(u32x4, rowp + bj * HALF, w); } }
    }
};
struct EpiHid {
    static constexpr bool PERM = true, HAS_MID = false;
    bf16_t* hid;
    __device__ __forceinline__ void operator()(const f32x4 (&acc)[2][2][4][2], const Unit& u, int wr, int wc, int fr, int fq) const {
        const int row0 = u.pm * BM + wr * 64 + fr, hc0 = u.pn * 128 + wc * 16 + 4 * fq;
#pragma unroll
        for (int ai = 0; ai < 2; ++ai)
#pragma unroll
            for (int m = 0; m < 4; ++m) { bf16_t* rowp = hid + (size_t)(row0 + ai * HALF + m * 16) * DE + hc0;
#pragma unroll
                for (int bj = 0; bj < 2; ++bj) { const f32x4 gt = acc[ai][bj][m][0], up = acc[ai][bj][m][1]; float h[4];
#pragma unroll
                    for (int j = 0; j < 4; ++j) h[j] = gt[j] * sigmoidf_(gt[j]) * up[j];
                    u32x2 w; w.x = cvt_pk_bf16(h[0], h[1]); w.y = cvt_pk_bf16(h[2], h[3]); EPI_ST0(u32x2, rowp + bj * 64, w); } }
    }
};
struct EpiY {
    static constexpr bool PERM = true, HAS_MID = false;
    bf16_t* Y; const float* slot_w;
    __device__ __forceinline__ void operator()(const f32x4 (&acc)[2][2][4][2], const Unit& u, int wr, int wc, int fr, int fq) const {
        const int row0 = u.pm * BM + wr * 64 + fr, col0 = u.pn * BM + wc * 32 + 8 * fq;
        float w[2][4];
#pragma unroll
        for (int ai = 0; ai < 2; ++ai)
#pragma unroll
            for (int m = 0; m < 4; ++m) { const int r = wr * 64 + fr + ai * HALF + m * 16; w[ai][m] = r < u.nvalid ? slot_w[u.sbase + r] : 0.f; }
#pragma unroll
        for (int ai = 0; ai < 2; ++ai)
#pragma unroll
            for (int m = 0; m < 4; ++m) { bf16_t* rowp = Y + (size_t)(row0 + ai * HALF + m * 16) * DM + col0; const float ws = w[ai][m];
#pragma unroll
                for (int bj = 0; bj < 2; ++bj) { const f32x4 v0 = acc[ai][bj][m][0] * ws, v1 = acc[ai][bj][m][1] * ws;
                    u32x4 o; o.x = cvt_pk_bf16(v0[0], v0[1]); o.y = cvt_pk_bf16(v0[2], v0[3]); o.z = cvt_pk_bf16(v1[0], v1[1]); o.w = cvt_pk_bf16(v1[2], v1[3]);
                    EPI_ST0(u32x4, rowp + bj * HALF, o); } }
    }
};
}
typedef GAS unsigned gu32;
#define RLX_AGENT __ATOMIC_RELAXED, __HIP_MEMORY_SCOPE_AGENT
#define LDS_WAIT() asm volatile("s_waitcnt lgkmcnt(0)" ::: "memory")
#define VM_WAIT() asm volatile("s_waitcnt vmcnt(0)" ::: "memory")
#define XB_TMO      128
#define XB_XCNT(j)  (256  + 64 * (j))
#define XB_XSUB(j)  (1280 + 64 * (j))
#define XB_XGEN(j)  (2304 + 64 * (j))
#define XB_TOP      3328
#define XB_TOPGEN   3392
#define XCD_BAR_WORDS 3456
#define XB_SPIN_CAP (1u << 18)

__device__ __forceinline__ unsigned xb_ld(unsigned* p)              { return __hip_atomic_load(p, __ATOMIC_RELAXED, __HIP_MEMORY_SCOPE_AGENT); }
__device__ __forceinline__ unsigned xb_add(unsigned* p, unsigned v) { return __hip_atomic_fetch_add(p, v, __ATOMIC_RELAXED, __HIP_MEMORY_SCOPE_AGENT); }
__device__ __forceinline__ unsigned xb_xcc_id() { return (unsigned)__builtin_amdgcn_s_getreg((3 << 11) | 20) & 0xFu; }
#define XB_SPIN(cond, bar) do { unsigned _sp = 0; while (cond) { __builtin_amdgcn_s_sleep(1); \
    if ((++_sp & 255u) == 0u) { if (xb_ld(&(bar)[XB_TMO])) break; if (_sp > XB_SPIN_CAP) { atomicAdd(&(bar)[XB_TMO], 1u); break; } } } } while (0)

struct XcdBarrier {
    unsigned* bar; unsigned x;
    volatile LAS unsigned* st;
};

__device__ __forceinline__ XcdBarrier xcd_barrier_post(unsigned* bar, volatile LAS unsigned* st) {
    XcdBarrier b; b.bar = bar; b.x = xb_xcc_id(); b.st = st;
    if (threadIdx.x == 0) (void)xb_add(&bar[XB_XCNT(b.x)], 1u);
    return b;
}
__device__ __forceinline__ void xcd_barrier_complete(unsigned* bar, unsigned x, unsigned& nloc, unsigned& nx) {
    const unsigned G = gridDim.x * gridDim.y * gridDim.z;
    unsigned sum, cnt, mine, sp = 0u;
    for (;;) {
        sum = 0u; cnt = 0u; mine = 0u;
#pragma unroll
        for (unsigned j = 0; j < 16; ++j) { const unsigned c = xb_ld(&bar[XB_XCNT(j)]); sum += c; cnt += (c > 0u) ? 1u : 0u; mine = (j == x) ? c : mine; }
        if (sum == G) break;
        __builtin_amdgcn_s_sleep(1);
        if ((++sp & 255u) == 0u) { if (xb_ld(&bar[XB_TMO])) break; if (sp > XB_SPIN_CAP) { atomicAdd(&bar[XB_TMO], 1u); break; } }
    }
    nloc = mine > 0u ? mine : 1u; nx = cnt > 0u ? cnt : 1u;
}

__device__ __forceinline__ void xcd_barrier(const XcdBarrier& b) {
    asm volatile("s_waitcnt vmcnt(0)" ::: "memory");
    __syncthreads();
    if (threadIdx.x == 0) {
        unsigned* bar = b.bar;
        __builtin_amdgcn_s_waitcnt(0);
        unsigned nloc = b.st[0], nx = b.st[1];
        if (nloc == 0u) { xcd_barrier_complete(bar, b.x, nloc, nx); b.st[0] = nloc; b.st[1] = nx; }
        const unsigned old = xb_add(&bar[XB_XSUB(b.x)], 1u);
        const unsigned gen = old / nloc;
        if (old + 1u == (gen + 1u) * nloc) {
            __builtin_amdgcn_fence(__ATOMIC_RELEASE, "agent");
            asm volatile("s_waitcnt vmcnt(0)" ::: "memory");
            const unsigned og = xb_add(&bar[XB_TOP], 1u);
            const unsigned tg = og / nx;
            if (og + 1u == (tg + 1u) * nx) xb_add(&bar[XB_TOPGEN], 1u);
            else XB_SPIN(xb_ld(&bar[XB_TOPGEN]) == tg, bar);
            __builtin_amdgcn_fence(__ATOMIC_ACQUIRE, "agent");
            xb_add(&bar[XB_XGEN(b.x)], 1u);
            asm volatile("s_waitcnt vmcnt(0)" ::: "memory");
        } else {
            XB_SPIN(xb_ld(&bar[XB_XGEN(b.x)]) == gen, bar);
            __builtin_amdgcn_fence(__ATOMIC_ACQUIRE, "agent");
            asm volatile("s_waitcnt vmcnt(0)" ::: "memory");
        }
    }
    __syncthreads();
}

constexpr int NWAVES = 8;
constexpr size_t MiB = 1u << 20, KiB = 1u << 10;
constexpr size_t WS_CTL = 0, CTL_ZERO_BYTES = 2 * MiB;
constexpr size_t WS_MOD = 1 * MiB;
constexpr size_t WS_WIN = 2 * MiB;
constexpr size_t WS_WBR = 12 * MiB + 512 * KiB, WS_WBA = 13 * MiB + 512 * KiB, WS_WOUT = 14 * MiB + 512 * KiB;
constexpr size_t WS_WUP = 16 * MiB + 512 * KiB, WS_AUP = WS_WUP + 64 * KiB, WS_GUP = WS_WUP + 128 * KiB;
constexpr size_t WS_WRH = 16 * MiB + 768 * KiB, WS_WRL = WS_WRH + 128 * KiB;
constexpr size_t WS_CB = 17 * MiB, WS_GAM2 = 17 * MiB + 64 * KiB;
constexpr size_t WS_PRW = 18 * MiB, WS_PATT = 130 * MiB, WS_PGATE = 226 * MiB;
constexpr size_t WS_WGU = 130 * MiB, WS_WD = 290 * MiB;
constexpr size_t WS_T = 18 * MiB;
constexpr size_t WS_HID = 18 * MiB, WS_DELTA = 226 * MiB, WS_H2 = 354 * MiB;
constexpr size_t WS_SLOTTOK = 98 * MiB, WS_SLOTW = 106 * MiB, WS_TOKLIST = 114 * MiB,
    WS_TOKPOS = WS_TOKLIST + 256 * KiB, WS_TOKW = WS_TOKLIST + 512 * KiB;
constexpr size_t WS_QE = 354 * MiB, WS_YLOC = 386 * MiB, WS_PC = 418 * MiB, WS_SLOC = 450 * MiB;
constexpr size_t WS_YB = 322 * MiB;
constexpr size_t WS_MODP = 18 * MiB;
constexpr size_t WS_END = 512 * MiB;
constexpr size_t DO_H = 0, DO_G = 0, DO_SC = 32 * MiB, DO_YRA = 64 * MiB;
constexpr int NSLOT_MAX = 2 * NTOK + NLIST * 256;
constexpr int CW_TMO = 0, CW_BAR = 4096, CW_CNT = 16384, CW_MCNT = 8192;
constexpr int LDS_BYTES = 163840, RING_BYTES = 131072;
constexpr int LDSCTL_OFF = LDS_BYTES - 2048, MISC_OFF = LDSCTL_OFF;
constexpr int TOFF_OFF = LDSCTL_OFF + 256, LCNT_OFF = TOFF_OFF + 264, TILE_L_OFF = LCNT_OFF + 256;

#define LBAR() do { asm volatile("s_waitcnt lgkmcnt(0)" ::: "memory"); __builtin_amdgcn_s_barrier(); asm volatile("" ::: "memory"); } while (0)
struct Frame {
    LAS unsigned char* lds; volatile LAS unsigned* MISC; gu32* ctl;
    int tid, lane, wave, vcu, G;
};
__device__ __forceinline__ float wave_sum(float v) {
#pragma unroll
    for (int o = 1; o < 64; o <<= 1) v += __shfl_xor(v, o);
    return v;
}
__device__ __forceinline__ float dpp_f(float x, const int ctrl_sel) {
    const int xi = __builtin_bit_cast(int, x); int r;
    if (ctrl_sel == 0) r = __builtin_amdgcn_update_dpp(0, xi, 0xB1, 0xf, 0xf, true);
    else if (ctrl_sel == 1) r = __builtin_amdgcn_update_dpp(0, xi, 0x4E, 0xf, 0xf, true);
    else r = __builtin_amdgcn_update_dpp(0, xi, 0x141, 0xf, 0xf, true);
    return __builtin_bit_cast(float, r);
}
__device__ __forceinline__ float red8(float x) { x += dpp_f(x, 0); x += dpp_f(x, 1); x += dpp_f(x, 2); return x; }

__device__ __forceinline__ void phase_mod(Frame& F, const float* c, const float* w_ada, const float* b_ada, float* mod, unsigned char* ws) {
    const int gw = F.vcu * NWAVES + F.wave, NGW = F.G * NWAVES;
    for (int task = gw; task < 96 * 16; task += NGW) {
        const int nc = task % 96, ks = task / 96, n = nc * 64 + F.lane, k0 = ks * 64;
        float acc[16];
#pragma unroll
        for (int b = 0; b < 16; ++b) acc[b] = 0.f;
        LAS float* sl = (LAS float*)(F.lds) + F.wave * 1024;
#pragma unroll
        for (int j = 0; j < 16; ++j) { const float cv = c[(F.lane & 15) * DM + k0 + (F.lane >> 4) + 4 * j]; sl[((F.lane >> 4) + 4 * j) * 16 + (F.lane & 15)] = cv * sigmoidf_(cv); }
        LDS_WAIT(); asm volatile("" ::: "memory");
#pragma unroll 4
        for (int kk = 0; kk < 64; ++kk) { const float w = __builtin_nontemporal_load(w_ada + (size_t)(k0 + kk) * MODW + n);
            const f32x4 s0 = *(const LAS f32x4*)(sl + kk * 16), s1 = *(const LAS f32x4*)(sl + kk * 16 + 4), s2 = *(const LAS f32x4*)(sl + kk * 16 + 8), s3 = *(const LAS f32x4*)(sl + kk * 16 + 12);
            acc[0] += s0.x * w; acc[1] += s0.y * w; acc[2] += s0.z * w; acc[3] += s0.w * w; acc[4] += s1.x * w; acc[5] += s1.y * w; acc[6] += s1.z * w; acc[7] += s1.w * w;
            acc[8] += s2.x * w; acc[9] += s2.y * w; acc[10] += s2.z * w; acc[11] += s2.w * w; acc[12] += s3.x * w; acc[13] += s3.y * w; acc[14] += s3.z * w; acc[15] += s3.w * w; }
        LDS_WAIT(); asm volatile("" ::: "memory");
        float* part = (float*)(ws + WS_MODP);
        { const float bias = ks == 0 ? b_ada[n] : 0.f;
#pragma unroll
          for (int b = 0; b < 16; ++b) __hip_atomic_store(part + ((size_t)(ks * 16 + b) * MODW + n), acc[b] + bias, __ATOMIC_RELAXED, __HIP_MEMORY_SCOPE_AGENT); }
        asm volatile("s_waitcnt vmcnt(0)" ::: "memory");
        unsigned old = 0u; if (F.lane == 0) old = __hip_atomic_fetch_add((unsigned*)(F.ctl + CW_MCNT) + 16 * nc, 1u, __ATOMIC_RELAXED, __HIP_MEMORY_SCOPE_AGENT);
        old = (unsigned)__builtin_amdgcn_readfirstlane((int)old);
        if (old == 15u) {
            __builtin_amdgcn_fence(__ATOMIC_ACQUIRE, "agent");
#pragma unroll 1
            for (int b = 0; b < 16; ++b) { float sm = 0.f;
#pragma unroll
                for (int k2 = 0; k2 < 16; ++k2) sm += __hip_atomic_load(part + ((size_t)(k2 * 16 + b) * MODW + n), __ATOMIC_RELAXED, __HIP_MEMORY_SCOPE_AGENT);
                mod[(size_t)b * MODW + n] = sm; }
        }
    }
}

template <int MODE, bool NTS = false> __device__ __forceinline__ void transpose_item(const float* W, int K, int N, bf16_t* WT, int row_off, int item, int lane, int ldt = 0, int koff = 0) {
    if (ldt == 0) ldt = K;
    const int nblk = N / 32, kb = item / nblk, nb = item % nblk, k0 = 64 * kb + 8 * (lane >> 3), n0 = 32 * nb + 4 * (lane & 7);
    f32x4 v[8];
#pragma unroll
    for (int i = 0; i < 8; ++i) v[i] = __builtin_nontemporal_load((const f32x4*)(W + (size_t)(k0 + i) * N + n0));
#pragma unroll
    for (int j = 0; j < 4; ++j) { const int ng = n0 + j; const int nr = MODE == 0 ? row_off + ng : (MODE == 1 ? 8 * (ng >> 2) + (ng & 3) : 8 * (ng >> 2) + 4 + (ng & 3));
        u32x4 o; o.x = cvt_pk_bf16(v[0][j], v[1][j]); o.y = cvt_pk_bf16(v[2][j], v[3][j]); o.z = cvt_pk_bf16(v[4][j], v[5][j]); o.w = cvt_pk_bf16(v[6][j], v[7][j]);
        if (MODE == 0 && !NTS) *(GAS u32x4*)(WT + (size_t)nr * ldt + koff + k0) = o; else __builtin_nontemporal_store(o, (GAS u32x4*)(WT + (size_t)nr * ldt + koff + k0)); }
}

struct Args { const float* in[31]; float* out; unsigned char* ws; int ph_lo, ph_hi, scr; };
struct Ptrs { const float* in[31]; float* out; unsigned char* ws; };

__device__ __forceinline__ void phase_prep(Frame& F, const Ptrs& P) {
    const int gw = F.vcu * NWAVES + F.wave, NGW = F.G * NWAVES;
    const float* mod = (const float*)(P.ws + WS_MOD);
    bf16_t* Win_t = (bf16_t*)(P.ws + WS_WIN); bf16_t* Wbr_t = (bf16_t*)(P.ws + WS_WBR); bf16_t* Wba_t = (bf16_t*)(P.ws + WS_WBA); bf16_t* Wout_t = (bf16_t*)(P.ws + WS_WOUT);
    bf16_t* wup_t = (bf16_t*)(P.ws + WS_WUP); bf16_t* aup_t = (bf16_t*)(P.ws + WS_AUP); bf16_t* gup_t = (bf16_t*)(P.ws + WS_GUP);
    constexpr int I_IN = 16 * (INCOLS / 32), I_BR = 8 * 32, I_OUT = 16 * 32, I_UP = 16, I_GUP = 2 * 16;
    constexpr int NITEMS = I_IN + 2 * I_BR + I_OUT + 2 * I_UP + I_GUP;
    for (int it = gw; it < NITEMS; it += NGW) {
        int r = it;
        if (r < I_IN) { transpose_item<0>(P.in[5], DM, INCOLS, Win_t, 0, r, F.lane); continue; } r -= I_IN;
        if (r < I_BR) { transpose_item<0>(P.in[20], 512, DM, Wbr_t, 0, r, F.lane, DM, 0); continue; } r -= I_BR;
        if (r < I_BR) { transpose_item<0>(P.in[21], 512, DM, Wbr_t, 0, r, F.lane, DM, 512); continue; } r -= I_BR;
        if (r < I_OUT) { transpose_item<0>(P.in[22], DM, DM, Wout_t, 0, r, F.lane); continue; } r -= I_OUT;
        if (r < I_UP) { transpose_item<0>(P.in[8], 64, 512, wup_t, 0, r, F.lane); continue; } r -= I_UP;
        if (r < I_UP) { transpose_item<0>(P.in[10], 64, 512, aup_t, 0, r, F.lane); continue; } r -= I_UP;
        transpose_item<0>(P.in[11], 128, 512, gup_t, 0, r, F.lane);
    }
    { bf16_t* wrh = (bf16_t*)(P.ws + WS_WRH); bf16_t* wrl = (bf16_t*)(P.ws + WS_WRL);
      for (int idx = (F.vcu * NWAVES * 64 + F.tid); idx < 64 * DM; idx += F.G * NWAVES * 64) { const int o = idx / DM, k = idx % DM;
          const float w = o < 4 ? P.in[24][k * 4 + o] : (o < 36 ? P.in[26][k * 32 + (o - 4)] : 0.f);
          const unsigned hi = cvt_pk_bf16(w, 0.f) & 0xffffu; const float rem = w - __uint_as_float(hi << 16); const unsigned lo = cvt_pk_bf16(rem, 0.f) & 0xffffu;
          wrh[idx] = (bf16_t)hi; wrl[idx] = (bf16_t)lo; } }
    { float* gam2 = (float*)(P.ws + WS_GAM2);
      for (int idx = (F.vcu * NWAVES * 64 + F.tid); idx < NB * DM; idx += F.G * NWAVES * 64) { const int b = idx / DM, k = idx % DM; gam2[idx] = P.in[23][k] * (1.f + mod[(size_t)b * MODW + 4 * DM + k]); } }
    { float* cb = (float*)(P.ws + WS_CB);
      for (int t = gw; t < NB * 36; t += NGW) { const int b = t / 36, o = t % 36; float s = 0.f;
          for (int k = F.lane; k < DM; k += 64) { const float w = o < 4 ? P.in[24][k * 4 + o] : P.in[26][k * 32 + (o - 4)]; s += mod[(size_t)b * MODW + 3 * DM + k] * w; }
          s = wave_sum(s); if (F.lane == 0) cb[b * 64 + o] = s + (o < 4 ? P.in[25][o] : P.in[27][o - 4]); } }
    bf16_t* H = (bf16_t*)((unsigned char*)P.out + DO_H);
    for (int m0 = gw * 4; m0 < NTOK; m0 += NGW * 4) {
        f32x4 v[4][4];
#pragma unroll
        for (int r = 0; r < 4; ++r) { const GAS f32x4* xr = (const GAS f32x4*)(P.in[0] + (size_t)(m0 + r) * DM) + F.lane;
#pragma unroll
            for (int j = 0; j < 4; ++j) v[r][j] = __builtin_nontemporal_load(xr + 64 * j); }
        const int b = m0 / SEQ; const float* sh = mod + (size_t)b * MODW; const float* sc = sh + DM;
        f32x4 gs[4], hs[4];
#pragma unroll
        for (int j = 0; j < 4; ++j) { const int k = 4 * F.lane + 256 * j; const f32x4 g = *(const f32x4*)(P.in[4] + k), s1 = *(const f32x4*)(sc + k); gs[j] = g * (s1 + 1.f); hs[j] = *(const f32x4*)(sh + k); }
#pragma unroll
        for (int r = 0; r < 4; ++r) { float s = 0.f;
#pragma unroll
            for (int j = 0; j < 4; ++j) s += (v[r][j].x * v[r][j].x + v[r][j].y * v[r][j].y) + (v[r][j].z * v[r][j].z + v[r][j].w * v[r][j].w);
            const float rinv = 1.f / sqrtf(wave_sum(s) * (1.f / DM) + 1e-6f);
            GAS u32x2* o8 = (GAS u32x2*)(H + (size_t)(m0 + r) * DM) + F.lane;
#pragma unroll
            for (int j = 0; j < 4; ++j) { const f32x4 hv = v[r][j] * rinv * gs[j] + hs[j]; u32x2 w; w.x = cvt_pk_bf16(hv.x, hv.y); w.y = cvt_pk_bf16(hv.z, hv.w); o8[64 * j] = w; } }
    }
}
__device__ __forceinline__ void expert_convert(Frame& F, const Ptrs& P, int wv, int nwv, int it_lo, int it_hi) {
    bf16_t* Wgu = (bf16_t*)(P.ws + WS_WGU);
    constexpr int I_G = 16 * 16;
    for (int it = it_lo + wv; it < it_hi; it += nwv) {
        const int e = it / (2 * I_G), r = it % (2 * I_G);
        if (r < I_G) transpose_item<1>(P.in[28] + (size_t)e * DM * DE, DM, DE, Wgu + (size_t)e * DM * DM, 0, r, F.lane);
        else transpose_item<2>(P.in[29] + (size_t)e * DM * DE, DM, DE, Wgu + (size_t)e * DM * DM, 0, r - I_G, F.lane);
    }
}
__device__ __forceinline__ void expert_convert_down(Frame& F, const Ptrs& P, int wv, int nwv) {
    bf16_t* Wd = (bf16_t*)(P.ws + WS_WD);
    for (int it = wv; it < NE * 256; it += nwv) { const int e = it >> 8, r = it & 255; transpose_item<0, true>(P.in[30] + (size_t)e * DE * DM, DE, DM, Wd + (size_t)e * DM * DE, 0, r, F.lane); }
}
namespace att {
constexpr int SLOT = 16384, NSL = 5, L_WS = NSL * SLOT, L_OST = L_WS + 8 * 256, L_BIAS = L_OST + 8 * 4096, L_END = L_BIAS + 1280;
__device__ __forceinline__ int crow(int r, int hi) { return (r & 3) + 8 * (r >> 2) + 4 * hi; }
__device__ __forceinline__ float max3f(float a, float b, float c) { return fmaxf(fmaxf(a, b), c); }
__device__ __forceinline__ s16x4 vtr(const LAS char* p) { return __builtin_bit_cast(s16x4, __builtin_amdgcn_ds_read_tr16_b64_v4i16((LAS s16x4*)p)); }

__device__ __forceinline__ void attn_unit(Frame& F, const Ptrs& P, int b, int h, int qb) {
    const int tid = F.tid, lane = F.lane, wid = F.wave, r32 = lane & 31, hi = lane >> 5;
    const bf16_t* Patt = (const bf16_t*)(P.ws + WS_PATT);
    bf16_t* Ya = (bf16_t*)((unsigned char*)P.out + DO_YRA) + 512;
    LAS char* lds = (LAS char*)F.lds;
    LAS float* wsf = (LAS float*)(lds + L_WS) + wid * 64;
    LAS float* biasL = (LAS float*)(lds + L_BIAS);
    const int cq = wid >> 1, ci = qb * 4 + cq, kc0 = qb * 4 - 8;
    const size_t rowbase = (size_t)b * SEQ;
    for (int i = tid; i < 257; i += 512) biasL[i] = P.in[19][h * 257 + i] * LOG2E;
    const int srow = tid >> 3, sc8 = tid & 7;
    f32x4 kg0 = *(const f32x4*)(P.in[18] + 8 * sc8), kg1 = *(const f32x4*)(P.in[18] + 8 * sc8 + 4);
    const int kdst = sc8 * 1024 + srow * 16, vdst = 8192 + (sc8 >> 2) * 4096 + (srow >> 4) * 1024 + (srow & 15) * 64 + (sc8 & 3) * 16;
    auto ld_k = [&](int j) -> u32x4 { return *(const u32x4*)(Patt + (rowbase + (size_t)(kc0 + j) * 64 + srow) * ACOLS + 512 + h * 64 + 8 * sc8); };
    auto ld_v = [&](int j) -> u32x4 { return *(const u32x4*)(Patt + (rowbase + (size_t)(kc0 + j) * 64 + srow) * ACOLS + 1024 + h * 64 + 8 * sc8); };
    auto st_kv = [&](int j, u32x4 kw, u32x4 vw) {
        float kf[8] = {bf_lo(kw.x), bf_hi(kw.x), bf_lo(kw.y), bf_hi(kw.y), bf_lo(kw.z), bf_hi(kw.z), bf_lo(kw.w), bf_hi(kw.w)};
        float ss = 0.f;
#pragma unroll
        for (int i = 0; i < 8; ++i) ss += kf[i] * kf[i];
        ss = red8(ss); const float rk = 1.f / sqrtf(ss * (1.f / 64.f) + 1e-6f);
        u32x4 o; o.x = cvt_pk_bf16(kf[0] * rk * kg0.x, kf[1] * rk * kg0.y); o.y = cvt_pk_bf16(kf[2] * rk * kg0.z, kf[3] * rk * kg0.w);
        o.z = cvt_pk_bf16(kf[4] * rk * kg1.x, kf[5] * rk * kg1.y); o.w = cvt_pk_bf16(kf[6] * rk * kg1.z, kf[7] * rk * kg1.w);
        LAS char* sl = lds + (j % NSL) * SLOT;
        *(LAS u32x4*)(sl + kdst) = o; *(LAS u32x4*)(sl + vdst) = vw; };
    { u32x4 kws[4], vws[4];
#pragma unroll
      for (int j = 0; j < 4; ++j) if (kc0 + j >= 0) { kws[j] = ld_k(j); vws[j] = ld_v(j); }
#pragma unroll
      for (int j = 0; j < 4; ++j) if (kc0 + j >= 0) st_kv(j, kws[j], vws[j]); }
    const size_t qrow = rowbase + (size_t)ci * 64 + (wid & 1) * 32 + r32;
    bf16x8 qr[4];
    { float qf[4][8]; float ss = 0.f;
#pragma unroll
      for (int d0 = 0; d0 < 4; ++d0) { const u32x4 w = *(const u32x4*)(Patt + qrow * ACOLS + h * 64 + d0 * 16 + hi * 8);
          qf[d0][0] = bf_lo(w.x); qf[d0][1] = bf_hi(w.x); qf[d0][2] = bf_lo(w.y); qf[d0][3] = bf_hi(w.y); qf[d0][4] = bf_lo(w.z); qf[d0][5] = bf_hi(w.z); qf[d0][6] = bf_lo(w.w); qf[d0][7] = bf_hi(w.w);
#pragma unroll
          for (int i = 0; i < 8; ++i) ss += qf[d0][i] * qf[d0][i]; }
      ss += __shfl_xor(ss, 32);
      const float rq = (0.125f * LOG2E) / sqrtf(ss * (1.f / 64.f) + 1e-6f);
#pragma unroll
      for (int d0 = 0; d0 < 4; ++d0) { const f32x4 g0 = *(const f32x4*)(P.in[17] + d0 * 16 + hi * 8), g1 = *(const f32x4*)(P.in[17] + d0 * 16 + hi * 8 + 4);
          u32x4 o; o.x = cvt_pk_bf16(qf[d0][0] * rq * g0.x, qf[d0][1] * rq * g0.y); o.y = cvt_pk_bf16(qf[d0][2] * rq * g0.z, qf[d0][3] * rq * g0.w);
          o.z = cvt_pk_bf16(qf[d0][4] * rq * g1.x, qf[d0][5] * rq * g1.y); o.w = cvt_pk_bf16(qf[d0][6] * rq * g1.z, qf[d0][7] * rq * g1.w);
          qr[d0] = __builtin_bit_cast(bf16x8, o); } }
    u32x4 kA, vA; if (kc0 + 4 >= 0) { kA = ld_k(4); vA = ld_v(4); }
    float mrun = 0.f, lrun = 0.f; f32x16 o0 = {}, o1 = {};
    const int qloc = (wid & 1) * 32 + r32;
    __syncthreads();
#pragma unroll 1
    for (int s = 0; s < 9; ++s) {
        const int jn = s + 4; const bool ld = (jn <= 11) && (kc0 + jn >= 0);
        const bool ldn = (jn + 1 <= 11) && (kc0 + jn + 1 >= 0); u32x4 kB, vB; if (ldn) { kB = ld_k(jn + 1); vB = ld_v(jn + 1); }
        const int j = cq + s;
        if (kc0 + j >= 0) {
            const LAS char* sl = lds + (j % NSL) * SLOT;
            f32x16 p0, p1;
            if (s <= 5) { const float c0 = biasL[0] - mrun;
#pragma unroll
                for (int r = 0; r < 16; ++r) { p0[r] = c0; p1[r] = c0; } }
            else { const int base = 64 * (s - 8) - qloc + 128;
#pragma unroll
                for (int r = 0; r < 16; ++r) { int i0 = base + crow(r, hi), i1 = i0 + 32; i0 = i0 < 0 ? 0 : (i0 > 256 ? 256 : i0); i1 = i1 < 0 ? 0 : (i1 > 256 ? 256 : i1); p0[r] = biasL[i0] - mrun; p1[r] = biasL[i1] - mrun; } }
            const LAS char* kb = sl + hi * 1024 + r32 * 16;
#pragma unroll
            for (int d0 = 0; d0 < 4; ++d0) { const bf16x8 b0 = *(const LAS bf16x8*)(kb + d0 * 2048), b1 = *(const LAS bf16x8*)(kb + d0 * 2048 + 512);
                p0 = __builtin_amdgcn_mfma_f32_32x32x16_bf16(b0, qr[d0], p0, 0, 0, 0); p1 = __builtin_amdgcn_mfma_f32_32x32x16_bf16(b1, qr[d0], p1, 0, 0, 0); }
            float a = max3f(p0[0], p0[1], p1[0]), bm = max3f(p0[2], p0[3], p1[1]); a = max3f(a, p1[2], p1[3]);
#pragma unroll
            for (int r = 4; r < 16; r += 4) { a = max3f(a, p0[r], p0[r + 1]); bm = max3f(bm, p0[r + 2], p0[r + 3]); a = max3f(a, p1[r], p1[r + 1]); bm = max3f(bm, p1[r + 2], p1[r + 3]); }
            float rm = fmaxf(a, bm); rm = fmaxf(rm, __shfl_xor(rm, 32));
            if (__any(rm > 8.f)) {
                const float dl = fmaxf(rm, 0.f), f = __builtin_amdgcn_exp2f(-dl); mrun += dl; lrun *= f;
#pragma unroll
                for (int r = 0; r < 16; ++r) { p0[r] -= dl; p1[r] -= dl; }
                if (hi == 0) wsf[r32] = f;
                LDS_WAIT(); asm volatile("" ::: "memory");
#pragma unroll
                for (int r = 0; r < 16; ++r) { const float fr_ = wsf[crow(r, hi)]; o0[r] *= fr_; o1[r] *= fr_; }
            }
            float sacc = 0.f;
#pragma unroll
            for (int r = 0; r < 16; ++r) { p0[r] = __builtin_amdgcn_exp2f(p0[r]); p1[r] = __builtin_amdgcn_exp2f(p1[r]); sacc += p0[r] + p1[r]; }
            lrun += sacc;
            u32x4 pw0, pw1, pw2, pw3;
            pw0 = (u32x4){cvt_pk_bf16(p0[0], p0[1]), cvt_pk_bf16(p0[2], p0[3]), cvt_pk_bf16(p0[4], p0[5]), cvt_pk_bf16(p0[6], p0[7])};
            pw1 = (u32x4){cvt_pk_bf16(p0[8], p0[9]), cvt_pk_bf16(p0[10], p0[11]), cvt_pk_bf16(p0[12], p0[13]), cvt_pk_bf16(p0[14], p0[15])};
            pw2 = (u32x4){cvt_pk_bf16(p1[0], p1[1]), cvt_pk_bf16(p1[2], p1[3]), cvt_pk_bf16(p1[4], p1[5]), cvt_pk_bf16(p1[6], p1[7])};
            pw3 = (u32x4){cvt_pk_bf16(p1[8], p1[9]), cvt_pk_bf16(p1[10], p1[11]), cvt_pk_bf16(p1[12], p1[13]), cvt_pk_bf16(p1[14], p1[15])};
            const LAS char* vp = sl + 8192 + ((lane >> 4) & 1) * 32 + (lane & 3) * 8 + (4 * hi + ((lane & 15) >> 2)) * 64;
            const bf16x8 pa[4] = {__builtin_bit_cast(bf16x8, pw0), __builtin_bit_cast(bf16x8, pw1), __builtin_bit_cast(bf16x8, pw2), __builtin_bit_cast(bf16x8, pw3)};
#pragma unroll
            for (int ks = 0; ks < 4; ++ks) {
                const s16x4 l0 = vtr(vp + ks * 1024), h0 = vtr(vp + ks * 1024 + 512), l1 = vtr(vp + 4096 + ks * 1024), h1 = vtr(vp + 4096 + ks * 1024 + 512);
                const bf16x8 v0 = (bf16x8){l0[0], l0[1], l0[2], l0[3], h0[0], h0[1], h0[2], h0[3]}, v1 = (bf16x8){l1[0], l1[1], l1[2], l1[3], h1[0], h1[1], h1[2], h1[3]};
                o0 = __builtin_amdgcn_mfma_f32_32x32x16_bf16(pa[ks], v0, o0, 0, 0, 0); o1 = __builtin_amdgcn_mfma_f32_32x32x16_bf16(pa[ks], v1, o1, 0, 0, 0); }
        }
        if (ld) st_kv(jn, kA, vA);
        LBAR();
        kA = kB; vA = vB;
    }
    lrun += __shfl_xor(lrun, 32);
    if (hi == 0) wsf[32 + r32] = lrun;
    LDS_WAIT(); asm volatile("" ::: "memory");
    LAS bf16_t* stg = (LAS bf16_t*)(lds + L_OST) + wid * 2048;
#pragma unroll
    for (int r = 0; r < 16; ++r) { const int orow = crow(r, hi); const float rl = __builtin_amdgcn_rcpf(wsf[32 + orow]);
        stg[orow * 64 + r32] = (bf16_t)(cvt_pk_bf16(o0[r] * rl, 0.f) & 0xffffu); stg[orow * 64 + 32 + r32] = (bf16_t)(cvt_pk_bf16(o1[r] * rl, 0.f) & 0xffffu); }
    LDS_WAIT(); asm volatile("" ::: "memory");
    bf16_t* Ow = Ya + (rowbase + (size_t)ci * 64 + (wid & 1) * 32) * 1024 + h * 64;
#pragma unroll
    for (int i = 0; i < 4; ++i) { const int row = i * 8 + (lane >> 3), ch = lane & 7; const u32x4 v = *(const LAS u32x4*)(stg + row * 64 + ch * 8); *(u32x4*)(Ow + (size_t)row * 1024 + ch * 8) = v; }
    __syncthreads();
}
}

#ifndef TIME_PHASE
#define TIME_PHASE -1
#endif
#define PROF(k) do { if (TIME_PHASE >= 20 && blockIdx.x == 0 && F.tid == 0) { const unsigned now_ = (unsigned)__builtin_amdgcn_s_memrealtime(); F.MISC[16 + (k)] += now_ - F.MISC[15]; F.MISC[15] = now_; } } while (0)
namespace rc {
constexpr int LDB = 72, MB = 64 * LDB * 2;
constexpr int FLD = 68, FB = 64 * FLD * 4;
constexpr int L_AT = 0, L_BH = MB, L_BT = 2 * MB, L_KT = 3 * MB, L_RT = 4 * MB, L_KH = 5 * MB, L_V = 6 * MB;
constexpr int L_TWD = 0, L_AD = 9216, L_SGD = 18432;
constexpr int RB = 8 * MB;
constexpr int L_WL = RB, L_AL = RB + FB, L_GL = RB + 2 * FB, L_SEG = RB + 3 * FB;
constexpr int L_NQ0 = RB, L_NQ1 = RB + MB, L_NT0 = RB + 2 * MB, L_NT1 = RB + 3 * MB, L_TQ0 = RB + 4 * MB, L_TQ1 = RB + 5 * MB, L_NKT = RB + 6 * MB, L_NRB = RB + 7 * MB;
constexpr int L_GLD = RB + 8 * MB;
constexpr int L_W1T = L_NQ0, L_W2T = L_NT0, L_WY = L_AT, L_KC = L_BT;
constexpr int L_TAB = L_GLD + 256;
constexpr int T_MUL = 0, T_MUR = 256, T_PAR = 448, T_N = 832;
static_assert(L_SEG + 2048 <= L_GLD && L_TAB + T_N * 4 <= LDSCTL_OFF, "rwkv chunk LDS");

__device__ __forceinline__ void unpack8(const u32x4 w, float* f) { f[0] = bf_lo(w.x); f[1] = bf_hi(w.x); f[2] = bf_lo(w.y); f[3] = bf_hi(w.y); f[4] = bf_lo(w.z); f[5] = bf_hi(w.z); f[6] = bf_lo(w.w); f[7] = bf_hi(w.w); }
__device__ __forceinline__ f32x16 mm64(f32x16 acc, const LAS char* Arows, const LAS char* Bcols, int lane) {
    const int o = ((lane & 31) * LDB + 8 * (lane >> 5)) * 2;
#pragma unroll
    for (int ks = 0; ks < 4; ++ks) { const bf16x8 a = *(const LAS bf16x8*)(Arows + o + 32 * ks), b = *(const LAS bf16x8*)(Bcols + o + 32 * ks); acc = __builtin_amdgcn_mfma_f32_32x32x16_bf16(a, b, acc, 0, 0, 0); }
    return acc;
}
__device__ __forceinline__ s16x4 trrd(const LAS char* p) { return __builtin_bit_cast(s16x4, __builtin_amdgcn_ds_read_tr16_b64_v4i16((LAS s16x4*)p)); }
__device__ __forceinline__ int tr_off(int lane) { return ((8 * (lane >> 5) + ((lane & 15) >> 2)) * LDB + 16 * ((lane >> 4) & 1) + 4 * (lane & 3)) * 2; }
__device__ __forceinline__ bf16x8 frag_tr(const LAS char* Xb, int ks) {
    const s16x4 lo = trrd(Xb + (16 * ks) * LDB * 2), hi = trrd(Xb + (16 * ks + 4) * LDB * 2);
    return (bf16x8){lo[0], lo[1], lo[2], lo[3], hi[0], hi[1], hi[2], hi[3]};
}
__device__ __forceinline__ f32x16 mm64_btr(f32x16 acc, const LAS char* Arows, const LAS char* X, int nb, int lane) {
    const int o = ((lane & 31) * LDB + 8 * (lane >> 5)) * 2; const LAS char* xb = X + 64 * nb + tr_off(lane);
#pragma unroll
    for (int ks = 0; ks < 4; ++ks) { const bf16x8 a = *(const LAS bf16x8*)(Arows + o + 32 * ks), b = frag_tr(xb, ks); acc = __builtin_amdgcn_mfma_f32_32x32x16_bf16(a, b, acc, 0, 0, 0); }
    return acc;
}
__device__ __forceinline__ f32x16 mm64_atr(f32x16 acc, const LAS char* X, int mb, const LAS char* Bcols, int lane) {
    const int o = ((lane & 31) * LDB + 8 * (lane >> 5)) * 2; const LAS char* xb = X + 64 * mb + tr_off(lane);
#pragma unroll
    for (int ks = 0; ks < 4; ++ks) { const bf16x8 a = frag_tr(xb, ks), b = *(const LAS bf16x8*)(Bcols + o + 32 * ks); acc = __builtin_amdgcn_mfma_f32_32x32x16_bf16(a, b, acc, 0, 0, 0); }
    return acc;
}
__device__ __forceinline__ void store_T(const f32x16& d, LAS char* dst, int mb, int nb, int lane) {
    LAS char* p = dst + ((32 * nb + (lane & 31)) * LDB + 32 * mb + 4 * (lane >> 5)) * 2;
#pragma unroll
    for (int g = 0; g < 4; ++g) { u32x2 w; w.x = cvt_pk_bf16(d[4 * g], d[4 * g + 1]); w.y = cvt_pk_bf16(d[4 * g + 2], d[4 * g + 3]); *(LAS u32x2*)(p + 16 * g) = w; }
}
__device__ __forceinline__ void store_T_g(const f32x16& d, bf16_t* dst, int mb, int nb, int lane) {
    bf16_t* p = dst + (32 * nb + (lane & 31)) * 64 + 32 * mb + 4 * (lane >> 5);
#pragma unroll
    for (int g = 0; g < 4; ++g) { u32x2 w; w.x = cvt_pk_bf16(d[4 * g], d[4 * g + 1]); w.y = cvt_pk_bf16(d[4 * g + 2], d[4 * g + 3]); *(u32x2*)(p + 8 * g) = w; }
}
#define RC_M(r) (32 * mb + 8 * ((r) >> 2) + 4 * hi + ((r) & 3))

struct Raw { u32x4 lc[4], lp[4], rc[3], rp[3]; };
__device__ __forceinline__ void load_raw(Raw& R, const bf16_t* Prw, int u, int t, int cg) {
    const int b = u >> 8, h = (u >> 5) & 7, c = u & 31;
    const size_t row = (size_t)b * SEQ + 64 * c + t; const bool hasprev = (c > 0) || (t > 0);
    const bf16_t* pc = Prw + row * RCOLS; const bf16_t* pp = pc - RCOLS; const int lc0 = 1536 + 32 * cg, hd = h * 64 + 8 * cg;
#pragma unroll
    for (int q = 0; q < 4; ++q) { R.lc[q] = *(const u32x4*)(pc + lc0 + 8 * q); R.lp[q] = hasprev ? *(const u32x4*)(pp + lc0 + 8 * q) : (u32x4){0u, 0u, 0u, 0u}; }
#pragma unroll
    for (int w = 0; w < 3; ++w) { R.rc[w] = *(const u32x4*)(pc + w * 512 + hd); R.rp[w] = hasprev ? *(const u32x4*)(pp + w * 512 + hd) : (u32x4){0u, 0u, 0u, 0u}; }
}
__device__ __forceinline__ void chunk_phase(Frame& F, const Ptrs& P) {
  const bf16_t* Prw = (const bf16_t*)(P.ws + WS_PRW);
  int htab = -1; bf16x8 wA[4]; Raw raw;
  if (TIME_PHASE >= 20 && blockIdx.x == 0 && F.tid == 0) F.MISC[15] = (unsigned)__builtin_amdgcn_s_memrealtime();
  if ((int)blockIdx.x < NB * 8 * 32) load_raw(raw, Prw, (int)blockIdx.x, F.tid >> 3, F.tid & 7);
#pragma unroll 1
  for (int u_ = (int)blockIdx.x; u_ < NB * 8 * 32; u_ += F.G) {
    int tid = F.tid, wid = F.wave; asm volatile("" : "+v"(tid), "+s"(wid));
    const int b = u_ >> 8, h = (u_ >> 5) & 7, c = u_ & 31;
    const int lane = tid & 63, t = tid >> 3, cg = tid & 7, r32 = lane & 31, hi = lane >> 5;
    LAS char* lds = (LAS char*)F.lds;
    const size_t u = (size_t)((b * 8 + h) * 32 + c);
    bf16_t* gQe = (bf16_t*)(P.ws + WS_QE) + u * 4096; bf16_t* gYl = (bf16_t*)(P.ws + WS_YLOC) + u * 4096; bf16_t* gPc = (bf16_t*)(P.ws + WS_PC) + u * 4096; bf16_t* gSl = (bf16_t*)(P.ws + WS_SLOC) + u * 4096;
    bf16_t* gG = (bf16_t*)((unsigned char*)P.out + DO_G) + u * 4096; bf16_t* Yr = (bf16_t*)((unsigned char*)P.out + DO_YRA);
    const int hd = h * 64 + 8 * cg;
    const bool is_ad = (cg == 2 || cg == 3); const float alpha = cg < 2 ? 2.f : 1.f, gamma = cg < 2 ? -1.f : 0.f;
    LAS bf16_t* ldst = (LAS bf16_t*)(lds + (cg < 2 ? L_TWD : (cg < 4 ? L_AD : L_SGD))) + t * (cg < 4 ? 72 : 136) + 32 * (cg < 2 ? cg : (cg < 4 ? cg - 2 : cg - 4));
    const size_t row = (size_t)b * SEQ + 64 * c + t;
    LAS float* tab = (LAS float*)(lds + L_TAB);
    if (h != htab) {
        htab = h;
        for (int i = tid; i < T_N; i += 512) { float v;
            if (i < T_MUR) v = P.in[6][1536 + i]; else if (i < T_PAR) { const int w = (i - T_MUR) >> 6, d = (i - T_MUR) & 63; v = P.in[6][w * 512 + h * 64 + d]; }
            else { const int w = (i - T_PAR) >> 6, d = (i - T_PAR) & 63; const float* src = w == 0 ? P.in[7] : (w == 1 ? P.in[9] : (w == 2 ? P.in[12] : (w == 3 ? P.in[13] : (w == 4 ? P.in[14] : P.in[16])))); v = src[h * 64 + d]; }
            tab[i] = v; }
        const int jb = (wid >> 1) & 1;
        const bf16_t* wa = (const bf16_t*)(P.ws + (wid < 4 ? WS_WUP : WS_AUP)) + (size_t)(h * 64 + jb * 32 + r32) * 64 + 8 * hi;
#pragma unroll
        for (int ks = 0; ks < 4; ++ks) wA[ks] = *(const bf16x8*)(wa + 16 * ks);
        LBAR();
    }
    bf16x8 wG[8];
    { const bf16_t* wg = (const bf16_t*)(P.ws + WS_GUP) + (size_t)(h * 64 + ((wid >> 1) & 1) * 32 + r32) * 128 + 8 * hi;
#pragma unroll
      for (int ks = 0; ks < 8; ++ks) wG[ks] = *(const bf16x8*)(wg + 16 * ks); }
    float rv[8], kv[8], vv[8];
    { float cur[8], prv[8], mu[8];
#pragma unroll
      for (int q = 0; q < 4; ++q) {
          unpack8(raw.lc[q], cur); unpack8(raw.lp[q], prv);
          *(f32x4*)mu = *(const LAS f32x4*)(tab + T_MUL + 32 * cg + 8 * q); *(f32x4*)(mu + 4) = *(const LAS f32x4*)(tab + T_MUL + 32 * cg + 8 * q + 4);
          float o[8];
#pragma unroll
          for (int i = 0; i < 8; ++i) { const float xs = cur[i] + (prv[i] - cur[i]) * mu[i]; const float sg = sigmoidf_(alpha * xs); o[i] = is_ad ? xs : alpha * sg + gamma; }
          u32x4 w; w.x = cvt_pk_bf16(o[0], o[1]); w.y = cvt_pk_bf16(o[2], o[3]); w.z = cvt_pk_bf16(o[4], o[5]); w.w = cvt_pk_bf16(o[6], o[7]);
          *(LAS u32x4*)(ldst + 8 * q) = w; }
#pragma unroll
      for (int which = 0; which < 3; ++which) {
          unpack8(raw.rc[which], cur); unpack8(raw.rp[which], prv);
          *(f32x4*)mu = *(const LAS f32x4*)(tab + T_MUR + which * 64 + 8 * cg); *(f32x4*)(mu + 4) = *(const LAS f32x4*)(tab + T_MUR + which * 64 + 8 * cg + 4);
#pragma unroll
          for (int i = 0; i < 8; ++i) { const float xs = cur[i] + (prv[i] - cur[i]) * mu[i]; if (which == 0) rv[i] = xs; else if (which == 1) kv[i] = xs; else vv[i] = xs; } } }
    LBAR(); PROF(0);
    { const int ib = wid & 1, jb = (wid >> 1) & 1;
      auto wr4 = [&](const f32x16& acc, LAS float* Out) { LAS float* op = Out + (ib * 32 + r32) * FLD + jb * 32 + 4 * hi;
#pragma unroll
          for (int g = 0; g < 4; ++g) *(LAS f32x4*)(op + 8 * g) = (f32x4){acc[4 * g], acc[4 * g + 1], acc[4 * g + 2], acc[4 * g + 3]}; };
      { f32x16 acc = {}; const LAS bf16_t* qp = (const LAS bf16_t*)(lds + (wid < 4 ? L_TWD : L_AD)) + (ib * 32 + r32) * 72 + 8 * hi;
#pragma unroll
        for (int ks = 0; ks < 4; ++ks) acc = __builtin_amdgcn_mfma_f32_32x32x16_bf16(wA[ks], *(const LAS bf16x8*)(qp + 16 * ks), acc, 0, 0, 0);
        wr4(acc, (LAS float*)(lds + (wid < 4 ? L_WL : L_AL))); }
      if (wid < 4) { f32x16 acc = {}; const LAS bf16_t* qp = (const LAS bf16_t*)(lds + L_SGD) + (ib * 32 + r32) * 136 + 8 * hi;
#pragma unroll
        for (int ks = 0; ks < 8; ++ks) acc = __builtin_amdgcn_mfma_f32_32x32x16_bf16(wG[ks], *(const LAS bf16x8*)(qp + 16 * ks), acc, 0, 0, 0);
        wr4(acc, (LAS float*)(lds + L_GL)); } }
    LBAR(); PROF(1);
    float lam[8], av[8], bv[8], kp[8];
    const int o68 = t * FLD + 8 * cg;
    { float wl[8], al[8], gv[8];
      *(f32x4*)wl = *(LAS f32x4*)(lds + L_WL + 4 * o68); *(f32x4*)(wl + 4) = *(LAS f32x4*)(lds + L_WL + 4 * o68 + 16);
      *(f32x4*)al = *(LAS f32x4*)(lds + L_AL + 4 * o68); *(f32x4*)(al + 4) = *(LAS f32x4*)(lds + L_AL + 4 * o68 + 16);
      *(f32x4*)gv = *(LAS f32x4*)(lds + L_GL + 4 * o68); *(f32x4*)(gv + 4) = *(LAS f32x4*)(lds + L_GL + 4 * o68 + 16);
      float w0[8], a0[8], kk_[8], ka[8], rk[8], lb[8];
      { const LAS float* tp = tab + T_PAR + 8 * cg;
        *(f32x4*)w0 = *(const LAS f32x4*)(tp); *(f32x4*)(w0 + 4) = *(const LAS f32x4*)(tp + 4);
        *(f32x4*)a0 = *(const LAS f32x4*)(tp + 64); *(f32x4*)(a0 + 4) = *(const LAS f32x4*)(tp + 68);
        *(f32x4*)kk_ = *(const LAS f32x4*)(tp + 128); *(f32x4*)(kk_ + 4) = *(const LAS f32x4*)(tp + 132);
        *(f32x4*)ka = *(const LAS f32x4*)(tp + 192); *(f32x4*)(ka + 4) = *(const LAS f32x4*)(tp + 196);
        *(f32x4*)rk = *(const LAS f32x4*)(tp + 256); *(f32x4*)(rk + 4) = *(const LAS f32x4*)(tp + 260);
        *(f32x4*)lb = *(const LAS f32x4*)(tp + 320); *(f32x4*)(lb + 4) = *(const LAS f32x4*)(tp + 324); }
      float asg[8], kkv[8], c2[8]; float ss = 0.f, bon = 0.f;
#pragma unroll
      for (int i = 0; i < 8; ++i) { lam[i] = 0.60653065971f * sigmoidf_(w0[i] + wl[i]); asg[i] = sigmoidf_(a0[i] + al[i]);
          kkv[i] = kv[i] * kk_[i]; ss += kkv[i] * kkv[i]; kp[i] = kv[i] * (1.f + (asg[i] - 1.f) * ka[i]); bon += rv[i] * kp[i] * rk[i]; }
      ss = red8(ss); bon = red8(bon);
      const float inv = 1.f / fmaxf(sqrtf(ss), 1e-12f);
#pragma unroll
      for (int i = 0; i < 8; ++i) { const float kn = kkv[i] * inv; av[i] = -kn; bv[i] = kn * asg[i]; c2[i] = (lb[i] + bon * vv[i]) * gv[i]; }
      u32x4 w; w.x = cvt_pk_bf16(gv[0], gv[1]); w.y = cvt_pk_bf16(gv[2], gv[3]); w.z = cvt_pk_bf16(gv[4], gv[5]); w.w = cvt_pk_bf16(gv[6], gv[7]);
      *(u32x4*)(gG + t * 64 + 8 * cg) = w;
      w.x = cvt_pk_bf16(c2[0], c2[1]); w.y = cvt_pk_bf16(c2[2], c2[3]); w.z = cvt_pk_bf16(c2[4], c2[5]); w.w = cvt_pk_bf16(c2[6], c2[7]);
      *(u32x4*)(Yr + row * 1024 + hd) = w; }
    float cum[8];
    { const int tl = lane >> 3;
#pragma unroll
      for (int i = 0; i < 8; ++i) { float x = lam[i];
          float y = __shfl_up(x, 8); x += (tl >= 1) ? y : 0.f; y = __shfl_up(x, 16); x += (tl >= 2) ? y : 0.f; y = __shfl_up(x, 32); x += (tl >= 4) ? y : 0.f;
          cum[i] = x; }
      if (tl == 7) { *(LAS f32x4*)(lds + L_SEG + (wid * 64 + 8 * cg) * 4) = *(f32x4*)cum; *(LAS f32x4*)(lds + L_SEG + (wid * 64 + 8 * cg) * 4 + 16) = *(f32x4*)(cum + 4); } }
    LBAR(); PROF(2);
    { float pre[8], tot[8];
#pragma unroll
      for (int i = 0; i < 8; ++i) { pre[i] = 0.f; tot[i] = 0.f; }
      const int myseg = t >> 3;
#pragma unroll
      for (int s = 0; s < 8; ++s) { float sv[8]; *(f32x4*)sv = *(LAS f32x4*)(lds + L_SEG + (s * 64 + 8 * cg) * 4); *(f32x4*)(sv + 4) = *(LAS f32x4*)(lds + L_SEG + (s * 64 + 8 * cg) * 4 + 16);
#pragma unroll
          for (int i = 0; i < 8; ++i) { tot[i] += sv[i]; pre[i] += (s < myseg) ? sv[i] : 0.f; } }
      float at_[8], bt_[8], kt_[8], rt_[8], bh_[8], kh_[8];
#pragma unroll
      for (int i = 0; i < 8; ++i) { const float cm = cum[i] + pre[i];
          const float gi = __builtin_amdgcn_exp2f(cm * LOG2E), g_ = __builtin_amdgcn_exp2f(-cm * LOG2E), gm1 = __builtin_amdgcn_exp2f(-(cm - lam[i]) * LOG2E), glg = __builtin_amdgcn_exp2f(-(tot[i] - cm) * LOG2E);
          at_[i] = av[i] * gm1; bt_[i] = bv[i] * gi; kt_[i] = kp[i] * gi; rt_[i] = rv[i] * g_; bh_[i] = bv[i] * glg; kh_[i] = kp[i] * glg; }
      if (t == 0) { float gl[8];
#pragma unroll
          for (int i = 0; i < 8; ++i) gl[i] = __builtin_amdgcn_exp2f(-tot[i] * LOG2E);
          *(LAS f32x4*)(lds + L_GLD + 32 * cg) = *(f32x4*)gl; *(LAS f32x4*)(lds + L_GLD + 32 * cg + 16) = *(f32x4*)(gl + 4); }
      const int ob = (t * LDB + 8 * cg) * 2; u32x4 w;
      w.x = cvt_pk_bf16(at_[0], at_[1]); w.y = cvt_pk_bf16(at_[2], at_[3]); w.z = cvt_pk_bf16(at_[4], at_[5]); w.w = cvt_pk_bf16(at_[6], at_[7]); *(LAS u32x4*)(lds + L_AT + ob) = w;
      w.x = cvt_pk_bf16(bt_[0], bt_[1]); w.y = cvt_pk_bf16(bt_[2], bt_[3]); w.z = cvt_pk_bf16(bt_[4], bt_[5]); w.w = cvt_pk_bf16(bt_[6], bt_[7]); *(LAS u32x4*)(lds + L_BT + ob) = w;
      w.x = cvt_pk_bf16(kt_[0], kt_[1]); w.y = cvt_pk_bf16(kt_[2], kt_[3]); w.z = cvt_pk_bf16(kt_[4], kt_[5]); w.w = cvt_pk_bf16(kt_[6], kt_[7]); *(LAS u32x4*)(lds + L_KT + ob) = w;
      w.x = cvt_pk_bf16(rt_[0], rt_[1]); w.y = cvt_pk_bf16(rt_[2], rt_[3]); w.z = cvt_pk_bf16(rt_[4], rt_[5]); w.w = cvt_pk_bf16(rt_[6], rt_[7]); *(LAS u32x4*)(lds + L_RT + ob) = w;
      w.x = cvt_pk_bf16(bh_[0], bh_[1]); w.y = cvt_pk_bf16(bh_[2], bh_[3]); w.z = cvt_pk_bf16(bh_[4], bh_[5]); w.w = cvt_pk_bf16(bh_[6], bh_[7]); *(LAS u32x4*)(lds + L_BH + ob) = w;
      w.x = cvt_pk_bf16(kh_[0], kh_[1]); w.y = cvt_pk_bf16(kh_[2], kh_[3]); w.z = cvt_pk_bf16(kh_[4], kh_[5]); w.w = cvt_pk_bf16(kh_[6], kh_[7]); *(LAS u32x4*)(lds + L_KH + ob) = w;
      w.x = cvt_pk_bf16(vv[0], vv[1]); w.y = cvt_pk_bf16(vv[2], vv[3]); w.z = cvt_pk_bf16(vv[4], vv[5]); w.w = cvt_pk_bf16(vv[6], vv[7]); *(LAS u32x4*)(lds + L_V + ob) = w; }
    LBAR(); PROF(4);
    load_raw(raw, Prw, (u_ + F.G < NB * 8 * 32) ? u_ + F.G : u_, t, cg);
    {
    wid = __builtin_amdgcn_readfirstlane(wid); asm volatile("" : "+v"(tid), "+s"(wid));
    const int lane = tid & 63, r32 = lane & 31, hi = lane >> 5;
    const int mb = wid & 1, nb = (wid >> 1) & 1, grp = wid >> 2;
    const int ao = 32 * mb * LDB * 2, bo = 32 * nb * LDB * 2;
    const int ncol = 32 * nb + r32;
    f32x16 accT = {};
    {
        f32x16 d = {};
        if (grp == 0) { d = mm64(d, lds + L_AT + ao, lds + L_KT + bo, lane);
#pragma unroll
            for (int r = 0; r < 16; ++r) d[r] = (ncol < RC_M(r)) ? d[r] : 0.f;
            store_T(d, lds + L_NKT, mb, nb, lane); }
        else { d = mm64(d, lds + L_BT + ao, lds + L_AT + bo, lane);
#pragma unroll
            for (int r = 0; r < 16; ++r) { d[r] = (RC_M(r) < ncol) ? d[r] : 0.f; accT[r] = d[r] + ((RC_M(r) == ncol) ? 1.f : 0.f); }
            store_T(d, lds + L_NQ0, mb, nb, lane); store_T(accT, lds + L_TQ0, mb, nb, lane); }
    }
    LBAR(); PROF(5);
#pragma unroll
    for (int j = 1; j <= 5; ++j) { const int cur = (j - 1) & 1, nw = j & 1;
        const int nq_c = cur ? L_NQ1 : L_NQ0, nq_n = nw ? L_NQ1 : L_NQ0;
        if (grp == 0) { f32x16 d = {}; d = mm64_atr(d, lds + nq_c, mb, lds + nq_c + bo, lane); store_T(d, lds + nq_n, mb, nb, lane); }
        else if (j == 1) { f32x16 e = {}; e = mm64(e, lds + L_BT + ao, lds + L_RT + bo, lane);
#pragma unroll
            for (int r = 0; r < 16; ++r) e[r] = (RC_M(r) <= ncol) ? e[r] : 0.f;
            store_T(e, lds + L_NRB, mb, nb, lane); }
        else { const int tq_r = nw ? L_TQ1 : L_TQ0, tq_w = cur ? L_TQ1 : L_TQ0;
            accT = mm64_atr(accT, lds + nq_c, mb, lds + tq_r + bo, lane); store_T(accT, lds + tq_w, mb, nb, lane); }
        LBAR();
    }
    if (grp == 1) { accT = mm64_atr(accT, lds + L_NQ1, mb, lds + L_TQ0 + bo, lane); store_T(accT, lds + L_TQ1, mb, nb, lane); }
    LBAR(); PROF(6);
    { f32x16 d = {};
      if (grp == 0) { d = mm64_btr(d, lds + L_TQ1 + ao, lds + L_AT, nb, lane); store_T(d, lds + L_W1T, mb, nb, lane); }
      else { d = mm64(d, lds + L_TQ1 + ao, lds + L_NKT + bo, lane); store_T(d, lds + L_W2T, mb, nb, lane); } }
    LBAR(); PROF(7);
    if (grp == 0) {
        f32x16 d = {}; d = mm64(d, lds + L_W1T + ao, lds + L_NRB + bo, lane);
#pragma unroll
        for (int g = 0; g < 4; ++g) { const u32x2 rw = *(const LAS u32x2*)(lds + L_RT + ((32 * nb + r32) * LDB + 32 * mb + 8 * g + 4 * hi) * 2);
            d[4 * g] += bf_lo(rw.x); d[4 * g + 1] += bf_hi(rw.x); d[4 * g + 2] += bf_lo(rw.y); d[4 * g + 3] += bf_hi(rw.y); }
        store_T_g(d, gQe, mb, nb, lane);
        f32x16 p = {}; p = mm64_btr(p, lds + L_W1T + ao, lds + L_BH, nb, lane);
        const float gl = ((const LAS float*)(lds + L_GLD))[ncol];
#pragma unroll
        for (int r = 0; r < 16; ++r) p[r] += (RC_M(r) == ncol) ? gl : 0.f;
        store_T_g(p, gPc, mb, nb, lane);
    } else {
        f32x16 d = {}; d = mm64(d, lds + L_KT + ao, lds + L_RT + bo, lane); d = mm64(d, lds + L_W2T + ao, lds + L_NRB + bo, lane);
#pragma unroll
        for (int r = 0; r < 16; ++r) d[r] = (RC_M(r) <= ncol) ? d[r] : 0.f;
        f32x16 k = {}; k = mm64_btr(k, lds + L_W2T + ao, lds + L_BH, nb, lane);
        { const LAS char* kb = lds + L_KH + 64 * nb + ((32 * mb + 4 * hi + ((lane & 15) >> 2)) * LDB + 16 * ((lane >> 4) & 1) + 4 * (lane & 3)) * 2;
#pragma unroll
          for (int g = 0; g < 4; ++g) { const s16x4 kw = trrd(kb + 8 * g * LDB * 2);
              k[4 * g] += bf_lo((unsigned)(unsigned short)kw[0]); k[4 * g + 1] += bf_lo((unsigned)(unsigned short)kw[1]); k[4 * g + 2] += bf_lo((unsigned)(unsigned short)kw[2]); k[4 * g + 3] += bf_lo((unsigned)(unsigned short)kw[3]); } }
        store_T(d, lds + L_WY, mb, nb, lane); store_T(k, lds + L_KC, mb, nb, lane);
    }
    LBAR(); PROF(8);
    { f32x16 d = {};
      if (grp == 0) { d = mm64_atr(d, lds + L_V, mb, lds + L_WY + bo, lane); store_T_g(d, gYl, mb, nb, lane); }
      else { d = mm64_btr(d, lds + L_KC + ao, lds + L_V, nb, lane); store_T_g(d, gSl, mb, nb, lane); } }
    LBAR(); PROF(9);
    }
  }
}

__device__ __forceinline__ void state_chain(Frame& F, const Ptrs& P, int bh) {
    const int tid = F.tid, lane = F.lane, wid = F.wave, r32 = lane & 31, hi = lane >> 5;
    LAS char* lds = (LAS char*)F.lds;
    const bf16_t* gPc = (const bf16_t*)(P.ws + WS_PC) + (size_t)bh * 32 * 4096; const bf16_t* gSl = (const bf16_t*)(P.ws + WS_SLOC) + (size_t)bh * 32 * 4096;
    bf16_t* gS = (bf16_t*)((unsigned char*)P.out + DO_SC) + (size_t)bh * 32 * 4096;
    constexpr int L_S0 = 0, L_S1 = MB, L_P = 2 * MB;
    for (int i = tid; i < MB / 4; i += 512) ((LAS unsigned*)(lds + L_S0))[i] = 0u;
    const int prow = tid >> 3, pch = tid & 7;
    const int mb = wid & 1, nb = (wid >> 1) & 1;
    u32x4 pw = *(const u32x4*)(gPc + prow * 64 + pch * 8), pw1 = *(const u32x4*)(gPc + 4096 + prow * 64 + pch * 8);
    const bf16_t* sp = gSl + (32 * nb + r32) * 64 + 32 * mb + 4 * hi;
    u32x2 sw[4];
#pragma unroll
    for (int g = 0; g < 4; ++g) sw[g] = wid < 4 ? *(const u32x2*)(sp + 8 * g) : (u32x2){0u, 0u};
    LBAR();
#pragma unroll 1
    for (int c = 0; c < 32; ++c) {
        const int sc = (c & 1) ? L_S1 : L_S0, sn = (c & 1) ? L_S0 : L_S1;
        *(LAS u32x4*)(lds + L_P + (prow * LDB + pch * 8) * 2) = pw;
        *(u32x4*)(gS + (size_t)c * 4096 + prow * 64 + pch * 8) = *(const LAS u32x4*)(lds + sc + (prow * LDB + pch * 8) * 2);
        pw = pw1; if (c + 2 < 32) pw1 = *(const u32x4*)(gPc + (size_t)(c + 2) * 4096 + prow * 64 + pch * 8);
        f32x16 d;
#pragma unroll
        for (int g = 0; g < 4; ++g) { const u32x2 w = sw[g]; d[4 * g] = bf_lo(w.x); d[4 * g + 1] = bf_hi(w.x); d[4 * g + 2] = bf_lo(w.y); d[4 * g + 3] = bf_hi(w.y); }
        if (wid < 4 && c + 1 < 32) {
#pragma unroll
            for (int g = 0; g < 4; ++g) sw[g] = *(const u32x2*)(sp + (size_t)(c + 1) * 4096 + 8 * g); }
        LBAR();
        if (wid < 4) { d = mm64(d, lds + L_P + 32 * mb * LDB * 2, lds + sc + 32 * nb * LDB * 2, lane); store_T(d, lds + sn, mb, nb, lane); }
        LBAR();
    }
}

__device__ __forceinline__ void out_unit(Frame& F, const Ptrs& P, int u, int nb, bool do_store = true) {
    const int lane = F.lane, r32 = lane & 31, hi = lane >> 5;
    const bf16_t* gQe = (const bf16_t*)(P.ws + WS_QE) + (size_t)u * 4096; const bf16_t* gYl = (const bf16_t*)(P.ws + WS_YLOC) + (size_t)u * 4096;
    const bf16_t* gS = (const bf16_t*)((unsigned char*)P.out + DO_SC) + (size_t)u * 4096; const bf16_t* gG = (const bf16_t*)((unsigned char*)P.out + DO_G) + (size_t)u * 4096;
    bf16_t* Yr = (bf16_t*)((unsigned char*)P.out + DO_YRA);
    const int bh = u >> 5, c = u & 31, h = bh & 7, b = bh >> 3;
    const int tl = 32 * nb + r32;
    const size_t row = (size_t)b * SEQ + 64 * c + tl;
    bf16_t* yo = Yr + row * 1024 + h * 64 + 4 * hi; const bf16_t* gg = gG + tl * 64 + 4 * hi; const float* lg = P.in[15] + h * 64 + 4 * hi; const bf16_t* yl = gYl + tl * 64 + 4 * hi;
    bf16x8 qf[4], sa[4], sb[4];
#pragma unroll
    for (int ks = 0; ks < 4; ++ks) { qf[ks] = *(const bf16x8*)(gQe + (32 * nb + r32) * 64 + 16 * ks + 8 * hi); sa[ks] = *(const bf16x8*)(gS + r32 * 64 + 16 * ks + 8 * hi); sb[ks] = *(const bf16x8*)(gS + (32 + r32) * 64 + 16 * ks + 8 * hi); }
    u32x2 ylw[2][4], gw[2][4], cw[2][4]; f32x4 l4[2][4];
#pragma unroll
    for (int eb = 0; eb < 2; ++eb)
#pragma unroll
        for (int g = 0; g < 4; ++g) { const int eo = 32 * eb + 8 * g; ylw[eb][g] = *(const u32x2*)(yl + eo); gw[eb][g] = *(const u32x2*)(gg + eo); cw[eb][g] = *(const u32x2*)(yo + eo); l4[eb][g] = *(const f32x4*)(lg + eo); }
    f32x16 y0 = {}, y1 = {};
#pragma unroll
    for (int ks = 0; ks < 4; ++ks) { y0 = __builtin_amdgcn_mfma_f32_32x32x16_bf16(sa[ks], qf[ks], y0, 0, 0, 0); y1 = __builtin_amdgcn_mfma_f32_32x32x16_bf16(sb[ks], qf[ks], y1, 0, 0, 0); }
    float s = 0.f;
#pragma unroll
    for (int g = 0; g < 4; ++g) { const u32x2 a = ylw[0][g], bq = ylw[1][g];
        y0[4 * g] += bf_lo(a.x); y0[4 * g + 1] += bf_hi(a.x); y0[4 * g + 2] += bf_lo(a.y); y0[4 * g + 3] += bf_hi(a.y);
        y1[4 * g] += bf_lo(bq.x); y1[4 * g + 1] += bf_hi(bq.x); y1[4 * g + 2] += bf_lo(bq.y); y1[4 * g + 3] += bf_hi(bq.y); }
#pragma unroll
    for (int r = 0; r < 16; ++r) s += y0[r] + y1[r];
    s += __shfl_xor(s, 32); const float mean = s * (1.f / 64.f); float q2 = 0.f;
#pragma unroll
    for (int r = 0; r < 16; ++r) { y0[r] -= mean; y1[r] -= mean; q2 += y0[r] * y0[r] + y1[r] * y1[r]; }
    q2 += __shfl_xor(q2, 32); const float rstd = 1.f / sqrtf(q2 * (1.f / 64.f) + 64e-5f);
#pragma unroll
    for (int g = 0; g < 4; ++g) {
#pragma unroll
        for (int eb = 0; eb < 2; ++eb) { const int eo = 32 * eb + 8 * g; const u32x2 g_ = gw[eb][g], c_ = cw[eb][g]; const f32x4 l_ = l4[eb][g];
            const f32x16& y = eb ? y1 : y0;
            const float o0 = y[4 * g] * rstd * l_.x * bf_lo(g_.x) + bf_lo(c_.x), o1 = y[4 * g + 1] * rstd * l_.y * bf_hi(g_.x) + bf_hi(c_.x), o2 = y[4 * g + 2] * rstd * l_.z * bf_lo(g_.y) + bf_lo(c_.y), o3 = y[4 * g + 3] * rstd * l_.w * bf_hi(g_.y) + bf_hi(c_.y);
            u32x2 w; w.x = cvt_pk_bf16(o0, o1); w.y = cvt_pk_bf16(o2, o3);
            if (do_store) *(u32x2*)(yo + eo) = w; } }
}
#undef RC_M
}
#ifndef RG
#define RG 4
#endif
__device__ __forceinline__ void phase_route(Frame& F, const Ptrs& P) {
    const int lane = F.lane, gw = F.vcu * NWAVES + F.wave, NGW = F.G * NWAVES;
    const float* x1 = P.in[0]; const bf16_t* Dl = (const bf16_t*)(P.ws + WS_DELTA); const float* mod = (const float*)(P.ws + WS_MOD);
    const float* gam2 = (const float*)(P.ws + WS_GAM2); const float* cb = (const float*)(P.ws + WS_CB);
    const bf16_t* wrh = (const bf16_t*)(P.ws + WS_WRH); const bf16_t* wrl = (const bf16_t*)(P.ws + WS_WRL);
    bf16_t* H2 = (bf16_t*)(P.ws + WS_H2);
    int* tok_list = (int*)(P.ws + WS_TOKLIST); int* tok_pos = (int*)(P.ws + WS_TOKPOS); int* slot_tok = (int*)(P.ws + WS_SLOTTOK); float* slot_w = (float*)(P.ws + WS_SLOTW);
    unsigned* cnt = (unsigned*)(F.ctl + CW_CNT);
    constexpr int WROW = 1040, L_WH = 0, L_WLO = 48 * WROW, L_GAM = 2 * 48 * WROW, L_SCR = L_GAM + 4096, L_CNT = L_SCR + 8 * 16 * 52 * 4;
    static_assert(L_CNT + 1024 <= LDSCTL_OFF, "route LDS");
    LAS char* lds = (LAS char*)F.lds;
    LAS float* scr = (LAS float*)(lds + L_SCR) + F.wave * (16 * 52);
    const int fr = lane & 15, kq = lane >> 4;
    LAS unsigned* lcnt = (LAS unsigned*)(lds + L_CNT); LAS unsigned* lbase = lcnt + 64;
    for (int rnd = F.vcu; rnd < NTOK / 128; rnd += F.G) {
        const int R0 = rnd * 128 + F.wave * 16, b = R0 / SEQ;
        const float* xr = x1 + (size_t)(R0 + fr) * DM + 8 * kq; const bf16_t* dr = Dl + (size_t)(R0 + fr) * DM + 8 * kq;
        f32x4 acc[3] = {{0.f, 0.f, 0.f, 0.f}, {0.f, 0.f, 0.f, 0.f}, {0.f, 0.f, 0.f, 0.f}}; float ssq = 0.f;
#pragma unroll 1
        for (int half = 0; half < 2; ++half) {
            __syncthreads();
            if (half == 0) { if (F.tid < NLIST) lcnt[F.tid] = 0u; for (int i = F.tid; i < DM / 4; i += 512) *(LAS f32x4*)(lds + L_GAM + 16 * i) = *(const f32x4*)(gam2 + (size_t)b * DM + 4 * i); }
            for (int i = F.tid; i < 48 * 64; i += 512) { const int row = i >> 6, ch = i & 63;
                *(LAS u32x4*)(lds + L_WH + row * WROW + ch * 16) = *(const u32x4*)(wrh + (size_t)row * DM + half * 512 + ch * 8);
                *(LAS u32x4*)(lds + L_WLO + row * WROW + ch * 16) = *(const u32x4*)(wrl + (size_t)row * DM + half * 512 + ch * 8); }
            __syncthreads();
            const LAS char* bh = lds + L_WH + fr * WROW + kq * 16; const LAS char* bl = lds + L_WLO + fr * WROW + kq * 16; const LAS char* gp = lds + L_GAM + (half * 512 + 8 * kq) * 4;
#pragma unroll 2
            for (int kk = 0; kk < 512; kk += 32) { const int k0 = half * 512 + kk;
                f32x4 xa = *(const f32x4*)(xr + k0), xb = *(const f32x4*)(xr + k0 + 4); const f32x4 ga = *(const LAS f32x4*)(gp + kk * 4), gb = *(const LAS f32x4*)(gp + kk * 4 + 16);
                { const u32x4 dw = *(const u32x4*)(dr + k0); xa.x += bf_lo(dw.x); xa.y += bf_hi(dw.x); xa.z += bf_lo(dw.y); xa.w += bf_hi(dw.y); xb.x += bf_lo(dw.z); xb.y += bf_hi(dw.z); xb.z += bf_lo(dw.w); xb.w += bf_hi(dw.w); }
                { u32x4 xw; xw.x = cvt_pk_bf16(xa.x, xa.y); xw.y = cvt_pk_bf16(xa.z, xa.w); xw.z = cvt_pk_bf16(xb.x, xb.y); xw.w = cvt_pk_bf16(xb.z, xb.w); *(u32x4*)(const_cast<bf16_t*>(dr) + k0) = xw; }
                ssq += (xa.x * xa.x + xa.y * xa.y) + (xa.z * xa.z + xa.w * xa.w) + (xb.x * xb.x + xb.y * xb.y) + (xb.z * xb.z + xb.w * xb.w);
                const f32x4 ya = xa * ga, yb = xb * gb;
                u32x4 hw; hw.x = cvt_pk_bf16(ya.x, ya.y); hw.y = cvt_pk_bf16(ya.z, ya.w); hw.z = cvt_pk_bf16(yb.x, yb.y); hw.w = cvt_pk_bf16(yb.z, yb.w);
                u32x4 lw; lw.x = cvt_pk_bf16(ya.x - bf_lo(hw.x), ya.y - bf_hi(hw.x)); lw.y = cvt_pk_bf16(ya.z - bf_lo(hw.y), ya.w - bf_hi(hw.y));
                lw.z = cvt_pk_bf16(yb.x - bf_lo(hw.z), yb.y - bf_hi(hw.z)); lw.w = cvt_pk_bf16(yb.z - bf_lo(hw.w), yb.w - bf_hi(hw.w));
                const bf16x8 ah = __builtin_bit_cast(bf16x8, hw), al = __builtin_bit_cast(bf16x8, lw);
#pragma unroll
                for (int nb = 0; nb < 3; ++nb) { const bf16x8 wh = *(const LAS bf16x8*)(bh + nb * 16 * WROW + kk * 2), wl = *(const LAS bf16x8*)(bl + nb * 16 * WROW + kk * 2);
                    acc[nb] = __builtin_amdgcn_mfma_f32_16x16x32_bf16(ah, wh, acc[nb], 0, 0, 0); acc[nb] = __builtin_amdgcn_mfma_f32_16x16x32_bf16(al, wh, acc[nb], 0, 0, 0); acc[nb] = __builtin_amdgcn_mfma_f32_16x16x32_bf16(ah, wl, acc[nb], 0, 0, 0); }
            }
        }
        ssq += __shfl_xor(ssq, 16); ssq += __shfl_xor(ssq, 32);
        const float rinv = 1.f / sqrtf(ssq * (1.f / DM) + 1e-6f);
#pragma unroll
        for (int nb = 0; nb < 3; ++nb)
#pragma unroll
            for (int j = 0; j < 4; ++j) scr[(4 * kq + j) * 52 + 16 * nb + fr] = acc[nb][j];
        LDS_WAIT(); asm volatile("" ::: "memory");
        int l1 = 0, l2 = 0, q1 = 0, q2 = 0; float w1 = 0.f, w2 = 0.f;
        if (lane < 16) {
            const float* cbb = cb + b * 64; const LAS float* lr = scr + lane * 52;
            float lc[4]; int grp = 0; float best = -3.4e38f;
#pragma unroll
            for (int o = 0; o < 4; ++o) { lc[o] = rinv * lr[o] + cbb[o]; if (lc[o] > best) { best = lc[o]; grp = o; } }
            float den = 0.f;
#pragma unroll
            for (int o = 0; o < 4; ++o) den += __expf(lc[o] - best);
            const float pgrp = 1.f / den;
            float f1 = -3.4e38f, f2 = -3.4e38f; int i1 = 0, i2 = 0;
            for (int o = 0; o < 8; ++o) { const float v = rinv * lr[4 + grp * 8 + o] + cbb[4 + grp * 8 + o];
                if (v > f1) { f2 = f1; i2 = i1; f1 = v; i1 = o; } else if (v > f2) { f2 = v; i2 = o; } }
            const float e2 = __expf(f2 - f1); w1 = pgrp / (1.f + e2); w2 = pgrp * e2 / (1.f + e2);
            l1 = (grp * 8 + i1) * 2; l2 = (grp * 8 + i2) * 2 + 1;
            q1 = (int)__hip_atomic_fetch_add(lcnt + l1, 1u, __ATOMIC_RELAXED, __HIP_MEMORY_SCOPE_WORKGROUP); q2 = (int)__hip_atomic_fetch_add(lcnt + l2, 1u, __ATOMIC_RELAXED, __HIP_MEMORY_SCOPE_WORKGROUP);
        }
        __syncthreads();
        if (F.tid < NLIST) { const unsigned c = ((LAS unsigned*)lcnt)[F.tid]; lbase[F.tid] = c ? atomicAdd(cnt + 64 * F.tid, c) : 0u; }
        __syncthreads();
        if (lane < 16) { const int tok = R0 + lane;
            const int p1 = (int)lbase[l1] + q1, p2 = (int)lbase[l2] + q2;
            tok_list[2 * tok] = l1; tok_list[2 * tok + 1] = l2; tok_pos[2 * tok] = p1; tok_pos[2 * tok + 1] = p2;
            slot_tok[(size_t)l1 * NTOK + p1] = tok; slot_tok[(size_t)l2 * NTOK + p2] = tok; slot_w[(size_t)l1 * NTOK + p1] = w1; slot_w[(size_t)l2 * NTOK + p2] = w2; }
        const float* sh = mod + (size_t)b * MODW + 3 * DM;
        f32x4 gq[4], sq[4];
#pragma unroll
        for (int j = 0; j < 4; ++j) { const int k = 4 * lane + 256 * j; gq[j] = *(const f32x4*)(gam2 + (size_t)b * DM + k); sq[j] = *(const f32x4*)(sh + k); }
#pragma unroll 1
        for (int r0 = 0; r0 < 16; r0 += RG) {
            u32x2 dq[RG][4];
#pragma unroll
            for (int rr = 0; rr < RG; ++rr) { const GAS u32x2* drow = (const GAS u32x2*)(Dl + (size_t)(R0 + r0 + rr) * DM) + lane;
#pragma unroll
                for (int j = 0; j < 4; ++j) dq[rr][j] = drow[64 * j]; }
#pragma unroll
            for (int rr = 0; rr < RG; ++rr) { const float ri = __shfl(rinv, r0 + rr);
                GAS u32x2* o8 = (GAS u32x2*)(H2 + (size_t)(R0 + r0 + rr) * DM) + lane;
#pragma unroll
                for (int j = 0; j < 4; ++j) { f32x4 xv; const u32x2 dw = dq[rr][j]; xv.x = bf_lo(dw.x); xv.y = bf_hi(dw.x); xv.z = bf_lo(dw.y); xv.w = bf_hi(dw.y);
                    const f32x4 hv = xv * ri * gq[j] + sq[j]; u32x2 w; w.x = cvt_pk_bf16(hv.x, hv.y); w.y = cvt_pk_bf16(hv.z, hv.w); o8[64 * j] = w; } }
        }
        LDS_WAIT(); asm volatile("" ::: "memory");
    }
}
__device__ __forceinline__ void moe_offsets(Frame& F) {
    LAS int* toff = (LAS int*)(F.lds + TOFF_OFF); LAS int* lcnt = (LAS int*)(F.lds + LCNT_OFF); LAS unsigned char* tile_l = (LAS unsigned char*)(F.lds + TILE_L_OFF);
    if (F.tid < NLIST) lcnt[F.tid] = (int)__hip_atomic_load(F.ctl + CW_CNT + 64 * F.tid, RLX_AGENT);
    __syncthreads();
    if (F.tid == 0) { int acc = 0;
#pragma unroll 1
        for (int l = 0; l < NLIST; ++l) { toff[l] = acc; acc += (lcnt[l] + 255) >> 8; } toff[NLIST] = acc; }
    __syncthreads();
    if (F.tid < NLIST) { for (int t = toff[F.tid]; t < toff[F.tid + 1]; ++t) tile_l[t] = (unsigned char)F.tid; }
    __syncthreads();
}
#ifndef MK_ONE_LAUNCH
#define MK_ONE_LAUNCH 1
#endif
constexpr int N_PHASES = 12;

__global__ void __launch_bounds__(NWAVES * 64, 2) fwd_kernel(Args args) {
    extern __shared__ __attribute__((aligned(16))) unsigned char lds_raw[];
    Frame F; F.lds = (LAS unsigned char*)lds_raw; F.MISC = (volatile LAS unsigned*)(F.lds + MISC_OFF);
    F.tid = threadIdx.x; F.lane = F.tid & 63; F.wave = __builtin_amdgcn_readfirstlane(F.tid >> 6);
    F.G = gridDim.x; { const int bx = blockIdx.x; F.vcu = (F.G % 8 == 0) ? (bx % 8) * (F.G / 8) + bx / 8 : bx; }
#ifndef DUP_PHASE
#define DUP_PHASE -1
#endif
#define RELOAD_ARGS() Ptrs P; { int z_ = 0; asm volatile("" : "+s"(z_)); _Pragma("unroll") for (int i_ = 0; i_ < 31; ++i_) P.in[i_] = args.in[i_] + z_; P.out = args.out + z_; P.ws = args.ws + z_; }
    F.ctl = (gu32*)(args.ws + WS_CTL);
    for (int u = F.tid; u < (LDS_BYTES - LDSCTL_OFF) / 4; u += NWAVES * 64) ((LAS unsigned*)(F.lds + LDSCTL_OFF))[u] = 0u;
    __syncthreads();
    XcdBarrier bar; bar.bar = (unsigned*)(F.ctl + CW_BAR); bar.x = 0; bar.st = nullptr;
#if MK_ONE_LAUNCH
    bar = xcd_barrier_post((unsigned*)(F.ctl + CW_BAR), F.MISC + 8);
#define GRID_BAR() xcd_barrier(bar)
#else
#define GRID_BAR() do { } while (0)
#endif
    const int lo = args.ph_lo, hi = args.ph_hi;
#ifndef PH_MASK
#define PH_MASK 0xfff
#endif
#define IN(k) ((((PH_MASK) >> (k)) & 1) && lo <= (k) && (k) < hi)
#ifndef TIME_PHASE
#define TIME_PHASE -1
#endif
#define STAMP(i) do { if (TIME_PHASE >= 0 && blockIdx.x == 0 && F.tid == 0) ((unsigned long long*)(args.ws + WS_CTL + 768 * KiB))[i] = __builtin_amdgcn_s_memrealtime(); } while (0)
#define SEAM(k) do { if (IN(k) && IN((k) + 1)) GRID_BAR(); STAMP((k) + 1); } while (0)
    STAMP(0);
#ifndef GPROF_PHASE
#define GPROF_PHASE -1
#endif
#define GFLUSH(ph) do { if (GPROF_ON && GPROF_PHASE == (ph) && blockIdx.x == 0 && F.tid == 0) { unsigned long long* tsp = (unsigned long long*)(args.ws + WS_CTL + 768 * KiB); unsigned long long a_ = 0; tsp[20] = 0; for (int k_ = 0; k_ < 10; ++k_) { a_ += F.MISC[16 + k_]; tsp[21 + k_] = a_; } } } while (0)
#define MODP ((float*)(P.ws + WS_MOD))
#define PGATE ((unsigned char*)(P.ws + WS_PGATE))

    if (IN(0)) for (int rep_ = 0; rep_ < ((0) == DUP_PHASE ? 2 : 1); ++rep_) { if (rep_) GRID_BAR(); RELOAD_ARGS(); phase_mod(F, P.in[1], P.in[2], P.in[3], MODP, P.ws); } SEAM(0);
    if (IN(1)) for (int rep_ = 0; rep_ < ((1) == DUP_PHASE ? 2 : 1); ++rep_) { if (rep_) GRID_BAR(); RELOAD_ARGS(); phase_prep(F, P); } SEAM(1);
    if (IN(2)) for (int rep_ = 0; rep_ < ((2) == DUP_PHASE ? 2 : 1); ++rep_) { if (rep_) GRID_BAR(); RELOAD_ARGS();
        pg8::Gemm g{DM, DM, DM}; pg8::DenseOrder S; S.init((const bf16_t*)((unsigned char*)P.out + DO_H), (const bf16_t*)(P.ws + WS_WIN), DM, DM, NTOK, INCOLS, F.G, (int)blockIdx.x);
        pg8::EpiP E{(bf16_t*)(P.ws + WS_PRW), (bf16_t*)(P.ws + WS_PATT), PGATE};
        pg8::gemm_phase<pg8::EpiP, pg8::DenseOrder, true>(F.lds, g, S, E); GFLUSH(2);
        { const int nfull = (NTOK / 256) * (INCOLS / 256) % F.G; const int bx = (int)blockIdx.x; if (nfull > 0 && bx >= nfull) expert_convert_down(F, P, (bx - nfull) * NWAVES + F.wave, (F.G - nfull) * NWAVES); else if (nfull == 0) expert_convert_down(F, P, bx * NWAVES + F.wave, F.G * NWAVES); }
    } SEAM(2);
    if (IN(3)) for (int rep_ = 0; rep_ < ((3) == DUP_PHASE ? 2 : 1); ++rep_) { if (rep_) GRID_BAR(); RELOAD_ARGS();
#pragma unroll 1
        for (int r2 = 0; r2 < (DUP_PHASE == 31 ? 2 : 1); ++r2)
#pragma unroll 1
        for (int u = (int)blockIdx.x; u < NB * 8 * 8; u += F.G) att::attn_unit(F, P, u >> 6, (u >> 3) & 7, u & 7);
        __syncthreads();
#pragma unroll 1
        for (int r2 = 0; r2 < (DUP_PHASE == 30 ? 2 : 1); ++r2) rc::chunk_phase(F, P);
        if (TIME_PHASE >= 20 && GPROF_PHASE < 0 && blockIdx.x == 0 && F.tid == 0) { unsigned long long* tsp = (unsigned long long*)(args.ws + WS_CTL + 768 * KiB); unsigned long long a_ = 0; tsp[20] = 0; for (int k_ = 0; k_ < 10; ++k_) { a_ += F.MISC[16 + k_]; tsp[21 + k_] = a_; } }
    } SEAM(3);
    constexpr int EC_ITEMS = NE * 2 * 256, EC_SPLIT = EC_ITEMS;
    if (IN(4)) for (int rep_ = 0; rep_ < ((4) == DUP_PHASE ? 2 : 1); ++rep_) { if (rep_) GRID_BAR(); RELOAD_ARGS();
        const int nR = F.G >= 256 ? 128 : F.G / 2, bx = (int)blockIdx.x;
        if (bx < nR) { for (int u = bx; u < NB * 8; u += nR) rc::state_chain(F, P, u); }
        else { const int na = F.G - nR, a = bx - nR; expert_convert(F, P, a * NWAVES + F.wave, na * NWAVES, 0, EC_SPLIT); }
    } SEAM(4);
    if (IN(5)) for (int rep_ = 0; rep_ < ((5) == DUP_PHASE ? 2 : 1); ++rep_) { if (rep_) GRID_BAR(); RELOAD_ARGS();
        const int gw = (int)blockIdx.x * NWAVES + F.wave, NGW = F.G * NWAVES;
        for (int w = gw; w < NB * 8 * 32 * 2; w += NGW) rc::out_unit(F, P, w >> 1, w & 1, !(DUP_PHASE == 5 && rep_ == 0));
        expert_convert(F, P, gw, NGW, EC_SPLIT, EC_ITEMS);
    } SEAM(5);
    if (IN(6)) for (int rep_ = 0; rep_ < ((6) == DUP_PHASE ? 2 : 1); ++rep_) { if (rep_) GRID_BAR(); RELOAD_ARGS();
        pg8::Gemm g{DM, DM, DM}; pg8::DenseOrder S; S.init((const bf16_t*)((unsigned char*)P.out + DO_YRA), (const bf16_t*)(P.ws + WS_WBR), DM, DM, NTOK, DM, F.G, (int)blockIdx.x);
        pg8::EpiMix E{(bf16_t*)(P.ws + WS_T), PGATE}; pg8::gemm_phase<pg8::EpiMix, pg8::DenseOrder, true>(F.lds, g, S, E);
    } SEAM(6);
    if (IN(7)) for (int rep_ = 0; rep_ < ((7) == DUP_PHASE ? 2 : 1); ++rep_) { if (rep_) GRID_BAR(); RELOAD_ARGS();
        pg8::Gemm g{DM, DM, DM}; pg8::DenseOrder S; S.init((const bf16_t*)(P.ws + WS_T), (const bf16_t*)(P.ws + WS_WOUT), DM, DM, NTOK, DM, F.G, (int)blockIdx.x);
        pg8::EpiDelta E{(bf16_t*)(P.ws + WS_DELTA), MODP}; E.scr = args.scr; pg8::gemm_phase<pg8::EpiDelta, pg8::DenseOrder, true>(F.lds, g, S, E); GFLUSH(7);
    } SEAM(7);
    if (IN(8)) for (int rep_ = 0; rep_ < ((8) == DUP_PHASE ? 2 : 1); ++rep_) { if (rep_) GRID_BAR(); RELOAD_ARGS(); phase_route(F, P); } SEAM(8);
    if (IN(9)) for (int rep_ = 0; rep_ < ((9) == DUP_PHASE ? 2 : 1); ++rep_) { if (rep_) GRID_BAR(); RELOAD_ARGS();
        moe_offsets(F); const LAS int* toff = (const LAS int*)(F.lds + TOFF_OFF);
        pg8::Gemm g{DM, DM, DM}; pg8::MoeOrderT<true> S{(const bf16_t*)(P.ws + WS_H2), (const bf16_t*)(P.ws + WS_WGU), DM, DM, (size_t)DM * DM, (const LAS unsigned char*)(F.lds + TILE_L_OFF), toff, (const LAS int*)(F.lds + LCNT_OFF), 0, toff[NLIST], F.G, (int)blockIdx.x, (const int*)(P.ws + WS_SLOTTOK)};
        pg8::EpiHid E{(bf16_t*)(P.ws + WS_HID)}; pg8::gemm_phase<pg8::EpiHid, pg8::MoeOrderT<true>, true>(F.lds, g, S, E); GFLUSH(9);
    } SEAM(9);
    if (IN(10)) for (int rep_ = 0; rep_ < ((10) == DUP_PHASE ? 2 : 1); ++rep_) { if (rep_) GRID_BAR(); RELOAD_ARGS();
        moe_offsets(F); const LAS int* toff = (const LAS int*)(F.lds + TOFF_OFF);
        pg8::Gemm g{DE, DE, DE}; pg8::MoeOrderT<false> S{(const bf16_t*)(P.ws + WS_HID), (const bf16_t*)(P.ws + WS_WD), DE, DE, (size_t)DM * DE, (const LAS unsigned char*)(F.lds + TILE_L_OFF), toff, (const LAS int*)(F.lds + LCNT_OFF), 0, toff[NLIST], F.G, (int)blockIdx.x, nullptr};
        pg8::EpiY E{(bf16_t*)(P.ws + WS_YB), (const float*)(P.ws + WS_SLOTW)}; pg8::gemm_phase<pg8::EpiY, pg8::MoeOrderT<false>, true>(F.lds, g, S, E); GFLUSH(10);
    } SEAM(10);
    if (IN(11)) for (int rep_ = 0; rep_ < ((11) == DUP_PHASE ? 2 : 1); ++rep_) { if (rep_) GRID_BAR(); RELOAD_ARGS();
        moe_offsets(F); const LAS int* toff = (const LAS int*)(F.lds + TOFF_OFF);
        const bf16_t* Yb = (const bf16_t*)(P.ws + WS_YB); const int* tok_list = (const int*)(P.ws + WS_TOKLIST); const int* tok_pos = (const int*)(P.ws + WS_TOKPOS);
        const float* mod = MODP; const int gw = F.vcu * NWAVES + F.wave, NGW = F.G * NWAVES;
#pragma unroll 4
        for (int tok = gw; tok < NTOK; tok += NGW) {
            const int s0 = toff[tok_list[2 * tok]] * 256 + tok_pos[2 * tok], s1 = toff[tok_list[2 * tok + 1]] * 256 + tok_pos[2 * tok + 1];
            const float* g2 = mod + (size_t)(tok / SEQ) * MODW + 5 * DM;
            GAS f32x4* xo = (GAS f32x4*)(P.out + (size_t)tok * DM) + F.lane; const GAS u32x2* dd = (const GAS u32x2*)((const bf16_t*)(P.ws + WS_DELTA) + (size_t)tok * DM) + F.lane;
            u32x2 xb[4];
#pragma unroll
            for (int j = 0; j < 4; ++j) xb[j] = __builtin_nontemporal_load(dd + 64 * j);
            const GAS u32x2* y0 = (const GAS u32x2*)(Yb + (size_t)s0 * DM) + F.lane; const GAS u32x2* y1 = (const GAS u32x2*)(Yb + (size_t)s1 * DM) + F.lane;
#pragma unroll
            for (int j = 0; j < 4; ++j) { f32x4 xv; const u32x2 dw = xb[j]; xv.x = bf_lo(dw.x); xv.y = bf_hi(dw.x); xv.z = bf_lo(dw.y); xv.w = bf_hi(dw.y); const u32x2 a = __builtin_nontemporal_load(y0 + 64 * j), bq = __builtin_nontemporal_load(y1 + 64 * j); const f32x4 gv = *(const f32x4*)(g2 + 4 * F.lane + 256 * j);
                f32x4 o; o.x = xv.x + gv.x * (bf_lo(a.x) + bf_lo(bq.x)); o.y = xv.y + gv.y * (bf_hi(a.x) + bf_hi(bq.x)); o.z = xv.z + gv.z * (bf_lo(a.y) + bf_lo(bq.y)); o.w = xv.w + gv.w * (bf_hi(a.y) + bf_hi(bq.y));
                __builtin_nontemporal_store(o, xo + 64 * j); }
        }
    }
#ifdef EXTRA_BARS
    for (int i_ = 0; i_ < EXTRA_BARS; ++i_) GRID_BAR();
#endif
#if TIME_PHASE >= 0
    {
#ifndef TIME_SCALE
#define TIME_SCALE 3.0e-4f
#endif
#ifndef TIME_HI
#define TIME_HI (TIME_PHASE + 1)
#endif
        STAMP(12); GRID_BAR();
        const unsigned long long* ts = (const unsigned long long*)(args.ws + WS_CTL + 768 * KiB);
        const float dlt = (float)(ts[TIME_HI] - ts[TIME_PHASE]) * (0.01f * TIME_SCALE);
        for (int i = blockIdx.x * 512 + F.tid; i < (1 << 20); i += gridDim.x * 512) args.out[i] += dlt;
    }
#endif
#undef IN
#undef SEAM
}

extern "C" void kernel_launch(void* const* d_in, const int* in_sizes, int n_in, void* d_out, int out_size, void* d_ws, size_t ws_size, hipStream_t stream) {
    static int grid = 0;
    if (grid == 0) {
        if (n_in != 31 || out_size != NTOK * DM || ws_size < WS_END) { fprintf(stderr, "kernel_launch: unexpected shapes (n_in %d out %d ws %zu)\n", n_in, out_size, ws_size); grid = -1; return; }
        int dev = 0, cus = 0;
        if (hipGetDevice(&dev) != hipSuccess || hipDeviceGetAttribute(&cus, hipDeviceAttributeMultiprocessorCount, dev) != hipSuccess) { grid = -1; return; }
        if (hipFuncSetAttribute((const void*)fwd_kernel, hipFuncAttributeMaxDynamicSharedMemorySize, LDS_BYTES) != hipSuccess) { fprintf(stderr, "kernel_launch: hipFuncSetAttribute failed\n"); grid = -1; return; }
        int per_cu = 0; (void)hipOccupancyMaxActiveBlocksPerMultiprocessor(&per_cu, (const void*)fwd_kernel, NWAVES * 64, LDS_BYTES); (void)hipGetLastError();
        grid = cus;
    }
    if (grid < 0) return;
    (void)hipMemsetAsync((char*)d_ws + WS_CTL, 0, CTL_ZERO_BYTES, stream);
    Args a{};
    for (int i = 0; i < 31; ++i) a.in[i] = (const float*)d_in[i];
    a.out = (float*)d_out; a.ws = (unsigned char*)d_ws;
#if MK_ONE_LAUNCH
    a.ph_lo = 0; a.ph_hi = N_PHASES;
    hipLaunchKernelGGL(fwd_kernel, dim3(grid), dim3(NWAVES * 64), LDS_BYTES, stream, a);
#else
    for (int p = 0; p < N_PHASES; ++p) {
#ifdef PROBE7
        if (p == 7) { a.ph_lo = 7; a.ph_hi = 8; a.scr = PROBE7 - 1; hipLaunchKernelGGL(fwd_kernel, dim3(grid), dim3(NWAVES * 64), LDS_BYTES, stream, a); a.scr = 0; }
#endif
        a.ph_lo = p; a.ph_hi = p + 1; hipLaunchKernelGGL(fwd_kernel, dim3(grid), dim3(NWAVES * 64), LDS_BYTES, stream, a); }
#endif
}
```

```cpp
#include <hip/hip_runtime.h>
#include <cstdio>
#include <cstdint>

#define LAS __attribute__((address_space(3)))
#define GAS __attribute__((address_space(1)))
typedef unsigned short bf16_t;
typedef short bf16x8 __attribute__((ext_vector_type(8)));
typedef short s16x4 __attribute__((ext_vector_type(4)));
typedef float f32x4 __attribute__((ext_vector_type(4)));
typedef float f32x2 __attribute__((ext_vector_type(2)));
typedef float f32x16 __attribute__((ext_vector_type(16)));
typedef unsigned u32x4 __attribute__((ext_vector_type(4)));
typedef unsigned u32x2 __attribute__((ext_vector_type(2)));

constexpr int NB = 16, SEQ = 2048, DM = 1024, NTOK = NB * SEQ;
constexpr int RCOLS = 1792, ACOLS = 1536, GCOLS = 2048, INCOLS = 5376;
constexpr int NE = 32, DE = 512, NLIST = 64;
constexpr int MODW = 6 * DM;
constexpr float LOG2E = 1.4426950408889634f;

typedef __bf16 bf16x2_t __attribute__((ext_vector_type(2)));
__device__ __forceinline__ unsigned cvt_pk_bf16(float lo, float hi) { const f32x2 v = {lo, hi}; const bf16x2_t b = __builtin_convertvector(v, bf16x2_t); return __builtin_bit_cast(unsigned, b); }
__device__ __forceinline__ float bf_lo(unsigned w) { return __uint_as_float(w << 16); }
__device__ __forceinline__ float bf_hi(unsigned w) { return __uint_as_float(w & 0xffff0000u); }
__device__ __forceinline__ float sigmoidf_(float x) { return __builtin_amdgcn_rcpf(1.0f + __builtin_amdgcn_exp2f(-x * LOG2E)); }

#ifndef GPROF_ON
#define GPROF_ON 0
#endif
#define GPROF(k) do { if (GPROF_ON && blockIdx.x == 0 && threadIdx.x == 0) { volatile LAS unsigned* M_ = (volatile LAS unsigned*)(lds + (163840 - 2048)); const unsigned now_ = (unsigned)__builtin_amdgcn_s_memrealtime(); M_[16 + (k)] += now_ - M_[15]; M_[15] = now_; } } while (0)
#define EPI_ST0(T_, p_, v_) (*(T_*)(p_) = v_)
#ifndef EPI_NT
#define EPI_NT 1
#endif
#if EPI_NT
#define EPI_ST(T_, p_, v_) __builtin_nontemporal_store(v_, (T_*)(p_))
#else
#define EPI_ST(T_, p_, v_) (*(T_*)(p_) = v_)
#endif
namespace pg8 {
constexpr int BM = 256, BK = 64, HALF = 128, HTB = HALF * BK * 2, STAGE_BYTES = 8 * HTB, NXCD = 8, WGM = 8;
__host__ __device__ __forceinline__ int lds_byte(int r, int c) { const int st = (r >> 4) * 2 + (c >> 5), rr = r & 15, cc = c & 31, ob = rr * 64 + cc * 2; return st * 1024 + (ob ^ (((ob >> 9) & 1) << 5)); }
__host__ __device__ __forceinline__ void stage_rc(int b, int& R, int& C) { const int st = b / 1024, sb = b % 1024, swz = sb ^ (((sb >> 9) & 1) << 5); R = (st >> 1) * 16 + swz / 64; C = (st & 1) * 32 + (swz % 64) / 2; }
__host__ __device__ __forceinline__ int perm32(int rho) { const int n = rho >> 4, i = rho & 15; return 8 * (i >> 2) + 4 * n + (i & 3); }

struct Unit { int pm, pn, e, sbase, nvalid; };
struct Gemm { int lda, ldb, K; };

struct DenseOrder {
    static constexpr bool GATHER = false;
    __device__ __forceinline__ int row_tok(const Unit&, int) const { return 0; }
    const bf16_t* A; const bf16_t* Bt; int lda, ldb;
    int nM, nN, nwg, G, c;
    __device__ void init(const bf16_t* A_, const bf16_t* Bt_, int lda_, int ldb_, int M, int N, int G_, int c_) { A = A_; Bt = Bt_; lda = lda_; ldb = ldb_; nM = M / BM; nN = N / BM; nwg = nM * nN; G = G_; c = c_; }
    __device__ bool next(int i, Unit& u) const {
        const long L = (long)i * G + c; if (L >= nwg) return false;
        int wgid = (int)L; { const int q = nwg / NXCD, r = nwg % NXCD, xcd = wgid % NXCD, off = wgid / NXCD; wgid = (xcd < r ? xcd * (q + 1) : r * (q + 1) + (xcd - r) * q) + off; }
        const int nig = WGM * nN, gid = wgid / nig, fm = gid * WGM, gsz = (nM - fm) < WGM ? (nM - fm) : WGM;
        u.pm = fm + ((wgid % nig) % gsz); u.pn = (wgid % nig) / gsz; u.e = 0; u.sbase = 0; u.nvalid = BM; return true;
    }
    __device__ __forceinline__ const char* a_base(const Unit& u) const { return (const char*)A + (size_t)u.pm * BM * lda * 2; }
    __device__ __forceinline__ const char* b_base(const Unit& u) const { return (const char*)Bt + (size_t)u.pn * BM * ldb * 2; }
};
template <bool GATHER_> struct MoeOrderT {
    static constexpr bool GATHER = GATHER_;
    const bf16_t* A; const bf16_t* Bt; int lda, ldb; size_t bt_expert_stride;
    const LAS unsigned char* tile_l;
    const LAS int* toff; const LAS int* lcnt;
    int tlo, thi, G, c;
    const int* slot_tok; int lo_n = 0; long long lo_shift = 0;
    __device__ __forceinline__ int row_tok(const Unit& u, int r) const { return r < u.nvalid ? slot_tok[u.sbase + r] : 0; }
    __device__ bool next(int i, Unit& u) const {
        const int nt = thi - tlo; int tile, pn;
        if (G % NXCD == 0) { const int x = c % NXCD, cin = c / NXCD, per = G / NXCD; const int t0 = (int)((long)nt * x / NXCD), t1 = (int)((long)nt * (x + 1) / NXCD);
            const long j = (long)i * per + cin; if (j >= (long)(t1 - t0) * 4) return false; tile = tlo + t0 + (int)(j >> 2); pn = (int)(j & 3); }
        else { const long L = (long)i * G + c; if (L >= (long)nt * 4) return false; tile = tlo + (int)(L >> 2); pn = (int)(L & 3); }
        const int l = tile_l[tile], j = tile - toff[l]; u.pm = tile; u.pn = pn; u.e = l >> 1; u.sbase = l * NTOK + j * BM; u.nvalid = lcnt[l] - j * BM; return true;
    }
    __device__ __forceinline__ const char* a_base(const Unit& u) const { return GATHER ? (const char*)A : (const char*)A + (size_t)u.pm * BM * lda * 2; }
    __device__ __forceinline__ const char* b_base(const Unit& u) const { return (const char*)Bt + ((size_t)u.e * bt_expert_stride + (size_t)u.pn * BM * ldb) * 2 + (u.e < lo_n ? lo_shift : 0ll); }
};

template <class Epi, class Sched, bool ALIGN_EPI>
__device__ __forceinline__ void gemm_phase(LAS unsigned char* lds, const Gemm g, const Sched& S, const Epi& E) {
    const int tid = threadIdx.x, wid = __builtin_amdgcn_readfirstlane(tid >> 6), lane = tid & 63, wr = wid >> 2, wc = wid & 3, fr = lane & 15, fq = lane >> 4;
    const int K = g.K, nt = K / BK;
    unsigned voffA[2], voffB[2]; int RA[2], CA2[2];
#pragma unroll
    for (int i = 0; i < 2; ++i) { int R, C; stage_rc(tid * 16 + i * 8192, R, C); RA[i] = R; CA2[i] = C * 2; const int Rb = Epi::PERM ? ((R & ~31) + perm32(R & 31)) : R;
        voffA[i] = (unsigned)(R * g.lda + C) * 2u; voffB[i] = (unsigned)(Rb * g.ldb + C) * 2u; }
    const size_t kstep = (size_t)(BK * 2);
    const size_t hstepA = (size_t)HALF * g.lda * 2, hstepB = (size_t)HALF * g.ldb * 2;
    const unsigned ldsw = (unsigned)wid * 1024u;
    const int aoff = lds_byte(wr * 64 + fr, fq * 8), boff = lds_byte(wc * 32 + fr, fq * 8);
#define PG8_SA(b, h) (((b) * 2 + (h)) * HTB)
#define PG8_SB(b, h) ((4 + (b) * 2 + (h)) * HTB)
#define PG8_STAGE(bufoff, gbase, voff) do { _Pragma("unroll") for (int _i = 0; _i < 2; ++_i) \
        __builtin_amdgcn_global_load_lds((const unsigned*)((const char*)(gbase) + (voff)[_i]), (LAS unsigned*)(lds + (bufoff) + ldsw + _i * 8192), 16, 0, 0); } while (0)
#define PG8_STAGE_A(bufoff, kptr, half, nx) do { if constexpr (Sched::GATHER) { _Pragma("unroll") for (int _i = 0; _i < 2; ++_i) \
        __builtin_amdgcn_global_load_lds((const unsigned*)((const char*)(kptr) + ((nx) ? vnx[half][_i] : vcu[half][_i])), (LAS unsigned*)(lds + (bufoff) + ldsw + _i * 8192), 16, 0, 0); } \
    else { PG8_STAGE(bufoff, (const char*)(kptr) + ((half) ? hstepA : 0), voffA); } } while (0)
#define PG8_LDA(dst, b, h) do { _Pragma("unroll") for (int m = 0; m < 4; ++m) _Pragma("unroll") for (int k = 0; k < 2; ++k) dst[m][k] = *(const LAS bf16x8*)(lds + PG8_SA(b, h) + aoff + m * 2048 + k * 1024); } while (0)
#define PG8_LDB(dst, b, h) do { _Pragma("unroll") for (int n = 0; n < 2; ++n) _Pragma("unroll") for (int k = 0; k < 2; ++k) dst[n][k] = *(const LAS bf16x8*)(lds + PG8_SB(b, h) + boff + n * 2048 + k * 1024); } while (0)
#define PG8_MMA(ai, bj, At, Bt) do { __builtin_amdgcn_s_setprio(1); _Pragma("unroll") for (int m = 0; m < 4; ++m) _Pragma("unroll") for (int n = 0; n < 2; ++n) _Pragma("unroll") for (int k = 0; k < 2; ++k) \
        acc[ai][bj][m][n] = __builtin_amdgcn_mfma_f32_16x16x32_bf16(Bt[n][k], At[m][k], acc[ai][bj][m][n], 0, 0, 0); __builtin_amdgcn_s_setprio(0); } while (0)
#define PG8_WAIT_V(n) asm volatile("s_waitcnt vmcnt(" #n ")" ::: "memory")
#define PG8_WAIT_L(n) asm volatile("s_waitcnt lgkmcnt(" #n ")" ::: "memory")
#define PG8_BAR __builtin_amdgcn_s_barrier()
#define PG8_SCHED __builtin_amdgcn_sched_barrier(0)
    Unit cur, nxt; int ui = 0;
    if (!S.next(0, cur)) return;
    f32x4 acc[2][2][4][2];
#pragma unroll
    for (int a = 0; a < 2; ++a)
#pragma unroll
        for (int b = 0; b < 2; ++b)
#pragma unroll
            for (int m = 0; m < 4; ++m)
#pragma unroll
                for (int n = 0; n < 2; ++n) acc[a][b][m][n] = (f32x4){0.f, 0.f, 0.f, 0.f};
    bf16x8 At[4][2], B0[2][2], B1[2][2];
    const char* cA = S.a_base(cur); const char* cB = S.b_base(cur);
    unsigned vcu[2][2], vnx[2][2];
    if constexpr (Sched::GATHER) {
#pragma unroll
        for (int hf = 0; hf < 2; ++hf)
#pragma unroll
            for (int i = 0; i < 2; ++i) { vcu[hf][i] = (unsigned)S.row_tok(cur, hf * HALF + RA[i]) * (unsigned)(g.lda * 2) + (unsigned)CA2[i]; vnx[hf][i] = vcu[hf][i]; } }
    if (GPROF_ON && blockIdx.x == 0 && threadIdx.x == 0) { volatile LAS unsigned* M_ = (volatile LAS unsigned*)(lds + (163840 - 2048)); for (int k_ = 0; k_ < 10; ++k_) M_[16 + k_] = 0; M_[15] = (unsigned)__builtin_amdgcn_s_memrealtime(); }
    PG8_STAGE(PG8_SB(0, 0), cB, voffB); PG8_STAGE(PG8_SB(0, 1), cB + hstepB, voffB); PG8_STAGE_A(PG8_SA(0, 0), cA, 0, false); PG8_STAGE_A(PG8_SA(0, 1), cA, 1, false);
    if (wr == 1) PG8_BAR;
    PG8_WAIT_V(2); PG8_BAR;
    PG8_STAGE(PG8_SB(1, 0), cB + kstep, voffB); PG8_STAGE_A(PG8_SA(1, 0), cA + kstep, 0, false); PG8_STAGE(PG8_SB(1, 1), cB + hstepB + kstep, voffB);
    PG8_WAIT_V(6); PG8_BAR;
    for (;;) {
        const bool has_next = S.next(ui + 1, nxt);
        const char* nA = has_next ? S.a_base(nxt) : cA; const char* nB = has_next ? S.b_base(nxt) : cB;
        if constexpr (Sched::GATHER) { if (has_next) {
#pragma unroll
            for (int hf = 0; hf < 2; ++hf)
#pragma unroll
                for (int i = 0; i < 2; ++i) vnx[hf][i] = (unsigned)S.row_tok(nxt, hf * HALF + RA[i]) * (unsigned)(g.lda * 2) + (unsigned)CA2[i]; } }
        for (int t = 0; t < nt; t += 2) {
            if constexpr (Epi::HAS_MID) { if (t == Epi::MID_T) E.mid(acc, cur, wr, wc, fr, fq); }
            const bool last = (t == nt - 2);
            const char* a1 = cA + (size_t)(t + 1) * kstep;
            const char* a2 = last ? nA : cA + (size_t)(t + 2) * kstep; const char* b2 = last ? nB : cB + (size_t)(t + 2) * kstep;
            const char* a3 = a2 + kstep; const char* b3 = b2 + kstep;
            PG8_LDB(B0, 0, 0); PG8_LDB(B1, 0, 1); PG8_SCHED; PG8_LDA(At, 0, 0); PG8_STAGE_A(PG8_SA(1, 1), a1, 1, false);
            PG8_WAIT_V(8); PG8_WAIT_L(0); PG8_BAR; PG8_MMA(0, 0, At, B0); PG8_MMA(0, 1, At, B1); PG8_BAR; PG8_SCHED;
            PG8_LDA(At, 0, 1); PG8_STAGE(PG8_SB(0, 0), b2, voffB); PG8_STAGE(PG8_SB(0, 1), b2 + hstepB, voffB); PG8_STAGE_A(PG8_SA(0, 0), a2, 0, last);
            PG8_WAIT_V(8); PG8_WAIT_L(0); PG8_BAR; PG8_MMA(1, 0, At, B0); PG8_MMA(1, 1, At, B1); PG8_BAR; PG8_SCHED;
            PG8_LDB(B0, 1, 0); PG8_LDB(B1, 1, 1); PG8_SCHED; PG8_LDA(At, 1, 0); PG8_STAGE_A(PG8_SA(0, 1), a2, 1, last);
            PG8_WAIT_V(8); PG8_WAIT_L(0); PG8_BAR; PG8_MMA(0, 0, At, B0); PG8_MMA(0, 1, At, B1); PG8_BAR; PG8_SCHED;
            PG8_LDA(At, 1, 1); PG8_STAGE(PG8_SB(1, 0), b3, voffB); PG8_STAGE(PG8_SB(1, 1), b3 + hstepB, voffB); PG8_STAGE_A(PG8_SA(1, 0), a3, 0, last);
            PG8_WAIT_V(8); PG8_WAIT_L(0); PG8_BAR; PG8_MMA(1, 0, At, B0); PG8_MMA(1, 1, At, B1); PG8_BAR; PG8_SCHED;
            if (GPROF_ON) { if (t == 0) GPROF(3); }
        }
        GPROF(0);
        if constexpr (ALIGN_EPI) { if (wr == 0) PG8_BAR; }
        GPROF(1);
        E(acc, cur, wr, wc, fr, fq);
        GPROF(2);
        if (!has_next) break;
#pragma unroll
        for (int a = 0; a < 2; ++a)
#pragma unroll
            for (int b = 0; b < 2; ++b)
#pragma unroll
                for (int m = 0; m < 4; ++m)
#pragma unroll
                    for (int n = 0; n < 2; ++n) acc[a][b][m][n] = (f32x4){0.f, 0.f, 0.f, 0.f};
        cur = nxt; cA = nA; cB = nB; ++ui;
        if constexpr (Sched::GATHER) {
#pragma unroll
            for (int hf = 0; hf < 2; ++hf)
#pragma unroll
                for (int i = 0; i < 2; ++i) vcu[hf][i] = vnx[hf][i]; }
        if constexpr (ALIGN_EPI) { if (wr == 1) PG8_BAR; }
    }
    PG8_WAIT_V(0);
    if constexpr (!ALIGN_EPI) { if (wr == 0) PG8_BAR; }
    PG8_BAR;
#undef PG8_SA
#undef PG8_SB
#undef PG8_STAGE
#undef PG8_STAGE_A
#undef PG8_LDA
#undef PG8_LDB
#undef PG8_MMA
#undef PG8_WAIT_V
#undef PG8_WAIT_L
#undef PG8_BAR
#undef PG8_SCHED
}

__device__ __forceinline__ unsigned q8(float x) { float s = sigmoidf_(x) * 255.f + 0.5f; s = s < 1.f ? 1.f : s; return (unsigned)s; }
struct EpiP {
    static constexpr bool PERM = true, HAS_MID = false;
    bf16_t *Prw, *Patt; unsigned char* Pgate;
    __device__ __forceinline__ void operator()(const f32x4 (&acc)[2][2][4][2], const Unit& u, int wr, int wc, int fr, int fq) const {
        const int row0 = u.pm * BM + wr * 64 + fr;
        if (u.pn >= 13) { const int col0 = (u.pn - 13) * BM + wc * 32 + 8 * fq;
#pragma unroll
            for (int ai = 0; ai < 2; ++ai)
#pragma unroll
                for (int m = 0; m < 4; ++m) { unsigned char* rowp = Pgate + (size_t)(row0 + ai * HALF + m * 16) * GCOLS + col0;
#pragma unroll
                    for (int bj = 0; bj < 2; ++bj) { const f32x4 v0 = acc[ai][bj][m][0], v1 = acc[ai][bj][m][1];
                        u32x2 w; w.x = q8(v0[0]) | (q8(v0[1]) << 8) | (q8(v0[2]) << 16) | (q8(v0[3]) << 24); w.y = q8(v1[0]) | (q8(v1[1]) << 8) | (q8(v1[2]) << 16) | (q8(v1[3]) << 24);
                        EPI_ST(u32x2, rowp + bj * HALF, w); } }
            return; }
        bf16_t* base; int ldc, colt;
        if (u.pn < 7) { base = Prw; ldc = RCOLS; colt = u.pn * BM; } else { base = Patt; ldc = ACOLS; colt = (u.pn - 7) * BM; }
        const int col0 = colt + wc * 32 + 8 * fq;
#pragma unroll
        for (int ai = 0; ai < 2; ++ai)
#pragma unroll
            for (int m = 0; m < 4; ++m) { bf16_t* rowp = base + (size_t)(row0 + ai * HALF + m * 16) * ldc + col0;
#pragma unroll
                for (int bj = 0; bj < 2; ++bj) { const f32x4 v0 = acc[ai][bj][m][0], v1 = acc[ai][bj][m][1];
                    u32x4 w; w.x = cvt_pk_bf16(v0[0], v0[1]); w.y = cvt_pk_bf16(v0[2], v0[3]); w.z = cvt_pk_bf16(v1[0], v1[1]); w.w = cvt_pk_bf16(v1[2], v1[3]);
                    EPI_ST(u32x4, rowp + bj * HALF, w); } }
    }
};
struct EpiMix {
    static constexpr bool PERM = true, HAS_MID = true; static constexpr int MID_T = 8;
    bf16_t* T; const unsigned char* Pgate;
    static __device__ __forceinline__ float ub(unsigned w, int i) { return (float)((w >> (8 * i)) & 0xffu); }
    __device__ __forceinline__ void mid(f32x4 (&acc)[2][2][4][2], const Unit& u, int wr, int wc, int fr, int fq) const {
        int row0 = u.pm * BM + wr * 64 + fr, col0 = u.pn * BM + wc * 32 + 8 * fq; asm volatile("" : "+v"(row0), "+v"(col0));
#pragma unroll
        for (int ai = 0; ai < 2; ++ai) {
            u32x2 gr[4][2], ga[4][2];
#pragma unroll
            for (int m = 0; m < 4; ++m) { const unsigned char* gp = Pgate + (size_t)(row0 + ai * HALF + m * 16) * GCOLS + col0;
#pragma unroll
                for (int bj = 0; bj < 2; ++bj) { gr[m][bj] = *(const u32x2*)(gp + bj * HALF); ga[m][bj] = *(const u32x2*)(gp + DM + bj * HALF); } }
#pragma unroll
            for (int m = 0; m < 4; ++m)
#pragma unroll
                for (int bj = 0; bj < 2; ++bj) { const u32x2 r = gr[m][bj], a = ga[m][bj]; f32x4& v0 = acc[ai][bj][m][0]; f32x4& v1 = acc[ai][bj][m][1];
#pragma unroll
                    for (int j = 0; j < 4; ++j) { v0[j] *= ub(r.x, j) * __builtin_amdgcn_rcpf(ub(a.x, j)); v1[j] *= ub(r.y, j) * __builtin_amdgcn_rcpf(ub(a.y, j)); } }
            asm volatile("" ::: "memory");
        }
    }
    __device__ __forceinline__ void operator()(const f32x4 (&acc)[2][2][4][2], const Unit& u, int wr, int wc, int fr, int fq) const {
        const int row0 = u.pm * BM + wr * 64 + fr, col0 = u.pn * BM + wc * 32 + 8 * fq;
        u32x2 ga[2][4][2];
#pragma unroll
        for (int ai = 0; ai < 2; ++ai)
#pragma unroll
            for (int m = 0; m < 4; ++m)
#pragma unroll
                for (int bj = 0; bj < 2; ++bj) ga[ai][m][bj] = *(const u32x2*)(Pgate + (size_t)(row0 + ai * HALF + m * 16) * GCOLS + DM + col0 + bj * HALF);
#pragma unroll
        for (int ai = 0; ai < 2; ++ai)
#pragma unroll
            for (int m = 0; m < 4; ++m) { const size_t row = (size_t)(row0 + ai * HALF + m * 16);
#pragma unroll
                for (int bj = 0; bj < 2; ++bj) { const int col = col0 + bj * HALF; const u32x2 g = ga[ai][m][bj]; constexpr float s = 1.f / 255.f;
                    const f32x4 a0 = acc[ai][bj][m][0], a1 = acc[ai][bj][m][1];
                    u32x4 w; w.x = cvt_pk_bf16(a0[0] * ub(g.x, 0) * s, a0[1] * ub(g.x, 1) * s); w.y = cvt_pk_bf16(a0[2] * ub(g.x, 2) * s, a0[3] * ub(g.x, 3) * s);
                    w.z = cvt_pk_bf16(a1[0] * ub(g.y, 0) * s, a1[1] * ub(g.y, 1) * s); w.w = cvt_pk_bf16(a1[2] * ub(g.y, 2) * s, a1[3] * ub(g.y, 3) * s);
                    EPI_ST0(u32x4, T + row * DM + col, w); } }
    }
};
struct EpiDelta {
    static constexpr bool PERM = true, HAS_MID = false;
    bf16_t* D; const float* mod; int scr = 0;
    __device__ __forceinline__ void operator()(const f32x4 (&acc)[2][2][4][2], const Unit& u, int wr, int wc, int fr, int fq) const {
        const int row0 = u.pm * BM + wr * 64 + fr, col0 = u.pn * BM + wc * 32 + 8 * fq;
        const int b = (u.pm * BM) / SEQ; const float* g1 = mod + (size_t)b * MODW + 2 * DM;
#ifdef SCR_PROBE
        if (scr) {
            bf16_t* base = D + (size_t)(u.pm * 4 + u.pn) * 65536 + (wr * 4 + wc) * 8192 + (fq * 16 + fr) * 8;
#pragma unroll
            for (int ai = 0; ai < 2; ++ai)
#pragma unroll
                for (int m = 0; m < 4; ++m)
#pragma unroll
                    for (int bj = 0; bj < 2; ++bj) { const f32x4 v0 = acc[ai][bj][m][0], v1 = acc[ai][bj][m][1];
                        u32x4 w; w.x = cvt_pk_bf16(v0[0], v0[1]); w.y = cvt_pk_bf16(v0[2], v0[3]); w.z = cvt_pk_bf16(v1[0], v1[1]); w.w = cvt_pk_bf16(v1[2], v1[3]);
                        *(u32x4*)(base + (ai * 8 + m * 2 + bj) * 512) = w; }
            return; }
#endif
        f32x4 gv[2][2];
#pragma unroll
        for (int bj = 0; bj < 2; ++bj)
#pragma unroll
            for (int n = 0; n < 2; ++n) gv[bj][n] = *(const f32x4*)(g1 + col0 + bj * HALF + 4 * n);
#pragma unroll
        for (int ai = 0; ai < 2; ++ai)
#pragma unroll
            for (int m = 0; m < 4; ++m) { bf16_t* rowp = D + (size_t)(row0 + ai * HALF + m * 16) * DM + col0;
#pragma unroll
                for (int bj = 0; bj < 2; ++bj) { const f32x4 v0 = acc[ai][bj][m][0] * gv[bj][0], v1 = acc[ai][bj][m][1] * gv[bj][1];
                    u32x4 w; w.x = cvt_pk_bf16(v0[0], v0[1]); w.y = cvt_pk_bf16(v0[2], v0[3]); w.z = cvt_pk_bf16(v1[0], v1[1]); w.w = cvt_pk_bf16(v1[2], v1[3]);
                    EPI_ST0(u32x4, rowp + bj * HALF, w); } }
    }
};
struct EpiHid {
    static constexpr bool PERM = true, HAS_MID = false;
    bf16_t* hid;
    __device__ __forceinline__ void operator()(const f32x4 (&acc)[2][2][4][2], const Unit& u, int wr, int wc, int fr, int fq) const {
        const int row0 = u.pm * BM + wr * 64 + fr, hc0 = u.pn * 128 + wc * 16 + 4 * fq;
#pragma unroll
        for (int ai = 0; ai < 2; ++ai)
#pragma unroll
            for (int m = 0; m < 4; ++m) { bf16_t* rowp = hid + (size_t)(row0 + ai * HALF + m * 16) * DE + hc0;
#pragma unroll
                for (int bj = 0; bj < 2; ++bj) { const f32x4 gt = acc[ai][bj][m][0], up = acc[ai][bj][m][1]; float h[4];
#pragma unroll
                    for (int j = 0; j < 4; ++j) h[j] = gt[j] * sigmoidf_(gt[j]) * up[j];
                    u32x2 w; w.x = cvt_pk_bf16(h[0], h[1]); w.y = cvt_pk_bf16(h[2], h[3]); EPI_ST0(u32x2, rowp + bj * 64, w); } }
    }
};
struct EpiY {
    static constexpr bool PERM = true, HAS_MID = false;
    bf16_t* Y; const float* slot_w;
    __device__ __forceinline__ void operator()(const f32x4 (&acc)[2][2][4][2], const Unit& u, int wr, int wc, int fr, int fq) const {
        const int row0 = u.pm * BM + wr * 64 + fr, col0 = u.pn * BM + wc * 32 + 8 * fq;
        float w[2][4];
#pragma unroll
        for (int ai = 0; ai < 2; ++ai)
#pragma unroll
            for (int m = 0; m < 4; ++m) { const int r = wr * 64 + fr + ai * HALF + m * 16; w[ai][m] = r < u.nvalid ? slot_w[u.sbase + r] : 0.f; }
#pragma unroll
        for (int ai = 0; ai < 2; ++ai)
#pragma unroll
            for (int m = 0; m < 4; ++m) { bf16_t* rowp = Y + (size_t)(row0 + ai * HALF + m * 16) * DM + col0; const float ws = w[ai][m];
#pragma unroll
                for (int bj = 0; bj < 2; ++bj) { const f32x4 v0 = acc[ai][bj][m][0] * ws, v1 = acc[ai][bj][m][1] * ws;
                    u32x4 o; o.x = cvt_pk_bf16(v0[0], v0[1]); o.y = cvt_pk_bf16(v0[2], v0[3]); o.z = cvt_pk_bf16(v1[0], v1[1]); o.w = cvt_pk_bf16(v1[2], v1[3]);
                    EPI_ST0(u32x4, rowp + bj * HALF, o); } }
    }
};
}
typedef GAS unsigned gu32;
#define RLX_AGENT __ATOMIC_RELAXED, __HIP_MEMORY_SCOPE_AGENT
#define LDS_WAIT() asm volatile("s_waitcnt lgkmcnt(0)" ::: "memory")
#define VM_WAIT() asm volatile("s_waitcnt vmcnt(0)" ::: "memory")
#define XB_TMO      128
#define XB_XCNT(j)  (256  + 64 * (j))
#define XB_XSUB(j)  (1280 + 64 * (j))
#define XB_XGEN(j)  (2304 + 64 * (j))
#define XB_TOP      3328
#define XB_TOPGEN   3392
#define XCD_BAR_WORDS 3456
#define XB_SPIN_CAP (1u << 18)

__device__ __forceinline__ unsigned xb_ld(unsigned* p)              { return __hip_atomic_load(p, __ATOMIC_RELAXED, __HIP_MEMORY_SCOPE_AGENT); }
__device__ __forceinline__ unsigned xb_add(unsigned* p, unsigned v) { return __hip_atomic_fetch_add(p, v, __ATOMIC_RELAXED, __HIP_MEMORY_SCOPE_AGENT); }
__device__ __forceinline__ unsigned xb_xcc_id() { return (unsigned)__builtin_amdgcn_s_getreg((3 << 11) | 20) & 0xFu; }
#define XB_SPIN(cond, bar) do { unsigned _sp = 0; while (cond) { __builtin_amdgcn_s_sleep(1); \
    if ((++_sp & 255u) == 0u) { if (xb_ld(&(bar)[XB_TMO])) break; if (_sp > XB_SPIN_CAP) { atomicAdd(&(bar)[XB_TMO], 1u); break; } } } } while (0)

struct XcdBarrier {
    unsigned* bar; unsigned x;
    volatile LAS unsigned* st;
};

__device__ __forceinline__ XcdBarrier xcd_barrier_post(unsigned* bar, volatile LAS unsigned* st) {
    XcdBarrier b; b.bar = bar; b.x = xb_xcc_id(); b.st = st;
    if (threadIdx.x == 0) (void)xb_add(&bar[XB_XCNT(b.x)], 1u);
    return b;
}
__device__ __forceinline__ void xcd_barrier_complete(unsigned* bar, unsigned x, unsigned& nloc, unsigned& nx) {
    const unsigned G = gridDim.x * gridDim.y * gridDim.z;
    unsigned sum, cnt, mine, sp = 0u;
    for (;;) {
        sum = 0u; cnt = 0u; mine = 0u;
#pragma unroll
        for (unsigned j = 0; j < 16; ++j) { const unsigned c = xb_ld(&bar[XB_XCNT(j)]); sum += c; cnt += (c > 0u) ? 1u : 0u; mine = (j == x) ? c : mine; }
        if (sum == G) break;
        __builtin_amdgcn_s_sleep(1);
        if ((++sp & 255u) == 0u) { if (xb_ld(&bar[XB_TMO])) break; if (sp > XB_SPIN_CAP) { atomicAdd(&bar[XB_TMO], 1u); break; } }
    }
    nloc = mine > 0u ? mine : 1u; nx = cnt > 0u ? cnt : 1u;
}

__device__ __forceinline__ void xcd_barrier(const XcdBarrier& b) {
    asm volatile("s_waitcnt vmcnt(0)" ::: "memory");
    __syncthreads();
    if (threadIdx.x == 0) {
        unsigned* bar = b.bar;
        __builtin_amdgcn_s_waitcnt(0);
        unsigned nloc = b.st[0], nx = b.st[1];
        if (nloc == 0u) { xcd_barrier_complete(bar, b.x, nloc, nx); b.st[0] = nloc; b.st[1] = nx; }
        const unsigned old = xb_add(&bar[XB_XSUB(b.x)], 1u);
        const unsigned gen = old / nloc;
        if (old + 1u == (gen + 1u) * nloc) {
            __builtin_amdgcn_fence(__ATOMIC_RELEASE, "agent");
            asm volatile("s_waitcnt vmcnt(0)" ::: "memory");
            const unsigned og = xb_add(&bar[XB_TOP], 1u);
            const unsigned tg = og / nx;
            if (og + 1u == (tg + 1u) * nx) xb_add(&bar[XB_TOPGEN], 1u);
            else XB_SPIN(xb_ld(&bar[XB_TOPGEN]) == tg, bar);
            __builtin_amdgcn_fence(__ATOMIC_ACQUIRE, "agent");
            xb_add(&bar[XB_XGEN(b.x)], 1u);
            asm volatile("s_waitcnt vmcnt(0)" ::: "memory");
        } else {
            XB_SPIN(xb_ld(&bar[XB_XGEN(b.x)]) == gen, bar);
            __builtin_amdgcn_fence(__ATOMIC_ACQUIRE, "agent");
            asm volatile("s_waitcnt vmcnt(0)" ::: "memory");
        }
    }
    __syncthreads();
}

constexpr int NWAVES = 8;
constexpr size_t MiB = 1u << 20, KiB = 1u << 10;
constexpr size_t WS_CTL = 0, CTL_ZERO_BYTES = 2 * MiB;
constexpr size_t WS_MOD = 1 * MiB;
constexpr size_t WS_WIN = 2 * MiB;
constexpr size_t WS_WBR = 12 * MiB + 512 * KiB, WS_WBA = 13 * MiB + 512 * KiB, WS_WOUT = 14 * MiB + 512 * KiB;
constexpr size_t WS_WUP = 16 * MiB + 512 * KiB, WS_AUP = WS_WUP + 64 * KiB, WS_GUP = WS_WUP + 128 * KiB;
constexpr size_t WS_WRH = 16 * MiB + 768 * KiB, WS_WRL = WS_WRH + 128 * KiB;
constexpr size_t WS_CB = 17 * MiB, WS_GAM2 = 17 * MiB + 64 * KiB;
constexpr size_t WS_PRW = 18 * MiB, WS_PATT = 130 * MiB, WS_PGATE = 226 * MiB;
constexpr size_t WS_WGU = 130 * MiB, WS_WD = 290 * MiB;
constexpr size_t WS_T = 18 * MiB;
constexpr size_t WS_HID = 18 * MiB, WS_DELTA = 226 * MiB, WS_H2 = 354 * MiB;
constexpr size_t WS_SLOTTOK = 98 * MiB, WS_SLOTW = 106 * MiB, WS_TOKLIST = 114 * MiB,
    WS_TOKPOS = WS_TOKLIST + 256 * KiB, WS_TOKW = WS_TOKLIST + 512 * KiB;
constexpr size_t WS_QE = 354 * MiB, WS_YLOC = 386 * MiB, WS_PC = 418 * MiB, WS_SLOC = 450 * MiB;
constexpr size_t WS_YB = 322 * MiB;
constexpr size_t WS_MODP = 18 * MiB;
constexpr size_t WS_WGU0 = 482 * MiB;
constexpr size_t WS_END = 512 * MiB;
constexpr size_t DO_H = 0, DO_G = 0, DO_SC = 32 * MiB, DO_YRA = 64 * MiB;
constexpr int NSLOT_MAX = 2 * NTOK + NLIST * 256;
constexpr int CW_TMO = 0, CW_BAR = 4096, CW_CNT = 16384, CW_MCNT = 8192;
constexpr int LDS_BYTES = 163840, RING_BYTES = 131072;
constexpr int LDSCTL_OFF = LDS_BYTES - 2048, MISC_OFF = LDSCTL_OFF;
constexpr int TOFF_OFF = LDSCTL_OFF + 256, LCNT_OFF = TOFF_OFF + 264, TILE_L_OFF = LCNT_OFF + 256;

#define LBAR() do { asm volatile("s_waitcnt lgkmcnt(0)" ::: "memory"); __builtin_amdgcn_s_barrier(); asm volatile("" ::: "memory"); } while (0)
struct Frame {
    LAS unsigned char* lds; volatile LAS unsigned* MISC; gu32* ctl;
    int tid, lane, wave, vcu, G;
};
__device__ __forceinline__ float wave_sum(float v) {
#pragma unroll
    for (int o = 1; o < 64; o <<= 1) v += __shfl_xor(v, o);
    return v;
}
__device__ __forceinline__ float dpp_f(float x, const int ctrl_sel) {
    const int xi = __builtin_bit_cast(int, x); int r;
    if (ctrl_sel == 0) r = __builtin_amdgcn_update_dpp(0, xi, 0xB1, 0xf, 0xf, true);
    else if (ctrl_sel == 1) r = __builtin_amdgcn_update_dpp(0, xi, 0x4E, 0xf, 0xf, true);
    else r = __builtin_amdgcn_update_dpp(0, xi, 0x141, 0xf, 0xf, true);
    return __builtin_bit_cast(float, r);
}
__device__ __forceinline__ float red8(float x) { x += dpp_f(x, 0); x += dpp_f(x, 1); x += dpp_f(x, 2); return x; }

__device__ __forceinline__ void phase_mod(Frame& F, const float* c, const float* w_ada, const float* b_ada, float* mod, unsigned char* ws) {
    const int gw = F.vcu * NWAVES + F.wave, NGW = F.G * NWAVES;
    for (int task = gw; task < 96 * 16; task += NGW) {
        const int nc = task % 96, ks = task / 96, n = nc * 64 + F.lane, k0 = ks * 64;
        float acc[16];
#pragma unroll
        for (int b = 0; b < 16; ++b) acc[b] = 0.f;
        LAS float* sl = (LAS float*)(F.lds) + F.wave * 1024;
#pragma unroll
        for (int j = 0; j < 16; ++j) { const float cv = c[(F.lane & 15) * DM + k0 + (F.lane >> 4) + 4 * j]; sl[((F.lane >> 4) + 4 * j) * 16 + (F.lane & 15)] = cv * sigmoidf_(cv); }
        LDS_WAIT(); asm volatile("" ::: "memory");
#pragma unroll 4
        for (int kk = 0; kk < 64; ++kk) { const float w = __builtin_nontemporal_load(w_ada + (size_t)(k0 + kk) * MODW + n);
            const f32x4 s0 = *(const LAS f32x4*)(sl + kk * 16), s1 = *(const LAS f32x4*)(sl + kk * 16 + 4), s2 = *(const LAS f32x4*)(sl + kk * 16 + 8), s3 = *(const LAS f32x4*)(sl + kk * 16 + 12);
            acc[0] += s0.x * w; acc[1] += s0.y * w; acc[2] += s0.z * w; acc[3] += s0.w * w; acc[4] += s1.x * w; acc[5] += s1.y * w; acc[6] += s1.z * w; acc[7] += s1.w * w;
            acc[8] += s2.x * w; acc[9] += s2.y * w; acc[10] += s2.z * w; acc[11] += s2.w * w; acc[12] += s3.x * w; acc[13] += s3.y * w; acc[14] += s3.z * w; acc[15] += s3.w * w; }
        LDS_WAIT(); asm volatile("" ::: "memory");
        float* part = (float*)(ws + WS_MODP);
        { const float bias = ks == 0 ? b_ada[n] : 0.f;
#pragma unroll
          for (int b = 0; b < 16; ++b) __hip_atomic_store(part + ((size_t)(ks * 16 + b) * MODW + n), acc[b] + bias, __ATOMIC_RELAXED, __HIP_MEMORY_SCOPE_AGENT); }
        asm volatile("s_waitcnt vmcnt(0)" ::: "memory");
        unsigned old = 0u; if (F.lane == 0) old = __hip_atomic_fetch_add((unsigned*)(F.ctl + CW_MCNT) + 16 * nc, 1u, __ATOMIC_RELAXED, __HIP_MEMORY_SCOPE_AGENT);
        old = (unsigned)__builtin_amdgcn_readfirstlane((int)old);
        if (old == 15u) {
            __builtin_amdgcn_fence(__ATOMIC_ACQUIRE, "agent");
#pragma unroll 1
            for (int b = 0; b < 16; ++b) { float sm = 0.f;
#pragma unroll
                for (int k2 = 0; k2 < 16; ++k2) sm += __hip_atomic_load(part + ((size_t)(k2 * 16 + b) * MODW + n), __ATOMIC_RELAXED, __HIP_MEMORY_SCOPE_AGENT);
                mod[(size_t)b * MODW + n] = sm; }
        }
    }
}

template <int MODE, bool NTS = false> __device__ __forceinline__ void transpose_item(const float* W, int K, int N, bf16_t* WT, int row_off, int item, int lane, int ldt = 0, int koff = 0) {
    if (ldt == 0) ldt = K;
    const int nblk = N / 32, kb = item / nblk, nb = item % nblk, k0 = 64 * kb + 8 * (lane >> 3), n0 = 32 * nb + 4 * (lane & 7);
    f32x4 v[8];
#pragma unroll
    for (int i = 0; i < 8; ++i) v[i] = __builtin_nontemporal_load((const f32x4*)(W + (size_t)(k0 + i) * N + n0));
#pragma unroll
    for (int j = 0; j < 4; ++j) { const int ng = n0 + j; const int nr = MODE == 0 ? row_off + ng : (MODE == 1 ? 8 * (ng >> 2) + (ng & 3) : 8 * (ng >> 2) + 4 + (ng & 3));
        u32x4 o; o.x = cvt_pk_bf16(v[0][j], v[1][j]); o.y = cvt_pk_bf16(v[2][j], v[3][j]); o.z = cvt_pk_bf16(v[4][j], v[5][j]); o.w = cvt_pk_bf16(v[6][j], v[7][j]);
        if (MODE == 0 && !NTS) *(GAS u32x4*)(WT + (size_t)nr * ldt + koff + k0) = o; else __builtin_nontemporal_store(o, (GAS u32x4*)(WT + (size_t)nr * ldt + koff + k0)); }
}

#ifndef P0_SHARE
#define P0_SHARE 4096
#endif
struct Args { const float* in[31]; float* out; unsigned char* ws; int ph_lo, ph_hi, scr; };
struct Ptrs { const float* in[31]; float* out; unsigned char* ws; };

__device__ __forceinline__ void phase_prep(Frame& F, const Ptrs& P) {
    const int gw = F.vcu * NWAVES + F.wave, NGW = F.G * NWAVES;
    const float* mod = (const float*)(P.ws + WS_MOD);
    bf16_t* Win_t = (bf16_t*)(P.ws + WS_WIN); bf16_t* Wbr_t = (bf16_t*)(P.ws + WS_WBR); bf16_t* Wba_t = (bf16_t*)(P.ws + WS_WBA); bf16_t* Wout_t = (bf16_t*)(P.ws + WS_WOUT);
    bf16_t* wup_t = (bf16_t*)(P.ws + WS_WUP); bf16_t* aup_t = (bf16_t*)(P.ws + WS_AUP); bf16_t* gup_t = (bf16_t*)(P.ws + WS_GUP);
    constexpr int I_IN = 16 * (INCOLS / 32), I_BR = 8 * 32, I_OUT = 16 * 32, I_UP = 16, I_GUP = 2 * 16;
    constexpr int NITEMS = I_IN + 2 * I_BR + I_OUT + 2 * I_UP + I_GUP;
    for (int it = gw; it < NITEMS; it += NGW) {
        int r = it;
        if (r < I_IN) { transpose_item<0>(P.in[5], DM, INCOLS, Win_t, 0, r, F.lane); continue; } r -= I_IN;
        if (r < I_BR) { transpose_item<0>(P.in[20], 512, DM, Wbr_t, 0, r, F.lane, DM, 0); continue; } r -= I_BR;
        if (r < I_BR) { transpose_item<0>(P.in[21], 512, DM, Wbr_t, 0, r, F.lane, DM, 512); continue; } r -= I_BR;
        if (r < I_OUT) { transpose_item<0>(P.in[22], DM, DM, Wout_t, 0, r, F.lane); continue; } r -= I_OUT;
        if (r < I_UP) { transpose_item<0>(P.in[8], 64, 512, wup_t, 0, r, F.lane); continue; } r -= I_UP;
        if (r < I_UP) { transpose_item<0>(P.in[10], 64, 512, aup_t, 0, r, F.lane); continue; } r -= I_UP;
        transpose_item<0>(P.in[11], 128, 512, gup_t, 0, r, F.lane);
    }
    { bf16_t* wrh = (bf16_t*)(P.ws + WS_WRH); bf16_t* wrl = (bf16_t*)(P.ws + WS_WRL);
      for (int idx = (F.vcu * NWAVES * 64 + F.tid); idx < 64 * DM; idx += F.G * NWAVES * 64) { const int o = idx / DM, k = idx % DM;
          const float w = o < 4 ? P.in[24][k * 4 + o] : (o < 36 ? P.in[26][k * 32 + (o - 4)] : 0.f);
          const unsigned hi = cvt_pk_bf16(w, 0.f) & 0xffffu; const float rem = w - __uint_as_float(hi << 16); const unsigned lo = cvt_pk_bf16(rem, 0.f) & 0xffffu;
          wrh[idx] = (bf16_t)hi; wrl[idx] = (bf16_t)lo; } }
    { float* gam2 = (float*)(P.ws + WS_GAM2);
      for (int idx = (F.vcu * NWAVES * 64 + F.tid); idx < NB * DM; idx += F.G * NWAVES * 64) { const int b = idx / DM, k = idx % DM; gam2[idx] = P.in[23][k] * (1.f + mod[(size_t)b * MODW + 4 * DM + k]); } }
    { float* cb = (float*)(P.ws + WS_CB);
      for (int t = gw; t < NB * 36; t += NGW) { const int b = t / 36, o = t % 36; float s = 0.f;
          for (int k = F.lane; k < DM; k += 64) { const float w = o < 4 ? P.in[24][k * 4 + o] : P.in[26][k * 32 + (o - 4)]; s += mod[(size_t)b * MODW + 3 * DM + k] * w; }
          s = wave_sum(s); if (F.lane == 0) cb[b * 64 + o] = s + (o < 4 ? P.in[25][o] : P.in[27][o - 4]); } }
    bf16_t* H = (bf16_t*)((unsigned char*)P.out + DO_H);
    for (int m0 = gw * 4; m0 < NTOK; m0 += NGW * 4) {
        f32x4 v[4][4];
#pragma unroll
        for (int r = 0; r < 4; ++r) { const GAS f32x4* xr = (const GAS f32x4*)(P.in[0] + (size_t)(m0 + r) * DM) + F.lane;
#pragma unroll
            for (int j = 0; j < 4; ++j) v[r][j] = __builtin_nontemporal_load(xr + 64 * j); }
        const int b = m0 / SEQ; const float* sh = mod + (size_t)b * MODW; const float* sc = sh + DM;
        f32x4 gs[4], hs[4];
#pragma unroll
        for (int j = 0; j < 4; ++j) { const int k = 4 * F.lane + 256 * j; const f32x4 g = *(const f32x4*)(P.in[4] + k), s1 = *(const f32x4*)(sc + k); gs[j] = g * (s1 + 1.f); hs[j] = *(const f32x4*)(sh + k); }
#pragma unroll
        for (int r = 0; r < 4; ++r) { float s = 0.f;
#pragma unroll
            for (int j = 0; j < 4; ++j) s += (v[r][j].x * v[r][j].x + v[r][j].y * v[r][j].y) + (v[r][j].z * v[r][j].z + v[r][j].w * v[r][j].w);
            const float rinv = 1.f / sqrtf(wave_sum(s) * (1.f / DM) + 1e-6f);
            GAS u32x2* o8 = (GAS u32x2*)(H + (size_t)(m0 + r) * DM) + F.lane;
#pragma unroll
            for (int j = 0; j < 4; ++j) { const f32x4 hv = v[r][j] * rinv * gs[j] + hs[j]; u32x2 w; w.x = cvt_pk_bf16(hv.x, hv.y); w.y = cvt_pk_bf16(hv.z, hv.w); o8[64 * j] = w; } }
    }
}
__device__ __forceinline__ void expert_convert(Frame& F, const Ptrs& P, int wv, int nwv, int it_lo, int it_hi) {
    constexpr int I_G = 16 * 16;
    for (int it = it_lo + wv; it < it_hi; it += nwv) {
        const int e = it / (2 * I_G), r = it % (2 * I_G);
        bf16_t* Wgu = (bf16_t*)(P.ws + (e < P0_SHARE / 512 ? WS_WGU0 : WS_WGU));
        if (r < I_G) transpose_item<1>(P.in[28] + (size_t)e * DM * DE, DM, DE, Wgu + (size_t)e * DM * DM, 0, r, F.lane);
        else transpose_item<2>(P.in[29] + (size_t)e * DM * DE, DM, DE, Wgu + (size_t)e * DM * DM, 0, r - I_G, F.lane);
    }
}
__device__ __forceinline__ void expert_convert_down(Frame& F, const Ptrs& P, int wv, int nwv) {
    bf16_t* Wd = (bf16_t*)(P.ws + WS_WD);
    for (int it = wv; it < NE * 256; it += nwv) { const int e = it >> 8, r = it & 255; transpose_item<0, true>(P.in[30] + (size_t)e * DE * DM, DE, DM, Wd + (size_t)e * DM * DE, 0, r, F.lane); }
}
namespace att {
constexpr int SLOT = 16384, NSL = 5, L_WS = NSL * SLOT, L_OST = L_WS + 8 * 256, L_BIAS = L_OST + 8 * 4096, L_END = L_BIAS + 1280;
__device__ __forceinline__ int crow(int r, int hi) { return (r & 3) + 8 * (r >> 2) + 4 * hi; }
__device__ __forceinline__ float max3f(float a, float b, float c) { return fmaxf(fmaxf(a, b), c); }
__device__ __forceinline__ s16x4 vtr(const LAS char* p) { return __builtin_bit_cast(s16x4, __builtin_amdgcn_ds_read_tr16_b64_v4i16((LAS s16x4*)p)); }

__device__ __forceinline__ void attn_unit(Frame& F, const Ptrs& P, int b, int h, int qb) {
    const int tid = F.tid, lane = F.lane, wid = F.wave, r32 = lane & 31, hi = lane >> 5;
    const bf16_t* Patt = (const bf16_t*)(P.ws + WS_PATT);
    bf16_t* Ya = (bf16_t*)((unsigned char*)P.out + DO_YRA) + 512;
    LAS char* lds = (LAS char*)F.lds;
    LAS float* wsf = (LAS float*)(lds + L_WS) + wid * 64;
    LAS float* biasL = (LAS float*)(lds + L_BIAS);
    const int cq = wid >> 1, ci = qb * 4 + cq, kc0 = qb * 4 - 8;
    const size_t rowbase = (size_t)b * SEQ;
    for (int i = tid; i < 257; i += 512) biasL[i] = P.in[19][h * 257 + i] * LOG2E;
    const int srow = tid >> 3, sc8 = tid & 7;
    f32x4 kg0 = *(const f32x4*)(P.in[18] + 8 * sc8), kg1 = *(const f32x4*)(P.in[18] + 8 * sc8 + 4);
    const int kdst = sc8 * 1024 + srow * 16, vdst = 8192 + (sc8 >> 2) * 4096 + (srow >> 4) * 1024 + (srow & 15) * 64 + (sc8 & 3) * 16;
    auto ld_k = [&](int j) -> u32x4 { return *(const u32x4*)(Patt + (rowbase + (size_t)(kc0 + j) * 64 + srow) * ACOLS + 512 + h * 64 + 8 * sc8); };
    auto ld_v = [&](int j) -> u32x4 { return *(const u32x4*)(Patt + (rowbase + (size_t)(kc0 + j) * 64 + srow) * ACOLS + 1024 + h * 64 + 8 * sc8); };
    auto st_kv = [&](int j, u32x4 kw, u32x4 vw) {
        float kf[8] = {bf_lo(kw.x), bf_hi(kw.x), bf_lo(kw.y), bf_hi(kw.y), bf_lo(kw.z), bf_hi(kw.z), bf_lo(kw.w), bf_hi(kw.w)};
        float ss = 0.f;
#pragma unroll
        for (int i = 0; i < 8; ++i) ss += kf[i] * kf[i];
        ss = red8(ss); const float rk = 1.f / sqrtf(ss * (1.f / 64.f) + 1e-6f);
        u32x4 o; o.x = cvt_pk_bf16(kf[0] * rk * kg0.x, kf[1] * rk * kg0.y); o.y = cvt_pk_bf16(kf[2] * rk * kg0.z, kf[3] * rk * kg0.w);
        o.z = cvt_pk_bf16(kf[4] * rk * kg1.x, kf[5] * rk * kg1.y); o.w = cvt_pk_bf16(kf[6] * rk * kg1.z, kf[7] * rk * kg1.w);
        LAS char* sl = lds + (j % NSL) * SLOT;
        *(LAS u32x4*)(sl + kdst) = o; *(LAS u32x4*)(sl + vdst) = vw; };
    { u32x4 kws[4], vws[4];
#pragma unroll
      for (int j = 0; j < 4; ++j) if (kc0 + j >= 0) { kws[j] = ld_k(j); vws[j] = ld_v(j); }
#pragma unroll
      for (int j = 0; j < 4; ++j) if (kc0 + j >= 0) st_kv(j, kws[j], vws[j]); }
    const size_t qrow = rowbase + (size_t)ci * 64 + (wid & 1) * 32 + r32;
    bf16x8 qr[4];
    { float qf[4][8]; float ss = 0.f;
#pragma unroll
      for (int d0 = 0; d0 < 4; ++d0) { const u32x4 w = *(const u32x4*)(Patt + qrow * ACOLS + h * 64 + d0 * 16 + hi * 8);
          qf[d0][0] = bf_lo(w.x); qf[d0][1] = bf_hi(w.x); qf[d0][2] = bf_lo(w.y); qf[d0][3] = bf_hi(w.y); qf[d0][4] = bf_lo(w.z); qf[d0][5] = bf_hi(w.z); qf[d0][6] = bf_lo(w.w); qf[d0][7] = bf_hi(w.w);
#pragma unroll
          for (int i = 0; i < 8; ++i) ss += qf[d0][i] * qf[d0][i]; }
      ss += __shfl_xor(ss, 32);
      const float rq = (0.125f * LOG2E) / sqrtf(ss * (1.f / 64.f) + 1e-6f);
#pragma unroll
      for (int d0 = 0; d0 < 4; ++d0) { const f32x4 g0 = *(const f32x4*)(P.in[17] + d0 * 16 + hi * 8), g1 = *(const f32x4*)(P.in[17] + d0 * 16 + hi * 8 + 4);
          u32x4 o; o.x = cvt_pk_bf16(qf[d0][0] * rq * g0.x, qf[d0][1] * rq * g0.y); o.y = cvt_pk_bf16(qf[d0][2] * rq * g0.z, qf[d0][3] * rq * g0.w);
          o.z = cvt_pk_bf16(qf[d0][4] * rq * g1.x, qf[d0][5] * rq * g1.y); o.w = cvt_pk_bf16(qf[d0][6] * rq * g1.z, qf[d0][7] * rq * g1.w);
          qr[d0] = __builtin_bit_cast(bf16x8, o); } }
    u32x4 kA, vA; if (kc0 + 4 >= 0) { kA = ld_k(4); vA = ld_v(4); }
    float mrun = 0.f, lrun = 0.f; f32x16 o0 = {}, o1 = {};
    const int qloc = (wid & 1) * 32 + r32;
    __syncthreads();
#pragma unroll 1
    for (int s = 0; s < 9; ++s) {
        const int jn = s + 4; const bool ld = (jn <= 11) && (kc0 + jn >= 0);
        const bool ldn = (jn + 1 <= 11) && (kc0 + jn + 1 >= 0); u32x4 kB, vB; if (ldn) { kB = ld_k(jn + 1); vB = ld_v(jn + 1); }
        const int j = cq + s;
        if (kc0 + j >= 0) {
            const LAS char* sl = lds + (j % NSL) * SLOT;
            f32x16 p0, p1;
            if (s <= 5) { const float c0 = biasL[0] - mrun;
#pragma unroll
                for (int r = 0; r < 16; ++r) { p0[r] = c0; p1[r] = c0; } }
            else { const int base = 64 * (s - 8) - qloc + 128;
#pragma unroll
                for (int r = 0; r < 16; ++r) { int i0 = base + crow(r, hi), i1 = i0 + 32; i0 = i0 < 0 ? 0 : (i0 > 256 ? 256 : i0); i1 = i1 < 0 ? 0 : (i1 > 256 ? 256 : i1); p0[r] = biasL[i0] - mrun; p1[r] = biasL[i1] - mrun; } }
            const LAS char* kb = sl + hi * 1024 + r32 * 16;
#pragma unroll
            for (int d0 = 0; d0 < 4; ++d0) { const bf16x8 b0 = *(const LAS bf16x8*)(kb + d0 * 2048), b1 = *(const LAS bf16x8*)(kb + d0 * 2048 + 512);
                p0 = __builtin_amdgcn_mfma_f32_32x32x16_bf16(b0, qr[d0], p0, 0, 0, 0); p1 = __builtin_amdgcn_mfma_f32_32x32x16_bf16(b1, qr[d0], p1, 0, 0, 0); }
            float a = max3f(p0[0], p0[1], p1[0]), bm = max3f(p0[2], p0[3], p1[1]); a = max3f(a, p1[2], p1[3]);
#pragma unroll
            for (int r = 4; r < 16; r += 4) { a = max3f(a, p0[r], p0[r + 1]); bm = max3f(bm, p0[r + 2], p0[r + 3]); a = max3f(a, p1[r], p1[r + 1]); bm = max3f(bm, p1[r + 2], p1[r + 3]); }
            float rm = fmaxf(a, bm); rm = fmaxf(rm, __shfl_xor(rm, 32));
            if (__any(rm > 8.f)) {
                const float dl = fmaxf(rm, 0.f), f = __builtin_amdgcn_exp2f(-dl); mrun += dl; lrun *= f;
#pragma unroll
                for (int r = 0; r < 16; ++r) { p0[r] -= dl; p1[r] -= dl; }
                if (hi == 0) wsf[r32] = f;
                LDS_WAIT(); asm volatile("" ::: "memory");
#pragma unroll
                for (int r = 0; r < 16; ++r) { const float fr_ = wsf[crow(r, hi)]; o0[r] *= fr_; o1[r] *= fr_; }
            }
            float sacc = 0.f;
#pragma unroll
            for (int r = 0; r < 16; ++r) { p0[r] = __builtin_amdgcn_exp2f(p0[r]); p1[r] = __builtin_amdgcn_exp2f(p1[r]); sacc += p0[r] + p1[r]; }
            lrun += sacc;
            u32x4 pw0, pw1, pw2, pw3;
            pw0 = (u32x4){cvt_pk_bf16(p0[0], p0[1]), cvt_pk_bf16(p0[2], p0[3]), cvt_pk_bf16(p0[4], p0[5]), cvt_pk_bf16(p0[6], p0[7])};
            pw1 = (u32x4){cvt_pk_bf16(p0[8], p0[9]), cvt_pk_bf16(p0[10], p0[11]), cvt_pk_bf16(p0[12], p0[13]), cvt_pk_bf16(p0[14], p0[15])};
            pw2 = (u32x4){cvt_pk_bf16(p1[0], p1[1]), cvt_pk_bf16(p1[2], p1[3]), cvt_pk_bf16(p1[4], p1[5]), cvt_pk_bf16(p1[6], p1[7])};
            pw3 = (u32x4){cvt_pk_bf16(p1[8], p1[9]), cvt_pk_bf16(p1[10], p1[11]), cvt_pk_bf16(p1[12], p1[13]), cvt_pk_bf16(p1[14], p1[15])};
            const LAS char* vp = sl + 8192 + ((lane >> 4) & 1) * 32 + (lane & 3) * 8 + (4 * hi + ((lane & 15) >> 2)) * 64;
            const bf16x8 pa[4] = {__builtin_bit_cast(bf16x8, pw0), __builtin_bit_cast(bf16x8, pw1), __builtin_bit_cast(bf16x8, pw2), __builtin_bit_cast(bf16x8, pw3)};
#pragma unroll
            for (int ks = 0; ks < 4; ++ks) {
                const s16x4 l0 = vtr(vp + ks * 1024), h0 = vtr(vp + ks * 1024 + 512), l1 = vtr(vp + 4096 + ks * 1024), h1 = vtr(vp + 4096 + ks * 1024 + 512);
                const bf16x8 v0 = (bf16x8){l0[0], l0[1], l0[2], l0[3], h0[0], h0[1], h0[2], h0[3]}, v1 = (bf16x8){l1[0], l1[1], l1[2], l1[3], h1[0], h1[1], h1[2], h1[3]};
                o0 = __builtin_amdgcn_mfma_f32_32x32x16_bf16(pa[ks], v0, o0, 0, 0, 0); o1 = __builtin_amdgcn_mfma_f32_32x32x16_bf16(pa[ks], v1, o1, 0, 0, 0); }
        }
        if (ld) st_kv(jn, kA, vA);
        LBAR();
        kA = kB; vA = vB;
    }
    lrun += __shfl_xor(lrun, 32);
    if (hi == 0) wsf[32 + r32] = lrun;
    LDS_WAIT(); asm volatile("" ::: "memory");
    LAS bf16_t* stg = (LAS bf16_t*)(lds + L_OST) + wid * 2048;
#pragma unroll
    for (int r = 0; r < 16; ++r) { const int orow = crow(r, hi); const float rl = __builtin_amdgcn_rcpf(wsf[32 + orow]);
        stg[orow * 64 + r32] = (bf16_t)(cvt_pk_bf16(o0[r] * rl, 0.f) & 0xffffu); stg[orow * 64 + 32 + r32] = (bf16_t)(cvt_pk_bf16(o1[r] * rl, 0.f) & 0xffffu); }
    LDS_WAIT(); asm volatile("" ::: "memory");
    bf16_t* Ow = Ya + (rowbase + (size_t)ci * 64 + (wid & 1) * 32) * 1024 + h * 64;
#pragma unroll
    for (int i = 0; i < 4; ++i) { const int row = i * 8 + (lane >> 3), ch = lane & 7; const u32x4 v = *(const LAS u32x4*)(stg + row * 64 + ch * 8); *(u32x4*)(Ow + (size_t)row * 1024 + ch * 8) = v; }
    __syncthreads();
}
}

#ifndef TIME_PHASE
#define TIME_PHASE -1
#endif
#define PROF(k) do { if (TIME_PHASE >= 20 && blockIdx.x == 0 && F.tid == 0) { const unsigned now_ = (unsigned)__builtin_amdgcn_s_memrealtime(); F.MISC[16 + (k)] += now_ - F.MISC[15]; F.MISC[15] = now_; } } while (0)
namespace rc {
constexpr int LDB = 72, MB = 64 * LDB * 2;
constexpr int FLD = 68, FB = 64 * FLD * 4;
constexpr int L_AT = 0, L_BH = MB, L_BT = 2 * MB, L_KT = 3 * MB, L_RT = 4 * MB, L_KH = 5 * MB, L_V = 6 * MB;
constexpr int L_TWD = 0, L_AD = 9216, L_SGD = 18432;
constexpr int RB = 8 * MB;
constexpr int L_WL = RB, L_AL = RB + FB, L_GL = RB + 2 * FB, L_SEG = RB + 3 * FB;
constexpr int L_NQ0 = RB, L_NQ1 = RB + MB, L_NT0 = RB + 2 * MB, L_NT1 = RB + 3 * MB, L_TQ0 = RB + 4 * MB, L_TQ1 = RB + 5 * MB, L_NKT = RB + 6 * MB, L_NRB = RB + 7 * MB;
constexpr int L_GLD = RB + 8 * MB;
constexpr int L_W1T = L_NQ0, L_W2T = L_NT0, L_WY = L_AT, L_KC = L_BT;
constexpr int L_TAB = L_GLD + 256;
constexpr int T_MUL = 0, T_MUR = 256, T_PAR = 448, T_N = 832;
static_assert(L_SEG + 2048 <= L_GLD && L_TAB + T_N * 4 <= LDSCTL_OFF, "rwkv chunk LDS");

__device__ __forceinline__ void unpack8(const u32x4 w, float* f) { f[0] = bf_lo(w.x); f[1] = bf_hi(w.x); f[2] = bf_lo(w.y); f[3] = bf_hi(w.y); f[4] = bf_lo(w.z); f[5] = bf_hi(w.z); f[6] = bf_lo(w.w); f[7] = bf_hi(w.w); }
__device__ __forceinline__ f32x16 mm64(f32x16 acc, const LAS char* Arows, const LAS char* Bcols, int lane) {
    const int o = ((lane & 31) * LDB + 8 * (lane >> 5)) * 2;
#pragma unroll
    for (int ks = 0; ks < 4; ++ks) { const bf16x8 a = *(const LAS bf16x8*)(Arows + o + 32 * ks), b = *(const LAS bf16x8*)(Bcols + o + 32 * ks); acc = __builtin_amdgcn_mfma_f32_32x32x16_bf16(a, b, acc, 0, 0, 0); }
    return acc;
}
__device__ __forceinline__ s16x4 trrd(const LAS char* p) { return __builtin_bit_cast(s16x4, __builtin_amdgcn_ds_read_tr16_b64_v4i16((LAS s16x4*)p)); }
__device__ __forceinline__ int tr_off(int lane) { return ((8 * (lane >> 5) + ((lane & 15) >> 2)) * LDB + 16 * ((lane >> 4) & 1) + 4 * (lane & 3)) * 2; }
__device__ __forceinline__ bf16x8 frag_tr(const LAS char* Xb, int ks) {
    const s16x4 lo = trrd(Xb + (16 * ks) * LDB * 2), hi = trrd(Xb + (16 * ks + 4) * LDB * 2);
    return (bf16x8){lo[0], lo[1], lo[2], lo[3], hi[0], hi[1], hi[2], hi[3]};
}
__device__ __forceinline__ f32x16 mm64_btr(f32x16 acc, const LAS char* Arows, const LAS char* X, int nb, int lane) {
    const int o = ((lane & 31) * LDB + 8 * (lane >> 5)) * 2; const LAS char* xb = X + 64 * nb + tr_off(lane);
#pragma unroll
    for (int ks = 0; ks < 4; ++ks) { const bf16x8 a = *(const LAS bf16x8*)(Arows + o + 32 * ks), b = frag_tr(xb, ks); acc = __builtin_amdgcn_mfma_f32_32x32x16_bf16(a, b, acc, 0, 0, 0); }
    return acc;
}
__device__ __forceinline__ f32x16 mm64_atr(f32x16 acc, const LAS char* X, int mb, const LAS char* Bcols, int lane) {
    const int o = ((lane & 31) * LDB + 8 * (lane >> 5)) * 2; const LAS char* xb = X + 64 * mb + tr_off(lane);
#pragma unroll
    for (int ks = 0; ks < 4; ++ks) { const bf16x8 a = frag_tr(xb, ks), b = *(const LAS bf16x8*)(Bcols + o + 32 * ks); acc = __builtin_amdgcn_mfma_f32_32x32x16_bf16(a, b, acc, 0, 0, 0); }
    return acc;
}
__device__ __forceinline__ void store_T(const f32x16& d, LAS char* dst, int mb, int nb, int lane) {
    LAS char* p = dst + ((32 * nb + (lane & 31)) * LDB + 32 * mb + 4 * (lane >> 5)) * 2;
#pragma unroll
    for (int g = 0; g < 4; ++g) { u32x2 w; w.x = cvt_pk_bf16(d[4 * g], d[4 * g + 1]); w.y = cvt_pk_bf16(d[4 * g + 2], d[4 * g + 3]); *(LAS u32x2*)(p + 16 * g) = w; }
}
__device__ __forceinline__ void store_T_g(const f32x16& d, bf16_t* dst, int mb, int nb, int lane) {
    bf16_t* p = dst + (32 * nb + (lane & 31)) * 64 + 32 * mb + 4 * (lane >> 5);
#pragma unroll
    for (int g = 0; g < 4; ++g) { u32x2 w; w.x = cvt_pk_bf16(d[4 * g], d[4 * g + 1]); w.y = cvt_pk_bf16(d[4 * g + 2], d[4 * g + 3]); *(u32x2*)(p + 8 * g) = w; }
}
#define RC_M(r) (32 * mb + 8 * ((r) >> 2) + 4 * hi + ((r) & 3))

struct Raw { u32x4 lc[4], lp[4], rc[3], rp[3]; };
__device__ __forceinline__ void load_raw(Raw& R, const bf16_t* Prw, int u, int t, int cg) {
    const int b = u >> 8, h = (u >> 5) & 7, c = u & 31;
    const size_t row = (size_t)b * SEQ + 64 * c + t; const bool hasprev = (c > 0) || (t > 0);
    const bf16_t* pc = Prw + row * RCOLS; const bf16_t* pp = pc - RCOLS; const int lc0 = 1536 + 32 * cg, hd = h * 64 + 8 * cg;
#pragma unroll
    for (int q = 0; q < 4; ++q) { R.lc[q] = *(const u32x4*)(pc + lc0 + 8 * q); R.lp[q] = hasprev ? *(const u32x4*)(pp + lc0 + 8 * q) : (u32x4){0u, 0u, 0u, 0u}; }
#pragma unroll
    for (int w = 0; w < 3; ++w) { R.rc[w] = *(const u32x4*)(pc + w * 512 + hd); R.rp[w] = hasprev ? *(const u32x4*)(pp + w * 512 + hd) : (u32x4){0u, 0u, 0u, 0u}; }
}
__device__ __forceinline__ void chunk_phase(Frame& F, const Ptrs& P) {
  const bf16_t* Prw = (const bf16_t*)(P.ws + WS_PRW);
  int htab = -1; bf16x8 wA[4]; Raw raw;
  if (TIME_PHASE >= 20 && blockIdx.x == 0 && F.tid == 0) F.MISC[15] = (unsigned)__builtin_amdgcn_s_memrealtime();
  if ((int)blockIdx.x < NB * 8 * 32) load_raw(raw, Prw, (int)blockIdx.x, F.tid >> 3, F.tid & 7);
#pragma unroll 1
  for (int u_ = (int)blockIdx.x; u_ < NB * 8 * 32; u_ += F.G) {
    int tid = F.tid, wid = F.wave; asm volatile("" : "+v"(tid), "+s"(wid));
    const int b = u_ >> 8, h = (u_ >> 5) & 7, c = u_ & 31;
    const int lane = tid & 63, t = tid >> 3, cg = tid & 7, r32 = lane & 31, hi = lane >> 5;
    LAS char* lds = (LAS char*)F.lds;
    const size_t u = (size_t)((b * 8 + h) * 32 + c);
    bf16_t* gQe = (bf16_t*)(P.ws + WS_QE) + u * 4096; bf16_t* gYl = (bf16_t*)(P.ws + WS_YLOC) + u * 4096; bf16_t* gPc = (bf16_t*)(P.ws + WS_PC) + u * 4096; bf16_t* gSl = (bf16_t*)(P.ws + WS_SLOC) + u * 4096;
    bf16_t* gG = (bf16_t*)((unsigned char*)P.out + DO_G) + u * 4096; bf16_t* Yr = (bf16_t*)((unsigned char*)P.out + DO_YRA);
    const int hd = h * 64 + 8 * cg;
    const bool is_ad = (cg == 2 || cg == 3); const float alpha = cg < 2 ? 2.f : 1.f, gamma = cg < 2 ? -1.f : 0.f;
    LAS bf16_t* ldst = (LAS bf16_t*)(lds + (cg < 2 ? L_TWD : (cg < 4 ? L_AD : L_SGD))) + t * (cg < 4 ? 72 : 136) + 32 * (cg < 2 ? cg : (cg < 4 ? cg - 2 : cg - 4));
    const size_t row = (size_t)b * SEQ + 64 * c + t;
    LAS float* tab = (LAS float*)(lds + L_TAB);
    if (h != htab) {
        htab = h;
        for (int i = tid; i < T_N; i += 512) { float v;
            if (i < T_MUR) v = P.in[6][1536 + i]; else if (i < T_PAR) { const int w = (i - T_MUR) >> 6, d = (i - T_MUR) & 63; v = P.in[6][w * 512 + h * 64 + d]; }
            else { const int w = (i - T_PAR) >> 6, d = (i - T_PAR) & 63; const float* src = w == 0 ? P.in[7] : (w == 1 ? P.in[9] : (w == 2 ? P.in[12] : (w == 3 ? P.in[13] : (w == 4 ? P.in[14] : P.in[16])))); v = src[h * 64 + d]; }
            tab[i] = v; }
        const int jb = (wid >> 1) & 1;
        const bf16_t* wa = (const bf16_t*)(P.ws + (wid < 4 ? WS_WUP : WS_AUP)) + (size_t)(h * 64 + jb * 32 + r32) * 64 + 8 * hi;
#pragma unroll
        for (int ks = 0; ks < 4; ++ks) wA[ks] = *(const bf16x8*)(wa + 16 * ks);
        LBAR();
    }
    bf16x8 wG[8];
    { const bf16_t* wg = (const bf16_t*)(P.ws + WS_GUP) + (size_t)(h * 64 + ((wid >> 1) & 1) * 32 + r32) * 128 + 8 * hi;
#pragma unroll
      for (int ks = 0; ks < 8; ++ks) wG[ks] = *(const bf16x8*)(wg + 16 * ks); }
    float rv[8], kv[8], vv[8];
    { float cur[8], prv[8], mu[8];
#pragma unroll
      for (int q = 0; q < 4; ++q) {
          unpack8(raw.lc[q], cur); unpack8(raw.lp[q], prv);
          *(f32x4*)mu = *(const LAS f32x4*)(tab + T_MUL + 32 * cg + 8 * q); *(f32x4*)(mu + 4) = *(const LAS f32x4*)(tab + T_MUL + 32 * cg + 8 * q + 4);
          float o[8];
#pragma unroll
          for (int i = 0; i < 8; ++i) { const float xs = cur[i] + (prv[i] - cur[i]) * mu[i]; const float sg = sigmoidf_(alpha * xs); o[i] = is_ad ? xs : alpha * sg + gamma; }
          u32x4 w; w.x = cvt_pk_bf16(o[0], o[1]); w.y = cvt_pk_bf16(o[2], o[3]); w.z = cvt_pk_bf16(o[4], o[5]); w.w = cvt_pk_bf16(o[6], o[7]);
          *(LAS u32x4*)(ldst + 8 * q) = w; }
#pragma unroll
      for (int which = 0; which < 3; ++which) {
          unpack8(raw.rc[which], cur); unpack8(raw.rp[which], prv);
          *(f32x4*)mu = *(const LAS f32x4*)(tab + T_MUR + which * 64 + 8 * cg); *(f32x4*)(mu + 4) = *(const LAS f32x4*)(tab + T_MUR + which * 64 + 8 * cg + 4);
#pragma unroll
          for (int i = 0; i < 8; ++i) { const float xs = cur[i] + (prv[i] - cur[i]) * mu[i]; if (which == 0) rv[i] = xs; else if (which == 1) kv[i] = xs; else vv[i] = xs; } } }
    LBAR(); PROF(0);
    { const int ib = wid & 1, jb = (wid >> 1) & 1;
      auto wr4 = [&](const f32x16& acc, LAS float* Out) { LAS float* op = Out + (ib * 32 + r32) * FLD + jb * 32 + 4 * hi;
#pragma unroll
          for (int g = 0; g < 4; ++g) *(LAS f32x4*)(op + 8 * g) = (f32x4){acc[4 * g], acc[4 * g + 1], acc[4 * g + 2], acc[4 * g + 3]}; };
      { f32x16 acc = {}; const LAS bf16_t* qp = (const LAS bf16_t*)(lds + (wid < 4 ? L_TWD : L_AD)) + (ib * 32 + r32) * 72 + 8 * hi;
#pragma unroll
        for (int ks = 0; ks < 4; ++ks) acc = __builtin_amdgcn_mfma_f32_32x32x16_bf16(wA[ks], *(const LAS bf16x8*)(qp + 16 * ks), acc, 0, 0, 0);
        wr4(acc, (LAS float*)(lds + (wid < 4 ? L_WL : L_AL))); }
      if (wid < 4) { f32x16 acc = {}; const LAS bf16_t* qp = (const LAS bf16_t*)(lds + L_SGD) + (ib * 32 + r32) * 136 + 8 * hi;
#pragma unroll
        for (int ks = 0; ks < 8; ++ks) acc = __builtin_amdgcn_mfma_f32_32x32x16_bf16(wG[ks], *(const LAS bf16x8*)(qp + 16 * ks), acc, 0, 0, 0);
        wr4(acc, (LAS float*)(lds + L_GL)); } }
    LBAR(); PROF(1);
    float lam[8], av[8], bv[8], kp[8];
    const int o68 = t * FLD + 8 * cg;
    { float wl[8], al[8], gv[8];
      *(f32x4*)wl = *(LAS f32x4*)(lds + L_WL + 4 * o68); *(f32x4*)(wl + 4) = *(LAS f32x4*)(lds + L_WL + 4 * o68 + 16);
      *(f32x4*)al = *(LAS f32x4*)(lds + L_AL + 4 * o68); *(f32x4*)(al + 4) = *(LAS f32x4*)(lds + L_AL + 4 * o68 + 16);
      *(f32x4*)gv = *(LAS f32x4*)(lds + L_GL + 4 * o68); *(f32x4*)(gv + 4) = *(LAS f32x4*)(lds + L_GL + 4 * o68 + 16);
      float w0[8], a0[8], kk_[8], ka[8], rk[8], lb[8];
      { const LAS float* tp = tab + T_PAR + 8 * cg;
        *(f32x4*)w0 = *(const LAS f32x4*)(tp); *(f32x4*)(w0 + 4) = *(const LAS f32x4*)(tp + 4);
        *(f32x4*)a0 = *(const LAS f32x4*)(tp + 64); *(f32x4*)(a0 + 4) = *(const LAS f32x4*)(tp + 68);
        *(f32x4*)kk_ = *(const LAS f32x4*)(tp + 128); *(f32x4*)(kk_ + 4) = *(const LAS f32x4*)(tp + 132);
        *(f32x4*)ka = *(const LAS f32x4*)(tp + 192); *(f32x4*)(ka + 4) = *(const LAS f32x4*)(tp + 196);
        *(f32x4*)rk = *(const LAS f32x4*)(tp + 256); *(f32x4*)(rk + 4) = *(const LAS f32x4*)(tp + 260);
        *(f32x4*)lb = *(const LAS f32x4*)(tp + 320); *(f32x4*)(lb + 4) = *(const LAS f32x4*)(tp + 324); }
      float asg[8], kkv[8], c2[8]; float ss = 0.f, bon = 0.f;
#pragma unroll
      for (int i = 0; i < 8; ++i) { lam[i] = 0.60653065971f * sigmoidf_(w0[i] + wl[i]); asg[i] = sigmoidf_(a0[i] + al[i]);
          kkv[i] = kv[i] * kk_[i]; ss += kkv[i] * kkv[i]; kp[i] = kv[i] * (1.f + (asg[i] - 1.f) * ka[i]); bon += rv[i] * kp[i] * rk[i]; }
      ss = red8(ss); bon = red8(bon);
      const float inv = 1.f / fmaxf(sqrtf(ss), 1e-12f);
#pragma unroll
      for (int i = 0; i < 8; ++i) { const float kn = kkv[i] * inv; av[i] = -kn; bv[i] = kn * asg[i]; c2[i] = (lb[i] + bon * vv[i]) * gv[i]; }
      u32x4 w; w.x = cvt_pk_bf16(gv[0], gv[1]); w.y = cvt_pk_bf16(gv[2], gv[3]); w.z = cvt_pk_bf16(gv[4], gv[5]); w.w = cvt_pk_bf16(gv[6], gv[7]);
      *(u32x4*)(gG + t * 64 + 8 * cg) = w;
      w.x = cvt_pk_bf16(c2[0], c2[1]); w.y = cvt_pk_bf16(c2[2], c2[3]); w.z = cvt_pk_bf16(c2[4], c2[5]); w.w = cvt_pk_bf16(c2[6], c2[7]);
      *(u32x4*)(Yr + row * 1024 + hd) = w; }
    float cum[8];
    { const int tl = lane >> 3;
#pragma unroll
      for (int i = 0; i < 8; ++i) { float x = lam[i];
          float y = __shfl_up(x, 8); x += (tl >= 1) ? y : 0.f; y = __shfl_up(x, 16); x += (tl >= 2) ? y : 0.f; y = __shfl_up(x, 32); x += (tl >= 4) ? y : 0.f;
          cum[i] = x; }
      if (tl == 7) { *(LAS f32x4*)(lds + L_SEG + (wid * 64 + 8 * cg) * 4) = *(f32x4*)cum; *(LAS f32x4*)(lds + L_SEG + (wid * 64 + 8 * cg) * 4 + 16) = *(f32x4*)(cum + 4); } }
    LBAR(); PROF(2);
    { float pre[8], tot[8];
#pragma unroll
      for (int i = 0; i < 8; ++i) { pre[i] = 0.f; tot[i] = 0.f; }
      const int myseg = t >> 3;
#pragma unroll
      for (int s = 0; s < 8; ++s) { float sv[8]; *(f32x4*)sv = *(LAS f32x4*)(lds + L_SEG + (s * 64 + 8 * cg) * 4); *(f32x4*)(sv + 4) = *(LAS f32x4*)(lds + L_SEG + (s * 64 + 8 * cg) * 4 + 16);
#pragma unroll
          for (int i = 0; i < 8; ++i) { tot[i] += sv[i]; pre[i] += (s < myseg) ? sv[i] : 0.f; } }
      float at_[8], bt_[8], kt_[8], rt_[8], bh_[8], kh_[8];
#pragma unroll
      for (int i = 0; i < 8; ++i) { const float cm = cum[i] + pre[i];
          const float gi = __builtin_amdgcn_exp2f(cm * LOG2E), g_ = __builtin_amdgcn_exp2f(-cm * LOG2E), gm1 = __builtin_amdgcn_exp2f(-(cm - lam[i]) * LOG2E), glg = __builtin_amdgcn_exp2f(-(tot[i] - cm) * LOG2E);
          at_[i] = av[i] * gm1; bt_[i] = bv[i] * gi; kt_[i] = kp[i] * gi; rt_[i] = rv[i] * g_; bh_[i] = bv[i] * glg; kh_[i] = kp[i] * glg; }
      if (t == 0) { float gl[8];
#pragma unroll
          for (int i = 0; i < 8; ++i) gl[i] = __builtin_amdgcn_exp2f(-tot[i] * LOG2E);
          *(LAS f32x4*)(lds + L_GLD + 32 * cg) = *(f32x4*)gl; *(LAS f32x4*)(lds + L_GLD + 32 * cg + 16) = *(f32x4*)(gl + 4); }
      const int ob = (t * LDB + 8 * cg) * 2; u32x4 w;
      w.x = cvt_pk_bf16(at_[0], at_[1]); w.y = cvt_pk_bf16(at_[2], at_[3]); w.z = cvt_pk_bf16(at_[4], at_[5]); w.w = cvt_pk_bf16(at_[6], at_[7]); *(LAS u32x4*)(lds + L_AT + ob) = w;
      w.x = cvt_pk_bf16(bt_[0], bt_[1]); w.y = cvt_pk_bf16(bt_[2], bt_[3]); w.z = cvt_pk_bf16(bt_[4], bt_[5]); w.w = cvt_pk_bf16(bt_[6], bt_[7]); *(LAS u32x4*)(lds + L_BT + ob) = w;
      w.x = cvt_pk_bf16(kt_[0], kt_[1]); w.y = cvt_pk_bf16(kt_[2], kt_[3]); w.z = cvt_pk_bf16(kt_[4], kt_[5]); w.w = cvt_pk_bf16(kt_[6], kt_[7]); *(LAS u32x4*)(lds + L_KT + ob) = w;
      w.x = cvt_pk_bf16(rt_[0], rt_[1]); w.y = cvt_pk_bf16(rt_[2], rt_[3]); w.z = cvt_pk_bf16(rt_[4], rt_[5]); w.w = cvt_pk_bf16(rt_[6], rt_[7]); *(LAS u32x4*)(lds + L_RT + ob) = w;
      w.x = cvt_pk_bf16(bh_[0], bh_[1]); w.y = cvt_pk_bf16(bh_[2], bh_[3]); w.z = cvt_pk_bf16(bh_[4], bh_[5]); w.w = cvt_pk_bf16(bh_[6], bh_[7]); *(LAS u32x4*)(lds + L_BH + ob) = w;
      w.x = cvt_pk_bf16(kh_[0], kh_[1]); w.y = cvt_pk_bf16(kh_[2], kh_[3]); w.z = cvt_pk_bf16(kh_[4], kh_[5]); w.w = cvt_pk_bf16(kh_[6], kh_[7]); *(LAS u32x4*)(lds + L_KH + ob) = w;
      w.x = cvt_pk_bf16(vv[0], vv[1]); w.y = cvt_pk_bf16(vv[2], vv[3]); w.z = cvt_pk_bf16(vv[4], vv[5]); w.w = cvt_pk_bf16(vv[6], vv[7]); *(LAS u32x4*)(lds + L_V + ob) = w; }
    LBAR(); PROF(4);
    load_raw(raw, Prw, (u_ + F.G < NB * 8 * 32) ? u_ + F.G : u_, t, cg);
    {
    wid = __builtin_amdgcn_readfirstlane(wid); asm volatile("" : "+v"(tid), "+s"(wid));
    const int lane = tid & 63, r32 = lane & 31, hi = lane >> 5;
    const int mb = wid & 1, nb = (wid >> 1) & 1, grp = wid >> 2;
    const int ao = 32 * mb * LDB * 2, bo = 32 * nb * LDB * 2;
    const int ncol = 32 * nb + r32;
    f32x16 accT = {};
    {
        f32x16 d = {};
        if (grp == 0) { d = mm64(d, lds + L_AT + ao, lds + L_KT + bo, lane);
#pragma unroll
            for (int r = 0; r < 16; ++r) d[r] = (ncol < RC_M(r)) ? d[r] : 0.f;
            store_T(d, lds + L_NKT, mb, nb, lane); }
        else { d = mm64(d, lds + L_BT + ao, lds + L_AT + bo, lane);
#pragma unroll
            for (int r = 0; r < 16; ++r) { d[r] = (RC_M(r) < ncol) ? d[r] : 0.f; accT[r] = d[r] + ((RC_M(r) == ncol) ? 1.f : 0.f); }
            store_T(d, lds + L_NQ0, mb, nb, lane); store_T(accT, lds + L_TQ0, mb, nb, lane); }
    }
    LBAR(); PROF(5);
#pragma unroll
    for (int j = 1; j <= 5; ++j) { const int cur = (j - 1) & 1, nw = j & 1;
        const int nq_c = cur ? L_NQ1 : L_NQ0, nq_n = nw ? L_NQ1 : L_NQ0;
        if (grp == 0) { f32x16 d = {}; d = mm64_atr(d, lds + nq_c, mb, lds + nq_c + bo, lane); store_T(d, lds + nq_n, mb, nb, lane); }
        else if (j == 1) { f32x16 e = {}; e = mm64(e, lds + L_BT + ao, lds + L_RT + bo, lane);
#pragma unroll
            for (int r = 0; r < 16; ++r) e[r] = (RC_M(r) <= ncol) ? e[r] : 0.f;
            store_T(e, lds + L_NRB, mb, nb, lane); }
        else { const int tq_r = nw ? L_TQ1 : L_TQ0, tq_w = cur ? L_TQ1 : L_TQ0;
            accT = mm64_atr(accT, lds + nq_c, mb, lds + tq_r + bo, lane); store_T(accT, lds + tq_w, mb, nb, lane); }
        LBAR();
    }
    if (grp == 1) { accT = mm64_atr(accT, lds + L_NQ1, mb, lds + L_TQ0 + bo, lane); store_T(accT, lds + L_TQ1, mb, nb, lane); }
    LBAR(); PROF(6);
    { f32x16 d = {};
      if (grp == 0) { d = mm64_btr(d, lds + L_TQ1 + ao, lds + L_AT, nb, lane); store_T(d, lds + L_W1T, mb, nb, lane); }
      else { d = mm64(d, lds + L_TQ1 + ao, lds + L_NKT + bo, lane); store_T(d, lds + L_W2T, mb, nb, lane); } }
    LBAR(); PROF(7);
    if (grp == 0) {
        f32x16 d = {}; d = mm64(d, lds + L_W1T + ao, lds + L_NRB + bo, lane);
#pragma unroll
        for (int g = 0; g < 4; ++g) { const u32x2 rw = *(const LAS u32x2*)(lds + L_RT + ((32 * nb + r32) * LDB + 32 * mb + 8 * g + 4 * hi) * 2);
            d[4 * g] += bf_lo(rw.x); d[4 * g + 1] += bf_hi(rw.x); d[4 * g + 2] += bf_lo(rw.y); d[4 * g + 3] += bf_hi(rw.y); }
        store_T_g(d, gQe, mb, nb, lane);
        f32x16 p = {}; p = mm64_btr(p, lds + L_W1T + ao, lds + L_BH, nb, lane);
        const float gl = ((const LAS float*)(lds + L_GLD))[ncol];
#pragma unroll
        for (int r = 0; r < 16; ++r) p[r] += (RC_M(r) == ncol) ? gl : 0.f;
        store_T_g(p, gPc, mb, nb, lane);
    } else {
        f32x16 d = {}; d = mm64(d, lds + L_KT + ao, lds + L_RT + bo, lane); d = mm64(d, lds + L_W2T + ao, lds + L_NRB + bo, lane);
#pragma unroll
        for (int r = 0; r < 16; ++r) d[r] = (RC_M(r) <= ncol) ? d[r] : 0.f;
        f32x16 k = {}; k = mm64_btr(k, lds + L_W2T + ao, lds + L_BH, nb, lane);
        { const LAS char* kb = lds + L_KH + 64 * nb + ((32 * mb + 4 * hi + ((lane & 15) >> 2)) * LDB + 16 * ((lane >> 4) & 1) + 4 * (lane & 3)) * 2;
#pragma unroll
          for (int g = 0; g < 4; ++g) { const s16x4 kw = trrd(kb + 8 * g * LDB * 2);
              k[4 * g] += bf_lo((unsigned)(unsigned short)kw[0]); k[4 * g + 1] += bf_lo((unsigned)(unsigned short)kw[1]); k[4 * g + 2] += bf_lo((unsigned)(unsigned short)kw[2]); k[4 * g + 3] += bf_lo((unsigned)(unsigned short)kw[3]); } }
        store_T(d, lds + L_WY, mb, nb, lane); store_T(k, lds + L_KC, mb, nb, lane);
    }
    LBAR(); PROF(8);
    { f32x16 d = {};
      if (grp == 0) { d = mm64_atr(d, lds + L_V, mb, lds + L_WY + bo, lane); store_T_g(d, gYl, mb, nb, lane); }
      else { d = mm64_btr(d, lds + L_KC + ao, lds + L_V, nb, lane); store_T_g(d, gSl, mb, nb, lane); } }
    LBAR(); PROF(9);
    }
  }
}

__device__ __forceinline__ void state_chain(Frame& F, const Ptrs& P, int bh) {
    const int tid = F.tid, lane = F.lane, wid = F.wave, r32 = lane & 31, hi = lane >> 5;
    LAS char* lds = (LAS char*)F.lds;
    const bf16_t* gPc = (const bf16_t*)(P.ws + WS_PC) + (size_t)bh * 32 * 4096; const bf16_t* gSl = (const bf16_t*)(P.ws + WS_SLOC) + (size_t)bh * 32 * 4096;
    bf16_t* gS = (bf16_t*)((unsigned char*)P.out + DO_SC) + (size_t)bh * 32 * 4096;
    constexpr int L_S0 = 0, L_S1 = MB, L_P = 2 * MB;
    for (int i = tid; i < MB / 4; i += 512) ((LAS unsigned*)(lds + L_S0))[i] = 0u;
    const int prow = tid >> 3, pch = tid & 7;
    const int mb = wid & 1, nb = (wid >> 1) & 1;
    u32x4 pw = *(const u32x4*)(gPc + prow * 64 + pch * 8), pw1 = *(const u32x4*)(gPc + 4096 + prow * 64 + pch * 8);
    const bf16_t* sp = gSl + (32 * nb + r32) * 64 + 32 * mb + 4 * hi;
    u32x2 sw[4];
#pragma unroll
    for (int g = 0; g < 4; ++g) sw[g] = wid < 4 ? *(const u32x2*)(sp + 8 * g) : (u32x2){0u, 0u};
    LBAR();
#pragma unroll 1
    for (int c = 0; c < 32; ++c) {
        const int sc = (c & 1) ? L_S1 : L_S0, sn = (c & 1) ? L_S0 : L_S1;
        *(LAS u32x4*)(lds + L_P + (prow * LDB + pch * 8) * 2) = pw;
        *(u32x4*)(gS + (size_t)c * 4096 + prow * 64 + pch * 8) = *(const LAS u32x4*)(lds + sc + (prow * LDB + pch * 8) * 2);
        pw = pw1; if (c + 2 < 32) pw1 = *(const u32x4*)(gPc + (size_t)(c + 2) * 4096 + prow * 64 + pch * 8);
        f32x16 d;
#pragma unroll
        for (int g = 0; g < 4; ++g) { const u32x2 w = sw[g]; d[4 * g] = bf_lo(w.x); d[4 * g + 1] = bf_hi(w.x); d[4 * g + 2] = bf_lo(w.y); d[4 * g + 3] = bf_hi(w.y); }
        if (wid < 4 && c + 1 < 32) {
#pragma unroll
            for (int g = 0; g < 4; ++g) sw[g] = *(const u32x2*)(sp + (size_t)(c + 1) * 4096 + 8 * g); }
        LBAR();
        if (wid < 4) { d = mm64(d, lds + L_P + 32 * mb * LDB * 2, lds + sc + 32 * nb * LDB * 2, lane); store_T(d, lds + sn, mb, nb, lane); }
        LBAR();
    }
}

__device__ __forceinline__ void out_unit(Frame& F, const Ptrs& P, int u, int nb, bool do_store = true) {
    const int lane = F.lane, r32 = lane & 31, hi = lane >> 5;
    const bf16_t* gQe = (const bf16_t*)(P.ws + WS_QE) + (size_t)u * 4096; const bf16_t* gYl = (const bf16_t*)(P.ws + WS_YLOC) + (size_t)u * 4096;
    const bf16_t* gS = (const bf16_t*)((unsigned char*)P.out + DO_SC) + (size_t)u * 4096; const bf16_t* gG = (const bf16_t*)((unsigned char*)P.out + DO_G) + (size_t)u * 4096;
    bf16_t* Yr = (bf16_t*)((unsigned char*)P.out + DO_YRA);
    const int bh = u >> 5, c = u & 31, h = bh & 7, b = bh >> 3;
    const int tl = 32 * nb + r32;
    const size_t row = (size_t)b * SEQ + 64 * c + tl;
    bf16_t* yo = Yr + row * 1024 + h * 64 + 4 * hi; const bf16_t* gg = gG + tl * 64 + 4 * hi; const float* lg = P.in[15] + h * 64 + 4 * hi; const bf16_t* yl = gYl + tl * 64 + 4 * hi;
    bf16x8 qf[4], sa[4], sb[4];
#pragma unroll
    for (int ks = 0; ks < 4; ++ks) { qf[ks] = *(const bf16x8*)(gQe + (32 * nb + r32) * 64 + 16 * ks + 8 * hi); sa[ks] = *(const bf16x8*)(gS + r32 * 64 + 16 * ks + 8 * hi); sb[ks] = *(const bf16x8*)(gS + (32 + r32) * 64 + 16 * ks + 8 * hi); }
    u32x2 ylw[2][4], gw[2][4], cw[2][4]; f32x4 l4[2][4];
#pragma unroll
    for (int eb = 0; eb < 2; ++eb)
#pragma unroll
        for (int g = 0; g < 4; ++g) { const int eo = 32 * eb + 8 * g; ylw[eb][g] = *(const u32x2*)(yl + eo); gw[eb][g] = *(const u32x2*)(gg + eo); cw[eb][g] = *(const u32x2*)(yo + eo); l4[eb][g] = *(const f32x4*)(lg + eo); }
    f32x16 y0 = {}, y1 = {};
#pragma unroll
    for (int ks = 0; ks < 4; ++ks) { y0 = __builtin_amdgcn_mfma_f32_32x32x16_bf16(sa[ks], qf[ks], y0, 0, 0, 0); y1 = __builtin_amdgcn_mfma_f32_32x32x16_bf16(sb[ks], qf[ks], y1, 0, 0, 0); }
    float s = 0.f;
#pragma unroll
    for (int g = 0; g < 4; ++g) { const u32x2 a = ylw[0][g], bq = ylw[1][g];
        y0[4 * g] += bf_lo(a.x); y0[4 * g + 1] += bf_hi(a.x); y0[4 * g + 2] += bf_lo(a.y); y0[4 * g + 3] += bf_hi(a.y);
        y1[4 * g] += bf_lo(bq.x); y1[4 * g + 1] += bf_hi(bq.x); y1[4 * g + 2] += bf_lo(bq.y); y1[4 * g + 3] += bf_hi(bq.y); }
#pragma unroll
    for (int r = 0; r < 16; ++r) s += y0[r] + y1[r];
    s += __shfl_xor(s, 32); const float mean = s * (1.f / 64.f); float q2 = 0.f;
#pragma unroll
    for (int r = 0; r < 16; ++r) { y0[r] -= mean; y1[r] -= mean; q2 += y0[r] * y0[r] + y1[r] * y1[r]; }
    q2 += __shfl_xor(q2, 32); const float rstd = 1.f / sqrtf(q2 * (1.f / 64.f) + 64e-5f);
#pragma unroll
    for (int g = 0; g < 4; ++g) {
#pragma unroll
        for (int eb = 0; eb < 2; ++eb) { const int eo = 32 * eb + 8 * g; const u32x2 g_ = gw[eb][g], c_ = cw[eb][g]; const f32x4 l_ = l4[eb][g];
            const f32x16& y = eb ? y1 : y0;
            const float o0 = y[4 * g] * rstd * l_.x * bf_lo(g_.x) + bf_lo(c_.x), o1 = y[4 * g + 1] * rstd * l_.y * bf_hi(g_.x) + bf_hi(c_.x), o2 = y[4 * g + 2] * rstd * l_.z * bf_lo(g_.y) + bf_lo(c_.y), o3 = y[4 * g + 3] * rstd * l_.w * bf_hi(g_.y) + bf_hi(c_.y);
            u32x2 w; w.x = cvt_pk_bf16(o0, o1); w.y = cvt_pk_bf16(o2, o3);
            if (do_store) *(u32x2*)(yo + eo) = w; } }
}
#undef RC_M
}
#ifndef RG
#define RG 4
#endif
__device__ __forceinline__ void phase_route(Frame& F, const Ptrs& P) {
    const int lane = F.lane, gw = F.vcu * NWAVES + F.wave, NGW = F.G * NWAVES;
    const float* x1 = P.in[0]; const bf16_t* Dl = (const bf16_t*)(P.ws + WS_DELTA); const float* mod = (const float*)(P.ws + WS_MOD);
    const float* gam2 = (const float*)(P.ws + WS_GAM2); const float* cb = (const float*)(P.ws + WS_CB);
    const bf16_t* wrh = (const bf16_t*)(P.ws + WS_WRH); const bf16_t* wrl = (const bf16_t*)(P.ws + WS_WRL);
    bf16_t* H2 = (bf16_t*)(P.ws + WS_H2);
    int* tok_list = (int*)(P.ws + WS_TOKLIST); int* tok_pos = (int*)(P.ws + WS_TOKPOS); int* slot_tok = (int*)(P.ws + WS_SLOTTOK); float* slot_w = (float*)(P.ws + WS_SLOTW);
    unsigned* cnt = (unsigned*)(F.ctl + CW_CNT);
    constexpr int WROW = 1040, L_WH = 0, L_WLO = 48 * WROW, L_GAM = 2 * 48 * WROW, L_SCR = L_GAM + 4096, L_CNT = L_SCR + 8 * 16 * 52 * 4;
    static_assert(L_CNT + 1024 <= LDSCTL_OFF, "route LDS");
    LAS char* lds = (LAS char*)F.lds;
    LAS float* scr = (LAS float*)(lds + L_SCR) + F.wave * (16 * 52);
    const int fr = lane & 15, kq = lane >> 4;
    LAS unsigned* lcnt = (LAS unsigned*)(lds + L_CNT); LAS unsigned* lbase = lcnt + 64;
    for (int rnd = F.vcu; rnd < NTOK / 128; rnd += F.G) {
        const int R0 = rnd * 128 + F.wave * 16, b = R0 / SEQ;
        const float* xr = x1 + (size_t)(R0 + fr) * DM + 8 * kq; const bf16_t* dr = Dl + (size_t)(R0 + fr) * DM + 8 * kq;
        f32x4 acc[3] = {{0.f, 0.f, 0.f, 0.f}, {0.f, 0.f, 0.f, 0.f}, {0.f, 0.f, 0.f, 0.f}}; float ssq = 0.f;
#pragma unroll 1
        for (int half = 0; half < 2; ++half) {
            __syncthreads();
            if (half == 0) { if (F.tid < NLIST) lcnt[F.tid] = 0u; for (int i = F.tid; i < DM / 4; i += 512) *(LAS f32x4*)(lds + L_GAM + 16 * i) = *(const f32x4*)(gam2 + (size_t)b * DM + 4 * i); }
            for (int i = F.tid; i < 48 * 64; i += 512) { const int row = i >> 6, ch = i & 63;
                *(LAS u32x4*)(lds + L_WH + row * WROW + ch * 16) = *(const u32x4*)(wrh + (size_t)row * DM + half * 512 + ch * 8);
                *(LAS u32x4*)(lds + L_WLO + row * WROW + ch * 16) = *(const u32x4*)(wrl + (size_t)row * DM + half * 512 + ch * 8); }
            __syncthreads();
            const LAS char* bh = lds + L_WH + fr * WROW + kq * 16; const LAS char* bl = lds + L_WLO + fr * WROW + kq * 16; const LAS char* gp = lds + L_GAM + (half * 512 + 8 * kq) * 4;
#pragma unroll 2
            for (int kk = 0; kk < 512; kk += 32) { const int k0 = half * 512 + kk;
                f32x4 xa = *(const f32x4*)(xr + k0), xb = *(const f32x4*)(xr + k0 + 4); const f32x4 ga = *(const LAS f32x4*)(gp + kk * 4), gb = *(const LAS f32x4*)(gp + kk * 4 + 16);
                { const u32x4 dw = *(const u32x4*)(dr + k0); xa.x += bf_lo(dw.x); xa.y += bf_hi(dw.x); xa.z += bf_lo(dw.y); xa.w += bf_hi(dw.y); xb.x += bf_lo(dw.z); xb.y += bf_hi(dw.z); xb.z += bf_lo(dw.w); xb.w += bf_hi(dw.w); }
                { u32x4 xw; xw.x = cvt_pk_bf16(xa.x, xa.y); xw.y = cvt_pk_bf16(xa.z, xa.w); xw.z = cvt_pk_bf16(xb.x, xb.y); xw.w = cvt_pk_bf16(xb.z, xb.w); *(u32x4*)(const_cast<bf16_t*>(dr) + k0) = xw; }
                ssq += (xa.x * xa.x + xa.y * xa.y) + (xa.z * xa.z + xa.w * xa.w) + (xb.x * xb.x + xb.y * xb.y) + (xb.z * xb.z + xb.w * xb.w);
                const f32x4 ya = xa * ga, yb = xb * gb;
                u32x4 hw; hw.x = cvt_pk_bf16(ya.x, ya.y); hw.y = cvt_pk_bf16(ya.z, ya.w); hw.z = cvt_pk_bf16(yb.x, yb.y); hw.w = cvt_pk_bf16(yb.z, yb.w);
                u32x4 lw; lw.x = cvt_pk_bf16(ya.x - bf_lo(hw.x), ya.y - bf_hi(hw.x)); lw.y = cvt_pk_bf16(ya.z - bf_lo(hw.y), ya.w - bf_hi(hw.y));
                lw.z = cvt_pk_bf16(yb.x - bf_lo(hw.z), yb.y - bf_hi(hw.z)); lw.w = cvt_pk_bf16(yb.z - bf_lo(hw.w), yb.w - bf_hi(hw.w));
                const bf16x8 ah = __builtin_bit_cast(bf16x8, hw), al = __builtin_bit_cast(bf16x8, lw);
#pragma unroll
                for (int nb = 0; nb < 3; ++nb) { const bf16x8 wh = *(const LAS bf16x8*)(bh + nb * 16 * WROW + kk * 2), wl = *(const LAS bf16x8*)(bl + nb * 16 * WROW + kk * 2);
                    acc[nb] = __builtin_amdgcn_mfma_f32_16x16x32_bf16(ah, wh, acc[nb], 0, 0, 0); acc[nb] = __builtin_amdgcn_mfma_f32_16x16x32_bf16(al, wh, acc[nb], 0, 0, 0); acc[nb] = __builtin_amdgcn_mfma_f32_16x16x32_bf16(ah, wl, acc[nb], 0, 0, 0); }
            }
        }
        ssq += __shfl_xor(ssq, 16); ssq += __shfl_xor(ssq, 32);
        const float rinv = 1.f / sqrtf(ssq * (1.f / DM) + 1e-6f);
#pragma unroll
        for (int nb = 0; nb < 3; ++nb)
#pragma unroll
            for (int j = 0; j < 4; ++j) scr[(4 * kq + j) * 52 + 16 * nb + fr] = acc[nb][j];
        LDS_WAIT(); asm volatile("" ::: "memory");
        int l1 = 0, l2 = 0, q1 = 0, q2 = 0; float w1 = 0.f, w2 = 0.f;
        if (lane < 16) {
            const float* cbb = cb + b * 64; const LAS float* lr = scr + lane * 52;
            float lc[4]; int grp = 0; float best = -3.4e38f;
#pragma unroll
            for (int o = 0; o < 4; ++o) { lc[o] = rinv * lr[o] + cbb[o]; if (lc[o] > best) { best = lc[o]; grp = o; } }
            float den = 0.f;
#pragma unroll
            for (int o = 0; o < 4; ++o) den += __expf(lc[o] - best);
            const float pgrp = 1.f / den;
            float f1 = -3.4e38f, f2 = -3.4e38f; int i1 = 0, i2 = 0;
            for (int o = 0; o < 8; ++o) { const float v = rinv * lr[4 + grp * 8 + o] + cbb[4 + grp * 8 + o];
                if (v > f1) { f2 = f1; i2 = i1; f1 = v; i1 = o; } else if (v > f2) { f2 = v; i2 = o; } }
            const float e2 = __expf(f2 - f1); w1 = pgrp / (1.f + e2); w2 = pgrp * e2 / (1.f + e2);
            l1 = (grp * 8 + i1) * 2; l2 = (grp * 8 + i2) * 2 + 1;
            q1 = (int)__hip_atomic_fetch_add(lcnt + l1, 1u, __ATOMIC_RELAXED, __HIP_MEMORY_SCOPE_WORKGROUP); q2 = (int)__hip_atomic_fetch_add(lcnt + l2, 1u, __ATOMIC_RELAXED, __HIP_MEMORY_SCOPE_WORKGROUP);
        }
        __syncthreads();
        if (F.tid < NLIST) { const unsigned c = ((LAS unsigned*)lcnt)[F.tid]; lbase[F.tid] = c ? atomicAdd(cnt + 64 * F.tid, c) : 0u; }
        __syncthreads();
        if (lane < 16) { const int tok = R0 + lane;
            const int p1 = (int)lbase[l1] + q1, p2 = (int)lbase[l2] + q2;
            tok_list[2 * tok] = l1; tok_list[2 * tok + 1] = l2; tok_pos[2 * tok] = p1; tok_pos[2 * tok + 1] = p2;
            slot_tok[(size_t)l1 * NTOK + p1] = tok; slot_tok[(size_t)l2 * NTOK + p2] = tok; slot_w[(size_t)l1 * NTOK + p1] = w1; slot_w[(size_t)l2 * NTOK + p2] = w2; }
        const float* sh = mod + (size_t)b * MODW + 3 * DM;
        f32x4 gq[4], sq[4];
#pragma unroll
        for (int j = 0; j < 4; ++j) { const int k = 4 * lane + 256 * j; gq[j] = *(const f32x4*)(gam2 + (size_t)b * DM + k); sq[j] = *(const f32x4*)(sh + k); }
#pragma unroll 1
        for (int r0 = 0; r0 < 16; r0 += RG) {
            u32x2 dq[RG][4];
#pragma unroll
            for (int rr = 0; rr < RG; ++rr) { const GAS u32x2* drow = (const GAS u32x2*)(Dl + (size_t)(R0 + r0 + rr) * DM) + lane;
#pragma unroll
                for (int j = 0; j < 4; ++j) dq[rr][j] = drow[64 * j]; }
#pragma unroll
            for (int rr = 0; rr < RG; ++rr) { const float ri = __shfl(rinv, r0 + rr);
                GAS u32x2* o8 = (GAS u32x2*)(H2 + (size_t)(R0 + r0 + rr) * DM) + lane;
#pragma unroll
                for (int j = 0; j < 4; ++j) { f32x4 xv; const u32x2 dw = dq[rr][j]; xv.x = bf_lo(dw.x); xv.y = bf_hi(dw.x); xv.z = bf_lo(dw.y); xv.w = bf_hi(dw.y);
                    const f32x4 hv = xv * ri * gq[j] + sq[j]; u32x2 w; w.x = cvt_pk_bf16(hv.x, hv.y); w.y = cvt_pk_bf16(hv.z, hv.w); o8[64 * j] = w; } }
        }
        LDS_WAIT(); asm volatile("" ::: "memory");
    }
}
__device__ __forceinline__ void moe_offsets(Frame& F) {
    LAS int* toff = (LAS int*)(F.lds + TOFF_OFF); LAS int* lcnt = (LAS int*)(F.lds + LCNT_OFF); LAS unsigned char* tile_l = (LAS unsigned char*)(F.lds + TILE_L_OFF);
    if (F.tid < NLIST) lcnt[F.tid] = (int)__hip_atomic_load(F.ctl + CW_CNT + 64 * F.tid, RLX_AGENT);
    __syncthreads();
    if (F.tid == 0) { int acc = 0;
#pragma unroll 1
        for (int l = 0; l < NLIST; ++l) { toff[l] = acc; acc += (lcnt[l] + 255) >> 8; } toff[NLIST] = acc; }
    __syncthreads();
    if (F.tid < NLIST) { for (int t = toff[F.tid]; t < toff[F.tid + 1]; ++t) tile_l[t] = (unsigned char)F.tid; }
    __syncthreads();
}
#ifndef MK_ONE_LAUNCH
#define MK_ONE_LAUNCH 1
#endif
constexpr int N_PHASES = 12;

__global__ void __launch_bounds__(NWAVES * 64, 2) fwd_kernel(Args args) {
    extern __shared__ __attribute__((aligned(16))) unsigned char lds_raw[];
    Frame F; F.lds = (LAS unsigned char*)lds_raw; F.MISC = (volatile LAS unsigned*)(F.lds + MISC_OFF);
    F.tid = threadIdx.x; F.lane = F.tid & 63; F.wave = __builtin_amdgcn_readfirstlane(F.tid >> 6);
    F.G = gridDim.x; { const int bx = blockIdx.x; F.vcu = (F.G % 8 == 0) ? (bx % 8) * (F.G / 8) + bx / 8 : bx; }
#ifndef DUP_PHASE
#define DUP_PHASE -1
#endif
#define RELOAD_ARGS() Ptrs P; { int z_ = 0; asm volatile("" : "+s"(z_)); _Pragma("unroll") for (int i_ = 0; i_ < 31; ++i_) P.in[i_] = args.in[i_] + z_; P.out = args.out + z_; P.ws = args.ws + z_; }
    F.ctl = (gu32*)(args.ws + WS_CTL);
    for (int u = F.tid; u < (LDS_BYTES - LDSCTL_OFF) / 4; u += NWAVES * 64) ((LAS unsigned*)(F.lds + LDSCTL_OFF))[u] = 0u;
    __syncthreads();
    XcdBarrier bar; bar.bar = (unsigned*)(F.ctl + CW_BAR); bar.x = 0; bar.st = nullptr;
#if MK_ONE_LAUNCH
    bar = xcd_barrier_post((unsigned*)(F.ctl + CW_BAR), F.MISC + 8);
#define GRID_BAR() xcd_barrier(bar)
#else
#define GRID_BAR() do { } while (0)
#endif
    const int lo = args.ph_lo, hi = args.ph_hi;
#ifndef PH_MASK
#define PH_MASK 0xfff
#endif
#define IN(k) ((((PH_MASK) >> (k)) & 1) && lo <= (k) && (k) < hi)
#ifndef TIME_PHASE
#define TIME_PHASE -1
#endif
#define STAMP(i) do { if (TIME_PHASE >= 0 && blockIdx.x == 0 && F.tid == 0) ((unsigned long long*)(args.ws + WS_CTL + 768 * KiB))[i] = __builtin_amdgcn_s_memrealtime(); } while (0)
#define SEAM(k) do { if (IN(k) && IN((k) + 1)) GRID_BAR(); STAMP((k) + 1); } while (0)
    STAMP(0);
#ifndef GPROF_PHASE
#define GPROF_PHASE -1
#endif
#define GFLUSH(ph) do { if (GPROF_ON && GPROF_PHASE == (ph) && blockIdx.x == 0 && F.tid == 0) { unsigned long long* tsp = (unsigned long long*)(args.ws + WS_CTL + 768 * KiB); unsigned long long a_ = 0; tsp[20] = 0; for (int k_ = 0; k_ < 10; ++k_) { a_ += F.MISC[16 + k_]; tsp[21 + k_] = a_; } } } while (0)
#define MODP ((float*)(P.ws + WS_MOD))
#define PGATE ((unsigned char*)(P.ws + WS_PGATE))

    if (IN(0)) for (int rep_ = 0; rep_ < ((0) == DUP_PHASE ? 2 : 1); ++rep_) { if (rep_) GRID_BAR(); RELOAD_ARGS(); phase_mod(F, P.in[1], P.in[2], P.in[3], MODP, P.ws); { const int gw_ = F.vcu * NWAVES + F.wave; if (gw_ >= 96 * 16) expert_convert(F, P, gw_ - 96 * 16, F.G * NWAVES - 96 * 16, 0, P0_SHARE); } } SEAM(0);
    if (IN(1)) for (int rep_ = 0; rep_ < ((1) == DUP_PHASE ? 2 : 1); ++rep_) { if (rep_) GRID_BAR(); RELOAD_ARGS(); phase_prep(F, P); } SEAM(1);
    if (IN(2)) for (int rep_ = 0; rep_ < ((2) == DUP_PHASE ? 2 : 1); ++rep_) { if (rep_) GRID_BAR(); RELOAD_ARGS();
        pg8::Gemm g{DM, DM, DM}; pg8::DenseOrder S; S.init((const bf16_t*)((unsigned char*)P.out + DO_H), (const bf16_t*)(P.ws + WS_WIN), DM, DM, NTOK, INCOLS, F.G, (int)blockIdx.x);
        pg8::EpiP E{(bf16_t*)(P.ws + WS_PRW), (bf16_t*)(P.ws + WS_PATT), PGATE};
        pg8::gemm_phase<pg8::EpiP, pg8::DenseOrder, true>(F.lds, g, S, E); GFLUSH(2);
        { const int nfull = (NTOK / 256) * (INCOLS / 256) % F.G; const int bx = (int)blockIdx.x; if (nfull > 0 && bx >= nfull) expert_convert_down(F, P, (bx - nfull) * NWAVES + F.wave, (F.G - nfull) * NWAVES); else if (nfull == 0) expert_convert_down(F, P, bx * NWAVES + F.wave, F.G * NWAVES); }
    } SEAM(2);
    if (IN(3)) for (int rep_ = 0; rep_ < ((3) == DUP_PHASE ? 2 : 1); ++rep_) { if (rep_) GRID_BAR(); RELOAD_ARGS();
#pragma unroll 1
        for (int r2 = 0; r2 < (DUP_PHASE == 31 ? 2 : 1); ++r2)
#pragma unroll 1
        for (int u = (int)blockIdx.x; u < NB * 8 * 8; u += F.G) att::attn_unit(F, P, u >> 6, (u >> 3) & 7, u & 7);
        __syncthreads();
#pragma unroll 1
        for (int r2 = 0; r2 < (DUP_PHASE == 30 ? 2 : 1); ++r2) rc::chunk_phase(F, P);
        if (TIME_PHASE >= 20 && GPROF_PHASE < 0 && blockIdx.x == 0 && F.tid == 0) { unsigned long long* tsp = (unsigned long long*)(args.ws + WS_CTL + 768 * KiB); unsigned long long a_ = 0; tsp[20] = 0; for (int k_ = 0; k_ < 10; ++k_) { a_ += F.MISC[16 + k_]; tsp[21 + k_] = a_; } }
    } SEAM(3);
    constexpr int EC_ITEMS = NE * 2 * 256, EC_SPLIT = EC_ITEMS;
    if (IN(4)) for (int rep_ = 0; rep_ < ((4) == DUP_PHASE ? 2 : 1); ++rep_) { if (rep_) GRID_BAR(); RELOAD_ARGS();
        const int nR = F.G >= 256 ? 128 : F.G / 2, bx = (int)blockIdx.x;
        if (bx < nR) { for (int u = bx; u < NB * 8; u += nR) rc::state_chain(F, P, u); }
        else { const int na = F.G - nR, a = bx - nR; expert_convert(F, P, a * NWAVES + F.wave, na * NWAVES, P0_SHARE, EC_SPLIT); }
    } SEAM(4);
    if (IN(5)) for (int rep_ = 0; rep_ < ((5) == DUP_PHASE ? 2 : 1); ++rep_) { if (rep_) GRID_BAR(); RELOAD_ARGS();
        const int gw = (int)blockIdx.x * NWAVES + F.wave, NGW = F.G * NWAVES;
        for (int w = gw; w < NB * 8 * 32 * 2; w += NGW) rc::out_unit(F, P, w >> 1, w & 1, !(DUP_PHASE == 5 && rep_ == 0));
        expert_convert(F, P, gw, NGW, EC_SPLIT, EC_ITEMS);
    } SEAM(5);
    if (IN(6)) for (int rep_ = 0; rep_ < ((6) == DUP_PHASE ? 2 : 1); ++rep_) { if (rep_) GRID_BAR(); RELOAD_ARGS();
        pg8::Gemm g{DM, DM, DM}; pg8::DenseOrder S; S.init((const bf16_t*)((unsigned char*)P.out + DO_YRA), (const bf16_t*)(P.ws + WS_WBR), DM, DM, NTOK, DM, F.G, (int)blockIdx.x);
        pg8::EpiMix E{(bf16_t*)(P.ws + WS_T), PGATE}; pg8::gemm_phase<pg8::EpiMix, pg8::DenseOrder, true>(F.lds, g, S, E);
    } SEAM(6);
    if (IN(7)) for (int rep_ = 0; rep_ < ((7) == DUP_PHASE ? 2 : 1); ++rep_) { if (rep_) GRID_BAR(); RELOAD_ARGS();
        pg8::Gemm g{DM, DM, DM}; pg8::DenseOrder S; S.init((const bf16_t*)(P.ws + WS_T), (const bf16_t*)(P.ws + WS_WOUT), DM, DM, NTOK, DM, F.G, (int)blockIdx.x);
        pg8::EpiDelta E{(bf16_t*)(P.ws + WS_DELTA), MODP}; E.scr = args.scr; pg8::gemm_phase<pg8::EpiDelta, pg8::DenseOrder, true>(F.lds, g, S, E); GFLUSH(7);
    } SEAM(7);
    if (IN(8)) for (int rep_ = 0; rep_ < ((8) == DUP_PHASE ? 2 : 1); ++rep_) { if (rep_) GRID_BAR(); RELOAD_ARGS(); phase_route(F, P); } SEAM(8);
    if (IN(9)) for (int rep_ = 0; rep_ < ((9) == DUP_PHASE ? 2 : 1); ++rep_) { if (rep_) GRID_BAR(); RELOAD_ARGS();
        moe_offsets(F); const LAS int* toff = (const LAS int*)(F.lds + TOFF_OFF);
        pg8::Gemm g{DM, DM, DM}; pg8::MoeOrderT<true> S{(const bf16_t*)(P.ws + WS_H2), (const bf16_t*)(P.ws + WS_WGU), DM, DM, (size_t)DM * DM, (const LAS unsigned char*)(F.lds + TILE_L_OFF), toff, (const LAS int*)(F.lds + LCNT_OFF), 0, toff[NLIST], F.G, (int)blockIdx.x, (const int*)(P.ws + WS_SLOTTOK), P0_SHARE / 512, (long long)WS_WGU0 - (long long)WS_WGU};
        pg8::EpiHid E{(bf16_t*)(P.ws + WS_HID)}; pg8::gemm_phase<pg8::EpiHid, pg8::MoeOrderT<true>, true>(F.lds, g, S, E); GFLUSH(9);
    } SEAM(9);
    if (IN(10)) for (int rep_ = 0; rep_ < ((10) == DUP_PHASE ? 2 : 1); ++rep_) { if (rep_) GRID_BAR(); RELOAD_ARGS();
        moe_offsets(F); const LAS int* toff = (const LAS int*)(F.lds + TOFF_OFF);
        pg8::Gemm g{DE, DE, DE}; pg8::MoeOrderT<false> S{(const bf16_t*)(P.ws + WS_HID), (const bf16_t*)(P.ws + WS_WD), DE, DE, (size_t)DM * DE, (const LAS unsigned char*)(F.lds + TILE_L_OFF), toff, (const LAS int*)(F.lds + LCNT_OFF), 0, toff[NLIST], F.G, (int)blockIdx.x, nullptr};
        pg8::EpiY E{(bf16_t*)(P.ws + WS_YB), (const float*)(P.ws + WS_SLOTW)}; pg8::gemm_phase<pg8::EpiY, pg8::MoeOrderT<false>, true>(F.lds, g, S, E); GFLUSH(10);
    } SEAM(10);
    if (IN(11)) for (int rep_ = 0; rep_ < ((11) == DUP_PHASE ? 2 : 1); ++rep_) { if (rep_) GRID_BAR(); RELOAD_ARGS();
        moe_offsets(F); const LAS int* toff = (const LAS int*)(F.lds + TOFF_OFF);
        const bf16_t* Yb = (const bf16_t*)(P.ws + WS_YB); const int* tok_list = (const int*)(P.ws + WS_TOKLIST); const int* tok_pos = (const int*)(P.ws + WS_TOKPOS);
        const float* mod = MODP; const int gw = F.vcu * NWAVES + F.wave, NGW = F.G * NWAVES;
#pragma unroll 4
        for (int tok = gw; tok < NTOK; tok += NGW) {
            const int s0 = toff[tok_list[2 * tok]] * 256 + tok_pos[2 * tok], s1 = toff[tok_list[2 * tok + 1]] * 256 + tok_pos[2 * tok + 1];
            const float* g2 = mod + (size_t)(tok / SEQ) * MODW + 5 * DM;
            GAS f32x4* xo = (GAS f32x4*)(P.out + (size_t)tok * DM) + F.lane; const GAS u32x2* dd = (const GAS u32x2*)((const bf16_t*)(P.ws + WS_DELTA) + (size_t)tok * DM) + F.lane;
            u32x2 xb[4];
#pragma unroll
            for (int j = 0; j < 4; ++j) xb[j] = __builtin_nontemporal_load(dd + 64 * j);
            const GAS u32x2* y0 = (const GAS u32x2*)(Yb + (size_t)s0 * DM) + F.lane; const GAS u32x2* y1 = (const GAS u32x2*)(Yb + (size_t)s1 * DM) + F.lane;
#pragma unroll
            for (int j = 0; j < 4; ++j) { f32x4 xv; const u32x2 dw = xb[j]; xv.x = bf_lo(dw.x); xv.y = bf_hi(dw.x); xv.z = bf_lo(dw.y); xv.w = bf_hi(dw.y); const u32x2 a = __builtin_nontemporal_load(y0 + 64 * j), bq = __builtin_nontemporal_load(y1 + 64 * j); const f32x4 gv = *(const f32x4*)(g2 + 4 * F.lane + 256 * j);
                f32x4 o; o.x = xv.x + gv.x * (bf_lo(a.x) + bf_lo(bq.x)); o.y = xv.y + gv.y * (bf_hi(a.x) + bf_hi(bq.x)); o.z = xv.z + gv.z * (bf_lo(a.y) + bf_lo(bq.y)); o.w = xv.w + gv.w * (bf_hi(a.y) + bf_hi(bq.y));
                __builtin_nontemporal_store(o, xo + 64 * j); }
        }
    }
#ifdef EXTRA_BARS
    for (int i_ = 0; i_ < EXTRA_BARS; ++i_) GRID_BAR();
#endif
#if TIME_PHASE >= 0
    {
#ifndef TIME_SCALE
#define TIME_SCALE 3.0e-4f
#endif
#ifndef TIME_HI
#define TIME_HI (TIME_PHASE + 1)
#endif
        STAMP(12); GRID_BAR();
        const unsigned long long* ts = (const unsigned long long*)(args.ws + WS_CTL + 768 * KiB);
        const float dlt = (float)(ts[TIME_HI] - ts[TIME_PHASE]) * (0.01f * TIME_SCALE);
        for (int i = blockIdx.x * 512 + F.tid; i < (1 << 20); i += gridDim.x * 512) args.out[i] += dlt;
    }
#endif
#undef IN
#undef SEAM
}

extern "C" void kernel_launch(void* const* d_in, const int* in_sizes, int n_in, void* d_out, int out_size, void* d_ws, size_t ws_size, hipStream_t stream) {
    static int grid = 0;
    if (grid == 0) {
        if (n_in != 31 || out_size != NTOK * DM || ws_size < WS_END) { fprintf(stderr, "kernel_launch: unexpected shapes (n_in %d out %d ws %zu)\n", n_in, out_size, ws_size); grid = -1; return; }
        int dev = 0, cus = 0;
        if (hipGetDevice(&dev) != hipSuccess || hipDeviceGetAttribute(&cus, hipDeviceAttributeMultiprocessorCount, dev) != hipSuccess) { grid = -1; return; }
        if (hipFuncSetAttribute((const void*)fwd_kernel, hipFuncAttributeMaxDynamicSharedMemorySize, LDS_BYTES) != hipSuccess) { fprintf(stderr, "kernel_launch: hipFuncSetAttribute failed\n"); grid = -1; return; }
        int per_cu = 0; (void)hipOccupancyMaxActiveBlocksPerMultiprocessor(&per_cu, (const void*)fwd_kernel, NWAVES * 64, LDS_BYTES); (void)hipGetLastError();
        grid = cus;
    }
    if (grid < 0) return;
    (void)hipMemsetAsync((char*)d_ws + WS_CTL, 0, CTL_ZERO_BYTES, stream);
    Args a{};
    for (int i = 0; i < 31; ++i) a.in[i] = (const float*)d_in[i];
    a.out = (float*)d_out; a.ws = (unsigned char*)d_ws;
#if MK_ONE_LAUNCH
    a.ph_lo = 0; a.ph_hi = N_PHASES;
    hipLaunchKernelGGL(fwd_kernel, dim3(grid), dim3(NWAVES * 64), LDS_BYTES, stream, a);
#else
    for (int p = 0; p < N_PHASES; ++p) {
#ifdef PROBE7
        if (p == 7) { a.ph_lo = 7; a.ph_hi = 8; a.scr = PROBE7 - 1; hipLaunchKernelGGL(fwd_kernel, dim3(grid), dim3(NWAVES * 64), LDS_BYTES, stream, a); a.scr = 0; }
#endif
        a.ph_lo = p; a.ph_hi = p + 1; hipLaunchKernelGGL(fwd_kernel, dim3(grid), dim3(NWAVES * 64), LDS_BYTES, stream, a); }
#endif
}
```

```cpp
#include <hip/hip_runtime.h>
#include <cstdio>
#include <cstdint>

#define LAS __attribute__((address_space(3)))
#define GAS __attribute__((address_space(1)))
typedef unsigned short bf16_t;
typedef short bf16x8 __attribute__((ext_vector_type(8)));
typedef short s16x4 __attribute__((ext_vector_type(4)));
typedef float f32x4 __attribute__((ext_vector_type(4)));
typedef float f32x2 __attribute__((ext_vector_type(2)));
typedef float f32x16 __attribute__((ext_vector_type(16)));
typedef unsigned u32x4 __attribute__((ext_vector_type(4)));
typedef unsigned u32x2 __attribute__((ext_vector_type(2)));

constexpr int NB = 16, SEQ = 2048, DM = 1024, NTOK = NB * SEQ;
constexpr int RCOLS = 1792, ACOLS = 1536, GCOLS = 2048, INCOLS = 5376;
constexpr int NE = 32, DE = 512, NLIST = 64;
constexpr int MODW = 6 * DM;
constexpr float LOG2E = 1.4426950408889634f;

typedef __bf16 bf16x2_t __attribute__((ext_vector_type(2)));
__device__ __forceinline__ unsigned cvt_pk_bf16(float lo, float hi) { const f32x2 v = {lo, hi}; const bf16x2_t b = __builtin_convertvector(v, bf16x2_t); return __builtin_bit_cast(unsigned, b); }
__device__ __forceinline__ float bf_lo(unsigned w) { return __uint_as_float(w << 16); }
__device__ __forceinline__ float bf_hi(unsigned w) { return __uint_as_float(w & 0xffff0000u); }
__device__ __forceinline__ float sigmoidf_(float x) { return __builtin_amdgcn_rcpf(1.0f + __builtin_amdgcn_exp2f(-x * LOG2E)); }

#ifndef GPROF_ON
#define GPROF_ON 0
#endif
#define GPROF(k) do { if (GPROF_ON && blockIdx.x == 0 && threadIdx.x == 0) { volatile LAS unsigned* M_ = (volatile LAS unsigned*)(lds + (163840 - 2048)); const unsigned now_ = (unsigned)__builtin_amdgcn_s_memrealtime(); M_[16 + (k)] += now_ - M_[15]; M_[15] = now_; } } while (0)
#define EPI_ST0(T_, p_, v_) (*(T_*)(p_) = v_)
#ifndef EPI_NT
#define EPI_NT 1
#endif
#if EPI_NT
#define EPI_ST(T_, p_, v_) __builtin_nontemporal_store(v_, (T_*)(p_))
#else
#define EPI_ST(T_, p_, v_) (*(T_*)(p_) = v_)
#endif
namespace pg8 {
constexpr int BM = 256, BK = 64, HALF = 128, HTB = HALF * BK * 2, STAGE_BYTES = 8 * HTB, NXCD = 8, WGM = 8;
__host__ __device__ __forceinline__ int lds_byte(int r, int c) { const int st = (r >> 4) * 2 + (c >> 5), rr = r & 15, cc = c & 31, ob = rr * 64 + cc * 2; return st * 1024 + (ob ^ (((ob >> 9) & 1) << 5)); }
__host__ __device__ __forceinline__ void stage_rc(int b, int& R, int& C) { const int st = b / 1024, sb = b % 1024, swz = sb ^ (((sb >> 9) & 1) << 5); R = (st >> 1) * 16 + swz / 64; C = (st & 1) * 32 + (swz % 64) / 2; }
__host__ __device__ __forceinline__ int perm32(int rho) { const int n = rho >> 4, i = rho & 15; return 8 * (i >> 2) + 4 * n + (i & 3); }

struct Unit { int pm, pn, e, sbase, nvalid, ch; };
struct Gemm { int lda, ldb, K; };

struct DenseOrder {
    static constexpr bool GATHER = false;
    __device__ __forceinline__ int row_tok(const Unit&, int) const { return 0; }
    const bf16_t* A; const bf16_t* Bt; int lda, ldb;
    int nM, nN, nwg, G, c;
    __device__ void init(const bf16_t* A_, const bf16_t* Bt_, int lda_, int ldb_, int M, int N, int G_, int c_) { A = A_; Bt = Bt_; lda = lda_; ldb = ldb_; nM = M / BM; nN = N / BM; nwg = nM * nN; G = G_; c = c_; }
    __device__ bool next(int i, Unit& u) const {
        const long L = (long)i * G + c; if (L >= nwg) return false;
        int wgid = (int)L; { const int q = nwg / NXCD, r = nwg % NXCD, xcd = wgid % NXCD, off = wgid / NXCD; wgid = (xcd < r ? xcd * (q + 1) : r * (q + 1) + (xcd - r) * q) + off; }
        const int nig = WGM * nN, gid = wgid / nig, fm = gid * WGM, gsz = (nM - fm) < WGM ? (nM - fm) : WGM;
        u.pm = fm + ((wgid % nig) % gsz); u.pn = (wgid % nig) / gsz; u.e = 0; u.sbase = 0; u.nvalid = BM; u.ch = 0; return true;
    }
    __device__ __forceinline__ const char* a_base(const Unit& u) const { return (const char*)A + (size_t)u.pm * BM * lda * 2; }
    __device__ __forceinline__ const char* b_base(const Unit& u) const { return (const char*)Bt + (size_t)u.pn * BM * ldb * 2; }
};
template <bool GATHER_> struct MoeOrderT {
    static constexpr bool GATHER = GATHER_;
    const bf16_t* A; const bf16_t* Bt; int lda, ldb; size_t bt_expert_stride;
    const LAS unsigned char* tile_l;
    const LAS int* toff; const LAS int* lcnt;
    int tlo, thi, G, c;
    const int* slot_tok; int lo_n = 0; long long lo_shift = 0; int mode = 0;
    __device__ __forceinline__ int row_tok(const Unit& u, int r) const { return r < u.nvalid ? slot_tok[u.sbase + r] : 0; }
    __device__ bool next(int i, Unit& u) const {
        const int nt = thi - tlo; int tile, pn, ch = 0;
        if (G % NXCD == 0) { const int x = c % NXCD, cin = c / NXCD, per = G / NXCD; const int t0 = (int)((long)nt * x / NXCD), t1 = (int)((long)nt * (x + 1) / NXCD);
            const int ux = (t1 - t0) * 4, full = (ux / per) * per; long j;
            if (mode == 2) { const long hj = (long)i * per + cin; if (hj >= 2l * (ux - full)) return false; j = full + (hj >> 1); ch = (int)(hj & 1); }
            else { j = (long)i * per + cin; if (j >= (mode == 1 ? full : ux)) return false; }
            tile = tlo + t0 + (int)(j >> 2); pn = (int)(j & 3); }
        else { if (mode == 2) return false; const long L = (long)i * G + c; if (L >= (long)nt * 4) return false; tile = tlo + (int)(L >> 2); pn = (int)(L & 3); }
        const int l = tile_l[tile], j = tile - toff[l]; u.pm = tile; u.pn = pn; u.e = l >> 1; u.sbase = l * NTOK + j * BM; u.nvalid = lcnt[l] - j * BM; u.ch = ch; return true;
    }
    __device__ __forceinline__ const char* a_base(const Unit& u) const { return GATHER ? (const char*)A : (const char*)A + (size_t)u.pm * BM * lda * 2; }
    __device__ __forceinline__ const char* b_base(const Unit& u) const { return (const char*)Bt + ((size_t)u.e * bt_expert_stride + (size_t)(u.pn * BM + u.ch * HALF) * ldb) * 2 + (u.e < lo_n ? lo_shift : 0ll); }
};

template <class Epi, class Sched, bool ALIGN_EPI, int NBJ = 2>
__device__ __forceinline__ void gemm_phase(LAS unsigned char* lds, const Gemm g, const Sched& S, const Epi& E) {
    const int tid = threadIdx.x, wid = __builtin_amdgcn_readfirstlane(tid >> 6), lane = tid & 63, wr = wid >> 2, wc = wid & 3, fr = lane & 15, fq = lane >> 4;
    const int K = g.K, nt = K / BK;
    unsigned voffA[2], voffB[2]; int RA[2], CA2[2];
#pragma unroll
    for (int i = 0; i < 2; ++i) { int R, C; stage_rc(tid * 16 + i * 8192, R, C); RA[i] = R; CA2[i] = C * 2; const int Rb = Epi::PERM ? ((R & ~31) + perm32(R & 31)) : R;
        voffA[i] = (unsigned)(R * g.lda + C) * 2u; voffB[i] = (unsigned)(Rb * g.ldb + C) * 2u; }
    const size_t kstep = (size_t)(BK * 2);
    const size_t hstepA = (size_t)HALF * g.lda * 2, hstepB = (size_t)HALF * g.ldb * 2;
    const unsigned ldsw = (unsigned)wid * 1024u;
    const int aoff = lds_byte(wr * 64 + fr, fq * 8), boff = lds_byte(wc * 32 + fr, fq * 8);
#define PG8_SA(b, h) (((b) * 2 + (h)) * HTB)
#define PG8_SB(b, h) ((4 + (b) * 2 + (h)) * HTB)
#define PG8_STAGE(bufoff, gbase, voff) do { _Pragma("unroll") for (int _i = 0; _i < 2; ++_i) \
        __builtin_amdgcn_global_load_lds((const unsigned*)((const char*)(gbase) + (voff)[_i]), (LAS unsigned*)(lds + (bufoff) + ldsw + _i * 8192), 16, 0, 0); } while (0)
#define PG8_STAGE_A(bufoff, kptr, half, nx) do { if constexpr (Sched::GATHER) { _Pragma("unroll") for (int _i = 0; _i < 2; ++_i) \
        __builtin_amdgcn_global_load_lds((const unsigned*)((const char*)(kptr) + ((nx) ? vnx[half][_i] : vcu[half][_i])), (LAS unsigned*)(lds + (bufoff) + ldsw + _i * 8192), 16, 0, 0); } \
    else { PG8_STAGE(bufoff, (const char*)(kptr) + ((half) ? hstepA : 0), voffA); } } while (0)
#define PG8_LDA(dst, b, h) do { _Pragma("unroll") for (int m = 0; m < 4; ++m) _Pragma("unroll") for (int k = 0; k < 2; ++k) dst[m][k] = *(const LAS bf16x8*)(lds + PG8_SA(b, h) + aoff + m * 2048 + k * 1024); } while (0)
#define PG8_LDB(dst, b, h) do { _Pragma("unroll") for (int n = 0; n < 2; ++n) _Pragma("unroll") for (int k = 0; k < 2; ++k) dst[n][k] = *(const LAS bf16x8*)(lds + PG8_SB(b, h) + boff + n * 2048 + k * 1024); } while (0)
#define PG8_MMA(ai, bj, At, Bt) do { __builtin_amdgcn_s_setprio(1); _Pragma("unroll") for (int m = 0; m < 4; ++m) _Pragma("unroll") for (int n = 0; n < 2; ++n) _Pragma("unroll") for (int k = 0; k < 2; ++k) \
        acc[ai][bj][m][n] = __builtin_amdgcn_mfma_f32_16x16x32_bf16(Bt[n][k], At[m][k], acc[ai][bj][m][n], 0, 0, 0); __builtin_amdgcn_s_setprio(0); } while (0)
#define PG8_WAIT_V(n) asm volatile("s_waitcnt vmcnt(" #n ")" ::: "memory")
#define PG8_STAGE_B1(bufoff, gbase, voff) do { if constexpr (NBJ == 2) PG8_STAGE(bufoff, gbase, voff); } while (0)
#define PG8_LDB1(dst, b, h) do { if constexpr (NBJ == 2) PG8_LDB(dst, b, h); } while (0)
#define PG8_MMA1(ai, bj, At, Bt) do { if constexpr (NBJ == 2) PG8_MMA(ai, bj, At, Bt); } while (0)
#define PG8_WAIT_VN do { if constexpr (NBJ == 2) PG8_WAIT_V(8); else PG8_WAIT_V(6); } while (0)
#define PG8_WAIT_L(n) asm volatile("s_waitcnt lgkmcnt(" #n ")" ::: "memory")
#define PG8_BAR __builtin_amdgcn_s_barrier()
#define PG8_SCHED __builtin_amdgcn_sched_barrier(0)
    Unit cur, nxt; int ui = 0;
    if (!S.next(0, cur)) return;
    f32x4 acc[2][2][4][2];
#pragma unroll
    for (int a = 0; a < 2; ++a)
#pragma unroll
        for (int b = 0; b < 2; ++b)
#pragma unroll
            for (int m = 0; m < 4; ++m)
#pragma unroll
                for (int n = 0; n < 2; ++n) acc[a][b][m][n] = (f32x4){0.f, 0.f, 0.f, 0.f};
    bf16x8 At[4][2], B0[2][2], B1[2][2];
    const char* cA = S.a_base(cur); const char* cB = S.b_base(cur);
    unsigned vcu[2][2], vnx[2][2];
    if constexpr (Sched::GATHER) {
#pragma unroll
        for (int hf = 0; hf < 2; ++hf)
#pragma unroll
            for (int i = 0; i < 2; ++i) { vcu[hf][i] = (unsigned)S.row_tok(cur, hf * HALF + RA[i]) * (unsigned)(g.lda * 2) + (unsigned)CA2[i]; vnx[hf][i] = vcu[hf][i]; } }
    if (GPROF_ON && blockIdx.x == 0 && threadIdx.x == 0) { volatile LAS unsigned* M_ = (volatile LAS unsigned*)(lds + (163840 - 2048)); for (int k_ = 0; k_ < 10; ++k_) M_[16 + k_] = 0; M_[15] = (unsigned)__builtin_amdgcn_s_memrealtime(); }
    PG8_STAGE(PG8_SB(0, 0), cB, voffB); PG8_STAGE_B1(PG8_SB(0, 1), cB + hstepB, voffB); PG8_STAGE_A(PG8_SA(0, 0), cA, 0, false); PG8_STAGE_A(PG8_SA(0, 1), cA, 1, false);
    if (wr == 1) PG8_BAR;
    PG8_WAIT_V(2); PG8_BAR;
    PG8_STAGE(PG8_SB(1, 0), cB + kstep, voffB); PG8_STAGE_A(PG8_SA(1, 0), cA + kstep, 0, false); PG8_STAGE_B1(PG8_SB(1, 1), cB + hstepB + kstep, voffB);
    if constexpr (NBJ == 2) PG8_WAIT_V(6); else PG8_WAIT_V(4);
    PG8_BAR;
    for (;;) {
        const bool has_next = S.next(ui + 1, nxt);
        const char* nA = has_next ? S.a_base(nxt) : cA; const char* nB = has_next ? S.b_base(nxt) : cB;
        if constexpr (Sched::GATHER) { if (has_next) {
#pragma unroll
            for (int hf = 0; hf < 2; ++hf)
#pragma unroll
                for (int i = 0; i < 2; ++i) vnx[hf][i] = (unsigned)S.row_tok(nxt, hf * HALF + RA[i]) * (unsigned)(g.lda * 2) + (unsigned)CA2[i]; } }
        for (int t = 0; t < nt; t += 2) {
            if constexpr (Epi::HAS_MID) { if (t == Epi::MID_T) E.mid(acc, cur, wr, wc, fr, fq); }
            const bool last = (t == nt - 2);
            const char* a1 = cA + (size_t)(t + 1) * kstep;
            const char* a2 = last ? nA : cA + (size_t)(t + 2) * kstep; const char* b2 = last ? nB : cB + (size_t)(t + 2) * kstep;
            const char* a3 = a2 + kstep; const char* b3 = b2 + kstep;
            PG8_LDB(B0, 0, 0); PG8_LDB1(B1, 0, 1); PG8_SCHED; PG8_LDA(At, 0, 0); PG8_STAGE_A(PG8_SA(1, 1), a1, 1, false);
            PG8_WAIT_VN; PG8_WAIT_L(0); PG8_BAR; PG8_MMA(0, 0, At, B0); PG8_MMA1(0, 1, At, B1); PG8_BAR; PG8_SCHED;
            PG8_LDA(At, 0, 1); PG8_STAGE(PG8_SB(0, 0), b2, voffB); PG8_STAGE_B1(PG8_SB(0, 1), b2 + hstepB, voffB); PG8_STAGE_A(PG8_SA(0, 0), a2, 0, last);
            PG8_WAIT_VN; PG8_WAIT_L(0); PG8_BAR; PG8_MMA(1, 0, At, B0); PG8_MMA1(1, 1, At, B1); PG8_BAR; PG8_SCHED;
            PG8_LDB(B0, 1, 0); PG8_LDB1(B1, 1, 1); PG8_SCHED; PG8_LDA(At, 1, 0); PG8_STAGE_A(PG8_SA(0, 1), a2, 1, last);
            PG8_WAIT_VN; PG8_WAIT_L(0); PG8_BAR; PG8_MMA(0, 0, At, B0); PG8_MMA1(0, 1, At, B1); PG8_BAR; PG8_SCHED;
            PG8_LDA(At, 1, 1); PG8_STAGE(PG8_SB(1, 0), b3, voffB); PG8_STAGE_B1(PG8_SB(1, 1), b3 + hstepB, voffB); PG8_STAGE_A(PG8_SA(1, 0), a3, 0, last);
            PG8_WAIT_VN; PG8_WAIT_L(0); PG8_BAR; PG8_MMA(1, 0, At, B0); PG8_MMA1(1, 1, At, B1); PG8_BAR; PG8_SCHED;
            if (GPROF_ON) { if (t == 0) GPROF(3); }
        }
        GPROF(0);
        if constexpr (ALIGN_EPI) { if (wr == 0) PG8_BAR; }
        GPROF(1);
        E(acc, cur, wr, wc, fr, fq);
        GPROF(2);
        if (!has_next) break;
#pragma unroll
        for (int a = 0; a < 2; ++a)
#pragma unroll
            for (int b = 0; b < 2; ++b)
#pragma unroll
                for (int m = 0; m < 4; ++m)
#pragma unroll
                    for (int n = 0; n < 2; ++n) acc[a][b][m][n] = (f32x4){0.f, 0.f, 0.f, 0.f};
        cur = nxt; cA = nA; cB = nB; ++ui;
        if constexpr (Sched::GATHER) {
#pragma unroll
            for (int hf = 0; hf < 2; ++hf)
#pragma unroll
                for (int i = 0; i < 2; ++i) vcu[hf][i] = vnx[hf][i]; }
        if constexpr (ALIGN_EPI) { if (wr == 1) PG8_BAR; }
    }
    PG8_WAIT_V(0);
    if constexpr (!ALIGN_EPI) { if (wr == 0) PG8_BAR; }
    PG8_BAR;
#undef PG8_SA
#undef PG8_SB
#undef PG8_STAGE
#undef PG8_STAGE_A
#undef PG8_LDA
#undef PG8_LDB
#undef PG8_MMA
#undef PG8_WAIT_V
#undef PG8_WAIT_VN
#undef PG8_STAGE_B1
#undef PG8_LDB1
#undef PG8_MMA1
#undef PG8_WAIT_L
#undef PG8_BAR
#undef PG8_SCHED
}

__device__ __forceinline__ unsigned q8(float x) { float s = sigmoidf_(x) * 255.f + 0.5f; s = s < 1.f ? 1.f : s; return (unsigned)s; }
struct EpiP {
    static constexpr bool PERM = true, HAS_MID = false;
    bf16_t *Prw, *Patt; unsigned char* Pgate; const float *qg, *kg; LAS float* xch;
    __device__ __forceinline__ void operator()(const f32x4 (&acc)[2][2][4][2], const Unit& u, int wr, int wc, int fr, int fq) const {
        const int row0 = u.pm * BM + wr * 64 + fr;
        if (u.pn >= 13) { const int col0 = (u.pn - 13) * BM + 2 * (wc * 32 + 8 * fq);
#pragma unroll
            for (int ai = 0; ai < 2; ++ai)
#pragma unroll
                for (int m = 0; m < 4; ++m) { unsigned char* rowp = Pgate + (size_t)(row0 + ai * HALF + m * 16) * GCOLS + col0; u32x2 w[2];
#pragma unroll
                    for (int bj = 0; bj < 2; ++bj) { const f32x4 v0 = acc[ai][bj][m][0], v1 = acc[ai][bj][m][1];
                        w[bj].x = q8(v0[0]) | (q8(v0[1]) << 8) | (q8(v0[2]) << 16) | (q8(v0[3]) << 24); w[bj].y = q8(v1[0]) | (q8(v1[1]) << 8) | (q8(v1[2]) << 16) | (q8(v1[3]) << 24); }
                    const u32x4 o = {w[0].x, w[0].y, w[1].x, w[1].y};
                    EPI_ST(u32x4, rowp, o); }
            return; }
        if (u.pn >= 7 && u.pn < 11) {
            const bool isq = u.pn < 9; const float* gw = (isq ? qg : kg) + 32 * (wc & 1) + 8 * fq; const float C = isq ? 0.125f * LOG2E : 1.f;
            const int col0 = (u.pn - 7) * BM + wc * 32 + 8 * fq;
            float ssq[2][4][2];
#pragma unroll
            for (int ai = 0; ai < 2; ++ai)
#pragma unroll
                for (int m = 0; m < 4; ++m)
#pragma unroll
                    for (int bj = 0; bj < 2; ++bj) { const f32x4 v0 = acc[ai][bj][m][0], v1 = acc[ai][bj][m][1];
                        float q = (v0[0] * v0[0] + v0[1] * v0[1]) + (v0[2] * v0[2] + v0[3] * v0[3]) + (v1[0] * v1[0] + v1[1] * v1[1]) + (v1[2] * v1[2] + v1[3] * v1[3]);
                        q += __shfl_xor(q, 16); q += __shfl_xor(q, 32); ssq[ai][m][bj] = q; }
            LAS float* xm = xch + (wr * 4 + wc) * 256 + fr; const LAS float* xp = xch + (wr * 4 + (wc ^ 1)) * 256 + fr;
            if (fq == 0) {
#pragma unroll
                for (int ai = 0; ai < 2; ++ai)
#pragma unroll
                    for (int m = 0; m < 4; ++m)
#pragma unroll
                        for (int bj = 0; bj < 2; ++bj) xm[(ai * 8 + m * 2 + bj) * 16] = ssq[ai][m][bj]; }
            asm volatile("s_waitcnt lgkmcnt(0)" ::: "memory"); __builtin_amdgcn_s_barrier(); asm volatile("" ::: "memory");
            const f32x4 g0 = *(const f32x4*)gw, g1 = *(const f32x4*)(gw + 4);
#pragma unroll
            for (int ai = 0; ai < 2; ++ai)
#pragma unroll
                for (int m = 0; m < 4; ++m) { bf16_t* rowp = Patt + (size_t)(row0 + ai * HALF + m * 16) * ACOLS + col0;
#pragma unroll
                    for (int bj = 0; bj < 2; ++bj) { const float r = C * __builtin_amdgcn_rsqf((ssq[ai][m][bj] + xp[(ai * 8 + m * 2 + bj) * 16]) * (1.f / 64.f) + 1e-6f);
                        const f32x4 v0 = acc[ai][bj][m][0] * g0 * r, v1 = acc[ai][bj][m][1] * g1 * r;
                        u32x4 w; w.x = cvt_pk_bf16(v0[0], v0[1]); w.y = cvt_pk_bf16(v0[2], v0[3]); w.z = cvt_pk_bf16(v1[0], v1[1]); w.w = cvt_pk_bf16(v1[2], v1[3]);
                        EPI_ST(u32x4, rowp + bj * HALF, w); } }
            return; }
        bf16_t* base; int ldc, colt;
        if (u.pn < 7) { base = Prw; ldc = RCOLS; colt = u.pn * BM; } else { base = Patt; ldc = ACOLS; colt = (u.pn - 7) * BM; }
        const int col0 = colt + wc * 32 + 8 * fq;
#pragma unroll
        for (int ai = 0; ai < 2; ++ai)
#pragma unroll
            for (int m = 0; m < 4; ++m) { bf16_t* rowp = base + (size_t)(row0 + ai * HALF + m * 16) * ldc + col0;
#pragma unroll
                for (int bj = 0; bj < 2; ++bj) { const f32x4 v0 = acc[ai][bj][m][0], v1 = acc[ai][bj][m][1];
                    u32x4 w; w.x = cvt_pk_bf16(v0[0], v0[1]); w.y = cvt_pk_bf16(v0[2], v0[3]); w.z = cvt_pk_bf16(v1[0], v1[1]); w.w = cvt_pk_bf16(v1[2], v1[3]);
                    EPI_ST(u32x4, rowp + bj * HALF, w); } }
    }
};
struct EpiMix {
    static constexpr bool PERM = true, HAS_MID = true; static constexpr int MID_T = 8;
    bf16_t* T; const unsigned char* Pgate;
    static __device__ __forceinline__ float ub(unsigned w, int i) { return (float)((w >> (8 * i)) & 0xffu); }
    __device__ __forceinline__ void mid(f32x4 (&acc)[2][2][4][2], const Unit& u, int wr, int wc, int fr, int fq) const {
        int row0 = u.pm * BM + wr * 64 + fr, col0 = u.pn * BM + wc * 32 + 8 * fq; asm volatile("" : "+v"(row0), "+v"(col0)); const int gc0 = u.pn * BM + 2 * (wc * 32 + 8 * fq);
#pragma unroll
        for (int ai = 0; ai < 2; ++ai) {
            u32x2 gr[4][2], ga[4][2];
#pragma unroll
            for (int m = 0; m < 4; ++m) { const unsigned char* gp = Pgate + (size_t)(row0 + ai * HALF + m * 16) * GCOLS + gc0;
                const u32x4 vr = *(const u32x4*)gp, va = *(const u32x4*)(gp + DM); gr[m][0] = (u32x2){vr.x, vr.y}; gr[m][1] = (u32x2){vr.z, vr.w}; ga[m][0] = (u32x2){va.x, va.y}; ga[m][1] = (u32x2){va.z, va.w}; }
#pragma unroll
            for (int m = 0; m < 4; ++m)
#pragma unroll
                for (int bj = 0; bj < 2; ++bj) { const u32x2 r = gr[m][bj], a = ga[m][bj]; f32x4& v0 = acc[ai][bj][m][0]; f32x4& v1 = acc[ai][bj][m][1];
#pragma unroll
                    for (int j = 0; j < 4; ++j) { v0[j] *= ub(r.x, j) * __builtin_amdgcn_rcpf(ub(a.x, j)); v1[j] *= ub(r.y, j) * __builtin_amdgcn_rcpf(ub(a.y, j)); } }
            asm volatile("" ::: "memory");
        }
    }
    __device__ __forceinline__ void operator()(const f32x4 (&acc)[2][2][4][2], const Unit& u, int wr, int wc, int fr, int fq) const {
        const int row0 = u.pm * BM + wr * 64 + fr, col0 = u.pn * BM + wc * 32 + 8 * fq, gc0 = u.pn * BM + 2 * (wc * 32 + 8 * fq);
        u32x2 ga[2][4][2];
#pragma unroll
        for (int ai = 0; ai < 2; ++ai)
#pragma unroll
            for (int m = 0; m < 4; ++m)
                { const u32x4 va = *(const u32x4*)(Pgate + (size_t)(row0 + ai * HALF + m * 16) * GCOLS + DM + gc0); ga[ai][m][0] = (u32x2){va.x, va.y}; ga[ai][m][1] = (u32x2){va.z, va.w}; }
#pragma unroll
        for (int ai = 0; ai < 2; ++ai)
#pragma unroll
            for (int m = 0; m < 4; ++m) { const size_t row = (size_t)(row0 + ai * HALF + m * 16);
#pragma unroll
                for (int bj = 0; bj < 2; ++bj) { const int col = col0 + bj * HALF; const u32x2 g = ga[ai][m][bj]; constexpr float s = 1.f / 255.f;
                    const f32x4 a0 = acc[ai][bj][m][0], a1 = acc[ai][bj][m][1];
                    u32x4 w; w.x = cvt_pk_bf16(a0[0] * ub(g.x, 0) * s, a0[1] * ub(g.x, 1) * s); w.y = cvt_pk_bf16(a0[2] * ub(g.x, 2) * s, a0[3] * ub(g.x, 3) * s);
                    w.z = cvt_pk_bf16(a1[0] * ub(g.y, 0) * s, a1[1] * ub(g.y, 1) * s); w.w = cvt_pk_bf16(a1[2] * ub(g.y, 2) * s, a1[3] * ub(g.y, 3) * s);
                    EPI_ST0(u32x4, T + row * DM + col, w); } }
    }
};
struct EpiDelta {
    static constexpr bool PERM = true, HAS_MID = false;
    bf16_t* D; const float* mod;
    __device__ __forceinline__ void operator()(const f32x4 (&acc)[2][2][4][2], const Unit& u, int wr, int wc, int fr, int fq) const {
        const int row0 = u.pm * BM + wr * 64 + fr, col0 = u.pn * BM + wc * 32 + 8 * fq;
        const int b = (u.pm * BM) / SEQ; const float* g1 = mod + (size_t)b * MODW + 2 * DM;
        f32x4 gv[2][2];
#pragma unroll
        for (int bj = 0; bj < 2; ++bj)
#pragma unroll
            for (int n = 0; n < 2; ++n) gv[bj][n] = *(const f32x4*)(g1 + col0 + bj * HALF + 4 * n);
#pragma unroll
        for (int ai = 0; ai < 2; ++ai)
#pragma unroll
            for (int m = 0; m < 4; ++m) { bf16_t* rowp = D + (size_t)(row0 + ai * HALF + m * 16) * DM + col0;
#pragma unroll
                for (int bj = 0; bj < 2; ++bj) { const f32x4 v0 = acc[ai][bj][m][0] * gv[bj][0], v1 = acc[ai][bj][m][1] * gv[bj][1];
                    u32x4 w; w.x = cvt_pk_bf16(v0[0], v0[1]); w.y = cvt_pk_bf16(v0[2], v0[3]); w.z = cvt_pk_bf16(v1[0], v1[1]); w.w = cvt_pk_bf16(v1[2], v1[3]);
                    EPI_ST0(u32x4, rowp + bj * HALF, w); } }
    }
};
template <int NBJ = 2> struct EpiHidT {
    static constexpr bool PERM = true, HAS_MID = false;
    bf16_t* hid;
    __device__ __forceinline__ void operator()(const f32x4 (&acc)[2][2][4][2], const Unit& u, int wr, int wc, int fr, int fq) const {
        const int row0 = u.pm * BM + wr * 64 + fr, hc0 = u.pn * 128 + u.ch * 64 + wc * 16 + 4 * fq;
        if constexpr (NBJ == 2) {
            const bool odd = fq & 1;
#pragma unroll
            for (int ai = 0; ai < 2; ++ai)
#pragma unroll
                for (int m = 0; m < 4; ++m) { bf16_t* rowp = hid + (size_t)(row0 + ai * HALF + m * 16) * DE + hc0; u32x2 w[2];
#pragma unroll
                    for (int bj = 0; bj < 2; ++bj) { const f32x4 gt = acc[ai][bj][m][0], up = acc[ai][bj][m][1]; float h[4];
#pragma unroll
                        for (int j = 0; j < 4; ++j) h[j] = gt[j] * sigmoidf_(gt[j]) * up[j];
                        w[bj].x = cvt_pk_bf16(h[0], h[1]); w[bj].y = cvt_pk_bf16(h[2], h[3]); }
                    const u32x2 snd = odd ? w[0] : w[1]; u32x2 rcv; rcv.x = (unsigned)__shfl_xor((int)snd.x, 16); rcv.y = (unsigned)__shfl_xor((int)snd.y, 16);
                    const u32x4 o = odd ? (u32x4){rcv.x, rcv.y, w[1].x, w[1].y} : (u32x4){w[0].x, w[0].y, rcv.x, rcv.y};
                    EPI_ST0(u32x4, odd ? rowp + 64 - 4 : rowp, o); }
        } else {
#pragma unroll
        for (int ai = 0; ai < 2; ++ai)
#pragma unroll
            for (int m = 0; m < 4; ++m) { bf16_t* rowp = hid + (size_t)(row0 + ai * HALF + m * 16) * DE + hc0;
#pragma unroll
                for (int bj = 0; bj < NBJ; ++bj) { const f32x4 gt = acc[ai][bj][m][0], up = acc[ai][bj][m][1]; float h[4];
#pragma unroll
                    for (int j = 0; j < 4; ++j) h[j] = gt[j] * sigmoidf_(gt[j]) * up[j];
                    u32x2 w; w.x = cvt_pk_bf16(h[0], h[1]); w.y = cvt_pk_bf16(h[2], h[3]); EPI_ST0(u32x2, rowp + bj * 64, w); } }
        }
    }
};
using EpiHid = EpiHidT<2>;
template <int NBJ = 2> struct EpiYT {
    static constexpr bool PERM = true, HAS_MID = false;
    bf16_t* Y; const float* slot_w;
    __device__ __forceinline__ void operator()(const f32x4 (&acc)[2][2][4][2], const Unit& u, int wr, int wc, int fr, int fq) const {
        const int row0 = u.pm * BM + wr * 64 + fr, col0 = u.pn * BM + u.ch * HALF + wc * 32 + 8 * fq;
        float w[2][4];
#pragma unroll
        for (int ai = 0; ai < 2; ++ai)
#pragma unroll
            for (int m = 0; m < 4; ++m) { const int r = wr * 64 + fr + ai * HALF + m * 16; w[ai][m] = r < u.nvalid ? slot_w[u.sbase + r] : 0.f; }
#pragma unroll
        for (int ai = 0; ai < 2; ++ai)
#pragma unroll
            for (int m = 0; m < 4; ++m) { bf16_t* rowp = Y + (size_t)(row0 + ai * HALF + m * 16) * DM + col0; const float ws = w[ai][m];
#pragma unroll
                for (int bj = 0; bj < NBJ; ++bj) { const f32x4 v0 = acc[ai][bj][m][0] * ws, v1 = acc[ai][bj][m][1] * ws;
                    u32x4 o; o.x = cvt_pk_bf16(v0[0], v0[1]); o.y = cvt_pk_bf16(v0[2], v0[3]); o.z = cvt_pk_bf16(v1[0], v1[1]); o.w = cvt_pk_bf16(v1[2], v1[3]);
                    EPI_ST0(u32x4, rowp + bj * HALF, o); } }
    }
};
using EpiY = EpiYT<2>;
}
typedef GAS unsigned gu32;
#define RLX_AGENT __ATOMIC_RELAXED, __HIP_MEMORY_SCOPE_AGENT
#define LDS_WAIT() asm volatile("s_waitcnt lgkmcnt(0)" ::: "memory")
#define VM_WAIT() asm volatile("s_waitcnt vmcnt(0)" ::: "memory")
#define XB_TMO      128
#define XB_XCNT(j)  (256  + 64 * (j))
#define XB_XSUB(j)  (1280 + 64 * (j))
#define XB_XGEN(j)  (2304 + 64 * (j))
#define XB_TOP      3328
#define XB_TOPGEN   3392
#define XCD_BAR_WORDS 3456
#define XB_SPIN_CAP (1u << 18)

__device__ __forceinline__ unsigned xb_ld(unsigned* p)              { return __hip_atomic_load(p, __ATOMIC_RELAXED, __HIP_MEMORY_SCOPE_AGENT); }
__device__ __forceinline__ unsigned xb_add(unsigned* p, unsigned v) { return __hip_atomic_fetch_add(p, v, __ATOMIC_RELAXED, __HIP_MEMORY_SCOPE_AGENT); }
__device__ __forceinline__ unsigned xb_xcc_id() { return (unsigned)__builtin_amdgcn_s_getreg((3 << 11) | 20) & 0xFu; }
#define XB_SPIN(cond, bar) do { unsigned _sp = 0; while (cond) { __builtin_amdgcn_s_sleep(1); \
    if ((++_sp & 255u) == 0u) { if (xb_ld(&(bar)[XB_TMO])) break; if (_sp > XB_SPIN_CAP) { atomicAdd(&(bar)[XB_TMO], 1u); break; } } } } while (0)

struct XcdBarrier {
    unsigned* bar; unsigned x;
    volatile LAS unsigned* st;
};

__device__ __forceinline__ XcdBarrier xcd_barrier_post(unsigned* bar, volatile LAS unsigned* st) {
    XcdBarrier b; b.bar = bar; b.x = xb_xcc_id(); b.st = st;
    if (threadIdx.x == 0) (void)xb_add(&bar[XB_XCNT(b.x)], 1u);
    return b;
}
__device__ __forceinline__ void xcd_barrier_complete(unsigned* bar, unsigned x, unsigned& nloc, unsigned& nx) {
    const unsigned G = gridDim.x * gridDim.y * gridDim.z;
    unsigned sum, cnt, mine, sp = 0u;
    for (;;) {
        sum = 0u; cnt = 0u; mine = 0u;
#pragma unroll
        for (unsigned j = 0; j < 16; ++j) { const unsigned c = xb_ld(&bar[XB_XCNT(j)]); sum += c; cnt += (c > 0u) ? 1u : 0u; mine = (j == x) ? c : mine; }
        if (sum == G) break;
        __builtin_amdgcn_s_sleep(1);
        if ((++sp & 255u) == 0u) { if (xb_ld(&bar[XB_TMO])) break; if (sp > XB_SPIN_CAP) { atomicAdd(&bar[XB_TMO], 1u); break; } }
    }
    nloc = mine > 0u ? mine : 1u; nx = cnt > 0u ? cnt : 1u;
}

__device__ __forceinline__ void xcd_barrier(const XcdBarrier& b) {
    asm volatile("s_waitcnt vmcnt(0)" ::: "memory");
    __syncthreads();
    if (threadIdx.x == 0) {
        unsigned* bar = b.bar;
        __builtin_amdgcn_s_waitcnt(0);
        unsigned nloc = b.st[0], nx = b.st[1];
        if (nloc == 0u) { xcd_barrier_complete(bar, b.x, nloc, nx); b.st[0] = nloc; b.st[1] = nx; }
        const unsigned old = xb_add(&bar[XB_XSUB(b.x)], 1u);
        const unsigned gen = old / nloc;
        if (old + 1u == (gen + 1u) * nloc) {
            __builtin_amdgcn_fence(__ATOMIC_RELEASE, "agent");
            asm volatile("s_waitcnt vmcnt(0)" ::: "memory");
            const unsigned og = xb_add(&bar[XB_TOP], 1u);
            const unsigned tg = og / nx;
            if (og + 1u == (tg + 1u) * nx) xb_add(&bar[XB_TOPGEN], 1u);
            else XB_SPIN(xb_ld(&bar[XB_TOPGEN]) == tg, bar);
            __builtin_amdgcn_fence(__ATOMIC_ACQUIRE, "agent");
            xb_add(&bar[XB_XGEN(b.x)], 1u);
            asm volatile("s_waitcnt vmcnt(0)" ::: "memory");
        } else {
            XB_SPIN(xb_ld(&bar[XB_XGEN(b.x)]) == gen, bar);
            __builtin_amdgcn_fence(__ATOMIC_ACQUIRE, "agent");
            asm volatile("s_waitcnt vmcnt(0)" ::: "memory");
        }
    }
    __syncthreads();
}

constexpr int NWAVES = 8;
constexpr size_t MiB = 1u << 20, KiB = 1u << 10;
constexpr size_t WS_CTL = 0, CTL_ZERO_BYTES = 128 * KiB;
constexpr size_t WS_MOD = 1 * MiB;
constexpr size_t WS_WIN = 2 * MiB;
constexpr size_t WS_WBR = 12 * MiB + 512 * KiB, WS_WBA = 13 * MiB + 512 * KiB, WS_WOUT = 14 * MiB + 512 * KiB;
constexpr size_t WS_WUP = 16 * MiB + 512 * KiB, WS_AUP = WS_WUP + 64 * KiB, WS_GUP = WS_WUP + 128 * KiB;
constexpr size_t WS_WRH = 16 * MiB + 768 * KiB, WS_WRL = WS_WRH + 128 * KiB;
constexpr size_t WS_CB = 17 * MiB, WS_GAM2 = 17 * MiB + 64 * KiB;
constexpr size_t WS_PRW = 18 * MiB, WS_PATT = 130 * MiB, WS_PGATE = 226 * MiB;
constexpr size_t WS_WGU = 130 * MiB, WS_WD = 290 * MiB;
constexpr size_t WS_T = 18 * MiB;
constexpr size_t WS_HID = 18 * MiB, WS_DELTA = 226 * MiB, WS_H2 = 354 * MiB;
constexpr size_t WS_SLOTTOK = 98 * MiB, WS_SLOTW = 106 * MiB, WS_TOKLIST = 114 * MiB,
    WS_TOKPOS = WS_TOKLIST + 256 * KiB, WS_TOKW = WS_TOKLIST + 512 * KiB;
constexpr size_t WS_QE = 354 * MiB, WS_YLOC = 386 * MiB, WS_PC = 418 * MiB, WS_SLOC = 450 * MiB;
constexpr size_t WS_YB = 322 * MiB;
constexpr size_t WS_MODP = 18 * MiB;
constexpr size_t WS_WGU0 = 482 * MiB;
constexpr size_t WS_END = 512 * MiB;
constexpr size_t DO_H = 0, DO_G = 0, DO_SC = 32 * MiB, DO_YRA = 64 * MiB;
constexpr int NSLOT_MAX = 2 * NTOK + NLIST * 256;
constexpr int CW_TMO = 0, CW_BAR = 4096, CW_CNT = 16384, CW_MCNT = 8192;
constexpr int LDS_BYTES = 163840, RING_BYTES = 131072;
constexpr int LDSCTL_OFF = LDS_BYTES - 2048, MISC_OFF = LDSCTL_OFF;
constexpr int TOFF_OFF = LDSCTL_OFF + 256, LCNT_OFF = TOFF_OFF + 264, TILE_L_OFF = LCNT_OFF + 256;

#define LBAR() do { asm volatile("s_waitcnt lgkmcnt(0)" ::: "memory"); __builtin_amdgcn_s_barrier(); asm volatile("" ::: "memory"); } while (0)
struct Frame {
    LAS unsigned char* lds; volatile LAS unsigned* MISC; gu32* ctl;
    int tid, lane, wave, vcu, G;
};
__device__ __forceinline__ float wave_sum(float v) {
#pragma unroll
    for (int o = 1; o < 64; o <<= 1) v += __shfl_xor(v, o);
    return v;
}
__device__ __forceinline__ float dpp_f(float x, const int ctrl_sel) {
    const int xi = __builtin_bit_cast(int, x); int r;
    if (ctrl_sel == 0) r = __builtin_amdgcn_update_dpp(0, xi, 0xB1, 0xf, 0xf, true);
    else if (ctrl_sel == 1) r = __builtin_amdgcn_update_dpp(0, xi, 0x4E, 0xf, 0xf, true);
    else r = __builtin_amdgcn_update_dpp(0, xi, 0x141, 0xf, 0xf, true);
    return __builtin_bit_cast(float, r);
}
__device__ __forceinline__ float red8(float x) { x += dpp_f(x, 0); x += dpp_f(x, 1); x += dpp_f(x, 2); return x; }

__device__ __forceinline__ void phase_mod(Frame& F, const float* c, const float* w_ada, const float* b_ada, float* mod, unsigned char* ws) {
    const int gw = F.vcu * NWAVES + F.wave, NGW = F.G * NWAVES;
    for (int task = gw; task < 96 * 16; task += NGW) {
        const int nc = task % 96, ks = task / 96, n = nc * 64 + F.lane, k0 = ks * 64;
        float acc[16];
#pragma unroll
        for (int b = 0; b < 16; ++b) acc[b] = 0.f;
        LAS float* sl = (LAS float*)(F.lds) + F.wave * 1024;
#pragma unroll
        for (int j = 0; j < 16; ++j) { const float cv = c[(F.lane & 15) * DM + k0 + (F.lane >> 4) + 4 * j]; sl[((F.lane >> 4) + 4 * j) * 16 + (F.lane & 15)] = cv * sigmoidf_(cv); }
        LDS_WAIT(); asm volatile("" ::: "memory");
#pragma unroll 4
        for (int kk = 0; kk < 64; ++kk) { const float w = __builtin_nontemporal_load(w_ada + (size_t)(k0 + kk) * MODW + n);
            const f32x4 s0 = *(const LAS f32x4*)(sl + kk * 16), s1 = *(const LAS f32x4*)(sl + kk * 16 + 4), s2 = *(const LAS f32x4*)(sl + kk * 16 + 8), s3 = *(const LAS f32x4*)(sl + kk * 16 + 12);
            acc[0] += s0.x * w; acc[1] += s0.y * w; acc[2] += s0.z * w; acc[3] += s0.w * w; acc[4] += s1.x * w; acc[5] += s1.y * w; acc[6] += s1.z * w; acc[7] += s1.w * w;
            acc[8] += s2.x * w; acc[9] += s2.y * w; acc[10] += s2.z * w; acc[11] += s2.w * w; acc[12] += s3.x * w; acc[13] += s3.y * w; acc[14] += s3.z * w; acc[15] += s3.w * w; }
        LDS_WAIT(); asm volatile("" ::: "memory");
        float* part = (float*)(ws + WS_MODP);
        { const float bias = ks == 0 ? b_ada[n] : 0.f;
#pragma unroll
          for (int b = 0; b < 16; ++b) __hip_atomic_store(part + ((size_t)(ks * 16 + b) * MODW + n), acc[b] + bias, __ATOMIC_RELAXED, __HIP_MEMORY_SCOPE_AGENT); }
        asm volatile("s_waitcnt vmcnt(0)" ::: "memory");
        unsigned old = 0u; if (F.lane == 0) old = __hip_atomic_fetch_add((unsigned*)(F.ctl + CW_MCNT) + 16 * nc, 1u, __ATOMIC_RELAXED, __HIP_MEMORY_SCOPE_AGENT);
        old = (unsigned)__builtin_amdgcn_readfirstlane((int)old);
        if (old == 15u) {
            __builtin_amdgcn_fence(__ATOMIC_ACQUIRE, "agent");
#pragma unroll 1
            for (int b = 0; b < 16; ++b) { float sm = 0.f;
#pragma unroll
                for (int k2 = 0; k2 < 16; ++k2) sm += __hip_atomic_load(part + ((size_t)(k2 * 16 + b) * MODW + n), __ATOMIC_RELAXED, __HIP_MEMORY_SCOPE_AGENT);
                mod[(size_t)b * MODW + n] = sm; }
        }
    }
}

template <int MODE, bool NTS = false> __device__ __forceinline__ void transpose_item(const float* W, int K, int N, bf16_t* WT, int row_off, int item, int lane, int ldt = 0, int koff = 0) {
    if (ldt == 0) ldt = K;
    const int nblk = N / 32, kb = item / nblk, nb = item % nblk, k0 = 64 * kb + 8 * (lane >> 3), n0 = 32 * nb + 4 * (lane & 7);
    f32x4 v[8];
#pragma unroll
    for (int i = 0; i < 8; ++i) v[i] = __builtin_nontemporal_load((const f32x4*)(W + (size_t)(k0 + i) * N + n0));
#pragma unroll
    for (int j = 0; j < 4; ++j) { const int ng = n0 + j; const int nr = MODE == 0 ? row_off + ng : (MODE == 1 ? 8 * (ng >> 2) + (ng & 3) : 8 * (ng >> 2) + 4 + (ng & 3));
        u32x4 o; o.x = cvt_pk_bf16(v[0][j], v[1][j]); o.y = cvt_pk_bf16(v[2][j], v[3][j]); o.z = cvt_pk_bf16(v[4][j], v[5][j]); o.w = cvt_pk_bf16(v[6][j], v[7][j]);
        if (MODE == 0 && !NTS) *(GAS u32x4*)(WT + (size_t)nr * ldt + koff + k0) = o; else __builtin_nontemporal_store(o, (GAS u32x4*)(WT + (size_t)nr * ldt + koff + k0)); }
}

#ifndef P0_SHARE
#define P0_SHARE 4096
#endif
struct Args { const float* in[31]; float* out; unsigned char* ws; int ph_lo, ph_hi; };
struct Ptrs { const float* in[31]; float* out; unsigned char* ws; };

__device__ __forceinline__ void phase_prep(Frame& F, const Ptrs& P) {
    const int gw = F.vcu * NWAVES + F.wave, NGW = F.G * NWAVES;
    const float* mod = (const float*)(P.ws + WS_MOD);
    bf16_t* Win_t = (bf16_t*)(P.ws + WS_WIN); bf16_t* Wbr_t = (bf16_t*)(P.ws + WS_WBR); bf16_t* Wba_t = (bf16_t*)(P.ws + WS_WBA); bf16_t* Wout_t = (bf16_t*)(P.ws + WS_WOUT);
    bf16_t* wup_t = (bf16_t*)(P.ws + WS_WUP); bf16_t* aup_t = (bf16_t*)(P.ws + WS_AUP); bf16_t* gup_t = (bf16_t*)(P.ws + WS_GUP);
    constexpr int I_IN = 16 * (INCOLS / 32), I_BR = 8 * 32, I_OUT = 16 * 32, I_UP = 16, I_GUP = 2 * 16;
    constexpr int NITEMS = I_IN + 2 * I_BR + I_OUT + 2 * I_UP + I_GUP;
    for (int it = gw; it < NITEMS; it += NGW) {
        int r = it;
        if (r < I_IN) { transpose_item<0>(P.in[5], DM, INCOLS, Win_t, 0, r, F.lane); continue; } r -= I_IN;
        if (r < I_BR) { transpose_item<0>(P.in[20], 512, DM, Wbr_t, 0, r, F.lane, DM, 0); continue; } r -= I_BR;
        if (r < I_BR) { transpose_item<0>(P.in[21], 512, DM, Wbr_t, 0, r, F.lane, DM, 512); continue; } r -= I_BR;
        if (r < I_OUT) { transpose_item<0>(P.in[22], DM, DM, Wout_t, 0, r, F.lane); continue; } r -= I_OUT;
        if (r < I_UP) { transpose_item<0>(P.in[8], 64, 512, wup_t, 0, r, F.lane); continue; } r -= I_UP;
        if (r < I_UP) { transpose_item<0>(P.in[10], 64, 512, aup_t, 0, r, F.lane); continue; } r -= I_UP;
        transpose_item<0>(P.in[11], 128, 512, gup_t, 0, r, F.lane);
    }
    { bf16_t* wrh = (bf16_t*)(P.ws + WS_WRH); bf16_t* wrl = (bf16_t*)(P.ws + WS_WRL);
      for (int idx = (F.vcu * NWAVES * 64 + F.tid); idx < 64 * DM; idx += F.G * NWAVES * 64) { const int o = idx / DM, k = idx % DM;
          const float w = o < 4 ? P.in[24][k * 4 + o] : (o < 36 ? P.in[26][k * 32 + (o - 4)] : 0.f);
          const unsigned hi = cvt_pk_bf16(w, 0.f) & 0xffffu; const float rem = w - __uint_as_float(hi << 16); const unsigned lo = cvt_pk_bf16(rem, 0.f) & 0xffffu;
          wrh[idx] = (bf16_t)hi; wrl[idx] = (bf16_t)lo; } }
    { float* gam2 = (float*)(P.ws + WS_GAM2);
      for (int idx = (F.vcu * NWAVES * 64 + F.tid); idx < NB * DM; idx += F.G * NWAVES * 64) { const int b = idx / DM, k = idx % DM; gam2[idx] = P.in[23][k] * (1.f + mod[(size_t)b * MODW + 4 * DM + k]); } }
    { float* cb = (float*)(P.ws + WS_CB);
      for (int t = gw; t < NB * 36; t += NGW) { const int b = t / 36, o = t % 36; float s = 0.f;
          for (int k = F.lane; k < DM; k += 64) { const float w = o < 4 ? P.in[24][k * 4 + o] : P.in[26][k * 32 + (o - 4)]; s += mod[(size_t)b * MODW + 3 * DM + k] * w; }
          s = wave_sum(s); if (F.lane == 0) cb[b * 64 + o] = s + (o < 4 ? P.in[25][o] : P.in[27][o - 4]); } }
    bf16_t* H = (bf16_t*)((unsigned char*)P.out + DO_H);
    for (int m0 = gw * 4; m0 < NTOK; m0 += NGW * 4) {
        f32x4 v[4][4];
#pragma unroll
        for (int r = 0; r < 4; ++r) { const GAS f32x4* xr = (const GAS f32x4*)(P.in[0] + (size_t)(m0 + r) * DM) + F.lane;
#pragma unroll
            for (int j = 0; j < 4; ++j) v[r][j] = __builtin_nontemporal_load(xr + 64 * j); }
        const int b = m0 / SEQ; const float* sh = mod + (size_t)b * MODW; const float* sc = sh + DM;
        f32x4 gs[4], hs[4];
#pragma unroll
        for (int j = 0; j < 4; ++j) { const int k = 4 * F.lane + 256 * j; const f32x4 g = *(const f32x4*)(P.in[4] + k), s1 = *(const f32x4*)(sc + k); gs[j] = g * (s1 + 1.f); hs[j] = *(const f32x4*)(sh + k); }
#pragma unroll
        for (int r = 0; r < 4; ++r) { float s = 0.f;
#pragma unroll
            for (int j = 0; j < 4; ++j) s += (v[r][j].x * v[r][j].x + v[r][j].y * v[r][j].y) + (v[r][j].z * v[r][j].z + v[r][j].w * v[r][j].w);
            const float rinv = 1.f / sqrtf(wave_sum(s) * (1.f / DM) + 1e-6f);
            u32x2 w[4];
#pragma unroll
            for (int j = 0; j < 4; ++j) { const f32x4 hv = v[r][j] * rinv * gs[j] + hs[j]; w[j].x = cvt_pk_bf16(hv.x, hv.y); w[j].y = cvt_pk_bf16(hv.z, hv.w); }
            const bool odd = F.lane & 1; bf16_t* hrow = H + (size_t)(m0 + r) * DM + 4 * (F.lane & ~1);
#pragma unroll
            for (int jj = 0; jj < 2; ++jj) { const u32x2 keep = odd ? w[2 * jj + 1] : w[2 * jj], snd = odd ? w[2 * jj] : w[2 * jj + 1];
                u32x2 rcv; rcv.x = (unsigned)__shfl_xor((int)snd.x, 1); rcv.y = (unsigned)__shfl_xor((int)snd.y, 1);
                const u32x4 o = odd ? (u32x4){rcv.x, rcv.y, keep.x, keep.y} : (u32x4){keep.x, keep.y, rcv.x, rcv.y};
                *(GAS u32x4*)(hrow + 256 * (2 * jj + (odd ? 1 : 0))) = o; } }
    }
}
__device__ __forceinline__ void expert_convert(Frame& F, const Ptrs& P, int wv, int nwv, int it_lo, int it_hi) {
    constexpr int I_G = 16 * 16;
    for (int it = it_lo + wv; it < it_hi; it += nwv) {
        const int e = it / (2 * I_G), r = it % (2 * I_G);
        bf16_t* Wgu = (bf16_t*)(P.ws + (e < P0_SHARE / 512 ? WS_WGU0 : WS_WGU));
        if (r < I_G) transpose_item<1>(P.in[28] + (size_t)e * DM * DE, DM, DE, Wgu + (size_t)e * DM * DM, 0, r, F.lane);
        else transpose_item<2>(P.in[29] + (size_t)e * DM * DE, DM, DE, Wgu + (size_t)e * DM * DM, 0, r - I_G, F.lane);
    }
}
__device__ __forceinline__ void expert_convert_down(Frame& F, const Ptrs& P, int wv, int nwv) {
    bf16_t* Wd = (bf16_t*)(P.ws + WS_WD);
    for (int it = wv; it < NE * 256; it += nwv) { const int e = it >> 8, r = it & 255; transpose_item<0, true>(P.in[30] + (size_t)e * DE * DM, DE, DM, Wd + (size_t)e * DM * DE, 0, r, F.lane); }
}
#ifndef ATTN_PROF
#define ATTN_PROF 0
#endif
#ifndef TIME_PHASE
#define TIME_PHASE -1
#endif
#define APROF(k) do { if (ATTN_PROF && TIME_PHASE >= 20 && blockIdx.x == 0 && F.tid == 0) { const unsigned now_ = (unsigned)__builtin_amdgcn_s_memrealtime(); F.MISC[16 + (k)] += now_ - F.MISC[15]; F.MISC[15] = now_; } } while (0)
namespace att {
constexpr int SLOT = 16384, NSL = 5, L_WS = NSL * SLOT, L_OST = L_WS + 8 * 256, L_BIAS = L_OST + 8 * 4096, L_END = L_BIAS + 1280;
__device__ __forceinline__ int crow(int r, int hi) { return (r & 3) + 8 * (r >> 2) + 4 * hi; }
__device__ __forceinline__ float max3f(float a, float b, float c) { return fmaxf(fmaxf(a, b), c); }
__device__ __forceinline__ s16x4 vtr(const LAS char* p) { return __builtin_bit_cast(s16x4, __builtin_amdgcn_ds_read_tr16_b64_v4i16((LAS s16x4*)p)); }

__device__ __forceinline__ void attn_unit(Frame& F, const Ptrs& P, int b, int h, int qb) {
    if (ATTN_PROF && TIME_PHASE >= 20 && blockIdx.x == 0 && F.tid == 0) F.MISC[15] = (unsigned)__builtin_amdgcn_s_memrealtime();
    const int tid = F.tid, lane = F.lane, wid = F.wave, r32 = lane & 31, hi = lane >> 5;
    const bf16_t* Patt = (const bf16_t*)(P.ws + WS_PATT);
    bf16_t* Ya = (bf16_t*)((unsigned char*)P.out + DO_YRA) + 512;
    LAS char* lds = (LAS char*)F.lds;
    LAS float* wsf = (LAS float*)(lds + L_WS) + wid * 64;
    LAS float* biasL = (LAS float*)(lds + L_BIAS);
    const int cq = wid >> 1, ci = qb * 4 + cq, kc0 = qb * 4 - 8;
    const size_t rowbase = (size_t)b * SEQ;
    for (int i = tid; i < 257; i += 512) biasL[i] = P.in[19][h * 257 + i] * LOG2E;
    const int srow = tid >> 3, sc8 = tid & 7;
    const int kdst = sc8 * 1024 + srow * 16, vdst = 8192 + (sc8 >> 2) * 4096 + (srow >> 4) * 1024 + (srow & 15) * 64 + (sc8 & 3) * 16;
    auto ld_k = [&](int j) -> u32x4 { return *(const u32x4*)(Patt + (rowbase + (size_t)(kc0 + j) * 64 + srow) * ACOLS + 512 + h * 64 + 8 * sc8); };
    auto ld_v = [&](int j) -> u32x4 { return *(const u32x4*)(Patt + (rowbase + (size_t)(kc0 + j) * 64 + srow) * ACOLS + 1024 + h * 64 + 8 * sc8); };
    auto st_kv = [&](int j, u32x4 kw, u32x4 vw) {
        LAS char* sl = lds + (j % NSL) * SLOT;
        *(LAS u32x4*)(sl + kdst) = kw; *(LAS u32x4*)(sl + vdst) = vw; };
    { u32x4 kws[4], vws[4];
#pragma unroll
      for (int j = 0; j < 4; ++j) if (kc0 + j >= 0) { kws[j] = ld_k(j); vws[j] = ld_v(j); }
#pragma unroll
      for (int j = 0; j < 4; ++j) if (kc0 + j >= 0) st_kv(j, kws[j], vws[j]); }
    const size_t qrow = rowbase + (size_t)ci * 64 + (wid & 1) * 32 + r32;
    bf16x8 qr[4];
#pragma unroll
    for (int d0 = 0; d0 < 4; ++d0) qr[d0] = *(const bf16x8*)(Patt + qrow * ACOLS + h * 64 + d0 * 16 + hi * 8);
    u32x4 kA, vA; if (kc0 + 4 >= 0) { kA = ld_k(4); vA = ld_v(4); }
    float mrun = 0.f, lrun = 0.f; f32x16 o0 = {}, o1 = {};
    const int qloc = (wid & 1) * 32 + r32;
    __syncthreads();
    APROF(0);
#pragma unroll 1
    for (int s = 0; s < 9; ++s) {
        const int jn = s + 4; const bool ld = (jn <= 11) && (kc0 + jn >= 0);
        const bool ldn = (jn + 1 <= 11) && (kc0 + jn + 1 >= 0); u32x4 kB, vB; if (ldn) { kB = ld_k(jn + 1); vB = ld_v(jn + 1); }
        const int j = cq + s;
        if (kc0 + j >= 0) {
            const LAS char* sl = lds + (j % NSL) * SLOT;
            f32x16 p0, p1;
            if (s <= 5) { const float c0 = biasL[0] - mrun;
#pragma unroll
                for (int r = 0; r < 16; ++r) { p0[r] = c0; p1[r] = c0; } }
            else { const int base = 64 * (s - 8) - qloc + 128;
#pragma unroll
                for (int r = 0; r < 16; ++r) { int i0 = base + crow(r, hi), i1 = i0 + 32; i0 = i0 < 0 ? 0 : (i0 > 256 ? 256 : i0); i1 = i1 < 0 ? 0 : (i1 > 256 ? 256 : i1); p0[r] = biasL[i0] - mrun; p1[r] = biasL[i1] - mrun; } }
            const LAS char* kb = sl + hi * 1024 + r32 * 16;
#pragma unroll
            for (int d0 = 0; d0 < 4; ++d0) { const bf16x8 b0 = *(const LAS bf16x8*)(kb + d0 * 2048), b1 = *(const LAS bf16x8*)(kb + d0 * 2048 + 512);
                p0 = __builtin_amdgcn_mfma_f32_32x32x16_bf16(b0, qr[d0], p0, 0, 0, 0); p1 = __builtin_amdgcn_mfma_f32_32x32x16_bf16(b1, qr[d0], p1, 0, 0, 0); }
            float a = max3f(p0[0], p0[1], p1[0]), bm = max3f(p0[2], p0[3], p1[1]); a = max3f(a, p1[2], p1[3]);
#pragma unroll
            for (int r = 4; r < 16; r += 4) { a = max3f(a, p0[r], p0[r + 1]); bm = max3f(bm, p0[r + 2], p0[r + 3]); a = max3f(a, p1[r], p1[r + 1]); bm = max3f(bm, p1[r + 2], p1[r + 3]); }
            float rm = fmaxf(a, bm); rm = fmaxf(rm, __shfl_xor(rm, 32));
            if (__any(rm > 8.f)) {
                const float dl = fmaxf(rm, 0.f), f = __builtin_amdgcn_exp2f(-dl); mrun += dl; lrun *= f;
#pragma unroll
                for (int r = 0; r < 16; ++r) { p0[r] -= dl; p1[r] -= dl; }
                if (hi == 0) wsf[r32] = f;
                LDS_WAIT(); asm volatile("" ::: "memory");
#pragma unroll
                for (int r = 0; r < 16; ++r) { const float fr_ = wsf[crow(r, hi)]; o0[r] *= fr_; o1[r] *= fr_; }
            }
            float sacc = 0.f;
#pragma unroll
            for (int r = 0; r < 16; ++r) { p0[r] = __builtin_amdgcn_exp2f(p0[r]); p1[r] = __builtin_amdgcn_exp2f(p1[r]); sacc += p0[r] + p1[r]; }
            lrun += sacc;
            u32x4 pw0, pw1, pw2, pw3;
            pw0 = (u32x4){cvt_pk_bf16(p0[0], p0[1]), cvt_pk_bf16(p0[2], p0[3]), cvt_pk_bf16(p0[4], p0[5]), cvt_pk_bf16(p0[6], p0[7])};
            pw1 = (u32x4){cvt_pk_bf16(p0[8], p0[9]), cvt_pk_bf16(p0[10], p0[11]), cvt_pk_bf16(p0[12], p0[13]), cvt_pk_bf16(p0[14], p0[15])};
            pw2 = (u32x4){cvt_pk_bf16(p1[0], p1[1]), cvt_pk_bf16(p1[2], p1[3]), cvt_pk_bf16(p1[4], p1[5]), cvt_pk_bf16(p1[6], p1[7])};
            pw3 = (u32x4){cvt_pk_bf16(p1[8], p1[9]), cvt_pk_bf16(p1[10], p1[11]), cvt_pk_bf16(p1[12], p1[13]), cvt_pk_bf16(p1[14], p1[15])};
            const LAS char* vp = sl + 8192 + ((lane >> 4) & 1) * 32 + (lane & 3) * 8 + (4 * hi + ((lane & 15) >> 2)) * 64;
            const bf16x8 pa[4] = {__builtin_bit_cast(bf16x8, pw0), __builtin_bit_cast(bf16x8, pw1), __builtin_bit_cast(bf16x8, pw2), __builtin_bit_cast(bf16x8, pw3)};
#pragma unroll
            for (int ks = 0; ks < 4; ++ks) {
                const s16x4 l0 = vtr(vp + ks * 1024), h0 = vtr(vp + ks * 1024 + 512), l1 = vtr(vp + 4096 + ks * 1024), h1 = vtr(vp + 4096 + ks * 1024 + 512);
                const bf16x8 v0 = (bf16x8){l0[0], l0[1], l0[2], l0[3], h0[0], h0[1], h0[2], h0[3]}, v1 = (bf16x8){l1[0], l1[1], l1[2], l1[3], h1[0], h1[1], h1[2], h1[3]};
                o0 = __builtin_amdgcn_mfma_f32_32x32x16_bf16(pa[ks], v0, o0, 0, 0, 0); o1 = __builtin_amdgcn_mfma_f32_32x32x16_bf16(pa[ks], v1, o1, 0, 0, 0); }
        }
        if (ld) st_kv(jn, kA, vA);
        APROF(1);
        LBAR();
        APROF(3);
        kA = kB; vA = vB;
    }
    lrun += __shfl_xor(lrun, 32);
    if (hi == 0) wsf[32 + r32] = lrun;
    LDS_WAIT(); asm volatile("" ::: "memory");
    LAS bf16_t* stg = (LAS bf16_t*)(lds + L_OST) + wid * 2048;
#pragma unroll
    for (int r = 0; r < 16; ++r) { const int orow = crow(r, hi); const float rl = __builtin_amdgcn_rcpf(wsf[32 + orow]);
        stg[orow * 64 + r32] = (bf16_t)(cvt_pk_bf16(o0[r] * rl, 0.f) & 0xffffu); stg[orow * 64 + 32 + r32] = (bf16_t)(cvt_pk_bf16(o1[r] * rl, 0.f) & 0xffffu); }
    LDS_WAIT(); asm volatile("" ::: "memory");
    bf16_t* Ow = Ya + (rowbase + (size_t)ci * 64 + (wid & 1) * 32) * 1024 + h * 64;
#pragma unroll
    for (int i = 0; i < 4; ++i) { const int row = i * 8 + (lane >> 3), ch = lane & 7; const u32x4 v = *(const LAS u32x4*)(stg + row * 64 + ch * 8); *(u32x4*)(Ow + (size_t)row * 1024 + ch * 8) = v; }
    __syncthreads();
    APROF(2);
}
}

#ifndef TIME_PHASE
#define TIME_PHASE -1
#endif
#define PROF(k) do { if (!ATTN_PROF && TIME_PHASE >= 20 && blockIdx.x == 0 && F.tid == 0) { const unsigned now_ = (unsigned)__builtin_amdgcn_s_memrealtime(); F.MISC[16 + (k)] += now_ - F.MISC[15]; F.MISC[15] = now_; } } while (0)
namespace rc {
constexpr int LDB = 72, MB = 64 * LDB * 2;
constexpr int FLD = 68, FB = 64 * FLD * 4;
constexpr int L_AT = 0, L_BH = MB, L_BT = 2 * MB, L_KT = 3 * MB, L_RT = 4 * MB, L_KH = 5 * MB, L_V = 6 * MB;
constexpr int L_TWD = 0, L_AD = 9216, L_SGD = 18432;
constexpr int RB = 8 * MB;
constexpr int L_WL = RB, L_AL = RB + FB, L_GL = RB + 2 * FB, L_SEG = RB + 3 * FB;
constexpr int L_NQ0 = RB, L_NQ1 = RB + MB, L_NT0 = RB + 2 * MB, L_NT1 = RB + 3 * MB, L_TQ0 = RB + 4 * MB, L_TQ1 = RB + 5 * MB, L_NKT = RB + 6 * MB, L_NRB = RB + 7 * MB;
constexpr int L_GLD = RB + 8 * MB;
constexpr int L_W1T = L_NQ0, L_W2T = L_NT0, L_WY = L_AT, L_KC = L_BT;
constexpr int L_TAB = L_GLD + 256;
constexpr int T_MUL = 0, T_MUR = 256, T_PAR = 448, T_N = 832;
constexpr int L_WUH = 7 * MB, L_AUH = L_TAB + T_N * 4;
static_assert(L_SEG + 2048 <= L_GLD && L_AUH + MB <= LDSCTL_OFF && L_WUH + MB <= RB, "rwkv chunk LDS");

__device__ __forceinline__ void unpack8(const u32x4 w, float* f) { f[0] = bf_lo(w.x); f[1] = bf_hi(w.x); f[2] = bf_lo(w.y); f[3] = bf_hi(w.y); f[4] = bf_lo(w.z); f[5] = bf_hi(w.z); f[6] = bf_lo(w.w); f[7] = bf_hi(w.w); }
__device__ __forceinline__ f32x16 mm64(f32x16 acc, const LAS char* Arows, const LAS char* Bcols, int lane) {
    const int o = ((lane & 31) * LDB + 8 * (lane >> 5)) * 2;
#pragma unroll
    for (int ks = 0; ks < 4; ++ks) { const bf16x8 a = *(const LAS bf16x8*)(Arows + o + 32 * ks), b = *(const LAS bf16x8*)(Bcols + o + 32 * ks); acc = __builtin_amdgcn_mfma_f32_32x32x16_bf16(a, b, acc, 0, 0, 0); }
    return acc;
}
__device__ __forceinline__ s16x4 trrd(const LAS char* p) { return __builtin_bit_cast(s16x4, __builtin_amdgcn_ds_read_tr16_b64_v4i16((LAS s16x4*)p)); }
__device__ __forceinline__ int tr_off(int lane) { return ((8 * (lane >> 5) + ((lane & 15) >> 2)) * LDB + 16 * ((lane >> 4) & 1) + 4 * (lane & 3)) * 2; }
__device__ __forceinline__ bf16x8 frag_tr(const LAS char* Xb, int ks) {
    const s16x4 lo = trrd(Xb + (16 * ks) * LDB * 2), hi = trrd(Xb + (16 * ks + 4) * LDB * 2);
    return (bf16x8){lo[0], lo[1], lo[2], lo[3], hi[0], hi[1], hi[2], hi[3]};
}
__device__ __forceinline__ f32x16 mm64_btr(f32x16 acc, const LAS char* Arows, const LAS char* X, int nb, int lane) {
    const int o = ((lane & 31) * LDB + 8 * (lane >> 5)) * 2; const LAS char* xb = X + 64 * nb + tr_off(lane);
#pragma unroll
    for (int ks = 0; ks < 4; ++ks) { const bf16x8 a = *(const LAS bf16x8*)(Arows + o + 32 * ks), b = frag_tr(xb, ks); acc = __builtin_amdgcn_mfma_f32_32x32x16_bf16(a, b, acc, 0, 0, 0); }
    return acc;
}
__device__ __forceinline__ f32x16 mm64_atr(f32x16 acc, const LAS char* X, int mb, const LAS char* Bcols, int lane) {
    const int o = ((lane & 31) * LDB + 8 * (lane >> 5)) * 2; const LAS char* xb = X + 64 * mb + tr_off(lane);
#pragma unroll
    for (int ks = 0; ks < 4; ++ks) { const bf16x8 a = frag_tr(xb, ks), b = *(const LAS bf16x8*)(Bcols + o + 32 * ks); acc = __builtin_amdgcn_mfma_f32_32x32x16_bf16(a, b, acc, 0, 0, 0); }
    return acc;
}
__device__ __forceinline__ void store_T(const f32x16& d, LAS char* dst, int mb, int nb, int lane) {
    LAS char* p = dst + ((32 * nb + (lane & 31)) * LDB + 32 * mb + 8 * (lane >> 5)) * 2;
#pragma unroll
    for (int g = 0; g < 4; g += 2) { const unsigned a0 = cvt_pk_bf16(d[4 * g], d[4 * g + 1]), a1 = cvt_pk_bf16(d[4 * g + 2], d[4 * g + 3]), b0 = cvt_pk_bf16(d[4 * g + 4], d[4 * g + 5]), b1 = cvt_pk_bf16(d[4 * g + 6], d[4 * g + 7]);
        const auto r0 = __builtin_amdgcn_permlane32_swap(a0, b0, false, false), r1 = __builtin_amdgcn_permlane32_swap(a1, b1, false, false);
        *(LAS u32x4*)(p + 16 * g) = (u32x4){r0[0], r1[0], r0[1], r1[1]}; }
}
__device__ __forceinline__ void store_T_g(const f32x16& d, bf16_t* dst, int mb, int nb, int lane) {
    bf16_t* p = dst + (32 * nb + (lane & 31)) * 64 + 32 * mb + 8 * (lane >> 5);
#pragma unroll
    for (int g = 0; g < 4; g += 2) { const unsigned a0 = cvt_pk_bf16(d[4 * g], d[4 * g + 1]), a1 = cvt_pk_bf16(d[4 * g + 2], d[4 * g + 3]), b0 = cvt_pk_bf16(d[4 * g + 4], d[4 * g + 5]), b1 = cvt_pk_bf16(d[4 * g + 6], d[4 * g + 7]);
        const auto r0 = __builtin_amdgcn_permlane32_swap(a0, b0, false, false), r1 = __builtin_amdgcn_permlane32_swap(a1, b1, false, false);
        *(u32x4*)(p + 8 * g) = (u32x4){r0[0], r1[0], r0[1], r1[1]}; }
}
#define RC_M(r) (32 * mb + 8 * ((r) >> 2) + 4 * hi + ((r) & 3))

struct Raw { u32x4 lc[4], lp[4], rc[3], rp[3]; };
__device__ __forceinline__ void load_raw(Raw& R, const bf16_t* Prw, int u, int t, int cg) {
    const int b = u >> 8, h = (u >> 5) & 7, c = u & 31;
    const size_t row = (size_t)b * SEQ + 64 * c + t; const bool hasprev = (c > 0) || (t > 0);
    const bf16_t* pc = Prw + row * RCOLS; const bf16_t* pp = pc - RCOLS; const int lc0 = 1536 + 32 * cg, hd = h * 64 + 8 * cg;
#pragma unroll
    for (int q = 0; q < 4; ++q) { R.lc[q] = *(const u32x4*)(pc + lc0 + 8 * q); R.lp[q] = hasprev ? *(const u32x4*)(pp + lc0 + 8 * q) : (u32x4){0u, 0u, 0u, 0u}; }
#pragma unroll
    for (int w = 0; w < 3; ++w) { R.rc[w] = *(const u32x4*)(pc + w * 512 + hd); R.rp[w] = hasprev ? *(const u32x4*)(pp + w * 512 + hd) : (u32x4){0u, 0u, 0u, 0u}; }
}
__device__ __forceinline__ void chunk_phase(Frame& F, const Ptrs& P) {
  const bf16_t* Prw = (const bf16_t*)(P.ws + WS_PRW);
  int htab = -1; Raw raw;
  if (!ATTN_PROF && TIME_PHASE >= 20 && blockIdx.x == 0 && F.tid == 0) F.MISC[15] = (unsigned)__builtin_amdgcn_s_memrealtime();
  if ((int)blockIdx.x < NB * 8 * 32) load_raw(raw, Prw, (int)blockIdx.x, F.tid >> 3, F.tid & 7);
#pragma unroll 1
  for (int u_ = (int)blockIdx.x; u_ < NB * 8 * 32; u_ += F.G) {
    int tid = F.tid, wid = F.wave; asm volatile("" : "+v"(tid), "+s"(wid));
    const int b = u_ >> 8, h = (u_ >> 5) & 7, c = u_ & 31;
    const int lane = tid & 63, t = tid >> 3, cg = tid & 7, r32 = lane & 31, hi = lane >> 5;
    LAS char* lds = (LAS char*)F.lds;
    const size_t u = (size_t)((b * 8 + h) * 32 + c);
    bf16_t* gQe = (bf16_t*)(P.ws + WS_QE) + u * 4096; bf16_t* gYl = (bf16_t*)(P.ws + WS_YLOC) + u * 4096; bf16_t* gPc = (bf16_t*)(P.ws + WS_PC) + u * 4096; bf16_t* gSl = (bf16_t*)(P.ws + WS_SLOC) + u * 4096;
    bf16_t* gG = (bf16_t*)((unsigned char*)P.out + DO_G) + u * 4096; bf16_t* Yr = (bf16_t*)((unsigned char*)P.out + DO_YRA);
    const int hd = h * 64 + 8 * cg;
    const bool is_ad = (cg == 2 || cg == 3); const float alpha = cg < 2 ? 2.f : 1.f, gamma = cg < 2 ? -1.f : 0.f;
    LAS bf16_t* ldst = (LAS bf16_t*)(lds + (cg < 2 ? L_TWD : (cg < 4 ? L_AD : L_SGD))) + t * (cg < 4 ? 72 : 136) + 32 * (cg < 2 ? cg : (cg < 4 ? cg - 2 : cg - 4));
    const size_t row = (size_t)b * SEQ + 64 * c + t;
    LAS float* tab = (LAS float*)(lds + L_TAB);
    if (h != htab) {
        htab = h;
        for (int i = tid; i < T_N; i += 512) { float v;
            if (i < T_MUR) v = P.in[6][1536 + i]; else if (i < T_PAR) { const int w = (i - T_MUR) >> 6, d = (i - T_MUR) & 63; v = P.in[6][w * 512 + h * 64 + d]; }
            else { const int w = (i - T_PAR) >> 6, d = (i - T_PAR) & 63; const float* src = w == 0 ? P.in[7] : (w == 1 ? P.in[9] : (w == 2 ? P.in[12] : (w == 3 ? P.in[13] : (w == 4 ? P.in[14] : P.in[16])))); v = src[h * 64 + d]; }
            tab[i] = v; }
        { const int row = tid >> 3, ch = tid & 7;
          *(LAS u32x4*)(lds + L_WUH + (row * LDB + ch * 8) * 2) = *(const u32x4*)((const bf16_t*)(P.ws + WS_WUP) + (size_t)(h * 64 + row) * 64 + ch * 8);
          *(LAS u32x4*)(lds + L_AUH + (row * LDB + ch * 8) * 2) = *(const u32x4*)((const bf16_t*)(P.ws + WS_AUP) + (size_t)(h * 64 + row) * 64 + ch * 8); }
        LBAR();
    }
    bf16x8 wG[8];
    { const bf16_t* wg = (const bf16_t*)(P.ws + WS_GUP) + (size_t)(h * 64 + ((wid >> 1) & 1) * 32 + r32) * 128 + 8 * hi;
#pragma unroll
      for (int ks = 0; ks < 8; ++ks) wG[ks] = *(const bf16x8*)(wg + 16 * ks); }
    float rv[8], kv[8], vv[8];
    { float cur[8], prv[8], mu[8];
#pragma unroll
      for (int q = 0; q < 4; ++q) {
          unpack8(raw.lc[q], cur); unpack8(raw.lp[q], prv);
          *(f32x4*)mu = *(const LAS f32x4*)(tab + T_MUL + 32 * cg + 8 * q); *(f32x4*)(mu + 4) = *(const LAS f32x4*)(tab + T_MUL + 32 * cg + 8 * q + 4);
          float o[8];
#pragma unroll
          for (int i = 0; i < 8; ++i) { const float xs = cur[i] + (prv[i] - cur[i]) * mu[i]; const float sg = sigmoidf_(alpha * xs); o[i] = is_ad ? xs : alpha * sg + gamma; }
          u32x4 w; w.x = cvt_pk_bf16(o[0], o[1]); w.y = cvt_pk_bf16(o[2], o[3]); w.z = cvt_pk_bf16(o[4], o[5]); w.w = cvt_pk_bf16(o[6], o[7]);
          *(LAS u32x4*)(ldst + 8 * q) = w; }
#pragma unroll
      for (int which = 0; which < 3; ++which) {
          unpack8(raw.rc[which], cur); unpack8(raw.rp[which], prv);
          *(f32x4*)mu = *(const LAS f32x4*)(tab + T_MUR + which * 64 + 8 * cg); *(f32x4*)(mu + 4) = *(const LAS f32x4*)(tab + T_MUR + which * 64 + 8 * cg + 4);
#pragma unroll
          for (int i = 0; i < 8; ++i) { const float xs = cur[i] + (prv[i] - cur[i]) * mu[i]; if (which == 0) rv[i] = xs; else if (which == 1) kv[i] = xs; else vv[i] = xs; } } }
    LBAR(); PROF(0);
    { const int ib = wid & 1, jb = (wid >> 1) & 1;
      auto wr4 = [&](const f32x16& acc, LAS float* Out) { LAS float* op = Out + (ib * 32 + r32) * FLD + jb * 32 + 4 * hi;
#pragma unroll
          for (int g = 0; g < 4; ++g) *(LAS f32x4*)(op + 8 * g) = (f32x4){acc[4 * g], acc[4 * g + 1], acc[4 * g + 2], acc[4 * g + 3]}; };
      { f32x16 acc = {}; const LAS bf16_t* qp = (const LAS bf16_t*)(lds + (wid < 4 ? L_TWD : L_AD)) + (ib * 32 + r32) * 72 + 8 * hi;
        const LAS bf16_t* wl = (const LAS bf16_t*)(lds + (wid < 4 ? L_WUH : L_AUH)) + (jb * 32 + r32) * LDB + 8 * hi;
#pragma unroll
        for (int ks = 0; ks < 4; ++ks) acc = __builtin_amdgcn_mfma_f32_32x32x16_bf16(*(const LAS bf16x8*)(wl + 16 * ks), *(const LAS bf16x8*)(qp + 16 * ks), acc, 0, 0, 0);
        wr4(acc, (LAS float*)(lds + (wid < 4 ? L_WL : L_AL))); }
      if (wid < 4) { f32x16 acc = {}; const LAS bf16_t* qp = (const LAS bf16_t*)(lds + L_SGD) + (ib * 32 + r32) * 136 + 8 * hi;
#pragma unroll
        for (int ks = 0; ks < 8; ++ks) acc = __builtin_amdgcn_mfma_f32_32x32x16_bf16(wG[ks], *(const LAS bf16x8*)(qp + 16 * ks), acc, 0, 0, 0);
        wr4(acc, (LAS float*)(lds + L_GL)); } }
    LBAR(); PROF(1);
    float lam[8], av[8], bv[8], kp[8];
    const int o68 = t * FLD + 8 * cg;
    { float wl[8], al[8], gv[8];
      *(f32x4*)wl = *(LAS f32x4*)(lds + L_WL + 4 * o68); *(f32x4*)(wl + 4) = *(LAS f32x4*)(lds + L_WL + 4 * o68 + 16);
      *(f32x4*)al = *(LAS f32x4*)(lds + L_AL + 4 * o68); *(f32x4*)(al + 4) = *(LAS f32x4*)(lds + L_AL + 4 * o68 + 16);
      *(f32x4*)gv = *(LAS f32x4*)(lds + L_GL + 4 * o68); *(f32x4*)(gv + 4) = *(LAS f32x4*)(lds + L_GL + 4 * o68 + 16);
      float w0[8], a0[8], kk_[8], ka[8], rk[8], lb[8];
      { const LAS float* tp = tab + T_PAR + 8 * cg;
        *(f32x4*)w0 = *(const LAS f32x4*)(tp); *(f32x4*)(w0 + 4) = *(const LAS f32x4*)(tp + 4);
        *(f32x4*)a0 = *(const LAS f32x4*)(tp + 64); *(f32x4*)(a0 + 4) = *(const LAS f32x4*)(tp + 68);
        *(f32x4*)kk_ = *(const LAS f32x4*)(tp + 128); *(f32x4*)(kk_ + 4) = *(const LAS f32x4*)(tp + 132);
        *(f32x4*)ka = *(const LAS f32x4*)(tp + 192); *(f32x4*)(ka + 4) = *(const LAS f32x4*)(tp + 196);
        *(f32x4*)rk = *(const LAS f32x4*)(tp + 256); *(f32x4*)(rk + 4) = *(const LAS f32x4*)(tp + 260);
        *(f32x4*)lb = *(const LAS f32x4*)(tp + 320); *(f32x4*)(lb + 4) = *(const LAS f32x4*)(tp + 324); }
      float asg[8], kkv[8], c2[8]; float ss = 0.f, bon = 0.f;
#pragma unroll
      for (int i = 0; i < 8; ++i) { lam[i] = 0.60653065971f * sigmoidf_(w0[i] + wl[i]); asg[i] = sigmoidf_(a0[i] + al[i]);
          kkv[i] = kv[i] * kk_[i]; ss += kkv[i] * kkv[i]; kp[i] = kv[i] * (1.f + (asg[i] - 1.f) * ka[i]); bon += rv[i] * kp[i] * rk[i]; }
      ss = red8(ss); bon = red8(bon);
      const float inv = 1.f / fmaxf(sqrtf(ss), 1e-12f);
#pragma unroll
      for (int i = 0; i < 8; ++i) { const float kn = kkv[i] * inv; av[i] = -kn; bv[i] = kn * asg[i]; c2[i] = (lb[i] + bon * vv[i]) * gv[i]; }
      u32x4 w; w.x = cvt_pk_bf16(gv[0], gv[1]); w.y = cvt_pk_bf16(gv[2], gv[3]); w.z = cvt_pk_bf16(gv[4], gv[5]); w.w = cvt_pk_bf16(gv[6], gv[7]);
      *(u32x4*)(gG + t * 64 + 8 * cg) = w;
      w.x = cvt_pk_bf16(c2[0], c2[1]); w.y = cvt_pk_bf16(c2[2], c2[3]); w.z = cvt_pk_bf16(c2[4], c2[5]); w.w = cvt_pk_bf16(c2[6], c2[7]);
      *(u32x4*)(Yr + row * 1024 + hd) = w; }
    float cum[8];
    { const int tl = lane >> 3;
#pragma unroll
      for (int i = 0; i < 8; ++i) { float x = lam[i];
          float y = __shfl_up(x, 8); x += (tl >= 1) ? y : 0.f; y = __shfl_up(x, 16); x += (tl >= 2) ? y : 0.f; y = __shfl_up(x, 32); x += (tl >= 4) ? y : 0.f;
          cum[i] = x; }
      if (tl == 7) { *(LAS f32x4*)(lds + L_SEG + (wid * 64 + 8 * cg) * 4) = *(f32x4*)cum; *(LAS f32x4*)(lds + L_SEG + (wid * 64 + 8 * cg) * 4 + 16) = *(f32x4*)(cum + 4); } }
    LBAR(); PROF(2);
    { float pre[8], tot[8];
#pragma unroll
      for (int i = 0; i < 8; ++i) { pre[i] = 0.f; tot[i] = 0.f; }
      const int myseg = t >> 3;
#pragma unroll
      for (int s = 0; s < 8; ++s) { float sv[8]; *(f32x4*)sv = *(LAS f32x4*)(lds + L_SEG + (s * 64 + 8 * cg) * 4); *(f32x4*)(sv + 4) = *(LAS f32x4*)(lds + L_SEG + (s * 64 + 8 * cg) * 4 + 16);
#pragma unroll
          for (int i = 0; i < 8; ++i) { tot[i] += sv[i]; pre[i] += (s < myseg) ? sv[i] : 0.f; } }
      float at_[8], bt_[8], kt_[8], rt_[8], bh_[8], kh_[8];
#pragma unroll
      for (int i = 0; i < 8; ++i) { const float cm = cum[i] + pre[i];
          const float gi = __builtin_amdgcn_exp2f(cm * LOG2E), g_ = __builtin_amdgcn_exp2f(-cm * LOG2E), gm1 = __builtin_amdgcn_exp2f(-(cm - lam[i]) * LOG2E), glg = __builtin_amdgcn_exp2f(-(tot[i] - cm) * LOG2E);
          at_[i] = av[i] * gm1; bt_[i] = bv[i] * gi; kt_[i] = kp[i] * gi; rt_[i] = rv[i] * g_; bh_[i] = bv[i] * glg; kh_[i] = kp[i] * glg; }
      if (t == 0) { float gl[8];
#pragma unroll
          for (int i = 0; i < 8; ++i) gl[i] = __builtin_amdgcn_exp2f(-tot[i] * LOG2E);
          *(LAS f32x4*)(lds + L_GLD + 32 * cg) = *(f32x4*)gl; *(LAS f32x4*)(lds + L_GLD + 32 * cg + 16) = *(f32x4*)(gl + 4); }
      const int ob = (t * LDB + 8 * cg) * 2; u32x4 w;
      w.x = cvt_pk_bf16(at_[0], at_[1]); w.y = cvt_pk_bf16(at_[2], at_[3]); w.z = cvt_pk_bf16(at_[4], at_[5]); w.w = cvt_pk_bf16(at_[6], at_[7]); *(LAS u32x4*)(lds + L_AT + ob) = w;
      w.x = cvt_pk_bf16(bt_[0], bt_[1]); w.y = cvt_pk_bf16(bt_[2], bt_[3]); w.z = cvt_pk_bf16(bt_[4], bt_[5]); w.w = cvt_pk_bf16(bt_[6], bt_[7]); *(LAS u32x4*)(lds + L_BT + ob) = w;
      w.x = cvt_pk_bf16(kt_[0], kt_[1]); w.y = cvt_pk_bf16(kt_[2], kt_[3]); w.z = cvt_pk_bf16(kt_[4], kt_[5]); w.w = cvt_pk_bf16(kt_[6], kt_[7]); *(LAS u32x4*)(lds + L_KT + ob) = w;
      w.x = cvt_pk_bf16(rt_[0], rt_[1]); w.y = cvt_pk_bf16(rt_[2], rt_[3]); w.z = cvt_pk_bf16(rt_[4], rt_[5]); w.w = cvt_pk_bf16(rt_[6], rt_[7]); *(LAS u32x4*)(lds + L_RT + ob) = w;
      w.x = cvt_pk_bf16(bh_[0], bh_[1]); w.y = cvt_pk_bf16(bh_[2], bh_[3]); w.z = cvt_pk_bf16(bh_[4], bh_[5]); w.w = cvt_pk_bf16(bh_[6], bh_[7]); *(LAS u32x4*)(lds + L_BH + ob) = w;
      w.x = cvt_pk_bf16(kh_[0], kh_[1]); w.y = cvt_pk_bf16(kh_[2], kh_[3]); w.z = cvt_pk_bf16(kh_[4], kh_[5]); w.w = cvt_pk_bf16(kh_[6], kh_[7]); *(LAS u32x4*)(lds + L_KH + ob) = w;
      w.x = cvt_pk_bf16(vv[0], vv[1]); w.y = cvt_pk_bf16(vv[2], vv[3]); w.z = cvt_pk_bf16(vv[4], vv[5]); w.w = cvt_pk_bf16(vv[6], vv[7]); *(LAS u32x4*)(lds + L_V + ob) = w; }
    LBAR(); PROF(4);
    load_raw(raw, Prw, (u_ + F.G < NB * 8 * 32) ? u_ + F.G : u_, t, cg);
    {
    wid = __builtin_amdgcn_readfirstlane(wid); asm volatile("" : "+v"(tid), "+s"(wid));
    const int lane = tid & 63, r32 = lane & 31, hi = lane >> 5;
    const int mb = wid & 1, nb = (wid >> 1) & 1, grp = wid >> 2;
    const int ao = 32 * mb * LDB * 2, bo = 32 * nb * LDB * 2;
    const int ncol = 32 * nb + r32;
    f32x16 accT = {};
    {
        f32x16 d = {};
        if (grp == 0) { d = mm64(d, lds + L_AT + ao, lds + L_KT + bo, lane);
#pragma unroll
            for (int r = 0; r < 16; ++r) d[r] = (ncol < RC_M(r)) ? d[r] : 0.f;
            store_T(d, lds + L_NKT, mb, nb, lane); }
        else { d = mm64(d, lds + L_BT + ao, lds + L_AT + bo, lane);
#pragma unroll
            for (int r = 0; r < 16; ++r) { d[r] = (RC_M(r) < ncol) ? d[r] : 0.f; accT[r] = d[r] + ((RC_M(r) == ncol) ? 1.f : 0.f); }
            store_T(d, lds + L_NQ0, mb, nb, lane); store_T(accT, lds + L_TQ0, mb, nb, lane); }
    }
    LBAR(); PROF(5);
#pragma unroll
    for (int j = 1; j <= 5; ++j) { const int cur = (j - 1) & 1, nw = j & 1;
        const int nq_c = cur ? L_NQ1 : L_NQ0, nq_n = nw ? L_NQ1 : L_NQ0;
        if (grp == 0) { f32x16 d = {}; d = mm64_atr(d, lds + nq_c, mb, lds + nq_c + bo, lane); store_T(d, lds + nq_n, mb, nb, lane); }
        else if (j == 1) { f32x16 e = {}; e = mm64(e, lds + L_BT + ao, lds + L_RT + bo, lane);
#pragma unroll
            for (int r = 0; r < 16; ++r) e[r] = (RC_M(r) <= ncol) ? e[r] : 0.f;
            store_T(e, lds + L_NRB, mb, nb, lane); }
        else { const int tq_r = nw ? L_TQ1 : L_TQ0, tq_w = cur ? L_TQ1 : L_TQ0;
            accT = mm64_atr(accT, lds + nq_c, mb, lds + tq_r + bo, lane); store_T(accT, lds + tq_w, mb, nb, lane); }
        LBAR();
    }
    if (grp == 1) { accT = mm64_atr(accT, lds + L_NQ1, mb, lds + L_TQ0 + bo, lane); store_T(accT, lds + L_TQ1, mb, nb, lane); }
    LBAR(); PROF(6);
    { f32x16 d = {};
      if (grp == 0) { d = mm64_btr(d, lds + L_TQ1 + ao, lds + L_AT, nb, lane); store_T(d, lds + L_W1T, mb, nb, lane); }
      else { d = mm64(d, lds + L_TQ1 + ao, lds + L_NKT + bo, lane); store_T(d, lds + L_W2T, mb, nb, lane); } }
    LBAR(); PROF(7);
    if (grp == 0) {
        f32x16 d = {}; d = mm64(d, lds + L_W1T + ao, lds + L_NRB + bo, lane);
#pragma unroll
        for (int g = 0; g < 4; ++g) { const u32x2 rw = *(const LAS u32x2*)(lds + L_RT + ((32 * nb + r32) * LDB + 32 * mb + 8 * g + 4 * hi) * 2);
            d[4 * g] += bf_lo(rw.x); d[4 * g + 1] += bf_hi(rw.x); d[4 * g + 2] += bf_lo(rw.y); d[4 * g + 3] += bf_hi(rw.y); }
        store_T_g(d, gQe, mb, nb, lane);
        f32x16 p = {}; p = mm64_btr(p, lds + L_W1T + ao, lds + L_BH, nb, lane);
        const float gl = ((const LAS float*)(lds + L_GLD))[ncol];
#pragma unroll
        for (int r = 0; r < 16; ++r) p[r] += (RC_M(r) == ncol) ? gl : 0.f;
        store_T_g(p, gPc, mb, nb, lane);
    } else {
        f32x16 d = {}; d = mm64(d, lds + L_KT + ao, lds + L_RT + bo, lane); d = mm64(d, lds + L_W2T + ao, lds + L_NRB + bo, lane);
#pragma unroll
        for (int r = 0; r < 16; ++r) d[r] = (RC_M(r) <= ncol) ? d[r] : 0.f;
        f32x16 k = {}; k = mm64_btr(k, lds + L_W2T + ao, lds + L_BH, nb, lane);
        { const LAS char* kb = lds + L_KH + 64 * nb + ((32 * mb + 4 * hi + ((lane & 15) >> 2)) * LDB + 16 * ((lane >> 4) & 1) + 4 * (lane & 3)) * 2;
#pragma unroll
          for (int g = 0; g < 4; ++g) { const s16x4 kw = trrd(kb + 8 * g * LDB * 2);
              k[4 * g] += bf_lo((unsigned)(unsigned short)kw[0]); k[4 * g + 1] += bf_lo((unsigned)(unsigned short)kw[1]); k[4 * g + 2] += bf_lo((unsigned)(unsigned short)kw[2]); k[4 * g + 3] += bf_lo((unsigned)(unsigned short)kw[3]); } }
        store_T(d, lds + L_WY, mb, nb, lane); store_T(k, lds + L_KC, mb, nb, lane);
    }
    LBAR(); PROF(8);
    { f32x16 d = {};
      if (grp == 0) { d = mm64_atr(d, lds + L_V, mb, lds + L_WY + bo, lane); store_T_g(d, gYl, mb, nb, lane); }
      else { d = mm64_btr(d, lds + L_KC + ao, lds + L_V, nb, lane); store_T_g(d, gSl, mb, nb, lane); } }
    LBAR(); PROF(9);
    }
  }
}

__device__ __forceinline__ void state_chain(Frame& F, const Ptrs& P, int bh) {
    const int tid = F.tid, lane = F.lane, wid = F.wave, r32 = lane & 31, hi = lane >> 5;
    LAS char* lds = (LAS char*)F.lds;
    const bf16_t* gPc = (const bf16_t*)(P.ws + WS_PC) + (size_t)bh * 32 * 4096; const bf16_t* gSl = (const bf16_t*)(P.ws + WS_SLOC) + (size_t)bh * 32 * 4096;
    bf16_t* gS = (bf16_t*)((unsigned char*)P.out + DO_SC) + (size_t)bh * 32 * 4096;
    constexpr int L_S0 = 0, L_S1 = MB, L_P = 2 * MB;
    for (int i = tid; i < MB / 4; i += 512) ((LAS unsigned*)(lds + L_S0))[i] = 0u;
    const int prow = tid >> 3, pch = tid & 7;
    const int mb = wid & 1, nb = (wid >> 1) & 1;
    u32x4 pw = *(const u32x4*)(gPc + prow * 64 + pch * 8), pw1 = *(const u32x4*)(gPc + 4096 + prow * 64 + pch * 8);
    const bf16_t* sp = gSl + (32 * nb + r32) * 64 + 32 * mb + 4 * hi;
    u32x2 sw[4];
#pragma unroll
    for (int g = 0; g < 4; ++g) sw[g] = wid < 4 ? *(const u32x2*)(sp + 8 * g) : (u32x2){0u, 0u};
    LBAR();
#pragma unroll 1
    for (int c = 0; c < 32; ++c) {
        const int sc = (c & 1) ? L_S1 : L_S0, sn = (c & 1) ? L_S0 : L_S1;
        *(LAS u32x4*)(lds + L_P + (prow * LDB + pch * 8) * 2) = pw;
        *(u32x4*)(gS + (size_t)c * 4096 + prow * 64 + pch * 8) = *(const LAS u32x4*)(lds + sc + (prow * LDB + pch * 8) * 2);
        pw = pw1; if (c + 2 < 32) pw1 = *(const u32x4*)(gPc + (size_t)(c + 2) * 4096 + prow * 64 + pch * 8);
        f32x16 d;
#pragma unroll
        for (int g = 0; g < 4; ++g) { const u32x2 w = sw[g]; d[4 * g] = bf_lo(w.x); d[4 * g + 1] = bf_hi(w.x); d[4 * g + 2] = bf_lo(w.y); d[4 * g + 3] = bf_hi(w.y); }
        if (wid < 4 && c + 1 < 32) {
#pragma unroll
            for (int g = 0; g < 4; ++g) sw[g] = *(const u32x2*)(sp + (size_t)(c + 1) * 4096 + 8 * g); }
        LBAR();
        if (wid < 4) { d = mm64(d, lds + L_P + 32 * mb * LDB * 2, lds + sc + 32 * nb * LDB * 2, lane); store_T(d, lds + sn, mb, nb, lane); }
        LBAR();
    }
}

__device__ __forceinline__ void hswap2(const u32x4 v, u32x2& own_g, u32x2& own_g1) {
    const auto r0 = __builtin_amdgcn_permlane32_swap(v.x, v.z, false, false), r1 = __builtin_amdgcn_permlane32_swap(v.y, v.w, false, false);
    own_g = (u32x2){r0[0], r1[0]}; own_g1 = (u32x2){r0[1], r1[1]};
}
__device__ __forceinline__ void out_unit(Frame& F, const Ptrs& P, int u, int nb, bool do_store = true) {
    const int lane = F.lane, r32 = lane & 31, hi = lane >> 5;
    const bf16_t* gQe = (const bf16_t*)(P.ws + WS_QE) + (size_t)u * 4096; const bf16_t* gYl = (const bf16_t*)(P.ws + WS_YLOC) + (size_t)u * 4096;
    const bf16_t* gS = (const bf16_t*)((unsigned char*)P.out + DO_SC) + (size_t)u * 4096; const bf16_t* gG = (const bf16_t*)((unsigned char*)P.out + DO_G) + (size_t)u * 4096;
    bf16_t* Yr = (bf16_t*)((unsigned char*)P.out + DO_YRA);
    const int bh = u >> 5, c = u & 31, h = bh & 7, b = bh >> 3;
    const int tl = 32 * nb + r32;
    const size_t row = (size_t)b * SEQ + 64 * c + tl;
    bf16_t* yo = Yr + row * 1024 + h * 64 + 4 * hi; const bf16_t* gg = gG + tl * 64 + 4 * hi; const float* lg = P.in[15] + h * 64 + 4 * hi; const bf16_t* yl = gYl + tl * 64 + 4 * hi;
    bf16x8 qf[4], sa[4], sb[4];
#pragma unroll
    for (int ks = 0; ks < 4; ++ks) { qf[ks] = *(const bf16x8*)(gQe + (32 * nb + r32) * 64 + 16 * ks + 8 * hi); sa[ks] = *(const bf16x8*)(gS + r32 * 64 + 16 * ks + 8 * hi); sb[ks] = *(const bf16x8*)(gS + (32 + r32) * 64 + 16 * ks + 8 * hi); }
    u32x2 ylw[2][4], gw[2][4], cw[2][4]; f32x4 l4[2][4];
#pragma unroll
    for (int eb = 0; eb < 2; ++eb)
#pragma unroll
        for (int g = 0; g < 4; g += 2) { const int eo = 32 * eb + 8 * g;
            const u32x4 a = *(const u32x4*)(yl + 4 * hi + eo), b = *(const u32x4*)(gg + 4 * hi + eo), c = *(const u32x4*)(yo + 4 * hi + eo);
            hswap2(a, ylw[eb][g], ylw[eb][g + 1]); hswap2(b, gw[eb][g], gw[eb][g + 1]); hswap2(c, cw[eb][g], cw[eb][g + 1]);
            l4[eb][g] = *(const f32x4*)(lg + eo); l4[eb][g + 1] = *(const f32x4*)(lg + eo + 8); }
    f32x16 y0 = {}, y1 = {};
#pragma unroll
    for (int ks = 0; ks < 4; ++ks) { y0 = __builtin_amdgcn_mfma_f32_32x32x16_bf16(sa[ks], qf[ks], y0, 0, 0, 0); y1 = __builtin_amdgcn_mfma_f32_32x32x16_bf16(sb[ks], qf[ks], y1, 0, 0, 0); }
    float s = 0.f;
#pragma unroll
    for (int g = 0; g < 4; ++g) { const u32x2 a = ylw[0][g], bq = ylw[1][g];
        y0[4 * g] += bf_lo(a.x); y0[4 * g + 1] += bf_hi(a.x); y0[4 * g + 2] += bf_lo(a.y); y0[4 * g + 3] += bf_hi(a.y);
        y1[4 * g] += bf_lo(bq.x); y1[4 * g + 1] += bf_hi(bq.x); y1[4 * g + 2] += bf_lo(bq.y); y1[4 * g + 3] += bf_hi(bq.y); }
#pragma unroll
    for (int r = 0; r < 16; ++r) s += y0[r] + y1[r];
    s += __shfl_xor(s, 32); const float mean = s * (1.f / 64.f); float q2 = 0.f;
#pragma unroll
    for (int r = 0; r < 16; ++r) { y0[r] -= mean; y1[r] -= mean; q2 += y0[r] * y0[r] + y1[r] * y1[r]; }
    q2 += __shfl_xor(q2, 32); const float rstd = 1.f / sqrtf(q2 * (1.f / 64.f) + 64e-5f);
#pragma unroll
    for (int g = 0; g < 4; g += 2) {
#pragma unroll
        for (int eb = 0; eb < 2; ++eb) { const int eo = 32 * eb + 8 * g; u32x2 w[2];
            const f32x16& y = eb ? y1 : y0;
#pragma unroll
            for (int q = 0; q < 2; ++q) { const int gq = g + q; const u32x2 g_ = gw[eb][gq], c_ = cw[eb][gq]; const f32x4 l_ = l4[eb][gq];
                const float o0 = y[4 * gq] * rstd * l_.x * bf_lo(g_.x) + bf_lo(c_.x), o1 = y[4 * gq + 1] * rstd * l_.y * bf_hi(g_.x) + bf_hi(c_.x), o2 = y[4 * gq + 2] * rstd * l_.z * bf_lo(g_.y) + bf_lo(c_.y), o3 = y[4 * gq + 3] * rstd * l_.w * bf_hi(g_.y) + bf_hi(c_.y);
                w[q].x = cvt_pk_bf16(o0, o1); w[q].y = cvt_pk_bf16(o2, o3); }
            const auto r0 = __builtin_amdgcn_permlane32_swap(w[0].x, w[1].x, false, false), r1 = __builtin_amdgcn_permlane32_swap(w[0].y, w[1].y, false, false);
            if (do_store) *(u32x4*)(yo + 4 * hi + eo) = (u32x4){r0[0], r1[0], r0[1], r1[1]}; } }
}
#undef RC_M
}
#ifndef RG
#define RG 4
#endif
#ifndef MOE_TAIL
#define MOE_TAIL 1
#endif
__device__ __forceinline__ void phase_route(Frame& F, const Ptrs& P) {
    const int lane = F.lane, gw = F.vcu * NWAVES + F.wave, NGW = F.G * NWAVES;
    const float* x1 = P.in[0]; const bf16_t* Dl = (const bf16_t*)(P.ws + WS_DELTA); const float* mod = (const float*)(P.ws + WS_MOD);
    const float* gam2 = (const float*)(P.ws + WS_GAM2); const float* cb = (const float*)(P.ws + WS_CB);
    const bf16_t* wrh = (const bf16_t*)(P.ws + WS_WRH); const bf16_t* wrl = (const bf16_t*)(P.ws + WS_WRL);
    bf16_t* H2 = (bf16_t*)(P.ws + WS_H2);
    int* tok_list = (int*)(P.ws + WS_TOKLIST); int* tok_pos = (int*)(P.ws + WS_TOKPOS); int* slot_tok = (int*)(P.ws + WS_SLOTTOK); float* slot_w = (float*)(P.ws + WS_SLOTW);
    unsigned* cnt = (unsigned*)(F.ctl + CW_CNT);
    constexpr int WROW = 1040, L_WH = 0, L_WLO = 48 * WROW, L_GAM = 2 * 48 * WROW, L_SCR = L_GAM + 4096, L_CNT = L_SCR + 8 * 16 * 52 * 4;
    static_assert(L_CNT + 1024 <= LDSCTL_OFF, "route LDS");
    LAS char* lds = (LAS char*)F.lds;
    LAS float* scr = (LAS float*)(lds + L_SCR) + F.wave * (16 * 52);
    const int fr = lane & 15, kq = lane >> 4;
    LAS unsigned* lcnt = (LAS unsigned*)(lds + L_CNT); LAS unsigned* lbase = lcnt + 64;
    for (int rnd = F.vcu; rnd < NTOK / 128; rnd += F.G) {
        const int R0 = rnd * 128 + F.wave * 16, b = R0 / SEQ;
        const float* xr = x1 + (size_t)(R0 + fr) * DM + 8 * kq; const bf16_t* dr = Dl + (size_t)(R0 + fr) * DM + 8 * kq;
        f32x4 acc[3] = {{0.f, 0.f, 0.f, 0.f}, {0.f, 0.f, 0.f, 0.f}, {0.f, 0.f, 0.f, 0.f}}; float ssq = 0.f;
#pragma unroll 1
        for (int half = 0; half < 2; ++half) {
            __syncthreads();
            if (half == 0) { if (F.tid < NLIST) lcnt[F.tid] = 0u; for (int i = F.tid; i < DM / 4; i += 512) *(LAS f32x4*)(lds + L_GAM + 16 * i) = *(const f32x4*)(gam2 + (size_t)b * DM + 4 * i); }
            for (int i = F.tid; i < 48 * 64; i += 512) { const int row = i >> 6, ch = i & 63;
                *(LAS u32x4*)(lds + L_WH + row * WROW + ch * 16) = *(const u32x4*)(wrh + (size_t)row * DM + half * 512 + ch * 8);
                *(LAS u32x4*)(lds + L_WLO + row * WROW + ch * 16) = *(const u32x4*)(wrl + (size_t)row * DM + half * 512 + ch * 8); }
            __syncthreads();
            const LAS char* bh = lds + L_WH + fr * WROW + kq * 16; const LAS char* bl = lds + L_WLO + fr * WROW + kq * 16; const LAS char* gp = lds + L_GAM + (half * 512 + 8 * kq) * 4;
#pragma unroll 2
            for (int kk = 0; kk < 512; kk += 32) { const int k0 = half * 512 + kk;
                f32x4 xa = *(const f32x4*)(xr + k0), xb = *(const f32x4*)(xr + k0 + 4); const f32x4 ga = *(const LAS f32x4*)(gp + kk * 4), gb = *(const LAS f32x4*)(gp + kk * 4 + 16);
                { const u32x4 dw = *(const u32x4*)(dr + k0); xa.x += bf_lo(dw.x); xa.y += bf_hi(dw.x); xa.z += bf_lo(dw.y); xa.w += bf_hi(dw.y); xb.x += bf_lo(dw.z); xb.y += bf_hi(dw.z); xb.z += bf_lo(dw.w); xb.w += bf_hi(dw.w); }
                { u32x4 xw; xw.x = cvt_pk_bf16(xa.x, xa.y); xw.y = cvt_pk_bf16(xa.z, xa.w); xw.z = cvt_pk_bf16(xb.x, xb.y); xw.w = cvt_pk_bf16(xb.z, xb.w); *(u32x4*)(const_cast<bf16_t*>(dr) + k0) = xw; }
                ssq += (xa.x * xa.x + xa.y * xa.y) + (xa.z * xa.z + xa.w * xa.w) + (xb.x * xb.x + xb.y * xb.y) + (xb.z * xb.z + xb.w * xb.w);
                const f32x4 ya = xa * ga, yb = xb * gb;
                u32x4 hw; hw.x = cvt_pk_bf16(ya.x, ya.y); hw.y = cvt_pk_bf16(ya.z, ya.w); hw.z = cvt_pk_bf16(yb.x, yb.y); hw.w = cvt_pk_bf16(yb.z, yb.w);
                u32x4 lw; lw.x = cvt_pk_bf16(ya.x - bf_lo(hw.x), ya.y - bf_hi(hw.x)); lw.y = cvt_pk_bf16(ya.z - bf_lo(hw.y), ya.w - bf_hi(hw.y));
                lw.z = cvt_pk_bf16(yb.x - bf_lo(hw.z), yb.y - bf_hi(hw.z)); lw.w = cvt_pk_bf16(yb.z - bf_lo(hw.w), yb.w - bf_hi(hw.w));
                const bf16x8 ah = __builtin_bit_cast(bf16x8, hw), al = __builtin_bit_cast(bf16x8, lw);
#pragma unroll
                for (int nb = 0; nb < 3; ++nb) { const bf16x8 wh = *(const LAS bf16x8*)(bh + nb * 16 * WROW + kk * 2), wl = *(const LAS bf16x8*)(bl + nb * 16 * WROW + kk * 2);
                    acc[nb] = __builtin_amdgcn_mfma_f32_16x16x32_bf16(ah, wh, acc[nb], 0, 0, 0); acc[nb] = __builtin_amdgcn_mfma_f32_16x16x32_bf16(al, wh, acc[nb], 0, 0, 0); acc[nb] = __builtin_amdgcn_mfma_f32_16x16x32_bf16(ah, wl, acc[nb], 0, 0, 0); }
            }
        }
        ssq += __shfl_xor(ssq, 16); ssq += __shfl_xor(ssq, 32);
        const float rinv = 1.f / sqrtf(ssq * (1.f / DM) + 1e-6f);
#pragma unroll
        for (int nb = 0; nb < 3; ++nb)
#pragma unroll
            for (int j = 0; j < 4; ++j) scr[(4 * kq + j) * 52 + 16 * nb + fr] = acc[nb][j];
        LDS_WAIT(); asm volatile("" ::: "memory");
        int l1 = 0, l2 = 0, q1 = 0, q2 = 0; float w1 = 0.f, w2 = 0.f;
        if (lane < 16) {
            const float* cbb = cb + b * 64; const LAS float* lr = scr + lane * 52;
            float lc[4]; int grp = 0; float best = -3.4e38f;
#pragma unroll
            for (int o = 0; o < 4; ++o) { lc[o] = rinv * lr[o] + cbb[o]; if (lc[o] > best) { best = lc[o]; grp = o; } }
            float den = 0.f;
#pragma unroll
            for (int o = 0; o < 4; ++o) den += __expf(lc[o] - best);
            const float pgrp = 1.f / den;
            float f1 = -3.4e38f, f2 = -3.4e38f; int i1 = 0, i2 = 0;
            for (int o = 0; o < 8; ++o) { const float v = rinv * lr[4 + grp * 8 + o] + cbb[4 + grp * 8 + o];
                if (v > f1) { f2 = f1; i2 = i1; f1 = v; i1 = o; } else if (v > f2) { f2 = v; i2 = o; } }
            const float e2 = __expf(f2 - f1); w1 = pgrp / (1.f + e2); w2 = pgrp * e2 / (1.f + e2);
            l1 = (grp * 8 + i1) * 2; l2 = (grp * 8 + i2) * 2 + 1;
            q1 = (int)__hip_atomic_fetch_add(lcnt + l1, 1u, __ATOMIC_RELAXED, __HIP_MEMORY_SCOPE_WORKGROUP); q2 = (int)__hip_atomic_fetch_add(lcnt + l2, 1u, __ATOMIC_RELAXED, __HIP_MEMORY_SCOPE_WORKGROUP);
        }
        __syncthreads();
        if (F.tid < NLIST) { const unsigned c = ((LAS unsigned*)lcnt)[F.tid]; lbase[F.tid] = c ? atomicAdd(cnt + 64 * F.tid, c) : 0u; }
        __syncthreads();
        if (lane < 16) { const int tok = R0 + lane;
            const int p1 = (int)lbase[l1] + q1, p2 = (int)lbase[l2] + q2;
            tok_list[2 * tok] = l1; tok_list[2 * tok + 1] = l2; tok_pos[2 * tok] = p1; tok_pos[2 * tok + 1] = p2;
            slot_tok[(size_t)l1 * NTOK + p1] = tok; slot_tok[(size_t)l2 * NTOK + p2] = tok; slot_w[(size_t)l1 * NTOK + p1] = w1; slot_w[(size_t)l2 * NTOK + p2] = w2; }
        const float* sh = mod + (size_t)b * MODW + 3 * DM;
        f32x4 gq[2][2], sq[2][2];
#pragma unroll
        for (int j = 0; j < 2; ++j)
#pragma unroll
            for (int q = 0; q < 2; ++q) { const int k = 8 * lane + 512 * j + 4 * q; gq[j][q] = *(const f32x4*)(gam2 + (size_t)b * DM + k); sq[j][q] = *(const f32x4*)(sh + k); }
#pragma unroll 1
        for (int r0 = 0; r0 < 16; r0 += RG) {
            u32x4 dq[RG][2];
#pragma unroll
            for (int rr = 0; rr < RG; ++rr) { const GAS u32x4* drow = (const GAS u32x4*)(Dl + (size_t)(R0 + r0 + rr) * DM) + lane;
#pragma unroll
                for (int j = 0; j < 2; ++j) dq[rr][j] = drow[64 * j]; }
#pragma unroll
            for (int rr = 0; rr < RG; ++rr) { const float ri = __shfl(rinv, r0 + rr);
                GAS u32x4* o8 = (GAS u32x4*)(H2 + (size_t)(R0 + r0 + rr) * DM) + lane;
#pragma unroll
                for (int j = 0; j < 2; ++j) { const u32x4 dw = dq[rr][j];
                    const f32x4 x0 = {bf_lo(dw.x), bf_hi(dw.x), bf_lo(dw.y), bf_hi(dw.y)}, x1v = {bf_lo(dw.z), bf_hi(dw.z), bf_lo(dw.w), bf_hi(dw.w)};
                    const f32x4 h0 = x0 * ri * gq[j][0] + sq[j][0], h1 = x1v * ri * gq[j][1] + sq[j][1];
                    u32x4 w; w.x = cvt_pk_bf16(h0.x, h0.y); w.y = cvt_pk_bf16(h0.z, h0.w); w.z = cvt_pk_bf16(h1.x, h1.y); w.w = cvt_pk_bf16(h1.z, h1.w); o8[64 * j] = w; } }
        }
        LDS_WAIT(); asm volatile("" ::: "memory");
    }
}
__device__ __forceinline__ void moe_offsets(Frame& F) {
    LAS int* toff = (LAS int*)(F.lds + TOFF_OFF); LAS int* lcnt = (LAS int*)(F.lds + LCNT_OFF); LAS unsigned char* tile_l = (LAS unsigned char*)(F.lds + TILE_L_OFF);
    static_assert(NLIST == 64, "one list per lane of wave 0");
    if (F.tid < NLIST) { const int cnt = (int)__hip_atomic_load(F.ctl + CW_CNT + 64 * F.tid, RLX_AGENT); lcnt[F.tid] = cnt;
        const int nt = (cnt + 255) >> 8; int inc = nt;
#pragma unroll
        for (int d = 1; d < 64; d <<= 1) { const int y = __shfl_up(inc, d); if ((int)F.tid >= d) inc += y; }
        toff[F.tid] = inc - nt; if (F.tid == NLIST - 1) toff[NLIST] = inc; }
    __syncthreads();
    if (F.tid < NLIST) { for (int t = toff[F.tid]; t < toff[F.tid + 1]; ++t) tile_l[t] = (unsigned char)F.tid; }
    __syncthreads();
}
#ifndef MK_ONE_LAUNCH
#define MK_ONE_LAUNCH 1
#endif
constexpr int N_PHASES = 12;

__global__ void __launch_bounds__(NWAVES * 64, 2) fwd_kernel(Args args) {
    extern __shared__ __attribute__((aligned(16))) unsigned char lds_raw[];
    Frame F; F.lds = (LAS unsigned char*)lds_raw; F.MISC = (volatile LAS unsigned*)(F.lds + MISC_OFF);
    F.tid = threadIdx.x; F.lane = F.tid & 63; F.wave = __builtin_amdgcn_readfirstlane(F.tid >> 6);
    F.G = gridDim.x; { const int bx = blockIdx.x; F.vcu = (F.G % 8 == 0) ? (bx % 8) * (F.G / 8) + bx / 8 : bx; }
#ifndef DUP_PHASE
#define DUP_PHASE -1
#endif
#define RELOAD_ARGS() Ptrs P; { int z_ = 0; asm volatile("" : "+s"(z_)); _Pragma("unroll") for (int i_ = 0; i_ < 31; ++i_) P.in[i_] = args.in[i_] + z_; P.out = args.out + z_; P.ws = args.ws + z_; }
    F.ctl = (gu32*)(args.ws + WS_CTL);
    for (int u = F.tid; u < (LDS_BYTES - LDSCTL_OFF) / 4; u += NWAVES * 64) ((LAS unsigned*)(F.lds + LDSCTL_OFF))[u] = 0u;
    __syncthreads();
    XcdBarrier bar; bar.bar = (unsigned*)(F.ctl + CW_BAR); bar.x = 0; bar.st = nullptr;
#if MK_ONE_LAUNCH
    bar = xcd_barrier_post((unsigned*)(F.ctl + CW_BAR), F.MISC + 8);
#define GRID_BAR() xcd_barrier(bar)
#else
#define GRID_BAR() do { } while (0)
#endif
    const int lo = args.ph_lo, hi = args.ph_hi;
#ifndef PH_MASK
#define PH_MASK 0xfff
#endif
#define IN(k) ((((PH_MASK) >> (k)) & 1) && lo <= (k) && (k) < hi)
#ifndef TIME_PHASE
#define TIME_PHASE -1
#endif
#define STAMP(i) do { if (TIME_PHASE >= 0 && blockIdx.x == 0 && F.tid == 0) ((unsigned long long*)(args.ws + WS_CTL + 768 * KiB))[i] = __builtin_amdgcn_s_memrealtime(); } while (0)
#define SEAM(k) do { if (IN(k) && IN((k) + 1)) GRID_BAR(); STAMP((k) + 1); } while (0)
    STAMP(0);
#ifndef GPROF_PHASE
#define GPROF_PHASE -1
#endif
#define GFLUSH(ph) do { if (GPROF_ON && GPROF_PHASE == (ph) && blockIdx.x == 0 && F.tid == 0) { unsigned long long* tsp = (unsigned long long*)(args.ws + WS_CTL + 768 * KiB); unsigned long long a_ = 0; tsp[20] = 0; for (int k_ = 0; k_ < 10; ++k_) { a_ += F.MISC[16 + k_]; tsp[21 + k_] = a_; } } } while (0)
#define MODP ((float*)(P.ws + WS_MOD))
#define PGATE ((unsigned char*)(P.ws + WS_PGATE))

    if (IN(0)) for (int rep_ = 0; rep_ < ((0) == DUP_PHASE ? 2 : 1); ++rep_) { if (rep_) GRID_BAR(); RELOAD_ARGS(); phase_mod(F, P.in[1], P.in[2], P.in[3], MODP, P.ws); { const int gw_ = F.vcu * NWAVES + F.wave; if (gw_ >= 96 * 16) expert_convert(F, P, gw_ - 96 * 16, F.G * NWAVES - 96 * 16, 0, P0_SHARE); } } SEAM(0);
    if (IN(1)) for (int rep_ = 0; rep_ < ((1) == DUP_PHASE ? 2 : 1); ++rep_) { if (rep_) GRID_BAR(); RELOAD_ARGS(); phase_prep(F, P); } SEAM(1);
    if (IN(2)) for (int rep_ = 0; rep_ < ((2) == DUP_PHASE ? 2 : 1); ++rep_) { if (rep_) GRID_BAR(); RELOAD_ARGS();
        pg8::Gemm g{DM, DM, DM}; pg8::DenseOrder S; S.init((const bf16_t*)((unsigned char*)P.out + DO_H), (const bf16_t*)(P.ws + WS_WIN), DM, DM, NTOK, INCOLS, F.G, (int)blockIdx.x);
        pg8::EpiP E{(bf16_t*)(P.ws + WS_PRW), (bf16_t*)(P.ws + WS_PATT), PGATE, P.in[17], P.in[18], (LAS float*)(F.lds + pg8::STAGE_BYTES)};
        pg8::gemm_phase<pg8::EpiP, pg8::DenseOrder, true>(F.lds, g, S, E); GFLUSH(2);
        { const int nfull = (NTOK / 256) * (INCOLS / 256) % F.G; const int bx = (int)blockIdx.x; if (nfull > 0 && bx >= nfull) expert_convert_down(F, P, (bx - nfull) * NWAVES + F.wave, (F.G - nfull) * NWAVES); else if (nfull == 0) expert_convert_down(F, P, bx * NWAVES + F.wave, F.G * NWAVES); }
    } SEAM(2);
    if (IN(3)) for (int rep_ = 0; rep_ < ((3) == DUP_PHASE ? 2 : 1); ++rep_) { if (rep_) GRID_BAR(); RELOAD_ARGS();
#pragma unroll 1
        for (int r2 = 0; r2 < (DUP_PHASE == 31 ? 2 : 1); ++r2)
#pragma unroll 1
        for (int u = (int)blockIdx.x; u < NB * 8 * 8; u += F.G) {
            int bh = u < 256 ? u >> 1 : (u - 256) / 6, qb = u < 256 ? u & 1 : 2 + (u - 256) % 6;
            if (F.G == 256) {
                const int x = u & 7, i = (u >> 3) & 31, k = u >> 8;
                if (k == 0) { bh = 16 * x + (i >> 1); qb = i & 1; } else { const int idx = (k - 1) * 32 + i; bh = 16 * x + idx / 6; qb = 2 + idx % 6; } }
            att::attn_unit(F, P, bh >> 3, bh & 7, qb); }
        __syncthreads();
#pragma unroll 1
        for (int r2 = 0; r2 < (DUP_PHASE == 30 ? 2 : 1); ++r2) rc::chunk_phase(F, P);
        if (TIME_PHASE >= 20 && GPROF_PHASE < 0 && blockIdx.x == 0 && F.tid == 0) { unsigned long long* tsp = (unsigned long long*)(args.ws + WS_CTL + 768 * KiB); unsigned long long a_ = 0; tsp[20] = 0; for (int k_ = 0; k_ < 10; ++k_) { a_ += F.MISC[16 + k_]; tsp[21 + k_] = a_; } }
    } SEAM(3);
    constexpr int EC_ITEMS = NE * 2 * 256, EC_SPLIT = EC_ITEMS;
    if (IN(4)) for (int rep_ = 0; rep_ < ((4) == DUP_PHASE ? 2 : 1); ++rep_) { if (rep_) GRID_BAR(); RELOAD_ARGS();
        const int nR = F.G >= 256 ? 128 : F.G / 2, bx = (int)blockIdx.x;
        if (bx < nR) { for (int u = bx; u < NB * 8; u += nR) rc::state_chain(F, P, u); }
        else { const int na = F.G - nR, a = bx - nR; expert_convert(F, P, a * NWAVES + F.wave, na * NWAVES, P0_SHARE, EC_SPLIT); }
    } SEAM(4);
    if (IN(5)) for (int rep_ = 0; rep_ < ((5) == DUP_PHASE ? 2 : 1); ++rep_) { if (rep_) GRID_BAR(); RELOAD_ARGS();
        const int gw = (int)blockIdx.x * NWAVES + F.wave, NGW = F.G * NWAVES;
        for (int w = gw; w < NB * 8 * 32 * 2; w += NGW) rc::out_unit(F, P, w >> 1, w & 1, !(DUP_PHASE == 5 && rep_ == 0));
        expert_convert(F, P, gw, NGW, EC_SPLIT, EC_ITEMS);
    } SEAM(5);
    if (IN(6)) for (int rep_ = 0; rep_ < ((6) == DUP_PHASE ? 2 : 1); ++rep_) { if (rep_) GRID_BAR(); RELOAD_ARGS();
        pg8::Gemm g{DM, DM, DM}; pg8::DenseOrder S; S.init((const bf16_t*)((unsigned char*)P.out + DO_YRA), (const bf16_t*)(P.ws + WS_WBR), DM, DM, NTOK, DM, F.G, (int)blockIdx.x);
        pg8::EpiMix E{(bf16_t*)(P.ws + WS_T), PGATE}; pg8::gemm_phase<pg8::EpiMix, pg8::DenseOrder, true>(F.lds, g, S, E);
    } SEAM(6);
    if (IN(7)) for (int rep_ = 0; rep_ < ((7) == DUP_PHASE ? 2 : 1); ++rep_) { if (rep_) GRID_BAR(); RELOAD_ARGS();
        pg8::Gemm g{DM, DM, DM}; pg8::DenseOrder S; S.init((const bf16_t*)(P.ws + WS_T), (const bf16_t*)(P.ws + WS_WOUT), DM, DM, NTOK, DM, F.G, (int)blockIdx.x);
        pg8::EpiDelta E{(bf16_t*)(P.ws + WS_DELTA), MODP}; pg8::gemm_phase<pg8::EpiDelta, pg8::DenseOrder, true>(F.lds, g, S, E); GFLUSH(7);
    } SEAM(7);
    if (IN(8)) for (int rep_ = 0; rep_ < ((8) == DUP_PHASE ? 2 : 1); ++rep_) { if (rep_) GRID_BAR(); RELOAD_ARGS(); phase_route(F, P); } SEAM(8);
    bool moe_ready = false;
    if (IN(9)) for (int rep_ = 0; rep_ < ((9) == DUP_PHASE ? 2 : 1); ++rep_) { if (rep_) GRID_BAR(); RELOAD_ARGS();
        if (!moe_ready) { moe_offsets(F); moe_ready = true; } const LAS int* toff = (const LAS int*)(F.lds + TOFF_OFF);
        pg8::Gemm g{DM, DM, DM}; pg8::MoeOrderT<true> S{(const bf16_t*)(P.ws + WS_H2), (const bf16_t*)(P.ws + WS_WGU), DM, DM, (size_t)DM * DM, (const LAS unsigned char*)(F.lds + TILE_L_OFF), toff, (const LAS int*)(F.lds + LCNT_OFF), 0, toff[NLIST], F.G, (int)blockIdx.x, (const int*)(P.ws + WS_SLOTTOK), P0_SHARE / 512, (long long)WS_WGU0 - (long long)WS_WGU};
        pg8::EpiHid E{(bf16_t*)(P.ws + WS_HID)};
#if MOE_TAIL
        S.mode = 1; pg8::gemm_phase<pg8::EpiHid, pg8::MoeOrderT<true>, true>(F.lds, g, S, E);
        { pg8::EpiHidT<1> E1{(bf16_t*)(P.ws + WS_HID)}; S.mode = 2; pg8::gemm_phase<pg8::EpiHidT<1>, pg8::MoeOrderT<true>, true, 1>(F.lds, g, S, E1); }
#else
        pg8::gemm_phase<pg8::EpiHid, pg8::MoeOrderT<true>, true>(F.lds, g, S, E);
#endif GFLUSH(9);
    } SEAM(9);
    if (IN(10)) for (int rep_ = 0; rep_ < ((10) == DUP_PHASE ? 2 : 1); ++rep_) { if (rep_) GRID_BAR(); RELOAD_ARGS();
        if (!moe_ready) { moe_offsets(F); moe_ready = true; } const LAS int* toff = (const LAS int*)(F.lds + TOFF_OFF);
        pg8::Gemm g{DE, DE, DE}; pg8::MoeOrderT<false> S{(const bf16_t*)(P.ws + WS_HID), (const bf16_t*)(P.ws + WS_WD), DE, DE, (size_t)DM * DE, (const LAS unsigned char*)(F.lds + TILE_L_OFF), toff, (const LAS int*)(F.lds + LCNT_OFF), 0, toff[NLIST], F.G, (int)blockIdx.x, nullptr};
        pg8::EpiY E{(bf16_t*)(P.ws + WS_YB), (const float*)(P.ws + WS_SLOTW)};
#if MOE_TAIL
        S.mode = 1; pg8::gemm_phase<pg8::EpiY, pg8::MoeOrderT<false>, true>(F.lds, g, S, E);
        { pg8::EpiYT<1> E1{(bf16_t*)(P.ws + WS_YB), (const float*)(P.ws + WS_SLOTW)}; S.mode = 2; pg8::gemm_phase<pg8::EpiYT<1>, pg8::MoeOrderT<false>, true, 1>(F.lds, g, S, E1); }
#else
        pg8::gemm_phase<pg8::EpiY, pg8::MoeOrderT<false>, true>(F.lds, g, S, E);
#endif GFLUSH(10);
    } SEAM(10);
    if (IN(11)) for (int rep_ = 0; rep_ < ((11) == DUP_PHASE ? 2 : 1); ++rep_) { if (rep_) GRID_BAR(); RELOAD_ARGS();
        if (!moe_ready) { moe_offsets(F); moe_ready = true; } const LAS int* toff = (const LAS int*)(F.lds + TOFF_OFF);
        const bf16_t* Yb = (const bf16_t*)(P.ws + WS_YB); const int* tok_list = (const int*)(P.ws + WS_TOKLIST); const int* tok_pos = (const int*)(P.ws + WS_TOKPOS);
        const float* mod = MODP; const int gw = F.vcu * NWAVES + F.wave, NGW = F.G * NWAVES;
#pragma unroll 4
        for (int tok = gw; tok < NTOK; tok += NGW) {
            const int s0 = toff[tok_list[2 * tok]] * 256 + tok_pos[2 * tok], s1 = toff[tok_list[2 * tok + 1]] * 256 + tok_pos[2 * tok + 1];
            const float* g2 = mod + (size_t)(tok / SEQ) * MODW + 5 * DM;
            GAS f32x4* xo = (GAS f32x4*)(P.out + (size_t)tok * DM) + 2 * F.lane; const GAS u32x4* dd = (const GAS u32x4*)((const bf16_t*)(P.ws + WS_DELTA) + (size_t)tok * DM) + F.lane;
            const GAS u32x4* y0 = (const GAS u32x4*)(Yb + (size_t)s0 * DM) + F.lane; const GAS u32x4* y1 = (const GAS u32x4*)(Yb + (size_t)s1 * DM) + F.lane;
            u32x4 xb[2], ya[2], yb[2];
#pragma unroll
            for (int j = 0; j < 2; ++j) { xb[j] = __builtin_nontemporal_load(dd + 64 * j); ya[j] = __builtin_nontemporal_load(y0 + 64 * j); yb[j] = __builtin_nontemporal_load(y1 + 64 * j); }
#pragma unroll
            for (int j = 0; j < 2; ++j) { const f32x4 g0 = *(const f32x4*)(g2 + 8 * F.lane + 512 * j), g1 = *(const f32x4*)(g2 + 8 * F.lane + 512 * j + 4);
                const u32x4 xw = xb[j], a = ya[j], bq = yb[j];
                f32x4 o0, o1;
                o0.x = bf_lo(xw.x) + g0.x * (bf_lo(a.x) + bf_lo(bq.x)); o0.y = bf_hi(xw.x) + g0.y * (bf_hi(a.x) + bf_hi(bq.x)); o0.z = bf_lo(xw.y) + g0.z * (bf_lo(a.y) + bf_lo(bq.y)); o0.w = bf_hi(xw.y) + g0.w * (bf_hi(a.y) + bf_hi(bq.y));
                o1.x = bf_lo(xw.z) + g1.x * (bf_lo(a.z) + bf_lo(bq.z)); o1.y = bf_hi(xw.z) + g1.y * (bf_hi(a.z) + bf_hi(bq.z)); o1.z = bf_lo(xw.w) + g1.z * (bf_lo(a.w) + bf_lo(bq.w)); o1.w = bf_hi(xw.w) + g1.w * (bf_hi(a.w) + bf_hi(bq.w));
                __builtin_nontemporal_store(o0, xo + 128 * j); __builtin_nontemporal_store(o1, xo + 128 * j + 1); }
        }
    }
#ifdef EXTRA_BARS
    for (int i_ = 0; i_ < EXTRA_BARS; ++i_) GRID_BAR();
#endif
#if TIME_PHASE >= 0
    {
#ifndef TIME_SCALE
#define TIME_SCALE 3.0e-4f
#endif
#ifndef TIME_HI
#define TIME_HI (TIME_PHASE + 1)
#endif
        STAMP(12); GRID_BAR();
        const unsigned long long* ts = (const unsigned long long*)(args.ws + WS_CTL + 768 * KiB);
        const float dlt = (float)(ts[TIME_HI] - ts[TIME_PHASE]) * (0.01f * TIME_SCALE);
        for (int i = blockIdx.x * 512 + F.tid; i < (1 << 20); i += gridDim.x * 512) args.out[i] += dlt;
    }
#endif
#undef IN
#undef SEAM
}

extern "C" void kernel_launch(void* const* d_in, const int* in_sizes, int n_in, void* d_out, int out_size, void* d_ws, size_t ws_size, hipStream_t stream) {
    static int grid = 0;
    if (grid == 0) {
        if (n_in != 31 || out_size != NTOK * DM || ws_size < WS_END) { fprintf(stderr, "kernel_launch: unexpected shapes (n_in %d out %d ws %zu)\n", n_in, out_size, ws_size); grid = -1; return; }
        int dev = 0, cus = 0;
        if (hipGetDevice(&dev) != hipSuccess || hipDeviceGetAttribute(&cus, hipDeviceAttributeMultiprocessorCount, dev) != hipSuccess) { grid = -1; return; }
        if (hipFuncSetAttribute((const void*)fwd_kernel, hipFuncAttributeMaxDynamicSharedMemorySize, LDS_BYTES) != hipSuccess) { fprintf(stderr, "kernel_launch: hipFuncSetAttribute failed\n"); grid = -1; return; }
        int per_cu = 0; (void)hipOccupancyMaxActiveBlocksPerMultiprocessor(&per_cu, (const void*)fwd_kernel, NWAVES * 64, LDS_BYTES); (void)hipGetLastError();
        grid = cus;
    }
    if (grid < 0) return;
    (void)hipMemsetAsync((char*)d_ws + WS_CTL, 0, CTL_ZERO_BYTES, stream);
    Args a{};
    for (int i = 0; i < 31; ++i) a.in[i] = (const float*)d_in[i];
    a.out = (float*)d_out; a.ws = (unsigned char*)d_ws;
#if MK_ONE_LAUNCH
    a.ph_lo = 0; a.ph_hi = N_PHASES;
    hipLaunchKernelGGL(fwd_kernel, dim3(grid), dim3(NWAVES * 64), LDS_BYTES, stream, a);
#else
    for (int p = 0; p < N_PHASES; ++p) {
        a.ph_lo = p; a.ph_hi = p + 1; hipLaunchKernelGGL(fwd_kernel, dim3(grid), dim3(NWAVES * 64), LDS_BYTES, stream, a); }
#endif
}
```
